# Optimizing an MI355X kernel written in HIP

```python
import math
import jax, jax.numpy as jnp
from jax import lax
import numpy as np

D_MODEL = 1024
BATCH = 2
SEQ = 16384
DEPTH = 1

EPS = 1e-5
NEG_INF = -1e30

A_HEADS = 8
A_HEAD_DIM = 64
A_WIDTH = A_HEADS * A_HEAD_DIM
A_PATTERNS = ((128, 1), (512, 4), (2048, 16))
A_QBLOCK = 64

B_HEADS = 8
B_NOPE = 64
B_ROPE = 32
B_V = 64
B_WIDTH = B_HEADS * B_V
Q_LORA = 256
KV_LORA = 128
ROPE_THETA = 10000.0
B_QBLOCK = 128

OFF_QA = 0
OFF_KA = OFF_QA + A_WIDTH
OFF_VA = OFF_KA + A_WIDTH
OFF_CQ = OFF_VA + A_WIDTH
OFF_CKV = OFF_CQ + Q_LORA
OFF_KR = OFF_CKV + KV_LORA
OFF_GA = OFF_KR + B_ROPE
OFF_GB = OFF_GA + D_MODEL
IN_COLS = OFF_GB + D_MODEL

N_EXPERTS = 32
TOP_K = 4
D_EXPERT = D_MODEL
SWIGLU_LIMIT = 7.0
SWIGLU_ALPHA = 1.702
MOE_BLOCK = 256

kernel_name = "hybrid_dilated_mla_moe_encoder"


def rmsnorm(x, g):
    xf = x.astype(jnp.float32)
    y = xf * lax.rsqrt(jnp.mean(xf * xf, axis=-1, keepdims=True) + EPS)
    return (y * g.astype(jnp.float32)).astype(x.dtype)


def alibi_slopes(n_heads):
    return 2.0 ** (-8.0 * (jnp.arange(n_heads, dtype=jnp.float32) + 1.0) / n_heads)


def dilated_pattern(q, k, v, window, dilation, slopes):
    B, S, H, Dh = q.shape
    hw = window // (2 * dilation)
    L = S // dilation
    nb = -(-L // A_QBLOCK)
    Lp = nb * A_QBLOCK
    W = A_QBLOCK + 2 * hw

    def strided(t):
        return t.reshape(B, L, dilation, H, Dh).transpose(0, 2, 1, 3, 4)

    qs = jnp.pad(strided(q), ((0, 0), (0, 0), (0, Lp - L), (0, 0), (0, 0)))
    kpad = ((0, 0), (0, 0), (hw, Lp - L + hw), (0, 0), (0, 0))
    ks = jnp.pad(strided(k), kpad)
    vs = jnp.pad(strided(v), kpad)
    qb = qs.reshape(B, dilation, nb, A_QBLOCK, H, Dh)
    kidx = jnp.arange(nb)[:, None] * A_QBLOCK + jnp.arange(W)[None, :]
    kb = ks[:, :, kidx]
    vb = vs[:, :, kidx]
    qpos = jnp.arange(nb)[:, None] * A_QBLOCK + jnp.arange(A_QBLOCK)[None, :]
    kpos = kidx - hw
    rel = kpos[:, None, :] - qpos[:, :, None]
    valid = (jnp.abs(rel) <= hw) & (kpos[:, None, :] >= 0) & (kpos[:, None, :] < L)
    dist = (jnp.abs(rel) * dilation).astype(jnp.float32)
    bias = -slopes[None, :, None, None] * dist[:, None, :, :]
    s = jnp.einsum('bdnqhe,bdnkhe->bdnhqk', qb, kb).astype(jnp.float32) * (A_HEAD_DIM ** -0.5)
    s = jnp.where(valid[:, None], s + bias, NEG_INF)
    m = jnp.max(s, axis=-1, keepdims=True)
    p = jnp.exp(s - m)
    l = jnp.sum(p, axis=-1)
    o = jnp.einsum('bdnhqk,bdnkhe->bdnqhe', (p / l[..., None]).astype(v.dtype), vb).astype(jnp.float32)
    lse = m[..., 0] + jnp.log(l)
    o = o.reshape(B, dilation, Lp, H, Dh)[:, :, :L].transpose(0, 2, 1, 3, 4).reshape(B, S, H, Dh)
    lse = lse.transpose(0, 1, 2, 4, 3).reshape(B, dilation, Lp, H)[:, :, :L]
    lse = lse.transpose(0, 2, 1, 3).reshape(B, S, H)
    return o, lse


def dilated_mixture(q, k, v):
    slopes = alibi_slopes(A_HEADS)
    outs, lses = [], []
    for window, dilation in A_PATTERNS:
        o, lse = dilated_pattern(q, k, v, window, dilation, slopes)
        outs.append(o)
        lses.append(lse)
    w = jax.nn.softmax(jnp.stack(lses, axis=0), axis=0)
    o = jnp.sum(w[..., None] * jnp.stack(outs, axis=0), axis=0)
    B, S = q.shape[0], q.shape[1]
    return o.reshape(B, S, A_WIDTH).astype(q.dtype)


def rope(x, cos, sin):
    xf = x.astype(jnp.float32)
    half = xf.shape[-1] // 2
    x1, x2 = xf[..., :half], xf[..., half:]
    return jnp.concatenate([x1 * cos - x2 * sin, x2 * cos + x1 * sin], axis=-1).astype(x.dtype)


def mla(c_q_raw, c_kv_raw, k_rope_raw, g_q, g_kv, w_uq, w_uk, w_uv):
    B, S, _ = c_q_raw.shape
    c_q = rmsnorm(c_q_raw, g_q)
    q = jnp.einsum('bsr,rhe->bshe', c_q, w_uq)
    q_nope, q_rope = q[..., :B_NOPE], q[..., B_NOPE:]
    c_kv = rmsnorm(c_kv_raw, g_kv)
    k_nope = jnp.einsum('bsr,rhe->bshe', c_kv, w_uk)
    v = jnp.einsum('bsr,rhe->bshe', c_kv, w_uv)
    pos = jnp.arange(S, dtype=jnp.float32)
    inv_freq = ROPE_THETA ** (-jnp.arange(0, B_ROPE, 2, dtype=jnp.float32) / B_ROPE)
    ang = pos[:, None] * inv_freq[None, :]
    cos, sin = jnp.cos(ang), jnp.sin(ang)
    q_rope = rope(q_rope, cos[None, :, None], sin[None, :, None])
    k_rope = rope(k_rope_raw, cos[None], sin[None])
    scale = (B_NOPE + B_ROPE) ** -0.5
    nb = S // B_QBLOCK
    qn = q_nope.reshape(B, nb, B_QBLOCK, B_HEADS, B_NOPE).transpose(1, 0, 2, 3, 4)
    qr = q_rope.reshape(B, nb, B_QBLOCK, B_HEADS, B_ROPE).transpose(1, 0, 2, 3, 4)

    def attend(blk):
        qn_b, qr_b = blk
        s = (jnp.einsum('bqhe,bkhe->bhqk', qn_b, k_nope)
             + jnp.einsum('bqhe,bke->bhqk', qr_b, k_rope)).astype(jnp.float32) * scale
        p = jax.nn.softmax(s, axis=-1)
        return jnp.einsum('bhqk,bkhe->bqhe', p.astype(v.dtype), v)

    o = lax.map(attend, (qn, qr))
    return o.transpose(1, 0, 2, 3, 4).reshape(B, S, B_WIDTH)


def moe(h, w_router, b_router, w_gu, b_gu, w_down, b_down):
    B, S, D = h.shape
    T = B * S
    xt = h.reshape(T, D)
    logits = (xt @ w_router + b_router).astype(jnp.float32)
    top_v, top_i = lax.top_k(logits, TOP_K)
    gates = jax.nn.softmax(top_v, axis=-1)
    N = T * TOP_K
    e_flat = top_i.reshape(N).astype(jnp.int32)
    tok_flat = (jnp.arange(N, dtype=jnp.int32) // TOP_K).astype(jnp.int32)
    g_flat = gates.reshape(N)
    order = jnp.argsort(e_flat)
    e_sorted = e_flat[order]
    counts = jnp.bincount(e_flat, length=N_EXPERTS).astype(jnp.int32)
    padded = (counts + MOE_BLOCK - 1) // MOE_BLOCK * MOE_BLOCK
    start = jnp.cumsum(counts) - counts
    pend = jnp.cumsum(padded)
    pstart = pend - padded
    rank = jnp.arange(N, dtype=jnp.int32) - start[e_sorted]
    dest = pstart[e_sorted] + rank
    NP = N + N_EXPERTS * MOE_BLOCK
    row_tok = jnp.full((NP,), T, dtype=jnp.int32).at[dest].set(tok_flat[order])
    row_w = jnp.zeros((NP,), jnp.float32).at[dest].set(g_flat[order])
    nblk = NP // MOE_BLOCK
    blk_start = jnp.arange(nblk, dtype=jnp.int32) * MOE_BLOCK
    blk_e = jnp.minimum(jnp.sum(pend[None, :] <= blk_start[:, None], axis=1), N_EXPERTS - 1).astype(jnp.int32)
    x_pad = jnp.concatenate([xt, jnp.zeros((1, D), xt.dtype)], axis=0)
    xb = x_pad[row_tok].reshape(nblk, MOE_BLOCK, D)

    def expert_block(args):
        xblk, e = args
        gu = xblk @ w_gu[e] + b_gu[e]
        gate = jnp.minimum(gu[:, :D_EXPERT], SWIGLU_LIMIT)
        up = jnp.clip(gu[:, D_EXPERT:], -SWIGLU_LIMIT, SWIGLU_LIMIT)
        act = (up + 1.0) * (gate * jax.nn.sigmoid(SWIGLU_ALPHA * gate))
        return act @ w_down[e] + b_down[e]

    yb = lax.map(expert_block, (xb, blk_e)).reshape(NP, D)
    out = jnp.zeros((T + 1, D), jnp.float32).at[row_tok].add(row_w[:, None] * yb.astype(jnp.float32))
    return out[:T].reshape(B, S, D).astype(h.dtype)


def setup_inputs(seed: int = 0) -> dict:
    key = jax.random.key(seed)
    ks = jax.random.split(key, 20)
    n = jax.random.normal
    f = jnp.float32
    return {
        "x": n(ks[0], (BATCH, SEQ, D_MODEL), f),
        "norm1_g": 1.0 + 0.02 * n(ks[1], (DEPTH, D_MODEL), f),
        "w_in": n(ks[2], (DEPTH, D_MODEL, IN_COLS), f) * D_MODEL ** -0.5,
        "q_a_norm_g": 1.0 + 0.02 * n(ks[3], (DEPTH, Q_LORA), f),
        "kv_a_norm_g": 1.0 + 0.02 * n(ks[4], (DEPTH, KV_LORA), f),
        "w_uq": n(ks[5], (DEPTH, Q_LORA, B_HEADS, B_NOPE + B_ROPE), f) * Q_LORA ** -0.5,
        "w_uk": n(ks[6], (DEPTH, KV_LORA, B_HEADS, B_NOPE), f) * KV_LORA ** -0.5,
        "w_uv": n(ks[7], (DEPTH, KV_LORA, B_HEADS, B_V), f) * KV_LORA ** -0.5,
        "w_a_out": n(ks[8], (DEPTH, A_WIDTH, D_MODEL), f) * A_WIDTH ** -0.5,
        "w_b_out": n(ks[9], (DEPTH, B_WIDTH, D_MODEL), f) * B_WIDTH ** -0.5,
        "w_o": n(ks[10], (DEPTH, D_MODEL, D_MODEL), f) * D_MODEL ** -0.5,
        "norm2_g": 1.0 + 0.02 * n(ks[11], (DEPTH, D_MODEL), f),
        "w_router": n(ks[12], (DEPTH, D_MODEL, N_EXPERTS), f) * D_MODEL ** -0.5,
        "b_router": 0.01 * n(ks[13], (DEPTH, N_EXPERTS), f),
        "w_gate_up": n(ks[14], (DEPTH, N_EXPERTS, D_MODEL, 2 * D_EXPERT), f) * D_MODEL ** -0.5,
        "b_gate_up": 0.02 * n(ks[15], (DEPTH, N_EXPERTS, 2 * D_EXPERT), f),
        "w_down": n(ks[16], (DEPTH, N_EXPERTS, D_EXPERT, D_MODEL), f) * D_EXPERT ** -0.5,
        "b_down": 0.02 * n(ks[17], (DEPTH, N_EXPERTS, D_MODEL), f),
        "final_g": 1.0 + 0.02 * n(ks[18], (D_MODEL,), f),
    }


def reference(x, norm1_g, w_in, q_a_norm_g, kv_a_norm_g, w_uq, w_uk, w_uv, w_a_out, w_b_out, w_o,
              norm2_g, w_router, b_router, w_gate_up, b_gate_up, w_down, b_down, final_g):
    B, S, D = x.shape
    for l in range(DEPTH):
        h = rmsnorm(x, norm1_g[l])
        z = h @ w_in[l]
        qa = z[..., OFF_QA:OFF_KA].reshape(B, S, A_HEADS, A_HEAD_DIM)
        ka = z[..., OFF_KA:OFF_VA].reshape(B, S, A_HEADS, A_HEAD_DIM)
        va = z[..., OFF_VA:OFF_CQ].reshape(B, S, A_HEADS, A_HEAD_DIM)
        o_a = dilated_mixture(qa, ka, va)
        o_b = mla(z[..., OFF_CQ:OFF_CKV], z[..., OFF_CKV:OFF_KR], z[..., OFF_KR:OFF_GA],
                  q_a_norm_g[l], kv_a_norm_g[l], w_uq[l], w_uk[l], w_uv[l])
        gate_a = jax.nn.sigmoid(z[..., OFF_GA:OFF_GB])
        gate_b = jax.nn.sigmoid(z[..., OFF_GB:IN_COLS])
        merged = gate_a * (o_a @ w_a_out[l]) + gate_b * (o_b @ w_b_out[l])
        x = x + merged @ w_o[l]
        h2 = rmsnorm(x, norm2_g[l])
        x = x + moe(h2, w_router[l], b_router[l], w_gate_up[l], b_gate_up[l], w_down[l], b_down[l])
    return rmsnorm(x, final_g)
```

```cpp
#include <hip/hip_runtime.h>
#include <cstdio>
#include <cstdint>

#define LAS __attribute__((address_space(3)))
#define GAS __attribute__((address_space(1)))
typedef unsigned short bf16_t;
typedef short bf16x8 __attribute__((ext_vector_type(8)));
typedef short s16x4 __attribute__((ext_vector_type(4)));
typedef float f32x2 __attribute__((ext_vector_type(2)));
typedef float f32x4 __attribute__((ext_vector_type(4)));
typedef float f32x16 __attribute__((ext_vector_type(16)));
typedef unsigned u32x2 __attribute__((ext_vector_type(2)));
typedef unsigned u32x4 __attribute__((ext_vector_type(4)));

constexpr int NB = 2, SEQ = 16384, T = NB * SEQ, DM = 1024;
constexpr int NIN = 4096;
constexpr int NEXP = 32, TOPK = 4, NSLOT = T * TOPK, NPMAX = NSLOT + NEXP * 256;
constexpr float EPS = 1e-5f, LOG2E = 1.4426950408889634f;
constexpr int NWAVES = 8, NTHREADS = 512;

constexpr size_t MiB = 1u << 20;
constexpr size_t WS_CTL = 0, CTL_ZERO_BYTES = 1 * MiB;
constexpr size_t WS_WIN = 1 * MiB;
constexpr size_t WS_WUQ = 9 * MiB;
constexpr size_t WS_WUKV = 10 * MiB;
constexpr size_t WS_WA = 11 * MiB, WS_WB = 12 * MiB;
constexpr size_t WS_WO = 13 * MiB;
constexpr size_t WS_ROPE = 15 * MiB;
constexpr size_t WS_WGU = 17 * MiB;
constexpr size_t WS_WD = 145 * MiB;
constexpr size_t WS_SMALL = 209 * MiB;
constexpr size_t WS_RSTDQ = WS_SMALL, WS_RSTDKV = WS_RSTDQ + T * 4, WS_RSTD2 = WS_RSTDKV + T * 4;
constexpr size_t WS_TOPI = WS_RSTD2 + T * 4, WS_GATEW = WS_TOPI + (size_t)NSLOT * 4, WS_SRANK = WS_GATEW + (size_t)NSLOT * 4, WS_POS = WS_SRANK + (size_t)NSLOT * 4;
constexpr size_t WS_ROWTOK = WS_POS + (size_t)NSLOT * 4, WS_ROWSCALE = WS_ROWTOK + 1 * MiB, WS_WGBASE = WS_ROWSCALE + 1 * MiB;
constexpr size_t WS_WRP = WS_WGBASE + 64 * 1024;
constexpr size_t WS_PARTL = WS_WRP + 128 * 1024;
static_assert(WS_PARTL + 3 * MiB <= 225 * MiB, "small region");
constexpr size_t WS_XB = 225 * MiB;
constexpr size_t WS_QA = 289 * MiB, WS_KA = 321 * MiB, WS_VA = 353 * MiB;
constexpr size_t WS_CQ = 385 * MiB;
constexpr size_t WS_CKV = 401 * MiB;
constexpr size_t WS_KR = 409 * MiB;
constexpr size_t WS_GA = 411 * MiB, WS_GB = 475 * MiB;
constexpr size_t WS_ACT = 225 * MiB;
static_assert(WS_ACT + (size_t)NPMAX * 2048 <= 539 * MiB, "ACT overlay");
constexpr size_t WS_QB = 539 * MiB;
constexpr size_t WS_KB = 587 * MiB, WS_VB = 619 * MiB;
constexpr size_t WS_OA = 651 * MiB, WS_OB = 683 * MiB;
constexpr size_t WS_MERGED = 715 * MiB;
constexpr size_t WS_PARTO = 779 * MiB;
constexpr size_t WS_H2 = 875 * MiB;
constexpr size_t WS_Y = 539 * MiB;
static_assert(WS_Y + (size_t)NPMAX * 2048 <= WS_H2, "Y overlay");
constexpr size_t WS_END = 939 * MiB;
constexpr int CW_TMO = 0, CW_BAR = 4096, CW_GCOUNT = 8192;

constexpr int RING_BYTES = 131072, MISC_OFF = RING_BYTES + 320, LDS_BYTES = 147456;
constexpr int MI_BAR = 8, MI_TPRE = 16, MI_HIST = 64, MI_PSTART = 96;

__device__ __forceinline__ unsigned f2bf(float f) { unsigned u = __builtin_bit_cast(unsigned, f); return (u + 0x7fffu + ((u >> 16) & 1u)) >> 16; }
__device__ __forceinline__ unsigned pk2(float lo, float hi) { return f2bf(lo) | (f2bf(hi) << 16); }
__device__ __forceinline__ float bf2f(unsigned short b) { return __builtin_bit_cast(float, (unsigned)b << 16); }
__device__ __forceinline__ float bflo(unsigned w) { return __builtin_bit_cast(float, w << 16); }
__device__ __forceinline__ float bfhi(unsigned w) { return __builtin_bit_cast(float, w & 0xffff0000u); }
typedef __bf16 bf16x2_t __attribute__((ext_vector_type(2)));
__device__ __forceinline__ unsigned cvtpk(float lo, float hi) { const f32x2 v = {lo, hi}; const bf16x2_t b = __builtin_convertvector(v, bf16x2_t); return __builtin_bit_cast(unsigned, b); }
__device__ __forceinline__ float wave_sum(float v) {
#pragma unroll
    for (int o = 1; o < 64; o <<= 1) v += __shfl_xor(v, o);
    return v;
}
__device__ __forceinline__ float fexp2(float x) { return __builtin_amdgcn_exp2f(x); }
__device__ __forceinline__ float frcp(float x) { return __builtin_amdgcn_rcpf(x); }
__device__ __forceinline__ float sigmoidf_(float z) { return frcp(1.f + fexp2(-z * LOG2E)); }
__device__ __forceinline__ int crow(int r, int hi) { return (r & 3) + 8 * (r >> 2) + 4 * hi; }
__device__ __forceinline__ u32x4 pack8(const float (&v)[8]) { u32x4 w; w.x = cvtpk(v[0], v[1]); w.y = cvtpk(v[2], v[3]); w.z = cvtpk(v[4], v[5]); w.w = cvtpk(v[6], v[7]); return w; }
__device__ __forceinline__ void unpack8(const u32x4 w, float (&v)[8]) { v[0] = bflo(w.x); v[1] = bfhi(w.x); v[2] = bflo(w.y); v[3] = bfhi(w.y); v[4] = bflo(w.z); v[5] = bfhi(w.z); v[6] = bflo(w.w); v[7] = bfhi(w.w); }

namespace pg8 {
constexpr int BM = 256, BK = 64, HALF = 128, HTB = HALF * BK * 2  , NXCD = 8, WGM = 8;
__host__ __device__ __forceinline__ int lds_byte(int r, int c) { const int st = (r >> 4) * 2 + (c >> 5), rr = r & 15, cc = c & 31, ob = rr * 64 + cc * 2; return st * 1024 + (ob ^ (((ob >> 9) & 1) << 5)); }
__host__ __device__ __forceinline__ void stage_rc(int b, int& R, int& C) { const int st = b / 1024, sb = b % 1024, swz = sb ^ (((sb >> 9) & 1) << 5); R = (st >> 1) * 16 + swz / 64; C = (st & 1) * 32 + (swz % 64) / 2; }
__host__ __device__ __forceinline__ int perm32(int rho) { const int n = rho >> 4, i = rho & 15; return 8 * (i >> 2) + 4 * n + (i & 3); }

struct Unit { int pm, pn, e; };

struct StaticOrder {
    int nM, nN, nwg, G, c;
    __host__ __device__ void init(int M, int N, int G_, int c_) { nM = M / BM; nN = N / BM; nwg = nM * nN; G = G_; c = c_; }
    __host__ __device__ bool next(int i, Unit& u) const {
        const long L = (long)i * G + c; if (L >= nwg) return false;
        int wgid = (int)L; { const int q = nwg / NXCD, r = nwg % NXCD, xcd = wgid % NXCD, off = wgid / NXCD; wgid = (xcd < r ? xcd * (q + 1) : r * (q + 1) + (xcd - r) * q) + off; }
        const int nig = WGM * nN, gid = wgid / nig, fm = gid * WGM, gsz = (nM - fm) < WGM ? (nM - fm) : WGM;
        u.pm = fm + ((wgid % nig) % gsz); u.pn = (wgid % nig) / gsz; u.e = 0; return true;
    }
};
struct DenseSched {
    StaticOrder so; const char* A; const char* Bt; int K;
    __device__ __forceinline__ void init(const bf16_t* A_, const bf16_t* Bt_, int M, int N, int K_, int G, int c) { so.init(M, N, G, c); A = (const char*)A_; Bt = (const char*)Bt_; K = K_; }
    __device__ __forceinline__ bool next(int i, Unit& u) const { return so.next(i, u); }
    __device__ __forceinline__ const char* a_base(const Unit& u) const { return A + (size_t)u.pm * ((size_t)BM * K * 2); }
    __device__ __forceinline__ const char* b_base(const Unit& u) const { return Bt + (size_t)u.pn * ((size_t)BM * K * 2); }
    __device__ __forceinline__ void a_off(const Unit&, const int (&sR)[2], const int (&sC)[2], unsigned (&vo)[2][2]) const {
#pragma unroll
        for (int h = 0; h < 2; ++h)
#pragma unroll
            for (int i = 0; i < 2; ++i) vo[h][i] = (unsigned)((h * HALF + sR[i]) * K + sC[i]) * 2u;
    }
};
template <int NPN_SHIFT, bool GATHER>
struct MoeSched {
    const LAS int* tpre; int ntiles, G, c, K; const char* A; const char* Bt; size_t estride; const int* row_tok;
    __device__ __forceinline__ bool next(int i, Unit& u) const {
        const int L = i * G + c, g = L >> NPN_SHIFT; if (g >= ntiles) return false;
        int e = 0; while (e < 31 && tpre[e + 1] <= g) ++e;
        u.pm = g; u.pn = L & ((1 << NPN_SHIFT) - 1); u.e = e; return true;
    }
    __device__ __forceinline__ const char* a_base(const Unit& u) const { return GATHER ? A : A + (size_t)u.pm * ((size_t)BM * K * 2); }
    __device__ __forceinline__ const char* b_base(const Unit& u) const { return Bt + (size_t)u.e * estride + (size_t)u.pn * ((size_t)BM * K * 2); }
    __device__ __forceinline__ void a_off(const Unit& u, const int (&sR)[2], const int (&sC)[2], unsigned (&vo)[2][2]) const {
#pragma unroll
        for (int h = 0; h < 2; ++h)
#pragma unroll
            for (int i = 0; i < 2; ++i) {
                if (GATHER) { const int tok = row_tok[u.pm * BM + h * HALF + sR[i]]; vo[h][i] = (unsigned)(tok * K + sC[i]) * 2u; }
                else vo[h][i] = (unsigned)((h * HALF + sR[i]) * K + sC[i]) * 2u;
            }
    }
};

template <class Epi, class Sched, bool ALIGN_EPI>
__device__ __forceinline__ void gemm_phase2(LAS unsigned char* lds, const int K_, const Sched& S, const Epi& E) {
    int K = K_; asm volatile("" : "+s"(K));
    const int tid = threadIdx.x, wid = __builtin_amdgcn_readfirstlane(tid >> 6), lane = tid & 63, wr = wid >> 2, wc = wid & 3, fr = lane & 15, fq = lane >> 4;
    const int nt = K / BK;
    int sR[2], sC[2]; unsigned voffB[2];
#pragma unroll
    for (int i = 0; i < 2; ++i) { int R, C; stage_rc(tid * 16 + i * 8192, R, C); sR[i] = R; sC[i] = C; const int Rb = Epi::PERM ? ((R & ~31) + perm32(R & 31)) : R; voffB[i] = (unsigned)(Rb * K + C) * 2u; }
    const size_t kstep = (size_t)(BK * 2);
    const size_t hstep = (size_t)HALF * K * 2;
    const unsigned ldsw = (unsigned)wid * 1024u;
    const int aoff = lds_byte(wr * 64 + fr, fq * 8), boff = lds_byte(wc * 32 + fr, fq * 8);
#define PG8_SA(b, h) (((b) * 2 + (h)) * HTB)
#define PG8_SB(b, h) ((4 + (b) * 2 + (h)) * HTB)
#define PG8_STAGE_B(bufoff, gbase) do { _Pragma("unroll") for (int _i = 0; _i < 2; ++_i) \
        __builtin_amdgcn_global_load_lds((const unsigned*)((const char*)(gbase) + voffB[_i]), (LAS unsigned*)(lds + (bufoff) + ldsw + _i * 8192), 16, 0, 0); } while (0)
#define PG8_STAGE_A(bufoff, gbase, o0, o1) do { \
        __builtin_amdgcn_global_load_lds((const unsigned*)((const char*)(gbase) + (o0)), (LAS unsigned*)(lds + (bufoff) + ldsw), 16, 0, 0); \
        __builtin_amdgcn_global_load_lds((const unsigned*)((const char*)(gbase) + (o1)), (LAS unsigned*)(lds + (bufoff) + ldsw + 8192), 16, 0, 0); } while (0)
#define PG8_LDA(dst, b, h) do { _Pragma("unroll") for (int m = 0; m < 4; ++m) _Pragma("unroll") for (int k = 0; k < 2; ++k) dst[m][k] = *(const LAS bf16x8*)(lds + PG8_SA(b, h) + aoff + m * 2048 + k * 1024); } while (0)
#define PG8_LDB(dst, b, h) do { _Pragma("unroll") for (int n = 0; n < 2; ++n) _Pragma("unroll") for (int k = 0; k < 2; ++k) dst[n][k] = *(const LAS bf16x8*)(lds + PG8_SB(b, h) + boff + n * 2048 + k * 1024); } while (0)
#define PG8_MMA(ai, bj, At, Bt) do { __builtin_amdgcn_s_setprio(1); _Pragma("unroll") for (int m = 0; m < 4; ++m) _Pragma("unroll") for (int n = 0; n < 2; ++n) _Pragma("unroll") for (int k = 0; k < 2; ++k) \
        acc[ai][bj][m][n] = __builtin_amdgcn_mfma_f32_16x16x32_bf16(Bt[n][k], At[m][k], acc[ai][bj][m][n], 0, 0, 0); __builtin_amdgcn_s_setprio(0); } while (0)
#define PG8_WAIT_V(n) asm volatile("s_waitcnt vmcnt(" #n ")" ::: "memory")
#define PG8_WAIT_L(n) asm volatile("s_waitcnt lgkmcnt(" #n ")" ::: "memory")
#define PG8_BAR __builtin_amdgcn_s_barrier()
#define PG8_SCHED __builtin_amdgcn_sched_barrier(0)
    Unit cur, nxt; int ui = 0;
    if (!S.next(0, cur)) return;
    f32x4 acc[2][2][4][2];
#pragma unroll
    for (int a = 0; a < 2; ++a)
#pragma unroll
        for (int b = 0; b < 2; ++b)
#pragma unroll
            for (int m = 0; m < 4; ++m)
#pragma unroll
                for (int n = 0; n < 2; ++n) acc[a][b][m][n] = (f32x4){0.f, 0.f, 0.f, 0.f};
    bf16x8 At[4][2], B0[2][2], B1[2][2];
    unsigned voA[2][2], voN[2][2];
    S.a_off(cur, sR, sC, voA);
    const char* cA = S.a_base(cur); const char* cB = S.b_base(cur);
    PG8_STAGE_B(PG8_SB(0, 0), cB); PG8_STAGE_B(PG8_SB(0, 1), cB + hstep); PG8_STAGE_A(PG8_SA(0, 0), cA, voA[0][0], voA[0][1]); PG8_STAGE_A(PG8_SA(0, 1), cA, voA[1][0], voA[1][1]);
    if (wr == 1) PG8_BAR;
    PG8_WAIT_V(2); PG8_BAR;
    PG8_STAGE_B(PG8_SB(1, 0), cB + kstep); PG8_STAGE_A(PG8_SA(1, 0), cA + kstep, voA[0][0], voA[0][1]); PG8_STAGE_B(PG8_SB(1, 1), cB + hstep + kstep);
    PG8_WAIT_V(6); PG8_BAR;
    for (;;) {
        const bool has_next = S.next(ui + 1, nxt);
        const char* nA = cA; const char* nB = cB;
#pragma unroll
        for (int h = 0; h < 2; ++h)
#pragma unroll
            for (int i = 0; i < 2; ++i) voN[h][i] = voA[h][i];
        if (has_next) { nA = S.a_base(nxt); nB = S.b_base(nxt); S.a_off(nxt, sR, sC, voN); }
        for (int t = 0; t < nt; t += 2) {
            const bool last = (t == nt - 2);
            const char* a1 = cA + (size_t)(t + 1) * kstep;
            const char* a2 = last ? nA : cA + (size_t)(t + 2) * kstep; const char* b2 = last ? nB : cB + (size_t)(t + 2) * kstep;
            const char* a3 = a2 + kstep; const char* b3 = b2 + kstep;
            const unsigned s00 = last ? voN[0][0] : voA[0][0], s01 = last ? voN[0][1] : voA[0][1], s10 = last ? voN[1][0] : voA[1][0], s11 = last ? voN[1][1] : voA[1][1];
            PG8_LDB(B0, 0, 0); PG8_LDB(B1, 0, 1); PG8_SCHED; PG8_LDA(At, 0, 0); PG8_STAGE_A(PG8_SA(1, 1), a1, voA[1][0], voA[1][1]);
            PG8_WAIT_V(8); PG8_WAIT_L(0); PG8_BAR; PG8_MMA(0, 0, At, B0); PG8_MMA(0, 1, At, B1); PG8_BAR; PG8_SCHED;
            PG8_LDA(At, 0, 1); PG8_STAGE_B(PG8_SB(0, 0), b2); PG8_STAGE_B(PG8_SB(0, 1), b2 + hstep); PG8_STAGE_A(PG8_SA(0, 0), a2, s00, s01);
            PG8_WAIT_V(8); PG8_WAIT_L(0); PG8_BAR; PG8_MMA(1, 0, At, B0); PG8_MMA(1, 1, At, B1); PG8_BAR; PG8_SCHED;
            PG8_LDB(B0, 1, 0); PG8_LDB(B1, 1, 1); PG8_SCHED; PG8_LDA(At, 1, 0); PG8_STAGE_A(PG8_SA(0, 1), a2, s10, s11);
            PG8_WAIT_V(8); PG8_WAIT_L(0); PG8_BAR; PG8_MMA(0, 0, At, B0); PG8_MMA(0, 1, At, B1); PG8_BAR; PG8_SCHED;
            PG8_LDA(At, 1, 1); PG8_STAGE_B(PG8_SB(1, 0), b3); PG8_STAGE_B(PG8_SB(1, 1), b3 + hstep); PG8_STAGE_A(PG8_SA(1, 0), a3, s00, s01);
            PG8_WAIT_V(8); PG8_WAIT_L(0); PG8_BAR; PG8_MMA(1, 0, At, B0); PG8_MMA(1, 1, At, B1); PG8_BAR; PG8_SCHED;
        }
        if constexpr (ALIGN_EPI) { if (wr == 0) PG8_BAR; }
        E(acc, cur, wr, wc, fr, fq);
        if (!has_next) break;
#pragma unroll
        for (int a = 0; a < 2; ++a)
#pragma unroll
            for (int b = 0; b < 2; ++b)
#pragma unroll
                for (int m = 0; m < 4; ++m)
#pragma unroll
                    for (int n = 0; n < 2; ++n) acc[a][b][m][n] = (f32x4){0.f, 0.f, 0.f, 0.f};
        cur = nxt; cA = nA; cB = nB; ++ui;
#pragma unroll
        for (int h = 0; h < 2; ++h)
#pragma unroll
            for (int i = 0; i < 2; ++i) voA[h][i] = voN[h][i];
        if constexpr (ALIGN_EPI) { if (wr == 1) PG8_BAR; }
    }
    PG8_WAIT_V(0);
    if constexpr (!ALIGN_EPI) { if (wr == 0) PG8_BAR; }
    PG8_BAR;
#undef PG8_SA
#undef PG8_SB
#undef PG8_STAGE_A
#undef PG8_STAGE_B
#undef PG8_LDA
#undef PG8_LDB
#undef PG8_MMA
#undef PG8_WAIT_V
#undef PG8_WAIT_L
#undef PG8_BAR
#undef PG8_SCHED
}
}

#define XB_TMO      128
#define XB_XCNT(j)  (256  + 64 * (j))
#define XB_XSUB(j)  (1280 + 64 * (j))
#define XB_XGEN(j)  (2304 + 64 * (j))
#define XB_TOP      3328
#define XB_TOPGEN   3392
#define XCD_BAR_WORDS 3456
#define XB_SPIN_CAP (1u << 18)

__device__ __forceinline__ unsigned xb_ld(unsigned* p)              { return __hip_atomic_load(p, __ATOMIC_RELAXED, __HIP_MEMORY_SCOPE_AGENT); }
__device__ __forceinline__ unsigned xb_add(unsigned* p, unsigned v) { return __hip_atomic_fetch_add(p, v, __ATOMIC_RELAXED, __HIP_MEMORY_SCOPE_AGENT); }
__device__ __forceinline__ unsigned xb_xcc_id() { return (unsigned)__builtin_amdgcn_s_getreg((3 << 11) | 20) & 0xFu; }
#define XB_SPIN(cond, bar) do { unsigned _sp = 0; while (cond) { __builtin_amdgcn_s_sleep(1); \
    if ((++_sp & 255u) == 0u) { if (xb_ld(&(bar)[XB_TMO])) break; if (_sp > XB_SPIN_CAP) { atomicAdd(&(bar)[XB_TMO], 1u); break; } } } } while (0)

struct XcdBarrier {
    unsigned* bar; unsigned x;
    volatile LAS unsigned* st;
};
__device__ __forceinline__ XcdBarrier xcd_barrier_post(unsigned* bar, volatile LAS unsigned* st) {
    XcdBarrier b; b.bar = bar; b.x = xb_xcc_id(); b.st = st;
    if (threadIdx.x == 0) (void)xb_add(&bar[XB_XCNT(b.x)], 1u);
    return b;
}
__device__ __forceinline__ void xcd_barrier_complete(unsigned* bar, unsigned x, unsigned& nloc, unsigned& nx) {
    const unsigned G = gridDim.x * gridDim.y * gridDim.z;
    unsigned sum, cnt, mine, sp = 0u;
    for (;;) {
        sum = 0u; cnt = 0u; mine = 0u;
#pragma unroll
        for (unsigned j = 0; j < 16; ++j) { const unsigned c = xb_ld(&bar[XB_XCNT(j)]); sum += c; cnt += (c > 0u) ? 1u : 0u; mine = (j == x) ? c : mine; }
        if (sum == G) break;
        __builtin_amdgcn_s_sleep(1);
        if ((++sp & 255u) == 0u) { if (xb_ld(&bar[XB_TMO])) break; if (sp > XB_SPIN_CAP) { atomicAdd(&bar[XB_TMO], 1u); break; } }
    }
    nloc = mine > 0u ? mine : 1u; nx = cnt > 0u ? cnt : 1u;
}
__device__ __forceinline__ void xcd_barrier(const XcdBarrier& b) {
    asm volatile("s_waitcnt vmcnt(0)" ::: "memory");
    __syncthreads();
    if (threadIdx.x == 0) {
        unsigned* bar = b.bar;
        __builtin_amdgcn_s_waitcnt(0);
        unsigned nloc = b.st[0], nx = b.st[1];
        if (nloc == 0u) { xcd_barrier_complete(bar, b.x, nloc, nx); b.st[0] = nloc; b.st[1] = nx; }
        const unsigned old = xb_add(&bar[XB_XSUB(b.x)], 1u);
        const unsigned gen = old / nloc;
        if (old + 1u == (gen + 1u) * nloc) {
            __builtin_amdgcn_fence(__ATOMIC_RELEASE, "agent");
            asm volatile("s_waitcnt vmcnt(0)" ::: "memory");
            const unsigned og = xb_add(&bar[XB_TOP], 1u);
            const unsigned tg = og / nx;
            if (og + 1u == (tg + 1u) * nx) xb_add(&bar[XB_TOPGEN], 1u);
            else XB_SPIN(xb_ld(&bar[XB_TOPGEN]) == tg, bar);
            __builtin_amdgcn_fence(__ATOMIC_ACQUIRE, "agent");
            xb_add(&bar[XB_XGEN(b.x)], 1u);
            asm volatile("s_waitcnt vmcnt(0)" ::: "memory");
        } else {
            XB_SPIN(xb_ld(&bar[XB_XGEN(b.x)]) == gen, bar);
            __builtin_amdgcn_fence(__ATOMIC_ACQUIRE, "agent");
            asm volatile("s_waitcnt vmcnt(0)" ::: "memory");
        }
    }
    __syncthreads();
}

#define EPI_WALK(...) \
    _Pragma("unroll") for (int ai = 0; ai < 2; ++ai) _Pragma("unroll") for (int m = 0; m < 4; ++m) { \
        const int row = u.pm * 256 + ai * 128 + wr * 64 + m * 16 + fr; \
        _Pragma("unroll") for (int bj = 0; bj < 2; ++bj) { const int cw = bj * 128 + wc * 32 + 8 * fq; \
            float v[8] = {acc[ai][bj][m][0][0], acc[ai][bj][m][0][1], acc[ai][bj][m][0][2], acc[ai][bj][m][0][3], acc[ai][bj][m][1][0], acc[ai][bj][m][1][1], acc[ai][bj][m][1][2], acc[ai][bj][m][1][3]}; \
            __VA_ARGS__ } asm volatile("" ::: "memory"); }

__device__ __forceinline__ void rope8(float (&v)[8], const f32x2* rope_row, int i0) {
#pragma unroll
    for (int j = 0; j < 4; ++j) { const f32x2 cs = rope_row[i0 + j]; const float x1 = v[2 * j], x2 = v[2 * j + 1]; v[2 * j] = x1 * cs.x - x2 * cs.y; v[2 * j + 1] = x2 * cs.x + x1 * cs.y; }
}

struct EpiInProj {
    static constexpr bool PERM = true;
    unsigned char* ws;
    __device__ __forceinline__ void operator()(const f32x4 (&acc)[2][2][4][2], const pg8::Unit& u, int wr, int wc, int fr, int fq) const {
        const int pn = u.pn;
        if (pn < 6) {
            bf16_t* base = (bf16_t*)(ws + (pn < 2 ? WS_QA : pn < 4 ? WS_KA : WS_VA)) + (pn & 1) * 256;
            EPI_WALK({ *(u32x4*)(base + (size_t)row * 512 + cw) = pack8(v); })
        } else if (pn == 6) {
            bf16_t* base = (bf16_t*)(ws + WS_CQ);
            EPI_WALK({ *(u32x4*)(base + (size_t)row * 256 + cw) = pack8(v); })
        } else if (pn == 7) {
            bf16_t* ckv = (bf16_t*)(ws + WS_CKV); bf16_t* kr = (bf16_t*)(ws + WS_KR); const f32x2* rope = (const f32x2*)(ws + WS_ROPE);
            EPI_WALK({ if (cw < 128) { *(u32x4*)(ckv + (size_t)row * 128 + cw) = pack8(v); }
                       else if (cw < 160) { rope8(v, rope + (size_t)(row & (SEQ - 1)) * 16, (cw - 128) >> 1); *(u32x4*)(kr + (size_t)row * 32 + (cw - 128)) = pack8(v); } })
        } else {
            bf16_t* base = (bf16_t*)(ws + (pn < 12 ? WS_GA : WS_GB)) + ((pn - 8) & 3) * 256;
            EPI_WALK({ _Pragma("unroll") for (int j = 0; j < 8; ++j) v[j] = sigmoidf_(v[j]); *(u32x4*)(base + (size_t)row * 1024 + cw) = pack8(v); })
        }
    }
};
struct EpiQ {
    static constexpr bool PERM = true;
    unsigned char* ws;
    __device__ __forceinline__ void operator()(const f32x4 (&acc)[2][2][4][2], const pg8::Unit& u, int wr, int wc, int fr, int fq) const {
        bf16_t* qb = (bf16_t*)(ws + WS_QB); const float* rs = (const float*)(ws + WS_RSTDQ); const f32x2* rope = (const f32x2*)(ws + WS_ROPE);
        EPI_WALK({ const int col = u.pn * 256 + cw; const int w = col % 96; const float r = rs[row];
                   _Pragma("unroll") for (int j = 0; j < 8; ++j) v[j] *= r;
                   if (w >= 64) rope8(v, rope + (size_t)(row & (SEQ - 1)) * 16, (w - 64) >> 1);
                   *(u32x4*)(qb + (size_t)row * 768 + col) = pack8(v); })
    }
};
struct EpiKV {
    static constexpr bool PERM = true;
    unsigned char* ws;
    __device__ __forceinline__ void operator()(const f32x4 (&acc)[2][2][4][2], const pg8::Unit& u, int wr, int wc, int fr, int fq) const {
        bf16_t* base = (bf16_t*)(ws + (u.pn < 2 ? WS_KB : WS_VB)) + (u.pn & 1) * 256; const float* rs = (const float*)(ws + WS_RSTDKV);
        EPI_WALK({ const float r = rs[row];
                   _Pragma("unroll") for (int j = 0; j < 8; ++j) v[j] *= r;
                   *(u32x4*)(base + (size_t)row * 512 + cw) = pack8(v); })
    }
};
template <bool SECOND> struct EpiGate {
    static constexpr bool PERM = true;
    unsigned char* ws;
    __device__ __forceinline__ void operator()(const f32x4 (&acc)[2][2][4][2], const pg8::Unit& u, int wr, int wc, int fr, int fq) const {
        bf16_t* mg = (bf16_t*)(ws + WS_MERGED); const bf16_t* gt = (const bf16_t*)(ws + (SECOND ? WS_GB : WS_GA));
        EPI_WALK({ const size_t o = (size_t)row * 1024 + u.pn * 256 + cw; float g[8]; unpack8(*(const u32x4*)(gt + o), g);
                   if (SECOND) { float p[8]; unpack8(*(const u32x4*)(mg + o), p); _Pragma("unroll") for (int j = 0; j < 8; ++j) v[j] = p[j] + g[j] * v[j]; }
                   else { _Pragma("unroll") for (int j = 0; j < 8; ++j) v[j] = g[j] * v[j]; }
                   *(u32x4*)(mg + o) = pack8(v); })
    }
};
struct EpiResid {
    static constexpr bool PERM = true;
    unsigned char* ws; const float* x; float* x1;
    __device__ __forceinline__ void operator()(const f32x4 (&acc)[2][2][4][2], const pg8::Unit& u, int wr, int wc, int fr, int fq) const {
        bf16_t* h2 = (bf16_t*)(ws + WS_H2);
        EPI_WALK({ const size_t o = (size_t)row * 1024 + u.pn * 256 + cw; const f32x4 a = *(const f32x4*)(x + o), b = *(const f32x4*)(x + o + 4);
                   v[0] += a[0]; v[1] += a[1]; v[2] += a[2]; v[3] += a[3]; v[4] += b[0]; v[5] += b[1]; v[6] += b[2]; v[7] += b[3];
                   *(f32x4*)(x1 + o) = (f32x4){v[0], v[1], v[2], v[3]}; *(f32x4*)(x1 + o + 4) = (f32x4){v[4], v[5], v[6], v[7]};
                   *(u32x4*)(h2 + o) = pack8(v); })
    }
};
struct EpiSwiglu {
    static constexpr bool PERM = true;
    unsigned char* ws; const float* bgu;
    __device__ __forceinline__ void operator()(const f32x4 (&acc)[2][2][4][2], const pg8::Unit& u, int wr, int wc, int fr, int fq) const {
        bf16_t* act = (bf16_t*)(ws + WS_ACT); const float* rsc = (const float*)(ws + WS_ROWSCALE);
        const int c0 = u.pn * 128 + wc * 32 + 8 * fq; const float* bg = bgu + (size_t)u.e * 2048 + c0;
        float bgv[8], buv[8];
#pragma unroll
        for (int j = 0; j < 8; ++j) { bgv[j] = bg[j]; buv[j] = bg[1024 + j]; }
#pragma unroll
        for (int ai = 0; ai < 2; ++ai)
#pragma unroll
            for (int m = 0; m < 4; ++m) {
                const int row = u.pm * 256 + ai * 128 + wr * 64 + m * 16 + fr; const float r = rsc[row]; float o[8];
#pragma unroll
                for (int j = 0; j < 8; ++j) { const float g0 = acc[ai][0][m][j >> 2][j & 3] * r + bgv[j], u0 = acc[ai][1][m][j >> 2][j & 3] * r + buv[j];
                    const float g = fminf(g0, 7.f), up = fminf(fmaxf(u0, -7.f), 7.f); o[j] = (up + 1.f) * (g * sigmoidf_(1.702f * g)); }
                *(u32x4*)(act + (size_t)row * 1024 + c0) = pack8(o);
            }
    }
};
struct EpiDown {
    static constexpr bool PERM = true;
    unsigned char* ws; const float* bd;
    __device__ __forceinline__ void operator()(const f32x4 (&acc)[2][2][4][2], const pg8::Unit& u, int wr, int wc, int fr, int fq) const {
        bf16_t* y = (bf16_t*)(ws + WS_Y); const float* b = bd + (size_t)u.e * 1024 + u.pn * 256;
        EPI_WALK({ _Pragma("unroll") for (int j = 0; j < 8; ++j) v[j] += b[cw + j];
                   *(u32x4*)(y + (size_t)row * 1024 + u.pn * 256 + cw) = pack8(v); })
    }
};

typedef short v4i16_t __attribute__((ext_vector_type(4)));
__device__ __forceinline__ s16x4 vtr(const LAS char* p) { return __builtin_bit_cast(s16x4, __builtin_amdgcn_ds_read_tr16_b64_v4i16((LAS v4i16_t*)p)); }
__device__ __forceinline__ float swapmax(float m) { auto rr = __builtin_amdgcn_permlane32_swap(__float_as_uint(m), __float_as_uint(m), false, false); return fmaxf(__uint_as_float(rr[0]), __uint_as_float(rr[1])); }
__device__ __forceinline__ float swapsum(float m) { auto rr = __builtin_amdgcn_permlane32_swap(__float_as_uint(m), __float_as_uint(m), false, false); return __uint_as_float(rr[0]) + __uint_as_float(rr[1]); }

struct AttnState { f32x16 o0, o1; float m, l; };

struct MlaKL {
    const bf16_t* Kn; const bf16_t* Kr; const bf16_t* V;
    template <int D0> __device__ __forceinline__ bf16x8 kfrag(int c, int r32, int hi) const {
        const size_t s = (size_t)(32 * c + r32);
        if (D0 < 4) return *(const bf16x8*)(Kn + s * 512 + 16 * D0 + 8 * hi);
        return *(const bf16x8*)(Kr + s * 32 + 16 * (D0 - 4) + 8 * hi);
    }
    __device__ __forceinline__ u32x4 vpiece(int c, int row, int c8) const { return *(const u32x4*)(V + (size_t)(32 * c + row) * 512 + 8 * c8); }
    __device__ __forceinline__ void modify(int, f32x16&, int, int) const {}
};
struct DilKL {
    const bf16_t* K; const bf16_t* V;
    int dil, res, u0, L; float slope2d;
    __device__ __forceinline__ size_t tok(int c, int kk) const { int v = u0 - 64 + 32 * c + kk; v = v < 0 ? 0 : (v >= L ? L - 1 : v); return (size_t)(res + dil * v); }
    template <int D0> __device__ __forceinline__ bf16x8 kfrag(int c, int r32, int hi) const { return *(const bf16x8*)(K + tok(c, r32) * 512 + 16 * D0 + 8 * hi); }
    __device__ __forceinline__ u32x4 vpiece(int c, int row, int c8) const { return *(const u32x4*)(V + tok(c, row) * 512 + 8 * c8); }
    __device__ __forceinline__ void modify(int c, f32x16& s, int r32, int hi) const {
#pragma unroll
        for (int r = 0; r < 16; ++r) { const int kk = crow(r, hi), rel = 32 * c - 64 + kk - r32, v = u0 - 64 + 32 * c + kk;
            const bool valid = (rel >= -64) && (rel <= 64) && (v >= 0) && (v < L);
            s[r] = valid ? s[r] - slope2d * fabsf((float)rel) : -1e30f; }
    }
};

template <int NDK, class KL> __device__ __forceinline__ void attn_load_k(bf16x8 (&kf)[NDK], const KL& kl, int c, int r32, int hi) {
    kf[0] = kl.template kfrag<0>(c, r32, hi); kf[1] = kl.template kfrag<1>(c, r32, hi); kf[2] = kl.template kfrag<2>(c, r32, hi); kf[3] = kl.template kfrag<3>(c, r32, hi);
    if constexpr (NDK == 6) { kf[4] = kl.template kfrag<4>(c, r32, hi); kf[5] = kl.template kfrag<5>(c, r32, hi); }
}
template <class KL> __device__ __forceinline__ void attn_load_v(u32x4 (&vp)[4], const KL& kl, int c, int lane) {
#pragma unroll
    for (int i = 0; i < 4; ++i) { const int p = lane + 64 * i; vp[i] = kl.vpiece(c, p >> 3, p & 7); }
}
__device__ __forceinline__ void attn_store_v(const u32x4 (&vp)[4], LAS char* vimg, int lane) {
#pragma unroll
    for (int i = 0; i < 4; ++i) { const int p = lane + 64 * i, row = p >> 3, c8 = p & 7; *(LAS u32x4*)(vimg + (c8 >> 2) * 2048 + row * 64 + (c8 & 3) * 16) = vp[i]; }
}
template <int NDK, class KL> __device__ __forceinline__ void attn_core(AttnState& st, const bf16x8 (&qf)[NDK], const bf16x8 (&kf)[NDK], const KL& kl, int c, LAS char* vimg, LAS float* wsf, int lane, int r32, int hi) {
    f32x16 s = {};
#pragma unroll
    for (int d0 = 0; d0 < NDK; ++d0) s = __builtin_amdgcn_mfma_f32_32x32x16_bf16(kf[d0], qf[d0], s, 0, 0, 0);
    kl.modify(c, s, r32, hi);
    float mx = s[0];
#pragma unroll
    for (int r = 1; r < 16; ++r) mx = fmaxf(mx, s[r]);
    mx = swapmax(mx);
    const float mn = fmaxf(st.m, mx), alpha = fexp2(st.m - mn);
    float ps = 0.f;
#pragma unroll
    for (int r = 0; r < 16; ++r) { s[r] = fexp2(s[r] - mn); ps += s[r]; }
    st.l = st.l * alpha + ps; st.m = mn;
    if (hi == 0) wsf[r32] = alpha;
#pragma unroll
    for (int r = 0; r < 16; ++r) { const float a = wsf[crow(r, hi)]; st.o0[r] *= a; st.o1[r] *= a; }
    const u32x4 pw0 = {cvtpk(s[0], s[1]), cvtpk(s[2], s[3]), cvtpk(s[4], s[5]), cvtpk(s[6], s[7])};
    const u32x4 pw1 = {cvtpk(s[8], s[9]), cvtpk(s[10], s[11]), cvtpk(s[12], s[13]), cvtpk(s[14], s[15])};
    const bf16x8 pa0 = __builtin_bit_cast(bf16x8, pw0), pa1 = __builtin_bit_cast(bf16x8, pw1);
    const LAS char* vp = vimg + ((lane >> 4) & 1) * 32 + (lane & 3) * 8 + (4 * hi + ((lane & 15) >> 2)) * 64;
#pragma unroll
    for (int ks = 0; ks < 2; ++ks) {
        const s16x4 l0 = vtr(vp + ks * 1024), h0 = vtr(vp + ks * 1024 + 512), l1 = vtr(vp + 2048 + ks * 1024), h1 = vtr(vp + 2048 + ks * 1024 + 512);
        const bf16x8 v0 = {l0[0], l0[1], l0[2], l0[3], h0[0], h0[1], h0[2], h0[3]}, v1 = {l1[0], l1[1], l1[2], l1[3], h1[0], h1[1], h1[2], h1[3]};
        st.o0 = __builtin_amdgcn_mfma_f32_32x32x16_bf16(ks == 0 ? pa0 : pa1, v0, st.o0, 0, 0, 0);
        st.o1 = __builtin_amdgcn_mfma_f32_32x32x16_bf16(ks == 0 ? pa0 : pa1, v1, st.o1, 0, 0, 0);
    }
}
template <int NDK, class KL> __device__ __forceinline__ void wave_attn(AttnState& st, const bf16x8 (&qf)[NDK], const KL& kl, int nchunk, LAS char* vimg, LAS float* wsf, int lane) {
    const int r32 = lane & 31, hi = lane >> 5;
    st.o0 = f32x16{}; st.o1 = f32x16{}; st.m = -1e30f; st.l = 0.f;
    bf16x8 kfa[NDK], kfb[NDK]; u32x4 vp[4];
    attn_load_k<NDK>(kfa, kl, 0, r32, hi); attn_load_v(vp, kl, 0, lane);
    for (int c = 0; c < nchunk; c += 2) {
        attn_store_v(vp, vimg, lane);
        if (c + 1 < nchunk) { attn_load_k<NDK>(kfb, kl, c + 1, r32, hi); attn_load_v(vp, kl, c + 1, lane); }
        attn_core<NDK>(st, qf, kfa, kl, c, vimg, wsf, lane, r32, hi);
        if (c + 1 < nchunk) {
            attn_store_v(vp, vimg, lane);
            if (c + 2 < nchunk) { attn_load_k<NDK>(kfa, kl, c + 2, r32, hi); attn_load_v(vp, kl, c + 2, lane); }
            attn_core<NDK>(st, qf, kfb, kl, c + 1, vimg, wsf, lane, r32, hi);
        }
    }
}
__device__ __forceinline__ float attn_finish(AttnState& st, LAS char* vimg, LAS float* wsf, int lane) {
    const int r32 = lane & 31, hi = lane >> 5;
    const float lt = swapsum(st.l);
    if (hi == 0) wsf[32 + r32] = lt;
    LAS bf16_t* stg = (LAS bf16_t*)vimg;
#pragma unroll
    for (int r = 0; r < 16; ++r) { const int q = crow(r, hi); const float il = frcp(wsf[32 + q]);
        stg[q * 64 + r32] = (bf16_t)f2bf(st.o0[r] * il); stg[q * 64 + 32 + r32] = (bf16_t)f2bf(st.o1[r] * il); }
    return lt;
}

template <class CM> __device__ __forceinline__ void tr_item(const float* W, int ld, const float* rs, bf16_t* WT, int K, int k0, int n0, const CM& cm, LAS float* scr, int lane) {
    const int n = lane & 31, sc = cm.col(n0 + n); const float cs = cm.scale(n0 + n);
#pragma unroll 8
    for (int i = 0; i < 32; ++i) { const int kk = 2 * i + (lane >> 5); float v = 0.f; if (sc >= 0) v = W[(size_t)(k0 + kk) * ld + sc] * cs * (rs ? rs[k0 + kk] : 1.f); scr[kk * 33 + n] = v; }
    asm volatile("s_waitcnt lgkmcnt(0)" ::: "memory");
    const int c = lane & 7;
#pragma unroll
    for (int j = 0; j < 4; ++j) { const int nn = (lane >> 3) + 8 * j; const LAS float* s = scr + (8 * c) * 33 + nn;
        u32x4 o; o.x = pk2(s[0 * 33], s[1 * 33]); o.y = pk2(s[2 * 33], s[3 * 33]); o.z = pk2(s[4 * 33], s[5 * 33]); o.w = pk2(s[6 * 33], s[7 * 33]);
        *(u32x4*)(WT + (size_t)(n0 + nn) * K + k0 + 8 * c) = o; }
    asm volatile("s_waitcnt lgkmcnt(0)" ::: "memory");
}
struct CmIn {
    __device__ __forceinline__ int col(int n) const {
        if (n < 1920) return n;
        if (n < 1952) { const int j = n - 1920, i = j >> 1; return 1920 + ((j & 1) ? i + 16 : i); }
        if (n < 2048) return -1;
        if (n < 3072) return 1952 + (n - 2048);
        return 2976 + (n - 3072);
    }
    __device__ __forceinline__ float scale(int n) const { return n < 512 ? 0.125f * LOG2E : 1.f; }
};
struct CmUq {
    __device__ __forceinline__ int col(int n) const { const int h = n / 96, w = n % 96; if (w < 64) return n; const int j = w - 64, i = j >> 1; return h * 96 + 64 + ((j & 1) ? i + 16 : i); }
    __device__ __forceinline__ float scale(int) const { return 0.10206207261596577f * LOG2E; }
};
struct CmId { int off; __device__ __forceinline__ int col(int n) const { return n - off; } __device__ __forceinline__ float scale(int) const { return 1.f; } };
struct CmGu {
    __device__ __forceinline__ int col(int n) const { const int pn = n >> 8, w = n & 255; return w < 128 ? 128 * pn + w : 1024 + 128 * pn + (w - 128); }
    __device__ __forceinline__ float scale(int) const { return 1.f; }
};

struct Args { const float* in[19]; float* out; unsigned char* ws; int ph_lo, ph_hi, li, pad; };

__device__ __forceinline__ void p0_prologue(const Args& a, LAS unsigned char* lds, int wave, int lane) {
    LAS float* scr = (LAS float*)(lds + wave * 16384);
    const int gw = blockIdx.x * NWAVES + wave, NGW = gridDim.x * NWAVES;
    unsigned char* ws = a.ws;
    constexpr int I_IN = 16 * 128, I_UQ = 4 * 24, I_UK = 2 * 16, I_UV = 2 * 16, I_A = 8 * 32, I_B = 8 * 32, I_O = 16 * 32, I_GU = 32 * 16 * 64, I_D = 32 * 16 * 32;
    constexpr int NITEMS = I_IN + I_UQ + I_UK + I_UV + I_A + I_B + I_O + I_GU + I_D;
    for (int it = gw; it < NITEMS; it += NGW) {
        int r = it;
        if (r < I_IN) { tr_item(a.in[2], 4000, a.in[1], (bf16_t*)(ws + WS_WIN), 1024, 64 * (r / 128), 32 * (r % 128), CmIn{}, scr, lane); continue; } r -= I_IN;
        if (r < I_UQ) { tr_item(a.in[5], 768, a.in[3], (bf16_t*)(ws + WS_WUQ), 256, 64 * (r / 24), 32 * (r % 24), CmUq{}, scr, lane); continue; } r -= I_UQ;
        if (r < I_UK) { tr_item(a.in[6], 512, a.in[4], (bf16_t*)(ws + WS_WUKV), 128, 64 * (r / 16), 32 * (r % 16), CmId{0}, scr, lane); continue; } r -= I_UK;
        if (r < I_UV) { tr_item(a.in[7], 512, a.in[4], (bf16_t*)(ws + WS_WUKV), 128, 64 * (r / 16), 512 + 32 * (r % 16), CmId{512}, scr, lane); continue; } r -= I_UV;
        if (r < I_A) { tr_item(a.in[8], 1024, nullptr, (bf16_t*)(ws + WS_WA), 512, 64 * (r / 32), 32 * (r % 32), CmId{0}, scr, lane); continue; } r -= I_A;
        if (r < I_B) { tr_item(a.in[9], 1024, nullptr, (bf16_t*)(ws + WS_WB), 512, 64 * (r / 32), 32 * (r % 32), CmId{0}, scr, lane); continue; } r -= I_B;
        if (r < I_O) { tr_item(a.in[10], 1024, nullptr, (bf16_t*)(ws + WS_WO), 1024, 64 * (r / 32), 32 * (r % 32), CmId{0}, scr, lane); continue; } r -= I_O;
        if (r < I_GU) { const int e = r / 1024, q = r % 1024; tr_item(a.in[14] + (size_t)e * 1024 * 2048, 2048, a.in[11], (bf16_t*)(ws + WS_WGU) + (size_t)e * 2048 * 1024, 1024, 64 * (q / 64), 32 * (q % 64), CmGu{}, scr, lane); continue; } r -= I_GU;
        { const int e = r / 512, q = r % 512; tr_item(a.in[16] + (size_t)e * 1024 * 1024, 1024, nullptr, (bf16_t*)(ws + WS_WD) + (size_t)e * 1024 * 1024, 1024, 64 * (q / 32), 32 * (q % 32), CmId{0}, scr, lane); }
    }
    for (int m = gw; m < T; m += NGW) {
        const f32x4* xr = (const f32x4*)(a.in[0] + (size_t)m * DM) + lane;
        f32x4 v[4]; float s2 = 0.f;
#pragma unroll
        for (int j = 0; j < 4; ++j) { v[j] = xr[64 * j]; s2 += (v[j].x * v[j].x + v[j].y * v[j].y) + (v[j].z * v[j].z + v[j].w * v[j].w); }
        const float rstd = 1.f / sqrtf(wave_sum(s2) * (1.f / DM) + EPS);
        u32x2* o8 = (u32x2*)((bf16_t*)(ws + WS_XB) + (size_t)m * DM) + lane;
#pragma unroll
        for (int j = 0; j < 4; ++j) o8[64 * j] = (u32x2){pk2(v[j].x * rstd, v[j].y * rstd), pk2(v[j].z * rstd, v[j].w * rstd)};
    }
    const int gt = blockIdx.x * NTHREADS + threadIdx.x, NGT = gridDim.x * NTHREADS;
    for (int idx = gt; idx < SEQ * 16; idx += NGT) {
        const int s = idx >> 4, i = idx & 15;
        const float inv = __builtin_powf(10000.f, -(float)i * (1.f / 16.f));
        const float ang = (float)s * inv;
        double x = (double)ang; const double n = __builtin_rint(x * 0.15915494309189535); x = (x - n * 6.283185307179586) - n * 2.4492935982947064e-16;
        const double x2 = x * x; double sn = 1.0, cs = 1.0;
#pragma unroll
        for (int k = 13; k >= 1; --k) { sn = 1.0 - sn * x2 * (1.0 / (double)((2 * k) * (2 * k + 1))); cs = 1.0 - cs * x2 * (1.0 / (double)((2 * k - 1) * (2 * k))); }
        sn *= x;
        ((f32x2*)(ws + WS_ROPE))[idx] = (f32x2){(float)cs, (float)sn};
    }
    for (int idx = gt; idx < 1024 * 32; idx += NGT) ((float*)(ws + WS_WRP))[idx] = a.in[12][idx] * a.in[11][idx >> 5];
}

__device__ __forceinline__ void p2_stats(const Args& a, int wave, int lane) {
    const int gw = blockIdx.x * NWAVES + wave, NGW = gridDim.x * NWAVES; unsigned char* ws = a.ws;
    for (int m = gw; m < T; m += NGW) {
        const u32x2 q = ((const u32x2*)((const bf16_t*)(ws + WS_CQ) + (size_t)m * 256))[lane];
        const unsigned kv = ((const unsigned*)((const bf16_t*)(ws + WS_CKV) + (size_t)m * 128))[lane];
        const float a0 = bflo(q.x), a1 = bfhi(q.x), a2 = bflo(q.y), a3 = bfhi(q.y), b0 = bflo(kv), b1 = bfhi(kv);
        const float sq = wave_sum((a0 * a0 + a1 * a1) + (a2 * a2 + a3 * a3)), sk = wave_sum(b0 * b0 + b1 * b1);
        if (lane == 0) { ((float*)(ws + WS_RSTDQ))[m] = 1.f / sqrtf(sq * (1.f / 256.f) + EPS); ((float*)(ws + WS_RSTDKV))[m] = 1.f / sqrtf(sk * (1.f / 128.f) + EPS); }
    }
}

__device__ __forceinline__ void p4_attention(const Args& a, LAS unsigned char* lds, int wave, int lane) {
    unsigned char* ws = a.ws;
    LAS char* vimg = (LAS char*)(lds + wave * 8192); LAS float* wsf = (LAS float*)(lds + wave * 8192 + 4096);
    const int r32 = lane & 31, hi = lane >> 5;
    const bf16_t* QA = (const bf16_t*)(ws + WS_QA); const bf16_t* KA = (const bf16_t*)(ws + WS_KA); const bf16_t* VA = (const bf16_t*)(ws + WS_VA);
    bf16_t* PO = (bf16_t*)(ws + WS_PARTO); float* PL = (float*)(ws + WS_PARTL); bf16_t* OA = (bf16_t*)(ws + WS_OA);
    for (int un = blockIdx.x; un < NB * 8 * 32; un += gridDim.x) {
        const int sb = un & 31, h = (un >> 5) & 7, b = un >> 8;
        const size_t bo = (size_t)b * SEQ;
        for (int task = wave; task < 48; task += NWAVES) {
            int p, dil, res, u0, L;
            if (task < 16) { p = 0; dil = 1; res = 0; u0 = 512 * sb + 32 * task; L = SEQ; }
            else if (task < 32) { const int j = task - 16; p = 1; dil = 4; res = j & 3; u0 = 128 * sb + 32 * (j >> 2); L = SEQ / 4; }
            else { p = 2; dil = 16; res = task - 32; u0 = 32 * sb; L = SEQ / 16; }
            DilKL kl; kl.K = KA + bo * 512 + h * 64; kl.V = VA + bo * 512 + h * 64; kl.dil = dil; kl.res = res; kl.u0 = u0; kl.L = L;
            kl.slope2d = __builtin_amdgcn_exp2f(-(float)(h + 1)) * LOG2E * (float)dil;
            const size_t tq = bo + (size_t)(res + dil * (u0 + r32));
            bf16x8 qf[4];
#pragma unroll
            for (int d0 = 0; d0 < 4; ++d0) qf[d0] = *(const bf16x8*)(QA + tq * 512 + h * 64 + 16 * d0 + 8 * hi);
            AttnState st; wave_attn<4>(st, qf, kl, 5, vimg, wsf, lane);
            const float lt = attn_finish(st, vimg, wsf, lane);
            if (hi == 0) PL[(((size_t)p * NB + b) * 8 + h) * SEQ + (res + dil * (u0 + r32))] = st.m + __builtin_amdgcn_logf(lt);
#pragma unroll
            for (int i = 0; i < 4; ++i) { const int row = i * 8 + (lane >> 3), ch = lane & 7; const u32x4 v = *(const LAS u32x4*)(vimg + row * 128 + ch * 16);
                *(u32x4*)(PO + ((size_t)p * T + bo + (size_t)(res + dil * (u0 + row))) * 512 + h * 64 + ch * 8) = v; }
        }
        asm volatile("s_waitcnt vmcnt(0)" ::: "memory");
        __syncthreads();
#pragma unroll 1
        for (int i = 0; i < 8; ++i) {
            const int s = 512 * sb + wave * 64 + i * 8 + (lane >> 3), ch = lane & 7;
            const float l0 = PL[(((size_t)0 * NB + b) * 8 + h) * SEQ + s], l1 = PL[(((size_t)1 * NB + b) * 8 + h) * SEQ + s], l2 = PL[(((size_t)2 * NB + b) * 8 + h) * SEQ + s];
            const float mx = fmaxf(fmaxf(l0, l1), l2); float w0 = fexp2(l0 - mx), w1 = fexp2(l1 - mx), w2 = fexp2(l2 - mx); const float iw = frcp(w0 + w1 + w2); w0 *= iw; w1 *= iw; w2 *= iw;
            float v0[8], v1[8], v2[8], o[8];
            unpack8(*(const u32x4*)(PO + ((size_t)0 * T + bo + s) * 512 + h * 64 + ch * 8), v0);
            unpack8(*(const u32x4*)(PO + ((size_t)1 * T + bo + s) * 512 + h * 64 + ch * 8), v1);
            unpack8(*(const u32x4*)(PO + ((size_t)2 * T + bo + s) * 512 + h * 64 + ch * 8), v2);
#pragma unroll
            for (int j = 0; j < 8; ++j) o[j] = w0 * v0[j] + w1 * v1[j] + w2 * v2[j];
            *(u32x4*)(OA + (bo + s) * 512 + h * 64 + ch * 8) = pack8(o);
        }
        __syncthreads();
    }
    const bf16_t* QB = (const bf16_t*)(ws + WS_QB); const bf16_t* KB = (const bf16_t*)(ws + WS_KB); const bf16_t* VB = (const bf16_t*)(ws + WS_VB); const bf16_t* KR = (const bf16_t*)(ws + WS_KR);
    bf16_t* OB = (bf16_t*)(ws + WS_OB);
    for (int un = blockIdx.x; un < NB * 8 * 64; un += gridDim.x) {
        const int qb = un & 63, h = (un >> 6) & 7, b = un >> 9;
        const size_t bo = (size_t)b * SEQ, tq0 = bo + (size_t)qb * 256 + wave * 32;
        MlaKL kl; kl.Kn = KB + bo * 512 + h * 64; kl.Kr = KR + bo * 32; kl.V = VB + bo * 512 + h * 64;
        bf16x8 qf[6];
#pragma unroll
        for (int d0 = 0; d0 < 6; ++d0) qf[d0] = *(const bf16x8*)(QB + (tq0 + r32) * 768 + h * 96 + 16 * d0 + 8 * hi);
        AttnState st; wave_attn<6>(st, qf, kl, SEQ / 32, vimg, wsf, lane);
        (void)attn_finish(st, vimg, wsf, lane);
#pragma unroll
        for (int i = 0; i < 4; ++i) { const int row = i * 8 + (lane >> 3), ch = lane & 7; const u32x4 v = *(const LAS u32x4*)(vimg + row * 128 + ch * 16);
            *(u32x4*)(OB + (tq0 + row) * 512 + h * 64 + ch * 8) = v; }
    }
}

__device__ __forceinline__ void p8_router(const Args& a, LAS unsigned char* lds, volatile LAS unsigned* MISC, int wave, int lane) {
    unsigned char* ws = a.ws; const float* x1 = a.out; const float* wrp = (const float*)(ws + WS_WRP); const float* br = a.in[13];
    LAS float* lg = (LAS float*)(lds + wave * 8192);
    LAS unsigned* hist = (LAS unsigned*)(MISC + MI_HIST);
    if (threadIdx.x < 32) hist[threadIdx.x] = 0u;
    __syncthreads();
    const int G = gridDim.x, i32 = lane & 31, hi = lane >> 5;
    for (int tb = wave * G + blockIdx.x; tb < T / 32; tb += G * NWAVES) {
        const int t = tb * 32 + i32;
        const float* xr = x1 + (size_t)t * DM + 512 * hi; const float* wr_ = wrp + (size_t)(512 * hi) * 32 + i32;
        f32x16 acc = {}; float ssq = 0.f;
#pragma unroll 4
        for (int s4 = 0; s4 < 128; ++s4) {
            const f32x4 xa = *(const f32x4*)(xr + 4 * s4);
            ssq += (xa.x * xa.x + xa.y * xa.y) + (xa.z * xa.z + xa.w * xa.w);
            acc = __builtin_amdgcn_mfma_f32_32x32x2f32(xa.x, wr_[(4 * s4 + 0) * 32], acc, 0, 0, 0);
            acc = __builtin_amdgcn_mfma_f32_32x32x2f32(xa.y, wr_[(4 * s4 + 1) * 32], acc, 0, 0, 0);
            acc = __builtin_amdgcn_mfma_f32_32x32x2f32(xa.z, wr_[(4 * s4 + 2) * 32], acc, 0, 0, 0);
            acc = __builtin_amdgcn_mfma_f32_32x32x2f32(xa.w, wr_[(4 * s4 + 3) * 32], acc, 0, 0, 0);
        }
        ssq = swapsum(ssq);
        const float rstd = 1.f / sqrtf(ssq * (1.f / DM) + EPS);
#pragma unroll
        for (int r = 0; r < 16; ++r) lg[crow(r, hi) * 33 + i32] = acc[r];
        asm volatile("s_waitcnt lgkmcnt(0)" ::: "memory");
        float v[32];
#pragma unroll
        for (int e = 0; e < 32; ++e) v[e] = lg[i32 * 33 + e] * rstd + br[e];
        int ti[4]; float tv[4];
#pragma unroll
        for (int k = 0; k < 4; ++k) {
            float best = v[0]; int bi = 0;
#pragma unroll
            for (int e = 1; e < 32; ++e) { const bool g = v[e] > best; best = g ? v[e] : best; bi = g ? e : bi; }
            ti[k] = bi; tv[k] = best;
#pragma unroll
            for (int e = 0; e < 32; ++e) v[e] = (e == bi) ? -3.0e38f : v[e];
        }
        const float e1 = __expf(tv[1] - tv[0]), e2 = __expf(tv[2] - tv[0]), e3 = __expf(tv[3] - tv[0]); const float inv = 1.f / (1.f + e1 + e2 + e3);
        const float gw[4] = {inv, e1 * inv, e2 * inv, e3 * inv};
        if (hi == 0) {
            ((float*)(ws + WS_RSTD2))[t] = rstd;
#pragma unroll
            for (int k = 0; k < 4; ++k) { const unsigned rk = __hip_atomic_fetch_add(&hist[ti[k]], 1u, __ATOMIC_RELAXED, __HIP_MEMORY_SCOPE_WORKGROUP);
                ((int*)(ws + WS_TOPI))[t * 4 + k] = ti[k]; ((float*)(ws + WS_GATEW))[t * 4 + k] = gw[k]; ((int*)(ws + WS_SRANK))[t * 4 + k] = (int)rk; }
        }
        asm volatile("s_waitcnt lgkmcnt(0)" ::: "memory");
    }
    __syncthreads();
    if (threadIdx.x < 32) {
        const unsigned c = hist[threadIdx.x];
        const unsigned base = __hip_atomic_fetch_add((unsigned*)(ws + WS_CTL) + CW_GCOUNT + threadIdx.x, c, __ATOMIC_RELAXED, __HIP_MEMORY_SCOPE_AGENT);
        ((int*)(ws + WS_WGBASE))[blockIdx.x * 32 + threadIdx.x] = (int)base;
    }
}
__device__ __forceinline__ void moe_prefix(const Args& a, volatile LAS unsigned* MISC) {
    if (threadIdx.x == 0) {
        const unsigned* gc = (const unsigned*)(a.ws + WS_CTL) + CW_GCOUNT; int acc = 0;
        for (int e = 0; e < 32; ++e) { MISC[MI_PSTART + e] = (unsigned)acc; MISC[MI_TPRE + e] = (unsigned)(acc >> 8);
            const int c = (int)__hip_atomic_load(gc + e, __ATOMIC_RELAXED, __HIP_MEMORY_SCOPE_AGENT); acc += (c + 255) & ~255; }
        MISC[MI_PSTART + 32] = (unsigned)acc; MISC[MI_TPRE + 32] = (unsigned)(acc >> 8);
    }
    __syncthreads();
}
__device__ __forceinline__ void p9_scatter(const Args& a, volatile LAS unsigned* MISC) {
    unsigned char* ws = a.ws; const int G = gridDim.x;
    moe_prefix(a, MISC);
    const int* topi = (const int*)(ws + WS_TOPI); const int* srank = (const int*)(ws + WS_SRANK); const int* wgbase = (const int*)(ws + WS_WGBASE); const float* rstd2 = (const float*)(ws + WS_RSTD2);
    int* pos = (int*)(ws + WS_POS); int* rowtok = (int*)(ws + WS_ROWTOK); float* rowscale = (float*)(ws + WS_ROWSCALE);
    for (int sl = blockIdx.x * NTHREADS + threadIdx.x; sl < NSLOT; sl += G * NTHREADS) {
        const int t = sl >> 2, e = topi[sl], wg = (t >> 5) % G;
        const int row = (int)MISC[MI_PSTART + e] + wgbase[wg * 32 + e] + srank[sl];
        pos[sl] = row; rowtok[row] = t; rowscale[row] = rstd2[t];
    }
    if (blockIdx.x < 32) {
        const int e = blockIdx.x; const int c = (int)__hip_atomic_load((const unsigned*)(ws + WS_CTL) + CW_GCOUNT + e, __ATOMIC_RELAXED, __HIP_MEMORY_SCOPE_AGENT);
        const int r0 = (int)MISC[MI_PSTART + e] + c, r1 = (int)MISC[MI_PSTART + e + 1];
        for (int r = r0 + threadIdx.x; r < r1; r += NTHREADS) { rowtok[r] = 0; rowscale[r] = 0.f; }
    }
}
__device__ __forceinline__ void p12_final(const Args& a, int wave, int lane) {
    unsigned char* ws = a.ws; const int gw = blockIdx.x * NWAVES + wave, NGW = gridDim.x * NWAVES;
    const int* pos = (const int*)(ws + WS_POS); const float* gatew = (const float*)(ws + WS_GATEW); const bf16_t* Y = (const bf16_t*)(ws + WS_Y);
    f32x4 g[4];
#pragma unroll
    for (int j = 0; j < 4; ++j) g[j] = ((const f32x4*)a.in[18])[lane + 64 * j];
    for (int t = gw; t < T; t += NGW) {
        f32x4* xr = (f32x4*)(a.out + (size_t)t * DM) + lane;
        f32x4 v[4];
#pragma unroll
        for (int j = 0; j < 4; ++j) v[j] = xr[64 * j];
#ifndef DBG_NO_MOE
#pragma unroll
        for (int k = 0; k < 4; ++k) {
            const int row = pos[t * 4 + k]; const float w = gatew[t * 4 + k];
            const u32x2* yr = (const u32x2*)(Y + (size_t)row * DM) + lane;
#pragma unroll
            for (int j = 0; j < 4; ++j) { const u32x2 y = yr[64 * j]; v[j].x += w * bflo(y.x); v[j].y += w * bfhi(y.x); v[j].z += w * bflo(y.y); v[j].w += w * bfhi(y.y); }
        }
#endif
        float s2 = 0.f;
#pragma unroll
        for (int j = 0; j < 4; ++j) s2 += (v[j].x * v[j].x + v[j].y * v[j].y) + (v[j].z * v[j].z + v[j].w * v[j].w);
        const float rstd = 1.f / sqrtf(wave_sum(s2) * (1.f / DM) + EPS);
#pragma unroll
        for (int j = 0; j < 4; ++j) xr[64 * j] = v[j] * rstd * g[j];
    }
}

constexpr int N_PHASES = 13;
#ifndef MK_ONE_LAUNCH
#define MK_ONE_LAUNCH 0
#endif
__global__ void __launch_bounds__(NTHREADS, 2) fwd(Args args) {
    extern __shared__ __attribute__((aligned(16))) unsigned char lds_raw[];
    LAS unsigned char* lds = (LAS unsigned char*)lds_raw;
    volatile LAS unsigned* MISC = (volatile LAS unsigned*)(lds + MISC_OFF);
    const int tid = threadIdx.x, lane = tid & 63, wave = __builtin_amdgcn_readfirstlane(tid >> 6);
    const int G = gridDim.x, bx = blockIdx.x;
    unsigned char* ws = args.ws;
    for (int u = tid; u < (LDS_BYTES - RING_BYTES) / 4; u += NTHREADS) ((LAS unsigned*)(lds + RING_BYTES))[u] = 0u;
    __syncthreads();
    XcdBarrier bar; bar.bar = (unsigned*)(ws + WS_CTL) + CW_BAR; bar.x = 0; bar.st = nullptr;
    if (MK_ONE_LAUNCH) bar = xcd_barrier_post((unsigned*)(ws + WS_CTL) + CW_BAR, MISC + MI_BAR);
    const int lo = args.ph_lo, hi = args.ph_hi;
#ifdef ONLY_PHASE
#define IN(k) ((k) == ONLY_PHASE && lo <= (k) && (k) < hi)
#else
#define IN(k) (lo <= (k) && (k) < hi)
#endif
#define SEAM(k) do { if (IN(k) && IN((k) + 1)) xcd_barrier(bar); } while (0)

    if (IN(0)) { p0_prologue(args, lds, wave, lane); } SEAM(0);
    if (IN(1)) { pg8::DenseSched S; S.init((const bf16_t*)(ws + WS_XB), (const bf16_t*)(ws + WS_WIN), T, NIN, 1024, G, bx); EpiInProj E{ws};
        pg8::gemm_phase2<EpiInProj, pg8::DenseSched, true>(lds, 1024, S, E); } SEAM(1);
    if (IN(2)) { p2_stats(args, wave, lane); } SEAM(2);
    if (IN(3)) {
        { pg8::DenseSched S; S.init((const bf16_t*)(ws + WS_CQ), (const bf16_t*)(ws + WS_WUQ), T, 768, 256, G, bx); EpiQ E{ws};
          pg8::gemm_phase2<EpiQ, pg8::DenseSched, true>(lds, 256, S, E); }
        { pg8::DenseSched S; S.init((const bf16_t*)(ws + WS_CKV), (const bf16_t*)(ws + WS_WUKV), T, 1024, 128, G, bx); EpiKV E{ws};
          pg8::gemm_phase2<EpiKV, pg8::DenseSched, true>(lds, 128, S, E); }
    } SEAM(3);
    if (IN(4)) { p4_attention(args, lds, wave, lane); } SEAM(4);
    if (IN(5)) { pg8::DenseSched S; S.init((const bf16_t*)(ws + WS_OA), (const bf16_t*)(ws + WS_WA), T, 1024, 512, G, bx); EpiGate<false> E{ws};
        pg8::gemm_phase2<EpiGate<false>, pg8::DenseSched, true>(lds, 512, S, E); } SEAM(5);
    if (IN(6)) { pg8::DenseSched S; S.init((const bf16_t*)(ws + WS_OB), (const bf16_t*)(ws + WS_WB), T, 1024, 512, G, bx); EpiGate<true> E{ws};
        pg8::gemm_phase2<EpiGate<true>, pg8::DenseSched, true>(lds, 512, S, E); } SEAM(6);
    if (IN(7)) { pg8::DenseSched S; S.init((const bf16_t*)(ws + WS_MERGED), (const bf16_t*)(ws + WS_WO), T, 1024, 1024, G, bx); EpiResid E{ws, args.in[0], args.out};
        pg8::gemm_phase2<EpiResid, pg8::DenseSched, true>(lds, 1024, S, E); } SEAM(7);
    if (IN(8)) { p8_router(args, lds, MISC, wave, lane); } SEAM(8);
    if (IN(9)) { p9_scatter(args, MISC); } SEAM(9);
    if (IN(10)) {
        moe_prefix(args, MISC);
        pg8::MoeSched<3, true> S; S.tpre = (const LAS int*)(MISC + MI_TPRE); S.ntiles = (int)MISC[MI_TPRE + 32]; S.G = G; S.c = bx; S.K = 1024;
        S.A = (const char*)(ws + WS_H2); S.Bt = (const char*)(ws + WS_WGU); S.estride = (size_t)2048 * 1024 * 2; S.row_tok = (const int*)(ws + WS_ROWTOK);
        EpiSwiglu E{ws, args.in[15]};
        pg8::gemm_phase2<EpiSwiglu, pg8::MoeSched<3, true>, true>(lds, 1024, S, E);
    } SEAM(10);
    if (IN(11)) {
        moe_prefix(args, MISC);
        pg8::MoeSched<2, false> S; S.tpre = (const LAS int*)(MISC + MI_TPRE); S.ntiles = (int)MISC[MI_TPRE + 32]; S.G = G; S.c = bx; S.K = 1024;
        S.A = (const char*)(ws + WS_ACT); S.Bt = (const char*)(ws + WS_WD); S.estride = (size_t)1024 * 1024 * 2; S.row_tok = nullptr;
        EpiDown E{ws, args.in[17]};
        pg8::gemm_phase2<EpiDown, pg8::MoeSched<2, false>, true>(lds, 1024, S, E);
    } SEAM(11);
    if (IN(12)) { p12_final(args, wave, lane); }
#undef IN
#undef SEAM
}

#ifdef DBG_DUMP
__global__ void dbg_dump(float* out, const unsigned char* ws, int level) {
    const size_t n = (size_t)T * DM; const size_t i0 = (size_t)blockIdx.x * blockDim.x + threadIdx.x, st = (size_t)gridDim.x * blockDim.x;
    for (size_t i = i0; i < n; i += st) {
        float v = 0.f;
#define ADD(off, ne) v += bf2f(((const bf16_t*)(ws + (off)))[i % (size_t)(ne)])
        if (level == 0) { ADD(WS_XB, (size_t)T * 1024); ADD(WS_WIN, (size_t)4096 * 1024); ADD(WS_WUQ, 768 * 256); ADD(WS_WUKV, 1024 * 128); ADD(WS_WA, 1024 * 512); ADD(WS_WB, 1024 * 512); ADD(WS_WO, 1024 * 1024); v += ((const float*)(ws + WS_ROPE))[i % (SEQ * 32)]; }
        if (level == 1) { ADD(WS_QA, (size_t)T * 512); ADD(WS_KA, (size_t)T * 512); ADD(WS_VA, (size_t)T * 512); ADD(WS_CQ, (size_t)T * 256); ADD(WS_CKV, (size_t)T * 128); ADD(WS_KR, (size_t)T * 32); ADD(WS_GA, (size_t)T * 1024); ADD(WS_GB, (size_t)T * 1024); }
        if (level == 3) { ADD(WS_QB, (size_t)T * 768); ADD(WS_KB, (size_t)T * 512); ADD(WS_VB, (size_t)T * 512); }
        if (level == 4) { ADD(WS_OA, (size_t)T * 512); }
        if (level == 5) { ADD(WS_OB, (size_t)T * 512); }
        if (level == 6) { ADD(WS_MERGED, (size_t)T * 1024); }
#undef ADD
        out[i] = v;
    }
}
#endif
extern "C" void kernel_launch(void* const* d_in, const int* in_sizes, int n_in, void* d_out, int out_size, void* d_ws, size_t ws_size, hipStream_t stream) {
    static int grid = 0;
    if (grid == 0) {
        if (n_in != 19 || in_sizes[0] != T * DM || out_size != T * DM || ws_size < WS_END) { fprintf(stderr, "kernel_launch: unexpected shapes (n_in %d, in0 %d, out %d, ws %zu); nothing launched\n", n_in, n_in > 0 ? in_sizes[0] : -1, out_size, ws_size); grid = -1; return; }
        int dev = 0, cus = 0, per_cu = 0;
        if (hipGetDevice(&dev) != hipSuccess || hipDeviceGetAttribute(&cus, hipDeviceAttributeMultiprocessorCount, dev) != hipSuccess) { grid = -1; return; }
        if (hipFuncSetAttribute((const void*)fwd, hipFuncAttributeMaxDynamicSharedMemorySize, LDS_BYTES) != hipSuccess) { fprintf(stderr, "kernel_launch: hipFuncSetAttribute failed\n"); grid = -1; return; }
        if (hipOccupancyMaxActiveBlocksPerMultiprocessor(&per_cu, (const void*)fwd, NTHREADS, LDS_BYTES) != hipSuccess || per_cu < 1) fprintf(stderr, "kernel_launch: occupancy query reports %d\n", per_cu);
        (void)hipGetLastError();
        grid = cus;
    }
    if (grid < 0) return;
    if (hipMemsetAsync((char*)d_ws + WS_CTL, 0, CTL_ZERO_BYTES, stream) != hipSuccess) { fprintf(stderr, "kernel_launch: memset failed\n"); return; }
    Args a{};
    for (int i = 0; i < 19; ++i) a.in[i] = (const float*)d_in[i];
    a.out = (float*)d_out; a.ws = (unsigned char*)d_ws; a.li = 0; a.pad = 0;
#if MK_ONE_LAUNCH
    a.ph_lo = 0; a.ph_hi = N_PHASES;
    hipLaunchKernelGGL(fwd, dim3(grid), dim3(NTHREADS), LDS_BYTES, stream, a);
#else
    for (int p = 0; p < N_PHASES; ++p) {
#ifdef DBG_NO_MOE
        if (p >= 8 && p <= 11) continue;
#endif
#ifdef DBG_DUMP
        if (p > (DBG_DUMP == 5 ? 4 : DBG_DUMP)) continue;
#endif
        a.ph_lo = p; a.ph_hi = p + 1; hipLaunchKernelGGL(fwd, dim3(grid), dim3(NTHREADS), LDS_BYTES, stream, a); }
#ifdef DBG_DUMP
    hipLaunchKernelGGL(dbg_dump, dim3(2048), dim3(256), 0, stream, (float*)d_out, (const unsigned char*)d_ws, (int)DBG_DUMP);
#endif
#endif
    const hipError_t le = hipPeekAtLastError();
    if (le != hipSuccess) fprintf(stderr, "kernel_launch: launch failed: %s\n", hipGetErrorName(le));
}
```

```cpp
#define MK_ONE_LAUNCH 1
#include <hip/hip_runtime.h>
#include <cstdio>
#include <cstdint>

#define LAS __attribute__((address_space(3)))
#define GAS __attribute__((address_space(1)))
typedef unsigned short bf16_t;
typedef short bf16x8 __attribute__((ext_vector_type(8)));
typedef short s16x4 __attribute__((ext_vector_type(4)));
typedef float f32x2 __attribute__((ext_vector_type(2)));
typedef float f32x4 __attribute__((ext_vector_type(4)));
typedef float f32x16 __attribute__((ext_vector_type(16)));
typedef unsigned u32x2 __attribute__((ext_vector_type(2)));
typedef unsigned u32x4 __attribute__((ext_vector_type(4)));

constexpr int NB = 2, SEQ = 16384, T = NB * SEQ, DM = 1024;
constexpr int NIN = 4096;
constexpr int NEXP = 32, TOPK = 4, NSLOT = T * TOPK, NPMAX = NSLOT + NEXP * 256;
constexpr float EPS = 1e-5f, LOG2E = 1.4426950408889634f;
constexpr int NWAVES = 8, NTHREADS = 512;

constexpr size_t MiB = 1u << 20;
constexpr size_t WS_CTL = 0, CTL_ZERO_BYTES = 1 * MiB;
constexpr size_t WS_WIN = 1 * MiB;
constexpr size_t WS_WUQ = 9 * MiB;
constexpr size_t WS_WUKV = 10 * MiB;
constexpr size_t WS_WA = 11 * MiB, WS_WB = 12 * MiB;
constexpr size_t WS_WO = 13 * MiB;
constexpr size_t WS_ROPE = 15 * MiB;
constexpr size_t WS_WGU = 17 * MiB;
constexpr size_t WS_WD = 145 * MiB;
constexpr size_t WS_SMALL = 209 * MiB;
constexpr size_t WS_RSTDQ = WS_SMALL, WS_RSTDKV = WS_RSTDQ + T * 4, WS_RSTD2 = WS_RSTDKV + T * 4;
constexpr size_t WS_TOPI = WS_RSTD2 + T * 4, WS_GATEW = WS_TOPI + (size_t)NSLOT * 4, WS_SRANK = WS_GATEW + (size_t)NSLOT * 4, WS_POS = WS_SRANK + (size_t)NSLOT * 4;
constexpr size_t WS_ROWTOK = WS_POS + (size_t)NSLOT * 4, WS_ROWSCALE = WS_ROWTOK + 1 * MiB, WS_WGBASE = WS_ROWSCALE + 1 * MiB;
constexpr size_t WS_WRP = WS_WGBASE + 64 * 1024;
constexpr size_t WS_PARTL = WS_WRP + 128 * 1024;
static_assert(WS_PARTL + 3 * MiB <= 225 * MiB, "small region");
constexpr size_t WS_XB = 225 * MiB;
constexpr size_t WS_QA = 289 * MiB, WS_KA = 321 * MiB, WS_VA = 353 * MiB;
constexpr size_t WS_CQ = 385 * MiB;
constexpr size_t WS_CKV = 401 * MiB;
constexpr size_t WS_KR = 409 * MiB;
constexpr size_t WS_GA = 411 * MiB, WS_GB = 475 * MiB;
constexpr size_t WS_ACT = 225 * MiB;
static_assert(WS_ACT + (size_t)NPMAX * 2048 <= 539 * MiB, "ACT overlay");
constexpr size_t WS_QB = 539 * MiB;
constexpr size_t WS_KB = 587 * MiB, WS_VB = 619 * MiB;
constexpr size_t WS_OA = 651 * MiB, WS_OB = 683 * MiB;
constexpr size_t WS_MERGED = 715 * MiB;
constexpr size_t WS_PARTO = 779 * MiB;
constexpr size_t WS_H2 = 875 * MiB;
constexpr size_t WS_Y = 539 * MiB;
static_assert(WS_Y + (size_t)NPMAX * 2048 <= WS_H2, "Y overlay");
constexpr size_t WS_END = 939 * MiB;
constexpr int CW_TMO = 0, CW_BAR = 4096, CW_GCOUNT = 8192;

constexpr int RING_BYTES = 131072, MISC_OFF = RING_BYTES + 320, LDS_BYTES = 147456;
constexpr int MI_BAR = 8, MI_TPRE = 16, MI_HIST = 64, MI_PSTART = 96;

__device__ __forceinline__ unsigned f2bf(float f) { unsigned u = __builtin_bit_cast(unsigned, f); return (u + 0x7fffu + ((u >> 16) & 1u)) >> 16; }
__device__ __forceinline__ unsigned pk2(float lo, float hi) { return f2bf(lo) | (f2bf(hi) << 16); }
__device__ __forceinline__ float bf2f(unsigned short b) { return __builtin_bit_cast(float, (unsigned)b << 16); }
__device__ __forceinline__ float bflo(unsigned w) { return __builtin_bit_cast(float, w << 16); }
__device__ __forceinline__ float bfhi(unsigned w) { return __builtin_bit_cast(float, w & 0xffff0000u); }
typedef __bf16 bf16x2_t __attribute__((ext_vector_type(2)));
__device__ __forceinline__ unsigned cvtpk(float lo, float hi) { const f32x2 v = {lo, hi}; const bf16x2_t b = __builtin_convertvector(v, bf16x2_t); return __builtin_bit_cast(unsigned, b); }
__device__ __forceinline__ float wave_sum(float v) {
#pragma unroll
    for (int o = 1; o < 64; o <<= 1) v += __shfl_xor(v, o);
    return v;
}
__device__ __forceinline__ float fexp2(float x) { return __builtin_amdgcn_exp2f(x); }
__device__ __forceinline__ float frcp(float x) { return __builtin_amdgcn_rcpf(x); }
__device__ __forceinline__ float sigmoidf_(float z) { return frcp(1.f + fexp2(-z * LOG2E)); }
__device__ __forceinline__ int crow(int r, int hi) { return (r & 3) + 8 * (r >> 2) + 4 * hi; }
__device__ __forceinline__ u32x4 pack8(const float (&v)[8]) { u32x4 w; w.x = cvtpk(v[0], v[1]); w.y = cvtpk(v[2], v[3]); w.z = cvtpk(v[4], v[5]); w.w = cvtpk(v[6], v[7]); return w; }
__device__ __forceinline__ void unpack8(const u32x4 w, float (&v)[8]) { v[0] = bflo(w.x); v[1] = bfhi(w.x); v[2] = bflo(w.y); v[3] = bfhi(w.y); v[4] = bflo(w.z); v[5] = bfhi(w.z); v[6] = bflo(w.w); v[7] = bfhi(w.w); }

namespace pg8 {
constexpr int BM = 256, BK = 64, HALF = 128, HTB = HALF * BK * 2  , NXCD = 8, WGM = 8;
__host__ __device__ __forceinline__ int lds_byte(int r, int c) { const int st = (r >> 4) * 2 + (c >> 5), rr = r & 15, cc = c & 31, ob = rr * 64 + cc * 2; return st * 1024 + (ob ^ (((ob >> 9) & 1) << 5)); }
__host__ __device__ __forceinline__ void stage_rc(int b, int& R, int& C) { const int st = b / 1024, sb = b % 1024, swz = sb ^ (((sb >> 9) & 1) << 5); R = (st >> 1) * 16 + swz / 64; C = (st & 1) * 32 + (swz % 64) / 2; }
__host__ __device__ __forceinline__ int perm32(int rho) { const int n = rho >> 4, i = rho & 15; return 8 * (i >> 2) + 4 * n + (i & 3); }

struct Unit { int pm, pn, e; };

struct StaticOrder {
    int nM, nN, nwg, G, c;
    __host__ __device__ void init(int M, int N, int G_, int c_) { nM = M / BM; nN = N / BM; nwg = nM * nN; G = G_; c = c_; }
    __host__ __device__ bool next(int i, Unit& u) const {
        const long L = (long)i * G + c; if (L >= nwg) return false;
        int wgid = (int)L; { const int q = nwg / NXCD, r = nwg % NXCD, xcd = wgid % NXCD, off = wgid / NXCD; wgid = (xcd < r ? xcd * (q + 1) : r * (q + 1) + (xcd - r) * q) + off; }
        const int nig = WGM * nN, gid = wgid / nig, fm = gid * WGM, gsz = (nM - fm) < WGM ? (nM - fm) : WGM;
        u.pm = fm + ((wgid % nig) % gsz); u.pn = (wgid % nig) / gsz; u.e = 0; return true;
    }
};
struct DenseSched {
    StaticOrder so; const char* A; const char* Bt; int K;
    __device__ __forceinline__ void init(const bf16_t* A_, const bf16_t* Bt_, int M, int N, int K_, int G, int c) { so.init(M, N, G, c); A = (const char*)A_; Bt = (const char*)Bt_; K = K_; }
    __device__ __forceinline__ bool next(int i, Unit& u) const { return so.next(i, u); }
    __device__ __forceinline__ const char* a_base(const Unit& u) const { return A + (size_t)u.pm * ((size_t)BM * K * 2); }
    __device__ __forceinline__ const char* b_base(const Unit& u) const { return Bt + (size_t)u.pn * ((size_t)BM * K * 2); }
    __device__ __forceinline__ void a_off(const Unit&, const int (&sR)[2], const int (&sC)[2], unsigned (&vo)[2][2]) const {
#pragma unroll
        for (int h = 0; h < 2; ++h)
#pragma unroll
            for (int i = 0; i < 2; ++i) vo[h][i] = (unsigned)((h * HALF + sR[i]) * K + sC[i]) * 2u;
    }
};
template <int NPN_SHIFT, bool GATHER>
struct MoeSched {
    const LAS int* tpre; int ntiles, G, c, K; const char* A; const char* Bt; size_t estride; const int* row_tok;
    __device__ __forceinline__ bool next(int i, Unit& u) const {
        const int L = i * G + c, g = L >> NPN_SHIFT; if (g >= ntiles) return false;
        int e = 0; while (e < 31 && tpre[e + 1] <= g) ++e;
        u.pm = g; u.pn = L & ((1 << NPN_SHIFT) - 1); u.e = e; return true;
    }
    __device__ __forceinline__ const char* a_base(const Unit& u) const { return GATHER ? A : A + (size_t)u.pm * ((size_t)BM * K * 2); }
    __device__ __forceinline__ const char* b_base(const Unit& u) const { return Bt + (size_t)u.e * estride + (size_t)u.pn * ((size_t)BM * K * 2); }
    __device__ __forceinline__ void a_off(const Unit& u, const int (&sR)[2], const int (&sC)[2], unsigned (&vo)[2][2]) const {
#pragma unroll
        for (int h = 0; h < 2; ++h)
#pragma unroll
            for (int i = 0; i < 2; ++i) {
                if (GATHER) { const int tok = row_tok[u.pm * BM + h * HALF + sR[i]]; vo[h][i] = (unsigned)(tok * K + sC[i]) * 2u; }
                else vo[h][i] = (unsigned)((h * HALF + sR[i]) * K + sC[i]) * 2u;
            }
    }
};

template <class Epi, class Sched, bool ALIGN_EPI>
__device__ __forceinline__ void gemm_phase2(LAS unsigned char* lds, const int K_, const Sched& S, const Epi& E) {
    int K = K_; asm volatile("" : "+s"(K));
    const int tid = threadIdx.x, wid = __builtin_amdgcn_readfirstlane(tid >> 6), lane = tid & 63, wr = wid >> 2, wc = wid & 3, fr = lane & 15, fq = lane >> 4;
    const int nt = K / BK;
    int sR[2], sC[2]; unsigned voffB[2];
#pragma unroll
    for (int i = 0; i < 2; ++i) { int R, C; stage_rc(tid * 16 + i * 8192, R, C); sR[i] = R; sC[i] = C; const int Rb = Epi::PERM ? ((R & ~31) + perm32(R & 31)) : R; voffB[i] = (unsigned)(Rb * K + C) * 2u; }
    const size_t kstep = (size_t)(BK * 2);
    const size_t hstep = (size_t)HALF * K * 2;
    const unsigned ldsw = (unsigned)wid * 1024u;
    const int aoff = lds_byte(wr * 64 + fr, fq * 8), boff = lds_byte(wc * 32 + fr, fq * 8);
#define PG8_SA(b, h) (((b) * 2 + (h)) * HTB)
#define PG8_SB(b, h) ((4 + (b) * 2 + (h)) * HTB)
#define PG8_STAGE_B(bufoff, gbase) do { _Pragma("unroll") for (int _i = 0; _i < 2; ++_i) \
        __builtin_amdgcn_global_load_lds((const unsigned*)((const char*)(gbase) + voffB[_i]), (LAS unsigned*)(lds + (bufoff) + ldsw + _i * 8192), 16, 0, 0); } while (0)
#define PG8_STAGE_A(bufoff, gbase, o0, o1) do { \
        __builtin_amdgcn_global_load_lds((const unsigned*)((const char*)(gbase) + (o0)), (LAS unsigned*)(lds + (bufoff) + ldsw), 16, 0, 0); \
        __builtin_amdgcn_global_load_lds((const unsigned*)((const char*)(gbase) + (o1)), (LAS unsigned*)(lds + (bufoff) + ldsw + 8192), 16, 0, 0); } while (0)
#define PG8_LDA(dst, b, h) do { _Pragma("unroll") for (int m = 0; m < 4; ++m) _Pragma("unroll") for (int k = 0; k < 2; ++k) dst[m][k] = *(const LAS bf16x8*)(lds + PG8_SA(b, h) + aoff + m * 2048 + k * 1024); } while (0)
#define PG8_LDB(dst, b, h) do { _Pragma("unroll") for (int n = 0; n < 2; ++n) _Pragma("unroll") for (int k = 0; k < 2; ++k) dst[n][k] = *(const LAS bf16x8*)(lds + PG8_SB(b, h) + boff + n * 2048 + k * 1024); } while (0)
#define PG8_MMA(ai, bj, At, Bt) do { __builtin_amdgcn_s_setprio(1); _Pragma("unroll") for (int m = 0; m < 4; ++m) _Pragma("unroll") for (int n = 0; n < 2; ++n) _Pragma("unroll") for (int k = 0; k < 2; ++k) \
        acc[ai][bj][m][n] = __builtin_amdgcn_mfma_f32_16x16x32_bf16(Bt[n][k], At[m][k], acc[ai][bj][m][n], 0, 0, 0); __builtin_amdgcn_s_setprio(0); } while (0)
#define PG8_WAIT_V(n) asm volatile("s_waitcnt vmcnt(" #n ")" ::: "memory")
#define PG8_WAIT_L(n) asm volatile("s_waitcnt lgkmcnt(" #n ")" ::: "memory")
#define PG8_BAR __builtin_amdgcn_s_barrier()
#define PG8_SCHED __builtin_amdgcn_sched_barrier(0)
    Unit cur, nxt; int ui = 0;
    if (!S.next(0, cur)) return;
    f32x4 acc[2][2][4][2];
#pragma unroll
    for (int a = 0; a < 2; ++a)
#pragma unroll
        for (int b = 0; b < 2; ++b)
#pragma unroll
            for (int m = 0; m < 4; ++m)
#pragma unroll
                for (int n = 0; n < 2; ++n) acc[a][b][m][n] = (f32x4){0.f, 0.f, 0.f, 0.f};
    bf16x8 At[4][2], B0[2][2], B1[2][2];
    unsigned voA[2][2], voN[2][2];
    S.a_off(cur, sR, sC, voA);
    const char* cA = S.a_base(cur); const char* cB = S.b_base(cur);
    PG8_STAGE_B(PG8_SB(0, 0), cB); PG8_STAGE_B(PG8_SB(0, 1), cB + hstep); PG8_STAGE_A(PG8_SA(0, 0), cA, voA[0][0], voA[0][1]); PG8_STAGE_A(PG8_SA(0, 1), cA, voA[1][0], voA[1][1]);
    if (wr == 1) PG8_BAR;
    PG8_WAIT_V(2); PG8_BAR;
    PG8_STAGE_B(PG8_SB(1, 0), cB + kstep); PG8_STAGE_A(PG8_SA(1, 0), cA + kstep, voA[0][0], voA[0][1]); PG8_STAGE_B(PG8_SB(1, 1), cB + hstep + kstep);
    PG8_WAIT_V(6); PG8_BAR;
    for (;;) {
        const bool has_next = S.next(ui + 1, nxt);
        const char* nA = cA; const char* nB = cB;
#pragma unroll
        for (int h = 0; h < 2; ++h)
#pragma unroll
            for (int i = 0; i < 2; ++i) voN[h][i] = voA[h][i];
        if (has_next) { nA = S.a_base(nxt); nB = S.b_base(nxt); S.a_off(nxt, sR, sC, voN); }
        for (int t = 0; t < nt; t += 2) {
            const bool last = (t == nt - 2);
            const char* a1 = cA + (size_t)(t + 1) * kstep;
            const char* a2 = last ? nA : cA + (size_t)(t + 2) * kstep; const char* b2 = last ? nB : cB + (size_t)(t + 2) * kstep;
            const char* a3 = a2 + kstep; const char* b3 = b2 + kstep;
            const unsigned s00 = last ? voN[0][0] : voA[0][0], s01 = last ? voN[0][1] : voA[0][1], s10 = last ? voN[1][0] : voA[1][0], s11 = last ? voN[1][1] : voA[1][1];
            PG8_LDB(B0, 0, 0); PG8_LDB(B1, 0, 1); PG8_SCHED; PG8_LDA(At, 0, 0); PG8_STAGE_A(PG8_SA(1, 1), a1, voA[1][0], voA[1][1]);
            PG8_WAIT_V(8); PG8_WAIT_L(0); PG8_BAR; PG8_MMA(0, 0, At, B0); PG8_MMA(0, 1, At, B1); PG8_BAR; PG8_SCHED;
            PG8_LDA(At, 0, 1); PG8_STAGE_B(PG8_SB(0, 0), b2); PG8_STAGE_B(PG8_SB(0, 1), b2 + hstep); PG8_STAGE_A(PG8_SA(0, 0), a2, s00, s01);
            PG8_WAIT_V(8); PG8_WAIT_L(0); PG8_BAR; PG8_MMA(1, 0, At, B0); PG8_MMA(1, 1, At, B1); PG8_BAR; PG8_SCHED;
            PG8_LDB(B0, 1, 0); PG8_LDB(B1, 1, 1); PG8_SCHED; PG8_LDA(At, 1, 0); PG8_STAGE_A(PG8_SA(0, 1), a2, s10, s11);
            PG8_WAIT_V(8); PG8_WAIT_L(0); PG8_BAR; PG8_MMA(0, 0, At, B0); PG8_MMA(0, 1, At, B1); PG8_BAR; PG8_SCHED;
            PG8_LDA(At, 1, 1); PG8_STAGE_B(PG8_SB(1, 0), b3); PG8_STAGE_B(PG8_SB(1, 1), b3 + hstep); PG8_STAGE_A(PG8_SA(1, 0), a3, s00, s01);
            PG8_WAIT_V(8); PG8_WAIT_L(0); PG8_BAR; PG8_MMA(1, 0, At, B0); PG8_MMA(1, 1, At, B1); PG8_BAR; PG8_SCHED;
        }
        if constexpr (ALIGN_EPI) { if (wr == 0) PG8_BAR; }
        E(acc, cur, wr, wc, fr, fq);
        if (!has_next) break;
#pragma unroll
        for (int a = 0; a < 2; ++a)
#pragma unroll
            for (int b = 0; b < 2; ++b)
#pragma unroll
                for (int m = 0; m < 4; ++m)
#pragma unroll
                    for (int n = 0; n < 2; ++n) acc[a][b][m][n] = (f32x4){0.f, 0.f, 0.f, 0.f};
        cur = nxt; cA = nA; cB = nB; ++ui;
#pragma unroll
        for (int h = 0; h < 2; ++h)
#pragma unroll
            for (int i = 0; i < 2; ++i) voA[h][i] = voN[h][i];
        if constexpr (ALIGN_EPI) { if (wr == 1) PG8_BAR; }
    }
    PG8_WAIT_V(0);
    if constexpr (!ALIGN_EPI) { if (wr == 0) PG8_BAR; }
    PG8_BAR;
#undef PG8_SA
#undef PG8_SB
#undef PG8_STAGE_A
#undef PG8_STAGE_B
#undef PG8_LDA
#undef PG8_LDB
#undef PG8_MMA
#undef PG8_WAIT_V
#undef PG8_WAIT_L
#undef PG8_BAR
#undef PG8_SCHED
}
}

#define XB_TMO      128
#define XB_XCNT(j)  (256  + 64 * (j))
#define XB_XSUB(j)  (1280 + 64 * (j))
#define XB_XGEN(j)  (2304 + 64 * (j))
#define XB_TOP      3328
#define XB_TOPGEN   3392
#define XCD_BAR_WORDS 3456
#define XB_SPIN_CAP (1u << 18)

__device__ __forceinline__ unsigned xb_ld(unsigned* p)              { return __hip_atomic_load(p, __ATOMIC_RELAXED, __HIP_MEMORY_SCOPE_AGENT); }
__device__ __forceinline__ unsigned xb_add(unsigned* p, unsigned v) { return __hip_atomic_fetch_add(p, v, __ATOMIC_RELAXED, __HIP_MEMORY_SCOPE_AGENT); }
__device__ __forceinline__ unsigned xb_xcc_id() { return (unsigned)__builtin_amdgcn_s_getreg((3 << 11) | 20) & 0xFu; }
#define XB_SPIN(cond, bar) do { unsigned _sp = 0; while (cond) { __builtin_amdgcn_s_sleep(1); \
    if ((++_sp & 255u) == 0u) { if (xb_ld(&(bar)[XB_TMO])) break; if (_sp > XB_SPIN_CAP) { atomicAdd(&(bar)[XB_TMO], 1u); break; } } } } while (0)

struct XcdBarrier {
    unsigned* bar; unsigned x;
    volatile LAS unsigned* st;
};
__device__ __forceinline__ XcdBarrier xcd_barrier_post(unsigned* bar, volatile LAS unsigned* st) {
    XcdBarrier b; b.bar = bar; b.x = xb_xcc_id(); b.st = st;
    if (threadIdx.x == 0) (void)xb_add(&bar[XB_XCNT(b.x)], 1u);
    return b;
}
__device__ __forceinline__ void xcd_barrier_complete(unsigned* bar, unsigned x, unsigned& nloc, unsigned& nx) {
    const unsigned G = gridDim.x * gridDim.y * gridDim.z;
    unsigned sum, cnt, mine, sp = 0u;
    for (;;) {
        sum = 0u; cnt = 0u; mine = 0u;
#pragma unroll
        for (unsigned j = 0; j < 16; ++j) { const unsigned c = xb_ld(&bar[XB_XCNT(j)]); sum += c; cnt += (c > 0u) ? 1u : 0u; mine = (j == x) ? c : mine; }
        if (sum == G) break;
        __builtin_amdgcn_s_sleep(1);
        if ((++sp & 255u) == 0u) { if (xb_ld(&bar[XB_TMO])) break; if (sp > XB_SPIN_CAP) { atomicAdd(&bar[XB_TMO], 1u); break; } }
    }
    nloc = mine > 0u ? mine : 1u; nx = cnt > 0u ? cnt : 1u;
}
__device__ __forceinline__ void xcd_barrier(const XcdBarrier& b) {
    asm volatile("s_waitcnt vmcnt(0)" ::: "memory");
    __syncthreads();
    if (threadIdx.x == 0) {
        unsigned* bar = b.bar;
        __builtin_amdgcn_s_waitcnt(0);
        unsigned nloc = b.st[0], nx = b.st[1];
        if (nloc == 0u) { xcd_barrier_complete(bar, b.x, nloc, nx); b.st[0] = nloc; b.st[1] = nx; }
        const unsigned old = xb_add(&bar[XB_XSUB(b.x)], 1u);
        const unsigned gen = old / nloc;
        if (old + 1u == (gen + 1u) * nloc) {
            __builtin_amdgcn_fence(__ATOMIC_RELEASE, "agent");
            asm volatile("s_waitcnt vmcnt(0)" ::: "memory");
            const unsigned og = xb_add(&bar[XB_TOP], 1u);
            const unsigned tg = og / nx;
            if (og + 1u == (tg + 1u) * nx) xb_add(&bar[XB_TOPGEN], 1u);
            else XB_SPIN(xb_ld(&bar[XB_TOPGEN]) == tg, bar);
            __builtin_amdgcn_fence(__ATOMIC_ACQUIRE, "agent");
            xb_add(&bar[XB_XGEN(b.x)], 1u);
            asm volatile("s_waitcnt vmcnt(0)" ::: "memory");
        } else {
            XB_SPIN(xb_ld(&bar[XB_XGEN(b.x)]) == gen, bar);
            __builtin_amdgcn_fence(__ATOMIC_ACQUIRE, "agent");
            asm volatile("s_waitcnt vmcnt(0)" ::: "memory");
        }
    }
    __syncthreads();
}

#define EPI_WALK(...) \
    _Pragma("unroll") for (int ai = 0; ai < 2; ++ai) _Pragma("unroll") for (int m = 0; m < 4; ++m) { \
        const int row = u.pm * 256 + ai * 128 + wr * 64 + m * 16 + fr; \
        _Pragma("unroll") for (int bj = 0; bj < 2; ++bj) { const int cw = bj * 128 + wc * 32 + 8 * fq; \
            float v[8] = {acc[ai][bj][m][0][0], acc[ai][bj][m][0][1], acc[ai][bj][m][0][2], acc[ai][bj][m][0][3], acc[ai][bj][m][1][0], acc[ai][bj][m][1][1], acc[ai][bj][m][1][2], acc[ai][bj][m][1][3]}; \
            __VA_ARGS__ } asm volatile("" ::: "memory"); }

__device__ __forceinline__ void rope8(float (&v)[8], const f32x2* rope_row, int i0) {
#pragma unroll
    for (int j = 0; j < 4; ++j) { const f32x2 cs = rope_row[i0 + j]; const float x1 = v[2 * j], x2 = v[2 * j + 1]; v[2 * j] = x1 * cs.x - x2 * cs.y; v[2 * j + 1] = x2 * cs.x + x1 * cs.y; }
}

struct EpiInProj {
    static constexpr bool PERM = true;
    unsigned char* ws;
    __device__ __forceinline__ void operator()(const f32x4 (&acc)[2][2][4][2], const pg8::Unit& u, int wr, int wc, int fr, int fq) const {
        const int pn = u.pn;
        if (pn < 6) {
            bf16_t* base = (bf16_t*)(ws + (pn < 2 ? WS_QA : pn < 4 ? WS_KA : WS_VA)) + (pn & 1) * 256;
            EPI_WALK({ *(u32x4*)(base + (size_t)row * 512 + cw) = pack8(v); })
        } else if (pn == 6) {
            bf16_t* base = (bf16_t*)(ws + WS_CQ);
            EPI_WALK({ *(u32x4*)(base + (size_t)row * 256 + cw) = pack8(v); })
        } else if (pn == 7) {
            bf16_t* ckv = (bf16_t*)(ws + WS_CKV); bf16_t* kr = (bf16_t*)(ws + WS_KR); const f32x2* rope = (const f32x2*)(ws + WS_ROPE);
            EPI_WALK({ if (cw < 128) { *(u32x4*)(ckv + (size_t)row * 128 + cw) = pack8(v); }
                       else if (cw < 160) { rope8(v, rope + (size_t)(row & (SEQ - 1)) * 16, (cw - 128) >> 1); *(u32x4*)(kr + (size_t)row * 32 + (cw - 128)) = pack8(v); } })
        } else {
            bf16_t* base = (bf16_t*)(ws + (pn < 12 ? WS_GA : WS_GB)) + ((pn - 8) & 3) * 256;
            EPI_WALK({ _Pragma("unroll") for (int j = 0; j < 8; ++j) v[j] = sigmoidf_(v[j]); *(u32x4*)(base + (size_t)row * 1024 + cw) = pack8(v); })
        }
    }
};
struct EpiQ {
    static constexpr bool PERM = true;
    unsigned char* ws;
    __device__ __forceinline__ void operator()(const f32x4 (&acc)[2][2][4][2], const pg8::Unit& u, int wr, int wc, int fr, int fq) const {
        bf16_t* qb = (bf16_t*)(ws + WS_QB); const float* rs = (const float*)(ws + WS_RSTDQ); const f32x2* rope = (const f32x2*)(ws + WS_ROPE);
        EPI_WALK({ const int col = u.pn * 256 + cw; const int w = col % 96; const float r = rs[row];
                   _Pragma("unroll") for (int j = 0; j < 8; ++j) v[j] *= r;
                   if (w >= 64) rope8(v, rope + (size_t)(row & (SEQ - 1)) * 16, (w - 64) >> 1);
                   *(u32x4*)(qb + (size_t)row * 768 + col) = pack8(v); })
    }
};
struct EpiKV {
    static constexpr bool PERM = true;
    unsigned char* ws;
    __device__ __forceinline__ void operator()(const f32x4 (&acc)[2][2][4][2], const pg8::Unit& u, int wr, int wc, int fr, int fq) const {
        bf16_t* base = (bf16_t*)(ws + (u.pn < 2 ? WS_KB : WS_VB)) + (u.pn & 1) * 256; const float* rs = (const float*)(ws + WS_RSTDKV);
        EPI_WALK({ const float r = rs[row];
                   _Pragma("unroll") for (int j = 0; j < 8; ++j) v[j] *= r;
                   *(u32x4*)(base + (size_t)row * 512 + cw) = pack8(v); })
    }
};
template <bool SECOND> struct EpiGate {
    static constexpr bool PERM = true;
    unsigned char* ws;
    __device__ __forceinline__ void operator()(const f32x4 (&acc)[2][2][4][2], const pg8::Unit& u, int wr, int wc, int fr, int fq) const {
        bf16_t* mg = (bf16_t*)(ws + WS_MERGED); const bf16_t* gt = (const bf16_t*)(ws + (SECOND ? WS_GB : WS_GA));
        EPI_WALK({ const size_t o = (size_t)row * 1024 + u.pn * 256 + cw; float g[8]; unpack8(*(const u32x4*)(gt + o), g);
                   if (SECOND) { float p[8]; unpack8(*(const u32x4*)(mg + o), p); _Pragma("unroll") for (int j = 0; j < 8; ++j) v[j] = p[j] + g[j] * v[j]; }
                   else { _Pragma("unroll") for (int j = 0; j < 8; ++j) v[j] = g[j] * v[j]; }
                   *(u32x4*)(mg + o) = pack8(v); })
    }
};
struct EpiResid {
    static constexpr bool PERM = true;
    unsigned char* ws; const float* x; float* x1;
    __device__ __forceinline__ void operator()(const f32x4 (&acc)[2][2][4][2], const pg8::Unit& u, int wr, int wc, int fr, int fq) const {
        bf16_t* h2 = (bf16_t*)(ws + WS_H2);
        EPI_WALK({ const size_t o = (size_t)row * 1024 + u.pn * 256 + cw; const f32x4 a = *(const f32x4*)(x + o), b = *(const f32x4*)(x + o + 4);
                   v[0] += a[0]; v[1] += a[1]; v[2] += a[2]; v[3] += a[3]; v[4] += b[0]; v[5] += b[1]; v[6] += b[2]; v[7] += b[3];
                   *(f32x4*)(x1 + o) = (f32x4){v[0], v[1], v[2], v[3]}; *(f32x4*)(x1 + o + 4) = (f32x4){v[4], v[5], v[6], v[7]};
                   *(u32x4*)(h2 + o) = pack8(v); })
    }
};
struct EpiSwiglu {
    static constexpr bool PERM = true;
    unsigned char* ws; const float* bgu;
    __device__ __forceinline__ void operator()(const f32x4 (&acc)[2][2][4][2], const pg8::Unit& u, int wr, int wc, int fr, int fq) const {
        bf16_t* act = (bf16_t*)(ws + WS_ACT); const float* rsc = (const float*)(ws + WS_ROWSCALE);
        const int c0 = u.pn * 128 + wc * 32 + 8 * fq; const float* bg = bgu + (size_t)u.e * 2048 + c0;
        float bgv[8], buv[8];
#pragma unroll
        for (int j = 0; j < 8; ++j) { bgv[j] = bg[j]; buv[j] = bg[1024 + j]; }
#pragma unroll
        for (int ai = 0; ai < 2; ++ai)
#pragma unroll
            for (int m = 0; m < 4; ++m) {
                const int row = u.pm * 256 + ai * 128 + wr * 64 + m * 16 + fr; const float r = rsc[row]; float o[8];
#pragma unroll
                for (int j = 0; j < 8; ++j) { const float g0 = acc[ai][0][m][j >> 2][j & 3] * r + bgv[j], u0 = acc[ai][1][m][j >> 2][j & 3] * r + buv[j];
                    const float g = fminf(g0, 7.f), up = fminf(fmaxf(u0, -7.f), 7.f); o[j] = (up + 1.f) * (g * sigmoidf_(1.702f * g)); }
                *(u32x4*)(act + (size_t)row * 1024 + c0) = pack8(o);
            }
    }
};
struct EpiDown {
    static constexpr bool PERM = true;
    unsigned char* ws; const float* bd;
    __device__ __forceinline__ void operator()(const f32x4 (&acc)[2][2][4][2], const pg8::Unit& u, int wr, int wc, int fr, int fq) const {
        bf16_t* y = (bf16_t*)(ws + WS_Y); const float* b = bd + (size_t)u.e * 1024 + u.pn * 256;
        EPI_WALK({ _Pragma("unroll") for (int j = 0; j < 8; ++j) v[j] += b[cw + j];
                   *(u32x4*)(y + (size_t)row * 1024 + u.pn * 256 + cw) = pack8(v); })
    }
};

typedef short v4i16_t __attribute__((ext_vector_type(4)));
__device__ __forceinline__ s16x4 vtr(const LAS char* p) { return __builtin_bit_cast(s16x4, __builtin_amdgcn_ds_read_tr16_b64_v4i16((LAS v4i16_t*)p)); }
__device__ __forceinline__ float swapmax(float m) { auto rr = __builtin_amdgcn_permlane32_swap(__float_as_uint(m), __float_as_uint(m), false, false); return fmaxf(__uint_as_float(rr[0]), __uint_as_float(rr[1])); }
__device__ __forceinline__ float swapsum(float m) { auto rr = __builtin_amdgcn_permlane32_swap(__float_as_uint(m), __float_as_uint(m), false, false); return __uint_as_float(rr[0]) + __uint_as_float(rr[1]); }

struct AttnState { f32x16 o0, o1; float m, l; };

struct MlaKL {
    const bf16_t* Kn; const bf16_t* Kr; const bf16_t* V;
    template <int D0> __device__ __forceinline__ bf16x8 kfrag(int c, int r32, int hi) const {
        const size_t s = (size_t)(32 * c + r32);
        if (D0 < 4) return *(const bf16x8*)(Kn + s * 512 + 16 * D0 + 8 * hi);
        return *(const bf16x8*)(Kr + s * 32 + 16 * (D0 - 4) + 8 * hi);
    }
    __device__ __forceinline__ u32x4 vpiece(int c, int row, int c8) const { return *(const u32x4*)(V + (size_t)(32 * c + row) * 512 + 8 * c8); }
    __device__ __forceinline__ void modify(int, f32x16&, int, int) const {}
};
struct DilKL {
    const bf16_t* K; const bf16_t* V;
    int dil, res, u0, L; float slope2d;
    __device__ __forceinline__ size_t tok(int c, int kk) const { int v = u0 - 64 + 32 * c + kk; v = v < 0 ? 0 : (v >= L ? L - 1 : v); return (size_t)(res + dil * v); }
    template <int D0> __device__ __forceinline__ bf16x8 kfrag(int c, int r32, int hi) const { return *(const bf16x8*)(K + tok(c, r32) * 512 + 16 * D0 + 8 * hi); }
    __device__ __forceinline__ u32x4 vpiece(int c, int row, int c8) const { return *(const u32x4*)(V + tok(c, row) * 512 + 8 * c8); }
    __device__ __forceinline__ void modify(int c, f32x16& s, int r32, int hi) const {
#pragma unroll
        for (int r = 0; r < 16; ++r) { const int kk = crow(r, hi), rel = 32 * c - 64 + kk - r32, v = u0 - 64 + 32 * c + kk;
            const bool valid = (rel >= -64) && (rel <= 64) && (v >= 0) && (v < L);
            s[r] = valid ? s[r] - slope2d * fabsf((float)rel) : -1e30f; }
    }
};

template <int NDK, class KL> __device__ __forceinline__ void attn_load_k(bf16x8 (&kf)[NDK], const KL& kl, int c, int r32, int hi) {
    kf[0] = kl.template kfrag<0>(c, r32, hi); kf[1] = kl.template kfrag<1>(c, r32, hi); kf[2] = kl.template kfrag<2>(c, r32, hi); kf[3] = kl.template kfrag<3>(c, r32, hi);
    if constexpr (NDK == 6) { kf[4] = kl.template kfrag<4>(c, r32, hi); kf[5] = kl.template kfrag<5>(c, r32, hi); }
}
template <class KL> __device__ __forceinline__ void attn_load_v(u32x4 (&vp)[4], const KL& kl, int c, int lane) {
#pragma unroll
    for (int i = 0; i < 4; ++i) { const int p = lane + 64 * i; vp[i] = kl.vpiece(c, p >> 3, p & 7); }
}
__device__ __forceinline__ void attn_store_v(const u32x4 (&vp)[4], LAS char* vimg, int lane) {
#pragma unroll
    for (int i = 0; i < 4; ++i) { const int p = lane + 64 * i, row = p >> 3, c8 = p & 7; *(LAS u32x4*)(vimg + (c8 >> 2) * 2048 + row * 64 + (c8 & 3) * 16) = vp[i]; }
}
template <int NDK, class KL> __device__ __forceinline__ void attn_core(AttnState& st, const bf16x8 (&qf)[NDK], const bf16x8 (&kf)[NDK], const KL& kl, int c, LAS char* vimg, LAS float* wsf, int lane, int r32, int hi) {
    f32x16 s = {};
#pragma unroll
    for (int d0 = 0; d0 < NDK; ++d0) s = __builtin_amdgcn_mfma_f32_32x32x16_bf16(kf[d0], qf[d0], s, 0, 0, 0);
    kl.modify(c, s, r32, hi);
    float mx = s[0];
#pragma unroll
    for (int r = 1; r < 16; ++r) mx = fmaxf(mx, s[r]);
    mx = swapmax(mx);
    const float mn = fmaxf(st.m, mx), alpha = fexp2(st.m - mn);
    float ps = 0.f;
#pragma unroll
    for (int r = 0; r < 16; ++r) { s[r] = fexp2(s[r] - mn); ps += s[r]; }
    st.l = st.l * alpha + ps; st.m = mn;
    if (hi == 0) wsf[r32] = alpha;
#pragma unroll
    for (int r = 0; r < 16; ++r) { const float a = wsf[crow(r, hi)]; st.o0[r] *= a; st.o1[r] *= a; }
    const u32x4 pw0 = {cvtpk(s[0], s[1]), cvtpk(s[2], s[3]), cvtpk(s[4], s[5]), cvtpk(s[6], s[7])};
    const u32x4 pw1 = {cvtpk(s[8], s[9]), cvtpk(s[10], s[11]), cvtpk(s[12], s[13]), cvtpk(s[14], s[15])};
    const bf16x8 pa0 = __builtin_bit_cast(bf16x8, pw0), pa1 = __builtin_bit_cast(bf16x8, pw1);
    const LAS char* vp = vimg + ((lane >> 4) & 1) * 32 + (lane & 3) * 8 + (4 * hi + ((lane & 15) >> 2)) * 64;
#pragma unroll
    for (int ks = 0; ks < 2; ++ks) {
        const s16x4 l0 = vtr(vp + ks * 1024), h0 = vtr(vp + ks * 1024 + 512), l1 = vtr(vp + 2048 + ks * 1024), h1 = vtr(vp + 2048 + ks * 1024 + 512);
        const bf16x8 v0 = {l0[0], l0[1], l0[2], l0[3], h0[0], h0[1], h0[2], h0[3]}, v1 = {l1[0], l1[1], l1[2], l1[3], h1[0], h1[1], h1[2], h1[3]};
        st.o0 = __builtin_amdgcn_mfma_f32_32x32x16_bf16(ks == 0 ? pa0 : pa1, v0, st.o0, 0, 0, 0);
        st.o1 = __builtin_amdgcn_mfma_f32_32x32x16_bf16(ks == 0 ? pa0 : pa1, v1, st.o1, 0, 0, 0);
    }
}
template <int NDK, class KL> __device__ __forceinline__ void wave_attn(AttnState& st, const bf16x8 (&qf)[NDK], const KL& kl, int nchunk, LAS char* vimg, LAS float* wsf, int lane) {
    const int r32 = lane & 31, hi = lane >> 5;
    st.o0 = f32x16{}; st.o1 = f32x16{}; st.m = -1e30f; st.l = 0.f;
    bf16x8 kfa[NDK], kfb[NDK]; u32x4 vp[4];
    attn_load_k<NDK>(kfa, kl, 0, r32, hi); attn_load_v(vp, kl, 0, lane);
    for (int c = 0; c < nchunk; c += 2) {
        attn_store_v(vp, vimg, lane);
        if (c + 1 < nchunk) { attn_load_k<NDK>(kfb, kl, c + 1, r32, hi); attn_load_v(vp, kl, c + 1, lane); }
        attn_core<NDK>(st, qf, kfa, kl, c, vimg, wsf, lane, r32, hi);
        if (c + 1 < nchunk) {
            attn_store_v(vp, vimg, lane);
            if (c + 2 < nchunk) { attn_load_k<NDK>(kfa, kl, c + 2, r32, hi); attn_load_v(vp, kl, c + 2, lane); }
            attn_core<NDK>(st, qf, kfb, kl, c + 1, vimg, wsf, lane, r32, hi);
        }
    }
}
__device__ __forceinline__ float attn_finish(AttnState& st, LAS char* vimg, LAS float* wsf, int lane) {
    const int r32 = lane & 31, hi = lane >> 5;
    const float lt = swapsum(st.l);
    if (hi == 0) wsf[32 + r32] = lt;
    LAS bf16_t* stg = (LAS bf16_t*)vimg;
#pragma unroll
    for (int r = 0; r < 16; ++r) { const int q = crow(r, hi); const float il = frcp(wsf[32 + q]);
        stg[q * 64 + r32] = (bf16_t)f2bf(st.o0[r] * il); stg[q * 64 + 32 + r32] = (bf16_t)f2bf(st.o1[r] * il); }
    return lt;
}

template <class CM> __device__ __forceinline__ void tr_item(const float* W, int ld, const float* rs, bf16_t* WT, int K, int k0, int n0, const CM& cm, LAS float* scr, int lane) {
    const int n = lane & 31, sc = cm.col(n0 + n); const float cs = cm.scale(n0 + n);
#pragma unroll 8
    for (int i = 0; i < 32; ++i) { const int kk = 2 * i + (lane >> 5); float v = 0.f; if (sc >= 0) v = W[(size_t)(k0 + kk) * ld + sc] * cs * (rs ? rs[k0 + kk] : 1.f); scr[kk * 33 + n] = v; }
    asm volatile("s_waitcnt lgkmcnt(0)" ::: "memory");
    const int c = lane & 7;
#pragma unroll
    for (int j = 0; j < 4; ++j) { const int nn = (lane >> 3) + 8 * j; const LAS float* s = scr + (8 * c) * 33 + nn;
        u32x4 o; o.x = pk2(s[0 * 33], s[1 * 33]); o.y = pk2(s[2 * 33], s[3 * 33]); o.z = pk2(s[4 * 33], s[5 * 33]); o.w = pk2(s[6 * 33], s[7 * 33]);
        *(u32x4*)(WT + (size_t)(n0 + nn) * K + k0 + 8 * c) = o; }
    asm volatile("s_waitcnt lgkmcnt(0)" ::: "memory");
}
struct CmIn {
    __device__ __forceinline__ int col(int n) const {
        if (n < 1920) return n;
        if (n < 1952) { const int j = n - 1920, i = j >> 1; return 1920 + ((j & 1) ? i + 16 : i); }
        if (n < 2048) return -1;
        if (n < 3072) return 1952 + (n - 2048);
        return 2976 + (n - 3072);
    }
    __device__ __forceinline__ float scale(int n) const { return n < 512 ? 0.125f * LOG2E : 1.f; }
};
struct CmUq {
    __device__ __forceinline__ int col(int n) const { const int h = n / 96, w = n % 96; if (w < 64) return n; const int j = w - 64, i = j >> 1; return h * 96 + 64 + ((j & 1) ? i + 16 : i); }
    __device__ __forceinline__ float scale(int) const { return 0.10206207261596577f * LOG2E; }
};
struct CmId { int off; __device__ __forceinline__ int col(int n) const { return n - off; } __device__ __forceinline__ float scale(int) const { return 1.f; } };
struct CmGu {
    __device__ __forceinline__ int col(int n) const { const int pn = n >> 8, w = n & 255; return w < 128 ? 128 * pn + w : 1024 + 128 * pn + (w - 128); }
    __device__ __forceinline__ float scale(int) const { return 1.f; }
};

struct Args { const float* in[19]; float* out; unsigned char* ws; int ph_lo, ph_hi, li, pad; };

__device__ __forceinline__ void p0_prologue(const Args& a, LAS unsigned char* lds, int wave, int lane) {
    LAS float* scr = (LAS float*)(lds + wave * 16384);
    const int gw = blockIdx.x * NWAVES + wave, NGW = gridDim.x * NWAVES;
    unsigned char* ws = a.ws;
    constexpr int I_IN = 16 * 128, I_UQ = 4 * 24, I_UK = 2 * 16, I_UV = 2 * 16, I_A = 8 * 32, I_B = 8 * 32, I_O = 16 * 32, I_GU = 32 * 16 * 64, I_D = 32 * 16 * 32;
    constexpr int NITEMS = I_IN + I_UQ + I_UK + I_UV + I_A + I_B + I_O + I_GU + I_D;
    for (int it = gw; it < NITEMS; it += NGW) {
        int r = it;
        if (r < I_IN) { tr_item(a.in[2], 4000, a.in[1], (bf16_t*)(ws + WS_WIN), 1024, 64 * (r / 128), 32 * (r % 128), CmIn{}, scr, lane); continue; } r -= I_IN;
        if (r < I_UQ) { tr_item(a.in[5], 768, a.in[3], (bf16_t*)(ws + WS_WUQ), 256, 64 * (r / 24), 32 * (r % 24), CmUq{}, scr, lane); continue; } r -= I_UQ;
        if (r < I_UK) { tr_item(a.in[6], 512, a.in[4], (bf16_t*)(ws + WS_WUKV), 128, 64 * (r / 16), 32 * (r % 16), CmId{0}, scr, lane); continue; } r -= I_UK;
        if (r < I_UV) { tr_item(a.in[7], 512, a.in[4], (bf16_t*)(ws + WS_WUKV), 128, 64 * (r / 16), 512 + 32 * (r % 16), CmId{512}, scr, lane); continue; } r -= I_UV;
        if (r < I_A) { tr_item(a.in[8], 1024, nullptr, (bf16_t*)(ws + WS_WA), 512, 64 * (r / 32), 32 * (r % 32), CmId{0}, scr, lane); continue; } r -= I_A;
        if (r < I_B) { tr_item(a.in[9], 1024, nullptr, (bf16_t*)(ws + WS_WB), 512, 64 * (r / 32), 32 * (r % 32), CmId{0}, scr, lane); continue; } r -= I_B;
        if (r < I_O) { tr_item(a.in[10], 1024, nullptr, (bf16_t*)(ws + WS_WO), 1024, 64 * (r / 32), 32 * (r % 32), CmId{0}, scr, lane); continue; } r -= I_O;
        if (r < I_GU) { const int e = r / 1024, q = r % 1024; tr_item(a.in[14] + (size_t)e * 1024 * 2048, 2048, a.in[11], (bf16_t*)(ws + WS_WGU) + (size_t)e * 2048 * 1024, 1024, 64 * (q / 64), 32 * (q % 64), CmGu{}, scr, lane); continue; } r -= I_GU;
        { const int e = r / 512, q = r % 512; tr_item(a.in[16] + (size_t)e * 1024 * 1024, 1024, nullptr, (bf16_t*)(ws + WS_WD) + (size_t)e * 1024 * 1024, 1024, 64 * (q / 32), 32 * (q % 32), CmId{0}, scr, lane); }
    }
    for (int m = gw; m < T; m += NGW) {
        const f32x4* xr = (const f32x4*)(a.in[0] + (size_t)m * DM) + lane;
        f32x4 v[4]; float s2 = 0.f;
#pragma unroll
        for (int j = 0; j < 4; ++j) { v[j] = xr[64 * j]; s2 += (v[j].x * v[j].x + v[j].y * v[j].y) + (v[j].z * v[j].z + v[j].w * v[j].w); }
        const float rstd = 1.f / sqrtf(wave_sum(s2) * (1.f / DM) + EPS);
        u32x2* o8 = (u32x2*)((bf16_t*)(ws + WS_XB) + (size_t)m * DM) + lane;
#pragma unroll
        for (int j = 0; j < 4; ++j) o8[64 * j] = (u32x2){pk2(v[j].x * rstd, v[j].y * rstd), pk2(v[j].z * rstd, v[j].w * rstd)};
    }
    const int gt = blockIdx.x * NTHREADS + threadIdx.x, NGT = gridDim.x * NTHREADS;
    for (int idx = gt; idx < SEQ * 16; idx += NGT) {
        const int s = idx >> 4, i = idx & 15;
        const float inv = __builtin_powf(10000.f, -(float)i * (1.f / 16.f));
        const float ang = (float)s * inv;
        double x = (double)ang; const double n = __builtin_rint(x * 0.15915494309189535); x = (x - n * 6.283185307179586) - n * 2.4492935982947064e-16;
        const double x2 = x * x; double sn = 1.0, cs = 1.0;
#pragma unroll
        for (int k = 13; k >= 1; --k) { sn = 1.0 - sn * x2 * (1.0 / (double)((2 * k) * (2 * k + 1))); cs = 1.0 - cs * x2 * (1.0 / (double)((2 * k - 1) * (2 * k))); }
        sn *= x;
        ((f32x2*)(ws + WS_ROPE))[idx] = (f32x2){(float)cs, (float)sn};
    }
    for (int idx = gt; idx < 1024 * 32; idx += NGT) ((float*)(ws + WS_WRP))[idx] = a.in[12][idx] * a.in[11][idx >> 5];
}

__device__ __forceinline__ void p2_stats(const Args& a, int wave, int lane) {
    const int gw = blockIdx.x * NWAVES + wave, NGW = gridDim.x * NWAVES; unsigned char* ws = a.ws;
    for (int m = gw; m < T; m += NGW) {
        const u32x2 q = ((const u32x2*)((const bf16_t*)(ws + WS_CQ) + (size_t)m * 256))[lane];
        const unsigned kv = ((const unsigned*)((const bf16_t*)(ws + WS_CKV) + (size_t)m * 128))[lane];
        const float a0 = bflo(q.x), a1 = bfhi(q.x), a2 = bflo(q.y), a3 = bfhi(q.y), b0 = bflo(kv), b1 = bfhi(kv);
        const float sq = wave_sum((a0 * a0 + a1 * a1) + (a2 * a2 + a3 * a3)), sk = wave_sum(b0 * b0 + b1 * b1);
        if (lane == 0) { ((float*)(ws + WS_RSTDQ))[m] = 1.f / sqrtf(sq * (1.f / 256.f) + EPS); ((float*)(ws + WS_RSTDKV))[m] = 1.f / sqrtf(sk * (1.f / 128.f) + EPS); }
    }
}

__device__ __forceinline__ void p4_attention(const Args& a, LAS unsigned char* lds, int wave, int lane) {
    unsigned char* ws = a.ws;
    LAS char* vimg = (LAS char*)(lds + wave * 8192); LAS float* wsf = (LAS float*)(lds + wave * 8192 + 4096);
    const int r32 = lane & 31, hi = lane >> 5;
    const bf16_t* QA = (const bf16_t*)(ws + WS_QA); const bf16_t* KA = (const bf16_t*)(ws + WS_KA); const bf16_t* VA = (const bf16_t*)(ws + WS_VA);
    bf16_t* PO = (bf16_t*)(ws + WS_PARTO); float* PL = (float*)(ws + WS_PARTL); bf16_t* OA = (bf16_t*)(ws + WS_OA);
    for (int un = blockIdx.x; un < NB * 8 * 32; un += gridDim.x) {
        const int sb = un & 31, h = (un >> 5) & 7, b = un >> 8;
        const size_t bo = (size_t)b * SEQ;
        for (int task = wave; task < 48; task += NWAVES) {
            int p, dil, res, u0, L;
            if (task < 16) { p = 0; dil = 1; res = 0; u0 = 512 * sb + 32 * task; L = SEQ; }
            else if (task < 32) { const int j = task - 16; p = 1; dil = 4; res = j & 3; u0 = 128 * sb + 32 * (j >> 2); L = SEQ / 4; }
            else { p = 2; dil = 16; res = task - 32; u0 = 32 * sb; L = SEQ / 16; }
            DilKL kl; kl.K = KA + bo * 512 + h * 64; kl.V = VA + bo * 512 + h * 64; kl.dil = dil; kl.res = res; kl.u0 = u0; kl.L = L;
            kl.slope2d = __builtin_amdgcn_exp2f(-(float)(h + 1)) * LOG2E * (float)dil;
            const size_t tq = bo + (size_t)(res + dil * (u0 + r32));
            bf16x8 qf[4];
#pragma unroll
            for (int d0 = 0; d0 < 4; ++d0) qf[d0] = *(const bf16x8*)(QA + tq * 512 + h * 64 + 16 * d0 + 8 * hi);
            AttnState st; wave_attn<4>(st, qf, kl, 5, vimg, wsf, lane);
            const float lt = attn_finish(st, vimg, wsf, lane);
            if (hi == 0) PL[(((size_t)p * NB + b) * 8 + h) * SEQ + (res + dil * (u0 + r32))] = st.m + __builtin_amdgcn_logf(lt);
#pragma unroll
            for (int i = 0; i < 4; ++i) { const int row = i * 8 + (lane >> 3), ch = lane & 7; const u32x4 v = *(const LAS u32x4*)(vimg + row * 128 + ch * 16);
                *(u32x4*)(PO + ((size_t)p * T + bo + (size_t)(res + dil * (u0 + row))) * 512 + h * 64 + ch * 8) = v; }
        }
        asm volatile("s_waitcnt vmcnt(0)" ::: "memory");
        __syncthreads();
#pragma unroll 1
        for (int i = 0; i < 8; ++i) {
            const int s = 512 * sb + wave * 64 + i * 8 + (lane >> 3), ch = lane & 7;
            const float l0 = PL[(((size_t)0 * NB + b) * 8 + h) * SEQ + s], l1 = PL[(((size_t)1 * NB + b) * 8 + h) * SEQ + s], l2 = PL[(((size_t)2 * NB + b) * 8 + h) * SEQ + s];
            const float mx = fmaxf(fmaxf(l0, l1), l2); float w0 = fexp2(l0 - mx), w1 = fexp2(l1 - mx), w2 = fexp2(l2 - mx); const float iw = frcp(w0 + w1 + w2); w0 *= iw; w1 *= iw; w2 *= iw;
            float v0[8], v1[8], v2[8], o[8];
            unpack8(*(const u32x4*)(PO + ((size_t)0 * T + bo + s) * 512 + h * 64 + ch * 8), v0);
            unpack8(*(const u32x4*)(PO + ((size_t)1 * T + bo + s) * 512 + h * 64 + ch * 8), v1);
            unpack8(*(const u32x4*)(PO + ((size_t)2 * T + bo + s) * 512 + h * 64 + ch * 8), v2);
#pragma unroll
            for (int j = 0; j < 8; ++j) o[j] = w0 * v0[j] + w1 * v1[j] + w2 * v2[j];
            *(u32x4*)(OA + (bo + s) * 512 + h * 64 + ch * 8) = pack8(o);
        }
        __syncthreads();
    }
    const bf16_t* QB = (const bf16_t*)(ws + WS_QB); const bf16_t* KB = (const bf16_t*)(ws + WS_KB); const bf16_t* VB = (const bf16_t*)(ws + WS_VB); const bf16_t* KR = (const bf16_t*)(ws + WS_KR);
    bf16_t* OB = (bf16_t*)(ws + WS_OB);
    for (int un = blockIdx.x; un < NB * 8 * 64; un += gridDim.x) {
        const int qb = un & 63, h = (un >> 6) & 7, b = un >> 9;
        const size_t bo = (size_t)b * SEQ, tq0 = bo + (size_t)qb * 256 + wave * 32;
        MlaKL kl; kl.Kn = KB + bo * 512 + h * 64; kl.Kr = KR + bo * 32; kl.V = VB + bo * 512 + h * 64;
        bf16x8 qf[6];
#pragma unroll
        for (int d0 = 0; d0 < 6; ++d0) qf[d0] = *(const bf16x8*)(QB + (tq0 + r32) * 768 + h * 96 + 16 * d0 + 8 * hi);
        AttnState st; wave_attn<6>(st, qf, kl, SEQ / 32, vimg, wsf, lane);
        (void)attn_finish(st, vimg, wsf, lane);
#pragma unroll
        for (int i = 0; i < 4; ++i) { const int row = i * 8 + (lane >> 3), ch = lane & 7; const u32x4 v = *(const LAS u32x4*)(vimg + row * 128 + ch * 16);
            *(u32x4*)(OB + (tq0 + row) * 512 + h * 64 + ch * 8) = v; }
    }
}

__device__ __forceinline__ void p8_router(const Args& a, LAS unsigned char* lds, volatile LAS unsigned* MISC, int wave, int lane) {
    unsigned char* ws = a.ws; const float* x1 = a.out; const float* wrp = (const float*)(ws + WS_WRP); const float* br = a.in[13];
    LAS float* lg = (LAS float*)(lds + wave * 8192);
    LAS unsigned* hist = (LAS unsigned*)(MISC + MI_HIST);
    if (threadIdx.x < 32) hist[threadIdx.x] = 0u;
    __syncthreads();
    const int G = gridDim.x, i32 = lane & 31, hi = lane >> 5;
    for (int tb = wave * G + blockIdx.x; tb < T / 32; tb += G * NWAVES) {
        const int t = tb * 32 + i32;
        const float* xr = x1 + (size_t)t * DM + 512 * hi; const float* wr_ = wrp + (size_t)(512 * hi) * 32 + i32;
        f32x16 acc = {}; float ssq = 0.f;
#pragma unroll 4
        for (int s4 = 0; s4 < 128; ++s4) {
            const f32x4 xa = *(const f32x4*)(xr + 4 * s4);
            ssq += (xa.x * xa.x + xa.y * xa.y) + (xa.z * xa.z + xa.w * xa.w);
            acc = __builtin_amdgcn_mfma_f32_32x32x2f32(xa.x, wr_[(4 * s4 + 0) * 32], acc, 0, 0, 0);
            acc = __builtin_amdgcn_mfma_f32_32x32x2f32(xa.y, wr_[(4 * s4 + 1) * 32], acc, 0, 0, 0);
            acc = __builtin_amdgcn_mfma_f32_32x32x2f32(xa.z, wr_[(4 * s4 + 2) * 32], acc, 0, 0, 0);
            acc = __builtin_amdgcn_mfma_f32_32x32x2f32(xa.w, wr_[(4 * s4 + 3) * 32], acc, 0, 0, 0);
        }
        ssq = swapsum(ssq);
        const float rstd = 1.f / sqrtf(ssq * (1.f / DM) + EPS);
#pragma unroll
        for (int r = 0; r < 16; ++r) lg[crow(r, hi) * 33 + i32] = acc[r];
        asm volatile("s_waitcnt lgkmcnt(0)" ::: "memory");
        float v[32];
#pragma unroll
        for (int e = 0; e < 32; ++e) v[e] = lg[i32 * 33 + e] * rstd + br[e];
        int ti[4]; float tv[4];
#pragma unroll
        for (int k = 0; k < 4; ++k) {
            float best = v[0]; int bi = 0;
#pragma unroll
            for (int e = 1; e < 32; ++e) { const bool g = v[e] > best; best = g ? v[e] : best; bi = g ? e : bi; }
            ti[k] = bi; tv[k] = best;
#pragma unroll
            for (int e = 0; e < 32; ++e) v[e] = (e == bi) ? -3.0e38f : v[e];
        }
        const float e1 = __expf(tv[1] - tv[0]), e2 = __expf(tv[2] - tv[0]), e3 = __expf(tv[3] - tv[0]); const float inv = 1.f / (1.f + e1 + e2 + e3);
        const float gw[4] = {inv, e1 * inv, e2 * inv, e3 * inv};
        if (hi == 0) {
            ((float*)(ws + WS_RSTD2))[t] = rstd;
#pragma unroll
            for (int k = 0; k < 4; ++k) { const unsigned rk = __hip_atomic_fetch_add(&hist[ti[k]], 1u, __ATOMIC_RELAXED, __HIP_MEMORY_SCOPE_WORKGROUP);
                ((int*)(ws + WS_TOPI))[t * 4 + k] = ti[k]; ((float*)(ws + WS_GATEW))[t * 4 + k] = gw[k]; ((int*)(ws + WS_SRANK))[t * 4 + k] = (int)rk; }
        }
        asm volatile("s_waitcnt lgkmcnt(0)" ::: "memory");
    }
    __syncthreads();
    if (threadIdx.x < 32) {
        const unsigned c = hist[threadIdx.x];
        const unsigned base = __hip_atomic_fetch_add((unsigned*)(ws + WS_CTL) + CW_GCOUNT + threadIdx.x, c, __ATOMIC_RELAXED, __HIP_MEMORY_SCOPE_AGENT);
        ((int*)(ws + WS_WGBASE))[blockIdx.x * 32 + threadIdx.x] = (int)base;
    }
}
__device__ __forceinline__ void moe_prefix(const Args& a, volatile LAS unsigned* MISC) {
    if (threadIdx.x == 0) {
        const unsigned* gc = (const unsigned*)(a.ws + WS_CTL) + CW_GCOUNT; int acc = 0;
        for (int e = 0; e < 32; ++e) { MISC[MI_PSTART + e] = (unsigned)acc; MISC[MI_TPRE + e] = (unsigned)(acc >> 8);
            const int c = (int)__hip_atomic_load(gc + e, __ATOMIC_RELAXED, __HIP_MEMORY_SCOPE_AGENT); acc += (c + 255) & ~255; }
        MISC[MI_PSTART + 32] = (unsigned)acc; MISC[MI_TPRE + 32] = (unsigned)(acc >> 8);
    }
    __syncthreads();
}
__device__ __forceinline__ void p9_scatter(const Args& a, volatile LAS unsigned* MISC) {
    unsigned char* ws = a.ws; const int G = gridDim.x;
    moe_prefix(a, MISC);
    const int* topi = (const int*)(ws + WS_TOPI); const int* srank = (const int*)(ws + WS_SRANK); const int* wgbase = (const int*)(ws + WS_WGBASE); const float* rstd2 = (const float*)(ws + WS_RSTD2);
    int* pos = (int*)(ws + WS_POS); int* rowtok = (int*)(ws + WS_ROWTOK); float* rowscale = (float*)(ws + WS_ROWSCALE);
    for (int sl = blockIdx.x * NTHREADS + threadIdx.x; sl < NSLOT; sl += G * NTHREADS) {
        const int t = sl >> 2, e = topi[sl], wg = (t >> 5) % G;
        const int row = (int)MISC[MI_PSTART + e] + wgbase[wg * 32 + e] + srank[sl];
        pos[sl] = row; rowtok[row] = t; rowscale[row] = rstd2[t];
    }
    if (blockIdx.x < 32) {
        const int e = blockIdx.x; const int c = (int)__hip_atomic_load((const unsigned*)(ws + WS_CTL) + CW_GCOUNT + e, __ATOMIC_RELAXED, __HIP_MEMORY_SCOPE_AGENT);
        const int r0 = (int)MISC[MI_PSTART + e] + c, r1 = (int)MISC[MI_PSTART + e + 1];
        for (int r = r0 + threadIdx.x; r < r1; r += NTHREADS) { rowtok[r] = 0; rowscale[r] = 0.f; }
    }
}
__device__ __forceinline__ void p12_final(const Args& a, int wave, int lane) {
    unsigned char* ws = a.ws; const int gw = blockIdx.x * NWAVES + wave, NGW = gridDim.x * NWAVES;
    const int* pos = (const int*)(ws + WS_POS); const float* gatew = (const float*)(ws + WS_GATEW); const bf16_t* Y = (const bf16_t*)(ws + WS_Y);
    f32x4 g[4];
#pragma unroll
    for (int j = 0; j < 4; ++j) g[j] = ((const f32x4*)a.in[18])[lane + 64 * j];
    for (int t = gw; t < T; t += NGW) {
        f32x4* xr = (f32x4*)(a.out + (size_t)t * DM) + lane;
        f32x4 v[4];
#pragma unroll
        for (int j = 0; j < 4; ++j) v[j] = xr[64 * j];
#ifndef DBG_NO_MOE
#pragma unroll
        for (int k = 0; k < 4; ++k) {
            const int row = pos[t * 4 + k]; const float w = gatew[t * 4 + k];
            const u32x2* yr = (const u32x2*)(Y + (size_t)row * DM) + lane;
#pragma unroll
            for (int j = 0; j < 4; ++j) { const u32x2 y = yr[64 * j]; v[j].x += w * bflo(y.x); v[j].y += w * bfhi(y.x); v[j].z += w * bflo(y.y); v[j].w += w * bfhi(y.y); }
        }
#endif
        float s2 = 0.f;
#pragma unroll
        for (int j = 0; j < 4; ++j) s2 += (v[j].x * v[j].x + v[j].y * v[j].y) + (v[j].z * v[j].z + v[j].w * v[j].w);
        const float rstd = 1.f / sqrtf(wave_sum(s2) * (1.f / DM) + EPS);
#pragma unroll
        for (int j = 0; j < 4; ++j) xr[64 * j] = v[j] * rstd * g[j];
    }
}

constexpr int N_PHASES = 13;
#ifndef MK_ONE_LAUNCH
#define MK_ONE_LAUNCH 0
#endif
__global__ void __launch_bounds__(NTHREADS, 2) fwd(Args args) {
    extern __shared__ __attribute__((aligned(16))) unsigned char lds_raw[];
    LAS unsigned char* lds = (LAS unsigned char*)lds_raw;
    volatile LAS unsigned* MISC = (volatile LAS unsigned*)(lds + MISC_OFF);
    const int tid = threadIdx.x, lane = tid & 63, wave = __builtin_amdgcn_readfirstlane(tid >> 6);
    const int G = gridDim.x, bx = blockIdx.x;
    unsigned char* ws = args.ws;
    for (int u = tid; u < (LDS_BYTES - RING_BYTES) / 4; u += NTHREADS) ((LAS unsigned*)(lds + RING_BYTES))[u] = 0u;
    __syncthreads();
    XcdBarrier bar; bar.bar = (unsigned*)(ws + WS_CTL) + CW_BAR; bar.x = 0; bar.st = nullptr;
    if (MK_ONE_LAUNCH) bar = xcd_barrier_post((unsigned*)(ws + WS_CTL) + CW_BAR, MISC + MI_BAR);
    const int lo = args.ph_lo, hi = args.ph_hi;
#ifdef ONLY_PHASE
#define IN(k) ((k) == ONLY_PHASE && lo <= (k) && (k) < hi)
#else
#define IN(k) (lo <= (k) && (k) < hi)
#endif
#define SEAM(k) do { if (IN(k) && IN((k) + 1)) xcd_barrier(bar); } while (0)

    if (IN(0)) { p0_prologue(args, lds, wave, lane); } SEAM(0);
    if (IN(1)) { pg8::DenseSched S; S.init((const bf16_t*)(ws + WS_XB), (const bf16_t*)(ws + WS_WIN), T, NIN, 1024, G, bx); EpiInProj E{ws};
        pg8::gemm_phase2<EpiInProj, pg8::DenseSched, true>(lds, 1024, S, E); } SEAM(1);
    if (IN(2)) { p2_stats(args, wave, lane); } SEAM(2);
    if (IN(3)) {
        { pg8::DenseSched S; S.init((const bf16_t*)(ws + WS_CQ), (const bf16_t*)(ws + WS_WUQ), T, 768, 256, G, bx); EpiQ E{ws};
          pg8::gemm_phase2<EpiQ, pg8::DenseSched, true>(lds, 256, S, E); }
        { pg8::DenseSched S; S.init((const bf16_t*)(ws + WS_CKV), (const bf16_t*)(ws + WS_WUKV), T, 1024, 128, G, bx); EpiKV E{ws};
          pg8::gemm_phase2<EpiKV, pg8::DenseSched, true>(lds, 128, S, E); }
    } SEAM(3);
    if (IN(4)) { p4_attention(args, lds, wave, lane); } SEAM(4);
    if (IN(5)) { pg8::DenseSched S; S.init((const bf16_t*)(ws + WS_OA), (const bf16_t*)(ws + WS_WA), T, 1024, 512, G, bx); EpiGate<false> E{ws};
        pg8::gemm_phase2<EpiGate<false>, pg8::DenseSched, true>(lds, 512, S, E); } SEAM(5);
    if (IN(6)) { pg8::DenseSched S; S.init((const bf16_t*)(ws + WS_OB), (const bf16_t*)(ws + WS_WB), T, 1024, 512, G, bx); EpiGate<true> E{ws};
        pg8::gemm_phase2<EpiGate<true>, pg8::DenseSched, true>(lds, 512, S, E); } SEAM(6);
    if (IN(7)) { pg8::DenseSched S; S.init((const bf16_t*)(ws + WS_MERGED), (const bf16_t*)(ws + WS_WO), T, 1024, 1024, G, bx); EpiResid E{ws, args.in[0], args.out};
        pg8::gemm_phase2<EpiResid, pg8::DenseSched, true>(lds, 1024, S, E); } SEAM(7);
    if (IN(8)) { p8_router(args, lds, MISC, wave, lane); } SEAM(8);
    if (IN(9)) { p9_scatter(args, MISC); } SEAM(9);
    if (IN(10)) {
        moe_prefix(args, MISC);
        pg8::MoeSched<3, true> S; S.tpre = (const LAS int*)(MISC + MI_TPRE); S.ntiles = (int)MISC[MI_TPRE + 32]; S.G = G; S.c = bx; S.K = 1024;
        S.A = (const char*)(ws + WS_H2); S.Bt = (const char*)(ws + WS_WGU); S.estride = (size_t)2048 * 1024 * 2; S.row_tok = (const int*)(ws + WS_ROWTOK);
        EpiSwiglu E{ws, args.in[15]};
        pg8::gemm_phase2<EpiSwiglu, pg8::MoeSched<3, true>, true>(lds, 1024, S, E);
    } SEAM(10);
    if (IN(11)) {
        moe_prefix(args, MISC);
        pg8::MoeSched<2, false> S; S.tpre = (const LAS int*)(MISC + MI_TPRE); S.ntiles = (int)MISC[MI_TPRE + 32]; S.G = G; S.c = bx; S.K = 1024;
        S.A = (const char*)(ws + WS_ACT); S.Bt = (const char*)(ws + WS_WD); S.estride = (size_t)1024 * 1024 * 2; S.row_tok = nullptr;
        EpiDown E{ws, args.in[17]};
        pg8::gemm_phase2<EpiDown, pg8::MoeSched<2, false>, true>(lds, 1024, S, E);
    } SEAM(11);
    if (IN(12)) { p12_final(args, wave, lane); }
#undef IN
#undef SEAM
}

#ifdef DBG_DUMP
__global__ void dbg_dump(float* out, const unsigned char* ws, int level) {
    const size_t n = (size_t)T * DM; const size_t i0 = (size_t)blockIdx.x * blockDim.x + threadIdx.x, st = (size_t)gridDim.x * blockDim.x;
    for (size_t i = i0; i < n; i += st) {
        float v = 0.f;
#define ADD(off, ne) v += bf2f(((const bf16_t*)(ws + (off)))[i % (size_t)(ne)])
        if (level == 0) { ADD(WS_XB, (size_t)T * 1024); ADD(WS_WIN, (size_t)4096 * 1024); ADD(WS_WUQ, 768 * 256); ADD(WS_WUKV, 1024 * 128); ADD(WS_WA, 1024 * 512); ADD(WS_WB, 1024 * 512); ADD(WS_WO, 1024 * 1024); v += ((const float*)(ws + WS_ROPE))[i % (SEQ * 32)]; }
        if (level == 1) { ADD(WS_QA, (size_t)T * 512); ADD(WS_KA, (size_t)T * 512); ADD(WS_VA, (size_t)T * 512); ADD(WS_CQ, (size_t)T * 256); ADD(WS_CKV, (size_t)T * 128); ADD(WS_KR, (size_t)T * 32); ADD(WS_GA, (size_t)T * 1024); ADD(WS_GB, (size_t)T * 1024); }
        if (level == 3) { ADD(WS_QB, (size_t)T * 768); ADD(WS_KB, (size_t)T * 512); ADD(WS_VB, (size_t)T * 512); }
        if (level == 4) { ADD(WS_OA, (size_t)T * 512); }
        if (level == 5) { ADD(WS_OB, (size_t)T * 512); }
        if (level == 6) { ADD(WS_MERGED, (size_t)T * 1024); }
#undef ADD
        out[i] = v;
    }
}
#endif
extern "C" void kernel_launch(void* const* d_in, const int* in_sizes, int n_in, void* d_out, int out_size, void* d_ws, size_t ws_size, hipStream_t stream) {
    static int grid = 0;
    if (grid == 0) {
        if (n_in != 19 || in_sizes[0] != T * DM || out_size != T * DM || ws_size < WS_END) { fprintf(stderr, "kernel_launch: unexpected shapes (n_in %d, in0 %d, out %d, ws %zu); nothing launched\n", n_in, n_in > 0 ? in_sizes[0] : -1, out_size, ws_size); grid = -1; return; }
        int dev = 0, cus = 0, per_cu = 0;
        if (hipGetDevice(&dev) != hipSuccess || hipDeviceGetAttribute(&cus, hipDeviceAttributeMultiprocessorCount, dev) != hipSuccess) { grid = -1; return; }
        if (hipFuncSetAttribute((const void*)fwd, hipFuncAttributeMaxDynamicSharedMemorySize, LDS_BYTES) != hipSuccess) { fprintf(stderr, "kernel_launch: hipFuncSetAttribute failed\n"); grid = -1; return; }
        if (hipOccupancyMaxActiveBlocksPerMultiprocessor(&per_cu, (const void*)fwd, NTHREADS, LDS_BYTES) != hipSuccess || per_cu < 1) fprintf(stderr, "kernel_launch: occupancy query reports %d\n", per_cu);
        (void)hipGetLastError();
        grid = cus;
    }
    if (grid < 0) return;
    if (hipMemsetAsync((char*)d_ws + WS_CTL, 0, CTL_ZERO_BYTES, stream) != hipSuccess) { fprintf(stderr, "kernel_launch: memset failed\n"); return; }
    Args a{};
    for (int i = 0; i < 19; ++i) a.in[i] = (const float*)d_in[i];
    a.out = (float*)d_out; a.ws = (unsigned char*)d_ws; a.li = 0; a.pad = 0;
#if MK_ONE_LAUNCH
    a.ph_lo = 0; a.ph_hi = N_PHASES;
    hipLaunchKernelGGL(fwd, dim3(grid), dim3(NTHREADS), LDS_BYTES, stream, a);
#else
    for (int p = 0; p < N_PHASES; ++p) {
#ifdef DBG_NO_MOE
        if (p >= 8 && p <= 11) continue;
#endif
#ifdef DBG_DUMP
        if (p > (DBG_DUMP == 5 ? 4 : DBG_DUMP)) continue;
#endif
        a.ph_lo = p; a.ph_hi = p + 1; hipLaunchKernelGGL(fwd, dim3(grid), dim3(NTHREADS), LDS_BYTES, stream, a); }
#ifdef DBG_DUMP
    hipLaunchKernelGGL(dbg_dump, dim3(2048), dim3(256), 0, stream, (float*)d_out, (const unsigned char*)d_ws, (int)DBG_DUMP);
#endif
#endif
    const hipError_t le = hipPeekAtLastError();
    if (le != hipSuccess) fprintf(stderr, "kernel_launch: launch failed: %s\n", hipGetErrorName(le));
}
```

```cpp
#define MK_ONE_LAUNCH 1
#include <hip/hip_runtime.h>
#include <cstdio>
#include <cstdint>

#define LAS __attribute__((address_space(3)))
#define GAS __attribute__((address_space(1)))
typedef unsigned short bf16_t;
typedef short bf16x8 __attribute__((ext_vector_type(8)));
typedef short s16x4 __attribute__((ext_vector_type(4)));
typedef float f32x2 __attribute__((ext_vector_type(2)));
typedef float f32x4 __attribute__((ext_vector_type(4)));
typedef float f32x16 __attribute__((ext_vector_type(16)));
typedef unsigned u32x2 __attribute__((ext_vector_type(2)));
typedef unsigned u32x4 __attribute__((ext_vector_type(4)));

constexpr int NB = 2, SEQ = 16384, T = NB * SEQ, DM = 1024;
constexpr int NIN = 4096;
constexpr int NEXP = 32, TOPK = 4, NSLOT = T * TOPK, NPMAX = NSLOT + NEXP * 256;
constexpr float EPS = 1e-5f, LOG2E = 1.4426950408889634f;
constexpr int NWAVES = 8, NTHREADS = 512;

constexpr size_t MiB = 1u << 20;
constexpr size_t WS_CTL = 0, CTL_ZERO_BYTES = 1 * MiB;
constexpr size_t WS_WIN = 1 * MiB;
constexpr size_t WS_WUQ = 9 * MiB;
constexpr size_t WS_WUKV = 10 * MiB;
constexpr size_t WS_WA = 11 * MiB, WS_WB = 12 * MiB;
constexpr size_t WS_WO = 13 * MiB;
constexpr size_t WS_ROPE = 15 * MiB;
constexpr size_t WS_WGU = 17 * MiB;
constexpr size_t WS_WD = 145 * MiB;
constexpr size_t WS_SMALL = 209 * MiB;
constexpr size_t WS_RSTDQ = WS_SMALL, WS_RSTDKV = WS_RSTDQ + T * 4, WS_RSTD2 = WS_RSTDKV + T * 4;
constexpr size_t WS_TOPI = WS_RSTD2 + T * 4, WS_GATEW = WS_TOPI + (size_t)NSLOT * 4, WS_SRANK = WS_GATEW + (size_t)NSLOT * 4, WS_POS = WS_SRANK + (size_t)NSLOT * 4;
constexpr size_t WS_ROWTOK = WS_POS + (size_t)NSLOT * 4, WS_ROWSCALE = WS_ROWTOK + 1 * MiB, WS_WGBASE = WS_ROWSCALE + 1 * MiB;
constexpr size_t WS_WRP = WS_WGBASE + 64 * 1024;
constexpr size_t WS_PARTL = WS_WRP + 128 * 1024;
static_assert(WS_PARTL + 3 * MiB <= 225 * MiB, "small region");
constexpr size_t WS_XB = 225 * MiB;
constexpr size_t WS_QA = 289 * MiB, WS_KA = 321 * MiB, WS_VA = 353 * MiB;
constexpr size_t WS_CQ = 385 * MiB;
constexpr size_t WS_CKV = 401 * MiB;
constexpr size_t WS_KR = 409 * MiB;
constexpr size_t WS_GA = 411 * MiB, WS_GB = 475 * MiB;
constexpr size_t WS_K8 = 225 * MiB;
constexpr size_t WS_Q8 = 249 * MiB;
constexpr size_t WS_ACT = 225 * MiB;
static_assert(WS_ACT + (size_t)NPMAX * 2048 <= 539 * MiB, "ACT overlay");
constexpr size_t WS_QB = 539 * MiB;
constexpr size_t WS_KIMG = 587 * MiB;
constexpr size_t WS_VIMG = 635 * MiB;
constexpr size_t WS_OA = 667 * MiB, WS_OB = 699 * MiB;
constexpr size_t WS_MERGED = 731 * MiB;
constexpr size_t WS_PARTO = 795 * MiB;
constexpr size_t WS_H2 = 891 * MiB;
constexpr size_t WS_Y = 539 * MiB;
static_assert(WS_Y + (size_t)NPMAX * 2048 <= WS_H2, "Y overlay");
constexpr size_t WS_END = 955 * MiB;
constexpr int CW_TMO = 0, CW_BAR = 4096, CW_GCOUNT = 8192, CW_NRM = 8256;

constexpr int RING_BYTES = 131072, MISC_OFF = RING_BYTES + 320, LDS_BYTES = 147456;
constexpr int MI_BAR = 8, MI_TPRE = 16, MI_HIST = 64, MI_PSTART = 96, MI_NRM = 160;

__device__ __forceinline__ unsigned f2bf(float f) { unsigned u = __builtin_bit_cast(unsigned, f); return (u + 0x7fffu + ((u >> 16) & 1u)) >> 16; }
__device__ __forceinline__ unsigned pk2(float lo, float hi) { return f2bf(lo) | (f2bf(hi) << 16); }
__device__ __forceinline__ float bf2f(unsigned short b) { return __builtin_bit_cast(float, (unsigned)b << 16); }
__device__ __forceinline__ float bflo(unsigned w) { return __builtin_bit_cast(float, w << 16); }
__device__ __forceinline__ float bfhi(unsigned w) { return __builtin_bit_cast(float, w & 0xffff0000u); }
typedef __bf16 bf16x2_t __attribute__((ext_vector_type(2)));
__device__ __forceinline__ unsigned cvtpk(float lo, float hi) { const f32x2 v = {lo, hi}; const bf16x2_t b = __builtin_convertvector(v, bf16x2_t); return __builtin_bit_cast(unsigned, b); }
__device__ __forceinline__ unsigned pack4_fp8(float a, float b, float c, float d) { int w = 0; w = __builtin_amdgcn_cvt_pk_fp8_f32(a, b, w, false); w = __builtin_amdgcn_cvt_pk_fp8_f32(c, d, w, true); return (unsigned)w; }
__device__ __forceinline__ float wave_sum(float v) {
#pragma unroll
    for (int o = 1; o < 64; o <<= 1) v += __shfl_xor(v, o);
    return v;
}
__device__ __forceinline__ float fexp2(float x) { return __builtin_amdgcn_exp2f(x); }
__device__ __forceinline__ float frcp(float x) { return __builtin_amdgcn_rcpf(x); }
__device__ __forceinline__ float sigmoidf_(float z) { return frcp(1.f + fexp2(-z * LOG2E)); }
__device__ __forceinline__ int crow(int r, int hi) { return (r & 3) + 8 * (r >> 2) + 4 * hi; }
__device__ __forceinline__ u32x4 pack8(const float (&v)[8]) { u32x4 w; w.x = cvtpk(v[0], v[1]); w.y = cvtpk(v[2], v[3]); w.z = cvtpk(v[4], v[5]); w.w = cvtpk(v[6], v[7]); return w; }
__device__ __forceinline__ void unpack8(const u32x4 w, float (&v)[8]) { v[0] = bflo(w.x); v[1] = bfhi(w.x); v[2] = bflo(w.y); v[3] = bfhi(w.y); v[4] = bflo(w.z); v[5] = bfhi(w.z); v[6] = bflo(w.w); v[7] = bfhi(w.w); }
__device__ __forceinline__ f32x2 rope_cs(int pos, int i) {
    const float inv = __builtin_powf(10000.f, -(float)i * (1.f / 16.f));
    const float ang = (float)pos * inv;
    double x = (double)ang; const double n = __builtin_rint(x * 0.15915494309189535); x = (x - n * 6.283185307179586) - n * 2.4492935982947064e-16;
    const double x2 = x * x; double sn = 1.0, cs = 1.0;
#pragma unroll
    for (int k = 13; k >= 1; --k) { sn = 1.0 - sn * x2 * (1.0 / (double)((2 * k) * (2 * k + 1))); cs = 1.0 - cs * x2 * (1.0 / (double)((2 * k - 1) * (2 * k))); }
    sn *= x;
    return (f32x2){(float)cs, (float)sn};
}

namespace pg8 {
constexpr int BM = 256, BK = 64, HALF = 128, HTB = HALF * BK * 2  , NXCD = 8, WGM = 8;
__host__ __device__ __forceinline__ int lds_byte(int r, int c) { const int st = (r >> 4) * 2 + (c >> 5), rr = r & 15, cc = c & 31, ob = rr * 64 + cc * 2; return st * 1024 + (ob ^ (((ob >> 9) & 1) << 5)); }
__host__ __device__ __forceinline__ void stage_rc(int b, int& R, int& C) { const int st = b / 1024, sb = b % 1024, swz = sb ^ (((sb >> 9) & 1) << 5); R = (st >> 1) * 16 + swz / 64; C = (st & 1) * 32 + (swz % 64) / 2; }
__host__ __device__ __forceinline__ int perm32(int rho) { const int n = rho >> 4, i = rho & 15; return 8 * (i >> 2) + 4 * n + (i & 3); }

struct Unit { int pm, pn, e; };

struct StaticOrder {
    int nM, nN, nwg, G, c;
    __host__ __device__ void init(int M, int N, int G_, int c_) { nM = M / BM; nN = N / BM; nwg = nM * nN; G = G_; c = c_; }
    __host__ __device__ bool next(int i, Unit& u) const {
        const long L = (long)i * G + c; if (L >= nwg) return false;
        int wgid = (int)L; { const int q = nwg / NXCD, r = nwg % NXCD, xcd = wgid % NXCD, off = wgid / NXCD; wgid = (xcd < r ? xcd * (q + 1) : r * (q + 1) + (xcd - r) * q) + off; }
        const int nig = WGM * nN, gid = wgid / nig, fm = gid * WGM, gsz = (nM - fm) < WGM ? (nM - fm) : WGM;
        u.pm = fm + ((wgid % nig) % gsz); u.pn = (wgid % nig) / gsz; u.e = 0; return true;
    }
};
struct DenseSched {
    static constexpr bool LATE = false;
    StaticOrder so; const char* A; const char* Bt; int K;
    __device__ __forceinline__ void prefetch_rows(const Unit&, LAS unsigned char*, int, int, int) const {}
    __device__ __forceinline__ void a_off_lds(const Unit&, const int (&)[2], const int (&)[2], LAS unsigned char*, int, unsigned (&)[2][2]) const {}
    __device__ __forceinline__ void init(const bf16_t* A_, const bf16_t* Bt_, int M, int N, int K_, int G, int c) { so.init(M, N, G, c); A = (const char*)A_; Bt = (const char*)Bt_; K = K_; }
    __device__ __forceinline__ bool next(int i, Unit& u) const { return so.next(i, u); }
    __device__ __forceinline__ const char* a_base(const Unit& u) const { return A + (size_t)u.pm * ((size_t)BM * K * 2); }
    __device__ __forceinline__ const char* b_base(const Unit& u) const { return Bt + (size_t)u.pn * ((size_t)BM * K * 2); }
    __device__ __forceinline__ void a_off(const Unit&, const int (&sR)[2], const int (&sC)[2], unsigned (&vo)[2][2]) const {
#pragma unroll
        for (int h = 0; h < 2; ++h)
#pragma unroll
            for (int i = 0; i < 2; ++i) vo[h][i] = (unsigned)((h * HALF + sR[i]) * K + sC[i]) * 2u;
    }
};
template <int NPN_SHIFT, bool GATHER>
struct MoeSched {
    static constexpr bool LATE = GATHER;
    static constexpr int TBL_OFF = 131072 + 4096;
    __device__ __forceinline__ void prefetch_rows(const Unit& u, LAS unsigned char* lds, int buf, int wid, int lane) const {
        if (wid < 4) __builtin_amdgcn_global_load_lds((const unsigned*)(row_tok + u.pm * BM + wid * 64 + lane), (LAS unsigned*)(lds + TBL_OFF + buf * 1024 + wid * 256), 4, 0, 0);
    }
    __device__ __forceinline__ void a_off_lds(const Unit&, const int (&sR)[2], const int (&sC)[2], LAS unsigned char* lds, int buf, unsigned (&vo)[2][2]) const {
        const LAS int* tb = (const LAS int*)(lds + TBL_OFF + buf * 1024);
#pragma unroll
        for (int h = 0; h < 2; ++h)
#pragma unroll
            for (int i = 0; i < 2; ++i) vo[h][i] = (unsigned)(tb[h * HALF + sR[i]] * K + sC[i]) * 2u;
    }
    const LAS int* tpre; int ntiles, G, c, K; const char* A; const char* Bt; size_t estride; const int* row_tok;
    __device__ __forceinline__ bool next(int i, Unit& u) const {
        const int L = i * G + c, g = L >> NPN_SHIFT; if (g >= ntiles) return false;
        int e = 0; while (e < 31 && tpre[e + 1] <= g) ++e;
        u.pm = g; u.pn = L & ((1 << NPN_SHIFT) - 1); u.e = e; return true;
    }
    __device__ __forceinline__ const char* a_base(const Unit& u) const { return GATHER ? A : A + (size_t)u.pm * ((size_t)BM * K * 2); }
    __device__ __forceinline__ const char* b_base(const Unit& u) const { return Bt + (size_t)u.e * estride + (size_t)u.pn * ((size_t)BM * K * 2); }
    __device__ __forceinline__ void a_off(const Unit& u, const int (&sR)[2], const int (&sC)[2], unsigned (&vo)[2][2]) const {
#pragma unroll
        for (int h = 0; h < 2; ++h)
#pragma unroll
            for (int i = 0; i < 2; ++i) {
                if (GATHER) { const int tok = row_tok[u.pm * BM + h * HALF + sR[i]]; vo[h][i] = (unsigned)(tok * K + sC[i]) * 2u; }
                else vo[h][i] = (unsigned)((h * HALF + sR[i]) * K + sC[i]) * 2u;
            }
    }
};

template <class Epi, class Sched, bool ALIGN_EPI>
__device__ __forceinline__ void gemm_phase2(LAS unsigned char* lds, const int K_, const Sched& S, const Epi& E) {
    int K = K_; asm volatile("" : "+s"(K));
    const int tid = threadIdx.x, wid = __builtin_amdgcn_readfirstlane(tid >> 6), lane = tid & 63, wr = wid >> 2, wc = wid & 3, fr = lane & 15, fq = lane >> 4;
    const int nt = K / BK;
    int sR[2], sC[2]; unsigned voffB[2];
#pragma unroll
    for (int i = 0; i < 2; ++i) { int R, C; stage_rc(tid * 16 + i * 8192, R, C); sR[i] = R; sC[i] = C; const int Rb = Epi::PERM ? ((R & ~31) + perm32(R & 31)) : R; voffB[i] = (unsigned)(Rb * K + C) * 2u; }
    const size_t kstep = (size_t)(BK * 2);
    const size_t hstep = (size_t)HALF * K * 2;
    const unsigned ldsw = (unsigned)wid * 1024u;
    const int aoff = lds_byte(wr * 64 + fr, fq * 8), boff = lds_byte(wc * 32 + fr, fq * 8);
#define PG8_SA(b, h) (((b) * 2 + (h)) * HTB)
#define PG8_SB(b, h) ((4 + (b) * 2 + (h)) * HTB)
#define PG8_STAGE_B(bufoff, gbase) do { _Pragma("unroll") for (int _i = 0; _i < 2; ++_i) \
        __builtin_amdgcn_global_load_lds((const unsigned*)((const char*)(gbase) + voffB[_i]), (LAS unsigned*)(lds + (bufoff) + ldsw + _i * 8192), 16, 0, 0); } while (0)
#define PG8_STAGE_A(bufoff, gbase, o0, o1) do { \
        __builtin_amdgcn_global_load_lds((const unsigned*)((const char*)(gbase) + (o0)), (LAS unsigned*)(lds + (bufoff) + ldsw), 16, 0, 0); \
        __builtin_amdgcn_global_load_lds((const unsigned*)((const char*)(gbase) + (o1)), (LAS unsigned*)(lds + (bufoff) + ldsw + 8192), 16, 0, 0); } while (0)
#define PG8_LDA(dst, b, h) do { _Pragma("unroll") for (int m = 0; m < 4; ++m) _Pragma("unroll") for (int k = 0; k < 2; ++k) dst[m][k] = *(const LAS bf16x8*)(lds + PG8_SA(b, h) + aoff + m * 2048 + k * 1024); } while (0)
#define PG8_LDB(dst, b, h) do { _Pragma("unroll") for (int n = 0; n < 2; ++n) _Pragma("unroll") for (int k = 0; k < 2; ++k) dst[n][k] = *(const LAS bf16x8*)(lds + PG8_SB(b, h) + boff + n * 2048 + k * 1024); } while (0)
#define PG8_MMA(ai, bj, At, Bt) do { __builtin_amdgcn_s_setprio(1); _Pragma("unroll") for (int m = 0; m < 4; ++m) _Pragma("unroll") for (int n = 0; n < 2; ++n) _Pragma("unroll") for (int k = 0; k < 2; ++k) \
        acc[ai][bj][m][n] = __builtin_amdgcn_mfma_f32_16x16x32_bf16(Bt[n][k], At[m][k], acc[ai][bj][m][n], 0, 0, 0); __builtin_amdgcn_s_setprio(0); } while (0)
#define PG8_WAIT_V(n) asm volatile("s_waitcnt vmcnt(" #n ")" ::: "memory")
#define PG8_WAIT_L(n) asm volatile("s_waitcnt lgkmcnt(" #n ")" ::: "memory")
#define PG8_BAR __builtin_amdgcn_s_barrier()
#define PG8_SCHED __builtin_amdgcn_sched_barrier(0)
    Unit cur, nxt; int ui = 0;
    if (!S.next(0, cur)) return;
    f32x4 acc[2][2][4][2];
#pragma unroll
    for (int a = 0; a < 2; ++a)
#pragma unroll
        for (int b = 0; b < 2; ++b)
#pragma unroll
            for (int m = 0; m < 4; ++m)
#pragma unroll
                for (int n = 0; n < 2; ++n) acc[a][b][m][n] = (f32x4){0.f, 0.f, 0.f, 0.f};
    bf16x8 At[4][2], B0[2][2], B1[2][2];
    unsigned voA[2][2], voN[2][2];
    S.a_off(cur, sR, sC, voA);
    const char* cA = S.a_base(cur); const char* cB = S.b_base(cur);
    PG8_STAGE_B(PG8_SB(0, 0), cB); PG8_STAGE_B(PG8_SB(0, 1), cB + hstep); PG8_STAGE_A(PG8_SA(0, 0), cA, voA[0][0], voA[0][1]); PG8_STAGE_A(PG8_SA(0, 1), cA, voA[1][0], voA[1][1]);
    if (wr == 1) PG8_BAR;
    PG8_WAIT_V(2); PG8_BAR;
    PG8_STAGE_B(PG8_SB(1, 0), cB + kstep); PG8_STAGE_A(PG8_SA(1, 0), cA + kstep, voA[0][0], voA[0][1]); PG8_STAGE_B(PG8_SB(1, 1), cB + hstep + kstep);
    PG8_WAIT_V(6); PG8_BAR;
    for (;;) {
        const bool has_next = S.next(ui + 1, nxt);
        const char* nA = cA; const char* nB = cB;
#pragma unroll
        for (int h = 0; h < 2; ++h)
#pragma unroll
            for (int i = 0; i < 2; ++i) voN[h][i] = voA[h][i];
        if (has_next) { nA = S.a_base(nxt); nB = S.b_base(nxt); if constexpr (Sched::LATE) S.prefetch_rows(nxt, lds, (ui + 1) & 1, wid, lane); else S.a_off(nxt, sR, sC, voN); }
        for (int t = 0; t < nt; t += 2) {
            const bool last = (t == nt - 2);
            if constexpr (Sched::LATE) { if (last && has_next) S.a_off_lds(nxt, sR, sC, lds, (ui + 1) & 1, voN); }
            const char* a1 = cA + (size_t)(t + 1) * kstep;
            const char* a2 = last ? nA : cA + (size_t)(t + 2) * kstep; const char* b2 = last ? nB : cB + (size_t)(t + 2) * kstep;
            const char* a3 = a2 + kstep; const char* b3 = b2 + kstep;
            const unsigned s00 = last ? voN[0][0] : voA[0][0], s01 = last ? voN[0][1] : voA[0][1], s10 = last ? voN[1][0] : voA[1][0], s11 = last ? voN[1][1] : voA[1][1];
            PG8_LDB(B0, 0, 0); PG8_LDB(B1, 0, 1); PG8_SCHED; PG8_LDA(At, 0, 0); PG8_STAGE_A(PG8_SA(1, 1), a1, voA[1][0], voA[1][1]);
            PG8_WAIT_V(8); PG8_WAIT_L(0); PG8_BAR; PG8_MMA(0, 0, At, B0); PG8_MMA(0, 1, At, B1); PG8_BAR; PG8_SCHED;
            PG8_LDA(At, 0, 1); PG8_STAGE_B(PG8_SB(0, 0), b2); PG8_STAGE_B(PG8_SB(0, 1), b2 + hstep); PG8_STAGE_A(PG8_SA(0, 0), a2, s00, s01);
            PG8_WAIT_V(8); PG8_WAIT_L(0); PG8_BAR; PG8_MMA(1, 0, At, B0); PG8_MMA(1, 1, At, B1); PG8_BAR; PG8_SCHED;
            PG8_LDB(B0, 1, 0); PG8_LDB(B1, 1, 1); PG8_SCHED; PG8_LDA(At, 1, 0); PG8_STAGE_A(PG8_SA(0, 1), a2, s10, s11);
            PG8_WAIT_V(8); PG8_WAIT_L(0); PG8_BAR; PG8_MMA(0, 0, At, B0); PG8_MMA(0, 1, At, B1); PG8_BAR; PG8_SCHED;
            PG8_LDA(At, 1, 1); PG8_STAGE_B(PG8_SB(1, 0), b3); PG8_STAGE_B(PG8_SB(1, 1), b3 + hstep); PG8_STAGE_A(PG8_SA(1, 0), a3, s00, s01);
            PG8_WAIT_V(8); PG8_WAIT_L(0); PG8_BAR; PG8_MMA(1, 0, At, B0); PG8_MMA(1, 1, At, B1); PG8_BAR; PG8_SCHED;
        }
        if constexpr (ALIGN_EPI) { if (wr == 0) PG8_BAR; }
        E(acc, cur, wr, wc, fr, fq);
        if (!has_next) break;
#pragma unroll
        for (int a = 0; a < 2; ++a)
#pragma unroll
            for (int b = 0; b < 2; ++b)
#pragma unroll
                for (int m = 0; m < 4; ++m)
#pragma unroll
                    for (int n = 0; n < 2; ++n) acc[a][b][m][n] = (f32x4){0.f, 0.f, 0.f, 0.f};
        cur = nxt; cA = nA; cB = nB; ++ui;
#pragma unroll
        for (int h = 0; h < 2; ++h)
#pragma unroll
            for (int i = 0; i < 2; ++i) voA[h][i] = voN[h][i];
        if constexpr (ALIGN_EPI) { if (wr == 1) PG8_BAR; }
    }
    PG8_WAIT_V(0);
    if constexpr (!ALIGN_EPI) { if (wr == 0) PG8_BAR; }
    PG8_BAR;
#undef PG8_SA
#undef PG8_SB
#undef PG8_STAGE_A
#undef PG8_STAGE_B
#undef PG8_LDA
#undef PG8_LDB
#undef PG8_MMA
#undef PG8_WAIT_V
#undef PG8_WAIT_L
#undef PG8_BAR
#undef PG8_SCHED
}
}

#define XB_TMO      128
#define XB_XCNT(j)  (256  + 64 * (j))
#define XB_XSUB(j)  (1280 + 64 * (j))
#define XB_XGEN(j)  (2304 + 64 * (j))
#define XB_TOP      3328
#define XB_TOPGEN   3392
#define XCD_BAR_WORDS 3456
#define XB_SPIN_CAP (1u << 18)

__device__ __forceinline__ unsigned xb_ld(unsigned* p)              { return __hip_atomic_load(p, __ATOMIC_RELAXED, __HIP_MEMORY_SCOPE_AGENT); }
__device__ __forceinline__ unsigned xb_add(unsigned* p, unsigned v) { return __hip_atomic_fetch_add(p, v, __ATOMIC_RELAXED, __HIP_MEMORY_SCOPE_AGENT); }
__device__ __forceinline__ unsigned xb_xcc_id() { return (unsigned)__builtin_amdgcn_s_getreg((3 << 11) | 20) & 0xFu; }
#define XB_SPIN(cond, bar) do { unsigned _sp = 0; while (cond) { __builtin_amdgcn_s_sleep(1); \
    if ((++_sp & 255u) == 0u) { if (xb_ld(&(bar)[XB_TMO])) break; if (_sp > XB_SPIN_CAP) { atomicAdd(&(bar)[XB_TMO], 1u); break; } } } } while (0)

struct XcdBarrier {
    unsigned* bar; unsigned x;
    volatile LAS unsigned* st;
};
__device__ __forceinline__ XcdBarrier xcd_barrier_post(unsigned* bar, volatile LAS unsigned* st) {
    XcdBarrier b; b.bar = bar; b.x = xb_xcc_id(); b.st = st;
    if (threadIdx.x == 0) (void)xb_add(&bar[XB_XCNT(b.x)], 1u);
    return b;
}
__device__ __forceinline__ void xcd_barrier_complete(unsigned* bar, unsigned x, unsigned& nloc, unsigned& nx) {
    const unsigned G = gridDim.x * gridDim.y * gridDim.z;
    unsigned sum, cnt, mine, sp = 0u;
    for (;;) {
        sum = 0u; cnt = 0u; mine = 0u;
#pragma unroll
        for (unsigned j = 0; j < 16; ++j) { const unsigned c = xb_ld(&bar[XB_XCNT(j)]); sum += c; cnt += (c > 0u) ? 1u : 0u; mine = (j == x) ? c : mine; }
        if (sum == G) break;
        __builtin_amdgcn_s_sleep(1);
        if ((++sp & 255u) == 0u) { if (xb_ld(&bar[XB_TMO])) break; if (sp > XB_SPIN_CAP) { atomicAdd(&bar[XB_TMO], 1u); break; } }
    }
    nloc = mine > 0u ? mine : 1u; nx = cnt > 0u ? cnt : 1u;
}
__device__ __forceinline__ void xcd_barrier(const XcdBarrier& b) {
    asm volatile("s_waitcnt vmcnt(0)" ::: "memory");
    __syncthreads();
    if (threadIdx.x == 0) {
        unsigned* bar = b.bar;
        __builtin_amdgcn_s_waitcnt(0);
        unsigned nloc = b.st[0], nx = b.st[1];
        if (nloc == 0u) { xcd_barrier_complete(bar, b.x, nloc, nx); b.st[0] = nloc; b.st[1] = nx; }
        const unsigned old = xb_add(&bar[XB_XSUB(b.x)], 1u);
        const unsigned gen = old / nloc;
        if (old + 1u == (gen + 1u) * nloc) {
            __builtin_amdgcn_fence(__ATOMIC_RELEASE, "agent");
            asm volatile("s_waitcnt vmcnt(0)" ::: "memory");
            const unsigned og = xb_add(&bar[XB_TOP], 1u);
            const unsigned tg = og / nx;
            if (og + 1u == (tg + 1u) * nx) xb_add(&bar[XB_TOPGEN], 1u);
            else XB_SPIN(xb_ld(&bar[XB_TOPGEN]) == tg, bar);
            __builtin_amdgcn_fence(__ATOMIC_ACQUIRE, "agent");
            xb_add(&bar[XB_XGEN(b.x)], 1u);
            asm volatile("s_waitcnt vmcnt(0)" ::: "memory");
        } else {
            XB_SPIN(xb_ld(&bar[XB_XGEN(b.x)]) == gen, bar);
            __builtin_amdgcn_fence(__ATOMIC_ACQUIRE, "agent");
            asm volatile("s_waitcnt vmcnt(0)" ::: "memory");
        }
    }
    __syncthreads();
}

#define EPI_WALK(...) \
    _Pragma("unroll") for (int ai = 0; ai < 2; ++ai) _Pragma("unroll") for (int m = 0; m < 4; ++m) { \
        const int row = u.pm * 256 + ai * 128 + wr * 64 + m * 16 + fr; \
        _Pragma("unroll") for (int bj = 0; bj < 2; ++bj) { const int cw = bj * 128 + wc * 32 + 8 * fq; \
            float v[8] = {acc[ai][bj][m][0][0], acc[ai][bj][m][0][1], acc[ai][bj][m][0][2], acc[ai][bj][m][0][3], acc[ai][bj][m][1][0], acc[ai][bj][m][1][1], acc[ai][bj][m][1][2], acc[ai][bj][m][1][3]}; \
            __VA_ARGS__ } asm volatile("" ::: "memory"); }

__device__ __forceinline__ void rope8(float (&v)[8], const f32x2* rope_row, int i0) {
#pragma unroll
    for (int j = 0; j < 4; ++j) { const f32x2 cs = rope_row[i0 + j]; const float x1 = v[2 * j], x2 = v[2 * j + 1]; v[2 * j] = x1 * cs.x - x2 * cs.y; v[2 * j + 1] = x2 * cs.x + x1 * cs.y; }
}

struct EpiInProj {
    static constexpr bool PERM = true;
    unsigned char* ws;
    __device__ __forceinline__ void operator()(const f32x4 (&acc)[2][2][4][2], const pg8::Unit& u, int wr, int wc, int fr, int fq) const {
        const int pn = u.pn;
        if (pn < 6) {
            bf16_t* base = (bf16_t*)(ws + (pn < 2 ? WS_QA : pn < 4 ? WS_KA : WS_VA)) + (pn & 1) * 256;
            EPI_WALK({ *(u32x4*)(base + (size_t)row * 512 + cw) = pack8(v); })
        } else if (pn == 6) {
            bf16_t* base = (bf16_t*)(ws + WS_CQ);
            EPI_WALK({ *(u32x4*)(base + (size_t)row * 256 + cw) = pack8(v); })
        } else if (pn == 7) {
            bf16_t* ckv = (bf16_t*)(ws + WS_CKV); bf16_t* kr = (bf16_t*)(ws + WS_KR); const f32x2* rope = (const f32x2*)(ws + WS_ROPE);
            EPI_WALK({ if (cw < 128) { *(u32x4*)(ckv + (size_t)row * 128 + cw) = pack8(v); }
                       else if (cw < 160) { rope8(v, rope + (size_t)(row & (SEQ - 1)) * 16, (cw - 128) >> 1); *(u32x4*)(kr + (size_t)row * 32 + (cw - 128)) = pack8(v); } })
        } else {
            bf16_t* base = (bf16_t*)(ws + (pn < 12 ? WS_GA : WS_GB)) + ((pn - 8) & 3) * 256;
            EPI_WALK({ _Pragma("unroll") for (int j = 0; j < 8; ++j) v[j] = sigmoidf_(v[j]); *(u32x4*)(base + (size_t)row * 1024 + cw) = pack8(v); })
        }
    }
};
#define EPI_ROW(ai, m) (u.pm * 256 + (ai) * 128 + wr * 64 + (m) * 16 + fr)
#define EPI_LOAD_RS(rs) float rs8[2][4]; _Pragma("unroll") for (int ai = 0; ai < 2; ++ai) _Pragma("unroll") for (int m = 0; m < 4; ++m) rs8[ai][m] = (rs)[EPI_ROW(ai, m)];
struct EpiQ {
    static constexpr bool PERM = true;
    unsigned char* ws;
    __device__ __forceinline__ void operator()(const f32x4 (&acc)[2][2][4][2], const pg8::Unit& u, int wr, int wc, int fr, int fq) const {
        bf16_t* qb = (bf16_t*)(ws + WS_QB); const float* rs = (const float*)(ws + WS_RSTDQ); const f32x2* rope = (const f32x2*)(ws + WS_ROPE);
        EPI_LOAD_RS(rs)
        EPI_WALK({ const int col = u.pn * 256 + cw; const int w = col % 96; const float r = rs8[ai][m];
                   _Pragma("unroll") for (int j = 0; j < 8; ++j) v[j] *= r;
                   if (w >= 64) rope8(v, rope + (size_t)(row & (SEQ - 1)) * 16, (w - 64) >> 1);
                   *(u32x4*)(qb + (size_t)row * 768 + col) = pack8(v);
                   *(u32x2*)(ws + WS_Q8 + (size_t)row * 768 + col) = (u32x2){pack4_fp8(v[0] * 16.f, v[1] * 16.f, v[2] * 16.f, v[3] * 16.f), pack4_fp8(v[4] * 16.f, v[5] * 16.f, v[6] * 16.f, v[7] * 16.f)}; })
    }
};
struct EpiKV {
    static constexpr bool PERM = true;
    unsigned char* ws;
    __device__ __forceinline__ void operator()(const f32x4 (&acc)[2][2][4][2], const pg8::Unit& u, int wr, int wc, int fr, int fq) const {
        const float* rs = (const float*)(ws + WS_RSTDKV); bf16_t* kimg = (bf16_t*)(ws + WS_KIMG); bf16_t* vimg = (bf16_t*)(ws + WS_VIMG);
        EPI_LOAD_RS(rs)
        EPI_WALK({ const float r = rs8[ai][m];
                   _Pragma("unroll") for (int j = 0; j < 8; ++j) v[j] *= r;
                   const int col = (u.pn & 1) * 256 + cw, h = col >> 6, b = row >> 14, sq = row & (SEQ - 1), tile = sq >> 6, rr = sq & 63; const size_t tb = (size_t)((b * 8 + h) * 256 + tile);
                   if (u.pn < 2) { *(u32x4*)(kimg + tb * 6144 + ((col & 63) >> 3) * 512 + rr * 8) = pack8(v);
                       *(u32x2*)(ws + WS_K8 + tb * 6144 + ((col & 63) >> 4) * 1024 + rr * 16 + (col & 8)) = (u32x2){pack4_fp8(v[0], v[1], v[2], v[3]), pack4_fp8(v[4], v[5], v[6], v[7])}; }
                   else *(u32x4*)(vimg + tb * 4096 + ((col & 63) >> 5) * 2048 + rr * 32 + (col & 31)) = pack8(v); })
    }
};
template <bool SECOND> struct EpiGate {
    static constexpr bool PERM = true;
    unsigned char* ws;
    __device__ __forceinline__ void operator()(const f32x4 (&acc)[2][2][4][2], const pg8::Unit& u, int wr, int wc, int fr, int fq) const {
        bf16_t* mg = (bf16_t*)(ws + WS_MERGED); const bf16_t* gt = (const bf16_t*)(ws + (SECOND ? WS_GB : WS_GA));
#pragma unroll
        for (int ai = 0; ai < 2; ++ai) {
            u32x4 gw[4][2], pw[4][2];
#pragma unroll
            for (int m = 0; m < 4; ++m)
#pragma unroll
                for (int bj = 0; bj < 2; ++bj) { const size_t o = (size_t)EPI_ROW(ai, m) * 1024 + u.pn * 256 + bj * 128 + wc * 32 + 8 * fq; gw[m][bj] = *(const u32x4*)(gt + o); if (SECOND) pw[m][bj] = *(const u32x4*)(mg + o); }
#pragma unroll
            for (int m = 0; m < 4; ++m)
#pragma unroll
                for (int bj = 0; bj < 2; ++bj) { const size_t o = (size_t)EPI_ROW(ai, m) * 1024 + u.pn * 256 + bj * 128 + wc * 32 + 8 * fq;
                    float v[8] = {acc[ai][bj][m][0][0], acc[ai][bj][m][0][1], acc[ai][bj][m][0][2], acc[ai][bj][m][0][3], acc[ai][bj][m][1][0], acc[ai][bj][m][1][1], acc[ai][bj][m][1][2], acc[ai][bj][m][1][3]};
                    float g[8]; unpack8(gw[m][bj], g);
                    if (SECOND) { float p[8]; unpack8(pw[m][bj], p); _Pragma("unroll") for (int j = 0; j < 8; ++j) v[j] = p[j] + g[j] * v[j]; }
                    else { _Pragma("unroll") for (int j = 0; j < 8; ++j) v[j] = g[j] * v[j]; }
                    *(u32x4*)(mg + o) = pack8(v); }
            asm volatile("" ::: "memory");
        }
    }
};
struct EpiResid {
    static constexpr bool PERM = true;
    unsigned char* ws; const float* x; float* x1;
    __device__ __forceinline__ void operator()(const f32x4 (&acc)[2][2][4][2], const pg8::Unit& u, int wr, int wc, int fr, int fq) const {
        bf16_t* h2 = (bf16_t*)(ws + WS_H2);
#pragma unroll
        for (int ai = 0; ai < 2; ++ai) {
            f32x4 xa[4][2][2];
#pragma unroll
            for (int m = 0; m < 4; ++m)
#pragma unroll
                for (int bj = 0; bj < 2; ++bj) { const size_t o = (size_t)EPI_ROW(ai, m) * 1024 + u.pn * 256 + bj * 128 + wc * 32 + 8 * fq; xa[m][bj][0] = *(const f32x4*)(x + o); xa[m][bj][1] = *(const f32x4*)(x + o + 4); }
#pragma unroll
            for (int m = 0; m < 4; ++m)
#pragma unroll
                for (int bj = 0; bj < 2; ++bj) { const size_t o = (size_t)EPI_ROW(ai, m) * 1024 + u.pn * 256 + bj * 128 + wc * 32 + 8 * fq;
                    const f32x4 r0 = acc[ai][bj][m][0] + xa[m][bj][0], r1 = acc[ai][bj][m][1] + xa[m][bj][1];
                    *(f32x4*)(x1 + o) = r0; *(f32x4*)(x1 + o + 4) = r1;
                    const float v[8] = {r0[0], r0[1], r0[2], r0[3], r1[0], r1[1], r1[2], r1[3]};
                    *(u32x4*)(h2 + o) = pack8(v); }
            asm volatile("" ::: "memory");
        }
    }
};
struct EpiSwiglu {
    static constexpr bool PERM = true;
    unsigned char* ws; const float* bgu;
    __device__ __forceinline__ void operator()(const f32x4 (&acc)[2][2][4][2], const pg8::Unit& u, int wr, int wc, int fr, int fq) const {
        bf16_t* act = (bf16_t*)(ws + WS_ACT); const float* rsc = (const float*)(ws + WS_ROWSCALE);
        const int c0 = u.pn * 128 + wc * 32 + 8 * fq; const float* bg = bgu + (size_t)u.e * 2048 + c0;
        float bgv[8], buv[8];
#pragma unroll
        for (int j = 0; j < 8; ++j) { bgv[j] = bg[j]; buv[j] = bg[1024 + j]; }
        EPI_LOAD_RS(rsc)
#pragma unroll
        for (int ai = 0; ai < 2; ++ai)
#pragma unroll
            for (int m = 0; m < 4; ++m) {
                const int row = u.pm * 256 + ai * 128 + wr * 64 + m * 16 + fr; const float r = rs8[ai][m]; float o[8];
#pragma unroll
                for (int j = 0; j < 8; ++j) { const float g0 = acc[ai][0][m][j >> 2][j & 3] * r + bgv[j], u0 = acc[ai][1][m][j >> 2][j & 3] * r + buv[j];
                    const float g = fminf(g0, 7.f), up = fminf(fmaxf(u0, -7.f), 7.f); o[j] = (up + 1.f) * (g * sigmoidf_(1.702f * g)); }
                *(u32x4*)(act + (size_t)row * 1024 + c0) = pack8(o);
            }
    }
};
struct EpiDown {
    static constexpr bool PERM = true;
    unsigned char* ws; const float* bd;
    __device__ __forceinline__ void operator()(const f32x4 (&acc)[2][2][4][2], const pg8::Unit& u, int wr, int wc, int fr, int fq) const {
        bf16_t* y = (bf16_t*)(ws + WS_Y); const float* b = bd + (size_t)u.e * 1024 + u.pn * 256;
        EPI_WALK({ _Pragma("unroll") for (int j = 0; j < 8; ++j) v[j] += b[cw + j];
                   *(u32x4*)(y + (size_t)row * 1024 + u.pn * 256 + cw) = pack8(v); })
    }
};

typedef short v4i16_t __attribute__((ext_vector_type(4)));
__device__ __forceinline__ s16x4 vtr(const LAS char* p) { return __builtin_bit_cast(s16x4, __builtin_amdgcn_ds_read_tr16_b64_v4i16((LAS v4i16_t*)p)); }
__device__ __forceinline__ float swapmax(float m) { auto rr = __builtin_amdgcn_permlane32_swap(__float_as_uint(m), __float_as_uint(m), false, false); return fmaxf(__uint_as_float(rr[0]), __uint_as_float(rr[1])); }
__device__ __forceinline__ float swapsum(float m) { auto rr = __builtin_amdgcn_permlane32_swap(__float_as_uint(m), __float_as_uint(m), false, false); return __uint_as_float(rr[0]) + __uint_as_float(rr[1]); }

struct AttnState { f32x16 o0, o1; float m, l; };

struct MlaKL {
    const bf16_t* K; const bf16_t* V;
    template <int D0> __device__ __forceinline__ bf16x8 kfrag(int c, int r32, int hi) const { return *(const bf16x8*)(K + (size_t)(c >> 1) * 6144 + (2 * D0 + hi) * 512 + ((c & 1) * 32 + r32) * 8); }
    __device__ __forceinline__ u32x4 vpiece(int c, int row, int c8) const { return *(const u32x4*)(V + (size_t)(c >> 1) * 4096 + (c8 >> 2) * 2048 + ((c & 1) * 32 + row) * 32 + (c8 & 3) * 8); }
    __device__ __forceinline__ void modify(int, f32x16&, int, int) const {}
    __device__ __forceinline__ int order(int i) const { return i; }
};
struct DilKL {
    const bf16_t* K; const bf16_t* V;
    int dil, res, u0, L; float slope2d;
    __device__ __forceinline__ size_t tok(int c, int kk) const { int v = u0 - 64 + 32 * c + kk; v = v < 0 ? 0 : (v >= L ? L - 1 : v); return (size_t)(res + dil * v); }
    template <int D0> __device__ __forceinline__ bf16x8 kfrag(int c, int r32, int hi) const { return *(const bf16x8*)(K + tok(c, r32) * 512 + 16 * D0 + 8 * hi); }
    __device__ __forceinline__ u32x4 vpiece(int c, int row, int c8) const { return *(const u32x4*)(V + tok(c, row) * 512 + 8 * c8); }
    __device__ __forceinline__ void modify(int c, f32x16& s, int r32, int hi) const {
        const float c0 = (float)(32 * c - 64); const int vb = u0 - 64 + 32 * c;
#pragma unroll
        for (int r = 0; r < 16; ++r) { const float d = (float)(crow(r, hi) - r32); s[r] = s[r] - slope2d * fabsf(d + c0); }
        if (c == 0) {
#pragma unroll
            for (int r = 0; r < 16; ++r) s[r] = (crow(r, hi) >= r32) ? s[r] : -1e30f; }
        if (c == 4) {
#pragma unroll
            for (int r = 0; r < 16; ++r) s[r] = (crow(r, hi) <= r32) ? s[r] : -1e30f; }
        if (vb < 0 || vb + 31 >= L) {
#pragma unroll
            for (int r = 0; r < 16; ++r) { const int v = vb + crow(r, hi); s[r] = (v >= 0 && v < L) ? s[r] : -1e30f; } }
    }
    __device__ __forceinline__ int order(int i) const { return i == 0 ? 2 : i == 1 ? 1 : i == 2 ? 3 : i == 3 ? 0 : 4; }
};

template <int NDK, class KL> __device__ __forceinline__ void attn_load_k(bf16x8 (&kf)[NDK], const KL& kl, int c, int r32, int hi) {
    kf[0] = kl.template kfrag<0>(c, r32, hi); kf[1] = kl.template kfrag<1>(c, r32, hi); kf[2] = kl.template kfrag<2>(c, r32, hi); kf[3] = kl.template kfrag<3>(c, r32, hi);
    if constexpr (NDK == 6) { kf[4] = kl.template kfrag<4>(c, r32, hi); kf[5] = kl.template kfrag<5>(c, r32, hi); }
}
template <class KL> __device__ __forceinline__ void attn_load_v(u32x4 (&vp)[4], const KL& kl, int c, int lane) {
#pragma unroll
    for (int i = 0; i < 4; ++i) { const int p = lane + 64 * i; vp[i] = kl.vpiece(c, p >> 3, p & 7); }
}
__device__ __forceinline__ void attn_store_v(const u32x4 (&vp)[4], LAS char* vimg, int lane) {
#pragma unroll
    for (int i = 0; i < 4; ++i) { const int p = lane + 64 * i, row = p >> 3, c8 = p & 7; *(LAS u32x4*)(vimg + (c8 >> 2) * 2048 + row * 64 + (c8 & 3) * 16) = vp[i]; }
}
template <int NDK, class KL> __device__ __forceinline__ void attn_core(AttnState& st, const bf16x8 (&qf)[NDK], const bf16x8 (&kf)[NDK], const KL& kl, int c, LAS char* vimg, LAS float* wsf, int lane, int r32, int hi) {
    f32x16 s = {};
#pragma unroll
    for (int d0 = 0; d0 < NDK; ++d0) s = __builtin_amdgcn_mfma_f32_32x32x16_bf16(kf[d0], qf[d0], s, 0, 0, 0);
    kl.modify(c, s, r32, hi);
    float mx = s[0];
#pragma unroll
    for (int r = 1; r < 16; ++r) mx = fmaxf(mx, s[r]);
    mx = swapmax(mx);
    const float mn = fmaxf(st.m, mx), alpha = fexp2(st.m - mn);
    float ps = 0.f;
#pragma unroll
    for (int r = 0; r < 16; ++r) { s[r] = fexp2(s[r] - mn); ps += s[r]; }
    st.l = st.l * alpha + ps; st.m = mn;
    if (__any(alpha != 1.f)) {
        if (hi == 0) wsf[r32] = alpha;
#pragma unroll
        for (int r = 0; r < 16; ++r) { const float a = wsf[crow(r, hi)]; st.o0[r] *= a; st.o1[r] *= a; }
    }
    const u32x4 pw0 = {cvtpk(s[0], s[1]), cvtpk(s[2], s[3]), cvtpk(s[4], s[5]), cvtpk(s[6], s[7])};
    const u32x4 pw1 = {cvtpk(s[8], s[9]), cvtpk(s[10], s[11]), cvtpk(s[12], s[13]), cvtpk(s[14], s[15])};
    const bf16x8 pa0 = __builtin_bit_cast(bf16x8, pw0), pa1 = __builtin_bit_cast(bf16x8, pw1);
    const LAS char* vp = vimg + ((lane >> 4) & 1) * 32 + (lane & 3) * 8 + (4 * hi + ((lane & 15) >> 2)) * 64;
#pragma unroll
    for (int ks = 0; ks < 2; ++ks) {
        const s16x4 l0 = vtr(vp + ks * 1024), h0 = vtr(vp + ks * 1024 + 512), l1 = vtr(vp + 2048 + ks * 1024), h1 = vtr(vp + 2048 + ks * 1024 + 512);
        const bf16x8 v0 = {l0[0], l0[1], l0[2], l0[3], h0[0], h0[1], h0[2], h0[3]}, v1 = {l1[0], l1[1], l1[2], l1[3], h1[0], h1[1], h1[2], h1[3]};
        st.o0 = __builtin_amdgcn_mfma_f32_32x32x16_bf16(ks == 0 ? pa0 : pa1, v0, st.o0, 0, 0, 0);
        st.o1 = __builtin_amdgcn_mfma_f32_32x32x16_bf16(ks == 0 ? pa0 : pa1, v1, st.o1, 0, 0, 0);
    }
}
template <int NDK, class KL> __device__ __forceinline__ void wave_attn(AttnState& st, const bf16x8 (&qf)[NDK], const KL& kl, int nchunk, LAS char* vimg, LAS float* wsf, int lane) {
    const int r32 = lane & 31, hi = lane >> 5;
    st.o0 = f32x16{}; st.o1 = f32x16{}; st.m = -1e30f; st.l = 0.f;
    bf16x8 kfa[NDK], kfb[NDK]; u32x4 vp[4];
    attn_load_k<NDK>(kfa, kl, kl.order(0), r32, hi); attn_load_v(vp, kl, kl.order(0), lane);
    asm volatile("" : "+s"(nchunk));
#pragma unroll 1
    for (int c = 0; c < nchunk; c += 2) {
        attn_store_v(vp, vimg, lane);
        if (c + 1 < nchunk) { attn_load_k<NDK>(kfb, kl, kl.order(c + 1), r32, hi); attn_load_v(vp, kl, kl.order(c + 1), lane); }
        attn_core<NDK>(st, qf, kfa, kl, kl.order(c), vimg, wsf, lane, r32, hi);
        if (c + 1 < nchunk) {
            attn_store_v(vp, vimg, lane);
            if (c + 2 < nchunk) { attn_load_k<NDK>(kfa, kl, kl.order(c + 2), r32, hi); attn_load_v(vp, kl, kl.order(c + 2), lane); }
            attn_core<NDK>(st, qf, kfb, kl, kl.order(c + 1), vimg, wsf, lane, r32, hi);
        }
    }
}
__device__ __forceinline__ float attn_finish(AttnState& st, LAS char* vimg, LAS float* wsf, int lane) {
    const int r32 = lane & 31, hi = lane >> 5;
    const float lt = swapsum(st.l);
    if (hi == 0) wsf[32 + r32] = lt;
    LAS bf16_t* stg = (LAS bf16_t*)vimg;
#pragma unroll
    for (int r = 0; r < 16; ++r) { const int q = crow(r, hi); const float il = frcp(wsf[32 + q]);
        stg[q * 64 + r32] = (bf16_t)f2bf(st.o0[r] * il); stg[q * 64 + 32 + r32] = (bf16_t)f2bf(st.o1[r] * il); }
    return lt;
}

namespace mla {
constexpr int NW = 8, QBLK = 32, QB = 256, KVBLK = 64, NT = SEQ / KVBLK;
constexpr int KSLOT = 12288, VSLOT = 8192, LDS_K = 0, LDS_V = 3 * KSLOT, LDS_WS = LDS_V + 3 * VSLOT, LDS_OST = LDS_WS + NW * 256, LDS_BYTES_ = LDS_OST + NW * 4096;
#define SBAR() __builtin_amdgcn_sched_barrier(0)
#define WAIT_BAR(N) asm volatile("s_waitcnt vmcnt(" #N ") lgkmcnt(0)\n\ts_barrier" ::: "memory")
__device__ __forceinline__ void glds16(const void* gsrc, unsigned lds_dst) { unsigned keep;
    asm volatile("s_mov_b32 %0, m0\n\ts_mov_b32 m0, %2\n\ts_nop 0\n\tglobal_load_lds_dwordx4 %1, off\n\ts_mov_b32 m0, %0" : "=&s"(keep) : "v"(gsrc), "s"(lds_dst) : "memory"); }
typedef LAS const char* lds_cptr;
__device__ __forceinline__ void kload2(bf16x8* kf, lds_cptr kp, int j) { kf[2 * j] = *(const LAS bf16x8*)(kp + j * 2048); kf[2 * j + 1] = *(const LAS bf16x8*)(kp + j * 2048 + 512); }

__device__ __forceinline__ void mla_unit(int b, int h, int qb, const bf16_t* Q, const bf16_t* __restrict__ Kim, const bf16_t* __restrict__ Vim, bf16_t* O, LAS char* shm) {
    const int tid = threadIdx.x, lane = tid & 63, r32 = lane & 31, hi = lane >> 5; const int wid = __builtin_amdgcn_readfirstlane(tid >> 6);
    const long rowbase = (long)b * SEQ; const int q0 = qb * QB;
    const bf16_t* Qw = Q + (rowbase + q0 + wid * QBLK) * 768 + h * 96;
    const unsigned lds0 = (unsigned)(uintptr_t)shm;
    LAS float* wsf = (LAS float*)(shm + LDS_WS) + wid * 64;
    const bf16_t* ksrc = Kim + wid * 512 + lane * 8;
    const bf16_t* rsrc = Kim + (8 + (wid & 3)) * 512 + lane * 8;
    const bf16_t* vsrc = Vim + wid * 512 + lane * 8;
    const unsigned kdst = lds0 + LDS_K + wid * 1024, rdst = lds0 + LDS_K + (8 + (wid & 3)) * 1024, vdst = lds0 + LDS_V + wid * 1024;
#define DMA_K(t, ks) do { glds16(ksrc + (long)(t) * 6144, (unsigned)__builtin_amdgcn_readfirstlane(kdst + (ks))); glds16(rsrc + (long)(t) * 6144, (unsigned)__builtin_amdgcn_readfirstlane(rdst + (ks))); } while (0)
#define DMA_V(t, vs) glds16(vsrc + (long)(t) * 4096, (unsigned)__builtin_amdgcn_readfirstlane(vdst + (vs)))
    const lds_cptr shm3 = (lds_cptr)shm; const lds_cptr kp0 = shm3 + LDS_K + hi * 1024 + r32 * 16;
    const lds_cptr vp0 = shm3 + LDS_V + ((lane >> 4) & 1) * 32 + (lane & 3) * 8 + (4 * hi + ((lane & 15) >> 2)) * 64;
    bf16x8 kf[12];
    DMA_K(0, 0); DMA_V(0, 0); DMA_K(1, KSLOT);
    bf16x8 qr[6];
#pragma unroll
    for (int d0 = 0; d0 < 6; ++d0) qr[d0] = *reinterpret_cast<const bf16x8*>(&Qw[(long)r32 * 768 + d0 * 16 + hi * 8]);
    float l_reg = 0.f; f32x16 o[2]; o[0] = f32x16{}; o[1] = f32x16{};
    f32x16 pA0, pA1, pB0, pB1;
    int si_prev = 0, si_cur = 0, si_next = 1;
#define ROT() do { si_prev = si_cur; si_cur = si_next; si_next = (si_next == 2) ? 0 : si_next + 1; } while (0)
    DMA_K(2, 2 * KSLOT);
    WAIT_BAR(5);
    { const lds_cptr kb = kp0;
#pragma unroll
      for (int d0 = 0; d0 < 6; ++d0) { const bf16x8 b0 = *(const LAS bf16x8*)(kb + d0 * 2048), b1 = *(const LAS bf16x8*)(kb + d0 * 2048 + 512);
          if (d0 == 0) { pA0 = __builtin_amdgcn_mfma_f32_32x32x16_bf16(b0, qr[0], f32x16{}, 0, 0, 0); pA1 = __builtin_amdgcn_mfma_f32_32x32x16_bf16(b1, qr[0], f32x16{}, 0, 0, 0); }
          else { pA0 = __builtin_amdgcn_mfma_f32_32x32x16_bf16(b0, qr[d0], pA0, 0, 0, 0); pA1 = __builtin_amdgcn_mfma_f32_32x32x16_bf16(b1, qr[d0], pA1, 0, 0, 0); } } }
#pragma unroll
    for (int r = 0; r < 16; ++r) { pA0[r] = __builtin_amdgcn_exp2f(pA0[r]); pA1[r] = __builtin_amdgcn_exp2f(pA1[r]); }
    WAIT_BAR(0);
    DMA_K(3, 0); DMA_V(1, VSLOT);
    ROT();
#pragma unroll
    for (int j = 0; j < 6; ++j) kload2(kf, kp0 + si_cur * KSLOT, j);
    WAIT_BAR(3);
    s16x4 vlo[8], vhi[8]; u32x4 pw0, pw1, pw2, pw3;
#define PKW(P, B) cvtpk(P[B], P[B + 1])
#define PAF(k) __builtin_bit_cast(bf16x8, pw##k)
#define VFR(i) (bf16x8){vlo[i][0], vlo[i][1], vlo[i][2], vlo[i][3], vhi[i][0], vhi[i][1], vhi[i][2], vhi[i][3]}
#define PIN(x) asm volatile("" : "+v"(x))
#define MF(a, b, c) __builtin_amdgcn_mfma_f32_32x32x16_bf16(a, b, c, 0, 0, 0)
#define GAPA(MFX, A0, A1, A2, A3, W0, W1, PW) do { MFX; sacc += A0; sacc += A1; sacc += A2; sacc += A3; PIN(sacc); W0; W1; PIN(PW); SBAR(); } while (0)
#define GAPM(MFX) do { MFX; SBAR(); } while (0)
#define EX(v) __builtin_amdgcn_exp2f(v)
#define GAPB(MFX, X, B) do { MFX; X[B] = EX(X[B]); X[B + 1] = EX(X[B + 1]); X[B + 2] = EX(X[B + 2]); X[B + 3] = EX(X[B + 3]); PIN(X); SBAR(); } while (0)
#define VRD(i) do { vlo[i] = vtr(vp_ + (((i) >> 2) * 4096 + ((i) & 3) * 1024)); vhi[i] = vtr(vp_ + (((i) >> 2) * 4096 + ((i) & 3) * 1024 + 512)); } while (0)
#define KRD(G, j) do { if (G) { kload2(kf, kp0 + si_next * KSLOT, j); SBAR(); } } while (0)
#define STEP(C0, C1, P0, P1, t, GK, GV, GL) do { SBAR(); \
    const lds_cptr vp_ = vp0 + si_prev * VSLOT; \
    VRD(0); SBAR(); float sacc = (P0[0] + P0[1]); \
    GAPA(C0 = MF(kf[0], qr[0], f32x16{}), P0[2], P0[3], P0[4], P0[5],     pw0[0] = PKW(P0, 0),  pw0[1] = PKW(P0, 2),  pw0); \
    VRD(4); SBAR(); GAPA(C1 = MF(kf[1], qr[0], f32x16{}), P0[6], P0[7], P0[8], P0[9],     pw0[2] = PKW(P0, 4),  pw0[3] = PKW(P0, 6),  pw0); \
    VRD(1); SBAR(); GAPA(C0 = MF(kf[2], qr[1], C0),   P0[10], P0[11], P0[12], P0[13], pw1[0] = PKW(P0, 8),  pw1[1] = PKW(P0, 10), pw1); \
    VRD(5); SBAR(); GAPA(C1 = MF(kf[3], qr[1], C1),   P0[14], P0[15], P1[0], P1[1],   pw1[2] = PKW(P0, 12), pw1[3] = PKW(P0, 14), pw1); \
    VRD(2); SBAR(); GAPA(C0 = MF(kf[4], qr[2], C0),   P1[2], P1[3], P1[4], P1[5],     pw2[0] = PKW(P1, 0),  pw2[1] = PKW(P1, 2),  pw2); \
    VRD(6); SBAR(); GAPA(C1 = MF(kf[5], qr[2], C1),   P1[6], P1[7], P1[8], P1[9],     pw2[2] = PKW(P1, 4),  pw2[3] = PKW(P1, 6),  pw2); \
    VRD(3); SBAR(); GAPA(C0 = MF(kf[6], qr[3], C0),   P1[10], P1[11], P1[12], P1[13], pw3[0] = PKW(P1, 8),  pw3[1] = PKW(P1, 10), pw3); \
    VRD(7); SBAR(); GAPA(C1 = MF(kf[7], qr[3], C1),   P1[14], P1[15], 0.f, 0.f,       pw3[2] = PKW(P1, 12), pw3[3] = PKW(P1, 14), pw3); \
    GAPM(C0 = MF(kf[8], qr[4], C0)); GAPM(C1 = MF(kf[9], qr[4], C1)); GAPM(C0 = MF(kf[10], qr[5], C0)); GAPM(C1 = MF(kf[11], qr[5], C1)); \
    l_reg += sacc; \
    if (GK) { DMA_K((t) + 3, si_cur * KSLOT); } if (GV) { DMA_V((t) + 1, si_next * VSLOT); } \
    SBAR(); \
    GAPB(o[0] = MF(PAF(0), VFR(0), o[0]), C0, 0); \
    GAPB(o[1] = MF(PAF(0), VFR(4), o[1]), C0, 4); \
    KRD(GL, 0); GAPB(o[0] = MF(PAF(1), VFR(1), o[0]), C0, 8); \
    KRD(GL, 1); GAPB(o[1] = MF(PAF(1), VFR(5), o[1]), C0, 12); \
    KRD(GL, 2); GAPB(o[0] = MF(PAF(2), VFR(2), o[0]), C1, 0); \
    KRD(GL, 3); GAPB(o[1] = MF(PAF(2), VFR(6), o[1]), C1, 4); \
    KRD(GL, 4); GAPB(o[0] = MF(PAF(3), VFR(3), o[0]), C1, 8); \
    KRD(GL, 5); GAPB(o[1] = MF(PAF(3), VFR(7), o[1]), C1, 12); \
    } while (0)
    int t = 1;
    for (; t + 5 < NT; t += 2) {
        STEP(pB0, pB1, pA0, pA1, t, true, true, true);     WAIT_BAR(3); ROT();
        STEP(pA0, pA1, pB0, pB1, t + 1, true, true, true); WAIT_BAR(3); ROT();
    }
#define ENDW(tt) do { if ((tt) + 3 < NT) { WAIT_BAR(3); } else if ((tt) + 2 < NT) { WAIT_BAR(1); } else { WAIT_BAR(0); } } while (0)
    for (; t + 1 < NT; t += 2) {
        STEP(pB0, pB1, pA0, pA1, t, (t + 3 < NT), (t + 1 < NT), (t + 1 < NT));         ENDW(t);     ROT();
        STEP(pA0, pA1, pB0, pB1, t + 1, (t + 4 < NT), (t + 2 < NT), (t + 2 < NT));     ENDW(t + 1); ROT();
    }
    STEP(pB0, pB1, pA0, pA1, NT - 1, false, false, false);
    { float sacc = pB0[0] + pB0[1];
#pragma unroll
      for (int r = 2; r < 16; ++r) sacc += pB0[r];
#pragma unroll
      for (int r = 0; r < 16; ++r) sacc += pB1[r];
      l_reg += sacc;
      pw0 = (u32x4){PKW(pB0, 0), PKW(pB0, 2), PKW(pB0, 4), PKW(pB0, 6)}; pw1 = (u32x4){PKW(pB0, 8), PKW(pB0, 10), PKW(pB0, 12), PKW(pB0, 14)};
      pw2 = (u32x4){PKW(pB1, 0), PKW(pB1, 2), PKW(pB1, 4), PKW(pB1, 6)}; pw3 = (u32x4){PKW(pB1, 8), PKW(pB1, 10), PKW(pB1, 12), PKW(pB1, 14)};
      SBAR();
      const lds_cptr vp_ = vp0 + si_cur * VSLOT;
#pragma unroll
      for (int d0 = 0; d0 < 2; ++d0) {
          s16x4 lo4[4], hi4[4];
#pragma unroll
          for (int ks = 0; ks < 4; ++ks) { lo4[ks] = vtr(vp_ + d0 * 4096 + ks * 1024); hi4[ks] = vtr(vp_ + d0 * 4096 + ks * 1024 + 512); }
#define PK4(k) (bf16x8){lo4[k][0], lo4[k][1], lo4[k][2], lo4[k][3], hi4[k][0], hi4[k][1], hi4[k][2], hi4[k][3]}
          o[d0] = MF(PAF(0), PK4(0), o[d0]); o[d0] = MF(PAF(1), PK4(1), o[d0]); o[d0] = MF(PAF(2), PK4(2), o[d0]); o[d0] = MF(PAF(3), PK4(3), o[d0]);
#undef PK4
      } }
    l_reg = swapsum(l_reg);
    if (hi == 0) wsf[32 + r32] = l_reg;
    asm volatile("s_waitcnt lgkmcnt(0)" ::: "memory");
    float rli[16];
#pragma unroll
    for (int r = 0; r < 16; ++r) rli[r] = __builtin_amdgcn_rcpf(wsf[32 + crow(r, hi)]);
    bf16_t* Ow = O + (rowbase + q0 + wid * QBLK) * 512 + h * 64;
    { LAS bf16_t* stg = (LAS bf16_t*)(shm + LDS_OST) + wid * 2048;
#pragma unroll
      for (int r = 0; r < 16; ++r) { const int orow = crow(r, hi);
#pragma unroll
          for (int d0 = 0; d0 < 2; ++d0) stg[orow * 64 + d0 * 32 + r32] = (bf16_t)f2bf(o[d0][r] * rli[r]); }
      asm volatile("s_waitcnt lgkmcnt(0)" ::: "memory");
#pragma unroll
      for (int i = 0; i < 4; ++i) { const int row = i * 8 + (lane >> 3), ch = lane & 7; const u32x4 v = *(const LAS u32x4*)(stg + row * 64 + ch * 8); *(u32x4*)(Ow + (long)row * 512 + ch * 8) = v; } }
    asm volatile("s_waitcnt lgkmcnt(0)\n\ts_barrier" ::: "memory");
#undef DMA_K
#undef DMA_V
#undef ROT
#undef PKW
#undef PAF
#undef VFR
#undef PIN
#undef MF
#undef GAPA
#undef GAPM
#undef GAPB
#undef EX
#undef VRD
#undef KRD
#undef STEP
#undef ENDW
}
#undef SBAR
#undef WAIT_BAR
}

namespace mla8 {
using mla::glds16; using mla::lds_cptr;
typedef int v8i __attribute__((ext_vector_type(8)));
constexpr int NW = 8, QBLK = 32, QB = 256, KVBLK = 64, NT = SEQ / KVBLK;
constexpr int KSLOT = 6144, VSLOT = 8192, LDS_K = 0, LDS_V = 3 * KSLOT, LDS_WS = LDS_V + 3 * VSLOT, LDS_OST = LDS_WS + NW * 256, LDS_BYTES_ = LDS_OST + NW * 4096;
#define SBAR() __builtin_amdgcn_sched_barrier(0)
#define WAIT_BAR(N) asm volatile("s_waitcnt vmcnt(" #N ") lgkmcnt(0)\n\ts_barrier" ::: "memory")
__device__ __forceinline__ v8i kfrag8(lds_cptr slot, int n, int ks, int r32, int hi) {
    const lds_cptr p = slot + (ks == 0 ? 2 * hi : 4) * 1024 + (32 * n + r32) * 16;
    const u32x4 a = *(const LAS u32x4*)p, b = *(const LAS u32x4*)(p + 1024);
    return (v8i){(int)a.x, (int)a.y, (int)a.z, (int)a.w, (int)b.x, (int)b.y, (int)b.z, (int)b.w};
}
#define MF8(a, b, c) __builtin_amdgcn_mfma_scale_f32_32x32x64_f8f6f4(a, b, c, 0, 0, 0, 0x7f7f7f7f, 0, 0x7b7b7b7b)

__device__ __forceinline__ void mla8_unit(int b, int h, int qb, const unsigned char* Q8, const unsigned char* __restrict__ K8im, const bf16_t* __restrict__ Vim, bf16_t* O, LAS char* shm) {
    const int tid = threadIdx.x, lane = tid & 63, r32 = lane & 31, hi = lane >> 5; const int wid = __builtin_amdgcn_readfirstlane(tid >> 6);
    const long rowbase = (long)b * SEQ; const int q0 = qb * QB;
    const unsigned char* Qw = Q8 + (size_t)(rowbase + q0 + wid * QBLK + r32) * 768 + h * 96;
    const unsigned lds0 = (unsigned)(uintptr_t)shm;
    LAS float* wsf = (LAS float*)(shm + LDS_WS) + wid * 64;
    const int kpc = wid < 6 ? wid : wid - 6;
    const unsigned char* ksrc = K8im + kpc * 1024 + lane * 16;
    const bf16_t* vsrc = Vim + wid * 512 + lane * 8;
    const unsigned kdst = lds0 + LDS_K + kpc * 1024, vdst = lds0 + LDS_V + wid * 1024;
#define DMA_K(t, ks) glds16(ksrc + (long)(t) * 6144, (unsigned)__builtin_amdgcn_readfirstlane(kdst + (ks)))
#define DMA_V(t, vs) glds16(vsrc + (long)(t) * 4096, (unsigned)__builtin_amdgcn_readfirstlane(vdst + (vs)))
    const lds_cptr shm3 = (lds_cptr)shm; const lds_cptr ks0 = shm3 + LDS_K;
    const lds_cptr vp0 = shm3 + LDS_V + ((lane >> 4) & 1) * 32 + (lane & 3) * 8 + (4 * hi + ((lane & 15) >> 2)) * 64;
    v8i kf[4];
    DMA_K(0, 0); DMA_V(0, 0); DMA_K(1, KSLOT);
    v8i qr[2];
    { const u32x4 a = *(const u32x4*)(Qw + 32 * hi), c = *(const u32x4*)(Qw + 32 * hi + 16); qr[0] = (v8i){(int)a.x, (int)a.y, (int)a.z, (int)a.w, (int)c.x, (int)c.y, (int)c.z, (int)c.w};
      u32x4 d = *(const u32x4*)(Qw + 64), e = *(const u32x4*)(Qw + 80); if (hi) { d = (u32x4){0u, 0u, 0u, 0u}; e = d; }
      qr[1] = (v8i){(int)d.x, (int)d.y, (int)d.z, (int)d.w, (int)e.x, (int)e.y, (int)e.z, (int)e.w}; }
    float l_reg = 0.f; f32x16 o[2]; o[0] = f32x16{}; o[1] = f32x16{};
    f32x16 pA0, pA1, pB0, pB1;
    int si_prev = 0, si_cur = 0, si_next = 1;
#define ROT() do { si_prev = si_cur; si_cur = si_next; si_next = (si_next == 2) ? 0 : si_next + 1; } while (0)
    DMA_K(2, 2 * KSLOT);
    WAIT_BAR(3);
    { pA0 = MF8(kfrag8(ks0, 0, 0, r32, hi), qr[0], f32x16{}); pA1 = MF8(kfrag8(ks0, 1, 0, r32, hi), qr[0], f32x16{});
      pA0 = MF8(kfrag8(ks0, 0, 1, r32, hi), qr[1], pA0); pA1 = MF8(kfrag8(ks0, 1, 1, r32, hi), qr[1], pA1); }
#pragma unroll
    for (int r = 0; r < 16; ++r) { pA0[r] = __builtin_amdgcn_exp2f(pA0[r]); pA1[r] = __builtin_amdgcn_exp2f(pA1[r]); }
    WAIT_BAR(0);
    DMA_K(3, 0); DMA_V(1, VSLOT);
    ROT();
    kf[0] = kfrag8(ks0 + si_cur * KSLOT, 0, 0, r32, hi); kf[1] = kfrag8(ks0 + si_cur * KSLOT, 0, 1, r32, hi); kf[2] = kfrag8(ks0 + si_cur * KSLOT, 1, 0, r32, hi); kf[3] = kfrag8(ks0 + si_cur * KSLOT, 1, 1, r32, hi);
    WAIT_BAR(2);
    s16x4 vlo[8], vhi[8]; u32x4 pw0, pw1, pw2, pw3;
#define PKW(P, B) cvtpk(P[B], P[B + 1])
#define PAF(k) __builtin_bit_cast(bf16x8, pw##k)
#define VFR(i) (bf16x8){vlo[i][0], vlo[i][1], vlo[i][2], vlo[i][3], vhi[i][0], vhi[i][1], vhi[i][2], vhi[i][3]}
#define PIN(x) asm volatile("" : "+v"(x))
#define MF(a, b, c) __builtin_amdgcn_mfma_f32_32x32x16_bf16(a, b, c, 0, 0, 0)
#define GAPA(MFX, A0, A1, A2, A3, W0, W1, PW) do { MFX; sacc += A0; sacc += A1; sacc += A2; sacc += A3; PIN(sacc); W0; W1; PIN(PW); SBAR(); } while (0)
#define GAPM(MFX) do { MFX; SBAR(); } while (0)
#define EX(v) __builtin_amdgcn_exp2f(v)
#define GAPB(MFX, X, B) do { MFX; X[B] = EX(X[B]); X[B + 1] = EX(X[B + 1]); X[B + 2] = EX(X[B + 2]); X[B + 3] = EX(X[B + 3]); PIN(X); SBAR(); } while (0)
#define VRD(i) do { vlo[i] = vtr(vp_ + (((i) >> 2) * 4096 + ((i) & 3) * 1024)); vhi[i] = vtr(vp_ + (((i) >> 2) * 4096 + ((i) & 3) * 1024 + 512)); } while (0)
#define KRD(G, j) do { if (G) { kf[j] = kfrag8(ks0 + si_next * KSLOT, (j) >> 1, (j) & 1, r32, hi); SBAR(); } } while (0)
#define GAPA8(MFX, A0, A1, A2, A3, A4, A5, A6, A7, W0, W1, W2, W3, PWa, PWb) do { MFX; sacc += A0; sacc += A1; sacc += A2; sacc += A3; PIN(sacc); W0; W1; PIN(PWa); sacc += A4; sacc += A5; sacc += A6; sacc += A7; PIN(sacc); W2; W3; PIN(PWb); SBAR(); } while (0)
#define STEP(C0, C1, P0, P1, t, GK, GV, GL) do { SBAR(); \
    const lds_cptr vp_ = vp0 + si_prev * VSLOT; \
    VRD(0); VRD(4); SBAR(); float sacc = (P0[0] + P0[1]); \
    GAPA8(C0 = MF8(kf[0], qr[0], f32x16{}), P0[2], P0[3], P0[4], P0[5], P0[6], P0[7], P0[8], P0[9],         pw0[0] = PKW(P0, 0), pw0[1] = PKW(P0, 2), pw0[2] = PKW(P0, 4), pw0[3] = PKW(P0, 6), pw0, pw0); \
    VRD(1); VRD(5); SBAR(); \
    GAPA8(C1 = MF8(kf[2], qr[0], f32x16{}), P0[10], P0[11], P0[12], P0[13], P0[14], P0[15], P1[0], P1[1],   pw1[0] = PKW(P0, 8), pw1[1] = PKW(P0, 10), pw1[2] = PKW(P0, 12), pw1[3] = PKW(P0, 14), pw1, pw1); \
    VRD(2); VRD(6); SBAR(); \
    GAPA8(C0 = MF8(kf[1], qr[1], C0),       P1[2], P1[3], P1[4], P1[5], P1[6], P1[7], P1[8], P1[9],         pw2[0] = PKW(P1, 0), pw2[1] = PKW(P1, 2), pw2[2] = PKW(P1, 4), pw2[3] = PKW(P1, 6), pw2, pw2); \
    VRD(3); VRD(7); SBAR(); \
    GAPA8(C1 = MF8(kf[3], qr[1], C1),       P1[10], P1[11], P1[12], P1[13], P1[14], P1[15], 0.f, 0.f,       pw3[0] = PKW(P1, 8), pw3[1] = PKW(P1, 10), pw3[2] = PKW(P1, 12), pw3[3] = PKW(P1, 14), pw3, pw3); \
    l_reg += sacc; \
    if (GK) { DMA_K((t) + 3, si_cur * KSLOT); } if (GV) { DMA_V((t) + 1, si_next * VSLOT); } \
    SBAR(); \
    GAPB(o[0] = MF(PAF(0), VFR(0), o[0]), C0, 0); \
    GAPB(o[1] = MF(PAF(0), VFR(4), o[1]), C0, 4); \
    KRD(GL, 0); GAPB(o[0] = MF(PAF(1), VFR(1), o[0]), C0, 8); \
    KRD(GL, 1); GAPB(o[1] = MF(PAF(1), VFR(5), o[1]), C0, 12); \
    KRD(GL, 2); GAPB(o[0] = MF(PAF(2), VFR(2), o[0]), C1, 0); \
    KRD(GL, 3); GAPB(o[1] = MF(PAF(2), VFR(6), o[1]), C1, 4); \
    GAPB(o[0] = MF(PAF(3), VFR(3), o[0]), C1, 8); \
    GAPB(o[1] = MF(PAF(3), VFR(7), o[1]), C1, 12); \
    } while (0)
    int t = 1;
    for (; t + 5 < NT; t += 2) {
        STEP(pB0, pB1, pA0, pA1, t, true, true, true);     WAIT_BAR(2); ROT();
        STEP(pA0, pA1, pB0, pB1, t + 1, true, true, true); WAIT_BAR(2); ROT();
    }
#define ENDW(tt) do { if ((tt) + 3 < NT) { WAIT_BAR(2); } else if ((tt) + 2 < NT) { WAIT_BAR(1); } else { WAIT_BAR(0); } } while (0)
    for (; t + 1 < NT; t += 2) {
        STEP(pB0, pB1, pA0, pA1, t, (t + 3 < NT), (t + 1 < NT), (t + 1 < NT));         ENDW(t);     ROT();
        STEP(pA0, pA1, pB0, pB1, t + 1, (t + 4 < NT), (t + 2 < NT), (t + 2 < NT));     ENDW(t + 1); ROT();
    }
    STEP(pB0, pB1, pA0, pA1, NT - 1, false, false, false);
    { float sacc = pB0[0] + pB0[1];
#pragma unroll
      for (int r = 2; r < 16; ++r) sacc += pB0[r];
#pragma unroll
      for (int r = 0; r < 16; ++r) sacc += pB1[r];
      l_reg += sacc;
      pw0 = (u32x4){PKW(pB0, 0), PKW(pB0, 2), PKW(pB0, 4), PKW(pB0, 6)}; pw1 = (u32x4){PKW(pB0, 8), PKW(pB0, 10), PKW(pB0, 12), PKW(pB0, 14)};
      pw2 = (u32x4){PKW(pB1, 0), PKW(pB1, 2), PKW(pB1, 4), PKW(pB1, 6)}; pw3 = (u32x4){PKW(pB1, 8), PKW(pB1, 10), PKW(pB1, 12), PKW(pB1, 14)};
      SBAR();
      const lds_cptr vp_ = vp0 + si_cur * VSLOT;
#pragma unroll
      for (int d0 = 0; d0 < 2; ++d0) {
          s16x4 lo4[4], hi4[4];
#pragma unroll
          for (int ks = 0; ks < 4; ++ks) { lo4[ks] = vtr(vp_ + d0 * 4096 + ks * 1024); hi4[ks] = vtr(vp_ + d0 * 4096 + ks * 1024 + 512); }
#define PK4(k) (bf16x8){lo4[k][0], lo4[k][1], lo4[k][2], lo4[k][3], hi4[k][0], hi4[k][1], hi4[k][2], hi4[k][3]}
          o[d0] = MF(PAF(0), PK4(0), o[d0]); o[d0] = MF(PAF(1), PK4(1), o[d0]); o[d0] = MF(PAF(2), PK4(2), o[d0]); o[d0] = MF(PAF(3), PK4(3), o[d0]);
#undef PK4
      } }
    l_reg = swapsum(l_reg);
    if (hi == 0) wsf[32 + r32] = l_reg;
    asm volatile("s_waitcnt lgkmcnt(0)" ::: "memory");
    float rli[16];
#pragma unroll
    for (int r = 0; r < 16; ++r) rli[r] = __builtin_amdgcn_rcpf(wsf[32 + crow(r, hi)]);
    bf16_t* Ow = O + (rowbase + q0 + wid * QBLK) * 512 + h * 64;
    { LAS bf16_t* stg = (LAS bf16_t*)(shm + LDS_OST) + wid * 2048;
#pragma unroll
      for (int r = 0; r < 16; ++r) { const int orow = crow(r, hi);
#pragma unroll
          for (int d0 = 0; d0 < 2; ++d0) stg[orow * 64 + d0 * 32 + r32] = (bf16_t)f2bf(o[d0][r] * rli[r]); }
      asm volatile("s_waitcnt lgkmcnt(0)" ::: "memory");
#pragma unroll
      for (int i = 0; i < 4; ++i) { const int row = i * 8 + (lane >> 3), ch = lane & 7; const u32x4 v = *(const LAS u32x4*)(stg + row * 64 + ch * 8); *(u32x4*)(Ow + (long)row * 512 + ch * 8) = v; } }
    asm volatile("s_waitcnt lgkmcnt(0)\n\ts_barrier" ::: "memory");
#undef DMA_K
#undef DMA_V
#undef ROT
#undef PKW
#undef PAF
#undef VFR
#undef PIN
#undef MF
#undef GAPA
#undef GAPA8
#undef GAPM
#undef GAPB
#undef EX
#undef VRD
#undef KRD
#undef STEP
#undef ENDW
}
#undef SBAR
#undef WAIT_BAR
#undef MF8
}

template <class CM> __device__ __forceinline__ void tr_item(const float* W, int ld, const float* rs, bf16_t* WT, int K, int k0, int n0, const CM& cm, LAS float* scr, int lane) {
    const int n = lane & 31, sc = cm.col(n0 + n); const float cs = cm.scale(n0 + n);
#pragma unroll 8
    for (int i = 0; i < 32; ++i) { const int kk = 2 * i + (lane >> 5); float v = 0.f; if (sc >= 0) v = W[(size_t)(k0 + kk) * ld + sc] * cs * (rs ? rs[k0 + kk] : 1.f); scr[kk * 33 + n] = v; }
    asm volatile("s_waitcnt lgkmcnt(0)" ::: "memory");
    const int c = lane & 7;
#pragma unroll
    for (int j = 0; j < 4; ++j) { const int nn = (lane >> 3) + 8 * j; const LAS float* s = scr + (8 * c) * 33 + nn;
        u32x4 o; o.x = pk2(s[0 * 33], s[1 * 33]); o.y = pk2(s[2 * 33], s[3 * 33]); o.z = pk2(s[4 * 33], s[5 * 33]); o.w = pk2(s[6 * 33], s[7 * 33]);
        *(u32x4*)(WT + (size_t)(n0 + nn) * K + k0 + 8 * c) = o; }
    asm volatile("s_waitcnt lgkmcnt(0)" ::: "memory");
}
template <class CM> __device__ __forceinline__ void tr_item4(const float* W, int ld, const float* rs, bf16_t* WT, int K, int k0, int n0, const CM& cm, LAS float* scr, int lane) {
    const int n4 = (lane & 7) * 4, sc = cm.col(n0 + n4); const float cs = cm.scale(n0 + n4);
    f32x4 v[8];
#pragma unroll
    for (int i = 0; i < 8; ++i) { const int kk = (lane >> 3) + 8 * i; v[i] = (sc >= 0) ? *(const f32x4*)(W + (size_t)(k0 + kk) * ld + sc) : (f32x4){0.f, 0.f, 0.f, 0.f}; }
#pragma unroll
    for (int i = 0; i < 8; ++i) { const int kk = (lane >> 3) + 8 * i; const float r = cs * (rs ? rs[k0 + kk] : 1.f); LAS float* d = scr + kk * 33 + n4; d[0] = v[i].x * r; d[1] = v[i].y * r; d[2] = v[i].z * r; d[3] = v[i].w * r; }
    asm volatile("s_waitcnt lgkmcnt(0)" ::: "memory");
    const int c = lane & 7;
#pragma unroll
    for (int j = 0; j < 4; ++j) { const int nn = (lane >> 3) + 8 * j; const LAS float* s = scr + (8 * c) * 33 + nn;
        u32x4 o; o.x = pk2(s[0 * 33], s[1 * 33]); o.y = pk2(s[2 * 33], s[3 * 33]); o.z = pk2(s[4 * 33], s[5 * 33]); o.w = pk2(s[6 * 33], s[7 * 33]);
        *(u32x4*)(WT + (size_t)(n0 + nn) * K + k0 + 8 * c) = o; }
    asm volatile("s_waitcnt lgkmcnt(0)" ::: "memory");
}
struct CmIn {
    __device__ __forceinline__ int col(int n) const {
        if (n < 1920) return n;
        if (n < 1952) { const int j = n - 1920, i = j >> 1; return 1920 + ((j & 1) ? i + 16 : i); }
        if (n < 2048) return -1;
        if (n < 3072) return 1952 + (n - 2048);
        return 2976 + (n - 3072);
    }
    __device__ __forceinline__ float scale(int n) const { return n < 512 ? 0.125f * LOG2E : 1.f; }
    __device__ __forceinline__ bool regular(int n0) const { return n0 < 1920 || n0 >= 1952; }
};
struct CmUq {
    __device__ __forceinline__ int col(int n) const { const int h = n / 96, w = n % 96; if (w < 64) return n; const int j = w - 64, i = j >> 1; return h * 96 + 64 + ((j & 1) ? i + 16 : i); }
    __device__ __forceinline__ float scale(int) const { return 0.10206207261596577f * LOG2E; }
    __device__ __forceinline__ bool regular(int n0) const { return (n0 % 96) < 64; }
};
struct CmId { int off; __device__ __forceinline__ int col(int n) const { return n - off; } __device__ __forceinline__ float scale(int) const { return 1.f; } __device__ __forceinline__ bool regular(int) const { return true; } };
struct CmGu {
    __device__ __forceinline__ int col(int n) const { const int pn = n >> 8, w = n & 255; return w < 128 ? 128 * pn + w : 1024 + 128 * pn + (w - 128); }
    __device__ __forceinline__ float scale(int) const { return 1.f; }
    __device__ __forceinline__ bool regular(int) const { return true; }
};
template <class CM> __device__ __forceinline__ void tr_any(const float* W, int ld, const float* rs, bf16_t* WT, int K, int k0, int n0, const CM& cm, LAS float* scr, int lane) {
    if (cm.regular(n0)) tr_item4(W, ld, rs, WT, K, k0, n0, cm, scr, lane); else tr_item(W, ld, rs, WT, K, k0, n0, cm, scr, lane);
}

struct Args { const float* in[19]; float* out; unsigned char* ws; int ph_lo, ph_hi, li, pad; };

__device__ __forceinline__ void p0_prologue(const Args& a, LAS unsigned char* lds, int wave, int lane) {
    LAS float* scr = (LAS float*)(lds + wave * 16384);
    const int gw = blockIdx.x * NWAVES + wave, NGW = gridDim.x * NWAVES;
    unsigned char* ws = a.ws;
    constexpr int I_IN = 16 * 128, I_UQ = 4 * 24, I_UK = 2 * 16, I_UV = 2 * 16, I_A = 8 * 32, I_B = 8 * 32, I_O = 16 * 32, I_GU = 32 * 16 * 64, I_D = 32 * 16 * 32;
    constexpr int NITEMS = I_IN + I_UQ + I_UK + I_UV + I_A + I_B + I_O + I_GU + I_D;
    for (int it = gw; it < NITEMS; it += NGW) {
        int r = it;
        if (r < I_IN) { tr_any(a.in[2], 4000, a.in[1], (bf16_t*)(ws + WS_WIN), 1024, 64 * (r / 128), 32 * (r % 128), CmIn{}, scr, lane); continue; } r -= I_IN;
        if (r < I_UQ) { tr_any(a.in[5], 768, a.in[3], (bf16_t*)(ws + WS_WUQ), 256, 64 * (r / 24), 32 * (r % 24), CmUq{}, scr, lane); continue; } r -= I_UQ;
        if (r < I_UK) { tr_any(a.in[6], 512, a.in[4], (bf16_t*)(ws + WS_WUKV), 128, 64 * (r / 16), 32 * (r % 16), CmId{0}, scr, lane); continue; } r -= I_UK;
        if (r < I_UV) { tr_any(a.in[7], 512, a.in[4], (bf16_t*)(ws + WS_WUKV), 128, 64 * (r / 16), 512 + 32 * (r % 16), CmId{512}, scr, lane); continue; } r -= I_UV;
        if (r < I_A) { tr_any(a.in[8], 1024, nullptr, (bf16_t*)(ws + WS_WA), 512, 64 * (r / 32), 32 * (r % 32), CmId{0}, scr, lane); continue; } r -= I_A;
        if (r < I_B) { tr_any(a.in[9], 1024, nullptr, (bf16_t*)(ws + WS_WB), 512, 64 * (r / 32), 32 * (r % 32), CmId{0}, scr, lane); continue; } r -= I_B;
        if (r < I_O) { tr_any(a.in[10], 1024, nullptr, (bf16_t*)(ws + WS_WO), 1024, 64 * (r / 32), 32 * (r % 32), CmId{0}, scr, lane); continue; } r -= I_O;
        if (r < I_GU) { const int e = r / 1024, q = r % 1024; tr_any(a.in[14] + (size_t)e * 1024 * 2048, 2048, a.in[11], (bf16_t*)(ws + WS_WGU) + (size_t)e * 2048 * 1024, 1024, 64 * (q / 64), 32 * (q % 64), CmGu{}, scr, lane); continue; } r -= I_GU;
        { const int e = r / 512, q = r % 512; tr_any(a.in[16] + (size_t)e * 1024 * 1024, 1024, nullptr, (bf16_t*)(ws + WS_WD) + (size_t)e * 1024 * 1024, 1024, 64 * (q / 32), 32 * (q % 32), CmId{0}, scr, lane); }
    }
    for (int m = gw; m < T; m += NGW) {
        const f32x4* xr = (const f32x4*)(a.in[0] + (size_t)m * DM) + lane;
        f32x4 v[4]; float s2 = 0.f;
#pragma unroll
        for (int j = 0; j < 4; ++j) { v[j] = xr[64 * j]; s2 += (v[j].x * v[j].x + v[j].y * v[j].y) + (v[j].z * v[j].z + v[j].w * v[j].w); }
        const float rstd = 1.f / sqrtf(wave_sum(s2) * (1.f / DM) + EPS);
        u32x2* o8 = (u32x2*)((bf16_t*)(ws + WS_XB) + (size_t)m * DM) + lane;
#pragma unroll
        for (int j = 0; j < 4; ++j) o8[64 * j] = (u32x2){pk2(v[j].x * rstd, v[j].y * rstd), pk2(v[j].z * rstd, v[j].w * rstd)};
    }
    const int gt = blockIdx.x * NTHREADS + threadIdx.x, NGT = gridDim.x * NTHREADS;
    for (int idx = gt; idx < SEQ * 16; idx += NGT) {
        ((f32x2*)(ws + WS_ROPE))[idx] = rope_cs(idx >> 4, idx & 15);
    }
    for (int idx = gt; idx < 1024 * 32; idx += NGT) ((float*)(ws + WS_WRP))[idx] = a.in[12][idx] * a.in[11][idx >> 5];
}

__device__ __forceinline__ void p2_stats(const Args& a, int wave, int lane) {
    const int gw = blockIdx.x * NWAVES + wave, NGW = gridDim.x * NWAVES; unsigned char* ws = a.ws;
    for (int m = gw; m < T; m += NGW) {
        const u32x2 q = ((const u32x2*)((const bf16_t*)(ws + WS_CQ) + (size_t)m * 256))[lane];
        const unsigned kv = ((const unsigned*)((const bf16_t*)(ws + WS_CKV) + (size_t)m * 128))[lane];
        const float a0 = bflo(q.x), a1 = bfhi(q.x), a2 = bflo(q.y), a3 = bfhi(q.y), b0 = bflo(kv), b1 = bfhi(kv);
        const float sq = wave_sum((a0 * a0 + a1 * a1) + (a2 * a2 + a3 * a3)), sk = wave_sum(b0 * b0 + b1 * b1);
        if (lane == 0) { ((float*)(ws + WS_RSTDQ))[m] = 1.f / sqrtf(sq * (1.f / 256.f) + EPS); ((float*)(ws + WS_RSTDKV))[m] = 1.f / sqrtf(sk * (1.f / 128.f) + EPS); }
        if (lane < 32) { const int b = m >> 14, sq2 = m & (SEQ - 1); const u32x4 kr = *(const u32x4*)((const bf16_t*)(ws + WS_KR) + (size_t)m * 32 + 8 * (lane & 3));
            *(u32x4*)((bf16_t*)(ws + WS_KIMG) + (size_t)((b * 8 + (lane >> 2)) * 256 + (sq2 >> 6)) * 6144 + (8 + (lane & 3)) * 512 + (sq2 & 63) * 8) = kr; }
        if (lane < 16) { const int b = m >> 14, sq2 = m & (SEQ - 1); const bf16_t* kp = (const bf16_t*)(ws + WS_KR) + (size_t)m * 32 + 16 * (lane & 1);
            float k0[8], k1[8]; unpack8(*(const u32x4*)kp, k0); unpack8(*(const u32x4*)(kp + 8), k1);
            *(u32x4*)(ws + WS_K8 + (size_t)((b * 8 + (lane >> 1)) * 256 + (sq2 >> 6)) * 6144 + (4 + (lane & 1)) * 1024 + (sq2 & 63) * 16) =
                (u32x4){pack4_fp8(k0[0], k0[1], k0[2], k0[3]), pack4_fp8(k0[4], k0[5], k0[6], k0[7]), pack4_fp8(k1[0], k1[1], k1[2], k1[3]), pack4_fp8(k1[4], k1[5], k1[6], k1[7])}; }
    }
}

__device__ __forceinline__ void p4_dilated(const Args& a, LAS unsigned char* lds, volatile LAS unsigned* MISC, int wave, int lane) {
    unsigned char* ws = a.ws;
    const int r32 = lane & 31, hi = lane >> 5;
    {
        LAS unsigned* nm = (LAS unsigned*)(MISC + MI_NRM);
        if (threadIdx.x < 32) nm[threadIdx.x] = 0u;
        __syncthreads();
        const bf16_t* QB = (const bf16_t*)(ws + WS_QB); const bf16_t* KIM = (const bf16_t*)(ws + WS_KIMG); const bf16_t* KR = (const bf16_t*)(ws + WS_KR);
        const int gw = blockIdx.x * NWAVES + wave, NGW = gridDim.x * NWAVES;
        for (int t = gw; t < T; t += NGW) {
            const int b = t >> 14;
            const u32x2* qp = (const u32x2*)(QB + (size_t)t * 768 + 12 * lane);
            const u32x2 q0 = qp[0], q1 = qp[1], q2 = qp[2];
            float sq = (bflo(q0.x) * bflo(q0.x) + bfhi(q0.x) * bfhi(q0.x)) + (bflo(q0.y) * bflo(q0.y) + bfhi(q0.y) * bfhi(q0.y));
            sq += (bflo(q1.x) * bflo(q1.x) + bfhi(q1.x) * bfhi(q1.x)) + (bflo(q1.y) * bflo(q1.y) + bfhi(q1.y) * bfhi(q1.y));
            sq += (bflo(q2.x) * bflo(q2.x) + bfhi(q2.x) * bfhi(q2.x)) + (bflo(q2.y) * bflo(q2.y) + bfhi(q2.y) * bfhi(q2.y));
            float kk8[8]; unpack8(*(const u32x4*)(KIM + (size_t)((b * 8 + (lane >> 3)) * 256 + ((t & (SEQ - 1)) >> 6)) * 6144 + (lane & 7) * 512 + (t & 63) * 8), kk8);
            float sk = 0.f;
#pragma unroll
            for (int j = 0; j < 8; ++j) sk += kk8[j] * kk8[j];
            float kr8[8]; unpack8(*(const u32x4*)(KR + (size_t)t * 32 + 8 * (lane & 3)), kr8);
            float sr = 0.f;
#pragma unroll
            for (int j = 0; j < 8; ++j) sr += kr8[j] * kr8[j];
            sr += __shfl_xor(sr, 1); sr += __shfl_xor(sr, 2);
            sq += __shfl_xor(sq, 1); sq += __shfl_xor(sq, 2); sq += __shfl_xor(sq, 4);
            sk += __shfl_xor(sk, 1); sk += __shfl_xor(sk, 2); sk += __shfl_xor(sk, 4);
            sk += sr;
            if ((lane & 7) == 0) { const int hh = lane >> 3;
                __hip_atomic_fetch_max(&nm[b * 8 + hh], __float_as_uint(sq), __ATOMIC_RELAXED, __HIP_MEMORY_SCOPE_WORKGROUP);
                __hip_atomic_fetch_max(&nm[16 + b * 8 + hh], __float_as_uint(sk), __ATOMIC_RELAXED, __HIP_MEMORY_SCOPE_WORKGROUP); }
        }
        __syncthreads();
        if (threadIdx.x < 32) __hip_atomic_fetch_max((unsigned*)(ws + WS_CTL) + CW_NRM + threadIdx.x, nm[threadIdx.x], __ATOMIC_RELAXED, __HIP_MEMORY_SCOPE_AGENT);
    }
    __syncthreads();
    const bf16_t* QA = (const bf16_t*)(ws + WS_QA); const bf16_t* KA = (const bf16_t*)(ws + WS_KA); const bf16_t* VA = (const bf16_t*)(ws + WS_VA);
    bf16_t* PO = (bf16_t*)(ws + WS_PARTO); float* PL = (float*)(ws + WS_PARTL);
    constexpr int DK = 0, DV = 49152, DWS = 98304;
    const unsigned lds0 = (unsigned)(uintptr_t)lds;
    LAS float* wsf = (LAS float*)(lds + DWS) + wave * 64;
    for (int un = blockIdx.x; un < NB * 8 * 192; un += gridDim.x) {
        const int bh = un / 192, within = un % 192, b = bh >> 3, h = bh & 7;
        int p, dil, res, blk, L;
        if (within < 64) { p = 0; dil = 1; res = 0; blk = within; L = SEQ; }
        else if (within < 128) { p = 1; dil = 4; res = (within - 64) >> 4; blk = (within - 64) & 15; L = SEQ / 4; }
        else { p = 2; dil = 16; res = (within - 128) >> 2; blk = (within - 128) & 3; L = SEQ / 16; }
        const size_t bo = (size_t)b * SEQ; const int u0w = 256 * blk - 64;
#pragma unroll
        for (int j = 0; j < 6; ++j) {
            int uk = u0w + 64 * j + lane; uk = uk < 0 ? 0 : (uk >= L ? L - 1 : uk);
            mla::glds16(KA + (bo + (size_t)(res + dil * uk)) * 512 + h * 64 + wave * 8, (unsigned)__builtin_amdgcn_readfirstlane(lds0 + DK + j * 8192 + wave * 1024));
            int uv = u0w + 64 * j + 16 * (wave & 3) + (lane >> 2); uv = uv < 0 ? 0 : (uv >= L ? L - 1 : uv);
            mla::glds16(VA + (bo + (size_t)(res + dil * uv)) * 512 + h * 64 + (wave >> 2) * 32 + (lane & 3) * 8, (unsigned)__builtin_amdgcn_readfirstlane(lds0 + DV + j * 8192 + wave * 1024));
        }
        const int ur = 256 * blk + 32 * wave;
        const size_t tq = bo + (size_t)(res + dil * (ur + r32));
        bf16x8 qf[4];
#pragma unroll
        for (int d0 = 0; d0 < 4; ++d0) qf[d0] = *(const bf16x8*)(QA + tq * 512 + h * 64 + 16 * d0 + 8 * hi);
        const float slope2d = __builtin_amdgcn_exp2f(-(float)(h + 1)) * LOG2E * (float)dil;
        asm volatile("s_waitcnt vmcnt(0)\n\ts_barrier" ::: "memory");
        f32x16 o0 = {}, o1 = {}; float m_run = -1e30f, l_run = 0.f;
#pragma unroll 1
        for (int ci = 0; ci < 5; ++ci) {
            const int c = ci == 0 ? 2 : ci == 1 ? 1 : ci == 2 ? 3 : ci == 3 ? 0 : 4;
            const int cw = wave + c, j = cw >> 1, n = cw & 1;
            const LAS char* kp = (const LAS char*)lds + DK + j * 8192 + hi * 1024 + (32 * n + r32) * 16;
            f32x16 s = {};
#pragma unroll
            for (int d0 = 0; d0 < 4; ++d0) s = __builtin_amdgcn_mfma_f32_32x32x16_bf16(*(const LAS bf16x8*)(kp + d0 * 2048), qf[d0], s, 0, 0, 0);
            { const float c0 = (float)(32 * c - 64); const int vb = ur - 64 + 32 * c;
#pragma unroll
              for (int r = 0; r < 16; ++r) { const float d = (float)(crow(r, hi) - r32); s[r] = s[r] - slope2d * fabsf(d + c0); }
              if (c == 0) {
#pragma unroll
                  for (int r = 0; r < 16; ++r) s[r] = (crow(r, hi) >= r32) ? s[r] : -1e30f; }
              if (c == 4) {
#pragma unroll
                  for (int r = 0; r < 16; ++r) s[r] = (crow(r, hi) <= r32) ? s[r] : -1e30f; }
              if (vb < 0 || vb + 31 >= L) {
#pragma unroll
                  for (int r = 0; r < 16; ++r) { const int v = vb + crow(r, hi); s[r] = (v >= 0 && v < L) ? s[r] : -1e30f; } } }
            float mx = s[0];
#pragma unroll
            for (int r = 1; r < 16; ++r) mx = fmaxf(mx, s[r]);
            mx = swapmax(mx);
            const float mn = fmaxf(m_run, mx), alpha = fexp2(m_run - mn);
            float ps = 0.f;
#pragma unroll
            for (int r = 0; r < 16; ++r) { s[r] = fexp2(s[r] - mn); ps += s[r]; }
            l_run = l_run * alpha + ps; m_run = mn;
            if (__any(alpha != 1.f)) {
                if (hi == 0) wsf[r32] = alpha;
#pragma unroll
                for (int r = 0; r < 16; ++r) { const float al = wsf[crow(r, hi)]; o0[r] *= al; o1[r] *= al; }
            }
            const u32x4 pw0 = {cvtpk(s[0], s[1]), cvtpk(s[2], s[3]), cvtpk(s[4], s[5]), cvtpk(s[6], s[7])};
            const u32x4 pw1 = {cvtpk(s[8], s[9]), cvtpk(s[10], s[11]), cvtpk(s[12], s[13]), cvtpk(s[14], s[15])};
            const bf16x8 pa0 = __builtin_bit_cast(bf16x8, pw0), pa1 = __builtin_bit_cast(bf16x8, pw1);
            const LAS char* vp = (const LAS char*)lds + DV + j * 8192 + n * 2048 + ((lane >> 4) & 1) * 32 + (lane & 3) * 8 + (4 * hi + ((lane & 15) >> 2)) * 64;
#pragma unroll
            for (int ks = 0; ks < 2; ++ks) {
                const s16x4 l0 = vtr(vp + ks * 1024), h0 = vtr(vp + ks * 1024 + 512), l1 = vtr(vp + 4096 + ks * 1024), h1 = vtr(vp + 4096 + ks * 1024 + 512);
                const bf16x8 v0 = {l0[0], l0[1], l0[2], l0[3], h0[0], h0[1], h0[2], h0[3]}, v1 = {l1[0], l1[1], l1[2], l1[3], h1[0], h1[1], h1[2], h1[3]};
                o0 = __builtin_amdgcn_mfma_f32_32x32x16_bf16(ks == 0 ? pa0 : pa1, v0, o0, 0, 0, 0);
                o1 = __builtin_amdgcn_mfma_f32_32x32x16_bf16(ks == 0 ? pa0 : pa1, v1, o1, 0, 0, 0);
            }
        }
        const float lt = swapsum(l_run);
        if (hi == 0) { wsf[32 + r32] = lt; PL[(((size_t)p * NB + b) * 8 + h) * SEQ + (res + dil * (ur + r32))] = m_run + __builtin_amdgcn_logf(lt); }
        asm volatile("s_waitcnt lgkmcnt(0)\n\ts_barrier" ::: "memory");
        { LAS bf16_t* stg = (LAS bf16_t*)(lds + DK) + wave * 2048;
#pragma unroll
          for (int r = 0; r < 16; ++r) { const int q = crow(r, hi); const float il = frcp(wsf[32 + q]);
              stg[q * 64 + r32] = (bf16_t)f2bf(o0[r] * il); stg[q * 64 + 32 + r32] = (bf16_t)f2bf(o1[r] * il); }
#pragma unroll
          for (int i = 0; i < 4; ++i) { const int row = i * 8 + (lane >> 3), ch = lane & 7; const u32x4 v = *(const LAS u32x4*)(stg + row * 64 + ch * 8);
              *(u32x4*)(PO + ((size_t)p * T + bo + (size_t)(res + dil * (ur + row))) * 512 + h * 64 + ch * 8) = v; } }
        asm volatile("s_waitcnt lgkmcnt(0)\n\ts_barrier" ::: "memory");
    }
}
__device__ __forceinline__ void p5_combine(const Args& a, int wave, int lane) {
    unsigned char* ws = a.ws; const bf16_t* PO = (const bf16_t*)(ws + WS_PARTO); const float* PL = (const float*)(ws + WS_PARTL); bf16_t* OA = (bf16_t*)(ws + WS_OA);
    const int gw = blockIdx.x * NWAVES + wave, NGW = gridDim.x * NWAVES;
    for (int it = gw; it < T; it += NGW) {
        const int t = it, b = t >> 14, s = t & (SEQ - 1), h = lane >> 3, ch = lane & 7;
        const float l0 = PL[(((size_t)0 * NB + b) * 8 + h) * SEQ + s], l1 = PL[(((size_t)1 * NB + b) * 8 + h) * SEQ + s], l2 = PL[(((size_t)2 * NB + b) * 8 + h) * SEQ + s];
        const float mx = fmaxf(fmaxf(l0, l1), l2); float w0 = fexp2(l0 - mx), w1 = fexp2(l1 - mx), w2 = fexp2(l2 - mx); const float iw = frcp(w0 + w1 + w2); w0 *= iw; w1 *= iw; w2 *= iw;
        float v0[8], v1[8], v2[8], o[8];
        unpack8(*(const u32x4*)(PO + ((size_t)0 * T + t) * 512 + h * 64 + ch * 8), v0);
        unpack8(*(const u32x4*)(PO + ((size_t)1 * T + t) * 512 + h * 64 + ch * 8), v1);
        unpack8(*(const u32x4*)(PO + ((size_t)2 * T + t) * 512 + h * 64 + ch * 8), v2);
#pragma unroll
        for (int j = 0; j < 8; ++j) o[j] = w0 * v0[j] + w1 * v1[j] + w2 * v2[j];
        *(u32x4*)(OA + (size_t)t * 512 + h * 64 + ch * 8) = pack8(o);
    }
}
__device__ __forceinline__ void p5_mla(const Args& a, LAS unsigned char* lds, int wave, int lane) {
    unsigned char* ws = a.ws;
    LAS char* vimg = (LAS char*)(lds + wave * 8192); LAS float* wsf = (LAS float*)(lds + wave * 8192 + 4096);
    const int r32 = lane & 31, hi = lane >> 5;
    const bf16_t* QB = (const bf16_t*)(ws + WS_QB); const bf16_t* KIM = (const bf16_t*)(ws + WS_KIMG); const bf16_t* VIM = (const bf16_t*)(ws + WS_VIMG);
    bf16_t* OB = (bf16_t*)(ws + WS_OB);
    const unsigned* nrm = (const unsigned*)(ws + WS_CTL) + CW_NRM;
    for (int un = blockIdx.x; un < NB * 8 * 64; un += gridDim.x) {
        const int qb = un & 63, h = (un >> 6) & 7, b = un >> 9;
        const float mq = __uint_as_float(__hip_atomic_load(nrm + b * 8 + h, __ATOMIC_RELAXED, __HIP_MEMORY_SCOPE_AGENT)), mk = __uint_as_float(__hip_atomic_load(nrm + 16 + b * 8 + h, __ATOMIC_RELAXED, __HIP_MEMORY_SCOPE_AGENT));
        bool fast = (mq * mk < 3600.f) && (mq < 700.f) && (mk < 160000.f);
#ifdef MLA_FORCE_GENERAL
        fast = false;
#endif
#ifdef MLA_BF16_FAST
        if (__builtin_amdgcn_readfirstlane((int)fast)) mla::mla_unit(b, h, qb, QB, KIM + (size_t)(b * 8 + h) * 256 * 6144, VIM + (size_t)(b * 8 + h) * 256 * 4096, OB, (LAS char*)lds);
#else
        if (__builtin_amdgcn_readfirstlane((int)fast)) mla8::mla8_unit(b, h, qb, (const unsigned char*)(ws + WS_Q8), (const unsigned char*)(ws + WS_K8) + (size_t)(b * 8 + h) * 256 * 6144, VIM + (size_t)(b * 8 + h) * 256 * 4096, OB, (LAS char*)lds);
#endif
    }
    for (int un = blockIdx.x; un < NB * 8 * 64; un += gridDim.x) {
        const int qb = un & 63, h = (un >> 6) & 7, b = un >> 9;
        const float mq = __uint_as_float(__hip_atomic_load(nrm + b * 8 + h, __ATOMIC_RELAXED, __HIP_MEMORY_SCOPE_AGENT)), mk = __uint_as_float(__hip_atomic_load(nrm + 16 + b * 8 + h, __ATOMIC_RELAXED, __HIP_MEMORY_SCOPE_AGENT));
        bool fast = (mq * mk < 3600.f) && (mq < 700.f) && (mk < 160000.f);
#ifdef MLA_FORCE_GENERAL
        fast = false;
#endif
        if (!__builtin_amdgcn_readfirstlane((int)fast)) {
            const size_t bo = (size_t)b * SEQ, tq0 = bo + (size_t)qb * 256 + wave * 32;
            MlaKL kl; kl.K = KIM + (size_t)(b * 8 + h) * 256 * 6144; kl.V = VIM + (size_t)(b * 8 + h) * 256 * 4096;
            bf16x8 qf[6];
#pragma unroll
            for (int d0 = 0; d0 < 6; ++d0) qf[d0] = *(const bf16x8*)(QB + (tq0 + r32) * 768 + h * 96 + 16 * d0 + 8 * hi);
            AttnState st; wave_attn<6>(st, qf, kl, SEQ / 32, vimg, wsf, lane);
            (void)attn_finish(st, vimg, wsf, lane);
#pragma unroll
            for (int i = 0; i < 4; ++i) { const int row = i * 8 + (lane >> 3), ch = lane & 7; const u32x4 v = *(const LAS u32x4*)(vimg + row * 128 + ch * 16);
                *(u32x4*)(OB + (tq0 + row) * 512 + h * 64 + ch * 8) = v; }
        }
    }
}

__device__ __forceinline__ void p8_router(const Args& a, LAS unsigned char* lds, volatile LAS unsigned* MISC, int wave, int lane) {
    unsigned char* ws = a.ws; const float* x1 = a.out; const float* wrp = (const float*)(ws + WS_WRP); const float* br = a.in[13];
    LAS float* lg = (LAS float*)(lds + wave * 8192);
    LAS unsigned* hist = (LAS unsigned*)(MISC + MI_HIST);
    if (threadIdx.x < 32) hist[threadIdx.x] = 0u;
    __syncthreads();
    const int G = gridDim.x, i32 = lane & 31, hi = lane >> 5;
    for (int tb = wave * G + blockIdx.x; tb < T / 32; tb += G * NWAVES) {
        const int t = tb * 32 + i32;
        const float* xr = x1 + (size_t)t * DM + 512 * hi; const float* wr_ = wrp + (size_t)(512 * hi) * 32 + i32;
        f32x16 acc = {}; float ssq = 0.f;
#pragma unroll 4
        for (int s4 = 0; s4 < 128; ++s4) {
            const f32x4 xa = *(const f32x4*)(xr + 4 * s4);
            ssq += (xa.x * xa.x + xa.y * xa.y) + (xa.z * xa.z + xa.w * xa.w);
            acc = __builtin_amdgcn_mfma_f32_32x32x2f32(xa.x, wr_[(4 * s4 + 0) * 32], acc, 0, 0, 0);
            acc = __builtin_amdgcn_mfma_f32_32x32x2f32(xa.y, wr_[(4 * s4 + 1) * 32], acc, 0, 0, 0);
            acc = __builtin_amdgcn_mfma_f32_32x32x2f32(xa.z, wr_[(4 * s4 + 2) * 32], acc, 0, 0, 0);
            acc = __builtin_amdgcn_mfma_f32_32x32x2f32(xa.w, wr_[(4 * s4 + 3) * 32], acc, 0, 0, 0);
        }
        ssq = swapsum(ssq);
        const float rstd = 1.f / sqrtf(ssq * (1.f / DM) + EPS);
#pragma unroll
        for (int r = 0; r < 16; ++r) lg[crow(r, hi) * 33 + i32] = acc[r];
        asm volatile("s_waitcnt lgkmcnt(0)" ::: "memory");
        float v[32];
#pragma unroll
        for (int e = 0; e < 32; ++e) v[e] = lg[i32 * 33 + e] * rstd + br[e];
        int ti[4]; float tv[4];
#pragma unroll
        for (int k = 0; k < 4; ++k) {
            float best = v[0]; int bi = 0;
#pragma unroll
            for (int e = 1; e < 32; ++e) { const bool g = v[e] > best; best = g ? v[e] : best; bi = g ? e : bi; }
            ti[k] = bi; tv[k] = best;
#pragma unroll
            for (int e = 0; e < 32; ++e) v[e] = (e == bi) ? -3.0e38f : v[e];
        }
        const float e1 = __expf(tv[1] - tv[0]), e2 = __expf(tv[2] - tv[0]), e3 = __expf(tv[3] - tv[0]); const float inv = 1.f / (1.f + e1 + e2 + e3);
        const float gw[4] = {inv, e1 * inv, e2 * inv, e3 * inv};
        if (hi == 0) {
            ((float*)(ws + WS_RSTD2))[t] = rstd;
#pragma unroll
            for (int k = 0; k < 4; ++k) { const unsigned rk = __hip_atomic_fetch_add(&hist[ti[k]], 1u, __ATOMIC_RELAXED, __HIP_MEMORY_SCOPE_WORKGROUP);
                ((int*)(ws + WS_TOPI))[t * 4 + k] = ti[k]; ((float*)(ws + WS_GATEW))[t * 4 + k] = gw[k]; ((int*)(ws + WS_SRANK))[t * 4 + k] = (int)rk; }
        }
        asm volatile("s_waitcnt lgkmcnt(0)" ::: "memory");
    }
    __syncthreads();
    if (threadIdx.x < 32) {
        const unsigned c = hist[threadIdx.x];
        const unsigned base = __hip_atomic_fetch_add((unsigned*)(ws + WS_CTL) + CW_GCOUNT + threadIdx.x, c, __ATOMIC_RELAXED, __HIP_MEMORY_SCOPE_AGENT);
        ((int*)(ws + WS_WGBASE))[blockIdx.x * 32 + threadIdx.x] = (int)base;
    }
}
__device__ __forceinline__ void moe_prefix(const Args& a, volatile LAS unsigned* MISC) {
    if (threadIdx.x < 64) {
        const unsigned* gc = (const unsigned*)(a.ws + WS_CTL) + CW_GCOUNT; const int e = threadIdx.x & 31;
        const int c = (int)__hip_atomic_load(gc + e, __ATOMIC_RELAXED, __HIP_MEMORY_SCOPE_AGENT), pad = (c + 255) & ~255;
        int inc = pad;
#pragma unroll
        for (int o = 1; o < 32; o <<= 1) { const int v = __shfl_up(inc, o, 32); if (e >= o) inc += v; }
        if (threadIdx.x < 32) { MISC[MI_PSTART + e] = (unsigned)(inc - pad); MISC[MI_TPRE + e] = (unsigned)((inc - pad) >> 8);
            if (e == 31) { MISC[MI_PSTART + 32] = (unsigned)inc; MISC[MI_TPRE + 32] = (unsigned)(inc >> 8); } }
    }
    __syncthreads();
}
__device__ __forceinline__ void p9_scatter(const Args& a, volatile LAS unsigned* MISC) {
    unsigned char* ws = a.ws; const int G = gridDim.x;
    moe_prefix(a, MISC);
    const int* topi = (const int*)(ws + WS_TOPI); const int* srank = (const int*)(ws + WS_SRANK); const int* wgbase = (const int*)(ws + WS_WGBASE); const float* rstd2 = (const float*)(ws + WS_RSTD2);
    int* pos = (int*)(ws + WS_POS); int* rowtok = (int*)(ws + WS_ROWTOK); float* rowscale = (float*)(ws + WS_ROWSCALE);
    for (int sl = blockIdx.x * NTHREADS + threadIdx.x; sl < NSLOT; sl += G * NTHREADS) {
        const int t = sl >> 2, e = topi[sl], wg = (t >> 5) % G;
        const int row = (int)MISC[MI_PSTART + e] + wgbase[wg * 32 + e] + srank[sl];
        pos[sl] = row; rowtok[row] = t; rowscale[row] = rstd2[t];
    }
    if (blockIdx.x < 32) {
        const int e = blockIdx.x; const int c = (int)__hip_atomic_load((const unsigned*)(ws + WS_CTL) + CW_GCOUNT + e, __ATOMIC_RELAXED, __HIP_MEMORY_SCOPE_AGENT);
        const int r0 = (int)MISC[MI_PSTART + e] + c, r1 = (int)MISC[MI_PSTART + e + 1];
        for (int r = r0 + threadIdx.x; r < r1; r += NTHREADS) { rowtok[r] = 0; rowscale[r] = 0.f; }
    }
}
__device__ __forceinline__ void p12_final(const Args& a, int wave, int lane) {
    unsigned char* ws = a.ws; const int gw = blockIdx.x * NWAVES + wave, NGW = gridDim.x * NWAVES;
    const int* pos = (const int*)(ws + WS_POS); const float* gatew = (const float*)(ws + WS_GATEW); const bf16_t* Y = (const bf16_t*)(ws + WS_Y);
    f32x4 g[4];
#pragma unroll
    for (int j = 0; j < 4; ++j) g[j] = ((const f32x4*)a.in[18])[lane + 64 * j];
    for (int t = gw; t < T; t += NGW) {
        f32x4* xr = (f32x4*)(a.out + (size_t)t * DM) + lane;
        f32x4 v[4];
#pragma unroll
        for (int j = 0; j < 4; ++j) v[j] = xr[64 * j];
#ifndef DBG_NO_MOE
#pragma unroll
        for (int k = 0; k < 4; ++k) {
            const int row = pos[t * 4 + k]; const float w = gatew[t * 4 + k];
            const u32x2* yr = (const u32x2*)(Y + (size_t)row * DM) + lane;
#pragma unroll
            for (int j = 0; j < 4; ++j) { const u32x2 y = yr[64 * j]; v[j].x += w * bflo(y.x); v[j].y += w * bfhi(y.x); v[j].z += w * bflo(y.y); v[j].w += w * bfhi(y.y); }
        }
#endif
        float s2 = 0.f;
#pragma unroll
        for (int j = 0; j < 4; ++j) s2 += (v[j].x * v[j].x + v[j].y * v[j].y) + (v[j].z * v[j].z + v[j].w * v[j].w);
        const float rstd = 1.f / sqrtf(wave_sum(s2) * (1.f / DM) + EPS);
#pragma unroll
        for (int j = 0; j < 4; ++j) xr[64 * j] = v[j] * rstd * g[j];
    }
}

#ifdef MLA_CHECK
constexpr size_t CK_BASE = 225 * MiB;
constexpr size_t CK_CKVN = CK_BASE, CK_KRR = CK_CKVN + (size_t)T * 128 * 4, CK_KN = CK_KRR + (size_t)T * 32 * 4, CK_VV = CK_KN + (size_t)T * 512 * 4, CK_QS = CK_VV + (size_t)T * 512 * 4;
constexpr int CK_NS = 16;
constexpr size_t CK_OBS = 224 * MiB;
__device__ __forceinline__ int ck_tok(int i) { const int tb[16] = {0, 1, 255, 256, 4097, 8191, 12345, 16383, 16384, 16385, 20000, 24575, 24576, 30001, 32766, 32767}; return tb[i]; }
__device__ __forceinline__ float blk_sum(float v, float* red) {
    v = wave_sum(v); __syncthreads(); if ((threadIdx.x & 63) == 0) red[threadIdx.x >> 6] = v; __syncthreads(); return red[0] + red[1] + red[2] + red[3];
}
__global__ void __launch_bounds__(256) ck_kv(const float* x, const float* g1, const float* w_in, const float* gkv, const float* w_uk, const float* w_uv, unsigned char* ws) {
    __shared__ float hn[1024]; __shared__ float red[4]; __shared__ float c[160]; __shared__ float cn[128];
    const int t = blockIdx.x, tid = threadIdx.x;
    float s2 = 0.f; for (int k = tid; k < 1024; k += 256) { const float v = x[(size_t)t * 1024 + k]; s2 += v * v; }
    const float rstd = 1.f / sqrtf(blk_sum(s2, red) / 1024.f + EPS);
    for (int k = tid; k < 1024; k += 256) hn[k] = x[(size_t)t * 1024 + k] * rstd * g1[k];
    __syncthreads();
    if (tid < 160) { float acc = 0.f; for (int k = 0; k < 1024; ++k) acc += hn[k] * w_in[(size_t)k * 4000 + 1792 + tid]; c[tid] = acc; }
    __syncthreads();
    const float q2 = blk_sum(tid < 128 ? c[tid] * c[tid] : 0.f, red); const float r2 = 1.f / sqrtf(q2 / 128.f + EPS);
    if (tid < 128) cn[tid] = c[tid] * r2 * gkv[tid];
    if (tid < 16) { const f32x2 cs = rope_cs(t & (SEQ - 1), tid); const float x1 = c[128 + tid], x2 = c[128 + 16 + tid];
        ((float*)(ws + CK_KRR))[(size_t)t * 32 + tid] = x1 * cs.x - x2 * cs.y; ((float*)(ws + CK_KRR))[(size_t)t * 32 + 16 + tid] = x2 * cs.x + x1 * cs.y; }
    __syncthreads();
    for (int o = tid; o < 512; o += 256) { float a = 0.f, b = 0.f; for (int k = 0; k < 128; ++k) { a += cn[k] * w_uk[(size_t)k * 512 + o]; b += cn[k] * w_uv[(size_t)k * 512 + o]; }
        ((float*)(ws + CK_KN))[(size_t)t * 512 + o] = a; ((float*)(ws + CK_VV))[(size_t)t * 512 + o] = b; }
}
__global__ void __launch_bounds__(256) ck_q(const float* x, const float* g1, const float* w_in, const float* gq, const float* w_uq, unsigned char* ws) {
    __shared__ float hn[1024]; __shared__ float red[4]; __shared__ float c[256]; __shared__ float qq[768];
    const int t = ck_tok(blockIdx.x), tid = threadIdx.x;
    float s2 = 0.f; for (int k = tid; k < 1024; k += 256) { const float v = x[(size_t)t * 1024 + k]; s2 += v * v; }
    const float rstd = 1.f / sqrtf(blk_sum(s2, red) / 1024.f + EPS);
    for (int k = tid; k < 1024; k += 256) hn[k] = x[(size_t)t * 1024 + k] * rstd * g1[k];
    __syncthreads();
    { float acc = 0.f; for (int k = 0; k < 1024; ++k) acc += hn[k] * w_in[(size_t)k * 4000 + 1536 + tid]; c[tid] = acc; }
    __syncthreads();
    const float q2 = blk_sum(c[tid] * c[tid], red); const float r2 = 1.f / sqrtf(q2 / 256.f + EPS);
    __syncthreads(); c[tid] = c[tid] * r2 * gq[tid]; __syncthreads();
    for (int o = tid; o < 768; o += 256) { float a = 0.f; for (int k = 0; k < 256; ++k) a += c[k] * w_uq[(size_t)k * 768 + o]; qq[o] = a; }
    __syncthreads();
    if (tid < 128) { const int hh = tid >> 4, i = tid & 15; const f32x2 cs = rope_cs(t & (SEQ - 1), i); const float x1 = qq[hh * 96 + 64 + i], x2 = qq[hh * 96 + 80 + i];
        qq[hh * 96 + 64 + i] = x1 * cs.x - x2 * cs.y; qq[hh * 96 + 80 + i] = x2 * cs.x + x1 * cs.y; }
    __syncthreads();
    for (int o = tid; o < 768; o += 256) ((float*)(ws + CK_QS))[(size_t)blockIdx.x * 768 + o] = qq[o] * 0.10206207261596577f;
}
__global__ void __launch_bounds__(256) ck_attn(unsigned char* ws, unsigned* flag) {
    __shared__ float q[96]; __shared__ float red[4]; __shared__ float part[256]; __shared__ float sc[SEQ];
    const int si = blockIdx.x >> 3, h = blockIdx.x & 7, t = ck_tok(si), b = t >> 14, tid = threadIdx.x;
    const float* KN = (const float*)(ws + CK_KN); const float* VV = (const float*)(ws + CK_VV); const float* KRR = (const float*)(ws + CK_KRR);
    if (tid < 96) q[tid] = ((const float*)(ws + CK_QS))[(size_t)si * 768 + h * 96 + tid];
    __syncthreads();
    float mx = -1e30f;
    for (int s = tid; s < SEQ; s += 256) { const size_t ts = (size_t)b * SEQ + s; float a = 0.f; for (int e = 0; e < 64; ++e) a += q[e] * KN[ts * 512 + h * 64 + e]; for (int e = 0; e < 32; ++e) a += q[64 + e] * KRR[ts * 32 + e]; sc[s] = a; mx = fmaxf(mx, a); }
    for (int o = 1; o < 64; o <<= 1) mx = fmaxf(mx, __shfl_xor(mx, o));
    __syncthreads(); if ((tid & 63) == 0) red[tid >> 6] = mx; __syncthreads(); mx = fmaxf(fmaxf(red[0], red[1]), fmaxf(red[2], red[3])); __syncthreads();
    float l = 0.f;
    for (int s = tid; s < SEQ; s += 256) { const float p = expf(sc[s] - mx); sc[s] = p; l += p; }
    l = blk_sum(l, red);
    const int e = tid & 63, g = tid >> 6; float o = 0.f;
    for (int s = g; s < SEQ; s += 4) o += sc[s] * VV[((size_t)b * SEQ + s) * 512 + h * 64 + e];
    part[tid] = o; __syncthreads();
    if (tid < 64) { const float ref = (part[tid] + part[64 + tid] + part[128 + tid] + part[192 + tid]) / l, got = bf2f(((const bf16_t*)(ws + CK_OBS))[(size_t)si * 512 + h * 64 + tid]);
        atomicMax(flag, __float_as_uint(fabsf(ref - got))); atomicMax(flag + 1, __float_as_uint(fabsf(ref))); }
}
__global__ void ck_apply(float* out, const unsigned* flag) {
    const float d = __uint_as_float(flag[0]), r = __uint_as_float(flag[1]);
    const bool bad = !(r > 0.f) || !(d <= MLA_CHECK_TOL * r);
    if (bad) for (size_t i = (size_t)blockIdx.x * blockDim.x + threadIdx.x; i < (size_t)T * DM; i += (size_t)gridDim.x * blockDim.x) out[i] = __builtin_nanf("");
}
#endif

constexpr int N_PHASES = 13;
#ifndef REP0
#define REP0 1
#endif
#ifndef REP1
#define REP1 1
#endif
#ifndef REP3
#define REP3 1
#endif
#ifndef REP5
#define REP5 1
#endif
#ifndef REP7
#define REP7 1
#endif
#ifndef REP10
#define REP10 1
#endif
#ifndef REP11
#define REP11 1
#endif
#ifndef MK_ONE_LAUNCH
#define MK_ONE_LAUNCH 0
#endif
__global__ void __launch_bounds__(NTHREADS, 2) fwd(Args args) {
    extern __shared__ __attribute__((aligned(16))) unsigned char lds_raw[];
    LAS unsigned char* lds = (LAS unsigned char*)lds_raw;
    volatile LAS unsigned* MISC = (volatile LAS unsigned*)(lds + MISC_OFF);
    const int tid = threadIdx.x, lane = tid & 63, wave = __builtin_amdgcn_readfirstlane(tid >> 6);
    const int G = gridDim.x, bx = blockIdx.x;
    unsigned char* ws = args.ws;
    for (int u = tid; u < (LDS_BYTES - RING_BYTES) / 4; u += NTHREADS) ((LAS unsigned*)(lds + RING_BYTES))[u] = 0u;
    __syncthreads();
    XcdBarrier bar; bar.bar = (unsigned*)(ws + WS_CTL) + CW_BAR; bar.x = 0; bar.st = nullptr;
    if (MK_ONE_LAUNCH) bar = xcd_barrier_post((unsigned*)(ws + WS_CTL) + CW_BAR, MISC + MI_BAR);
    const int lo = args.ph_lo, hi = args.ph_hi;
#ifdef ONLY_PHASE
#define IN(k) ((k) == ONLY_PHASE && lo <= (k) && (k) < hi)
#else
#define IN(k) (lo <= (k) && (k) < hi)
#endif
#define SEAM(k) do { if (IN(k) && IN((k) + 1)) xcd_barrier(bar); } while (0)

    if (IN(0)) { p0_prologue(args, lds, wave, lane);
#if REP0 > 1
        p0_prologue(args, lds, wave, lane);
#endif
    } SEAM(0);
#define PH1_BODY { pg8::DenseSched S; S.init((const bf16_t*)(ws + WS_XB), (const bf16_t*)(ws + WS_WIN), T, NIN, 1024, G, bx); EpiInProj E{ws}; \
        pg8::gemm_phase2<EpiInProj, pg8::DenseSched, true>(lds, 1024, S, E); }
    if (IN(1)) { PH1_BODY
#if REP1 > 1
        PH1_BODY
#endif
    } SEAM(1);
    if (IN(2)) { p2_stats(args, wave, lane); } SEAM(2);
#define PH3_BODY { { pg8::DenseSched S; S.init((const bf16_t*)(ws + WS_CQ), (const bf16_t*)(ws + WS_WUQ), T, 768, 256, G, bx); EpiQ E{ws}; \
          pg8::gemm_phase2<EpiQ, pg8::DenseSched, true>(lds, 256, S, E); } \
        { pg8::DenseSched S; S.init((const bf16_t*)(ws + WS_CKV), (const bf16_t*)(ws + WS_WUKV), T, 1024, 128, G, bx); EpiKV E{ws}; \
          pg8::gemm_phase2<EpiKV, pg8::DenseSched, true>(lds, 128, S, E); } }
    if (IN(3)) { PH3_BODY
#if REP3 > 1
        PH3_BODY
#endif
    } SEAM(3);
    if (IN(4)) { p4_dilated(args, lds, MISC, wave, lane);
#ifdef REP_DIL
        p4_dilated(args, lds, MISC, wave, lane);
#endif
    } SEAM(4);
    if (IN(5)) { p5_combine(args, wave, lane); p5_mla(args, lds, wave, lane);
#ifdef REP_MLA
        p5_mla(args, lds, wave, lane);
#endif
    } SEAM(5);
#ifdef MLA_CHECK
    if (IN(6) && bx == 0) { for (int i = tid; i < CK_NS * 512; i += NTHREADS) ((bf16_t*)(ws + CK_OBS))[i] = ((const bf16_t*)(ws + WS_OB))[(size_t)ck_tok(i >> 9) * 512 + (i & 511)]; }
#endif
    if (IN(6)) {
        { pg8::DenseSched S; S.init((const bf16_t*)(ws + WS_OA), (const bf16_t*)(ws + WS_WA), T, 1024, 512, G, bx); EpiGate<false> E{ws};
          pg8::gemm_phase2<EpiGate<false>, pg8::DenseSched, true>(lds, 512, S, E); }
        { pg8::DenseSched S; S.init((const bf16_t*)(ws + WS_OB), (const bf16_t*)(ws + WS_WB), T, 1024, 512, G, bx); EpiGate<true> E{ws};
          pg8::gemm_phase2<EpiGate<true>, pg8::DenseSched, true>(lds, 512, S, E); }
    } SEAM(6);
#define PH7_BODY { pg8::DenseSched S; S.init((const bf16_t*)(ws + WS_MERGED), (const bf16_t*)(ws + WS_WO), T, 1024, 1024, G, bx); EpiResid E{ws, args.in[0], args.out}; \
        pg8::gemm_phase2<EpiResid, pg8::DenseSched, true>(lds, 1024, S, E); }
    if (IN(7)) { PH7_BODY
#if REP7 > 1
        PH7_BODY
#endif
    } SEAM(7);
    if (IN(8)) { p8_router(args, lds, MISC, wave, lane); } SEAM(8);
    if (IN(9)) { p9_scatter(args, MISC); } SEAM(9);
#define PH10_BODY { moe_prefix(args, MISC); \
        pg8::MoeSched<3, true> S; S.tpre = (const LAS int*)(MISC + MI_TPRE); S.ntiles = (int)MISC[MI_TPRE + 32]; S.G = G; S.c = bx; S.K = 1024; \
        S.A = (const char*)(ws + WS_H2); S.Bt = (const char*)(ws + WS_WGU); S.estride = (size_t)2048 * 1024 * 2; S.row_tok = (const int*)(ws + WS_ROWTOK); \
        EpiSwiglu E{ws, args.in[15]}; \
        pg8::gemm_phase2<EpiSwiglu, pg8::MoeSched<3, true>, true>(lds, 1024, S, E); }
    if (IN(10)) { PH10_BODY
#if REP10 > 1
        PH10_BODY
#endif
    } SEAM(10);
#define PH11_BODY { moe_prefix(args, MISC); \
        pg8::MoeSched<2, false> S; S.tpre = (const LAS int*)(MISC + MI_TPRE); S.ntiles = (int)MISC[MI_TPRE + 32]; S.G = G; S.c = bx; S.K = 1024; \
        S.A = (const char*)(ws + WS_ACT); S.Bt = (const char*)(ws + WS_WD); S.estride = (size_t)1024 * 1024 * 2; S.row_tok = nullptr; \
        EpiDown E{ws, args.in[17]}; \
        pg8::gemm_phase2<EpiDown, pg8::MoeSched<2, false>, true>(lds, 1024, S, E); }
    if (IN(11)) { PH11_BODY
#if REP11 > 1
        PH11_BODY
#endif
    } SEAM(11);
    if (IN(12)) { p12_final(args, wave, lane); }
#undef IN
#undef SEAM
}

extern "C" void kernel_launch(void* const* d_in, const int* in_sizes, int n_in, void* d_out, int out_size, void* d_ws, size_t ws_size, hipStream_t stream) {
    static int grid = 0;
    if (grid == 0) {
        if (n_in != 19 || in_sizes[0] != T * DM || out_size != T * DM || ws_size < WS_END) { fprintf(stderr, "kernel_launch: unexpected shapes (n_in %d, in0 %d, out %d, ws %zu); nothing launched\n", n_in, n_in > 0 ? in_sizes[0] : -1, out_size, ws_size); grid = -1; return; }
        int dev = 0, cus = 0, per_cu = 0;
        if (hipGetDevice(&dev) != hipSuccess || hipDeviceGetAttribute(&cus, hipDeviceAttributeMultiprocessorCount, dev) != hipSuccess) { grid = -1; return; }
        if (hipFuncSetAttribute((const void*)fwd, hipFuncAttributeMaxDynamicSharedMemorySize, LDS_BYTES) != hipSuccess) { fprintf(stderr, "kernel_launch: hipFuncSetAttribute failed\n"); grid = -1; return; }
        if (hipOccupancyMaxActiveBlocksPerMultiprocessor(&per_cu, (const void*)fwd, NTHREADS, LDS_BYTES) != hipSuccess || per_cu < 1) fprintf(stderr, "kernel_launch: occupancy query reports %d\n", per_cu);
        (void)hipGetLastError();
        grid = cus;
    }
    if (grid < 0) return;
    if (hipMemsetAsync((char*)d_ws + WS_CTL, 0, CTL_ZERO_BYTES, stream) != hipSuccess) { fprintf(stderr, "kernel_launch: memset failed\n"); return; }
    Args a{};
    for (int i = 0; i < 19; ++i) a.in[i] = (const float*)d_in[i];
    a.out = (float*)d_out; a.ws = (unsigned char*)d_ws; a.li = 0; a.pad = 0;
#if MK_ONE_LAUNCH
    a.ph_lo = 0; a.ph_hi = N_PHASES;
    hipLaunchKernelGGL(fwd, dim3(grid), dim3(NTHREADS), LDS_BYTES, stream, a);
#else
    for (int p = 0; p < N_PHASES; ++p) {
        a.ph_lo = p; a.ph_hi = p + 1; hipLaunchKernelGGL(fwd, dim3(grid), dim3(NTHREADS), LDS_BYTES, stream, a); }

#endif
#ifdef MLA_CHECK
    {   unsigned* flag = (unsigned*)((unsigned char*)d_ws + WS_CTL) + 16384;
        hipLaunchKernelGGL(ck_kv, dim3(T), dim3(256), 0, stream, a.in[0], a.in[1], a.in[2], a.in[4], a.in[6], a.in[7], (unsigned char*)d_ws);
        hipLaunchKernelGGL(ck_q, dim3(CK_NS), dim3(256), 0, stream, a.in[0], a.in[1], a.in[2], a.in[3], a.in[5], (unsigned char*)d_ws);
        hipLaunchKernelGGL(ck_attn, dim3(CK_NS * 8), dim3(256), 0, stream, (unsigned char*)d_ws, flag);
        hipLaunchKernelGGL(ck_apply, dim3(1024), dim3(256), 0, stream, (float*)d_out, (const unsigned*)flag); }
#endif
    const hipError_t le = hipPeekAtLastError();
    if (le != hipSuccess) fprintf(stderr, "kernel_launch: launch failed: %s\n", hipGetErrorName(le));
}
```

```cpp
#define MK_ONE_LAUNCH 1
#include <hip/hip_runtime.h>
#include <cstdio>
#include <cstdint>

#define LAS __attribute__((address_space(3)))
#define GAS __attribute__((address_space(1)))
typedef unsigned short bf16_t;
typedef short bf16x8 __attribute__((ext_vector_type(8)));
typedef short s16x4 __attribute__((ext_vector_type(4)));
typedef float f32x2 __attribute__((ext_vector_type(2)));
typedef float f32x4 __attribute__((ext_vector_type(4)));
typedef float f32x16 __attribute__((ext_vector_type(16)));
typedef unsigned u32x2 __attribute__((ext_vector_type(2)));
typedef unsigned u32x4 __attribute__((ext_vector_type(4)));

constexpr int NB = 2, SEQ = 16384, T = NB * SEQ, DM = 1024;
constexpr int NIN = 4096;
constexpr int NEXP = 32, TOPK = 4, NSLOT = T * TOPK, NPMAX = NSLOT + NEXP * 256;
constexpr float EPS = 1e-5f, LOG2E = 1.4426950408889634f;
constexpr int NWAVES = 8, NTHREADS = 512;

constexpr size_t MiB = 1u << 20;
constexpr size_t WS_CTL = 0, CTL_ZERO_BYTES = 1 * MiB;
constexpr size_t WS_WIN = 1 * MiB;
constexpr size_t WS_WUQ = 9 * MiB;
constexpr size_t WS_WUKV = 10 * MiB;
constexpr size_t WS_WA = 11 * MiB, WS_WB = 12 * MiB;
constexpr size_t WS_WO = 13 * MiB;
constexpr size_t WS_ROPE = 15 * MiB;
constexpr size_t WS_WGU = 17 * MiB;
constexpr size_t WS_WD = 145 * MiB;
constexpr size_t WS_SMALL = 209 * MiB;
constexpr size_t WS_RSTDQ = WS_SMALL, WS_RSTDKV = WS_RSTDQ + T * 4, WS_RSTD2 = WS_RSTDKV + T * 4;
constexpr size_t WS_TOPI = WS_RSTD2 + T * 4, WS_GATEW = WS_TOPI + (size_t)NSLOT * 4, WS_SRANK = WS_GATEW + (size_t)NSLOT * 4, WS_POS = WS_SRANK + (size_t)NSLOT * 4;
constexpr size_t WS_ROWTOK = WS_POS + (size_t)NSLOT * 4, WS_ROWSCALE = WS_ROWTOK + 1 * MiB, WS_WGBASE = WS_ROWSCALE + 1 * MiB;
constexpr size_t WS_WRP = WS_WGBASE + 64 * 1024;
constexpr size_t WS_PARTL = WS_WRP + 128 * 1024;
static_assert(WS_PARTL + 3 * MiB <= 225 * MiB, "small region");
constexpr size_t WS_XB = 225 * MiB;
constexpr size_t WS_QA = 289 * MiB, WS_KA = 321 * MiB, WS_VA = 353 * MiB;
constexpr size_t WS_CQ = 385 * MiB;
constexpr size_t WS_CKV = 401 * MiB;
constexpr size_t WS_KR = 409 * MiB;
constexpr size_t WS_GA = 411 * MiB, WS_GB = 475 * MiB;
constexpr size_t WS_K8 = 225 * MiB;
constexpr size_t WS_Q8 = 249 * MiB;
constexpr size_t WS_ACT = 225 * MiB;
static_assert(WS_ACT + (size_t)NPMAX * 2048 <= 539 * MiB, "ACT overlay");
constexpr size_t WS_QB = 539 * MiB;
constexpr size_t WS_KIMG = 587 * MiB;
constexpr size_t WS_VIMG = 635 * MiB;
constexpr size_t WS_OA = 667 * MiB, WS_OB = 699 * MiB;
constexpr size_t WS_MERGED = 731 * MiB;
constexpr size_t WS_PARTO = 795 * MiB;
constexpr size_t WS_H2 = 891 * MiB;
constexpr size_t WS_Y = 539 * MiB;
static_assert(WS_Y + (size_t)NPMAX * 2048 <= WS_H2, "Y overlay");
constexpr size_t WS_END = 955 * MiB;
constexpr int CW_TMO = 0, CW_BAR = 4096, CW_GCOUNT = 8192, CW_NRM = 8256;

constexpr int RING_BYTES = 131072, MISC_OFF = RING_BYTES + 320, LDS_BYTES = 147456;
constexpr int MI_BAR = 8, MI_TPRE = 16, MI_HIST = 64, MI_PSTART = 96, MI_NRM = 160;

__device__ __forceinline__ unsigned f2bf(float f) { unsigned u = __builtin_bit_cast(unsigned, f); return (u + 0x7fffu + ((u >> 16) & 1u)) >> 16; }
__device__ __forceinline__ unsigned pk2(float lo, float hi) { return f2bf(lo) | (f2bf(hi) << 16); }
__device__ __forceinline__ float bf2f(unsigned short b) { return __builtin_bit_cast(float, (unsigned)b << 16); }
__device__ __forceinline__ float bflo(unsigned w) { return __builtin_bit_cast(float, w << 16); }
__device__ __forceinline__ float bfhi(unsigned w) { return __builtin_bit_cast(float, w & 0xffff0000u); }
typedef __bf16 bf16x2_t __attribute__((ext_vector_type(2)));
__device__ __forceinline__ unsigned cvtpk(float lo, float hi) { const f32x2 v = {lo, hi}; const bf16x2_t b = __builtin_convertvector(v, bf16x2_t); return __builtin_bit_cast(unsigned, b); }
__device__ __forceinline__ unsigned pack4_fp8(float a, float b, float c, float d) { int w = 0; w = __builtin_amdgcn_cvt_pk_fp8_f32(a, b, w, false); w = __builtin_amdgcn_cvt_pk_fp8_f32(c, d, w, true); return (unsigned)w; }
__device__ __forceinline__ float wave_sum(float v) {
#pragma unroll
    for (int o = 1; o < 64; o <<= 1) v += __shfl_xor(v, o);
    return v;
}
__device__ __forceinline__ float fexp2(float x) { return __builtin_amdgcn_exp2f(x); }
__device__ __forceinline__ float frcp(float x) { return __builtin_amdgcn_rcpf(x); }
__device__ __forceinline__ float sigmoidf_(float z) { return frcp(1.f + fexp2(-z * LOG2E)); }
__device__ __forceinline__ int crow(int r, int hi) { return (r & 3) + 8 * (r >> 2) + 4 * hi; }
__device__ __forceinline__ u32x4 pack8(const float (&v)[8]) { u32x4 w; w.x = cvtpk(v[0], v[1]); w.y = cvtpk(v[2], v[3]); w.z = cvtpk(v[4], v[5]); w.w = cvtpk(v[6], v[7]); return w; }
__device__ __forceinline__ void unpack8(const u32x4 w, float (&v)[8]) { v[0] = bflo(w.x); v[1] = bfhi(w.x); v[2] = bflo(w.y); v[3] = bfhi(w.y); v[4] = bflo(w.z); v[5] = bfhi(w.z); v[6] = bflo(w.w); v[7] = bfhi(w.w); }
__device__ __forceinline__ f32x2 rope_cs(int pos, int i) {
    const float inv = __builtin_powf(10000.f, -(float)i * (1.f / 16.f));
    const float ang = (float)pos * inv;
    double x = (double)ang; const double n = __builtin_rint(x * 0.15915494309189535); x = (x - n * 6.283185307179586) - n * 2.4492935982947064e-16;
    const double x2 = x * x; double sn = 1.0, cs = 1.0;
#pragma unroll
    for (int k = 13; k >= 1; --k) { sn = 1.0 - sn * x2 * (1.0 / (double)((2 * k) * (2 * k + 1))); cs = 1.0 - cs * x2 * (1.0 / (double)((2 * k - 1) * (2 * k))); }
    sn *= x;
    return (f32x2){(float)cs, (float)sn};
}

namespace pg8 {
constexpr int BM = 256, BK = 64, HALF = 128, HTB = HALF * BK * 2  , NXCD = 8, WGM = 8;
__host__ __device__ __forceinline__ int lds_byte(int r, int c) { const int st = (r >> 4) * 2 + (c >> 5), rr = r & 15, cc = c & 31, ob = rr * 64 + cc * 2; return st * 1024 + (ob ^ (((ob >> 9) & 1) << 5)); }
__host__ __device__ __forceinline__ void stage_rc(int b, int& R, int& C) { const int st = b / 1024, sb = b % 1024, swz = sb ^ (((sb >> 9) & 1) << 5); R = (st >> 1) * 16 + swz / 64; C = (st & 1) * 32 + (swz % 64) / 2; }
__host__ __device__ __forceinline__ int perm32(int rho) { const int n = rho >> 4, i = rho & 15; return 8 * (i >> 2) + 4 * n + (i & 3); }

struct Unit { int pm, pn, e; };

struct StaticOrder {
    int nM, nN, nwg, G, c;
    __host__ __device__ void init(int M, int N, int G_, int c_) { nM = M / BM; nN = N / BM; nwg = nM * nN; G = G_; c = c_; }
    __host__ __device__ bool next(int i, Unit& u) const {
        const long L = (long)i * G + c; if (L >= nwg) return false;
        int wgid = (int)L; { const int q = nwg / NXCD, r = nwg % NXCD, xcd = wgid % NXCD, off = wgid / NXCD; wgid = (xcd < r ? xcd * (q + 1) : r * (q + 1) + (xcd - r) * q) + off; }
        const int nig = WGM * nN, gid = wgid / nig, fm = gid * WGM, gsz = (nM - fm) < WGM ? (nM - fm) : WGM;
        u.pm = fm + ((wgid % nig) % gsz); u.pn = (wgid % nig) / gsz; u.e = 0; return true;
    }
};
struct DenseSched {
    static constexpr bool LATE = false;
    StaticOrder so; const char* A; const char* Bt; int K;
    __device__ __forceinline__ void prefetch_rows(const Unit&, LAS unsigned char*, int, int, int) const {}
    __device__ __forceinline__ void a_off_lds(const Unit&, const int (&)[2], const int (&)[2], LAS unsigned char*, int, unsigned (&)[2][2]) const {}
    __device__ __forceinline__ void init(const bf16_t* A_, const bf16_t* Bt_, int M, int N, int K_, int G, int c) { so.init(M, N, G, c); A = (const char*)A_; Bt = (const char*)Bt_; K = K_; }
    __device__ __forceinline__ bool next(int i, Unit& u) const { return so.next(i, u); }
    __device__ __forceinline__ const char* a_base(const Unit& u) const { return A + (size_t)u.pm * ((size_t)BM * K * 2); }
    __device__ __forceinline__ const char* b_base(const Unit& u) const { return Bt + (size_t)u.pn * ((size_t)BM * K * 2); }
    __device__ __forceinline__ void a_off(const Unit&, const int (&sR)[2], const int (&sC)[2], unsigned (&vo)[2][2]) const {
#pragma unroll
        for (int h = 0; h < 2; ++h)
#pragma unroll
            for (int i = 0; i < 2; ++i) vo[h][i] = (unsigned)((h * HALF + sR[i]) * K + sC[i]) * 2u;
    }
};
template <int NPN_SHIFT, bool GATHER>
struct MoeSched {
    static constexpr bool LATE = GATHER;
    static constexpr int TBL_OFF = 131072 + 4096;
    __device__ __forceinline__ void prefetch_rows(const Unit& u, LAS unsigned char* lds, int buf, int wid, int lane) const {
        if (wid < 4) __builtin_amdgcn_global_load_lds((const unsigned*)(row_tok + u.pm * BM + wid * 64 + lane), (LAS unsigned*)(lds + TBL_OFF + buf * 1024 + wid * 256), 4, 0, 0);
    }
    __device__ __forceinline__ void a_off_lds(const Unit&, const int (&sR)[2], const int (&sC)[2], LAS unsigned char* lds, int buf, unsigned (&vo)[2][2]) const {
        const LAS int* tb = (const LAS int*)(lds + TBL_OFF + buf * 1024);
#pragma unroll
        for (int h = 0; h < 2; ++h)
#pragma unroll
            for (int i = 0; i < 2; ++i) vo[h][i] = (unsigned)(tb[h * HALF + sR[i]] * K + sC[i]) * 2u;
    }
    const LAS int* tpre; int ntiles, G, c, K; const char* A; const char* Bt; size_t estride; const int* row_tok;
    __device__ __forceinline__ bool next(int i, Unit& u) const {
        const int L = i * G + c, g = L >> NPN_SHIFT; if (g >= ntiles) return false;
        int e = 0; while (e < 31 && tpre[e + 1] <= g) ++e;
        u.pm = g; u.pn = L & ((1 << NPN_SHIFT) - 1); u.e = e; return true;
    }
    __device__ __forceinline__ const char* a_base(const Unit& u) const { return GATHER ? A : A + (size_t)u.pm * ((size_t)BM * K * 2); }
    __device__ __forceinline__ const char* b_base(const Unit& u) const { return Bt + (size_t)u.e * estride + (size_t)u.pn * ((size_t)BM * K * 2); }
    __device__ __forceinline__ void a_off(const Unit& u, const int (&sR)[2], const int (&sC)[2], unsigned (&vo)[2][2]) const {
#pragma unroll
        for (int h = 0; h < 2; ++h)
#pragma unroll
            for (int i = 0; i < 2; ++i) {
                if (GATHER) { const int tok = row_tok[u.pm * BM + h * HALF + sR[i]]; vo[h][i] = (unsigned)(tok * K + sC[i]) * 2u; }
                else vo[h][i] = (unsigned)((h * HALF + sR[i]) * K + sC[i]) * 2u;
            }
    }
};

typedef int v8i_ __attribute__((ext_vector_type(8)));
__device__ __forceinline__ v8i_ cat16(const bf16x8 a, const bf16x8 b) { const u32x4 x = __builtin_bit_cast(u32x4, a), y = __builtin_bit_cast(u32x4, b); return (v8i_){(int)x.x, (int)x.y, (int)x.z, (int)x.w, (int)y.x, (int)y.y, (int)y.z, (int)y.w}; }
__device__ __forceinline__ v8i_ lds_ld32(const LAS unsigned char* p) { const u32x4 x = *(const LAS u32x4*)p, y = *(const LAS u32x4*)(p + 1024); return (v8i_){(int)x.x, (int)x.y, (int)x.z, (int)x.w, (int)y.x, (int)y.y, (int)y.z, (int)y.w}; }
template <class Epi, class Sched, bool ALIGN_EPI, bool FP8 = false, int SCALE_W = 127>
__device__ __forceinline__ void gemm_phase2(LAS unsigned char* lds, const int K_, const Sched& S, const Epi& E) {
    int K = K_; asm volatile("" : "+s"(K));
    const int tid = threadIdx.x, wid = __builtin_amdgcn_readfirstlane(tid >> 6), lane = tid & 63, wr = wid >> 2, wc = wid & 3, fr = lane & 15, fq = lane >> 4;
    const int nt = K / BK;
    int sR[2], sC[2]; unsigned voffB[2];
#pragma unroll
    for (int i = 0; i < 2; ++i) { int R, C; stage_rc(tid * 16 + i * 8192, R, C); sR[i] = R; sC[i] = C; const int Rb = Epi::PERM ? ((R & ~31) + perm32(R & 31)) : R; voffB[i] = (unsigned)(Rb * K + C) * 2u; }
    const size_t kstep = (size_t)(BK * 2);
    const size_t hstep = (size_t)HALF * K * 2;
    const unsigned ldsw = (unsigned)wid * 1024u;
    const int aoff = lds_byte(wr * 64 + fr, fq * 8), boff = lds_byte(wc * 32 + fr, fq * 8);
#define PG8_SA(b, h) (((b) * 2 + (h)) * HTB)
#define PG8_SB(b, h) ((4 + (b) * 2 + (h)) * HTB)
#define PG8_STAGE_B(bufoff, gbase) do { _Pragma("unroll") for (int _i = 0; _i < 2; ++_i) \
        __builtin_amdgcn_global_load_lds((const unsigned*)((const char*)(gbase) + voffB[_i]), (LAS unsigned*)(lds + (bufoff) + ldsw + _i * 8192), 16, 0, 0); } while (0)
#define PG8_STAGE_A(bufoff, gbase, o0, o1) do { \
        __builtin_amdgcn_global_load_lds((const unsigned*)((const char*)(gbase) + (o0)), (LAS unsigned*)(lds + (bufoff) + ldsw), 16, 0, 0); \
        __builtin_amdgcn_global_load_lds((const unsigned*)((const char*)(gbase) + (o1)), (LAS unsigned*)(lds + (bufoff) + ldsw + 8192), 16, 0, 0); } while (0)
#define PG8_LDA(dst, b, h) do { if constexpr (FP8) { _Pragma("unroll") for (int m = 0; m < 4; ++m) dst##8[m] = lds_ld32(lds + PG8_SA(b, h) + aoff + m * 2048); } else { _Pragma("unroll") for (int m = 0; m < 4; ++m) _Pragma("unroll") for (int k = 0; k < 2; ++k) dst[m][k] = *(const LAS bf16x8*)(lds + PG8_SA(b, h) + aoff + m * 2048 + k * 1024); } } while (0)
#define PG8_LDB(dst, b, h) do { if constexpr (FP8) { _Pragma("unroll") for (int n = 0; n < 2; ++n) dst##8[n] = lds_ld32(lds + PG8_SB(b, h) + boff + n * 2048); } else { _Pragma("unroll") for (int n = 0; n < 2; ++n) _Pragma("unroll") for (int k = 0; k < 2; ++k) dst[n][k] = *(const LAS bf16x8*)(lds + PG8_SB(b, h) + boff + n * 2048 + k * 1024); } } while (0)
#define PG8_MMA(ai, bj, At, Bt) do { __builtin_amdgcn_s_setprio(1); if constexpr (FP8) { _Pragma("unroll") for (int m = 0; m < 4; ++m) _Pragma("unroll") for (int n = 0; n < 2; ++n) \
        asm volatile("v_mfma_scale_f32_16x16x128_f8f6f4 %0, %1, %2, %0, %3, %4 op_sel_hi:[0,0,0]" : "+v"(acc[ai][bj][m][n]) : "v"(Bt##8[n]), "v"(At##8[m]), "v"(scw_), "v"(sca_)); } else { \
        _Pragma("unroll") for (int m = 0; m < 4; ++m) _Pragma("unroll") for (int n = 0; n < 2; ++n) _Pragma("unroll") for (int k = 0; k < 2; ++k) \
        acc[ai][bj][m][n] = __builtin_amdgcn_mfma_f32_16x16x32_bf16(Bt[n][k], At[m][k], acc[ai][bj][m][n], 0, 0, 0); } __builtin_amdgcn_s_setprio(0); } while (0)
#define PG8_WAIT_V(n) asm volatile("s_waitcnt vmcnt(" #n ")" ::: "memory")
#define PG8_WAIT_L(n) asm volatile("s_waitcnt lgkmcnt(" #n ")" ::: "memory")
#define PG8_BAR __builtin_amdgcn_s_barrier()
#define PG8_SCHED __builtin_amdgcn_sched_barrier(0)
    Unit cur, nxt; int ui = 0;
    if (!S.next(0, cur)) return;
    f32x4 acc[2][2][4][2];
#pragma unroll
    for (int a = 0; a < 2; ++a)
#pragma unroll
        for (int b = 0; b < 2; ++b)
#pragma unroll
            for (int m = 0; m < 4; ++m)
#pragma unroll
                for (int n = 0; n < 2; ++n) acc[a][b][m][n] = (f32x4){0.f, 0.f, 0.f, 0.f};
    bf16x8 At[4][2], B0[2][2], B1[2][2]; v8i_ At8[4], B08[2], B18[2];
    int scw_ = SCALE_W * 0x01010101, sca_ = 0x7f7f7f7f; asm volatile("" : "+v"(scw_), "+v"(sca_));
    unsigned voA[2][2], voN[2][2];
    S.a_off(cur, sR, sC, voA);
    const char* cA = S.a_base(cur); const char* cB = S.b_base(cur);
    PG8_STAGE_B(PG8_SB(0, 0), cB); PG8_STAGE_B(PG8_SB(0, 1), cB + hstep); PG8_STAGE_A(PG8_SA(0, 0), cA, voA[0][0], voA[0][1]); PG8_STAGE_A(PG8_SA(0, 1), cA, voA[1][0], voA[1][1]);
    if (wr == 1) PG8_BAR;
    PG8_WAIT_V(2); PG8_BAR;
    PG8_STAGE_B(PG8_SB(1, 0), cB + kstep); PG8_STAGE_A(PG8_SA(1, 0), cA + kstep, voA[0][0], voA[0][1]); PG8_STAGE_B(PG8_SB(1, 1), cB + hstep + kstep);
    PG8_WAIT_V(6); PG8_BAR;
    for (;;) {
        const bool has_next = S.next(ui + 1, nxt);
        const char* nA = cA; const char* nB = cB;
#pragma unroll
        for (int h = 0; h < 2; ++h)
#pragma unroll
            for (int i = 0; i < 2; ++i) voN[h][i] = voA[h][i];
        if (has_next) { nA = S.a_base(nxt); nB = S.b_base(nxt); if constexpr (Sched::LATE) S.prefetch_rows(nxt, lds, (ui + 1) & 1, wid, lane); else S.a_off(nxt, sR, sC, voN); }
        for (int t = 0; t < nt; t += 2) {
            const bool last = (t == nt - 2);
            if constexpr (Sched::LATE) { if (last && has_next) S.a_off_lds(nxt, sR, sC, lds, (ui + 1) & 1, voN); }
            const char* a1 = cA + (size_t)(t + 1) * kstep;
            const char* a2 = last ? nA : cA + (size_t)(t + 2) * kstep; const char* b2 = last ? nB : cB + (size_t)(t + 2) * kstep;
            const char* a3 = a2 + kstep; const char* b3 = b2 + kstep;
            const unsigned s00 = last ? voN[0][0] : voA[0][0], s01 = last ? voN[0][1] : voA[0][1], s10 = last ? voN[1][0] : voA[1][0], s11 = last ? voN[1][1] : voA[1][1];
            PG8_LDB(B0, 0, 0); PG8_LDB(B1, 0, 1); PG8_SCHED; PG8_LDA(At, 0, 0); PG8_STAGE_A(PG8_SA(1, 1), a1, voA[1][0], voA[1][1]);
            PG8_WAIT_V(8); PG8_WAIT_L(0); PG8_BAR; PG8_MMA(0, 0, At, B0); PG8_MMA(0, 1, At, B1); PG8_BAR; PG8_SCHED;
            PG8_LDA(At, 0, 1); PG8_STAGE_B(PG8_SB(0, 0), b2); PG8_STAGE_B(PG8_SB(0, 1), b2 + hstep); PG8_STAGE_A(PG8_SA(0, 0), a2, s00, s01);
            PG8_WAIT_V(8); PG8_WAIT_L(0); PG8_BAR; PG8_MMA(1, 0, At, B0); PG8_MMA(1, 1, At, B1); PG8_BAR; PG8_SCHED;
            PG8_LDB(B0, 1, 0); PG8_LDB(B1, 1, 1); PG8_SCHED; PG8_LDA(At, 1, 0); PG8_STAGE_A(PG8_SA(0, 1), a2, s10, s11);
            PG8_WAIT_V(8); PG8_WAIT_L(0); PG8_BAR; PG8_MMA(0, 0, At, B0); PG8_MMA(0, 1, At, B1); PG8_BAR; PG8_SCHED;
            PG8_LDA(At, 1, 1); PG8_STAGE_B(PG8_SB(1, 0), b3); PG8_STAGE_B(PG8_SB(1, 1), b3 + hstep); PG8_STAGE_A(PG8_SA(1, 0), a3, s00, s01);
            PG8_WAIT_V(8); PG8_WAIT_L(0); PG8_BAR; PG8_MMA(1, 0, At, B0); PG8_MMA(1, 1, At, B1); PG8_BAR; PG8_SCHED;
        }
        if constexpr (ALIGN_EPI) { if (wr == 0) PG8_BAR; }
        E(acc, cur, wr, wc, fr, fq);
        if (!has_next) break;
#pragma unroll
        for (int a = 0; a < 2; ++a)
#pragma unroll
            for (int b = 0; b < 2; ++b)
#pragma unroll
                for (int m = 0; m < 4; ++m)
#pragma unroll
                    for (int n = 0; n < 2; ++n) acc[a][b][m][n] = (f32x4){0.f, 0.f, 0.f, 0.f};
        cur = nxt; cA = nA; cB = nB; ++ui;
#pragma unroll
        for (int h = 0; h < 2; ++h)
#pragma unroll
            for (int i = 0; i < 2; ++i) voA[h][i] = voN[h][i];
        if constexpr (ALIGN_EPI) { if (wr == 1) PG8_BAR; }
    }
    PG8_WAIT_V(0);
    if constexpr (!ALIGN_EPI) { if (wr == 0) PG8_BAR; }
    PG8_BAR;
#undef PG8_SA
#undef PG8_SB
#undef PG8_STAGE_A
#undef PG8_STAGE_B
#undef PG8_LDA
#undef PG8_LDB
#undef PG8_MMA
#undef PG8_WAIT_V
#undef PG8_WAIT_L
#undef PG8_BAR
#undef PG8_SCHED
}
}

#define XB_TMO      128
#define XB_XCNT(j)  (256  + 64 * (j))
#define XB_XSUB(j)  (1280 + 64 * (j))
#define XB_XGEN(j)  (2304 + 64 * (j))
#define XB_TOP      3328
#define XB_TOPGEN   3392
#define XCD_BAR_WORDS 3456
#define XB_SPIN_CAP (1u << 18)

__device__ __forceinline__ unsigned xb_ld(unsigned* p)              { return __hip_atomic_load(p, __ATOMIC_RELAXED, __HIP_MEMORY_SCOPE_AGENT); }
__device__ __forceinline__ unsigned xb_add(unsigned* p, unsigned v) { return __hip_atomic_fetch_add(p, v, __ATOMIC_RELAXED, __HIP_MEMORY_SCOPE_AGENT); }
__device__ __forceinline__ unsigned xb_xcc_id() { return (unsigned)__builtin_amdgcn_s_getreg((3 << 11) | 20) & 0xFu; }
#define XB_SPIN(cond, bar) do { unsigned _sp = 0; while (cond) { __builtin_amdgcn_s_sleep(1); \
    if ((++_sp & 255u) == 0u) { if (xb_ld(&(bar)[XB_TMO])) break; if (_sp > XB_SPIN_CAP) { atomicAdd(&(bar)[XB_TMO], 1u); break; } } } } while (0)

struct XcdBarrier {
    unsigned* bar; unsigned x;
    volatile LAS unsigned* st;
};
__device__ __forceinline__ XcdBarrier xcd_barrier_post(unsigned* bar, volatile LAS unsigned* st) {
    XcdBarrier b; b.bar = bar; b.x = xb_xcc_id(); b.st = st;
    if (threadIdx.x == 0) (void)xb_add(&bar[XB_XCNT(b.x)], 1u);
    return b;
}
__device__ __forceinline__ void xcd_barrier_complete(unsigned* bar, unsigned x, unsigned& nloc, unsigned& nx) {
    const unsigned G = gridDim.x * gridDim.y * gridDim.z;
    unsigned sum, cnt, mine, sp = 0u;
    for (;;) {
        sum = 0u; cnt = 0u; mine = 0u;
#pragma unroll
        for (unsigned j = 0; j < 16; ++j) { const unsigned c = xb_ld(&bar[XB_XCNT(j)]); sum += c; cnt += (c > 0u) ? 1u : 0u; mine = (j == x) ? c : mine; }
        if (sum == G) break;
        __builtin_amdgcn_s_sleep(1);
        if ((++sp & 255u) == 0u) { if (xb_ld(&bar[XB_TMO])) break; if (sp > XB_SPIN_CAP) { atomicAdd(&bar[XB_TMO], 1u); break; } }
    }
    nloc = mine > 0u ? mine : 1u; nx = cnt > 0u ? cnt : 1u;
}
__device__ __forceinline__ void xcd_barrier(const XcdBarrier& b) {
    asm volatile("s_waitcnt vmcnt(0)" ::: "memory");
    __syncthreads();
    if (threadIdx.x == 0) {
        unsigned* bar = b.bar;
        __builtin_amdgcn_s_waitcnt(0);
        unsigned nloc = b.st[0], nx = b.st[1];
        if (nloc == 0u) { xcd_barrier_complete(bar, b.x, nloc, nx); b.st[0] = nloc; b.st[1] = nx; }
        const unsigned old = xb_add(&bar[XB_XSUB(b.x)], 1u);
        const unsigned gen = old / nloc;
        if (old + 1u == (gen + 1u) * nloc) {
            __builtin_amdgcn_fence(__ATOMIC_RELEASE, "agent");
            asm volatile("s_waitcnt vmcnt(0)" ::: "memory");
            const unsigned og = xb_add(&bar[XB_TOP], 1u);
            const unsigned tg = og / nx;
            if (og + 1u == (tg + 1u) * nx) xb_add(&bar[XB_TOPGEN], 1u);
            else XB_SPIN(xb_ld(&bar[XB_TOPGEN]) == tg, bar);
            __builtin_amdgcn_fence(__ATOMIC_ACQUIRE, "agent");
            xb_add(&bar[XB_XGEN(b.x)], 1u);
            asm volatile("s_waitcnt vmcnt(0)" ::: "memory");
        } else {
            XB_SPIN(xb_ld(&bar[XB_XGEN(b.x)]) == gen, bar);
            __builtin_amdgcn_fence(__ATOMIC_ACQUIRE, "agent");
            asm volatile("s_waitcnt vmcnt(0)" ::: "memory");
        }
    }
    __syncthreads();
}

#define EPI_WALK(...) \
    _Pragma("unroll") for (int ai = 0; ai < 2; ++ai) _Pragma("unroll") for (int m = 0; m < 4; ++m) { \
        const int row = u.pm * 256 + ai * 128 + wr * 64 + m * 16 + fr; \
        _Pragma("unroll") for (int bj = 0; bj < 2; ++bj) { const int cw = bj * 128 + wc * 32 + 8 * fq; \
            float v[8] = {acc[ai][bj][m][0][0], acc[ai][bj][m][0][1], acc[ai][bj][m][0][2], acc[ai][bj][m][0][3], acc[ai][bj][m][1][0], acc[ai][bj][m][1][1], acc[ai][bj][m][1][2], acc[ai][bj][m][1][3]}; \
            __VA_ARGS__ } asm volatile("" ::: "memory"); }

__device__ __forceinline__ void rope8(float (&v)[8], const f32x2* rope_row, int i0) {
#pragma unroll
    for (int j = 0; j < 4; ++j) { const f32x2 cs = rope_row[i0 + j]; const float x1 = v[2 * j], x2 = v[2 * j + 1]; v[2 * j] = x1 * cs.x - x2 * cs.y; v[2 * j + 1] = x2 * cs.x + x1 * cs.y; }
}

struct EpiInProj {
    static constexpr bool PERM = true;
    unsigned char* ws;
    __device__ __forceinline__ void operator()(const f32x4 (&acc)[2][2][4][2], const pg8::Unit& u, int wr, int wc, int fr, int fq) const {
        const int pn = u.pn;
        if (pn < 6) {
            bf16_t* base = (bf16_t*)(ws + (pn < 2 ? WS_QA : pn < 4 ? WS_KA : WS_VA)) + (pn & 1) * 256;
            EPI_WALK({ *(u32x4*)(base + (size_t)row * 512 + cw) = pack8(v); })
        } else if (pn == 6) {
            bf16_t* base = (bf16_t*)(ws + WS_CQ);
            EPI_WALK({ *(u32x4*)(base + (size_t)row * 256 + cw) = pack8(v); })
        } else if (pn == 7) {
            bf16_t* ckv = (bf16_t*)(ws + WS_CKV); bf16_t* kr = (bf16_t*)(ws + WS_KR); const f32x2* rope = (const f32x2*)(ws + WS_ROPE);
            EPI_WALK({ if (cw < 128) { *(u32x4*)(ckv + (size_t)row * 128 + cw) = pack8(v); }
                       else if (cw < 160) { rope8(v, rope + (size_t)(row & (SEQ - 1)) * 16, (cw - 128) >> 1); *(u32x4*)(kr + (size_t)row * 32 + (cw - 128)) = pack8(v); } })
        } else {
            bf16_t* base = (bf16_t*)(ws + (pn < 12 ? WS_GA : WS_GB)) + ((pn - 8) & 3) * 256;
            EPI_WALK({ _Pragma("unroll") for (int j = 0; j < 8; ++j) v[j] = sigmoidf_(v[j]); *(u32x4*)(base + (size_t)row * 1024 + cw) = pack8(v); })
        }
    }
};
#define EPI_ROW(ai, m) (u.pm * 256 + (ai) * 128 + wr * 64 + (m) * 16 + fr)
#define EPI_LOAD_RS(rs) float rs8[2][4]; _Pragma("unroll") for (int ai = 0; ai < 2; ++ai) _Pragma("unroll") for (int m = 0; m < 4; ++m) rs8[ai][m] = (rs)[EPI_ROW(ai, m)];
struct EpiQ {
    static constexpr bool PERM = true;
    unsigned char* ws;
    __device__ __forceinline__ void operator()(const f32x4 (&acc)[2][2][4][2], const pg8::Unit& u, int wr, int wc, int fr, int fq) const {
        bf16_t* qb = (bf16_t*)(ws + WS_QB); const float* rs = (const float*)(ws + WS_RSTDQ); const f32x2* rope = (const f32x2*)(ws + WS_ROPE);
        EPI_LOAD_RS(rs)
        EPI_WALK({ const int col = u.pn * 256 + cw; const int w = col % 96; const float r = rs8[ai][m];
                   _Pragma("unroll") for (int j = 0; j < 8; ++j) v[j] *= r;
                   if (w >= 64) rope8(v, rope + (size_t)(row & (SEQ - 1)) * 16, (w - 64) >> 1);
                   *(u32x4*)(qb + (size_t)row * 768 + col) = pack8(v);
                   *(u32x2*)(ws + WS_Q8 + (size_t)row * 768 + col) = (u32x2){pack4_fp8(v[0] * 16.f, v[1] * 16.f, v[2] * 16.f, v[3] * 16.f), pack4_fp8(v[4] * 16.f, v[5] * 16.f, v[6] * 16.f, v[7] * 16.f)}; })
    }
};
struct EpiKV {
    static constexpr bool PERM = true;
    unsigned char* ws;
    __device__ __forceinline__ void operator()(const f32x4 (&acc)[2][2][4][2], const pg8::Unit& u, int wr, int wc, int fr, int fq) const {
        const float* rs = (const float*)(ws + WS_RSTDKV); bf16_t* kimg = (bf16_t*)(ws + WS_KIMG); bf16_t* vimg = (bf16_t*)(ws + WS_VIMG);
        EPI_LOAD_RS(rs)
        EPI_WALK({ const float r = rs8[ai][m];
                   _Pragma("unroll") for (int j = 0; j < 8; ++j) v[j] *= r;
                   const int col = (u.pn & 1) * 256 + cw, h = col >> 6, b = row >> 14, sq = row & (SEQ - 1), tile = sq >> 6, rr = sq & 63; const size_t tb = (size_t)((b * 8 + h) * 256 + tile);
                   if (u.pn < 2) { *(u32x4*)(kimg + tb * 6144 + ((col & 63) >> 3) * 512 + rr * 8) = pack8(v);
                       *(u32x2*)(ws + WS_K8 + tb * 6144 + ((col & 63) >> 4) * 1024 + rr * 16 + (col & 8)) = (u32x2){pack4_fp8(v[0], v[1], v[2], v[3]), pack4_fp8(v[4], v[5], v[6], v[7])}; }
                   else *(u32x4*)(vimg + tb * 4096 + ((col & 63) >> 5) * 2048 + rr * 32 + (col & 31)) = pack8(v); })
    }
};
template <bool SECOND> struct EpiGate {
    static constexpr bool PERM = true;
    unsigned char* ws;
    __device__ __forceinline__ void operator()(const f32x4 (&acc)[2][2][4][2], const pg8::Unit& u, int wr, int wc, int fr, int fq) const {
        bf16_t* mg = (bf16_t*)(ws + WS_MERGED); const bf16_t* gt = (const bf16_t*)(ws + (SECOND ? WS_GB : WS_GA));
#pragma unroll
        for (int ai = 0; ai < 2; ++ai) {
            u32x4 gw[4][2], pw[4][2];
#pragma unroll
            for (int m = 0; m < 4; ++m)
#pragma unroll
                for (int bj = 0; bj < 2; ++bj) { const size_t o = (size_t)EPI_ROW(ai, m) * 1024 + u.pn * 256 + bj * 128 + wc * 32 + 8 * fq; gw[m][bj] = *(const u32x4*)(gt + o); if (SECOND) pw[m][bj] = *(const u32x4*)(mg + o); }
#pragma unroll
            for (int m = 0; m < 4; ++m)
#pragma unroll
                for (int bj = 0; bj < 2; ++bj) { const size_t o = (size_t)EPI_ROW(ai, m) * 1024 + u.pn * 256 + bj * 128 + wc * 32 + 8 * fq;
                    float v[8] = {acc[ai][bj][m][0][0], acc[ai][bj][m][0][1], acc[ai][bj][m][0][2], acc[ai][bj][m][0][3], acc[ai][bj][m][1][0], acc[ai][bj][m][1][1], acc[ai][bj][m][1][2], acc[ai][bj][m][1][3]};
                    float g[8]; unpack8(gw[m][bj], g);
                    if (SECOND) { float p[8]; unpack8(pw[m][bj], p); _Pragma("unroll") for (int j = 0; j < 8; ++j) v[j] = p[j] + g[j] * v[j]; }
                    else { _Pragma("unroll") for (int j = 0; j < 8; ++j) v[j] = g[j] * v[j]; }
                    *(u32x4*)(mg + o) = pack8(v); }
            asm volatile("" ::: "memory");
        }
    }
};
struct EpiResid {
    static constexpr bool PERM = true;
    unsigned char* ws; const float* x; float* x1;
    __device__ __forceinline__ void operator()(const f32x4 (&acc)[2][2][4][2], const pg8::Unit& u, int wr, int wc, int fr, int fq) const {
        bf16_t* h2 = (bf16_t*)(ws + WS_H2);
#pragma unroll
        for (int ai = 0; ai < 2; ++ai) {
            f32x4 xa[4][2][2];
#pragma unroll
            for (int m = 0; m < 4; ++m)
#pragma unroll
                for (int bj = 0; bj < 2; ++bj) { const size_t o = (size_t)EPI_ROW(ai, m) * 1024 + u.pn * 256 + bj * 128 + wc * 32 + 8 * fq; xa[m][bj][0] = *(const f32x4*)(x + o); xa[m][bj][1] = *(const f32x4*)(x + o + 4); }
#pragma unroll
            for (int m = 0; m < 4; ++m)
#pragma unroll
                for (int bj = 0; bj < 2; ++bj) { const size_t o = (size_t)EPI_ROW(ai, m) * 1024 + u.pn * 256 + bj * 128 + wc * 32 + 8 * fq;
                    const f32x4 r0 = acc[ai][bj][m][0] + xa[m][bj][0], r1 = acc[ai][bj][m][1] + xa[m][bj][1];
                    *(f32x4*)(x1 + o) = r0; *(f32x4*)(x1 + o + 4) = r1;
                    const float v[8] = {r0[0], r0[1], r0[2], r0[3], r1[0], r1[1], r1[2], r1[3]};
                    *(u32x2*)((unsigned char*)h2 + o) = (u32x2){pack4_fp8(v[0], v[1], v[2], v[3]), pack4_fp8(v[4], v[5], v[6], v[7])}; }
            asm volatile("" ::: "memory");
        }
    }
};
struct EpiSwiglu {
    static constexpr bool PERM = true;
    unsigned char* ws; const float* bgu;
    __device__ __forceinline__ void operator()(const f32x4 (&acc)[2][2][4][2], const pg8::Unit& u, int wr, int wc, int fr, int fq) const {
        bf16_t* act = (bf16_t*)(ws + WS_ACT); const float* rsc = (const float*)(ws + WS_ROWSCALE);
        const int c0 = u.pn * 128 + wc * 32 + 8 * fq; const float* bg = bgu + (size_t)u.e * 2048 + c0;
        float bgv[8], buv[8];
#pragma unroll
        for (int j = 0; j < 8; ++j) { bgv[j] = bg[j]; buv[j] = bg[1024 + j]; }
        EPI_LOAD_RS(rsc)
#pragma unroll
        for (int ai = 0; ai < 2; ++ai)
#pragma unroll
            for (int m = 0; m < 4; ++m) {
                const int row = u.pm * 256 + ai * 128 + wr * 64 + m * 16 + fr; const float r = rs8[ai][m]; float o[8];
#pragma unroll
                for (int j = 0; j < 8; ++j) { const float g0 = acc[ai][0][m][j >> 2][j & 3] * r + bgv[j], u0 = acc[ai][1][m][j >> 2][j & 3] * r + buv[j];
                    const float g = fminf(g0, 7.f), up = fminf(fmaxf(u0, -7.f), 7.f); o[j] = (up + 1.f) * (g * sigmoidf_(1.702f * g)); }
                *(u32x2*)((unsigned char*)act + (size_t)row * 1024 + c0) = (u32x2){pack4_fp8(o[0], o[1], o[2], o[3]), pack4_fp8(o[4], o[5], o[6], o[7])};
            }
    }
};
struct EpiDown {
    static constexpr bool PERM = true;
    unsigned char* ws; const float* bd;
    __device__ __forceinline__ void operator()(const f32x4 (&acc)[2][2][4][2], const pg8::Unit& u, int wr, int wc, int fr, int fq) const {
        bf16_t* y = (bf16_t*)(ws + WS_Y); const float* b = bd + (size_t)u.e * 1024 + u.pn * 256;
        EPI_WALK({ _Pragma("unroll") for (int j = 0; j < 8; ++j) v[j] += b[cw + j];
                   *(u32x4*)(y + (size_t)row * 1024 + u.pn * 256 + cw) = pack8(v); })
    }
};

typedef short v4i16_t __attribute__((ext_vector_type(4)));
__device__ __forceinline__ s16x4 vtr(const LAS char* p) { return __builtin_bit_cast(s16x4, __builtin_amdgcn_ds_read_tr16_b64_v4i16((LAS v4i16_t*)p)); }
__device__ __forceinline__ float swapmax(float m) { auto rr = __builtin_amdgcn_permlane32_swap(__float_as_uint(m), __float_as_uint(m), false, false); return fmaxf(__uint_as_float(rr[0]), __uint_as_float(rr[1])); }
__device__ __forceinline__ float swapsum(float m) { auto rr = __builtin_amdgcn_permlane32_swap(__float_as_uint(m), __float_as_uint(m), false, false); return __uint_as_float(rr[0]) + __uint_as_float(rr[1]); }

struct AttnState { f32x16 o0, o1; float m, l; };

struct MlaKL {
    const bf16_t* K; const bf16_t* V;
    template <int D0> __device__ __forceinline__ bf16x8 kfrag(int c, int r32, int hi) const { return *(const bf16x8*)(K + (size_t)(c >> 1) * 6144 + (2 * D0 + hi) * 512 + ((c & 1) * 32 + r32) * 8); }
    __device__ __forceinline__ u32x4 vpiece(int c, int row, int c8) const { return *(const u32x4*)(V + (size_t)(c >> 1) * 4096 + (c8 >> 2) * 2048 + ((c & 1) * 32 + row) * 32 + (c8 & 3) * 8); }
    __device__ __forceinline__ void modify(int, f32x16&, int, int) const {}
    __device__ __forceinline__ int order(int i) const { return i; }
};
struct DilKL {
    const bf16_t* K; const bf16_t* V;
    int dil, res, u0, L; float slope2d;
    __device__ __forceinline__ size_t tok(int c, int kk) const { int v = u0 - 64 + 32 * c + kk; v = v < 0 ? 0 : (v >= L ? L - 1 : v); return (size_t)(res + dil * v); }
    template <int D0> __device__ __forceinline__ bf16x8 kfrag(int c, int r32, int hi) const { return *(const bf16x8*)(K + tok(c, r32) * 512 + 16 * D0 + 8 * hi); }
    __device__ __forceinline__ u32x4 vpiece(int c, int row, int c8) const { return *(const u32x4*)(V + tok(c, row) * 512 + 8 * c8); }
    __device__ __forceinline__ void modify(int c, f32x16& s, int r32, int hi) const {
        const float c0 = (float)(32 * c - 64); const int vb = u0 - 64 + 32 * c;
#pragma unroll
        for (int r = 0; r < 16; ++r) { const float d = (float)(crow(r, hi) - r32); s[r] = s[r] - slope2d * fabsf(d + c0); }
        if (c == 0) {
#pragma unroll
            for (int r = 0; r < 16; ++r) s[r] = (crow(r, hi) >= r32) ? s[r] : -1e30f; }
        if (c == 4) {
#pragma unroll
            for (int r = 0; r < 16; ++r) s[r] = (crow(r, hi) <= r32) ? s[r] : -1e30f; }
        if (vb < 0 || vb + 31 >= L) {
#pragma unroll
            for (int r = 0; r < 16; ++r) { const int v = vb + crow(r, hi); s[r] = (v >= 0 && v < L) ? s[r] : -1e30f; } }
    }
    __device__ __forceinline__ int order(int i) const { return i == 0 ? 2 : i == 1 ? 1 : i == 2 ? 3 : i == 3 ? 0 : 4; }
};

template <int NDK, class KL> __device__ __forceinline__ void attn_load_k(bf16x8 (&kf)[NDK], const KL& kl, int c, int r32, int hi) {
    kf[0] = kl.template kfrag<0>(c, r32, hi); kf[1] = kl.template kfrag<1>(c, r32, hi); kf[2] = kl.template kfrag<2>(c, r32, hi); kf[3] = kl.template kfrag<3>(c, r32, hi);
    if constexpr (NDK == 6) { kf[4] = kl.template kfrag<4>(c, r32, hi); kf[5] = kl.template kfrag<5>(c, r32, hi); }
}
template <class KL> __device__ __forceinline__ void attn_load_v(u32x4 (&vp)[4], const KL& kl, int c, int lane) {
#pragma unroll
    for (int i = 0; i < 4; ++i) { const int p = lane + 64 * i; vp[i] = kl.vpiece(c, p >> 3, p & 7); }
}
__device__ __forceinline__ void attn_store_v(const u32x4 (&vp)[4], LAS char* vimg, int lane) {
#pragma unroll
    for (int i = 0; i < 4; ++i) { const int p = lane + 64 * i, row = p >> 3, c8 = p & 7; *(LAS u32x4*)(vimg + (c8 >> 2) * 2048 + row * 64 + (c8 & 3) * 16) = vp[i]; }
}
template <int NDK, class KL> __device__ __forceinline__ void attn_core(AttnState& st, const bf16x8 (&qf)[NDK], const bf16x8 (&kf)[NDK], const KL& kl, int c, LAS char* vimg, LAS float* wsf, int lane, int r32, int hi) {
    f32x16 s = {};
#pragma unroll
    for (int d0 = 0; d0 < NDK; ++d0) s = __builtin_amdgcn_mfma_f32_32x32x16_bf16(kf[d0], qf[d0], s, 0, 0, 0);
    kl.modify(c, s, r32, hi);
    float mx = s[0];
#pragma unroll
    for (int r = 1; r < 16; ++r) mx = fmaxf(mx, s[r]);
    mx = swapmax(mx);
    const float mn = fmaxf(st.m, mx), alpha = fexp2(st.m - mn);
    float ps = 0.f;
#pragma unroll
    for (int r = 0; r < 16; ++r) { s[r] = fexp2(s[r] - mn); ps += s[r]; }
    st.l = st.l * alpha + ps; st.m = mn;
    if (__any(alpha != 1.f)) {
        if (hi == 0) wsf[r32] = alpha;
#pragma unroll
        for (int r = 0; r < 16; ++r) { const float a = wsf[crow(r, hi)]; st.o0[r] *= a; st.o1[r] *= a; }
    }
    const u32x4 pw0 = {cvtpk(s[0], s[1]), cvtpk(s[2], s[3]), cvtpk(s[4], s[5]), cvtpk(s[6], s[7])};
    const u32x4 pw1 = {cvtpk(s[8], s[9]), cvtpk(s[10], s[11]), cvtpk(s[12], s[13]), cvtpk(s[14], s[15])};
    const bf16x8 pa0 = __builtin_bit_cast(bf16x8, pw0), pa1 = __builtin_bit_cast(bf16x8, pw1);
    const LAS char* vp = vimg + ((lane >> 4) & 1) * 32 + (lane & 3) * 8 + (4 * hi + ((lane & 15) >> 2)) * 64;
#pragma unroll
    for (int ks = 0; ks < 2; ++ks) {
        const s16x4 l0 = vtr(vp + ks * 1024), h0 = vtr(vp + ks * 1024 + 512), l1 = vtr(vp + 2048 + ks * 1024), h1 = vtr(vp + 2048 + ks * 1024 + 512);
        const bf16x8 v0 = {l0[0], l0[1], l0[2], l0[3], h0[0], h0[1], h0[2], h0[3]}, v1 = {l1[0], l1[1], l1[2], l1[3], h1[0], h1[1], h1[2], h1[3]};
        st.o0 = __builtin_amdgcn_mfma_f32_32x32x16_bf16(ks == 0 ? pa0 : pa1, v0, st.o0, 0, 0, 0);
        st.o1 = __builtin_amdgcn_mfma_f32_32x32x16_bf16(ks == 0 ? pa0 : pa1, v1, st.o1, 0, 0, 0);
    }
}
template <int NDK, class KL> __device__ __forceinline__ void wave_attn(AttnState& st, const bf16x8 (&qf)[NDK], const KL& kl, int nchunk, LAS char* vimg, LAS float* wsf, int lane) {
    const int r32 = lane & 31, hi = lane >> 5;
    st.o0 = f32x16{}; st.o1 = f32x16{}; st.m = -1e30f; st.l = 0.f;
    bf16x8 kfa[NDK], kfb[NDK]; u32x4 vp[4];
    attn_load_k<NDK>(kfa, kl, kl.order(0), r32, hi); attn_load_v(vp, kl, kl.order(0), lane);
    asm volatile("" : "+s"(nchunk));
#pragma unroll 1
    for (int c = 0; c < nchunk; c += 2) {
        attn_store_v(vp, vimg, lane);
        if (c + 1 < nchunk) { attn_load_k<NDK>(kfb, kl, kl.order(c + 1), r32, hi); attn_load_v(vp, kl, kl.order(c + 1), lane); }
        attn_core<NDK>(st, qf, kfa, kl, kl.order(c), vimg, wsf, lane, r32, hi);
        if (c + 1 < nchunk) {
            attn_store_v(vp, vimg, lane);
            if (c + 2 < nchunk) { attn_load_k<NDK>(kfa, kl, kl.order(c + 2), r32, hi); attn_load_v(vp, kl, kl.order(c + 2), lane); }
            attn_core<NDK>(st, qf, kfb, kl, kl.order(c + 1), vimg, wsf, lane, r32, hi);
        }
    }
}
__device__ __forceinline__ float attn_finish(AttnState& st, LAS char* vimg, LAS float* wsf, int lane) {
    const int r32 = lane & 31, hi = lane >> 5;
    const float lt = swapsum(st.l);
    if (hi == 0) wsf[32 + r32] = lt;
    LAS bf16_t* stg = (LAS bf16_t*)vimg;
#pragma unroll
    for (int r = 0; r < 16; ++r) { const int q = crow(r, hi); const float il = frcp(wsf[32 + q]);
        stg[q * 64 + r32] = (bf16_t)f2bf(st.o0[r] * il); stg[q * 64 + 32 + r32] = (bf16_t)f2bf(st.o1[r] * il); }
    return lt;
}

namespace mla {
constexpr int NW = 8, QBLK = 32, QB = 256, KVBLK = 64, NT = SEQ / KVBLK;
constexpr int KSLOT = 12288, VSLOT = 8192, LDS_K = 0, LDS_V = 3 * KSLOT, LDS_WS = LDS_V + 3 * VSLOT, LDS_OST = LDS_WS + NW * 256, LDS_BYTES_ = LDS_OST + NW * 4096;
#define SBAR() __builtin_amdgcn_sched_barrier(0)
#define WAIT_BAR(N) asm volatile("s_waitcnt vmcnt(" #N ") lgkmcnt(0)\n\ts_barrier" ::: "memory")
__device__ __forceinline__ void glds16(const void* gsrc, unsigned lds_dst) { unsigned keep;
    asm volatile("s_mov_b32 %0, m0\n\ts_mov_b32 m0, %2\n\ts_nop 0\n\tglobal_load_lds_dwordx4 %1, off\n\ts_mov_b32 m0, %0" : "=&s"(keep) : "v"(gsrc), "s"(lds_dst) : "memory"); }
typedef LAS const char* lds_cptr;
__device__ __forceinline__ void kload2(bf16x8* kf, lds_cptr kp, int j) { kf[2 * j] = *(const LAS bf16x8*)(kp + j * 2048); kf[2 * j + 1] = *(const LAS bf16x8*)(kp + j * 2048 + 512); }

__device__ __forceinline__ void mla_unit(int b, int h, int qb, const bf16_t* Q, const bf16_t* __restrict__ Kim, const bf16_t* __restrict__ Vim, bf16_t* O, LAS char* shm) {
    const int tid = threadIdx.x, lane = tid & 63, r32 = lane & 31, hi = lane >> 5; const int wid = __builtin_amdgcn_readfirstlane(tid >> 6);
    const long rowbase = (long)b * SEQ; const int q0 = qb * QB;
    const bf16_t* Qw = Q + (rowbase + q0 + wid * QBLK) * 768 + h * 96;
    const unsigned lds0 = (unsigned)(uintptr_t)shm;
    LAS float* wsf = (LAS float*)(shm + LDS_WS) + wid * 64;
    const bf16_t* ksrc = Kim + wid * 512 + lane * 8;
    const bf16_t* rsrc = Kim + (8 + (wid & 3)) * 512 + lane * 8;
    const bf16_t* vsrc = Vim + wid * 512 + lane * 8;
    const unsigned kdst = lds0 + LDS_K + wid * 1024, rdst = lds0 + LDS_K + (8 + (wid & 3)) * 1024, vdst = lds0 + LDS_V + wid * 1024;
#define DMA_K(t, ks) do { glds16(ksrc + (long)(t) * 6144, (unsigned)__builtin_amdgcn_readfirstlane(kdst + (ks))); glds16(rsrc + (long)(t) * 6144, (unsigned)__builtin_amdgcn_readfirstlane(rdst + (ks))); } while (0)
#define DMA_V(t, vs) glds16(vsrc + (long)(t) * 4096, (unsigned)__builtin_amdgcn_readfirstlane(vdst + (vs)))
    const lds_cptr shm3 = (lds_cptr)shm; const lds_cptr kp0 = shm3 + LDS_K + hi * 1024 + r32 * 16;
    const lds_cptr vp0 = shm3 + LDS_V + ((lane >> 4) & 1) * 32 + (lane & 3) * 8 + (4 * hi + ((lane & 15) >> 2)) * 64;
    bf16x8 kf[12];
    DMA_K(0, 0); DMA_V(0, 0); DMA_K(1, KSLOT);
    bf16x8 qr[6];
#pragma unroll
    for (int d0 = 0; d0 < 6; ++d0) qr[d0] = *reinterpret_cast<const bf16x8*>(&Qw[(long)r32 * 768 + d0 * 16 + hi * 8]);
    float l_reg = 0.f; f32x16 o[2]; o[0] = f32x16{}; o[1] = f32x16{};
    f32x16 pA0, pA1, pB0, pB1;
    int si_prev = 0, si_cur = 0, si_next = 1;
#define ROT() do { si_prev = si_cur; si_cur = si_next; si_next = (si_next == 2) ? 0 : si_next + 1; } while (0)
    DMA_K(2, 2 * KSLOT);
    WAIT_BAR(5);
    { const lds_cptr kb = kp0;
#pragma unroll
      for (int d0 = 0; d0 < 6; ++d0) { const bf16x8 b0 = *(const LAS bf16x8*)(kb + d0 * 2048), b1 = *(const LAS bf16x8*)(kb + d0 * 2048 + 512);
          if (d0 == 0) { pA0 = __builtin_amdgcn_mfma_f32_32x32x16_bf16(b0, qr[0], f32x16{}, 0, 0, 0); pA1 = __builtin_amdgcn_mfma_f32_32x32x16_bf16(b1, qr[0], f32x16{}, 0, 0, 0); }
          else { pA0 = __builtin_amdgcn_mfma_f32_32x32x16_bf16(b0, qr[d0], pA0, 0, 0, 0); pA1 = __builtin_amdgcn_mfma_f32_32x32x16_bf16(b1, qr[d0], pA1, 0, 0, 0); } } }
#pragma unroll
    for (int r = 0; r < 16; ++r) { pA0[r] = __builtin_amdgcn_exp2f(pA0[r]); pA1[r] = __builtin_amdgcn_exp2f(pA1[r]); }
    WAIT_BAR(0);
    DMA_K(3, 0); DMA_V(1, VSLOT);
    ROT();
#pragma unroll
    for (int j = 0; j < 6; ++j) kload2(kf, kp0 + si_cur * KSLOT, j);
    WAIT_BAR(3);
    s16x4 vlo[8], vhi[8]; u32x4 pw0, pw1, pw2, pw3;
#define PKW(P, B) cvtpk(P[B], P[B + 1])
#define PAF(k) __builtin_bit_cast(bf16x8, pw##k)
#define VFR(i) (bf16x8){vlo[i][0], vlo[i][1], vlo[i][2], vlo[i][3], vhi[i][0], vhi[i][1], vhi[i][2], vhi[i][3]}
#define PIN(x) asm volatile("" : "+v"(x))
#define MF(a, b, c) __builtin_amdgcn_mfma_f32_32x32x16_bf16(a, b, c, 0, 0, 0)
#define GAPA(MFX, A0, A1, A2, A3, W0, W1, PW) do { MFX; sacc += A0; sacc += A1; sacc += A2; sacc += A3; PIN(sacc); W0; W1; PIN(PW); SBAR(); } while (0)
#define GAPM(MFX) do { MFX; SBAR(); } while (0)
#define EX(v) __builtin_amdgcn_exp2f(v)
#define GAPB(MFX, X, B) do { MFX; X[B] = EX(X[B]); X[B + 1] = EX(X[B + 1]); X[B + 2] = EX(X[B + 2]); X[B + 3] = EX(X[B + 3]); PIN(X); SBAR(); } while (0)
#define VRD(i) do { vlo[i] = vtr(vp_ + (((i) >> 2) * 4096 + ((i) & 3) * 1024)); vhi[i] = vtr(vp_ + (((i) >> 2) * 4096 + ((i) & 3) * 1024 + 512)); } while (0)
#define KRD(G, j) do { if (G) { kload2(kf, kp0 + si_next * KSLOT, j); SBAR(); } } while (0)
#define STEP(C0, C1, P0, P1, t, GK, GV, GL) do { SBAR(); \
    const lds_cptr vp_ = vp0 + si_prev * VSLOT; \
    VRD(0); SBAR(); float sacc = (P0[0] + P0[1]); \
    GAPA(C0 = MF(kf[0], qr[0], f32x16{}), P0[2], P0[3], P0[4], P0[5],     pw0[0] = PKW(P0, 0),  pw0[1] = PKW(P0, 2),  pw0); \
    VRD(4); SBAR(); GAPA(C1 = MF(kf[1], qr[0], f32x16{}), P0[6], P0[7], P0[8], P0[9],     pw0[2] = PKW(P0, 4),  pw0[3] = PKW(P0, 6),  pw0); \
    VRD(1); SBAR(); GAPA(C0 = MF(kf[2], qr[1], C0),   P0[10], P0[11], P0[12], P0[13], pw1[0] = PKW(P0, 8),  pw1[1] = PKW(P0, 10), pw1); \
    VRD(5); SBAR(); GAPA(C1 = MF(kf[3], qr[1], C1),   P0[14], P0[15], P1[0], P1[1],   pw1[2] = PKW(P0, 12), pw1[3] = PKW(P0, 14), pw1); \
    VRD(2); SBAR(); GAPA(C0 = MF(kf[4], qr[2], C0),   P1[2], P1[3], P1[4], P1[5],     pw2[0] = PKW(P1, 0),  pw2[1] = PKW(P1, 2),  pw2); \
    VRD(6); SBAR(); GAPA(C1 = MF(kf[5], qr[2], C1),   P1[6], P1[7], P1[8], P1[9],     pw2[2] = PKW(P1, 4),  pw2[3] = PKW(P1, 6),  pw2); \
    VRD(3); SBAR(); GAPA(C0 = MF(kf[6], qr[3], C0),   P1[10], P1[11], P1[12], P1[13], pw3[0] = PKW(P1, 8),  pw3[1] = PKW(P1, 10), pw3); \
    VRD(7); SBAR(); GAPA(C1 = MF(kf[7], qr[3], C1),   P1[14], P1[15], 0.f, 0.f,       pw3[2] = PKW(P1, 12), pw3[3] = PKW(P1, 14), pw3); \
    GAPM(C0 = MF(kf[8], qr[4], C0)); GAPM(C1 = MF(kf[9], qr[4], C1)); GAPM(C0 = MF(kf[10], qr[5], C0)); GAPM(C1 = MF(kf[11], qr[5], C1)); \
    l_reg += sacc; \
    if (GK) { DMA_K((t) + 3, si_cur * KSLOT); } if (GV) { DMA_V((t) + 1, si_next * VSLOT); } \
    SBAR(); \
    GAPB(o[0] = MF(PAF(0), VFR(0), o[0]), C0, 0); \
    GAPB(o[1] = MF(PAF(0), VFR(4), o[1]), C0, 4); \
    KRD(GL, 0); GAPB(o[0] = MF(PAF(1), VFR(1), o[0]), C0, 8); \
    KRD(GL, 1); GAPB(o[1] = MF(PAF(1), VFR(5), o[1]), C0, 12); \
    KRD(GL, 2); GAPB(o[0] = MF(PAF(2), VFR(2), o[0]), C1, 0); \
    KRD(GL, 3); GAPB(o[1] = MF(PAF(2), VFR(6), o[1]), C1, 4); \
    KRD(GL, 4); GAPB(o[0] = MF(PAF(3), VFR(3), o[0]), C1, 8); \
    KRD(GL, 5); GAPB(o[1] = MF(PAF(3), VFR(7), o[1]), C1, 12); \
    } while (0)
    int t = 1;
    for (; t + 5 < NT; t += 2) {
        STEP(pB0, pB1, pA0, pA1, t, true, true, true);     WAIT_BAR(3); ROT();
        STEP(pA0, pA1, pB0, pB1, t + 1, true, true, true); WAIT_BAR(3); ROT();
    }
#define ENDW(tt) do { if ((tt) + 3 < NT) { WAIT_BAR(3); } else if ((tt) + 2 < NT) { WAIT_BAR(1); } else { WAIT_BAR(0); } } while (0)
    for (; t + 1 < NT; t += 2) {
        STEP(pB0, pB1, pA0, pA1, t, (t + 3 < NT), (t + 1 < NT), (t + 1 < NT));         ENDW(t);     ROT();
        STEP(pA0, pA1, pB0, pB1, t + 1, (t + 4 < NT), (t + 2 < NT), (t + 2 < NT));     ENDW(t + 1); ROT();
    }
    STEP(pB0, pB1, pA0, pA1, NT - 1, false, false, false);
    { float sacc = pB0[0] + pB0[1];
#pragma unroll
      for (int r = 2; r < 16; ++r) sacc += pB0[r];
#pragma unroll
      for (int r = 0; r < 16; ++r) sacc += pB1[r];
      l_reg += sacc;
      pw0 = (u32x4){PKW(pB0, 0), PKW(pB0, 2), PKW(pB0, 4), PKW(pB0, 6)}; pw1 = (u32x4){PKW(pB0, 8), PKW(pB0, 10), PKW(pB0, 12), PKW(pB0, 14)};
      pw2 = (u32x4){PKW(pB1, 0), PKW(pB1, 2), PKW(pB1, 4), PKW(pB1, 6)}; pw3 = (u32x4){PKW(pB1, 8), PKW(pB1, 10), PKW(pB1, 12), PKW(pB1, 14)};
      SBAR();
      const lds_cptr vp_ = vp0 + si_cur * VSLOT;
#pragma unroll
      for (int d0 = 0; d0 < 2; ++d0) {
          s16x4 lo4[4], hi4[4];
#pragma unroll
          for (int ks = 0; ks < 4; ++ks) { lo4[ks] = vtr(vp_ + d0 * 4096 + ks * 1024); hi4[ks] = vtr(vp_ + d0 * 4096 + ks * 1024 + 512); }
#define PK4(k) (bf16x8){lo4[k][0], lo4[k][1], lo4[k][2], lo4[k][3], hi4[k][0], hi4[k][1], hi4[k][2], hi4[k][3]}
          o[d0] = MF(PAF(0), PK4(0), o[d0]); o[d0] = MF(PAF(1), PK4(1), o[d0]); o[d0] = MF(PAF(2), PK4(2), o[d0]); o[d0] = MF(PAF(3), PK4(3), o[d0]);
#undef PK4
      } }
    l_reg = swapsum(l_reg);
    if (hi == 0) wsf[32 + r32] = l_reg;
    asm volatile("s_waitcnt lgkmcnt(0)" ::: "memory");
    float rli[16];
#pragma unroll
    for (int r = 0; r < 16; ++r) rli[r] = __builtin_amdgcn_rcpf(wsf[32 + crow(r, hi)]);
    bf16_t* Ow = O + (rowbase + q0 + wid * QBLK) * 512 + h * 64;
    { LAS bf16_t* stg = (LAS bf16_t*)(shm + LDS_OST) + wid * 2048;
#pragma unroll
      for (int r = 0; r < 16; ++r) { const int orow = crow(r, hi);
#pragma unroll
          for (int d0 = 0; d0 < 2; ++d0) stg[orow * 64 + d0 * 32 + r32] = (bf16_t)f2bf(o[d0][r] * rli[r]); }
      asm volatile("s_waitcnt lgkmcnt(0)" ::: "memory");
#pragma unroll
      for (int i = 0; i < 4; ++i) { const int row = i * 8 + (lane >> 3), ch = lane & 7; const u32x4 v = *(const LAS u32x4*)(stg + row * 64 + ch * 8); *(u32x4*)(Ow + (long)row * 512 + ch * 8) = v; } }
    asm volatile("s_waitcnt lgkmcnt(0)\n\ts_barrier" ::: "memory");
#undef DMA_K
#undef DMA_V
#undef ROT
#undef PKW
#undef PAF
#undef VFR
#undef PIN
#undef MF
#undef GAPA
#undef GAPM
#undef GAPB
#undef EX
#undef VRD
#undef KRD
#undef STEP
#undef ENDW
}
#undef SBAR
#undef WAIT_BAR
}

namespace mla8 {
using mla::glds16; using mla::lds_cptr;
typedef int v8i __attribute__((ext_vector_type(8)));
constexpr int NW = 8, QBLK = 32, QB = 256, KVBLK = 64, NT = SEQ / KVBLK;
constexpr int KSLOT = 6144, VSLOT = 8192, LDS_K = 0, LDS_V = 3 * KSLOT, LDS_WS = LDS_V + 3 * VSLOT, LDS_OST = LDS_WS + NW * 256, LDS_BYTES_ = LDS_OST + NW * 4096;
#define SBAR() __builtin_amdgcn_sched_barrier(0)
#define WAIT_BAR(N) asm volatile("s_waitcnt vmcnt(" #N ") lgkmcnt(0)\n\ts_barrier" ::: "memory")
__device__ __forceinline__ v8i kfrag8(lds_cptr slot, int n, int ks, int r32, int hi) {
    const lds_cptr p = slot + (ks == 0 ? 2 * hi : 4) * 1024 + (32 * n + r32) * 16;
    const u32x4 a = *(const LAS u32x4*)p, b = *(const LAS u32x4*)(p + 1024);
    return (v8i){(int)a.x, (int)a.y, (int)a.z, (int)a.w, (int)b.x, (int)b.y, (int)b.z, (int)b.w};
}
#define MF8(a, b, c) __builtin_amdgcn_mfma_scale_f32_32x32x64_f8f6f4(a, b, c, 0, 0, 0, 0x7f7f7f7f, 0, 0x7b7b7b7b)

__device__ __forceinline__ void mla8_unit(int b, int h, int qb, const unsigned char* Q8, const unsigned char* __restrict__ K8im, const bf16_t* __restrict__ Vim, bf16_t* O, LAS char* shm) {
    const int tid = threadIdx.x, lane = tid & 63, r32 = lane & 31, hi = lane >> 5; const int wid = __builtin_amdgcn_readfirstlane(tid >> 6);
    const long rowbase = (long)b * SEQ; const int q0 = qb * QB;
    const unsigned char* Qw = Q8 + (size_t)(rowbase + q0 + wid * QBLK + r32) * 768 + h * 96;
    const unsigned lds0 = (unsigned)(uintptr_t)shm;
    LAS float* wsf = (LAS float*)(shm + LDS_WS) + wid * 64;
    const int kpc = wid < 6 ? wid : wid - 6;
    const unsigned char* ksrc = K8im + kpc * 1024 + lane * 16;
    const bf16_t* vsrc = Vim + wid * 512 + lane * 8;
    const unsigned kdst = lds0 + LDS_K + kpc * 1024, vdst = lds0 + LDS_V + wid * 1024;
#define DMA_K(t, ks) glds16(ksrc + (long)(t) * 6144, (unsigned)__builtin_amdgcn_readfirstlane(kdst + (ks)))
#define DMA_V(t, vs) glds16(vsrc + (long)(t) * 4096, (unsigned)__builtin_amdgcn_readfirstlane(vdst + (vs)))
    const lds_cptr shm3 = (lds_cptr)shm; const lds_cptr ks0 = shm3 + LDS_K;
    const lds_cptr vp0 = shm3 + LDS_V + ((lane >> 4) & 1) * 32 + (lane & 3) * 8 + (4 * hi + ((lane & 15) >> 2)) * 64;
    v8i kf[4];
    DMA_K(0, 0); DMA_V(0, 0); DMA_K(1, KSLOT);
    v8i qr[2];
    { const u32x4 a = *(const u32x4*)(Qw + 32 * hi), c = *(const u32x4*)(Qw + 32 * hi + 16); qr[0] = (v8i){(int)a.x, (int)a.y, (int)a.z, (int)a.w, (int)c.x, (int)c.y, (int)c.z, (int)c.w};
      u32x4 d = *(const u32x4*)(Qw + 64), e = *(const u32x4*)(Qw + 80); if (hi) { d = (u32x4){0u, 0u, 0u, 0u}; e = d; }
      qr[1] = (v8i){(int)d.x, (int)d.y, (int)d.z, (int)d.w, (int)e.x, (int)e.y, (int)e.z, (int)e.w}; }
    float l_reg = 0.f; f32x16 o[2]; o[0] = f32x16{}; o[1] = f32x16{};
    f32x16 pA0, pA1, pB0, pB1;
    int si_prev = 0, si_cur = 0, si_next = 1;
#define ROT() do { si_prev = si_cur; si_cur = si_next; si_next = (si_next == 2) ? 0 : si_next + 1; } while (0)
    DMA_K(2, 2 * KSLOT);
    WAIT_BAR(3);
    { pA0 = MF8(kfrag8(ks0, 0, 0, r32, hi), qr[0], f32x16{}); pA1 = MF8(kfrag8(ks0, 1, 0, r32, hi), qr[0], f32x16{});
      pA0 = MF8(kfrag8(ks0, 0, 1, r32, hi), qr[1], pA0); pA1 = MF8(kfrag8(ks0, 1, 1, r32, hi), qr[1], pA1); }
#pragma unroll
    for (int r = 0; r < 16; ++r) { pA0[r] = __builtin_amdgcn_exp2f(pA0[r]); pA1[r] = __builtin_amdgcn_exp2f(pA1[r]); }
    WAIT_BAR(0);
    DMA_K(3, 0); DMA_V(1, VSLOT);
    ROT();
    kf[0] = kfrag8(ks0 + si_cur * KSLOT, 0, 0, r32, hi); kf[1] = kfrag8(ks0 + si_cur * KSLOT, 0, 1, r32, hi); kf[2] = kfrag8(ks0 + si_cur * KSLOT, 1, 0, r32, hi); kf[3] = kfrag8(ks0 + si_cur * KSLOT, 1, 1, r32, hi);
    WAIT_BAR(2);
    s16x4 vlo[8], vhi[8]; u32x4 pw0, pw1, pw2, pw3;
#define PKW(P, B) cvtpk(P[B], P[B + 1])
#define PAF(k) __builtin_bit_cast(bf16x8, pw##k)
#define VFR(i) (bf16x8){vlo[i][0], vlo[i][1], vlo[i][2], vlo[i][3], vhi[i][0], vhi[i][1], vhi[i][2], vhi[i][3]}
#define PIN(x) asm volatile("" : "+v"(x))
#define MF(a, b, c) __builtin_amdgcn_mfma_f32_32x32x16_bf16(a, b, c, 0, 0, 0)
#define GAPA(MFX, A0, A1, A2, A3, W0, W1, PW) do { MFX; sacc += A0; sacc += A1; sacc += A2; sacc += A3; PIN(sacc); W0; W1; PIN(PW); SBAR(); } while (0)
#define GAPM(MFX) do { MFX; SBAR(); } while (0)
#define EX(v) __builtin_amdgcn_exp2f(v)
#define GAPB(MFX, X, B) do { MFX; X[B] = EX(X[B]); X[B + 1] = EX(X[B + 1]); X[B + 2] = EX(X[B + 2]); X[B + 3] = EX(X[B + 3]); PIN(X); SBAR(); } while (0)
#define VRD(i) do { vlo[i] = vtr(vp_ + (((i) >> 2) * 4096 + ((i) & 3) * 1024)); vhi[i] = vtr(vp_ + (((i) >> 2) * 4096 + ((i) & 3) * 1024 + 512)); } while (0)
#define KRD(G, j) do { if (G) { kf[j] = kfrag8(ks0 + si_next * KSLOT, (j) >> 1, (j) & 1, r32, hi); SBAR(); } } while (0)
#define GAPA8(MFX, A0, A1, A2, A3, A4, A5, A6, A7, W0, W1, W2, W3, PWa, PWb) do { MFX; sacc += A0; sacc += A1; sacc += A2; sacc += A3; PIN(sacc); W0; W1; PIN(PWa); sacc += A4; sacc += A5; sacc += A6; sacc += A7; PIN(sacc); W2; W3; PIN(PWb); SBAR(); } while (0)
#define STEP(C0, C1, P0, P1, t, GK, GV, GL) do { SBAR(); \
    const lds_cptr vp_ = vp0 + si_prev * VSLOT; \
    VRD(0); VRD(4); SBAR(); float sacc = (P0[0] + P0[1]); \
    GAPA8(C0 = MF8(kf[0], qr[0], f32x16{}), P0[2], P0[3], P0[4], P0[5], P0[6], P0[7], P0[8], P0[9],         pw0[0] = PKW(P0, 0), pw0[1] = PKW(P0, 2), pw0[2] = PKW(P0, 4), pw0[3] = PKW(P0, 6), pw0, pw0); \
    VRD(1); VRD(5); SBAR(); \
    GAPA8(C1 = MF8(kf[2], qr[0], f32x16{}), P0[10], P0[11], P0[12], P0[13], P0[14], P0[15], P1[0], P1[1],   pw1[0] = PKW(P0, 8), pw1[1] = PKW(P0, 10), pw1[2] = PKW(P0, 12), pw1[3] = PKW(P0, 14), pw1, pw1); \
    VRD(2); VRD(6); SBAR(); \
    GAPA8(C0 = MF8(kf[1], qr[1], C0),       P1[2], P1[3], P1[4], P1[5], P1[6], P1[7], P1[8], P1[9],         pw2[0] = PKW(P1, 0), pw2[1] = PKW(P1, 2), pw2[2] = PKW(P1, 4), pw2[3] = PKW(P1, 6), pw2, pw2); \
    VRD(3); VRD(7); SBAR(); \
    GAPA8(C1 = MF8(kf[3], qr[1], C1),       P1[10], P1[11], P1[12], P1[13], P1[14], P1[15], 0.f, 0.f,       pw3[0] = PKW(P1, 8), pw3[1] = PKW(P1, 10), pw3[2] = PKW(P1, 12), pw3[3] = PKW(P1, 14), pw3, pw3); \
    l_reg += sacc; \
    if (GK) { DMA_K((t) + 3, si_cur * KSLOT); } if (GV) { DMA_V((t) + 1, si_next * VSLOT); } \
    SBAR(); \
    GAPB(o[0] = MF(PAF(0), VFR(0), o[0]), C0, 0); \
    GAPB(o[1] = MF(PAF(0), VFR(4), o[1]), C0, 4); \
    KRD(GL, 0); GAPB(o[0] = MF(PAF(1), VFR(1), o[0]), C0, 8); \
    KRD(GL, 1); GAPB(o[1] = MF(PAF(1), VFR(5), o[1]), C0, 12); \
    KRD(GL, 2); GAPB(o[0] = MF(PAF(2), VFR(2), o[0]), C1, 0); \
    KRD(GL, 3); GAPB(o[1] = MF(PAF(2), VFR(6), o[1]), C1, 4); \
    GAPB(o[0] = MF(PAF(3), VFR(3), o[0]), C1, 8); \
    GAPB(o[1] = MF(PAF(3), VFR(7), o[1]), C1, 12); \
    } while (0)
    int t = 1;
    for (; t + 5 < NT; t += 2) {
        STEP(pB0, pB1, pA0, pA1, t, true, true, true);     WAIT_BAR(2); ROT();
        STEP(pA0, pA1, pB0, pB1, t + 1, true, true, true); WAIT_BAR(2); ROT();
    }
#define ENDW(tt) do { if ((tt) + 3 < NT) { WAIT_BAR(2); } else if ((tt) + 2 < NT) { WAIT_BAR(1); } else { WAIT_BAR(0); } } while (0)
    for (; t + 1 < NT; t += 2) {
        STEP(pB0, pB1, pA0, pA1, t, (t + 3 < NT), (t + 1 < NT), (t + 1 < NT));         ENDW(t);     ROT();
        STEP(pA0, pA1, pB0, pB1, t + 1, (t + 4 < NT), (t + 2 < NT), (t + 2 < NT));     ENDW(t + 1); ROT();
    }
    STEP(pB0, pB1, pA0, pA1, NT - 1, false, false, false);
    { float sacc = pB0[0] + pB0[1];
#pragma unroll
      for (int r = 2; r < 16; ++r) sacc += pB0[r];
#pragma unroll
      for (int r = 0; r < 16; ++r) sacc += pB1[r];
      l_reg += sacc;
      pw0 = (u32x4){PKW(pB0, 0), PKW(pB0, 2), PKW(pB0, 4), PKW(pB0, 6)}; pw1 = (u32x4){PKW(pB0, 8), PKW(pB0, 10), PKW(pB0, 12), PKW(pB0, 14)};
      pw2 = (u32x4){PKW(pB1, 0), PKW(pB1, 2), PKW(pB1, 4), PKW(pB1, 6)}; pw3 = (u32x4){PKW(pB1, 8), PKW(pB1, 10), PKW(pB1, 12), PKW(pB1, 14)};
      SBAR();
      const lds_cptr vp_ = vp0 + si_cur * VSLOT;
#pragma unroll
      for (int d0 = 0; d0 < 2; ++d0) {
          s16x4 lo4[4], hi4[4];
#pragma unroll
          for (int ks = 0; ks < 4; ++ks) { lo4[ks] = vtr(vp_ + d0 * 4096 + ks * 1024); hi4[ks] = vtr(vp_ + d0 * 4096 + ks * 1024 + 512); }
#define PK4(k) (bf16x8){lo4[k][0], lo4[k][1], lo4[k][2], lo4[k][3], hi4[k][0], hi4[k][1], hi4[k][2], hi4[k][3]}
          o[d0] = MF(PAF(0), PK4(0), o[d0]); o[d0] = MF(PAF(1), PK4(1), o[d0]); o[d0] = MF(PAF(2), PK4(2), o[d0]); o[d0] = MF(PAF(3), PK4(3), o[d0]);
#undef PK4
      } }
    l_reg = swapsum(l_reg);
    if (hi == 0) wsf[32 + r32] = l_reg;
    asm volatile("s_waitcnt lgkmcnt(0)" ::: "memory");
    float rli[16];
#pragma unroll
    for (int r = 0; r < 16; ++r) rli[r] = __builtin_amdgcn_rcpf(wsf[32 + crow(r, hi)]);
    bf16_t* Ow = O + (rowbase + q0 + wid * QBLK) * 512 + h * 64;
    { LAS bf16_t* stg = (LAS bf16_t*)(shm + LDS_OST) + wid * 2048;
#pragma unroll
      for (int r = 0; r < 16; ++r) { const int orow = crow(r, hi);
#pragma unroll
          for (int d0 = 0; d0 < 2; ++d0) stg[orow * 64 + d0 * 32 + r32] = (bf16_t)f2bf(o[d0][r] * rli[r]); }
      asm volatile("s_waitcnt lgkmcnt(0)" ::: "memory");
#pragma unroll
      for (int i = 0; i < 4; ++i) { const int row = i * 8 + (lane >> 3), ch = lane & 7; const u32x4 v = *(const LAS u32x4*)(stg + row * 64 + ch * 8); *(u32x4*)(Ow + (long)row * 512 + ch * 8) = v; } }
    asm volatile("s_waitcnt lgkmcnt(0)\n\ts_barrier" ::: "memory");
#undef DMA_K
#undef DMA_V
#undef ROT
#undef PKW
#undef PAF
#undef VFR
#undef PIN
#undef MF
#undef GAPA
#undef GAPA8
#undef GAPM
#undef GAPB
#undef EX
#undef VRD
#undef KRD
#undef STEP
#undef ENDW
}
#undef SBAR
#undef WAIT_BAR
#undef MF8
}

template <bool F8, class CM> __device__ __forceinline__ void tr_item(const float* W, int ld, const float* rs, bf16_t* WT, int K, int k0, int n0, const CM& cm, LAS float* scr, int lane) {
    const int n = lane & 31, sc = cm.col(n0 + n); const float cs = cm.scale(n0 + n);
#pragma unroll 8
    for (int i = 0; i < 32; ++i) { const int kk = 2 * i + (lane >> 5); float v = 0.f; if (sc >= 0) v = W[(size_t)(k0 + kk) * ld + sc] * cs * (rs ? rs[k0 + kk] : 1.f); scr[kk * 33 + n] = v; }
    asm volatile("s_waitcnt lgkmcnt(0)" ::: "memory");
    const int c = lane & 7;
#pragma unroll
    for (int j = 0; j < 4; ++j) { const int nn = (lane >> 3) + 8 * j; const LAS float* s = scr + (8 * c) * 33 + nn;
        if constexpr (F8) { *(u32x2*)((unsigned char*)WT + (size_t)(n0 + nn) * K + k0 + 8 * c) = (u32x2){pack4_fp8(s[0 * 33], s[1 * 33], s[2 * 33], s[3 * 33]), pack4_fp8(s[4 * 33], s[5 * 33], s[6 * 33], s[7 * 33])}; }
        else { u32x4 o; o.x = pk2(s[0 * 33], s[1 * 33]); o.y = pk2(s[2 * 33], s[3 * 33]); o.z = pk2(s[4 * 33], s[5 * 33]); o.w = pk2(s[6 * 33], s[7 * 33]);
        *(u32x4*)(WT + (size_t)(n0 + nn) * K + k0 + 8 * c) = o; } }
    asm volatile("s_waitcnt lgkmcnt(0)" ::: "memory");
}
template <bool F8, class CM> __device__ __forceinline__ void tr_item4(const float* W, int ld, const float* rs, bf16_t* WT, int K, int k0, int n0, const CM& cm, LAS float* scr, int lane) {
    const int n4 = (lane & 7) * 4, sc = cm.col(n0 + n4); const float cs = cm.scale(n0 + n4);
    f32x4 v[8];
#pragma unroll
    for (int i = 0; i < 8; ++i) { const int kk = (lane >> 3) + 8 * i; v[i] = (sc >= 0) ? *(const f32x4*)(W + (size_t)(k0 + kk) * ld + sc) : (f32x4){0.f, 0.f, 0.f, 0.f}; }
#pragma unroll
    for (int i = 0; i < 8; ++i) { const int kk = (lane >> 3) + 8 * i; const float r = cs * (rs ? rs[k0 + kk] : 1.f); LAS float* d = scr + kk * 33 + n4; d[0] = v[i].x * r; d[1] = v[i].y * r; d[2] = v[i].z * r; d[3] = v[i].w * r; }
    asm volatile("s_waitcnt lgkmcnt(0)" ::: "memory");
    const int c = lane & 7;
#pragma unroll
    for (int j = 0; j < 4; ++j) { const int nn = (lane >> 3) + 8 * j; const LAS float* s = scr + (8 * c) * 33 + nn;
        if constexpr (F8) { *(u32x2*)((unsigned char*)WT + (size_t)(n0 + nn) * K + k0 + 8 * c) = (u32x2){pack4_fp8(s[0 * 33], s[1 * 33], s[2 * 33], s[3 * 33]), pack4_fp8(s[4 * 33], s[5 * 33], s[6 * 33], s[7 * 33])}; }
        else { u32x4 o; o.x = pk2(s[0 * 33], s[1 * 33]); o.y = pk2(s[2 * 33], s[3 * 33]); o.z = pk2(s[4 * 33], s[5 * 33]); o.w = pk2(s[6 * 33], s[7 * 33]);
        *(u32x4*)(WT + (size_t)(n0 + nn) * K + k0 + 8 * c) = o; } }
    asm volatile("s_waitcnt lgkmcnt(0)" ::: "memory");
}
struct CmIn {
    __device__ __forceinline__ int col(int n) const {
        if (n < 1920) return n;
        if (n < 1952) { const int j = n - 1920, i = j >> 1; return 1920 + ((j & 1) ? i + 16 : i); }
        if (n < 2048) return -1;
        if (n < 3072) return 1952 + (n - 2048);
        return 2976 + (n - 3072);
    }
    __device__ __forceinline__ float scale(int n) const { return n < 512 ? 0.125f * LOG2E : 1.f; }
    __device__ __forceinline__ bool regular(int n0) const { return n0 < 1920 || n0 >= 1952; }
};
struct CmUq {
    __device__ __forceinline__ int col(int n) const { const int h = n / 96, w = n % 96; if (w < 64) return n; const int j = w - 64, i = j >> 1; return h * 96 + 64 + ((j & 1) ? i + 16 : i); }
    __device__ __forceinline__ float scale(int) const { return 0.10206207261596577f * LOG2E; }
    __device__ __forceinline__ bool regular(int n0) const { return (n0 % 96) < 64; }
};
struct CmId64 { __device__ __forceinline__ int col(int n) const { return n; } __device__ __forceinline__ float scale(int) const { return 64.f; } __device__ __forceinline__ bool regular(int) const { return true; } };
struct CmId { int off; __device__ __forceinline__ int col(int n) const { return n - off; } __device__ __forceinline__ float scale(int) const { return 1.f; } __device__ __forceinline__ bool regular(int) const { return true; } };
struct CmGu {
    __device__ __forceinline__ int col(int n) const { const int pn = n >> 8, w = n & 255; return w < 128 ? 128 * pn + w : 1024 + 128 * pn + (w - 128); }
    __device__ __forceinline__ float scale(int) const { return 64.f; }
    __device__ __forceinline__ bool regular(int) const { return true; }
};
template <class CM, bool F8 = false> __device__ __forceinline__ void tr_any(const float* W, int ld, const float* rs, bf16_t* WT, int K, int k0, int n0, const CM& cm, LAS float* scr, int lane) {
    if (cm.regular(n0)) tr_item4<F8>(W, ld, rs, WT, K, k0, n0, cm, scr, lane); else tr_item<F8>(W, ld, rs, WT, K, k0, n0, cm, scr, lane);
}

struct Args { const float* in[19]; float* out; unsigned char* ws; int ph_lo, ph_hi, li, pad; };

__device__ __forceinline__ void p0_prologue(const Args& a, LAS unsigned char* lds, int wave, int lane) {
    LAS float* scr = (LAS float*)(lds + wave * 16384);
    const int gw = blockIdx.x * NWAVES + wave, NGW = gridDim.x * NWAVES;
    unsigned char* ws = a.ws;
    constexpr int I_IN = 16 * 128, I_UQ = 4 * 24, I_UK = 2 * 16, I_UV = 2 * 16, I_A = 8 * 32, I_B = 8 * 32, I_O = 16 * 32, I_GU = 32 * 16 * 64, I_D = 32 * 16 * 32;
    constexpr int NITEMS = I_IN + I_UQ + I_UK + I_UV + I_A + I_B + I_O + I_GU + I_D;
    for (int it = gw; it < NITEMS; it += NGW) {
        int r = it;
        if (r < I_IN) { tr_any(a.in[2], 4000, a.in[1], (bf16_t*)(ws + WS_WIN), 1024, 64 * (r / 128), 32 * (r % 128), CmIn{}, scr, lane); continue; } r -= I_IN;
        if (r < I_UQ) { tr_any(a.in[5], 768, a.in[3], (bf16_t*)(ws + WS_WUQ), 256, 64 * (r / 24), 32 * (r % 24), CmUq{}, scr, lane); continue; } r -= I_UQ;
        if (r < I_UK) { tr_any(a.in[6], 512, a.in[4], (bf16_t*)(ws + WS_WUKV), 128, 64 * (r / 16), 32 * (r % 16), CmId{0}, scr, lane); continue; } r -= I_UK;
        if (r < I_UV) { tr_any(a.in[7], 512, a.in[4], (bf16_t*)(ws + WS_WUKV), 128, 64 * (r / 16), 512 + 32 * (r % 16), CmId{512}, scr, lane); continue; } r -= I_UV;
        if (r < I_A) { tr_any(a.in[8], 1024, nullptr, (bf16_t*)(ws + WS_WA), 512, 64 * (r / 32), 32 * (r % 32), CmId{0}, scr, lane); continue; } r -= I_A;
        if (r < I_B) { tr_any(a.in[9], 1024, nullptr, (bf16_t*)(ws + WS_WB), 512, 64 * (r / 32), 32 * (r % 32), CmId{0}, scr, lane); continue; } r -= I_B;
        if (r < I_O) { tr_any(a.in[10], 1024, nullptr, (bf16_t*)(ws + WS_WO), 1024, 64 * (r / 32), 32 * (r % 32), CmId{0}, scr, lane); continue; } r -= I_O;
        if (r < I_GU) { const int e = r / 1024, q = r % 1024; tr_any<CmGu, true>(a.in[14] + (size_t)e * 1024 * 2048, 2048, a.in[11], (bf16_t*)(ws + WS_WGU + (size_t)e * 2048 * 1024), 1024, 64 * (q / 64), 32 * (q % 64), CmGu{}, scr, lane); continue; } r -= I_GU;
        { const int e = r / 512, q = r % 512; tr_any<CmId64, true>(a.in[16] + (size_t)e * 1024 * 1024, 1024, nullptr, (bf16_t*)(ws + WS_WD + (size_t)e * 1024 * 1024), 1024, 64 * (q / 32), 32 * (q % 32), CmId64{}, scr, lane); }
    }
    for (int m = gw; m < T; m += NGW) {
        const f32x4* xr = (const f32x4*)(a.in[0] + (size_t)m * DM) + lane;
        f32x4 v[4]; float s2 = 0.f;
#pragma unroll
        for (int j = 0; j < 4; ++j) { v[j] = xr[64 * j]; s2 += (v[j].x * v[j].x + v[j].y * v[j].y) + (v[j].z * v[j].z + v[j].w * v[j].w); }
        const float rstd = 1.f / sqrtf(wave_sum(s2) * (1.f / DM) + EPS);
        u32x2* o8 = (u32x2*)((bf16_t*)(ws + WS_XB) + (size_t)m * DM) + lane;
#pragma unroll
        for (int j = 0; j < 4; ++j) o8[64 * j] = (u32x2){pk2(v[j].x * rstd, v[j].y * rstd), pk2(v[j].z * rstd, v[j].w * rstd)};
    }
    const int gt = blockIdx.x * NTHREADS + threadIdx.x, NGT = gridDim.x * NTHREADS;
    for (int idx = gt; idx < SEQ * 16; idx += NGT) {
        ((f32x2*)(ws + WS_ROPE))[idx] = rope_cs(idx >> 4, idx & 15);
    }
    for (int idx = gt; idx < 1024 * 32; idx += NGT) ((float*)(ws + WS_WRP))[idx] = a.in[12][idx] * a.in[11][idx >> 5];
}

__device__ __forceinline__ void p2_stats(const Args& a, int wave, int lane) {
    const int gw = blockIdx.x * NWAVES + wave, NGW = gridDim.x * NWAVES; unsigned char* ws = a.ws;
    for (int m = gw; m < T; m += NGW) {
        const u32x2 q = ((const u32x2*)((const bf16_t*)(ws + WS_CQ) + (size_t)m * 256))[lane];
        const unsigned kv = ((const unsigned*)((const bf16_t*)(ws + WS_CKV) + (size_t)m * 128))[lane];
        const float a0 = bflo(q.x), a1 = bfhi(q.x), a2 = bflo(q.y), a3 = bfhi(q.y), b0 = bflo(kv), b1 = bfhi(kv);
        const float sq = wave_sum((a0 * a0 + a1 * a1) + (a2 * a2 + a3 * a3)), sk = wave_sum(b0 * b0 + b1 * b1);
        if (lane == 0) { ((float*)(ws + WS_RSTDQ))[m] = 1.f / sqrtf(sq * (1.f / 256.f) + EPS); ((float*)(ws + WS_RSTDKV))[m] = 1.f / sqrtf(sk * (1.f / 128.f) + EPS); }
        if (lane < 32) { const int b = m >> 14, sq2 = m & (SEQ - 1); const u32x4 kr = *(const u32x4*)((const bf16_t*)(ws + WS_KR) + (size_t)m * 32 + 8 * (lane & 3));
            *(u32x4*)((bf16_t*)(ws + WS_KIMG) + (size_t)((b * 8 + (lane >> 2)) * 256 + (sq2 >> 6)) * 6144 + (8 + (lane & 3)) * 512 + (sq2 & 63) * 8) = kr; }
        if (lane < 16) { const int b = m >> 14, sq2 = m & (SEQ - 1); const bf16_t* kp = (const bf16_t*)(ws + WS_KR) + (size_t)m * 32 + 16 * (lane & 1);
            float k0[8], k1[8]; unpack8(*(const u32x4*)kp, k0); unpack8(*(const u32x4*)(kp + 8), k1);
            *(u32x4*)(ws + WS_K8 + (size_t)((b * 8 + (lane >> 1)) * 256 + (sq2 >> 6)) * 6144 + (4 + (lane & 1)) * 1024 + (sq2 & 63) * 16) =
                (u32x4){pack4_fp8(k0[0], k0[1], k0[2], k0[3]), pack4_fp8(k0[4], k0[5], k0[6], k0[7]), pack4_fp8(k1[0], k1[1], k1[2], k1[3]), pack4_fp8(k1[4], k1[5], k1[6], k1[7])}; }
    }
}

__device__ __forceinline__ void p4_dilated(const Args& a, LAS unsigned char* lds, volatile LAS unsigned* MISC, int wave, int lane) {
    unsigned char* ws = a.ws;
    const int r32 = lane & 31, hi = lane >> 5;
    {
        LAS unsigned* nm = (LAS unsigned*)(MISC + MI_NRM);
        if (threadIdx.x < 32) nm[threadIdx.x] = 0u;
        __syncthreads();
        const bf16_t* QB = (const bf16_t*)(ws + WS_QB); const bf16_t* KIM = (const bf16_t*)(ws + WS_KIMG); const bf16_t* KR = (const bf16_t*)(ws + WS_KR);
        const int gw = blockIdx.x * NWAVES + wave, NGW = gridDim.x * NWAVES;
        for (int t = gw; t < T; t += NGW) {
            const int b = t >> 14;
            const u32x2* qp = (const u32x2*)(QB + (size_t)t * 768 + 12 * lane);
            const u32x2 q0 = qp[0], q1 = qp[1], q2 = qp[2];
            float sq = (bflo(q0.x) * bflo(q0.x) + bfhi(q0.x) * bfhi(q0.x)) + (bflo(q0.y) * bflo(q0.y) + bfhi(q0.y) * bfhi(q0.y));
            sq += (bflo(q1.x) * bflo(q1.x) + bfhi(q1.x) * bfhi(q1.x)) + (bflo(q1.y) * bflo(q1.y) + bfhi(q1.y) * bfhi(q1.y));
            sq += (bflo(q2.x) * bflo(q2.x) + bfhi(q2.x) * bfhi(q2.x)) + (bflo(q2.y) * bflo(q2.y) + bfhi(q2.y) * bfhi(q2.y));
            float kk8[8]; unpack8(*(const u32x4*)(KIM + (size_t)((b * 8 + (lane >> 3)) * 256 + ((t & (SEQ - 1)) >> 6)) * 6144 + (lane & 7) * 512 + (t & 63) * 8), kk8);
            float sk = 0.f;
#pragma unroll
            for (int j = 0; j < 8; ++j) sk += kk8[j] * kk8[j];
            float kr8[8]; unpack8(*(const u32x4*)(KR + (size_t)t * 32 + 8 * (lane & 3)), kr8);
            float sr = 0.f;
#pragma unroll
            for (int j = 0; j < 8; ++j) sr += kr8[j] * kr8[j];
            sr += __shfl_xor(sr, 1); sr += __shfl_xor(sr, 2);
            sq += __shfl_xor(sq, 1); sq += __shfl_xor(sq, 2); sq += __shfl_xor(sq, 4);
            sk += __shfl_xor(sk, 1); sk += __shfl_xor(sk, 2); sk += __shfl_xor(sk, 4);
            sk += sr;
            if ((lane & 7) == 0) { const int hh = lane >> 3;
                __hip_atomic_fetch_max(&nm[b * 8 + hh], __float_as_uint(sq), __ATOMIC_RELAXED, __HIP_MEMORY_SCOPE_WORKGROUP);
                __hip_atomic_fetch_max(&nm[16 + b * 8 + hh], __float_as_uint(sk), __ATOMIC_RELAXED, __HIP_MEMORY_SCOPE_WORKGROUP); }
        }
        __syncthreads();
        if (threadIdx.x < 32) __hip_atomic_fetch_max((unsigned*)(ws + WS_CTL) + CW_NRM + threadIdx.x, nm[threadIdx.x], __ATOMIC_RELAXED, __HIP_MEMORY_SCOPE_AGENT);
    }
    __syncthreads();
    const bf16_t* QA = (const bf16_t*)(ws + WS_QA); const bf16_t* KA = (const bf16_t*)(ws + WS_KA); const bf16_t* VA = (const bf16_t*)(ws + WS_VA);
    bf16_t* PO = (bf16_t*)(ws + WS_PARTO); float* PL = (float*)(ws + WS_PARTL);
    constexpr int DK = 0, DV = 49152, DWS = 98304;
    const unsigned lds0 = (unsigned)(uintptr_t)lds;
    LAS float* wsf = (LAS float*)(lds + DWS) + wave * 64;
    for (int un = blockIdx.x; un < NB * 8 * 192; un += gridDim.x) {
        const int bh = un / 192, within = un % 192, b = bh >> 3, h = bh & 7;
        int p, dil, res, blk, L;
        if (within < 64) { p = 0; dil = 1; res = 0; blk = within; L = SEQ; }
        else if (within < 128) { p = 1; dil = 4; res = (within - 64) >> 4; blk = (within - 64) & 15; L = SEQ / 4; }
        else { p = 2; dil = 16; res = (within - 128) >> 2; blk = (within - 128) & 3; L = SEQ / 16; }
        const size_t bo = (size_t)b * SEQ; const int u0w = 256 * blk - 64;
#pragma unroll
        for (int j = 0; j < 6; ++j) {
            int uk = u0w + 64 * j + lane; uk = uk < 0 ? 0 : (uk >= L ? L - 1 : uk);
            mla::glds16(KA + (bo + (size_t)(res + dil * uk)) * 512 + h * 64 + wave * 8, (unsigned)__builtin_amdgcn_readfirstlane(lds0 + DK + j * 8192 + wave * 1024));
            int uv = u0w + 64 * j + 16 * (wave & 3) + (lane >> 2); uv = uv < 0 ? 0 : (uv >= L ? L - 1 : uv);
            mla::glds16(VA + (bo + (size_t)(res + dil * uv)) * 512 + h * 64 + (wave >> 2) * 32 + (lane & 3) * 8, (unsigned)__builtin_amdgcn_readfirstlane(lds0 + DV + j * 8192 + wave * 1024));
        }
        const int ur = 256 * blk + 32 * wave;
        const size_t tq = bo + (size_t)(res + dil * (ur + r32));
        bf16x8 qf[4];
#pragma unroll
        for (int d0 = 0; d0 < 4; ++d0) qf[d0] = *(const bf16x8*)(QA + tq * 512 + h * 64 + 16 * d0 + 8 * hi);
        const float slope2d = __builtin_amdgcn_exp2f(-(float)(h + 1)) * LOG2E * (float)dil;
        asm volatile("s_waitcnt vmcnt(0)\n\ts_barrier" ::: "memory");
        f32x16 o0 = {}, o1 = {}; float m_run = -1e30f, l_run = 0.f;
#pragma unroll 1
        for (int ci = 0; ci < 5; ++ci) {
            const int c = ci == 0 ? 2 : ci == 1 ? 1 : ci == 2 ? 3 : ci == 3 ? 0 : 4;
            const int cw = wave + c, j = cw >> 1, n = cw & 1;
            const LAS char* kp = (const LAS char*)lds + DK + j * 8192 + hi * 1024 + (32 * n + r32) * 16;
            f32x16 s = {};
#pragma unroll
            for (int d0 = 0; d0 < 4; ++d0) s = __builtin_amdgcn_mfma_f32_32x32x16_bf16(*(const LAS bf16x8*)(kp + d0 * 2048), qf[d0], s, 0, 0, 0);
            { const float c0 = (float)(32 * c - 64); const int vb = ur - 64 + 32 * c;
#pragma unroll
              for (int r = 0; r < 16; ++r) { const float d = (float)(crow(r, hi) - r32); s[r] = s[r] - slope2d * fabsf(d + c0); }
              if (c == 0) {
#pragma unroll
                  for (int r = 0; r < 16; ++r) s[r] = (crow(r, hi) >= r32) ? s[r] : -1e30f; }
              if (c == 4) {
#pragma unroll
                  for (int r = 0; r < 16; ++r) s[r] = (crow(r, hi) <= r32) ? s[r] : -1e30f; }
              if (vb < 0 || vb + 31 >= L) {
#pragma unroll
                  for (int r = 0; r < 16; ++r) { const int v = vb + crow(r, hi); s[r] = (v >= 0 && v < L) ? s[r] : -1e30f; } } }
            float mx = s[0];
#pragma unroll
            for (int r = 1; r < 16; ++r) mx = fmaxf(mx, s[r]);
            mx = swapmax(mx);
            const float mn = fmaxf(m_run, mx), alpha = fexp2(m_run - mn);
            float ps = 0.f;
#pragma unroll
            for (int r = 0; r < 16; ++r) { s[r] = fexp2(s[r] - mn); ps += s[r]; }
            l_run = l_run * alpha + ps; m_run = mn;
            if (__any(alpha != 1.f)) {
                if (hi == 0) wsf[r32] = alpha;
#pragma unroll
                for (int r = 0; r < 16; ++r) { const float al = wsf[crow(r, hi)]; o0[r] *= al; o1[r] *= al; }
            }
            const u32x4 pw0 = {cvtpk(s[0], s[1]), cvtpk(s[2], s[3]), cvtpk(s[4], s[5]), cvtpk(s[6], s[7])};
            const u32x4 pw1 = {cvtpk(s[8], s[9]), cvtpk(s[10], s[11]), cvtpk(s[12], s[13]), cvtpk(s[14], s[15])};
            const bf16x8 pa0 = __builtin_bit_cast(bf16x8, pw0), pa1 = __builtin_bit_cast(bf16x8, pw1);
            const LAS char* vp = (const LAS char*)lds + DV + j * 8192 + n * 2048 + ((lane >> 4) & 1) * 32 + (lane & 3) * 8 + (4 * hi + ((lane & 15) >> 2)) * 64;
#pragma unroll
            for (int ks = 0; ks < 2; ++ks) {
                const s16x4 l0 = vtr(vp + ks * 1024), h0 = vtr(vp + ks * 1024 + 512), l1 = vtr(vp + 4096 + ks * 1024), h1 = vtr(vp + 4096 + ks * 1024 + 512);
                const bf16x8 v0 = {l0[0], l0[1], l0[2], l0[3], h0[0], h0[1], h0[2], h0[3]}, v1 = {l1[0], l1[1], l1[2], l1[3], h1[0], h1[1], h1[2], h1[3]};
                o0 = __builtin_amdgcn_mfma_f32_32x32x16_bf16(ks == 0 ? pa0 : pa1, v0, o0, 0, 0, 0);
                o1 = __builtin_amdgcn_mfma_f32_32x32x16_bf16(ks == 0 ? pa0 : pa1, v1, o1, 0, 0, 0);
            }
        }
        const float lt = swapsum(l_run);
        if (hi == 0) { wsf[32 + r32] = lt; PL[(((size_t)p * NB + b) * 8 + h) * SEQ + (res + dil * (ur + r32))] = m_run + __builtin_amdgcn_logf(lt); }
        asm volatile("s_waitcnt lgkmcnt(0)\n\ts_barrier" ::: "memory");
        { LAS bf16_t* stg = (LAS bf16_t*)(lds + DK) + wave * 2048;
#pragma unroll
          for (int r = 0; r < 16; ++r) { const int q = crow(r, hi); const float il = frcp(wsf[32 + q]);
              stg[q * 64 + r32] = (bf16_t)f2bf(o0[r] * il); stg[q * 64 + 32 + r32] = (bf16_t)f2bf(o1[r] * il); }
#pragma unroll
          for (int i = 0; i < 4; ++i) { const int row = i * 8 + (lane >> 3), ch = lane & 7; const u32x4 v = *(const LAS u32x4*)(stg + row * 64 + ch * 8);
              *(u32x4*)(PO + ((size_t)p * T + bo + (size_t)(res + dil * (ur + row))) * 512 + h * 64 + ch * 8) = v; } }
        asm volatile("s_waitcnt lgkmcnt(0)\n\ts_barrier" ::: "memory");
    }
}
__device__ __forceinline__ void p5_combine(const Args& a, int wave, int lane) {
    unsigned char* ws = a.ws; const bf16_t* PO = (const bf16_t*)(ws + WS_PARTO); const float* PL = (const float*)(ws + WS_PARTL); bf16_t* OA = (bf16_t*)(ws + WS_OA);
    const int gw = blockIdx.x * NWAVES + wave, NGW = gridDim.x * NWAVES;
    for (int it = gw; it < T; it += NGW) {
        const int t = it, b = t >> 14, s = t & (SEQ - 1), h = lane >> 3, ch = lane & 7;
        const float l0 = PL[(((size_t)0 * NB + b) * 8 + h) * SEQ + s], l1 = PL[(((size_t)1 * NB + b) * 8 + h) * SEQ + s], l2 = PL[(((size_t)2 * NB + b) * 8 + h) * SEQ + s];
        const float mx = fmaxf(fmaxf(l0, l1), l2); float w0 = fexp2(l0 - mx), w1 = fexp2(l1 - mx), w2 = fexp2(l2 - mx); const float iw = frcp(w0 + w1 + w2); w0 *= iw; w1 *= iw; w2 *= iw;
        float v0[8], v1[8], v2[8], o[8];
        unpack8(*(const u32x4*)(PO + ((size_t)0 * T + t) * 512 + h * 64 + ch * 8), v0);
        unpack8(*(const u32x4*)(PO + ((size_t)1 * T + t) * 512 + h * 64 + ch * 8), v1);
        unpack8(*(const u32x4*)(PO + ((size_t)2 * T + t) * 512 + h * 64 + ch * 8), v2);
#pragma unroll
        for (int j = 0; j < 8; ++j) o[j] = w0 * v0[j] + w1 * v1[j] + w2 * v2[j];
        *(u32x4*)(OA + (size_t)t * 512 + h * 64 + ch * 8) = pack8(o);
    }
}
__device__ __forceinline__ void p5_mla(const Args& a, LAS unsigned char* lds, int wave, int lane) {
    unsigned char* ws = a.ws;
    LAS char* vimg = (LAS char*)(lds + wave * 8192); LAS float* wsf = (LAS float*)(lds + wave * 8192 + 4096);
    const int r32 = lane & 31, hi = lane >> 5;
    const bf16_t* QB = (const bf16_t*)(ws + WS_QB); const bf16_t* KIM = (const bf16_t*)(ws + WS_KIMG); const bf16_t* VIM = (const bf16_t*)(ws + WS_VIMG);
    bf16_t* OB = (bf16_t*)(ws + WS_OB);
    const unsigned* nrm = (const unsigned*)(ws + WS_CTL) + CW_NRM;
    for (int un = blockIdx.x; un < NB * 8 * 64; un += gridDim.x) {
        const int qb = un & 63, h = (un >> 6) & 7, b = un >> 9;
        const float mq = __uint_as_float(__hip_atomic_load(nrm + b * 8 + h, __ATOMIC_RELAXED, __HIP_MEMORY_SCOPE_AGENT)), mk = __uint_as_float(__hip_atomic_load(nrm + 16 + b * 8 + h, __ATOMIC_RELAXED, __HIP_MEMORY_SCOPE_AGENT));
        bool fast = (mq * mk < 3600.f) && (mq < 700.f) && (mk < 160000.f);
#ifdef MLA_FORCE_GENERAL
        fast = false;
#endif
#ifdef MLA_BF16_FAST
        if (__builtin_amdgcn_readfirstlane((int)fast)) mla::mla_unit(b, h, qb, QB, KIM + (size_t)(b * 8 + h) * 256 * 6144, VIM + (size_t)(b * 8 + h) * 256 * 4096, OB, (LAS char*)lds);
#else
        if (__builtin_amdgcn_readfirstlane((int)fast)) mla8::mla8_unit(b, h, qb, (const unsigned char*)(ws + WS_Q8), (const unsigned char*)(ws + WS_K8) + (size_t)(b * 8 + h) * 256 * 6144, VIM + (size_t)(b * 8 + h) * 256 * 4096, OB, (LAS char*)lds);
#endif
    }
    for (int un = blockIdx.x; un < NB * 8 * 64; un += gridDim.x) {
        const int qb = un & 63, h = (un >> 6) & 7, b = un >> 9;
        const float mq = __uint_as_float(__hip_atomic_load(nrm + b * 8 + h, __ATOMIC_RELAXED, __HIP_MEMORY_SCOPE_AGENT)), mk = __uint_as_float(__hip_atomic_load(nrm + 16 + b * 8 + h, __ATOMIC_RELAXED, __HIP_MEMORY_SCOPE_AGENT));
        bool fast = (mq * mk < 3600.f) && (mq < 700.f) && (mk < 160000.f);
#ifdef MLA_FORCE_GENERAL
        fast = false;
#endif
        if (!__builtin_amdgcn_readfirstlane((int)fast)) {
            const size_t bo = (size_t)b * SEQ, tq0 = bo + (size_t)qb * 256 + wave * 32;
            MlaKL kl; kl.K = KIM + (size_t)(b * 8 + h) * 256 * 6144; kl.V = VIM + (size_t)(b * 8 + h) * 256 * 4096;
            bf16x8 qf[6];
#pragma unroll
            for (int d0 = 0; d0 < 6; ++d0) qf[d0] = *(const bf16x8*)(QB + (tq0 + r32) * 768 + h * 96 + 16 * d0 + 8 * hi);
            AttnState st; wave_attn<6>(st, qf, kl, SEQ / 32, vimg, wsf, lane);
            (void)attn_finish(st, vimg, wsf, lane);
#pragma unroll
            for (int i = 0; i < 4; ++i) { const int row = i * 8 + (lane >> 3), ch = lane & 7; const u32x4 v = *(const LAS u32x4*)(vimg + row * 128 + ch * 16);
                *(u32x4*)(OB + (tq0 + row) * 512 + h * 64 + ch * 8) = v; }
        }
    }
}

__device__ __forceinline__ void p8_router(const Args& a, LAS unsigned char* lds, volatile LAS unsigned* MISC, int wave, int lane) {
    unsigned char* ws = a.ws; const float* x1 = a.out; const float* wrp = (const float*)(ws + WS_WRP); const float* br = a.in[13];
    LAS float* lg = (LAS float*)(lds + wave * 8192);
    LAS unsigned* hist = (LAS unsigned*)(MISC + MI_HIST);
    if (threadIdx.x < 32) hist[threadIdx.x] = 0u;
    __syncthreads();
    const int G = gridDim.x, i32 = lane & 31, hi = lane >> 5;
    for (int tb = wave * G + blockIdx.x; tb < T / 32; tb += G * NWAVES) {
        const int t = tb * 32 + i32;
        const float* xr = x1 + (size_t)t * DM + 512 * hi; const float* wr_ = wrp + (size_t)(512 * hi) * 32 + i32;
        f32x16 acc = {}; float ssq = 0.f;
#pragma unroll 4
        for (int s4 = 0; s4 < 128; ++s4) {
            const f32x4 xa = *(const f32x4*)(xr + 4 * s4);
            ssq += (xa.x * xa.x + xa.y * xa.y) + (xa.z * xa.z + xa.w * xa.w);
            acc = __builtin_amdgcn_mfma_f32_32x32x2f32(xa.x, wr_[(4 * s4 + 0) * 32], acc, 0, 0, 0);
            acc = __builtin_amdgcn_mfma_f32_32x32x2f32(xa.y, wr_[(4 * s4 + 1) * 32], acc, 0, 0, 0);
            acc = __builtin_amdgcn_mfma_f32_32x32x2f32(xa.z, wr_[(4 * s4 + 2) * 32], acc, 0, 0, 0);
            acc = __builtin_amdgcn_mfma_f32_32x32x2f32(xa.w, wr_[(4 * s4 + 3) * 32], acc, 0, 0, 0);
        }
        ssq = swapsum(ssq);
        const float rstd = 1.f / sqrtf(ssq * (1.f / DM) + EPS);
#pragma unroll
        for (int r = 0; r < 16; ++r) lg[crow(r, hi) * 33 + i32] = acc[r];
        asm volatile("s_waitcnt lgkmcnt(0)" ::: "memory");
        float v[32];
#pragma unroll
        for (int e = 0; e < 32; ++e) v[e] = lg[i32 * 33 + e] * rstd + br[e];
        int ti[4]; float tv[4];
#pragma unroll
        for (int k = 0; k < 4; ++k) {
            float best = v[0]; int bi = 0;
#pragma unroll
            for (int e = 1; e < 32; ++e) { const bool g = v[e] > best; best = g ? v[e] : best; bi = g ? e : bi; }
            ti[k] = bi; tv[k] = best;
#pragma unroll
            for (int e = 0; e < 32; ++e) v[e] = (e == bi) ? -3.0e38f : v[e];
        }
        const float e1 = __expf(tv[1] - tv[0]), e2 = __expf(tv[2] - tv[0]), e3 = __expf(tv[3] - tv[0]); const float inv = 1.f / (1.f + e1 + e2 + e3);
        const float gw[4] = {inv, e1 * inv, e2 * inv, e3 * inv};
        if (hi == 0) {
            ((float*)(ws + WS_RSTD2))[t] = rstd;
#pragma unroll
            for (int k = 0; k < 4; ++k) { const unsigned rk = __hip_atomic_fetch_add(&hist[ti[k]], 1u, __ATOMIC_RELAXED, __HIP_MEMORY_SCOPE_WORKGROUP);
                ((int*)(ws + WS_TOPI))[t * 4 + k] = ti[k]; ((float*)(ws + WS_GATEW))[t * 4 + k] = gw[k]; ((int*)(ws + WS_SRANK))[t * 4 + k] = (int)rk; }
        }
        asm volatile("s_waitcnt lgkmcnt(0)" ::: "memory");
    }
    __syncthreads();
    if (threadIdx.x < 32) {
        const unsigned c = hist[threadIdx.x];
        const unsigned base = __hip_atomic_fetch_add((unsigned*)(ws + WS_CTL) + CW_GCOUNT + threadIdx.x, c, __ATOMIC_RELAXED, __HIP_MEMORY_SCOPE_AGENT);
        ((int*)(ws + WS_WGBASE))[blockIdx.x * 32 + threadIdx.x] = (int)base;
    }
}
__device__ __forceinline__ void moe_prefix(const Args& a, volatile LAS unsigned* MISC) {
    if (threadIdx.x < 64) {
        const unsigned* gc = (const unsigned*)(a.ws + WS_CTL) + CW_GCOUNT; const int e = threadIdx.x & 31;
        const int c = (int)__hip_atomic_load(gc + e, __ATOMIC_RELAXED, __HIP_MEMORY_SCOPE_AGENT), pad = (c + 255) & ~255;
        int inc = pad;
#pragma unroll
        for (int o = 1; o < 32; o <<= 1) { const int v = __shfl_up(inc, o, 32); if (e >= o) inc += v; }
        if (threadIdx.x < 32) { MISC[MI_PSTART + e] = (unsigned)(inc - pad); MISC[MI_TPRE + e] = (unsigned)((inc - pad) >> 8);
            if (e == 31) { MISC[MI_PSTART + 32] = (unsigned)inc; MISC[MI_TPRE + 32] = (unsigned)(inc >> 8); } }
    }
    __syncthreads();
}
__device__ __forceinline__ void p9_scatter(const Args& a, volatile LAS unsigned* MISC) {
    unsigned char* ws = a.ws; const int G = gridDim.x;
    moe_prefix(a, MISC);
    const int* topi = (const int*)(ws + WS_TOPI); const int* srank = (const int*)(ws + WS_SRANK); const int* wgbase = (const int*)(ws + WS_WGBASE); const float* rstd2 = (const float*)(ws + WS_RSTD2);
    int* pos = (int*)(ws + WS_POS); int* rowtok = (int*)(ws + WS_ROWTOK); float* rowscale = (float*)(ws + WS_ROWSCALE);
    for (int sl = blockIdx.x * NTHREADS + threadIdx.x; sl < NSLOT; sl += G * NTHREADS) {
        const int t = sl >> 2, e = topi[sl], wg = (t >> 5) % G;
        const int row = (int)MISC[MI_PSTART + e] + wgbase[wg * 32 + e] + srank[sl];
        pos[sl] = row; rowtok[row] = t; rowscale[row] = rstd2[t];
    }
    if (blockIdx.x < 32) {
        const int e = blockIdx.x; const int c = (int)__hip_atomic_load((const unsigned*)(ws + WS_CTL) + CW_GCOUNT + e, __ATOMIC_RELAXED, __HIP_MEMORY_SCOPE_AGENT);
        const int r0 = (int)MISC[MI_PSTART + e] + c, r1 = (int)MISC[MI_PSTART + e + 1];
        for (int r = r0 + threadIdx.x; r < r1; r += NTHREADS) { rowtok[r] = 0; rowscale[r] = 0.f; }
    }
}
__device__ __forceinline__ void p12_final(const Args& a, int wave, int lane) {
    unsigned char* ws = a.ws; const int gw = blockIdx.x * NWAVES + wave, NGW = gridDim.x * NWAVES;
    const int* pos = (const int*)(ws + WS_POS); const float* gatew = (const float*)(ws + WS_GATEW); const bf16_t* Y = (const bf16_t*)(ws + WS_Y);
    f32x4 g[4];
#pragma unroll
    for (int j = 0; j < 4; ++j) g[j] = ((const f32x4*)a.in[18])[lane + 64 * j];
    for (int t = gw; t < T; t += NGW) {
        f32x4* xr = (f32x4*)(a.out + (size_t)t * DM) + lane;
        f32x4 v[4];
#pragma unroll
        for (int j = 0; j < 4; ++j) v[j] = xr[64 * j];
#ifndef DBG_NO_MOE
#pragma unroll
        for (int k = 0; k < 4; ++k) {
            const int row = pos[t * 4 + k]; const float w = gatew[t * 4 + k];
            const u32x2* yr = (const u32x2*)(Y + (size_t)row * DM) + lane;
#pragma unroll
            for (int j = 0; j < 4; ++j) { const u32x2 y = yr[64 * j]; v[j].x += w * bflo(y.x); v[j].y += w * bfhi(y.x); v[j].z += w * bflo(y.y); v[j].w += w * bfhi(y.y); }
        }
#endif
        float s2 = 0.f;
#pragma unroll
        for (int j = 0; j < 4; ++j) s2 += (v[j].x * v[j].x + v[j].y * v[j].y) + (v[j].z * v[j].z + v[j].w * v[j].w);
        const float rstd = 1.f / sqrtf(wave_sum(s2) * (1.f / DM) + EPS);
#pragma unroll
        for (int j = 0; j < 4; ++j) xr[64 * j] = v[j] * rstd * g[j];
    }
}

#ifdef MLA_CHECK
constexpr size_t CK_BASE = 225 * MiB;
constexpr size_t CK_CKVN = CK_BASE, CK_KRR = CK_CKVN + (size_t)T * 128 * 4, CK_KN = CK_KRR + (size_t)T * 32 * 4, CK_VV = CK_KN + (size_t)T * 512 * 4, CK_QS = CK_VV + (size_t)T * 512 * 4;
constexpr int CK_NS = 16;
constexpr size_t CK_OBS = 224 * MiB;
__device__ __forceinline__ int ck_tok(int i) { const int tb[16] = {0, 1, 255, 256, 4097, 8191, 12345, 16383, 16384, 16385, 20000, 24575, 24576, 30001, 32766, 32767}; return tb[i]; }
__device__ __forceinline__ float blk_sum(float v, float* red) {
    v = wave_sum(v); __syncthreads(); if ((threadIdx.x & 63) == 0) red[threadIdx.x >> 6] = v; __syncthreads(); return red[0] + red[1] + red[2] + red[3];
}
__global__ void __launch_bounds__(256) ck_kv(const float* x, const float* g1, const float* w_in, const float* gkv, const float* w_uk, const float* w_uv, unsigned char* ws) {
    __shared__ float hn[1024]; __shared__ float red[4]; __shared__ float c[160]; __shared__ float cn[128];
    const int t = blockIdx.x, tid = threadIdx.x;
    float s2 = 0.f; for (int k = tid; k < 1024; k += 256) { const float v = x[(size_t)t * 1024 + k]; s2 += v * v; }
    const float rstd = 1.f / sqrtf(blk_sum(s2, red) / 1024.f + EPS);
    for (int k = tid; k < 1024; k += 256) hn[k] = x[(size_t)t * 1024 + k] * rstd * g1[k];
    __syncthreads();
    if (tid < 160) { float acc = 0.f; for (int k = 0; k < 1024; ++k) acc += hn[k] * w_in[(size_t)k * 4000 + 1792 + tid]; c[tid] = acc; }
    __syncthreads();
    const float q2 = blk_sum(tid < 128 ? c[tid] * c[tid] : 0.f, red); const float r2 = 1.f / sqrtf(q2 / 128.f + EPS);
    if (tid < 128) cn[tid] = c[tid] * r2 * gkv[tid];
    if (tid < 16) { const f32x2 cs = rope_cs(t & (SEQ - 1), tid); const float x1 = c[128 + tid], x2 = c[128 + 16 + tid];
        ((float*)(ws + CK_KRR))[(size_t)t * 32 + tid] = x1 * cs.x - x2 * cs.y; ((float*)(ws + CK_KRR))[(size_t)t * 32 + 16 + tid] = x2 * cs.x + x1 * cs.y; }
    __syncthreads();
    for (int o = tid; o < 512; o += 256) { float a = 0.f, b = 0.f; for (int k = 0; k < 128; ++k) { a += cn[k] * w_uk[(size_t)k * 512 + o]; b += cn[k] * w_uv[(size_t)k * 512 + o]; }
        ((float*)(ws + CK_KN))[(size_t)t * 512 + o] = a; ((float*)(ws + CK_VV))[(size_t)t * 512 + o] = b; }
}
__global__ void __launch_bounds__(256) ck_q(const float* x, const float* g1, const float* w_in, const float* gq, const float* w_uq, unsigned char* ws) {
    __shared__ float hn[1024]; __shared__ float red[4]; __shared__ float c[256]; __shared__ float qq[768];
    const int t = ck_tok(blockIdx.x), tid = threadIdx.x;
    float s2 = 0.f; for (int k = tid; k < 1024; k += 256) { const float v = x[(size_t)t * 1024 + k]; s2 += v * v; }
    const float rstd = 1.f / sqrtf(blk_sum(s2, red) / 1024.f + EPS);
    for (int k = tid; k < 1024; k += 256) hn[k] = x[(size_t)t * 1024 + k] * rstd * g1[k];
    __syncthreads();
    { float acc = 0.f; for (int k = 0; k < 1024; ++k) acc += hn[k] * w_in[(size_t)k * 4000 + 1536 + tid]; c[tid] = acc; }
    __syncthreads();
    const float q2 = blk_sum(c[tid] * c[tid], red); const float r2 = 1.f / sqrtf(q2 / 256.f + EPS);
    __syncthreads(); c[tid] = c[tid] * r2 * gq[tid]; __syncthreads();
    for (int o = tid; o < 768; o += 256) { float a = 0.f; for (int k = 0; k < 256; ++k) a += c[k] * w_uq[(size_t)k * 768 + o]; qq[o] = a; }
    __syncthreads();
    if (tid < 128) { const int hh = tid >> 4, i = tid & 15; const f32x2 cs = rope_cs(t & (SEQ - 1), i); const float x1 = qq[hh * 96 + 64 + i], x2 = qq[hh * 96 + 80 + i];
        qq[hh * 96 + 64 + i] = x1 * cs.x - x2 * cs.y; qq[hh * 96 + 80 + i] = x2 * cs.x + x1 * cs.y; }
    __syncthreads();
    for (int o = tid; o < 768; o += 256) ((float*)(ws + CK_QS))[(size_t)blockIdx.x * 768 + o] = qq[o] * 0.10206207261596577f;
}
__global__ void __launch_bounds__(256) ck_attn(unsigned char* ws, unsigned* flag) {
    __shared__ float q[96]; __shared__ float red[4]; __shared__ float part[256]; __shared__ float sc[SEQ];
    const int si = blockIdx.x >> 3, h = blockIdx.x & 7, t = ck_tok(si), b = t >> 14, tid = threadIdx.x;
    const float* KN = (const float*)(ws + CK_KN); const float* VV = (const float*)(ws + CK_VV); const float* KRR = (const float*)(ws + CK_KRR);
    if (tid < 96) q[tid] = ((const float*)(ws + CK_QS))[(size_t)si * 768 + h * 96 + tid];
    __syncthreads();
    float mx = -1e30f;
    for (int s = tid; s < SEQ; s += 256) { const size_t ts = (size_t)b * SEQ + s; float a = 0.f; for (int e = 0; e < 64; ++e) a += q[e] * KN[ts * 512 + h * 64 + e]; for (int e = 0; e < 32; ++e) a += q[64 + e] * KRR[ts * 32 + e]; sc[s] = a; mx = fmaxf(mx, a); }
    for (int o = 1; o < 64; o <<= 1) mx = fmaxf(mx, __shfl_xor(mx, o));
    __syncthreads(); if ((tid & 63) == 0) red[tid >> 6] = mx; __syncthreads(); mx = fmaxf(fmaxf(red[0], red[1]), fmaxf(red[2], red[3])); __syncthreads();
    float l = 0.f;
    for (int s = tid; s < SEQ; s += 256) { const float p = expf(sc[s] - mx); sc[s] = p; l += p; }
    l = blk_sum(l, red);
    const int e = tid & 63, g = tid >> 6; float o = 0.f;
    for (int s = g; s < SEQ; s += 4) o += sc[s] * VV[((size_t)b * SEQ + s) * 512 + h * 64 + e];
    part[tid] = o; __syncthreads();
    if (tid < 64) { const float ref = (part[tid] + part[64 + tid] + part[128 + tid] + part[192 + tid]) / l, got = bf2f(((const bf16_t*)(ws + CK_OBS))[(size_t)si * 512 + h * 64 + tid]);
        atomicMax(flag, __float_as_uint(fabsf(ref - got))); atomicMax(flag + 1, __float_as_uint(fabsf(ref))); }
}
__global__ void ck_apply(float* out, const unsigned* flag) {
    const float d = __uint_as_float(flag[0]), r = __uint_as_float(flag[1]);
    const bool bad = !(r > 0.f) || !(d <= MLA_CHECK_TOL * r);
    if (bad) for (size_t i = (size_t)blockIdx.x * blockDim.x + threadIdx.x; i < (size_t)T * DM; i += (size_t)gridDim.x * blockDim.x) out[i] = __builtin_nanf("");
}
#endif

constexpr int N_PHASES = 13;
#ifndef REP0
#define REP0 1
#endif
#ifndef REP1
#define REP1 1
#endif
#ifndef REP3
#define REP3 1
#endif
#ifndef REP5
#define REP5 1
#endif
#ifndef REP7
#define REP7 1
#endif
#ifndef REP10
#define REP10 1
#endif
#ifndef REP11
#define REP11 1
#endif
#ifndef MK_ONE_LAUNCH
#define MK_ONE_LAUNCH 0
#endif
__global__ void __launch_bounds__(NTHREADS, 2) fwd(Args args) {
    extern __shared__ __attribute__((aligned(16))) unsigned char lds_raw[];
    LAS unsigned char* lds = (LAS unsigned char*)lds_raw;
    volatile LAS unsigned* MISC = (volatile LAS unsigned*)(lds + MISC_OFF);
    const int tid = threadIdx.x, lane = tid & 63, wave = __builtin_amdgcn_readfirstlane(tid >> 6);
    const int G = gridDim.x, bx = blockIdx.x;
    unsigned char* ws = args.ws;
    for (int u = tid; u < (LDS_BYTES - RING_BYTES) / 4; u += NTHREADS) ((LAS unsigned*)(lds + RING_BYTES))[u] = 0u;
    __syncthreads();
    XcdBarrier bar; bar.bar = (unsigned*)(ws + WS_CTL) + CW_BAR; bar.x = 0; bar.st = nullptr;
    if (MK_ONE_LAUNCH) bar = xcd_barrier_post((unsigned*)(ws + WS_CTL) + CW_BAR, MISC + MI_BAR);
    const int lo = args.ph_lo, hi = args.ph_hi;
#ifdef ONLY_PHASE
#define IN(k) ((k) == ONLY_PHASE && lo <= (k) && (k) < hi)
#else
#define IN(k) (lo <= (k) && (k) < hi)
#endif
#define SEAM(k) do { if (IN(k) && IN((k) + 1)) xcd_barrier(bar); } while (0)

    if (IN(0)) { p0_prologue(args, lds, wave, lane);
#if REP0 > 1
        p0_prologue(args, lds, wave, lane);
#endif
    } SEAM(0);
#define PH1_BODY { pg8::DenseSched S; S.init((const bf16_t*)(ws + WS_XB), (const bf16_t*)(ws + WS_WIN), T, NIN, 1024, G, bx); EpiInProj E{ws}; \
        pg8::gemm_phase2<EpiInProj, pg8::DenseSched, true>(lds, 1024, S, E); }
    if (IN(1)) { PH1_BODY
#if REP1 > 1
        PH1_BODY
#endif
    } SEAM(1);
    if (IN(2)) { p2_stats(args, wave, lane); } SEAM(2);
#define PH3_BODY { { pg8::DenseSched S; S.init((const bf16_t*)(ws + WS_CQ), (const bf16_t*)(ws + WS_WUQ), T, 768, 256, G, bx); EpiQ E{ws}; \
          pg8::gemm_phase2<EpiQ, pg8::DenseSched, true>(lds, 256, S, E); } \
        { pg8::DenseSched S; S.init((const bf16_t*)(ws + WS_CKV), (const bf16_t*)(ws + WS_WUKV), T, 1024, 128, G, bx); EpiKV E{ws}; \
          pg8::gemm_phase2<EpiKV, pg8::DenseSched, true>(lds, 128, S, E); } }
    if (IN(3)) { PH3_BODY
#if REP3 > 1
        PH3_BODY
#endif
    } SEAM(3);
    if (IN(4)) { p4_dilated(args, lds, MISC, wave, lane);
#ifdef REP_DIL
        p4_dilated(args, lds, MISC, wave, lane);
#endif
    } SEAM(4);
    if (IN(5)) { p5_combine(args, wave, lane); p5_mla(args, lds, wave, lane);
#ifdef REP_MLA
        p5_mla(args, lds, wave, lane);
#endif
    } SEAM(5);
#ifdef MLA_CHECK
    if (IN(6) && bx == 0) { for (int i = tid; i < CK_NS * 512; i += NTHREADS) ((bf16_t*)(ws + CK_OBS))[i] = ((const bf16_t*)(ws + WS_OB))[(size_t)ck_tok(i >> 9) * 512 + (i & 511)]; }
#endif
    if (IN(6)) {
        { pg8::DenseSched S; S.init((const bf16_t*)(ws + WS_OA), (const bf16_t*)(ws + WS_WA), T, 1024, 512, G, bx); EpiGate<false> E{ws};
          pg8::gemm_phase2<EpiGate<false>, pg8::DenseSched, true>(lds, 512, S, E); }
        { pg8::DenseSched S; S.init((const bf16_t*)(ws + WS_OB), (const bf16_t*)(ws + WS_WB), T, 1024, 512, G, bx); EpiGate<true> E{ws};
          pg8::gemm_phase2<EpiGate<true>, pg8::DenseSched, true>(lds, 512, S, E); }
    } SEAM(6);
#define PH7_BODY { pg8::DenseSched S; S.init((const bf16_t*)(ws + WS_MERGED), (const bf16_t*)(ws + WS_WO), T, 1024, 1024, G, bx); EpiResid E{ws, args.in[0], args.out}; \
        pg8::gemm_phase2<EpiResid, pg8::DenseSched, true>(lds, 1024, S, E); }
    if (IN(7)) { PH7_BODY
#if REP7 > 1
        PH7_BODY
#endif
    } SEAM(7);
    if (IN(8)) { p8_router(args, lds, MISC, wave, lane); } SEAM(8);
    if (IN(9)) { p9_scatter(args, MISC); } SEAM(9);
#define PH10_BODY { moe_prefix(args, MISC); \
        pg8::MoeSched<3, true> S; S.tpre = (const LAS int*)(MISC + MI_TPRE); S.ntiles = (int)MISC[MI_TPRE + 32]; S.G = G; S.c = bx; S.K = 512; \
        S.A = (const char*)(ws + WS_H2); S.Bt = (const char*)(ws + WS_WGU); S.estride = (size_t)2048 * 1024; S.row_tok = (const int*)(ws + WS_ROWTOK); \
        EpiSwiglu E{ws, args.in[15]}; \
        pg8::gemm_phase2<EpiSwiglu, pg8::MoeSched<3, true>, true, true, 121>(lds, 512, S, E); }
    if (IN(10)) { PH10_BODY
#if REP10 > 1
        PH10_BODY
#endif
    } SEAM(10);
#define PH11_BODY { moe_prefix(args, MISC); \
        pg8::MoeSched<2, false> S; S.tpre = (const LAS int*)(MISC + MI_TPRE); S.ntiles = (int)MISC[MI_TPRE + 32]; S.G = G; S.c = bx; S.K = 512; \
        S.A = (const char*)(ws + WS_ACT); S.Bt = (const char*)(ws + WS_WD); S.estride = (size_t)1024 * 1024; S.row_tok = nullptr; \
        EpiDown E{ws, args.in[17]}; \
        pg8::gemm_phase2<EpiDown, pg8::MoeSched<2, false>, true, true, 121>(lds, 512, S, E); }
    if (IN(11)) { PH11_BODY
#if REP11 > 1
        PH11_BODY
#endif
    } SEAM(11);
    if (IN(12)) { p12_final(args, wave, lane); }
#undef IN
#undef SEAM
}

extern "C" void kernel_launch(void* const* d_in, const int* in_sizes, int n_in, void* d_out, int out_size, void* d_ws, size_t ws_size, hipStream_t stream) {
    static int grid = 0;
    if (grid == 0) {
        if (n_in != 19 || in_sizes[0] != T * DM || out_size != T * DM || ws_size < WS_END) { fprintf(stderr, "kernel_launch: unexpected shapes (n_in %d, in0 %d, out %d, ws %zu); nothing launched\n", n_in, n_in > 0 ? in_sizes[0] : -1, out_size, ws_size); grid = -1; return; }
        int dev = 0, cus = 0, per_cu = 0;
        if (hipGetDevice(&dev) != hipSuccess || hipDeviceGetAttribute(&cus, hipDeviceAttributeMultiprocessorCount, dev) != hipSuccess) { grid = -1; return; }
        if (hipFuncSetAttribute((const void*)fwd, hipFuncAttributeMaxDynamicSharedMemorySize, LDS_BYTES) != hipSuccess) { fprintf(stderr, "kernel_launch: hipFuncSetAttribute failed\n"); grid = -1; return; }
        if (hipOccupancyMaxActiveBlocksPerMultiprocessor(&per_cu, (const void*)fwd, NTHREADS, LDS_BYTES) != hipSuccess || per_cu < 1) fprintf(stderr, "kernel_launch: occupancy query reports %d\n", per_cu);
        (void)hipGetLastError();
        grid = cus;
    }
    if (grid < 0) return;
    if (hipMemsetAsync((char*)d_ws + WS_CTL, 0, CTL_ZERO_BYTES, stream) != hipSuccess) { fprintf(stderr, "kernel_launch: memset failed\n"); return; }
    Args a{};
    for (int i = 0; i < 19; ++i) a.in[i] = (const float*)d_in[i];
    a.out = (float*)d_out; a.ws = (unsigned char*)d_ws; a.li = 0; a.pad = 0;
#if MK_ONE_LAUNCH
    a.ph_lo = 0; a.ph_hi = N_PHASES;
    hipLaunchKernelGGL(fwd, dim3(grid), dim3(NTHREADS), LDS_BYTES, stream, a);
#else
    for (int p = 0; p < N_PHASES; ++p) {
        a.ph_lo = p; a.ph_hi = p + 1; hipLaunchKernelGGL(fwd, dim3(grid), dim3(NTHREADS), LDS_BYTES, stream, a); }

#endif
#ifdef MLA_CHECK
    {   unsigned* flag = (unsigned*)((unsigned char*)d_ws + WS_CTL) + 16384;
        hipLaunchKernelGGL(ck_kv, dim3(T), dim3(256), 0, stream, a.in[0], a.in[1], a.in[2], a.in[4], a.in[6], a.in[7], (unsigned char*)d_ws);
        hipLaunchKernelGGL(ck_q, dim3(CK_NS), dim3(256), 0, stream, a.in[0], a.in[1], a.in[2], a.in[3], a.in[5], (unsigned char*)d_ws);
        hipLaunchKernelGGL(ck_attn, dim3(CK_NS * 8), dim3(256), 0, stream, (unsigned char*)d_ws, flag);
        hipLaunchKernelGGL(ck_apply, dim3(1024), dim3(256), 0, stream, (float*)d_out, (const unsigned*)flag); }
#endif
    const hipError_t le = hipPeekAtLastError();
    if (le != hipSuccess) fprintf(stderr, "kernel_launch: launch failed: %s\n", hipGetErrorName(le));
}
```

```cpp
#define MK_ONE_LAUNCH 1
#include <hip/hip_runtime.h>
#include <cstdio>
#include <cstdint>

#define LAS __attribute__((address_space(3)))
#define GAS __attribute__((address_space(1)))
typedef unsigned short bf16_t;
typedef short bf16x8 __attribute__((ext_vector_type(8)));
typedef short s16x4 __attribute__((ext_vector_type(4)));
typedef float f32x2 __attribute__((ext_vector_type(2)));
typedef float f32x4 __attribute__((ext_vector_type(4)));
typedef float f32x16 __attribute__((ext_vector_type(16)));
typedef unsigned u32x2 __attribute__((ext_vector_type(2)));
typedef unsigned u32x4 __attribute__((ext_vector_type(4)));

constexpr int NB = 2, SEQ = 16384, T = NB * SEQ, DM = 1024;
constexpr int NIN = 4096;
constexpr int NEXP = 32, TOPK = 4, NSLOT = T * TOPK, NPMAX = NSLOT + NEXP * 256;
constexpr float EPS = 1e-5f, LOG2E = 1.4426950408889634f;
constexpr int NWAVES = 8, NTHREADS = 512;

constexpr size_t MiB = 1u << 20;
constexpr size_t WS_CTL = 0, CTL_ZERO_BYTES = 1 * MiB;
constexpr size_t WS_WIN = 1 * MiB;
constexpr size_t WS_WUQ = 9 * MiB;
constexpr size_t WS_WUKV = 10 * MiB;
constexpr size_t WS_WA = 11 * MiB, WS_WB = 12 * MiB;
constexpr size_t WS_WO = 13 * MiB;
constexpr size_t WS_ROPE = 15 * MiB;
constexpr size_t WS_WGU = 17 * MiB;
constexpr size_t WS_WD = 145 * MiB;
constexpr size_t WS_SMALL = 209 * MiB;
constexpr size_t WS_RSTDQ = WS_SMALL, WS_RSTDKV = WS_RSTDQ + T * 4, WS_RSTD2 = WS_RSTDKV + T * 4;
constexpr size_t WS_TOPI = WS_RSTD2 + T * 4, WS_GATEW = WS_TOPI + (size_t)NSLOT * 4, WS_SRANK = WS_GATEW + (size_t)NSLOT * 4, WS_POS = WS_SRANK + (size_t)NSLOT * 4;
constexpr size_t WS_ROWTOK = WS_POS + (size_t)NSLOT * 4, WS_ROWSCALE = WS_ROWTOK + 1 * MiB, WS_WGBASE = WS_ROWSCALE + 1 * MiB;
constexpr size_t WS_WRP = WS_WGBASE + 64 * 1024;
constexpr size_t WS_PARTL = WS_WRP + 128 * 1024;
static_assert(WS_PARTL + 3 * MiB <= 225 * MiB, "small region");
constexpr size_t WS_XB = 225 * MiB;
constexpr size_t WS_QA = 289 * MiB, WS_KA = 321 * MiB, WS_VA = 353 * MiB;
constexpr size_t WS_CQ = 385 * MiB;
constexpr size_t WS_CKV = 401 * MiB;
constexpr size_t WS_KR = 409 * MiB;
constexpr size_t WS_GA = 411 * MiB, WS_GB = 475 * MiB;
constexpr size_t WS_K8 = 225 * MiB;
constexpr size_t WS_Q8 = 249 * MiB;
constexpr size_t WS_ACT = 225 * MiB;
static_assert(WS_ACT + (size_t)NPMAX * 2048 <= 539 * MiB, "ACT overlay");
constexpr size_t WS_QB = 539 * MiB;
constexpr size_t WS_KIMG = 587 * MiB;
constexpr size_t WS_VIMG = 635 * MiB;
constexpr size_t WS_OA = 667 * MiB, WS_OB = 699 * MiB;
constexpr size_t WS_MERGED = 731 * MiB;
constexpr size_t WS_PARTO = 795 * MiB;
constexpr size_t WS_H2 = 891 * MiB;
constexpr size_t WS_Y = 539 * MiB;
static_assert(WS_Y + (size_t)NPMAX * 2048 <= WS_H2, "Y overlay");
constexpr size_t WS_END = 955 * MiB;
constexpr int CW_TMO = 0, CW_BAR = 4096, CW_GCOUNT = 8192, CW_NRM = 8256;

constexpr int RING_BYTES = 131072, MISC_OFF = RING_BYTES + 320, LDS_BYTES = 147456;
constexpr int MI_BAR = 8, MI_TPRE = 16, MI_HIST = 64, MI_PSTART = 96, MI_NRM = 160;

__device__ __forceinline__ unsigned f2bf(float f) { unsigned u = __builtin_bit_cast(unsigned, f); return (u + 0x7fffu + ((u >> 16) & 1u)) >> 16; }
__device__ __forceinline__ unsigned pk2(float lo, float hi) { return f2bf(lo) | (f2bf(hi) << 16); }
__device__ __forceinline__ float bf2f(unsigned short b) { return __builtin_bit_cast(float, (unsigned)b << 16); }
__device__ __forceinline__ float bflo(unsigned w) { return __builtin_bit_cast(float, w << 16); }
__device__ __forceinline__ float bfhi(unsigned w) { return __builtin_bit_cast(float, w & 0xffff0000u); }
typedef __bf16 bf16x2_t __attribute__((ext_vector_type(2)));
__device__ __forceinline__ unsigned cvtpk(float lo, float hi) { const f32x2 v = {lo, hi}; const bf16x2_t b = __builtin_convertvector(v, bf16x2_t); return __builtin_bit_cast(unsigned, b); }
__device__ __forceinline__ unsigned pack4_fp8(float a, float b, float c, float d) { int w = 0; w = __builtin_amdgcn_cvt_pk_fp8_f32(a, b, w, false); w = __builtin_amdgcn_cvt_pk_fp8_f32(c, d, w, true); return (unsigned)w; }
__device__ __forceinline__ float wave_sum(float v) {
#pragma unroll
    for (int o = 1; o < 64; o <<= 1) v += __shfl_xor(v, o);
    return v;
}
__device__ __forceinline__ float fexp2(float x) { return __builtin_amdgcn_exp2f(x); }
__device__ __forceinline__ float frcp(float x) { return __builtin_amdgcn_rcpf(x); }
__device__ __forceinline__ float sigmoidf_(float z) { return frcp(1.f + fexp2(-z * LOG2E)); }
__device__ __forceinline__ int crow(int r, int hi) { return (r & 3) + 8 * (r >> 2) + 4 * hi; }
__device__ __forceinline__ u32x4 pack8(const float (&v)[8]) { u32x4 w; w.x = cvtpk(v[0], v[1]); w.y = cvtpk(v[2], v[3]); w.z = cvtpk(v[4], v[5]); w.w = cvtpk(v[6], v[7]); return w; }
__device__ __forceinline__ void unpack8(const u32x4 w, float (&v)[8]) { v[0] = bflo(w.x); v[1] = bfhi(w.x); v[2] = bflo(w.y); v[3] = bfhi(w.y); v[4] = bflo(w.z); v[5] = bfhi(w.z); v[6] = bflo(w.w); v[7] = bfhi(w.w); }
__device__ __forceinline__ f32x2 rope_cs(int pos, int i) {
    const float inv = __builtin_powf(10000.f, -(float)i * (1.f / 16.f));
    const float ang = (float)pos * inv;
    double x = (double)ang; const double n = __builtin_rint(x * 0.15915494309189535); x = (x - n * 6.283185307179586) - n * 2.4492935982947064e-16;
    const double x2 = x * x; double sn = 1.0, cs = 1.0;
#pragma unroll
    for (int k = 13; k >= 1; --k) { sn = 1.0 - sn * x2 * (1.0 / (double)((2 * k) * (2 * k + 1))); cs = 1.0 - cs * x2 * (1.0 / (double)((2 * k - 1) * (2 * k))); }
    sn *= x;
    return (f32x2){(float)cs, (float)sn};
}

namespace pg8 {
constexpr int BM = 256, BK = 64, HALF = 128, HTB = HALF * BK * 2  , NXCD = 8, WGM = 8;
__host__ __device__ __forceinline__ int lds_byte(int r, int c) { const int st = (r >> 4) * 2 + (c >> 5), rr = r & 15, cc = c & 31, ob = rr * 64 + cc * 2; return st * 1024 + (ob ^ (((ob >> 9) & 1) << 5)); }
__host__ __device__ __forceinline__ void stage_rc(int b, int& R, int& C) { const int st = b / 1024, sb = b % 1024, swz = sb ^ (((sb >> 9) & 1) << 5); R = (st >> 1) * 16 + swz / 64; C = (st & 1) * 32 + (swz % 64) / 2; }
__host__ __device__ __forceinline__ int perm32(int rho) { const int n = rho >> 4, i = rho & 15; return 8 * (i >> 2) + 4 * n + (i & 3); }

struct Unit { int pm, pn, e; };

struct StaticOrder {
    int nM, nN, nwg, G, c;
    __host__ __device__ void init(int M, int N, int G_, int c_) { nM = M / BM; nN = N / BM; nwg = nM * nN; G = G_; c = c_; }
    __host__ __device__ bool next(int i, Unit& u) const {
        const long L = (long)i * G + c; if (L >= nwg) return false;
        int wgid = (int)L; { const int q = nwg / NXCD, r = nwg % NXCD, xcd = wgid % NXCD, off = wgid / NXCD; wgid = (xcd < r ? xcd * (q + 1) : r * (q + 1) + (xcd - r) * q) + off; }
        const int nig = WGM * nN, gid = wgid / nig, fm = gid * WGM, gsz = (nM - fm) < WGM ? (nM - fm) : WGM;
        u.pm = fm + ((wgid % nig) % gsz); u.pn = (wgid % nig) / gsz; u.e = 0; return true;
    }
};
struct DenseSched {
    static constexpr bool LATE = false;
    StaticOrder so; const char* A; const char* Bt; int K;
    __device__ __forceinline__ void prefetch_rows(const Unit&, LAS unsigned char*, int, int, int) const {}
    __device__ __forceinline__ void a_off_lds(const Unit&, const int (&)[2], const int (&)[2], LAS unsigned char*, int, unsigned (&)[2][2]) const {}
    __device__ __forceinline__ void init(const bf16_t* A_, const bf16_t* Bt_, int M, int N, int K_, int G, int c) { so.init(M, N, G, c); A = (const char*)A_; Bt = (const char*)Bt_; K = K_; }
    __device__ __forceinline__ bool next(int i, Unit& u) const { return so.next(i, u); }
    __device__ __forceinline__ const char* a_base(const Unit& u) const { return A + (size_t)u.pm * ((size_t)BM * K * 2); }
    __device__ __forceinline__ const char* b_base(const Unit& u) const { return Bt + (size_t)u.pn * ((size_t)BM * K * 2); }
    __device__ __forceinline__ void a_off(const Unit&, const int (&sR)[2], const int (&sC)[2], unsigned (&vo)[2][2]) const {
#pragma unroll
        for (int h = 0; h < 2; ++h)
#pragma unroll
            for (int i = 0; i < 2; ++i) vo[h][i] = (unsigned)((h * HALF + sR[i]) * K + sC[i]) * 2u;
    }
};
template <int NPN_SHIFT, bool GATHER>
struct MoeSched {
    static constexpr bool LATE = GATHER;
    static constexpr int TBL_OFF = 131072 + 4096;
    __device__ __forceinline__ void prefetch_rows(const Unit& u, LAS unsigned char* lds, int buf, int wid, int lane) const {
        if (wid < 4) __builtin_amdgcn_global_load_lds((const unsigned*)(row_tok + u.pm * BM + wid * 64 + lane), (LAS unsigned*)(lds + TBL_OFF + buf * 1024 + wid * 256), 4, 0, 0);
    }
    __device__ __forceinline__ void a_off_lds(const Unit&, const int (&sR)[2], const int (&sC)[2], LAS unsigned char* lds, int buf, unsigned (&vo)[2][2]) const {
        const LAS int* tb = (const LAS int*)(lds + TBL_OFF + buf * 1024);
#pragma unroll
        for (int h = 0; h < 2; ++h)
#pragma unroll
            for (int i = 0; i < 2; ++i) vo[h][i] = (unsigned)(tb[h * HALF + sR[i]] * K + sC[i]) * 2u;
    }
    const LAS int* tpre; int ntiles, G, c, K; const char* A; const char* Bt; size_t estride; const int* row_tok;
    __device__ __forceinline__ bool next(int i, Unit& u) const {
        const int L = i * G + c, g = L >> NPN_SHIFT; if (g >= ntiles) return false;
        int e = 0; while (e < 31 && tpre[e + 1] <= g) ++e;
        u.pm = g; u.pn = L & ((1 << NPN_SHIFT) - 1); u.e = e; return true;
    }
    __device__ __forceinline__ const char* a_base(const Unit& u) const { return GATHER ? A : A + (size_t)u.pm * ((size_t)BM * K * 2); }
    __device__ __forceinline__ const char* b_base(const Unit& u) const { return Bt + (size_t)u.e * estride + (size_t)u.pn * ((size_t)BM * K * 2); }
    __device__ __forceinline__ void a_off(const Unit& u, const int (&sR)[2], const int (&sC)[2], unsigned (&vo)[2][2]) const {
#pragma unroll
        for (int h = 0; h < 2; ++h)
#pragma unroll
            for (int i = 0; i < 2; ++i) {
                if (GATHER) { const int tok = row_tok[u.pm * BM + h * HALF + sR[i]]; vo[h][i] = (unsigned)(tok * K + sC[i]) * 2u; }
                else vo[h][i] = (unsigned)((h * HALF + sR[i]) * K + sC[i]) * 2u;
            }
    }
};

typedef int v8i_ __attribute__((ext_vector_type(8)));
__device__ __forceinline__ v8i_ cat16(const bf16x8 a, const bf16x8 b) { const u32x4 x = __builtin_bit_cast(u32x4, a), y = __builtin_bit_cast(u32x4, b); return (v8i_){(int)x.x, (int)x.y, (int)x.z, (int)x.w, (int)y.x, (int)y.y, (int)y.z, (int)y.w}; }
__device__ __forceinline__ v8i_ lds_ld32(const LAS unsigned char* p) { const u32x4 x = *(const LAS u32x4*)p, y = *(const LAS u32x4*)(p + 1024); return (v8i_){(int)x.x, (int)x.y, (int)x.z, (int)x.w, (int)y.x, (int)y.y, (int)y.z, (int)y.w}; }
template <class Epi, class Sched, bool ALIGN_EPI, bool FP8 = false, int SCALE_W = 127>
__device__ __forceinline__ void gemm_phase2(LAS unsigned char* lds, const int K_, const Sched& S, const Epi& E) {
    int K = K_; asm volatile("" : "+s"(K));
    const int tid = threadIdx.x, wid = __builtin_amdgcn_readfirstlane(tid >> 6), lane = tid & 63, wr = wid >> 2, wc = wid & 3, fr = lane & 15, fq = lane >> 4;
    const int nt = K / BK;
    int sR[2], sC[2]; unsigned voffB[2];
#pragma unroll
    for (int i = 0; i < 2; ++i) { int R, C; stage_rc(tid * 16 + i * 8192, R, C); sR[i] = R; sC[i] = C; const int Rb = Epi::PERM ? ((R & ~31) + perm32(R & 31)) : R; voffB[i] = (unsigned)(Rb * K + C) * 2u; }
    const size_t kstep = (size_t)(BK * 2);
    const size_t hstep = (size_t)HALF * K * 2;
    const unsigned ldsw = (unsigned)wid * 1024u;
    const int aoff = lds_byte(wr * 64 + fr, fq * 8), boff = lds_byte(wc * 32 + fr, fq * 8);
#define PG8_SA(b, h) (((b) * 2 + (h)) * HTB)
#define PG8_SB(b, h) ((4 + (b) * 2 + (h)) * HTB)
#define PG8_STAGE_B(bufoff, gbase) do { _Pragma("unroll") for (int _i = 0; _i < 2; ++_i) \
        __builtin_amdgcn_global_load_lds((const unsigned*)((const char*)(gbase) + voffB[_i]), (LAS unsigned*)(lds + (bufoff) + ldsw + _i * 8192), 16, 0, 0); } while (0)
#define PG8_STAGE_A(bufoff, gbase, o0, o1) do { \
        __builtin_amdgcn_global_load_lds((const unsigned*)((const char*)(gbase) + (o0)), (LAS unsigned*)(lds + (bufoff) + ldsw), 16, 0, 0); \
        __builtin_amdgcn_global_load_lds((const unsigned*)((const char*)(gbase) + (o1)), (LAS unsigned*)(lds + (bufoff) + ldsw + 8192), 16, 0, 0); } while (0)
#define PG8_LDA(dst, b, h) do { if constexpr (FP8) { _Pragma("unroll") for (int m = 0; m < 4; ++m) dst##8[m] = lds_ld32(lds + PG8_SA(b, h) + aoff + m * 2048); } else { _Pragma("unroll") for (int m = 0; m < 4; ++m) _Pragma("unroll") for (int k = 0; k < 2; ++k) dst[m][k] = *(const LAS bf16x8*)(lds + PG8_SA(b, h) + aoff + m * 2048 + k * 1024); } } while (0)
#define PG8_LDB(dst, b, h) do { if constexpr (FP8) { _Pragma("unroll") for (int n = 0; n < 2; ++n) dst##8[n] = lds_ld32(lds + PG8_SB(b, h) + boff + n * 2048); } else { _Pragma("unroll") for (int n = 0; n < 2; ++n) _Pragma("unroll") for (int k = 0; k < 2; ++k) dst[n][k] = *(const LAS bf16x8*)(lds + PG8_SB(b, h) + boff + n * 2048 + k * 1024); } } while (0)
#define PG8_MMA(ai, bj, At, Bt) do { __builtin_amdgcn_s_setprio(1); if constexpr (FP8) { _Pragma("unroll") for (int m = 0; m < 4; ++m) _Pragma("unroll") for (int n = 0; n < 2; ++n) \
        asm volatile("v_mfma_scale_f32_16x16x128_f8f6f4 %0, %1, %2, %0, %3, %4 op_sel_hi:[0,0,0]" : "+v"(acc[ai][bj][m][n]) : "v"(Bt##8[n]), "v"(At##8[m]), "v"(scw_), "v"(sca_)); } else { \
        _Pragma("unroll") for (int m = 0; m < 4; ++m) _Pragma("unroll") for (int n = 0; n < 2; ++n) _Pragma("unroll") for (int k = 0; k < 2; ++k) \
        acc[ai][bj][m][n] = __builtin_amdgcn_mfma_f32_16x16x32_bf16(Bt[n][k], At[m][k], acc[ai][bj][m][n], 0, 0, 0); } __builtin_amdgcn_s_setprio(0); } while (0)
#define PG8_WAIT_V(n) asm volatile("s_waitcnt vmcnt(" #n ")" ::: "memory")
#define PG8_WAIT_L(n) asm volatile("s_waitcnt lgkmcnt(" #n ")" ::: "memory")
#define PG8_BAR __builtin_amdgcn_s_barrier()
#define PG8_SCHED __builtin_amdgcn_sched_barrier(0)
    Unit cur, nxt; int ui = 0;
    if (!S.next(0, cur)) return;
    f32x4 acc[2][2][4][2];
#pragma unroll
    for (int a = 0; a < 2; ++a)
#pragma unroll
        for (int b = 0; b < 2; ++b)
#pragma unroll
            for (int m = 0; m < 4; ++m)
#pragma unroll
                for (int n = 0; n < 2; ++n) acc[a][b][m][n] = (f32x4){0.f, 0.f, 0.f, 0.f};
    bf16x8 At[4][2], B0[2][2], B1[2][2]; v8i_ At8[4], B08[2], B18[2];
    int scw_ = SCALE_W * 0x01010101, sca_ = 0x7f7f7f7f; asm volatile("" : "+v"(scw_), "+v"(sca_));
    unsigned voA[2][2], voN[2][2];
    S.a_off(cur, sR, sC, voA);
    const char* cA = S.a_base(cur); const char* cB = S.b_base(cur);
    PG8_STAGE_B(PG8_SB(0, 0), cB); PG8_STAGE_B(PG8_SB(0, 1), cB + hstep); PG8_STAGE_A(PG8_SA(0, 0), cA, voA[0][0], voA[0][1]); PG8_STAGE_A(PG8_SA(0, 1), cA, voA[1][0], voA[1][1]);
    if (wr == 1) PG8_BAR;
    PG8_WAIT_V(2); PG8_BAR;
    PG8_STAGE_B(PG8_SB(1, 0), cB + kstep); PG8_STAGE_A(PG8_SA(1, 0), cA + kstep, voA[0][0], voA[0][1]); PG8_STAGE_B(PG8_SB(1, 1), cB + hstep + kstep);
    PG8_WAIT_V(6); PG8_BAR;
    for (;;) {
        const bool has_next = S.next(ui + 1, nxt);
        const char* nA = cA; const char* nB = cB;
#pragma unroll
        for (int h = 0; h < 2; ++h)
#pragma unroll
            for (int i = 0; i < 2; ++i) voN[h][i] = voA[h][i];
        if (has_next) { nA = S.a_base(nxt); nB = S.b_base(nxt); if constexpr (Sched::LATE) S.prefetch_rows(nxt, lds, (ui + 1) & 1, wid, lane); else S.a_off(nxt, sR, sC, voN); }
        for (int t = 0; t < nt; t += 2) {
            const bool last = (t == nt - 2);
            if constexpr (Sched::LATE) { if (last && has_next) S.a_off_lds(nxt, sR, sC, lds, (ui + 1) & 1, voN); }
            const char* a1 = cA + (size_t)(t + 1) * kstep;
            const char* a2 = last ? nA : cA + (size_t)(t + 2) * kstep; const char* b2 = last ? nB : cB + (size_t)(t + 2) * kstep;
            const char* a3 = a2 + kstep; const char* b3 = b2 + kstep;
            const unsigned s00 = last ? voN[0][0] : voA[0][0], s01 = last ? voN[0][1] : voA[0][1], s10 = last ? voN[1][0] : voA[1][0], s11 = last ? voN[1][1] : voA[1][1];
            PG8_LDB(B0, 0, 0); PG8_LDB(B1, 0, 1); PG8_SCHED; PG8_LDA(At, 0, 0); PG8_STAGE_A(PG8_SA(1, 1), a1, voA[1][0], voA[1][1]);
            PG8_WAIT_V(8); PG8_WAIT_L(0); PG8_BAR; PG8_MMA(0, 0, At, B0); PG8_MMA(0, 1, At, B1); PG8_BAR; PG8_SCHED;
            PG8_LDA(At, 0, 1); PG8_STAGE_B(PG8_SB(0, 0), b2); PG8_STAGE_B(PG8_SB(0, 1), b2 + hstep); PG8_STAGE_A(PG8_SA(0, 0), a2, s00, s01);
            PG8_WAIT_V(8); PG8_WAIT_L(0); PG8_BAR; PG8_MMA(1, 0, At, B0); PG8_MMA(1, 1, At, B1); PG8_BAR; PG8_SCHED;
            PG8_LDB(B0, 1, 0); PG8_LDB(B1, 1, 1); PG8_SCHED; PG8_LDA(At, 1, 0); PG8_STAGE_A(PG8_SA(0, 1), a2, s10, s11);
            PG8_WAIT_V(8); PG8_WAIT_L(0); PG8_BAR; PG8_MMA(0, 0, At, B0); PG8_MMA(0, 1, At, B1); PG8_BAR; PG8_SCHED;
            PG8_LDA(At, 1, 1); PG8_STAGE_B(PG8_SB(1, 0), b3); PG8_STAGE_B(PG8_SB(1, 1), b3 + hstep); PG8_STAGE_A(PG8_SA(1, 0), a3, s00, s01);
            PG8_WAIT_V(8); PG8_WAIT_L(0); PG8_BAR; PG8_MMA(1, 0, At, B0); PG8_MMA(1, 1, At, B1); PG8_BAR; PG8_SCHED;
        }
        if constexpr (ALIGN_EPI) { if (wr == 0) PG8_BAR; }
        E(acc, cur, wr, wc, fr, fq);
        if (!has_next) break;
#pragma unroll
        for (int a = 0; a < 2; ++a)
#pragma unroll
            for (int b = 0; b < 2; ++b)
#pragma unroll
                for (int m = 0; m < 4; ++m)
#pragma unroll
                    for (int n = 0; n < 2; ++n) acc[a][b][m][n] = (f32x4){0.f, 0.f, 0.f, 0.f};
        cur = nxt; cA = nA; cB = nB; ++ui;
#pragma unroll
        for (int h = 0; h < 2; ++h)
#pragma unroll
            for (int i = 0; i < 2; ++i) voA[h][i] = voN[h][i];
        if constexpr (ALIGN_EPI) { if (wr == 1) PG8_BAR; }
    }
    PG8_WAIT_V(0);
    if constexpr (!ALIGN_EPI) { if (wr == 0) PG8_BAR; }
    PG8_BAR;
#undef PG8_SA
#undef PG8_SB
#undef PG8_STAGE_A
#undef PG8_STAGE_B
#undef PG8_LDA
#undef PG8_LDB
#undef PG8_MMA
#undef PG8_WAIT_V
#undef PG8_WAIT_L
#undef PG8_BAR
#undef PG8_SCHED
}
}

#define XB_TMO      128
#define XB_XCNT(j)  (256  + 64 * (j))
#define XB_XSUB(j)  (1280 + 64 * (j))
#define XB_XGEN(j)  (2304 + 64 * (j))
#define XB_TOP      3328
#define XB_TOPGEN   3392
#define XCD_BAR_WORDS 3456
#define XB_SPIN_CAP (1u << 18)

__device__ __forceinline__ unsigned xb_ld(unsigned* p)              { return __hip_atomic_load(p, __ATOMIC_RELAXED, __HIP_MEMORY_SCOPE_AGENT); }
__device__ __forceinline__ unsigned xb_add(unsigned* p, unsigned v) { return __hip_atomic_fetch_add(p, v, __ATOMIC_RELAXED, __HIP_MEMORY_SCOPE_AGENT); }
__device__ __forceinline__ unsigned xb_xcc_id() { return (unsigned)__builtin_amdgcn_s_getreg((3 << 11) | 20) & 0xFu; }
#define XB_SPIN(cond, bar) do { unsigned _sp = 0; while (cond) { __builtin_amdgcn_s_sleep(1); \
    if ((++_sp & 255u) == 0u) { if (xb_ld(&(bar)[XB_TMO])) break; if (_sp > XB_SPIN_CAP) { atomicAdd(&(bar)[XB_TMO], 1u); break; } } } } while (0)

struct XcdBarrier {
    unsigned* bar; unsigned x;
    volatile LAS unsigned* st;
};
__device__ __forceinline__ XcdBarrier xcd_barrier_post(unsigned* bar, volatile LAS unsigned* st) {
    XcdBarrier b; b.bar = bar; b.x = xb_xcc_id(); b.st = st;
    if (threadIdx.x == 0) (void)xb_add(&bar[XB_XCNT(b.x)], 1u);
    return b;
}
__device__ __forceinline__ void xcd_barrier_complete(unsigned* bar, unsigned x, unsigned& nloc, unsigned& nx) {
    const unsigned G = gridDim.x * gridDim.y * gridDim.z;
    unsigned sum, cnt, mine, sp = 0u;
    for (;;) {
        sum = 0u; cnt = 0u; mine = 0u;
#pragma unroll
        for (unsigned j = 0; j < 16; ++j) { const unsigned c = xb_ld(&bar[XB_XCNT(j)]); sum += c; cnt += (c > 0u) ? 1u : 0u; mine = (j == x) ? c : mine; }
        if (sum == G) break;
        __builtin_amdgcn_s_sleep(1);
        if ((++sp & 255u) == 0u) { if (xb_ld(&bar[XB_TMO])) break; if (sp > XB_SPIN_CAP) { atomicAdd(&bar[XB_TMO], 1u); break; } }
    }
    nloc = mine > 0u ? mine : 1u; nx = cnt > 0u ? cnt : 1u;
}
__device__ __forceinline__ void xcd_barrier(const XcdBarrier& b) {
    asm volatile("s_waitcnt vmcnt(0)" ::: "memory");
    __syncthreads();
    if (threadIdx.x == 0) {
        unsigned* bar = b.bar;
        __builtin_amdgcn_s_waitcnt(0);
        unsigned nloc = b.st[0], nx = b.st[1];
        if (nloc == 0u) { xcd_barrier_complete(bar, b.x, nloc, nx); b.st[0] = nloc; b.st[1] = nx; }
        const unsigned old = xb_add(&bar[XB_XSUB(b.x)], 1u);
        const unsigned gen = old / nloc;
        if (old + 1u == (gen + 1u) * nloc) {
            __builtin_amdgcn_fence(__ATOMIC_RELEASE, "agent");
            asm volatile("s_waitcnt vmcnt(0)" ::: "memory");
            const unsigned og = xb_add(&bar[XB_TOP], 1u);
            const unsigned tg = og / nx;
            if (og + 1u == (tg + 1u) * nx) xb_add(&bar[XB_TOPGEN], 1u);
            else XB_SPIN(xb_ld(&bar[XB_TOPGEN]) == tg, bar);
            __builtin_amdgcn_fence(__ATOMIC_ACQUIRE, "agent");
            xb_add(&bar[XB_XGEN(b.x)], 1u);
            asm volatile("s_waitcnt vmcnt(0)" ::: "memory");
        } else {
            XB_SPIN(xb_ld(&bar[XB_XGEN(b.x)]) == gen, bar);
            __builtin_amdgcn_fence(__ATOMIC_ACQUIRE, "agent");
            asm volatile("s_waitcnt vmcnt(0)" ::: "memory");
        }
    }
    __syncthreads();
}

#define EPI_WALK(...) \
    _Pragma("unroll") for (int ai = 0; ai < 2; ++ai) _Pragma("unroll") for (int m = 0; m < 4; ++m) { \
        const int row = u.pm * 256 + ai * 128 + wr * 64 + m * 16 + fr; \
        _Pragma("unroll") for (int bj = 0; bj < 2; ++bj) { const int cw = bj * 128 + wc * 32 + 8 * fq; \
            float v[8] = {acc[ai][bj][m][0][0], acc[ai][bj][m][0][1], acc[ai][bj][m][0][2], acc[ai][bj][m][0][3], acc[ai][bj][m][1][0], acc[ai][bj][m][1][1], acc[ai][bj][m][1][2], acc[ai][bj][m][1][3]}; \
            __VA_ARGS__ } asm volatile("" ::: "memory"); }

__device__ __forceinline__ void rope8(float (&v)[8], const f32x2* rope_row, int i0) {
#pragma unroll
    for (int j = 0; j < 4; ++j) { const f32x2 cs = rope_row[i0 + j]; const float x1 = v[2 * j], x2 = v[2 * j + 1]; v[2 * j] = x1 * cs.x - x2 * cs.y; v[2 * j + 1] = x2 * cs.x + x1 * cs.y; }
}

struct EpiInProj {
    static constexpr bool PERM = true;
    unsigned char* ws;
    __device__ __forceinline__ void operator()(const f32x4 (&acc)[2][2][4][2], const pg8::Unit& u, int wr, int wc, int fr, int fq) const {
        const int pn = u.pn;
        if (pn < 6) {
            bf16_t* base = (bf16_t*)(ws + (pn < 2 ? WS_QA : pn < 4 ? WS_KA : WS_VA)) + (pn & 1) * 256;
            EPI_WALK({ *(u32x4*)(base + (size_t)row * 512 + cw) = pack8(v); })
        } else if (pn == 6) {
            bf16_t* base = (bf16_t*)(ws + WS_CQ);
            EPI_WALK({ *(u32x4*)(base + (size_t)row * 256 + cw) = pack8(v); })
        } else if (pn == 7) {
            bf16_t* ckv = (bf16_t*)(ws + WS_CKV); bf16_t* kr = (bf16_t*)(ws + WS_KR); const f32x2* rope = (const f32x2*)(ws + WS_ROPE);
            EPI_WALK({ if (cw < 128) { *(u32x4*)(ckv + (size_t)row * 128 + cw) = pack8(v); }
                       else if (cw < 160) { rope8(v, rope + (size_t)(row & (SEQ - 1)) * 16, (cw - 128) >> 1); *(u32x4*)(kr + (size_t)row * 32 + (cw - 128)) = pack8(v); } })
        } else {
            bf16_t* base = (bf16_t*)(ws + (pn < 12 ? WS_GA : WS_GB)) + ((pn - 8) & 3) * 256;
            EPI_WALK({ _Pragma("unroll") for (int j = 0; j < 8; ++j) v[j] = sigmoidf_(v[j]); *(u32x4*)(base + (size_t)row * 1024 + cw) = pack8(v); })
        }
    }
};
#define EPI_ROW(ai, m) (u.pm * 256 + (ai) * 128 + wr * 64 + (m) * 16 + fr)
#define EPI_LOAD_RS(rs) float rs8[2][4]; _Pragma("unroll") for (int ai = 0; ai < 2; ++ai) _Pragma("unroll") for (int m = 0; m < 4; ++m) rs8[ai][m] = (rs)[EPI_ROW(ai, m)];
struct EpiQ {
    static constexpr bool PERM = true;
    unsigned char* ws;
    __device__ __forceinline__ void operator()(const f32x4 (&acc)[2][2][4][2], const pg8::Unit& u, int wr, int wc, int fr, int fq) const {
        bf16_t* qb = (bf16_t*)(ws + WS_QB); const float* rs = (const float*)(ws + WS_RSTDQ); const f32x2* rope = (const f32x2*)(ws + WS_ROPE);
        EPI_LOAD_RS(rs)
        EPI_WALK({ const int col = u.pn * 256 + cw; const int w = col % 96; const float r = rs8[ai][m];
                   _Pragma("unroll") for (int j = 0; j < 8; ++j) v[j] *= r;
                   if (w >= 64) rope8(v, rope + (size_t)(row & (SEQ - 1)) * 16, (w - 64) >> 1);
                   *(u32x4*)(qb + (size_t)row * 768 + col) = pack8(v);
                   *(u32x2*)(ws + WS_Q8 + (size_t)row * 768 + col) = (u32x2){pack4_fp8(v[0] * 16.f, v[1] * 16.f, v[2] * 16.f, v[3] * 16.f), pack4_fp8(v[4] * 16.f, v[5] * 16.f, v[6] * 16.f, v[7] * 16.f)}; })
    }
};
struct EpiKV {
    static constexpr bool PERM = true;
    unsigned char* ws;
    __device__ __forceinline__ void operator()(const f32x4 (&acc)[2][2][4][2], const pg8::Unit& u, int wr, int wc, int fr, int fq) const {
        const float* rs = (const float*)(ws + WS_RSTDKV); bf16_t* kimg = (bf16_t*)(ws + WS_KIMG); bf16_t* vimg = (bf16_t*)(ws + WS_VIMG);
        EPI_LOAD_RS(rs)
        EPI_WALK({ const float r = rs8[ai][m];
                   _Pragma("unroll") for (int j = 0; j < 8; ++j) v[j] *= r;
                   const int col = (u.pn & 1) * 256 + cw, h = col >> 6, b = row >> 14, sq = row & (SEQ - 1), tile = sq >> 6, rr = sq & 63; const size_t tb = (size_t)((b * 8 + h) * 256 + tile);
                   if (u.pn < 2) { *(u32x4*)(kimg + tb * 6144 + ((col & 63) >> 3) * 512 + rr * 8) = pack8(v);
                       *(u32x2*)(ws + WS_K8 + tb * 6144 + ((col & 63) >> 4) * 1024 + rr * 16 + (col & 8)) = (u32x2){pack4_fp8(v[0], v[1], v[2], v[3]), pack4_fp8(v[4], v[5], v[6], v[7])}; }
                   else *(u32x4*)(vimg + tb * 4096 + ((col & 63) >> 5) * 2048 + rr * 32 + (col & 31)) = pack8(v); })
    }
};
template <bool SECOND> struct EpiGate {
    static constexpr bool PERM = true;
    unsigned char* ws;
    __device__ __forceinline__ void operator()(const f32x4 (&acc)[2][2][4][2], const pg8::Unit& u, int wr, int wc, int fr, int fq) const {
        bf16_t* mg = (bf16_t*)(ws + WS_MERGED); const bf16_t* gt = (const bf16_t*)(ws + (SECOND ? WS_GB : WS_GA));
#pragma unroll
        for (int ai = 0; ai < 2; ++ai) {
            u32x4 gw[4][2], pw[4][2];
#pragma unroll
            for (int m = 0; m < 4; ++m)
#pragma unroll
                for (int bj = 0; bj < 2; ++bj) { const size_t o = (size_t)EPI_ROW(ai, m) * 1024 + u.pn * 256 + bj * 128 + wc * 32 + 8 * fq; gw[m][bj] = *(const u32x4*)(gt + o); if (SECOND) pw[m][bj] = *(const u32x4*)(mg + o); }
#pragma unroll
            for (int m = 0; m < 4; ++m)
#pragma unroll
                for (int bj = 0; bj < 2; ++bj) { const size_t o = (size_t)EPI_ROW(ai, m) * 1024 + u.pn * 256 + bj * 128 + wc * 32 + 8 * fq;
                    float v[8] = {acc[ai][bj][m][0][0], acc[ai][bj][m][0][1], acc[ai][bj][m][0][2], acc[ai][bj][m][0][3], acc[ai][bj][m][1][0], acc[ai][bj][m][1][1], acc[ai][bj][m][1][2], acc[ai][bj][m][1][3]};
                    float g[8]; unpack8(gw[m][bj], g);
                    if (SECOND) { float p[8]; unpack8(pw[m][bj], p); _Pragma("unroll") for (int j = 0; j < 8; ++j) v[j] = p[j] + g[j] * v[j]; }
                    else { _Pragma("unroll") for (int j = 0; j < 8; ++j) v[j] = g[j] * v[j]; }
                    *(u32x4*)(mg + o) = pack8(v); }
            asm volatile("" ::: "memory");
        }
    }
};
struct EpiResid {
    static constexpr bool PERM = true;
    unsigned char* ws; const float* x; float* x1;
    __device__ __forceinline__ void operator()(const f32x4 (&acc)[2][2][4][2], const pg8::Unit& u, int wr, int wc, int fr, int fq) const {
        bf16_t* h2 = (bf16_t*)(ws + WS_H2);
#pragma unroll
        for (int ai = 0; ai < 2; ++ai) {
            f32x4 xa[4][2][2];
#pragma unroll
            for (int m = 0; m < 4; ++m)
#pragma unroll
                for (int bj = 0; bj < 2; ++bj) { const size_t o = (size_t)EPI_ROW(ai, m) * 1024 + u.pn * 256 + bj * 128 + wc * 32 + 8 * fq; xa[m][bj][0] = *(const f32x4*)(x + o); xa[m][bj][1] = *(const f32x4*)(x + o + 4); }
#pragma unroll
            for (int m = 0; m < 4; ++m)
#pragma unroll
                for (int bj = 0; bj < 2; ++bj) { const size_t o = (size_t)EPI_ROW(ai, m) * 1024 + u.pn * 256 + bj * 128 + wc * 32 + 8 * fq;
                    const f32x4 r0 = acc[ai][bj][m][0] + xa[m][bj][0], r1 = acc[ai][bj][m][1] + xa[m][bj][1];
                    *(f32x4*)(x1 + o) = r0; *(f32x4*)(x1 + o + 4) = r1;
                    const float v[8] = {r0[0], r0[1], r0[2], r0[3], r1[0], r1[1], r1[2], r1[3]};
                    *(u32x2*)((unsigned char*)h2 + o) = (u32x2){pack4_fp8(v[0], v[1], v[2], v[3]), pack4_fp8(v[4], v[5], v[6], v[7])}; }
            asm volatile("" ::: "memory");
        }
    }
};
struct EpiSwiglu {
    static constexpr bool PERM = true;
    unsigned char* ws; const float* bgu;
    __device__ __forceinline__ void operator()(const f32x4 (&acc)[2][2][4][2], const pg8::Unit& u, int wr, int wc, int fr, int fq) const {
        bf16_t* act = (bf16_t*)(ws + WS_ACT); const float* rsc = (const float*)(ws + WS_ROWSCALE);
        const int c0 = u.pn * 128 + wc * 32 + 8 * fq; const float* bg = bgu + (size_t)u.e * 2048 + c0;
        float bgv[8], buv[8];
#pragma unroll
        for (int j = 0; j < 8; ++j) { bgv[j] = bg[j]; buv[j] = bg[1024 + j]; }
        EPI_LOAD_RS(rsc)
#pragma unroll
        for (int ai = 0; ai < 2; ++ai)
#pragma unroll
            for (int m = 0; m < 4; ++m) {
                const int row = u.pm * 256 + ai * 128 + wr * 64 + m * 16 + fr; const float r = rs8[ai][m]; float o[8];
#pragma unroll
                for (int j = 0; j < 8; ++j) { const float g0 = acc[ai][0][m][j >> 2][j & 3] * r + bgv[j], u0 = acc[ai][1][m][j >> 2][j & 3] * r + buv[j];
                    const float g = fminf(g0, 7.f), up = __builtin_amdgcn_fmed3f(u0, -7.f, 7.f);
                    const float gs = g * frcp(1.f + fexp2(g * (-1.702f * LOG2E)));
                    o[j] = __builtin_fmaf(up, gs, gs); }
                *(u32x2*)((unsigned char*)act + (size_t)row * 1024 + c0) = (u32x2){pack4_fp8(o[0], o[1], o[2], o[3]), pack4_fp8(o[4], o[5], o[6], o[7])};
            }
    }
};
struct EpiDown {
    static constexpr bool PERM = true;
    unsigned char* ws; const float* bd;
    __device__ __forceinline__ void operator()(const f32x4 (&acc)[2][2][4][2], const pg8::Unit& u, int wr, int wc, int fr, int fq) const {
        bf16_t* y = (bf16_t*)(ws + WS_Y); const float* b = bd + (size_t)u.e * 1024 + u.pn * 256;
        EPI_WALK({ _Pragma("unroll") for (int j = 0; j < 8; ++j) v[j] += b[cw + j];
                   *(u32x4*)(y + (size_t)row * 1024 + u.pn * 256 + cw) = pack8(v); })
    }
};

typedef short v4i16_t __attribute__((ext_vector_type(4)));
__device__ __forceinline__ s16x4 vtr(const LAS char* p) { return __builtin_bit_cast(s16x4, __builtin_amdgcn_ds_read_tr16_b64_v4i16((LAS v4i16_t*)p)); }
__device__ __forceinline__ float swapmax(float m) { auto rr = __builtin_amdgcn_permlane32_swap(__float_as_uint(m), __float_as_uint(m), false, false); return fmaxf(__uint_as_float(rr[0]), __uint_as_float(rr[1])); }
__device__ __forceinline__ float swapsum(float m) { auto rr = __builtin_amdgcn_permlane32_swap(__float_as_uint(m), __float_as_uint(m), false, false); return __uint_as_float(rr[0]) + __uint_as_float(rr[1]); }

struct AttnState { f32x16 o0, o1; float m, l; };

struct MlaKL {
    const bf16_t* K; const bf16_t* V;
    template <int D0> __device__ __forceinline__ bf16x8 kfrag(int c, int r32, int hi) const { return *(const bf16x8*)(K + (size_t)(c >> 1) * 6144 + (2 * D0 + hi) * 512 + ((c & 1) * 32 + r32) * 8); }
    __device__ __forceinline__ u32x4 vpiece(int c, int row, int c8) const { return *(const u32x4*)(V + (size_t)(c >> 1) * 4096 + (c8 >> 2) * 2048 + ((c & 1) * 32 + row) * 32 + (c8 & 3) * 8); }
    __device__ __forceinline__ void modify(int, f32x16&, int, int) const {}
    __device__ __forceinline__ int order(int i) const { return i; }
};
struct DilKL {
    const bf16_t* K; const bf16_t* V;
    int dil, res, u0, L; float slope2d;
    __device__ __forceinline__ size_t tok(int c, int kk) const { int v = u0 - 64 + 32 * c + kk; v = v < 0 ? 0 : (v >= L ? L - 1 : v); return (size_t)(res + dil * v); }
    template <int D0> __device__ __forceinline__ bf16x8 kfrag(int c, int r32, int hi) const { return *(const bf16x8*)(K + tok(c, r32) * 512 + 16 * D0 + 8 * hi); }
    __device__ __forceinline__ u32x4 vpiece(int c, int row, int c8) const { return *(const u32x4*)(V + tok(c, row) * 512 + 8 * c8); }
    __device__ __forceinline__ void modify(int c, f32x16& s, int r32, int hi) const {
        const float c0 = (float)(32 * c - 64); const int vb = u0 - 64 + 32 * c;
#pragma unroll
        for (int r = 0; r < 16; ++r) { const float d = (float)(crow(r, hi) - r32); s[r] = s[r] - slope2d * fabsf(d + c0); }
        if (c == 0) {
#pragma unroll
            for (int r = 0; r < 16; ++r) s[r] = (crow(r, hi) >= r32) ? s[r] : -1e30f; }
        if (c == 4) {
#pragma unroll
            for (int r = 0; r < 16; ++r) s[r] = (crow(r, hi) <= r32) ? s[r] : -1e30f; }
        if (vb < 0 || vb + 31 >= L) {
#pragma unroll
            for (int r = 0; r < 16; ++r) { const int v = vb + crow(r, hi); s[r] = (v >= 0 && v < L) ? s[r] : -1e30f; } }
    }
    __device__ __forceinline__ int order(int i) const { return i == 0 ? 2 : i == 1 ? 1 : i == 2 ? 3 : i == 3 ? 0 : 4; }
};

template <int NDK, class KL> __device__ __forceinline__ void attn_load_k(bf16x8 (&kf)[NDK], const KL& kl, int c, int r32, int hi) {
    kf[0] = kl.template kfrag<0>(c, r32, hi); kf[1] = kl.template kfrag<1>(c, r32, hi); kf[2] = kl.template kfrag<2>(c, r32, hi); kf[3] = kl.template kfrag<3>(c, r32, hi);
    if constexpr (NDK == 6) { kf[4] = kl.template kfrag<4>(c, r32, hi); kf[5] = kl.template kfrag<5>(c, r32, hi); }
}
template <class KL> __device__ __forceinline__ void attn_load_v(u32x4 (&vp)[4], const KL& kl, int c, int lane) {
#pragma unroll
    for (int i = 0; i < 4; ++i) { const int p = lane + 64 * i; vp[i] = kl.vpiece(c, p >> 3, p & 7); }
}
__device__ __forceinline__ void attn_store_v(const u32x4 (&vp)[4], LAS char* vimg, int lane) {
#pragma unroll
    for (int i = 0; i < 4; ++i) { const int p = lane + 64 * i, row = p >> 3, c8 = p & 7; *(LAS u32x4*)(vimg + (c8 >> 2) * 2048 + row * 64 + (c8 & 3) * 16) = vp[i]; }
}
template <int NDK, class KL> __device__ __forceinline__ void attn_core(AttnState& st, const bf16x8 (&qf)[NDK], const bf16x8 (&kf)[NDK], const KL& kl, int c, LAS char* vimg, LAS float* wsf, int lane, int r32, int hi) {
    f32x16 s = {};
#pragma unroll
    for (int d0 = 0; d0 < NDK; ++d0) s = __builtin_amdgcn_mfma_f32_32x32x16_bf16(kf[d0], qf[d0], s, 0, 0, 0);
    kl.modify(c, s, r32, hi);
    float mx = s[0];
#pragma unroll
    for (int r = 1; r < 16; ++r) mx = fmaxf(mx, s[r]);
    mx = swapmax(mx);
    const float mn = fmaxf(st.m, mx), alpha = fexp2(st.m - mn);
    float ps = 0.f;
#pragma unroll
    for (int r = 0; r < 16; ++r) { s[r] = fexp2(s[r] - mn); ps += s[r]; }
    st.l = st.l * alpha + ps; st.m = mn;
    if (__any(alpha != 1.f)) {
        if (hi == 0) wsf[r32] = alpha;
#pragma unroll
        for (int r = 0; r < 16; ++r) { const float a = wsf[crow(r, hi)]; st.o0[r] *= a; st.o1[r] *= a; }
    }
    const u32x4 pw0 = {cvtpk(s[0], s[1]), cvtpk(s[2], s[3]), cvtpk(s[4], s[5]), cvtpk(s[6], s[7])};
    const u32x4 pw1 = {cvtpk(s[8], s[9]), cvtpk(s[10], s[11]), cvtpk(s[12], s[13]), cvtpk(s[14], s[15])};
    const bf16x8 pa0 = __builtin_bit_cast(bf16x8, pw0), pa1 = __builtin_bit_cast(bf16x8, pw1);
    const LAS char* vp = vimg + ((lane >> 4) & 1) * 32 + (lane & 3) * 8 + (4 * hi + ((lane & 15) >> 2)) * 64;
#pragma unroll
    for (int ks = 0; ks < 2; ++ks) {
        const s16x4 l0 = vtr(vp + ks * 1024), h0 = vtr(vp + ks * 1024 + 512), l1 = vtr(vp + 2048 + ks * 1024), h1 = vtr(vp + 2048 + ks * 1024 + 512);
        const bf16x8 v0 = {l0[0], l0[1], l0[2], l0[3], h0[0], h0[1], h0[2], h0[3]}, v1 = {l1[0], l1[1], l1[2], l1[3], h1[0], h1[1], h1[2], h1[3]};
        st.o0 = __builtin_amdgcn_mfma_f32_32x32x16_bf16(ks == 0 ? pa0 : pa1, v0, st.o0, 0, 0, 0);
        st.o1 = __builtin_amdgcn_mfma_f32_32x32x16_bf16(ks == 0 ? pa0 : pa1, v1, st.o1, 0, 0, 0);
    }
}
template <int NDK, class KL> __device__ __forceinline__ void wave_attn(AttnState& st, const bf16x8 (&qf)[NDK], const KL& kl, int nchunk, LAS char* vimg, LAS float* wsf, int lane) {
    const int r32 = lane & 31, hi = lane >> 5;
    st.o0 = f32x16{}; st.o1 = f32x16{}; st.m = -1e30f; st.l = 0.f;
    bf16x8 kfa[NDK], kfb[NDK]; u32x4 vp[4];
    attn_load_k<NDK>(kfa, kl, kl.order(0), r32, hi); attn_load_v(vp, kl, kl.order(0), lane);
    asm volatile("" : "+s"(nchunk));
#pragma unroll 1
    for (int c = 0; c < nchunk; c += 2) {
        attn_store_v(vp, vimg, lane);
        if (c + 1 < nchunk) { attn_load_k<NDK>(kfb, kl, kl.order(c + 1), r32, hi); attn_load_v(vp, kl, kl.order(c + 1), lane); }
        attn_core<NDK>(st, qf, kfa, kl, kl.order(c), vimg, wsf, lane, r32, hi);
        if (c + 1 < nchunk) {
            attn_store_v(vp, vimg, lane);
            if (c + 2 < nchunk) { attn_load_k<NDK>(kfa, kl, kl.order(c + 2), r32, hi); attn_load_v(vp, kl, kl.order(c + 2), lane); }
            attn_core<NDK>(st, qf, kfb, kl, kl.order(c + 1), vimg, wsf, lane, r32, hi);
        }
    }
}
__device__ __forceinline__ float attn_finish(AttnState& st, LAS char* vimg, LAS float* wsf, int lane) {
    const int r32 = lane & 31, hi = lane >> 5;
    const float lt = swapsum(st.l);
    if (hi == 0) wsf[32 + r32] = lt;
    LAS bf16_t* stg = (LAS bf16_t*)vimg;
#pragma unroll
    for (int r = 0; r < 16; ++r) { const int q = crow(r, hi); const float il = frcp(wsf[32 + q]);
        stg[q * 64 + r32] = (bf16_t)f2bf(st.o0[r] * il); stg[q * 64 + 32 + r32] = (bf16_t)f2bf(st.o1[r] * il); }
    return lt;
}

namespace mla {
constexpr int NW = 8, QBLK = 32, QB = 256, KVBLK = 64, NT = SEQ / KVBLK;
constexpr int KSLOT = 12288, VSLOT = 8192, LDS_K = 0, LDS_V = 3 * KSLOT, LDS_WS = LDS_V + 3 * VSLOT, LDS_OST = LDS_WS + NW * 256, LDS_BYTES_ = LDS_OST + NW * 4096;
#define SBAR() __builtin_amdgcn_sched_barrier(0)
#define WAIT_BAR(N) asm volatile("s_waitcnt vmcnt(" #N ") lgkmcnt(0)\n\ts_barrier" ::: "memory")
__device__ __forceinline__ void glds16(const void* gsrc, unsigned lds_dst) { unsigned keep;
    asm volatile("s_mov_b32 %0, m0\n\ts_mov_b32 m0, %2\n\ts_nop 0\n\tglobal_load_lds_dwordx4 %1, off\n\ts_mov_b32 m0, %0" : "=&s"(keep) : "v"(gsrc), "s"(lds_dst) : "memory"); }
typedef LAS const char* lds_cptr;
__device__ __forceinline__ void kload2(bf16x8* kf, lds_cptr kp, int j) { kf[2 * j] = *(const LAS bf16x8*)(kp + j * 2048); kf[2 * j + 1] = *(const LAS bf16x8*)(kp + j * 2048 + 512); }

__device__ __forceinline__ void mla_unit(int b, int h, int qb, const bf16_t* Q, const bf16_t* __restrict__ Kim, const bf16_t* __restrict__ Vim, bf16_t* O, LAS char* shm) {
    const int tid = threadIdx.x, lane = tid & 63, r32 = lane & 31, hi = lane >> 5; const int wid = __builtin_amdgcn_readfirstlane(tid >> 6);
    const long rowbase = (long)b * SEQ; const int q0 = qb * QB;
    const bf16_t* Qw = Q + (rowbase + q0 + wid * QBLK) * 768 + h * 96;
    const unsigned lds0 = (unsigned)(uintptr_t)shm;
    LAS float* wsf = (LAS float*)(shm + LDS_WS) + wid * 64;
    const bf16_t* ksrc = Kim + wid * 512 + lane * 8;
    const bf16_t* rsrc = Kim + (8 + (wid & 3)) * 512 + lane * 8;
    const bf16_t* vsrc = Vim + wid * 512 + lane * 8;
    const unsigned kdst = lds0 + LDS_K + wid * 1024, rdst = lds0 + LDS_K + (8 + (wid & 3)) * 1024, vdst = lds0 + LDS_V + wid * 1024;
#define DMA_K(t, ks) do { glds16(ksrc + (long)(t) * 6144, (unsigned)__builtin_amdgcn_readfirstlane(kdst + (ks))); glds16(rsrc + (long)(t) * 6144, (unsigned)__builtin_amdgcn_readfirstlane(rdst + (ks))); } while (0)
#define DMA_V(t, vs) glds16(vsrc + (long)(t) * 4096, (unsigned)__builtin_amdgcn_readfirstlane(vdst + (vs)))
    const lds_cptr shm3 = (lds_cptr)shm; const lds_cptr kp0 = shm3 + LDS_K + hi * 1024 + r32 * 16;
    const lds_cptr vp0 = shm3 + LDS_V + ((lane >> 4) & 1) * 32 + (lane & 3) * 8 + (4 * hi + ((lane & 15) >> 2)) * 64;
    bf16x8 kf[12];
    DMA_K(0, 0); DMA_V(0, 0); DMA_K(1, KSLOT);
    bf16x8 qr[6];
#pragma unroll
    for (int d0 = 0; d0 < 6; ++d0) qr[d0] = *reinterpret_cast<const bf16x8*>(&Qw[(long)r32 * 768 + d0 * 16 + hi * 8]);
    float l_reg = 0.f; f32x16 o[2]; o[0] = f32x16{}; o[1] = f32x16{};
    f32x16 pA0, pA1, pB0, pB1;
    int si_prev = 0, si_cur = 0, si_next = 1;
#define ROT() do { si_prev = si_cur; si_cur = si_next; si_next = (si_next == 2) ? 0 : si_next + 1; } while (0)
    DMA_K(2, 2 * KSLOT);
    WAIT_BAR(5);
    { const lds_cptr kb = kp0;
#pragma unroll
      for (int d0 = 0; d0 < 6; ++d0) { const bf16x8 b0 = *(const LAS bf16x8*)(kb + d0 * 2048), b1 = *(const LAS bf16x8*)(kb + d0 * 2048 + 512);
          if (d0 == 0) { pA0 = __builtin_amdgcn_mfma_f32_32x32x16_bf16(b0, qr[0], f32x16{}, 0, 0, 0); pA1 = __builtin_amdgcn_mfma_f32_32x32x16_bf16(b1, qr[0], f32x16{}, 0, 0, 0); }
          else { pA0 = __builtin_amdgcn_mfma_f32_32x32x16_bf16(b0, qr[d0], pA0, 0, 0, 0); pA1 = __builtin_amdgcn_mfma_f32_32x32x16_bf16(b1, qr[d0], pA1, 0, 0, 0); } } }
#pragma unroll
    for (int r = 0; r < 16; ++r) { pA0[r] = __builtin_amdgcn_exp2f(pA0[r]); pA1[r] = __builtin_amdgcn_exp2f(pA1[r]); }
    WAIT_BAR(0);
    DMA_K(3, 0); DMA_V(1, VSLOT);
    ROT();
#pragma unroll
    for (int j = 0; j < 6; ++j) kload2(kf, kp0 + si_cur * KSLOT, j);
    WAIT_BAR(3);
    s16x4 vlo[8], vhi[8]; u32x4 pw0, pw1, pw2, pw3;
#define PKW(P, B) cvtpk(P[B], P[B + 1])
#define PAF(k) __builtin_bit_cast(bf16x8, pw##k)
#define VFR(i) (bf16x8){vlo[i][0], vlo[i][1], vlo[i][2], vlo[i][3], vhi[i][0], vhi[i][1], vhi[i][2], vhi[i][3]}
#define PIN(x) asm volatile("" : "+v"(x))
#define MF(a, b, c) __builtin_amdgcn_mfma_f32_32x32x16_bf16(a, b, c, 0, 0, 0)
#define GAPA(MFX, A0, A1, A2, A3, W0, W1, PW) do { MFX; sacc += A0; sacc += A1; sacc += A2; sacc += A3; PIN(sacc); W0; W1; PIN(PW); SBAR(); } while (0)
#define GAPM(MFX) do { MFX; SBAR(); } while (0)
#define EX(v) __builtin_amdgcn_exp2f(v)
#define GAPB(MFX, X, B) do { MFX; X[B] = EX(X[B]); X[B + 1] = EX(X[B + 1]); X[B + 2] = EX(X[B + 2]); X[B + 3] = EX(X[B + 3]); PIN(X); SBAR(); } while (0)
#define VRD(i) do { vlo[i] = vtr(vp_ + (((i) >> 2) * 4096 + ((i) & 3) * 1024)); vhi[i] = vtr(vp_ + (((i) >> 2) * 4096 + ((i) & 3) * 1024 + 512)); } while (0)
#define KRD(G, j) do { if (G) { kload2(kf, kp0 + si_next * KSLOT, j); SBAR(); } } while (0)
#define STEP(C0, C1, P0, P1, t, GK, GV, GL) do { SBAR(); \
    const lds_cptr vp_ = vp0 + si_prev * VSLOT; \
    VRD(0); SBAR(); float sacc = (P0[0] + P0[1]); \
    GAPA(C0 = MF(kf[0], qr[0], f32x16{}), P0[2], P0[3], P0[4], P0[5],     pw0[0] = PKW(P0, 0),  pw0[1] = PKW(P0, 2),  pw0); \
    VRD(4); SBAR(); GAPA(C1 = MF(kf[1], qr[0], f32x16{}), P0[6], P0[7], P0[8], P0[9],     pw0[2] = PKW(P0, 4),  pw0[3] = PKW(P0, 6),  pw0); \
    VRD(1); SBAR(); GAPA(C0 = MF(kf[2], qr[1], C0),   P0[10], P0[11], P0[12], P0[13], pw1[0] = PKW(P0, 8),  pw1[1] = PKW(P0, 10), pw1); \
    VRD(5); SBAR(); GAPA(C1 = MF(kf[3], qr[1], C1),   P0[14], P0[15], P1[0], P1[1],   pw1[2] = PKW(P0, 12), pw1[3] = PKW(P0, 14), pw1); \
    VRD(2); SBAR(); GAPA(C0 = MF(kf[4], qr[2], C0),   P1[2], P1[3], P1[4], P1[5],     pw2[0] = PKW(P1, 0),  pw2[1] = PKW(P1, 2),  pw2); \
    VRD(6); SBAR(); GAPA(C1 = MF(kf[5], qr[2], C1),   P1[6], P1[7], P1[8], P1[9],     pw2[2] = PKW(P1, 4),  pw2[3] = PKW(P1, 6),  pw2); \
    VRD(3); SBAR(); GAPA(C0 = MF(kf[6], qr[3], C0),   P1[10], P1[11], P1[12], P1[13], pw3[0] = PKW(P1, 8),  pw3[1] = PKW(P1, 10), pw3); \
    VRD(7); SBAR(); GAPA(C1 = MF(kf[7], qr[3], C1),   P1[14], P1[15], 0.f, 0.f,       pw3[2] = PKW(P1, 12), pw3[3] = PKW(P1, 14), pw3); \
    GAPM(C0 = MF(kf[8], qr[4], C0)); GAPM(C1 = MF(kf[9], qr[4], C1)); GAPM(C0 = MF(kf[10], qr[5], C0)); GAPM(C1 = MF(kf[11], qr[5], C1)); \
    l_reg += sacc; \
    if (GK) { DMA_K((t) + 3, si_cur * KSLOT); } if (GV) { DMA_V((t) + 1, si_next * VSLOT); } \
    SBAR(); \
    GAPB(o[0] = MF(PAF(0), VFR(0), o[0]), C0, 0); \
    GAPB(o[1] = MF(PAF(0), VFR(4), o[1]), C0, 4); \
    KRD(GL, 0); GAPB(o[0] = MF(PAF(1), VFR(1), o[0]), C0, 8); \
    KRD(GL, 1); GAPB(o[1] = MF(PAF(1), VFR(5), o[1]), C0, 12); \
    KRD(GL, 2); GAPB(o[0] = MF(PAF(2), VFR(2), o[0]), C1, 0); \
    KRD(GL, 3); GAPB(o[1] = MF(PAF(2), VFR(6), o[1]), C1, 4); \
    KRD(GL, 4); GAPB(o[0] = MF(PAF(3), VFR(3), o[0]), C1, 8); \
    KRD(GL, 5); GAPB(o[1] = MF(PAF(3), VFR(7), o[1]), C1, 12); \
    } while (0)
    int t = 1;
    for (; t + 5 < NT; t += 2) {
        STEP(pB0, pB1, pA0, pA1, t, true, true, true);     WAIT_BAR(3); ROT();
        STEP(pA0, pA1, pB0, pB1, t + 1, true, true, true); WAIT_BAR(3); ROT();
    }
#define ENDW(tt) do { if ((tt) + 3 < NT) { WAIT_BAR(3); } else if ((tt) + 2 < NT) { WAIT_BAR(1); } else { WAIT_BAR(0); } } while (0)
    for (; t + 1 < NT; t += 2) {
        STEP(pB0, pB1, pA0, pA1, t, (t + 3 < NT), (t + 1 < NT), (t + 1 < NT));         ENDW(t);     ROT();
        STEP(pA0, pA1, pB0, pB1, t + 1, (t + 4 < NT), (t + 2 < NT), (t + 2 < NT));     ENDW(t + 1); ROT();
    }
    STEP(pB0, pB1, pA0, pA1, NT - 1, false, false, false);
    { float sacc = pB0[0] + pB0[1];
#pragma unroll
      for (int r = 2; r < 16; ++r) sacc += pB0[r];
#pragma unroll
      for (int r = 0; r < 16; ++r) sacc += pB1[r];
      l_reg += sacc;
      pw0 = (u32x4){PKW(pB0, 0), PKW(pB0, 2), PKW(pB0, 4), PKW(pB0, 6)}; pw1 = (u32x4){PKW(pB0, 8), PKW(pB0, 10), PKW(pB0, 12), PKW(pB0, 14)};
      pw2 = (u32x4){PKW(pB1, 0), PKW(pB1, 2), PKW(pB1, 4), PKW(pB1, 6)}; pw3 = (u32x4){PKW(pB1, 8), PKW(pB1, 10), PKW(pB1, 12), PKW(pB1, 14)};
      SBAR();
      const lds_cptr vp_ = vp0 + si_cur * VSLOT;
#pragma unroll
      for (int d0 = 0; d0 < 2; ++d0) {
          s16x4 lo4[4], hi4[4];
#pragma unroll
          for (int ks = 0; ks < 4; ++ks) { lo4[ks] = vtr(vp_ + d0 * 4096 + ks * 1024); hi4[ks] = vtr(vp_ + d0 * 4096 + ks * 1024 + 512); }
#define PK4(k) (bf16x8){lo4[k][0], lo4[k][1], lo4[k][2], lo4[k][3], hi4[k][0], hi4[k][1], hi4[k][2], hi4[k][3]}
          o[d0] = MF(PAF(0), PK4(0), o[d0]); o[d0] = MF(PAF(1), PK4(1), o[d0]); o[d0] = MF(PAF(2), PK4(2), o[d0]); o[d0] = MF(PAF(3), PK4(3), o[d0]);
#undef PK4
      } }
    l_reg = swapsum(l_reg);
    if (hi == 0) wsf[32 + r32] = l_reg;
    asm volatile("s_waitcnt lgkmcnt(0)" ::: "memory");
    float rli[16];
#pragma unroll
    for (int r = 0; r < 16; ++r) rli[r] = __builtin_amdgcn_rcpf(wsf[32 + crow(r, hi)]);
    bf16_t* Ow = O + (rowbase + q0 + wid * QBLK) * 512 + h * 64;
    { LAS bf16_t* stg = (LAS bf16_t*)(shm + LDS_OST) + wid * 2048;
#pragma unroll
      for (int r = 0; r < 16; ++r) { const int orow = crow(r, hi);
#pragma unroll
          for (int d0 = 0; d0 < 2; ++d0) stg[orow * 64 + d0 * 32 + r32] = (bf16_t)f2bf(o[d0][r] * rli[r]); }
      asm volatile("s_waitcnt lgkmcnt(0)" ::: "memory");
#pragma unroll
      for (int i = 0; i < 4; ++i) { const int row = i * 8 + (lane >> 3), ch = lane & 7; const u32x4 v = *(const LAS u32x4*)(stg + row * 64 + ch * 8); *(u32x4*)(Ow + (long)row * 512 + ch * 8) = v; } }
    asm volatile("s_waitcnt lgkmcnt(0)\n\ts_barrier" ::: "memory");
#undef DMA_K
#undef DMA_V
#undef ROT
#undef PKW
#undef PAF
#undef VFR
#undef PIN
#undef MF
#undef GAPA
#undef GAPM
#undef GAPB
#undef EX
#undef VRD
#undef KRD
#undef STEP
#undef ENDW
}
#undef SBAR
#undef WAIT_BAR
}

namespace mla8 {
using mla::glds16; using mla::lds_cptr;
typedef int v8i __attribute__((ext_vector_type(8)));
constexpr int NW = 8, QBLK = 32, QB = 256, KVBLK = 64, NT = SEQ / KVBLK;
constexpr int KSLOT = 6144, VSLOT = 8192, LDS_K = 0, LDS_V = 3 * KSLOT, LDS_WS = LDS_V + 3 * VSLOT, LDS_OST = LDS_WS + NW * 256, LDS_BYTES_ = LDS_OST + NW * 4096;
#define SBAR() __builtin_amdgcn_sched_barrier(0)
#define WAIT_BAR(N) asm volatile("s_waitcnt vmcnt(" #N ") lgkmcnt(0)\n\ts_barrier" ::: "memory")
__device__ __forceinline__ v8i kfrag8(lds_cptr slot, int n, int ks, int r32, int hi) {
    const lds_cptr p = slot + (ks == 0 ? 2 * hi : 4) * 1024 + (32 * n + r32) * 16;
    const u32x4 a = *(const LAS u32x4*)p, b = *(const LAS u32x4*)(p + 1024);
    return (v8i){(int)a.x, (int)a.y, (int)a.z, (int)a.w, (int)b.x, (int)b.y, (int)b.z, (int)b.w};
}
#define MF8(a, b, c) __builtin_amdgcn_mfma_scale_f32_32x32x64_f8f6f4(a, b, c, 0, 0, 0, 0x7f7f7f7f, 0, 0x7b7b7b7b)

__device__ __forceinline__ void mla8_unit(int b, int h, int qb, const unsigned char* Q8, const unsigned char* __restrict__ K8im, const bf16_t* __restrict__ Vim, bf16_t* O, LAS char* shm) {
    const int tid = threadIdx.x, lane = tid & 63, r32 = lane & 31, hi = lane >> 5; const int wid = __builtin_amdgcn_readfirstlane(tid >> 6);
    const long rowbase = (long)b * SEQ; const int q0 = qb * QB;
    const unsigned char* Qw = Q8 + (size_t)(rowbase + q0 + wid * QBLK + r32) * 768 + h * 96;
    const unsigned lds0 = (unsigned)(uintptr_t)shm;
    LAS float* wsf = (LAS float*)(shm + LDS_WS) + wid * 64;
    const int kpc = wid < 6 ? wid : wid - 6;
    const unsigned char* ksrc = K8im + kpc * 1024 + lane * 16;
    const bf16_t* vsrc = Vim + wid * 512 + lane * 8;
    const unsigned kdst = lds0 + LDS_K + kpc * 1024, vdst = lds0 + LDS_V + wid * 1024;
#define DMA_K(t, ks) glds16(ksrc + (long)(t) * 6144, (unsigned)__builtin_amdgcn_readfirstlane(kdst + (ks)))
#define DMA_V(t, vs) glds16(vsrc + (long)(t) * 4096, (unsigned)__builtin_amdgcn_readfirstlane(vdst + (vs)))
    const lds_cptr shm3 = (lds_cptr)shm; const lds_cptr ks0 = shm3 + LDS_K;
    const lds_cptr vp0 = shm3 + LDS_V + ((lane >> 4) & 1) * 32 + (lane & 3) * 8 + (4 * hi + ((lane & 15) >> 2)) * 64;
    v8i kf[4];
    DMA_K(0, 0); DMA_V(0, 0); DMA_K(1, KSLOT);
    v8i qr[2];
    { const u32x4 a = *(const u32x4*)(Qw + 32 * hi), c = *(const u32x4*)(Qw + 32 * hi + 16); qr[0] = (v8i){(int)a.x, (int)a.y, (int)a.z, (int)a.w, (int)c.x, (int)c.y, (int)c.z, (int)c.w};
      u32x4 d = *(const u32x4*)(Qw + 64), e = *(const u32x4*)(Qw + 80); if (hi) { d = (u32x4){0u, 0u, 0u, 0u}; e = d; }
      qr[1] = (v8i){(int)d.x, (int)d.y, (int)d.z, (int)d.w, (int)e.x, (int)e.y, (int)e.z, (int)e.w}; }
    float l_reg = 0.f; f32x16 o[2]; o[0] = f32x16{}; o[1] = f32x16{};
    f32x16 pA0, pA1, pB0, pB1;
    int si_prev = 0, si_cur = 0, si_next = 1;
#define ROT() do { si_prev = si_cur; si_cur = si_next; si_next = (si_next == 2) ? 0 : si_next + 1; } while (0)
    DMA_K(2, 2 * KSLOT);
    WAIT_BAR(3);
    { pA0 = MF8(kfrag8(ks0, 0, 0, r32, hi), qr[0], f32x16{}); pA1 = MF8(kfrag8(ks0, 1, 0, r32, hi), qr[0], f32x16{});
      pA0 = MF8(kfrag8(ks0, 0, 1, r32, hi), qr[1], pA0); pA1 = MF8(kfrag8(ks0, 1, 1, r32, hi), qr[1], pA1); }
#pragma unroll
    for (int r = 0; r < 16; ++r) { pA0[r] = __builtin_amdgcn_exp2f(pA0[r]); pA1[r] = __builtin_amdgcn_exp2f(pA1[r]); }
    WAIT_BAR(0);
    DMA_K(3, 0); DMA_V(1, VSLOT);
    ROT();
    kf[0] = kfrag8(ks0 + si_cur * KSLOT, 0, 0, r32, hi); kf[1] = kfrag8(ks0 + si_cur * KSLOT, 0, 1, r32, hi); kf[2] = kfrag8(ks0 + si_cur * KSLOT, 1, 0, r32, hi); kf[3] = kfrag8(ks0 + si_cur * KSLOT, 1, 1, r32, hi);
    WAIT_BAR(2);
    s16x4 vlo[8], vhi[8]; u32x4 pw0, pw1, pw2, pw3;
#define PKW(P, B) cvtpk(P[B], P[B + 1])
#define PAF(k) __builtin_bit_cast(bf16x8, pw##k)
#define VFR(i) (bf16x8){vlo[i][0], vlo[i][1], vlo[i][2], vlo[i][3], vhi[i][0], vhi[i][1], vhi[i][2], vhi[i][3]}
#define PIN(x) asm volatile("" : "+v"(x))
#define MF(a, b, c) __builtin_amdgcn_mfma_f32_32x32x16_bf16(a, b, c, 0, 0, 0)
#define GAPA(MFX, A0, A1, A2, A3, W0, W1, PW) do { MFX; sacc += A0; sacc += A1; sacc += A2; sacc += A3; PIN(sacc); W0; W1; PIN(PW); SBAR(); } while (0)
#define GAPM(MFX) do { MFX; SBAR(); } while (0)
#define EX(v) __builtin_amdgcn_exp2f(v)
#define GAPB(MFX, X, B) do { MFX; X[B] = EX(X[B]); X[B + 1] = EX(X[B + 1]); X[B + 2] = EX(X[B + 2]); X[B + 3] = EX(X[B + 3]); PIN(X); SBAR(); } while (0)
#define VRD(i) do { vlo[i] = vtr(vp_ + (((i) >> 2) * 4096 + ((i) & 3) * 1024)); vhi[i] = vtr(vp_ + (((i) >> 2) * 4096 + ((i) & 3) * 1024 + 512)); } while (0)
#define KRD(G, j) do { if (G) { kf[j] = kfrag8(ks0 + si_next * KSLOT, (j) >> 1, (j) & 1, r32, hi); SBAR(); } } while (0)
#define GAPA8(MFX, A0, A1, A2, A3, A4, A5, A6, A7, W0, W1, W2, W3, PWa, PWb) do { MFX; sacc += A0; sacc += A1; sacc += A2; sacc += A3; PIN(sacc); W0; W1; PIN(PWa); sacc += A4; sacc += A5; sacc += A6; sacc += A7; PIN(sacc); W2; W3; PIN(PWb); SBAR(); } while (0)
#define STEP(C0, C1, P0, P1, t, GK, GV, GL) do { SBAR(); \
    const lds_cptr vp_ = vp0 + si_prev * VSLOT; \
    VRD(0); VRD(4); SBAR(); float sacc = (P0[0] + P0[1]); \
    GAPA8(C0 = MF8(kf[0], qr[0], f32x16{}), P0[2], P0[3], P0[4], P0[5], P0[6], P0[7], P0[8], P0[9],         pw0[0] = PKW(P0, 0), pw0[1] = PKW(P0, 2), pw0[2] = PKW(P0, 4), pw0[3] = PKW(P0, 6), pw0, pw0); \
    VRD(1); VRD(5); SBAR(); \
    GAPA8(C1 = MF8(kf[2], qr[0], f32x16{}), P0[10], P0[11], P0[12], P0[13], P0[14], P0[15], P1[0], P1[1],   pw1[0] = PKW(P0, 8), pw1[1] = PKW(P0, 10), pw1[2] = PKW(P0, 12), pw1[3] = PKW(P0, 14), pw1, pw1); \
    VRD(2); VRD(6); SBAR(); \
    GAPA8(C0 = MF8(kf[1], qr[1], C0),       P1[2], P1[3], P1[4], P1[5], P1[6], P1[7], P1[8], P1[9],         pw2[0] = PKW(P1, 0), pw2[1] = PKW(P1, 2), pw2[2] = PKW(P1, 4), pw2[3] = PKW(P1, 6), pw2, pw2); \
    VRD(3); VRD(7); SBAR(); \
    GAPA8(C1 = MF8(kf[3], qr[1], C1),       P1[10], P1[11], P1[12], P1[13], P1[14], P1[15], 0.f, 0.f,       pw3[0] = PKW(P1, 8), pw3[1] = PKW(P1, 10), pw3[2] = PKW(P1, 12), pw3[3] = PKW(P1, 14), pw3, pw3); \
    l_reg += sacc; \
    if (GK) { DMA_K((t) + 3, si_cur * KSLOT); } if (GV) { DMA_V((t) + 1, si_next * VSLOT); } \
    SBAR(); \
    GAPB(o[0] = MF(PAF(0), VFR(0), o[0]), C0, 0); \
    GAPB(o[1] = MF(PAF(0), VFR(4), o[1]), C0, 4); \
    KRD(GL, 0); GAPB(o[0] = MF(PAF(1), VFR(1), o[0]), C0, 8); \
    KRD(GL, 1); GAPB(o[1] = MF(PAF(1), VFR(5), o[1]), C0, 12); \
    KRD(GL, 2); GAPB(o[0] = MF(PAF(2), VFR(2), o[0]), C1, 0); \
    KRD(GL, 3); GAPB(o[1] = MF(PAF(2), VFR(6), o[1]), C1, 4); \
    GAPB(o[0] = MF(PAF(3), VFR(3), o[0]), C1, 8); \
    GAPB(o[1] = MF(PAF(3), VFR(7), o[1]), C1, 12); \
    } while (0)
    int t = 1;
    for (; t + 5 < NT; t += 2) {
        STEP(pB0, pB1, pA0, pA1, t, true, true, true);     WAIT_BAR(2); ROT();
        STEP(pA0, pA1, pB0, pB1, t + 1, true, true, true); WAIT_BAR(2); ROT();
    }
#define ENDW(tt) do { if ((tt) + 3 < NT) { WAIT_BAR(2); } else if ((tt) + 2 < NT) { WAIT_BAR(1); } else { WAIT_BAR(0); } } while (0)
    for (; t + 1 < NT; t += 2) {
        STEP(pB0, pB1, pA0, pA1, t, (t + 3 < NT), (t + 1 < NT), (t + 1 < NT));         ENDW(t);     ROT();
        STEP(pA0, pA1, pB0, pB1, t + 1, (t + 4 < NT), (t + 2 < NT), (t + 2 < NT));     ENDW(t + 1); ROT();
    }
    STEP(pB0, pB1, pA0, pA1, NT - 1, false, false, false);
    { float sacc = pB0[0] + pB0[1];
#pragma unroll
      for (int r = 2; r < 16; ++r) sacc += pB0[r];
#pragma unroll
      for (int r = 0; r < 16; ++r) sacc += pB1[r];
      l_reg += sacc;
      pw0 = (u32x4){PKW(pB0, 0), PKW(pB0, 2), PKW(pB0, 4), PKW(pB0, 6)}; pw1 = (u32x4){PKW(pB0, 8), PKW(pB0, 10), PKW(pB0, 12), PKW(pB0, 14)};
      pw2 = (u32x4){PKW(pB1, 0), PKW(pB1, 2), PKW(pB1, 4), PKW(pB1, 6)}; pw3 = (u32x4){PKW(pB1, 8), PKW(pB1, 10), PKW(pB1, 12), PKW(pB1, 14)};
      SBAR();
      const lds_cptr vp_ = vp0 + si_cur * VSLOT;
#pragma unroll
      for (int d0 = 0; d0 < 2; ++d0) {
          s16x4 lo4[4], hi4[4];
#pragma unroll
          for (int ks = 0; ks < 4; ++ks) { lo4[ks] = vtr(vp_ + d0 * 4096 + ks * 1024); hi4[ks] = vtr(vp_ + d0 * 4096 + ks * 1024 + 512); }
#define PK4(k) (bf16x8){lo4[k][0], lo4[k][1], lo4[k][2], lo4[k][3], hi4[k][0], hi4[k][1], hi4[k][2], hi4[k][3]}
          o[d0] = MF(PAF(0), PK4(0), o[d0]); o[d0] = MF(PAF(1), PK4(1), o[d0]); o[d0] = MF(PAF(2), PK4(2), o[d0]); o[d0] = MF(PAF(3), PK4(3), o[d0]);
#undef PK4
      } }
    l_reg = swapsum(l_reg);
    if (hi == 0) wsf[32 + r32] = l_reg;
    asm volatile("s_waitcnt lgkmcnt(0)" ::: "memory");
    float rli[16];
#pragma unroll
    for (int r = 0; r < 16; ++r) rli[r] = __builtin_amdgcn_rcpf(wsf[32 + crow(r, hi)]);
    bf16_t* Ow = O + (rowbase + q0 + wid * QBLK) * 512 + h * 64;
    { LAS bf16_t* stg = (LAS bf16_t*)(shm + LDS_OST) + wid * 2048;
#pragma unroll
      for (int r = 0; r < 16; ++r) { const int orow = crow(r, hi);
#pragma unroll
          for (int d0 = 0; d0 < 2; ++d0) stg[orow * 64 + d0 * 32 + r32] = (bf16_t)f2bf(o[d0][r] * rli[r]); }
      asm volatile("s_waitcnt lgkmcnt(0)" ::: "memory");
#pragma unroll
      for (int i = 0; i < 4; ++i) { const int row = i * 8 + (lane >> 3), ch = lane & 7; const u32x4 v = *(const LAS u32x4*)(stg + row * 64 + ch * 8); *(u32x4*)(Ow + (long)row * 512 + ch * 8) = v; } }
    asm volatile("s_waitcnt lgkmcnt(0)\n\ts_barrier" ::: "memory");
#undef DMA_K
#undef DMA_V
#undef ROT
#undef PKW
#undef PAF
#undef VFR
#undef PIN
#undef MF
#undef GAPA
#undef GAPA8
#undef GAPM
#undef GAPB
#undef EX
#undef VRD
#undef KRD
#undef STEP
#undef ENDW
}
#undef SBAR
#undef WAIT_BAR
#undef MF8
}

template <bool F8, class CM> __device__ __forceinline__ void tr_item(const float* W, int ld, const float* rs, bf16_t* WT, int K, int k0, int n0, const CM& cm, LAS float* scr, int lane) {
    const int n = lane & 31, sc = cm.col(n0 + n); const float cs = cm.scale(n0 + n);
#pragma unroll 8
    for (int i = 0; i < 32; ++i) { const int kk = 2 * i + (lane >> 5); float v = 0.f; if (sc >= 0) v = W[(size_t)(k0 + kk) * ld + sc] * cs * (rs ? rs[k0 + kk] : 1.f); scr[kk * 33 + n] = v; }
    asm volatile("s_waitcnt lgkmcnt(0)" ::: "memory");
    const int c = lane & 7;
#pragma unroll
    for (int j = 0; j < 4; ++j) { const int nn = (lane >> 3) + 8 * j; const LAS float* s = scr + (8 * c) * 33 + nn;
        if constexpr (F8) { *(u32x2*)((unsigned char*)WT + (size_t)(n0 + nn) * K + k0 + 8 * c) = (u32x2){pack4_fp8(s[0 * 33], s[1 * 33], s[2 * 33], s[3 * 33]), pack4_fp8(s[4 * 33], s[5 * 33], s[6 * 33], s[7 * 33])}; }
        else { u32x4 o; o.x = pk2(s[0 * 33], s[1 * 33]); o.y = pk2(s[2 * 33], s[3 * 33]); o.z = pk2(s[4 * 33], s[5 * 33]); o.w = pk2(s[6 * 33], s[7 * 33]);
        *(u32x4*)(WT + (size_t)(n0 + nn) * K + k0 + 8 * c) = o; } }
    asm volatile("s_waitcnt lgkmcnt(0)" ::: "memory");
}
template <class CM> __device__ __forceinline__ void tr4_load(f32x4 (&v)[8], const float* W, int ld, int k0, int n0, const CM& cm, int lane) {
    const int n4 = (lane & 7) * 4, sc = cm.col(n0 + n4);
#pragma unroll
    for (int i = 0; i < 8; ++i) { const int kk = (lane >> 3) + 8 * i; v[i] = (sc >= 0) ? *(const f32x4*)(W + (size_t)(k0 + kk) * ld + sc) : (f32x4){0.f, 0.f, 0.f, 0.f}; }
}
template <bool F8, class CM> __device__ __forceinline__ void tr4_finish(const f32x4 (&v)[8], const float* rs, bf16_t* WT, int K, int k0, int n0, const CM& cm, LAS float* scr, int lane) {
    const int n4 = (lane & 7) * 4; const float cs = cm.scale(n0 + n4);
#pragma unroll
    for (int i = 0; i < 8; ++i) { const int kk = (lane >> 3) + 8 * i; const float r = cs * (rs ? rs[k0 + kk] : 1.f); LAS float* d = scr + kk * 33 + n4; d[0] = v[i].x * r; d[1] = v[i].y * r; d[2] = v[i].z * r; d[3] = v[i].w * r; }
    asm volatile("s_waitcnt lgkmcnt(0)" ::: "memory");
    const int c = lane & 7;
#pragma unroll
    for (int j = 0; j < 4; ++j) { const int nn = (lane >> 3) + 8 * j; const LAS float* s = scr + (8 * c) * 33 + nn;
        if constexpr (F8) { *(u32x2*)((unsigned char*)WT + (size_t)(n0 + nn) * K + k0 + 8 * c) = (u32x2){pack4_fp8(s[0 * 33], s[1 * 33], s[2 * 33], s[3 * 33]), pack4_fp8(s[4 * 33], s[5 * 33], s[6 * 33], s[7 * 33])}; }
        else { u32x4 o; o.x = pk2(s[0 * 33], s[1 * 33]); o.y = pk2(s[2 * 33], s[3 * 33]); o.z = pk2(s[4 * 33], s[5 * 33]); o.w = pk2(s[6 * 33], s[7 * 33]);
        *(u32x4*)(WT + (size_t)(n0 + nn) * K + k0 + 8 * c) = o; } }
    asm volatile("s_waitcnt lgkmcnt(0)" ::: "memory");
}
template <bool F8, class CM> __device__ __forceinline__ void tr_item4(const float* W, int ld, const float* rs, bf16_t* WT, int K, int k0, int n0, const CM& cm, LAS float* scr, int lane) {
    f32x4 v[8]; tr4_load(v, W, ld, k0, n0, cm, lane); tr4_finish<F8>(v, rs, WT, K, k0, n0, cm, scr, lane);
}
struct CmIn {
    __device__ __forceinline__ int col(int n) const {
        if (n < 1920) return n;
        if (n < 1952) { const int j = n - 1920, i = j >> 1; return 1920 + ((j & 1) ? i + 16 : i); }
        if (n < 2048) return -1;
        if (n < 3072) return 1952 + (n - 2048);
        return 2976 + (n - 3072);
    }
    __device__ __forceinline__ float scale(int n) const { return n < 512 ? 0.125f * LOG2E : 1.f; }
    __device__ __forceinline__ bool regular(int n0) const { return n0 < 1920 || n0 >= 1952; }
};
struct CmUq {
    __device__ __forceinline__ int col(int n) const { const int h = n / 96, w = n % 96; if (w < 64) return n; const int j = w - 64, i = j >> 1; return h * 96 + 64 + ((j & 1) ? i + 16 : i); }
    __device__ __forceinline__ float scale(int) const { return 0.10206207261596577f * LOG2E; }
    __device__ __forceinline__ bool regular(int n0) const { return (n0 % 96) < 64; }
};
struct CmId64 { __device__ __forceinline__ int col(int n) const { return n; } __device__ __forceinline__ float scale(int) const { return 64.f; } __device__ __forceinline__ bool regular(int) const { return true; } };
struct CmId { int off; __device__ __forceinline__ int col(int n) const { return n - off; } __device__ __forceinline__ float scale(int) const { return 1.f; } __device__ __forceinline__ bool regular(int) const { return true; } };
struct CmGu {
    __device__ __forceinline__ int col(int n) const { const int pn = n >> 8, w = n & 255; return w < 128 ? 128 * pn + w : 1024 + 128 * pn + (w - 128); }
    __device__ __forceinline__ float scale(int) const { return 64.f; }
    __device__ __forceinline__ bool regular(int) const { return true; }
};
template <class CM, bool F8 = false> __device__ __forceinline__ void tr_any(const float* W, int ld, const float* rs, bf16_t* WT, int K, int k0, int n0, const CM& cm, LAS float* scr, int lane) {
    if (cm.regular(n0)) tr_item4<F8>(W, ld, rs, WT, K, k0, n0, cm, scr, lane); else tr_item<F8>(W, ld, rs, WT, K, k0, n0, cm, scr, lane);
}

struct Args { const float* in[19]; float* out; unsigned char* ws; int ph_lo, ph_hi, li, pad; };

__device__ __forceinline__ void p0_prologue(const Args& a, LAS unsigned char* lds, int wave, int lane) {
    LAS float* scr = (LAS float*)(lds + wave * 16384);
    const int gw = blockIdx.x * NWAVES + wave, NGW = gridDim.x * NWAVES;
    unsigned char* ws = a.ws;
    constexpr int I_IN = 16 * 128, I_UQ = 4 * 24, I_UK = 2 * 16, I_UV = 2 * 16, I_A = 8 * 32, I_B = 8 * 32, I_O = 16 * 32, I_GU = 32 * 16 * 64, I_D = 32 * 16 * 32;
    constexpr int NITEMS = I_IN + I_UQ + I_UK + I_UV + I_A + I_B + I_O;
    for (int it = gw; it < NITEMS; it += NGW) {
        int r = it;
        if (r < I_IN) { tr_any(a.in[2], 4000, a.in[1], (bf16_t*)(ws + WS_WIN), 1024, 64 * (r / 128), 32 * (r % 128), CmIn{}, scr, lane); continue; } r -= I_IN;
        if (r < I_UQ) { tr_any(a.in[5], 768, a.in[3], (bf16_t*)(ws + WS_WUQ), 256, 64 * (r / 24), 32 * (r % 24), CmUq{}, scr, lane); continue; } r -= I_UQ;
        if (r < I_UK) { tr_any(a.in[6], 512, a.in[4], (bf16_t*)(ws + WS_WUKV), 128, 64 * (r / 16), 32 * (r % 16), CmId{0}, scr, lane); continue; } r -= I_UK;
        if (r < I_UV) { tr_any(a.in[7], 512, a.in[4], (bf16_t*)(ws + WS_WUKV), 128, 64 * (r / 16), 512 + 32 * (r % 16), CmId{512}, scr, lane); continue; } r -= I_UV;
        if (r < I_A) { tr_any(a.in[8], 1024, nullptr, (bf16_t*)(ws + WS_WA), 512, 64 * (r / 32), 32 * (r % 32), CmId{0}, scr, lane); continue; } r -= I_A;
        if (r < I_B) { tr_any(a.in[9], 1024, nullptr, (bf16_t*)(ws + WS_WB), 512, 64 * (r / 32), 32 * (r % 32), CmId{0}, scr, lane); continue; } r -= I_B;
        tr_any(a.in[10], 1024, nullptr, (bf16_t*)(ws + WS_WO), 1024, 64 * (r / 32), 32 * (r % 32), CmId{0}, scr, lane);
    }
    {   f32x4 va[8], vb[8];
#define GU_LOAD(v, r) tr4_load(v, a.in[14] + (size_t)((r) / 1024) * 1024 * 2048, 2048, 64 * (((r) % 1024) / 64), 32 * ((r) % 64), CmGu{}, lane)
#define GU_FIN(v, r) tr4_finish<true>(v, a.in[11], (bf16_t*)(ws + WS_WGU + (size_t)((r) / 1024) * 2048 * 1024), 1024, 64 * (((r) % 1024) / 64), 32 * ((r) % 64), CmGu{}, scr, lane)
        int r = gw; if (r < I_GU) GU_LOAD(va, r);
        for (; r < I_GU; r += 2 * NGW) {
            if (r + NGW < I_GU) GU_LOAD(vb, r + NGW);
            GU_FIN(va, r);
            if (r + NGW < I_GU) { if (r + 2 * NGW < I_GU) GU_LOAD(va, r + 2 * NGW); GU_FIN(vb, r + NGW); }
        }
#undef GU_LOAD
#undef GU_FIN
#define D_LOAD(v, r) tr4_load(v, a.in[16] + (size_t)((r) / 512) * 1024 * 1024, 1024, 64 * (((r) % 512) / 32), 32 * ((r) % 32), CmId64{}, lane)
#define D_FIN(v, r) tr4_finish<true>(v, nullptr, (bf16_t*)(ws + WS_WD + (size_t)((r) / 512) * 1024 * 1024), 1024, 64 * (((r) % 512) / 32), 32 * ((r) % 32), CmId64{}, scr, lane)
        r = gw; if (r < I_D) D_LOAD(va, r);
        for (; r < I_D; r += 2 * NGW) {
            if (r + NGW < I_D) D_LOAD(vb, r + NGW);
            D_FIN(va, r);
            if (r + NGW < I_D) { if (r + 2 * NGW < I_D) D_LOAD(va, r + 2 * NGW); D_FIN(vb, r + NGW); }
        }
#undef D_LOAD
#undef D_FIN
    }
    for (int m = gw; m < T; m += NGW) {
        const f32x4* xr = (const f32x4*)(a.in[0] + (size_t)m * DM) + lane;
        f32x4 v[4]; float s2 = 0.f;
#pragma unroll
        for (int j = 0; j < 4; ++j) { v[j] = xr[64 * j]; s2 += (v[j].x * v[j].x + v[j].y * v[j].y) + (v[j].z * v[j].z + v[j].w * v[j].w); }
        const float rstd = 1.f / sqrtf(wave_sum(s2) * (1.f / DM) + EPS);
        u32x2* o8 = (u32x2*)((bf16_t*)(ws + WS_XB) + (size_t)m * DM) + lane;
#pragma unroll
        for (int j = 0; j < 4; ++j) o8[64 * j] = (u32x2){pk2(v[j].x * rstd, v[j].y * rstd), pk2(v[j].z * rstd, v[j].w * rstd)};
    }
    const int gt = blockIdx.x * NTHREADS + threadIdx.x, NGT = gridDim.x * NTHREADS;
    for (int idx = gt; idx < SEQ * 16; idx += NGT) {
        ((f32x2*)(ws + WS_ROPE))[idx] = rope_cs(idx >> 4, idx & 15);
    }
    for (int idx = gt; idx < 1024 * 32; idx += NGT) ((float*)(ws + WS_WRP))[idx] = a.in[12][idx] * a.in[11][idx >> 5];
}

__device__ __forceinline__ void p2_stats(const Args& a, int wave, int lane) {
    const int gw = blockIdx.x * NWAVES + wave, NGW = gridDim.x * NWAVES; unsigned char* ws = a.ws;
    for (int m = gw; m < T; m += NGW) {
        const u32x2 q = ((const u32x2*)((const bf16_t*)(ws + WS_CQ) + (size_t)m * 256))[lane];
        const unsigned kv = ((const unsigned*)((const bf16_t*)(ws + WS_CKV) + (size_t)m * 128))[lane];
        const float a0 = bflo(q.x), a1 = bfhi(q.x), a2 = bflo(q.y), a3 = bfhi(q.y), b0 = bflo(kv), b1 = bfhi(kv);
        const float sq = wave_sum((a0 * a0 + a1 * a1) + (a2 * a2 + a3 * a3)), sk = wave_sum(b0 * b0 + b1 * b1);
        if (lane == 0) { ((float*)(ws + WS_RSTDQ))[m] = 1.f / sqrtf(sq * (1.f / 256.f) + EPS); ((float*)(ws + WS_RSTDKV))[m] = 1.f / sqrtf(sk * (1.f / 128.f) + EPS); }
        if (lane < 32) { const int b = m >> 14, sq2 = m & (SEQ - 1); const u32x4 kr = *(const u32x4*)((const bf16_t*)(ws + WS_KR) + (size_t)m * 32 + 8 * (lane & 3));
            *(u32x4*)((bf16_t*)(ws + WS_KIMG) + (size_t)((b * 8 + (lane >> 2)) * 256 + (sq2 >> 6)) * 6144 + (8 + (lane & 3)) * 512 + (sq2 & 63) * 8) = kr; }
        if (lane < 16) { const int b = m >> 14, sq2 = m & (SEQ - 1); const bf16_t* kp = (const bf16_t*)(ws + WS_KR) + (size_t)m * 32 + 16 * (lane & 1);
            float k0[8], k1[8]; unpack8(*(const u32x4*)kp, k0); unpack8(*(const u32x4*)(kp + 8), k1);
            *(u32x4*)(ws + WS_K8 + (size_t)((b * 8 + (lane >> 1)) * 256 + (sq2 >> 6)) * 6144 + (4 + (lane & 1)) * 1024 + (sq2 & 63) * 16) =
                (u32x4){pack4_fp8(k0[0], k0[1], k0[2], k0[3]), pack4_fp8(k0[4], k0[5], k0[6], k0[7]), pack4_fp8(k1[0], k1[1], k1[2], k1[3]), pack4_fp8(k1[4], k1[5], k1[6], k1[7])}; }
    }
}

__device__ __forceinline__ void p4_dilated(const Args& a, LAS unsigned char* lds, volatile LAS unsigned* MISC, int wave, int lane) {
    unsigned char* ws = a.ws;
    const int r32 = lane & 31, hi = lane >> 5;
    {
        LAS unsigned* nm = (LAS unsigned*)(MISC + MI_NRM);
        if (threadIdx.x < 32) nm[threadIdx.x] = 0u;
        __syncthreads();
        const bf16_t* QB = (const bf16_t*)(ws + WS_QB); const bf16_t* KIM = (const bf16_t*)(ws + WS_KIMG); const bf16_t* KR = (const bf16_t*)(ws + WS_KR);
        const int gw = blockIdx.x * NWAVES + wave, NGW = gridDim.x * NWAVES;
        for (int t = gw; t < T; t += NGW) {
            const int b = t >> 14;
            const u32x2* qp = (const u32x2*)(QB + (size_t)t * 768 + 12 * lane);
            const u32x2 q0 = qp[0], q1 = qp[1], q2 = qp[2];
            float sq = (bflo(q0.x) * bflo(q0.x) + bfhi(q0.x) * bfhi(q0.x)) + (bflo(q0.y) * bflo(q0.y) + bfhi(q0.y) * bfhi(q0.y));
            sq += (bflo(q1.x) * bflo(q1.x) + bfhi(q1.x) * bfhi(q1.x)) + (bflo(q1.y) * bflo(q1.y) + bfhi(q1.y) * bfhi(q1.y));
            sq += (bflo(q2.x) * bflo(q2.x) + bfhi(q2.x) * bfhi(q2.x)) + (bflo(q2.y) * bflo(q2.y) + bfhi(q2.y) * bfhi(q2.y));
            float kk8[8]; unpack8(*(const u32x4*)(KIM + (size_t)((b * 8 + (lane >> 3)) * 256 + ((t & (SEQ - 1)) >> 6)) * 6144 + (lane & 7) * 512 + (t & 63) * 8), kk8);
            float sk = 0.f;
#pragma unroll
            for (int j = 0; j < 8; ++j) sk += kk8[j] * kk8[j];
            float kr8[8]; unpack8(*(const u32x4*)(KR + (size_t)t * 32 + 8 * (lane & 3)), kr8);
            float sr = 0.f;
#pragma unroll
            for (int j = 0; j < 8; ++j) sr += kr8[j] * kr8[j];
            sr += __shfl_xor(sr, 1); sr += __shfl_xor(sr, 2);
            sq += __shfl_xor(sq, 1); sq += __shfl_xor(sq, 2); sq += __shfl_xor(sq, 4);
            sk += __shfl_xor(sk, 1); sk += __shfl_xor(sk, 2); sk += __shfl_xor(sk, 4);
            sk += sr;
            if ((lane & 7) == 0) { const int hh = lane >> 3;
                __hip_atomic_fetch_max(&nm[b * 8 + hh], __float_as_uint(sq), __ATOMIC_RELAXED, __HIP_MEMORY_SCOPE_WORKGROUP);
                __hip_atomic_fetch_max(&nm[16 + b * 8 + hh], __float_as_uint(sk), __ATOMIC_RELAXED, __HIP_MEMORY_SCOPE_WORKGROUP); }
        }
        __syncthreads();
        if (threadIdx.x < 32) __hip_atomic_fetch_max((unsigned*)(ws + WS_CTL) + CW_NRM + threadIdx.x, nm[threadIdx.x], __ATOMIC_RELAXED, __HIP_MEMORY_SCOPE_AGENT);
    }
    __syncthreads();
    const bf16_t* QA = (const bf16_t*)(ws + WS_QA); const bf16_t* KA = (const bf16_t*)(ws + WS_KA); const bf16_t* VA = (const bf16_t*)(ws + WS_VA);
    bf16_t* PO = (bf16_t*)(ws + WS_PARTO); float* PL = (float*)(ws + WS_PARTL);
    constexpr int DK = 0, DV = 49152, DWS = 98304;
    const unsigned lds0 = (unsigned)(uintptr_t)lds;
    LAS float* wsf = (LAS float*)(lds + DWS) + wave * 64;
    for (int un = blockIdx.x; un < NB * 8 * 192; un += gridDim.x) {
        const int bh = un / 192, within = un % 192, b = bh >> 3, h = bh & 7;
        int p, dil, res, blk, L;
        if (within < 64) { p = 0; dil = 1; res = 0; blk = within; L = SEQ; }
        else if (within < 128) { p = 1; dil = 4; res = (within - 64) >> 4; blk = (within - 64) & 15; L = SEQ / 4; }
        else { p = 2; dil = 16; res = (within - 128) >> 2; blk = (within - 128) & 3; L = SEQ / 16; }
        const size_t bo = (size_t)b * SEQ; const int u0w = 256 * blk - 64;
#pragma unroll
        for (int j = 0; j < 6; ++j) {
            int uk = u0w + 64 * j + lane; uk = uk < 0 ? 0 : (uk >= L ? L - 1 : uk);
            mla::glds16(KA + (bo + (size_t)(res + dil * uk)) * 512 + h * 64 + wave * 8, (unsigned)__builtin_amdgcn_readfirstlane(lds0 + DK + j * 8192 + wave * 1024));
            int uv = u0w + 64 * j + 16 * (wave & 3) + (lane >> 2); uv = uv < 0 ? 0 : (uv >= L ? L - 1 : uv);
            mla::glds16(VA + (bo + (size_t)(res + dil * uv)) * 512 + h * 64 + (wave >> 2) * 32 + (lane & 3) * 8, (unsigned)__builtin_amdgcn_readfirstlane(lds0 + DV + j * 8192 + wave * 1024));
        }
        const int ur = 256 * blk + 32 * wave;
        const size_t tq = bo + (size_t)(res + dil * (ur + r32));
        bf16x8 qf[4];
#pragma unroll
        for (int d0 = 0; d0 < 4; ++d0) qf[d0] = *(const bf16x8*)(QA + tq * 512 + h * 64 + 16 * d0 + 8 * hi);
        const float slope2d = __builtin_amdgcn_exp2f(-(float)(h + 1)) * LOG2E * (float)dil;
        asm volatile("s_waitcnt vmcnt(0)\n\ts_barrier" ::: "memory");
        f32x16 o0 = {}, o1 = {}; float m_run = -1e30f, l_run = 0.f;
#pragma unroll 1
        for (int ci = 0; ci < 5; ++ci) {
            const int c = ci == 0 ? 2 : ci == 1 ? 1 : ci == 2 ? 3 : ci == 3 ? 0 : 4;
            const int cw = wave + c, j = cw >> 1, n = cw & 1;
            const LAS char* kp = (const LAS char*)lds + DK + j * 8192 + hi * 1024 + (32 * n + r32) * 16;
            f32x16 s = {};
#pragma unroll
            for (int d0 = 0; d0 < 4; ++d0) s = __builtin_amdgcn_mfma_f32_32x32x16_bf16(*(const LAS bf16x8*)(kp + d0 * 2048), qf[d0], s, 0, 0, 0);
            { const float c0 = (float)(32 * c - 64); const int vb = ur - 64 + 32 * c;
#pragma unroll
              for (int r = 0; r < 16; ++r) { const float d = (float)(crow(r, hi) - r32); s[r] = s[r] - slope2d * fabsf(d + c0); }
              if (c == 0) {
#pragma unroll
                  for (int r = 0; r < 16; ++r) s[r] = (crow(r, hi) >= r32) ? s[r] : -1e30f; }
              if (c == 4) {
#pragma unroll
                  for (int r = 0; r < 16; ++r) s[r] = (crow(r, hi) <= r32) ? s[r] : -1e30f; }
              if (vb < 0 || vb + 31 >= L) {
#pragma unroll
                  for (int r = 0; r < 16; ++r) { const int v = vb + crow(r, hi); s[r] = (v >= 0 && v < L) ? s[r] : -1e30f; } } }
            float mx = s[0];
#pragma unroll
            for (int r = 1; r < 16; ++r) mx = fmaxf(mx, s[r]);
            mx = swapmax(mx);
            const float mn = fmaxf(m_run, mx), alpha = fexp2(m_run - mn);
            float ps = 0.f;
#pragma unroll
            for (int r = 0; r < 16; ++r) { s[r] = fexp2(s[r] - mn); ps += s[r]; }
            l_run = l_run * alpha + ps; m_run = mn;
            if (__any(alpha != 1.f)) {
                if (hi == 0) wsf[r32] = alpha;
#pragma unroll
                for (int r = 0; r < 16; ++r) { const float al = wsf[crow(r, hi)]; o0[r] *= al; o1[r] *= al; }
            }
            const u32x4 pw0 = {cvtpk(s[0], s[1]), cvtpk(s[2], s[3]), cvtpk(s[4], s[5]), cvtpk(s[6], s[7])};
            const u32x4 pw1 = {cvtpk(s[8], s[9]), cvtpk(s[10], s[11]), cvtpk(s[12], s[13]), cvtpk(s[14], s[15])};
            const bf16x8 pa0 = __builtin_bit_cast(bf16x8, pw0), pa1 = __builtin_bit_cast(bf16x8, pw1);
            const LAS char* vp = (const LAS char*)lds + DV + j * 8192 + n * 2048 + ((lane >> 4) & 1) * 32 + (lane & 3) * 8 + (4 * hi + ((lane & 15) >> 2)) * 64;
#pragma unroll
            for (int ks = 0; ks < 2; ++ks) {
                const s16x4 l0 = vtr(vp + ks * 1024), h0 = vtr(vp + ks * 1024 + 512), l1 = vtr(vp + 4096 + ks * 1024), h1 = vtr(vp + 4096 + ks * 1024 + 512);
                const bf16x8 v0 = {l0[0], l0[1], l0[2], l0[3], h0[0], h0[1], h0[2], h0[3]}, v1 = {l1[0], l1[1], l1[2], l1[3], h1[0], h1[1], h1[2], h1[3]};
                o0 = __builtin_amdgcn_mfma_f32_32x32x16_bf16(ks == 0 ? pa0 : pa1, v0, o0, 0, 0, 0);
                o1 = __builtin_amdgcn_mfma_f32_32x32x16_bf16(ks == 0 ? pa0 : pa1, v1, o1, 0, 0, 0);
            }
        }
        const float lt = swapsum(l_run);
        if (hi == 0) { wsf[32 + r32] = lt; PL[(((size_t)p * NB + b) * 8 + h) * SEQ + (res + dil * (ur + r32))] = m_run + __builtin_amdgcn_logf(lt); }
        asm volatile("s_waitcnt lgkmcnt(0)\n\ts_barrier" ::: "memory");
        { LAS bf16_t* stg = (LAS bf16_t*)(lds + DK) + wave * 2048;
#pragma unroll
          for (int r = 0; r < 16; ++r) { const int q = crow(r, hi); const float il = frcp(wsf[32 + q]);
              stg[q * 64 + r32] = (bf16_t)f2bf(o0[r] * il); stg[q * 64 + 32 + r32] = (bf16_t)f2bf(o1[r] * il); }
#pragma unroll
          for (int i = 0; i < 4; ++i) { const int row = i * 8 + (lane >> 3), ch = lane & 7; const u32x4 v = *(const LAS u32x4*)(stg + row * 64 + ch * 8);
              *(u32x4*)(PO + ((size_t)p * T + bo + (size_t)(res + dil * (ur + row))) * 512 + h * 64 + ch * 8) = v; } }
        asm volatile("s_waitcnt lgkmcnt(0)\n\ts_barrier" ::: "memory");
    }
}
__device__ __forceinline__ void p5_combine(const Args& a, int wave, int lane) {
    unsigned char* ws = a.ws; const bf16_t* PO = (const bf16_t*)(ws + WS_PARTO); const float* PL = (const float*)(ws + WS_PARTL); bf16_t* OA = (bf16_t*)(ws + WS_OA);
    const int gw = blockIdx.x * NWAVES + wave, NGW = gridDim.x * NWAVES;
    for (int it = gw; it < T; it += NGW) {
        const int t = it, b = t >> 14, s = t & (SEQ - 1), h = lane >> 3, ch = lane & 7;
        const float l0 = PL[(((size_t)0 * NB + b) * 8 + h) * SEQ + s], l1 = PL[(((size_t)1 * NB + b) * 8 + h) * SEQ + s], l2 = PL[(((size_t)2 * NB + b) * 8 + h) * SEQ + s];
        const float mx = fmaxf(fmaxf(l0, l1), l2); float w0 = fexp2(l0 - mx), w1 = fexp2(l1 - mx), w2 = fexp2(l2 - mx); const float iw = frcp(w0 + w1 + w2); w0 *= iw; w1 *= iw; w2 *= iw;
        float v0[8], v1[8], v2[8], o[8];
        unpack8(*(const u32x4*)(PO + ((size_t)0 * T + t) * 512 + h * 64 + ch * 8), v0);
        unpack8(*(const u32x4*)(PO + ((size_t)1 * T + t) * 512 + h * 64 + ch * 8), v1);
        unpack8(*(const u32x4*)(PO + ((size_t)2 * T + t) * 512 + h * 64 + ch * 8), v2);
#pragma unroll
        for (int j = 0; j < 8; ++j) o[j] = w0 * v0[j] + w1 * v1[j] + w2 * v2[j];
        *(u32x4*)(OA + (size_t)t * 512 + h * 64 + ch * 8) = pack8(o);
    }
}
__device__ __forceinline__ void p5_mla(const Args& a, LAS unsigned char* lds, int wave, int lane) {
    unsigned char* ws = a.ws;
    LAS char* vimg = (LAS char*)(lds + wave * 8192); LAS float* wsf = (LAS float*)(lds + wave * 8192 + 4096);
    const int r32 = lane & 31, hi = lane >> 5;
    const bf16_t* QB = (const bf16_t*)(ws + WS_QB); const bf16_t* KIM = (const bf16_t*)(ws + WS_KIMG); const bf16_t* VIM = (const bf16_t*)(ws + WS_VIMG);
    bf16_t* OB = (bf16_t*)(ws + WS_OB);
    const unsigned* nrm = (const unsigned*)(ws + WS_CTL) + CW_NRM;
    for (int un = blockIdx.x; un < NB * 8 * 64; un += gridDim.x) {
        const int qb = un & 63, h = (un >> 6) & 7, b = un >> 9;
        const float mq = __uint_as_float(__hip_atomic_load(nrm + b * 8 + h, __ATOMIC_RELAXED, __HIP_MEMORY_SCOPE_AGENT)), mk = __uint_as_float(__hip_atomic_load(nrm + 16 + b * 8 + h, __ATOMIC_RELAXED, __HIP_MEMORY_SCOPE_AGENT));
        bool fast = (mq * mk < 3600.f) && (mq < 700.f) && (mk < 160000.f);
#ifdef MLA_FORCE_GENERAL
        fast = false;
#endif
#ifdef MLA_BF16_FAST
        if (__builtin_amdgcn_readfirstlane((int)fast)) mla::mla_unit(b, h, qb, QB, KIM + (size_t)(b * 8 + h) * 256 * 6144, VIM + (size_t)(b * 8 + h) * 256 * 4096, OB, (LAS char*)lds);
#else
        if (__builtin_amdgcn_readfirstlane((int)fast)) mla8::mla8_unit(b, h, qb, (const unsigned char*)(ws + WS_Q8), (const unsigned char*)(ws + WS_K8) + (size_t)(b * 8 + h) * 256 * 6144, VIM + (size_t)(b * 8 + h) * 256 * 4096, OB, (LAS char*)lds);
#endif
    }
    for (int un = blockIdx.x; un < NB * 8 * 64; un += gridDim.x) {
        const int qb = un & 63, h = (un >> 6) & 7, b = un >> 9;
        const float mq = __uint_as_float(__hip_atomic_load(nrm + b * 8 + h, __ATOMIC_RELAXED, __HIP_MEMORY_SCOPE_AGENT)), mk = __uint_as_float(__hip_atomic_load(nrm + 16 + b * 8 + h, __ATOMIC_RELAXED, __HIP_MEMORY_SCOPE_AGENT));
        bool fast = (mq * mk < 3600.f) && (mq < 700.f) && (mk < 160000.f);
#ifdef MLA_FORCE_GENERAL
        fast = false;
#endif
        if (!__builtin_amdgcn_readfirstlane((int)fast)) {
            const size_t bo = (size_t)b * SEQ, tq0 = bo + (size_t)qb * 256 + wave * 32;
            MlaKL kl; kl.K = KIM + (size_t)(b * 8 + h) * 256 * 6144; kl.V = VIM + (size_t)(b * 8 + h) * 256 * 4096;
            bf16x8 qf[6];
#pragma unroll
            for (int d0 = 0; d0 < 6; ++d0) qf[d0] = *(const bf16x8*)(QB + (tq0 + r32) * 768 + h * 96 + 16 * d0 + 8 * hi);
            AttnState st; wave_attn<6>(st, qf, kl, SEQ / 32, vimg, wsf, lane);
            (void)attn_finish(st, vimg, wsf, lane);
#pragma unroll
            for (int i = 0; i < 4; ++i) { const int row = i * 8 + (lane >> 3), ch = lane & 7; const u32x4 v = *(const LAS u32x4*)(vimg + row * 128 + ch * 16);
                *(u32x4*)(OB + (tq0 + row) * 512 + h * 64 + ch * 8) = v; }
        }
    }
}

__device__ __forceinline__ void p8_router(const Args& a, LAS unsigned char* lds, volatile LAS unsigned* MISC, int wave, int lane) {
    unsigned char* ws = a.ws; const float* x1 = a.out; const float* wrp = (const float*)(ws + WS_WRP); const float* br = a.in[13];
    LAS float* lg = (LAS float*)(lds + wave * 8192);
    LAS unsigned* hist = (LAS unsigned*)(MISC + MI_HIST);
    if (threadIdx.x < 32) hist[threadIdx.x] = 0u;
    __syncthreads();
    const int G = gridDim.x, i32 = lane & 31, hi = lane >> 5;
    for (int tb = wave * G + blockIdx.x; tb < T / 32; tb += G * NWAVES) {
        const int t = tb * 32 + i32;
        const float* xr = x1 + (size_t)t * DM + 512 * hi; const float* wr_ = wrp + (size_t)(512 * hi) * 32 + i32;
        f32x16 acc = {}; float ssq = 0.f;
#pragma unroll 4
        for (int s4 = 0; s4 < 128; ++s4) {
            const f32x4 xa = *(const f32x4*)(xr + 4 * s4);
            ssq += (xa.x * xa.x + xa.y * xa.y) + (xa.z * xa.z + xa.w * xa.w);
            acc = __builtin_amdgcn_mfma_f32_32x32x2f32(xa.x, wr_[(4 * s4 + 0) * 32], acc, 0, 0, 0);
            acc = __builtin_amdgcn_mfma_f32_32x32x2f32(xa.y, wr_[(4 * s4 + 1) * 32], acc, 0, 0, 0);
            acc = __builtin_amdgcn_mfma_f32_32x32x2f32(xa.z, wr_[(4 * s4 + 2) * 32], acc, 0, 0, 0);
            acc = __builtin_amdgcn_mfma_f32_32x32x2f32(xa.w, wr_[(4 * s4 + 3) * 32], acc, 0, 0, 0);
        }
        ssq = swapsum(ssq);
        const float rstd = 1.f / sqrtf(ssq * (1.f / DM) + EPS);
#pragma unroll
        for (int r = 0; r < 16; ++r) lg[crow(r, hi) * 33 + i32] = acc[r];
        asm volatile("s_waitcnt lgkmcnt(0)" ::: "memory");
        float v[32];
#pragma unroll
        for (int e = 0; e < 32; ++e) v[e] = lg[i32 * 33 + e] * rstd + br[e];
        int ti[4]; float tv[4];
#pragma unroll
        for (int k = 0; k < 4; ++k) {
            float best = v[0]; int bi = 0;
#pragma unroll
            for (int e = 1; e < 32; ++e) { const bool g = v[e] > best; best = g ? v[e] : best; bi = g ? e : bi; }
            ti[k] = bi; tv[k] = best;
#pragma unroll
            for (int e = 0; e < 32; ++e) v[e] = (e == bi) ? -3.0e38f : v[e];
        }
        const float e1 = __expf(tv[1] - tv[0]), e2 = __expf(tv[2] - tv[0]), e3 = __expf(tv[3] - tv[0]); const float inv = 1.f / (1.f + e1 + e2 + e3);
        const float gw[4] = {inv, e1 * inv, e2 * inv, e3 * inv};
        if (hi == 0) {
            ((float*)(ws + WS_RSTD2))[t] = rstd;
#pragma unroll
            for (int k = 0; k < 4; ++k) { const unsigned rk = __hip_atomic_fetch_add(&hist[ti[k]], 1u, __ATOMIC_RELAXED, __HIP_MEMORY_SCOPE_WORKGROUP);
                ((int*)(ws + WS_TOPI))[t * 4 + k] = ti[k]; ((float*)(ws + WS_GATEW))[t * 4 + k] = gw[k]; ((int*)(ws + WS_SRANK))[t * 4 + k] = (int)rk; }
        }
        asm volatile("s_waitcnt lgkmcnt(0)" ::: "memory");
    }
    __syncthreads();
    if (threadIdx.x < 32) {
        const unsigned c = hist[threadIdx.x];
        const unsigned base = __hip_atomic_fetch_add((unsigned*)(ws + WS_CTL) + CW_GCOUNT + threadIdx.x, c, __ATOMIC_RELAXED, __HIP_MEMORY_SCOPE_AGENT);
        ((int*)(ws + WS_WGBASE))[blockIdx.x * 32 + threadIdx.x] = (int)base;
    }
}
__device__ __forceinline__ void moe_prefix(const Args& a, volatile LAS unsigned* MISC) {
    if (threadIdx.x < 64) {
        const unsigned* gc = (const unsigned*)(a.ws + WS_CTL) + CW_GCOUNT; const int e = threadIdx.x & 31;
        const int c = (int)__hip_atomic_load(gc + e, __ATOMIC_RELAXED, __HIP_MEMORY_SCOPE_AGENT), pad = (c + 255) & ~255;
        int inc = pad;
#pragma unroll
        for (int o = 1; o < 32; o <<= 1) { const int v = __shfl_up(inc, o, 32); if (e >= o) inc += v; }
        if (threadIdx.x < 32) { MISC[MI_PSTART + e] = (unsigned)(inc - pad); MISC[MI_TPRE + e] = (unsigned)((inc - pad) >> 8);
            if (e == 31) { MISC[MI_PSTART + 32] = (unsigned)inc; MISC[MI_TPRE + 32] = (unsigned)(inc >> 8); } }
    }
    __syncthreads();
}
__device__ __forceinline__ void p9_scatter(const Args& a, volatile LAS unsigned* MISC) {
    unsigned char* ws = a.ws; const int G = gridDim.x;
    moe_prefix(a, MISC);
    const int* topi = (const int*)(ws + WS_TOPI); const int* srank = (const int*)(ws + WS_SRANK); const int* wgbase = (const int*)(ws + WS_WGBASE); const float* rstd2 = (const float*)(ws + WS_RSTD2);
    int* pos = (int*)(ws + WS_POS); int* rowtok = (int*)(ws + WS_ROWTOK); float* rowscale = (float*)(ws + WS_ROWSCALE);
    for (int sl = blockIdx.x * NTHREADS + threadIdx.x; sl < NSLOT; sl += G * NTHREADS) {
        const int t = sl >> 2, e = topi[sl], wg = (t >> 5) % G;
        const int row = (int)MISC[MI_PSTART + e] + wgbase[wg * 32 + e] + srank[sl];
        pos[sl] = row; rowtok[row] = t; rowscale[row] = rstd2[t];
    }
    if (blockIdx.x < 32) {
        const int e = blockIdx.x; const int c = (int)__hip_atomic_load((const unsigned*)(ws + WS_CTL) + CW_GCOUNT + e, __ATOMIC_RELAXED, __HIP_MEMORY_SCOPE_AGENT);
        const int r0 = (int)MISC[MI_PSTART + e] + c, r1 = (int)MISC[MI_PSTART + e + 1];
        for (int r = r0 + threadIdx.x; r < r1; r += NTHREADS) { rowtok[r] = 0; rowscale[r] = 0.f; }
    }
}
__device__ __forceinline__ void p12_final(const Args& a, int wave, int lane) {
    unsigned char* ws = a.ws; const int gw = blockIdx.x * NWAVES + wave, NGW = gridDim.x * NWAVES;
    const int* pos = (const int*)(ws + WS_POS); const float* gatew = (const float*)(ws + WS_GATEW); const bf16_t* Y = (const bf16_t*)(ws + WS_Y);
    f32x4 g[4];
#pragma unroll
    for (int j = 0; j < 4; ++j) g[j] = ((const f32x4*)a.in[18])[lane + 64 * j];
    for (int t = gw; t < T; t += NGW) {
        f32x4* xr = (f32x4*)(a.out + (size_t)t * DM) + lane;
        f32x4 v[4];
#pragma unroll
        for (int j = 0; j < 4; ++j) v[j] = xr[64 * j];
#ifndef DBG_NO_MOE
#pragma unroll
        for (int k = 0; k < 4; ++k) {
            const int row = pos[t * 4 + k]; const float w = gatew[t * 4 + k];
            const u32x2* yr = (const u32x2*)(Y + (size_t)row * DM) + lane;
#pragma unroll
            for (int j = 0; j < 4; ++j) { const u32x2 y = yr[64 * j]; v[j].x += w * bflo(y.x); v[j].y += w * bfhi(y.x); v[j].z += w * bflo(y.y); v[j].w += w * bfhi(y.y); }
        }
#endif
        float s2 = 0.f;
#pragma unroll
        for (int j = 0; j < 4; ++j) s2 += (v[j].x * v[j].x + v[j].y * v[j].y) + (v[j].z * v[j].z + v[j].w * v[j].w);
        const float rstd = 1.f / sqrtf(wave_sum(s2) * (1.f / DM) + EPS);
#pragma unroll
        for (int j = 0; j < 4; ++j) xr[64 * j] = v[j] * rstd * g[j];
    }
}

#ifdef MLA_CHECK
constexpr size_t CK_BASE = 225 * MiB;
constexpr size_t CK_CKVN = CK_BASE, CK_KRR = CK_CKVN + (size_t)T * 128 * 4, CK_KN = CK_KRR + (size_t)T * 32 * 4, CK_VV = CK_KN + (size_t)T * 512 * 4, CK_QS = CK_VV + (size_t)T * 512 * 4;
constexpr int CK_NS = 16;
constexpr size_t CK_OBS = 224 * MiB;
__device__ __forceinline__ int ck_tok(int i) { const int tb[16] = {0, 1, 255, 256, 4097, 8191, 12345, 16383, 16384, 16385, 20000, 24575, 24576, 30001, 32766, 32767}; return tb[i]; }
__device__ __forceinline__ float blk_sum(float v, float* red) {
    v = wave_sum(v); __syncthreads(); if ((threadIdx.x & 63) == 0) red[threadIdx.x >> 6] = v; __syncthreads(); return red[0] + red[1] + red[2] + red[3];
}
__global__ void __launch_bounds__(256) ck_kv(const float* x, const float* g1, const float* w_in, const float* gkv, const float* w_uk, const float* w_uv, unsigned char* ws) {
    __shared__ float hn[1024]; __shared__ float red[4]; __shared__ float c[160]; __shared__ float cn[128];
    const int t = blockIdx.x, tid = threadIdx.x;
    float s2 = 0.f; for (int k = tid; k < 1024; k += 256) { const float v = x[(size_t)t * 1024 + k]; s2 += v * v; }
    const float rstd = 1.f / sqrtf(blk_sum(s2, red) / 1024.f + EPS);
    for (int k = tid; k < 1024; k += 256) hn[k] = x[(size_t)t * 1024 + k] * rstd * g1[k];
    __syncthreads();
    if (tid < 160) { float acc = 0.f; for (int k = 0; k < 1024; ++k) acc += hn[k] * w_in[(size_t)k * 4000 + 1792 + tid]; c[tid] = acc; }
    __syncthreads();
    const float q2 = blk_sum(tid < 128 ? c[tid] * c[tid] : 0.f, red); const float r2 = 1.f / sqrtf(q2 / 128.f + EPS);
    if (tid < 128) cn[tid] = c[tid] * r2 * gkv[tid];
    if (tid < 16) { const f32x2 cs = rope_cs(t & (SEQ - 1), tid); const float x1 = c[128 + tid], x2 = c[128 + 16 + tid];
        ((float*)(ws + CK_KRR))[(size_t)t * 32 + tid] = x1 * cs.x - x2 * cs.y; ((float*)(ws + CK_KRR))[(size_t)t * 32 + 16 + tid] = x2 * cs.x + x1 * cs.y; }
    __syncthreads();
    for (int o = tid; o < 512; o += 256) { float a = 0.f, b = 0.f; for (int k = 0; k < 128; ++k) { a += cn[k] * w_uk[(size_t)k * 512 + o]; b += cn[k] * w_uv[(size_t)k * 512 + o]; }
        ((float*)(ws + CK_KN))[(size_t)t * 512 + o] = a; ((float*)(ws + CK_VV))[(size_t)t * 512 + o] = b; }
}
__global__ void __launch_bounds__(256) ck_q(const float* x, const float* g1, const float* w_in, const float* gq, const float* w_uq, unsigned char* ws) {
    __shared__ float hn[1024]; __shared__ float red[4]; __shared__ float c[256]; __shared__ float qq[768];
    const int t = ck_tok(blockIdx.x), tid = threadIdx.x;
    float s2 = 0.f; for (int k = tid; k < 1024; k += 256) { const float v = x[(size_t)t * 1024 + k]; s2 += v * v; }
    const float rstd = 1.f / sqrtf(blk_sum(s2, red) / 1024.f + EPS);
    for (int k = tid; k < 1024; k += 256) hn[k] = x[(size_t)t * 1024 + k] * rstd * g1[k];
    __syncthreads();
    { float acc = 0.f; for (int k = 0; k < 1024; ++k) acc += hn[k] * w_in[(size_t)k * 4000 + 1536 + tid]; c[tid] = acc; }
    __syncthreads();
    const float q2 = blk_sum(c[tid] * c[tid], red); const float r2 = 1.f / sqrtf(q2 / 256.f + EPS);
    __syncthreads(); c[tid] = c[tid] * r2 * gq[tid]; __syncthreads();
    for (int o = tid; o < 768; o += 256) { float a = 0.f; for (int k = 0; k < 256; ++k) a += c[k] * w_uq[(size_t)k * 768 + o]; qq[o] = a; }
    __syncthreads();
    if (tid < 128) { const int hh = tid >> 4, i = tid & 15; const f32x2 cs = rope_cs(t & (SEQ - 1), i); const float x1 = qq[hh * 96 + 64 + i], x2 = qq[hh * 96 + 80 + i];
        qq[hh * 96 + 64 + i] = x1 * cs.x - x2 * cs.y; qq[hh * 96 + 80 + i] = x2 * cs.x + x1 * cs.y; }
    __syncthreads();
    for (int o = tid; o < 768; o += 256) ((float*)(ws + CK_QS))[(size_t)blockIdx.x * 768 + o] = qq[o] * 0.10206207261596577f;
}
__global__ void __launch_bounds__(256) ck_attn(unsigned char* ws, unsigned* flag) {
    __shared__ float q[96]; __shared__ float red[4]; __shared__ float part[256]; __shared__ float sc[SEQ];
    const int si = blockIdx.x >> 3, h = blockIdx.x & 7, t = ck_tok(si), b = t >> 14, tid = threadIdx.x;
    const float* KN = (const float*)(ws + CK_KN); const float* VV = (const float*)(ws + CK_VV); const float* KRR = (const float*)(ws + CK_KRR);
    if (tid < 96) q[tid] = ((const float*)(ws + CK_QS))[(size_t)si * 768 + h * 96 + tid];
    __syncthreads();
    float mx = -1e30f;
    for (int s = tid; s < SEQ; s += 256) { const size_t ts = (size_t)b * SEQ + s; float a = 0.f; for (int e = 0; e < 64; ++e) a += q[e] * KN[ts * 512 + h * 64 + e]; for (int e = 0; e < 32; ++e) a += q[64 + e] * KRR[ts * 32 + e]; sc[s] = a; mx = fmaxf(mx, a); }
    for (int o = 1; o < 64; o <<= 1) mx = fmaxf(mx, __shfl_xor(mx, o));
    __syncthreads(); if ((tid & 63) == 0) red[tid >> 6] = mx; __syncthreads(); mx = fmaxf(fmaxf(red[0], red[1]), fmaxf(red[2], red[3])); __syncthreads();
    float l = 0.f;
    for (int s = tid; s < SEQ; s += 256) { const float p = expf(sc[s] - mx); sc[s] = p; l += p; }
    l = blk_sum(l, red);
    const int e = tid & 63, g = tid >> 6; float o = 0.f;
    for (int s = g; s < SEQ; s += 4) o += sc[s] * VV[((size_t)b * SEQ + s) * 512 + h * 64 + e];
    part[tid] = o; __syncthreads();
    if (tid < 64) { const float ref = (part[tid] + part[64 + tid] + part[128 + tid] + part[192 + tid]) / l, got = bf2f(((const bf16_t*)(ws + CK_OBS))[(size_t)si * 512 + h * 64 + tid]);
        atomicMax(flag, __float_as_uint(fabsf(ref - got))); atomicMax(flag + 1, __float_as_uint(fabsf(ref))); }
}
__global__ void ck_apply(float* out, const unsigned* flag) {
    const float d = __uint_as_float(flag[0]), r = __uint_as_float(flag[1]);
    const bool bad = !(r > 0.f) || !(d <= MLA_CHECK_TOL * r);
    if (bad) for (size_t i = (size_t)blockIdx.x * blockDim.x + threadIdx.x; i < (size_t)T * DM; i += (size_t)gridDim.x * blockDim.x) out[i] = __builtin_nanf("");
}
#endif

constexpr int N_PHASES = 13;
#ifndef REP0
#define REP0 1
#endif
#ifndef REP1
#define REP1 1
#endif
#ifndef REP3
#define REP3 1
#endif
#ifndef REP5
#define REP5 1
#endif
#ifndef REP7
#define REP7 1
#endif
#ifndef REP10
#define REP10 1
#endif
#ifndef REP11
#define REP11 1
#endif
#ifndef MK_ONE_LAUNCH
#define MK_ONE_LAUNCH 0
#endif
__global__ void __launch_bounds__(NTHREADS, 2) fwd(Args args) {
    extern __shared__ __attribute__((aligned(16))) unsigned char lds_raw[];
    LAS unsigned char* lds = (LAS unsigned char*)lds_raw;
    volatile LAS unsigned* MISC = (volatile LAS unsigned*)(lds + MISC_OFF);
    const int tid = threadIdx.x, lane = tid & 63, wave = __builtin_amdgcn_readfirstlane(tid >> 6);
    const int G = gridDim.x, bx = blockIdx.x;
    unsigned char* ws = args.ws;
    for (int u = tid; u < (LDS_BYTES - RING_BYTES) / 4; u += NTHREADS) ((LAS unsigned*)(lds + RING_BYTES))[u] = 0u;
    __syncthreads();
    XcdBarrier bar; bar.bar = (unsigned*)(ws + WS_CTL) + CW_BAR; bar.x = 0; bar.st = nullptr;
    if (MK_ONE_LAUNCH) bar = xcd_barrier_post((unsigned*)(ws + WS_CTL) + CW_BAR, MISC + MI_BAR);
    const int lo = args.ph_lo, hi = args.ph_hi;
#ifdef ONLY_PHASE
#define IN(k) ((k) == ONLY_PHASE && lo <= (k) && (k) < hi)
#else
#define IN(k) (lo <= (k) && (k) < hi)
#endif
#define SEAM(k) do { if (IN(k) && IN((k) + 1)) xcd_barrier(bar); } while (0)

    if (IN(0)) { p0_prologue(args, lds, wave, lane);
#if REP0 > 1
        p0_prologue(args, lds, wave, lane);
#endif
    } SEAM(0);
#define PH1_BODY { pg8::DenseSched S; S.init((const bf16_t*)(ws + WS_XB), (const bf16_t*)(ws + WS_WIN), T, NIN, 1024, G, bx); EpiInProj E{ws}; \
        pg8::gemm_phase2<EpiInProj, pg8::DenseSched, true>(lds, 1024, S, E); }
    if (IN(1)) { PH1_BODY
#if REP1 > 1
        PH1_BODY
#endif
    } SEAM(1);
    if (IN(2)) { p2_stats(args, wave, lane); } SEAM(2);
#define PH3_BODY { { pg8::DenseSched S; S.init((const bf16_t*)(ws + WS_CQ), (const bf16_t*)(ws + WS_WUQ), T, 768, 256, G, bx); EpiQ E{ws}; \
          pg8::gemm_phase2<EpiQ, pg8::DenseSched, true>(lds, 256, S, E); } \
        { pg8::DenseSched S; S.init((const bf16_t*)(ws + WS_CKV), (const bf16_t*)(ws + WS_WUKV), T, 1024, 128, G, bx); EpiKV E{ws}; \
          pg8::gemm_phase2<EpiKV, pg8::DenseSched, true>(lds, 128, S, E); } }
    if (IN(3)) { PH3_BODY
#if REP3 > 1
        PH3_BODY
#endif
    } SEAM(3);
    if (IN(4)) { p4_dilated(args, lds, MISC, wave, lane);
#ifdef REP_DIL
        p4_dilated(args, lds, MISC, wave, lane);
#endif
    } SEAM(4);
    if (IN(5)) { p5_combine(args, wave, lane); p5_mla(args, lds, wave, lane);
#ifdef REP_MLA
        p5_mla(args, lds, wave, lane);
#endif
    } SEAM(5);
#ifdef MLA_CHECK
    if (IN(6) && bx == 0) { for (int i = tid; i < CK_NS * 512; i += NTHREADS) ((bf16_t*)(ws + CK_OBS))[i] = ((const bf16_t*)(ws + WS_OB))[(size_t)ck_tok(i >> 9) * 512 + (i & 511)]; }
#endif
    if (IN(6)) {
        { pg8::DenseSched S; S.init((const bf16_t*)(ws + WS_OA), (const bf16_t*)(ws + WS_WA), T, 1024, 512, G, bx); EpiGate<false> E{ws};
          pg8::gemm_phase2<EpiGate<false>, pg8::DenseSched, true>(lds, 512, S, E); }
        { pg8::DenseSched S; S.init((const bf16_t*)(ws + WS_OB), (const bf16_t*)(ws + WS_WB), T, 1024, 512, G, bx); EpiGate<true> E{ws};
          pg8::gemm_phase2<EpiGate<true>, pg8::DenseSched, true>(lds, 512, S, E); }
    } SEAM(6);
#define PH7_BODY { pg8::DenseSched S; S.init((const bf16_t*)(ws + WS_MERGED), (const bf16_t*)(ws + WS_WO), T, 1024, 1024, G, bx); EpiResid E{ws, args.in[0], args.out}; \
        pg8::gemm_phase2<EpiResid, pg8::DenseSched, true>(lds, 1024, S, E); }
    if (IN(7)) { PH7_BODY
#if REP7 > 1
        PH7_BODY
#endif
    } SEAM(7);
    if (IN(8)) { p8_router(args, lds, MISC, wave, lane); } SEAM(8);
    if (IN(9)) { p9_scatter(args, MISC); } SEAM(9);
#define PH10_BODY { moe_prefix(args, MISC); \
        pg8::MoeSched<3, true> S; S.tpre = (const LAS int*)(MISC + MI_TPRE); S.ntiles = (int)MISC[MI_TPRE + 32]; S.G = G; S.c = bx; S.K = 512; \
        S.A = (const char*)(ws + WS_H2); S.Bt = (const char*)(ws + WS_WGU); S.estride = (size_t)2048 * 1024; S.row_tok = (const int*)(ws + WS_ROWTOK); \
        EpiSwiglu E{ws, args.in[15]}; \
        pg8::gemm_phase2<EpiSwiglu, pg8::MoeSched<3, true>, true, true, 121>(lds, 512, S, E); }
    if (IN(10)) { PH10_BODY
#if REP10 > 1
        PH10_BODY
#endif
    } SEAM(10);
#define PH11_BODY { moe_prefix(args, MISC); \
        pg8::MoeSched<2, false> S; S.tpre = (const LAS int*)(MISC + MI_TPRE); S.ntiles = (int)MISC[MI_TPRE + 32]; S.G = G; S.c = bx; S.K = 512; \
        S.A = (const char*)(ws + WS_ACT); S.Bt = (const char*)(ws + WS_WD); S.estride = (size_t)1024 * 1024; S.row_tok = nullptr; \
        EpiDown E{ws, args.in[17]}; \
        pg8::gemm_phase2<EpiDown, pg8::MoeSched<2, false>, true, true, 121>(lds, 512, S, E); }
    if (IN(11)) { PH11_BODY
#if REP11 > 1
        PH11_BODY
#endif
    } SEAM(11);
    if (IN(12)) { p12_final(args, wave, lane); }
#undef IN
#undef SEAM
}

extern "C" void kernel_launch(void* const* d_in, const int* in_sizes, int n_in, void* d_out, int out_size, void* d_ws, size_t ws_size, hipStream_t stream) {
    static int grid = 0;
    if (grid == 0) {
        if (n_in != 19 || in_sizes[0] != T * DM || out_size != T * DM || ws_size < WS_END) { fprintf(stderr, "kernel_launch: unexpected shapes (n_in %d, in0 %d, out %d, ws %zu); nothing launched\n", n_in, n_in > 0 ? in_sizes[0] : -1, out_size, ws_size); grid = -1; return; }
        int dev = 0, cus = 0, per_cu = 0;
        if (hipGetDevice(&dev) != hipSuccess || hipDeviceGetAttribute(&cus, hipDeviceAttributeMultiprocessorCount, dev) != hipSuccess) { grid = -1; return; }
        if (hipFuncSetAttribute((const void*)fwd, hipFuncAttributeMaxDynamicSharedMemorySize, LDS_BYTES) != hipSuccess) { fprintf(stderr, "kernel_launch: hipFuncSetAttribute failed\n"); grid = -1; return; }
        if (hipOccupancyMaxActiveBlocksPerMultiprocessor(&per_cu, (const void*)fwd, NTHREADS, LDS_BYTES) != hipSuccess || per_cu < 1) fprintf(stderr, "kernel_launch: occupancy query reports %d\n", per_cu);
        (void)hipGetLastError();
        grid = cus;
    }
    if (grid < 0) return;
    if (hipMemsetAsync((char*)d_ws + WS_CTL, 0, CTL_ZERO_BYTES, stream) != hipSuccess) { fprintf(stderr, "kernel_launch: memset failed\n"); return; }
    Args a{};
    for (int i = 0; i < 19; ++i) a.in[i] = (const float*)d_in[i];
    a.out = (float*)d_out; a.ws = (unsigned char*)d_ws; a.li = 0; a.pad = 0;
#if MK_ONE_LAUNCH
    a.ph_lo = 0; a.ph_hi = N_PHASES;
    hipLaunchKernelGGL(fwd, dim3(grid), dim3(NTHREADS), LDS_BYTES, stream, a);
#else
    for (int p = 0; p < N_PHASES; ++p) {
        a.ph_lo = p; a.ph_hi = p + 1; hipLaunchKernelGGL(fwd, dim3(grid), dim3(NTHREADS), LDS_BYTES, stream, a); }

#endif
#ifdef MLA_CHECK
    {   unsigned* flag = (unsigned*)((unsigned char*)d_ws + WS_CTL) + 16384;
        hipLaunchKernelGGL(ck_kv, dim3(T), dim3(256), 0, stream, a.in[0], a.in[1], a.in[2], a.in[4], a.in[6], a.in[7], (unsigned char*)d_ws);
        hipLaunchKernelGGL(ck_q, dim3(CK_NS), dim3(256), 0, stream, a.in[0], a.in[1], a.in[2], a.in[3], a.in[5], (unsigned char*)d_ws);
        hipLaunchKernelGGL(ck_attn, dim3(CK_NS * 8), dim3(256), 0, stream, (unsigned char*)d_ws, flag);
        hipLaunchKernelGGL(ck_apply, dim3(1024), dim3(256), 0, stream, (float*)d_out, (const unsigned*)flag); }
#endif
    const hipError_t le = hipPeekAtLastError();
    if (le != hipSuccess) fprintf(stderr, "kernel_launch: launch failed: %s\n", hipGetErrorName(le));
}
```

```cpp
#define MK_ONE_LAUNCH 1
#include <hip/hip_runtime.h>
#include <cstdio>
#include <cstdint>

#define LAS __attribute__((address_space(3)))
#define GAS __attribute__((address_space(1)))
typedef unsigned short bf16_t;
typedef short bf16x8 __attribute__((ext_vector_type(8)));
typedef short s16x4 __attribute__((ext_vector_type(4)));
typedef float f32x2 __attribute__((ext_vector_type(2)));
typedef float f32x4 __attribute__((ext_vector_type(4)));
typedef float f32x16 __attribute__((ext_vector_type(16)));
typedef unsigned u32x2 __attribute__((ext_vector_type(2)));
typedef unsigned u32x4 __attribute__((ext_vector_type(4)));

constexpr int NB = 2, SEQ = 16384, T = NB * SEQ, DM = 1024;
constexpr int NIN = 4096;
constexpr int NEXP = 32, TOPK = 4, NSLOT = T * TOPK, NPMAX = NSLOT + NEXP * 256;
constexpr float EPS = 1e-5f, LOG2E = 1.4426950408889634f;
constexpr int NWAVES = 8, NTHREADS = 512;

constexpr size_t MiB = 1u << 20;
constexpr size_t WS_CTL = 0, CTL_ZERO_BYTES = 1 * MiB;
constexpr size_t WS_WIN = 1 * MiB;
constexpr size_t WS_WUQ = 9 * MiB;
constexpr size_t WS_WUKV = 10 * MiB;
constexpr size_t WS_WA = 11 * MiB, WS_WB = 12 * MiB;
constexpr size_t WS_WO = 13 * MiB;
constexpr size_t WS_ROPE = 15 * MiB;
constexpr size_t WS_WGU = 17 * MiB;
constexpr size_t WS_WD = 145 * MiB;
constexpr size_t WS_SMALL = 209 * MiB;
constexpr size_t WS_RSTDQ = WS_SMALL, WS_RSTDKV = WS_RSTDQ + T * 4, WS_RSTD2 = WS_RSTDKV + T * 4;
constexpr size_t WS_TOPI = WS_RSTD2 + T * 4, WS_GATEW = WS_TOPI + (size_t)NSLOT * 4, WS_SRANK = WS_GATEW + (size_t)NSLOT * 4, WS_POS = WS_SRANK + (size_t)NSLOT * 4;
constexpr size_t WS_ROWTOK = WS_POS + (size_t)NSLOT * 4, WS_ROWSCALE = WS_ROWTOK + 1 * MiB, WS_WGBASE = WS_ROWSCALE + 1 * MiB;
constexpr size_t WS_WRP = WS_WGBASE + 64 * 1024;
constexpr size_t WS_PARTL = WS_WRP + 128 * 1024;
static_assert(WS_PARTL + 3 * MiB <= 225 * MiB, "small region");
constexpr size_t WS_XB = 225 * MiB;
constexpr size_t WS_QA = 289 * MiB, WS_KA = 321 * MiB, WS_VA = 353 * MiB;
constexpr size_t WS_CQ = 385 * MiB;
constexpr size_t WS_CKV = 401 * MiB;
constexpr size_t WS_KR = 409 * MiB;
constexpr size_t WS_GA = 411 * MiB, WS_GB = 475 * MiB;
constexpr size_t WS_K8 = 225 * MiB;
constexpr size_t WS_Q8 = 249 * MiB;
constexpr size_t WS_ACT = 225 * MiB;
static_assert(WS_ACT + (size_t)NPMAX * 2048 <= 539 * MiB, "ACT overlay");
constexpr size_t WS_QB = 539 * MiB;
constexpr size_t WS_KIMG = 587 * MiB;
constexpr size_t WS_VIMG = 635 * MiB;
constexpr size_t WS_OA = 667 * MiB, WS_OB = 699 * MiB;
constexpr size_t WS_MERGED = 731 * MiB;
constexpr size_t WS_PARTO = 795 * MiB;
constexpr size_t WS_H2 = 891 * MiB;
constexpr size_t WS_Y = 539 * MiB;
static_assert(WS_Y + (size_t)NPMAX * 2048 <= WS_H2, "Y overlay");
constexpr size_t WS_END = 955 * MiB;
constexpr int CW_TMO = 0, CW_BAR = 4096, CW_GCOUNT = 8192, CW_NRM = 8256;

constexpr int RING_BYTES = 131072, MISC_OFF = RING_BYTES + 320, LDS_BYTES = 147456;
constexpr int MI_BAR = 8, MI_TPRE = 16, MI_HIST = 64, MI_PSTART = 96, MI_NRM = 160;

__device__ __forceinline__ unsigned f2bf(float f) { unsigned u = __builtin_bit_cast(unsigned, f); return (u + 0x7fffu + ((u >> 16) & 1u)) >> 16; }
__device__ __forceinline__ unsigned pk2(float lo, float hi) { return f2bf(lo) | (f2bf(hi) << 16); }
__device__ __forceinline__ float bf2f(unsigned short b) { return __builtin_bit_cast(float, (unsigned)b << 16); }
__device__ __forceinline__ float bflo(unsigned w) { return __builtin_bit_cast(float, w << 16); }
__device__ __forceinline__ float bfhi(unsigned w) { return __builtin_bit_cast(float, w & 0xffff0000u); }
typedef __bf16 bf16x2_t __attribute__((ext_vector_type(2)));
__device__ __forceinline__ unsigned cvtpk(float lo, float hi) { const f32x2 v = {lo, hi}; const bf16x2_t b = __builtin_convertvector(v, bf16x2_t); return __builtin_bit_cast(unsigned, b); }
__device__ __forceinline__ unsigned pack4_fp8(float a, float b, float c, float d) { int w = 0; w = __builtin_amdgcn_cvt_pk_fp8_f32(a, b, w, false); w = __builtin_amdgcn_cvt_pk_fp8_f32(c, d, w, true); return (unsigned)w; }
__device__ __forceinline__ float wave_sum(float v) {
#pragma unroll
    for (int o = 1; o < 64; o <<= 1) v += __shfl_xor(v, o);
    return v;
}
__device__ __forceinline__ float fexp2(float x) { return __builtin_amdgcn_exp2f(x); }
__device__ __forceinline__ float frcp(float x) { return __builtin_amdgcn_rcpf(x); }
__device__ __forceinline__ float sigmoidf_(float z) { return frcp(1.f + fexp2(-z * LOG2E)); }
__device__ __forceinline__ int crow(int r, int hi) { return (r & 3) + 8 * (r >> 2) + 4 * hi; }
__device__ __forceinline__ u32x4 pack8(const float (&v)[8]) { u32x4 w; w.x = cvtpk(v[0], v[1]); w.y = cvtpk(v[2], v[3]); w.z = cvtpk(v[4], v[5]); w.w = cvtpk(v[6], v[7]); return w; }
__device__ __forceinline__ void unpack8(const u32x4 w, float (&v)[8]) { v[0] = bflo(w.x); v[1] = bfhi(w.x); v[2] = bflo(w.y); v[3] = bfhi(w.y); v[4] = bflo(w.z); v[5] = bfhi(w.z); v[6] = bflo(w.w); v[7] = bfhi(w.w); }
__device__ __forceinline__ f32x2 rope_cs(int pos, int i) {
    const float inv = __builtin_powf(10000.f, -(float)i * (1.f / 16.f));
    const float ang = (float)pos * inv;
    double x = (double)ang; const double n = __builtin_rint(x * 0.15915494309189535); x = (x - n * 6.283185307179586) - n * 2.4492935982947064e-16;
    const double x2 = x * x; double sn = 1.0, cs = 1.0;
#pragma unroll
    for (int k = 13; k >= 1; --k) { sn = 1.0 - sn * x2 * (1.0 / (double)((2 * k) * (2 * k + 1))); cs = 1.0 - cs * x2 * (1.0 / (double)((2 * k - 1) * (2 * k))); }
    sn *= x;
    return (f32x2){(float)cs, (float)sn};
}

namespace pg8 {
constexpr int BM = 256, BK = 64, HALF = 128, HTB = HALF * BK * 2  , NXCD = 8, WGM = 8;
__host__ __device__ __forceinline__ int lds_byte(int r, int c) { const int st = (r >> 4) * 2 + (c >> 5), rr = r & 15, cc = c & 31, ob = rr * 64 + cc * 2; return st * 1024 + (ob ^ (((ob >> 9) & 1) << 5)); }
__host__ __device__ __forceinline__ void stage_rc(int b, int& R, int& C) { const int st = b / 1024, sb = b % 1024, swz = sb ^ (((sb >> 9) & 1) << 5); R = (st >> 1) * 16 + swz / 64; C = (st & 1) * 32 + (swz % 64) / 2; }
__host__ __device__ __forceinline__ int perm32(int rho) { const int n = rho >> 4, i = rho & 15; return 8 * (i >> 2) + 4 * n + (i & 3); }

struct Unit { int pm, pn, e; };

struct StaticOrder {
    int nM, nN, nwg, G, c;
    __host__ __device__ void init(int M, int N, int G_, int c_) { nM = M / BM; nN = N / BM; nwg = nM * nN; G = G_; c = c_; }
    __host__ __device__ bool next(int i, Unit& u) const {
        const long L = (long)i * G + c; if (L >= nwg) return false;
        int wgid = (int)L; { const int q = nwg / NXCD, r = nwg % NXCD, xcd = wgid % NXCD, off = wgid / NXCD; wgid = (xcd < r ? xcd * (q + 1) : r * (q + 1) + (xcd - r) * q) + off; }
        const int nig = WGM * nN, gid = wgid / nig, fm = gid * WGM, gsz = (nM - fm) < WGM ? (nM - fm) : WGM;
        u.pm = fm + ((wgid % nig) % gsz); u.pn = (wgid % nig) / gsz; u.e = 0; return true;
    }
};
struct DenseSched {
    static constexpr bool LATE = false;
    StaticOrder so; const char* A; const char* Bt; int K;
    __device__ __forceinline__ void prefetch_rows(const Unit&, LAS unsigned char*, int, int, int) const {}
    __device__ __forceinline__ void a_off_lds(const Unit&, const int (&)[2], const int (&)[2], LAS unsigned char*, int, unsigned (&)[2][2]) const {}
    __device__ __forceinline__ void init(const bf16_t* A_, const bf16_t* Bt_, int M, int N, int K_, int G, int c) { so.init(M, N, G, c); A = (const char*)A_; Bt = (const char*)Bt_; K = K_; }
    __device__ __forceinline__ bool next(int i, Unit& u) const { return so.next(i, u); }
    __device__ __forceinline__ const char* a_base(const Unit& u) const { return A + (size_t)u.pm * ((size_t)BM * K * 2); }
    __device__ __forceinline__ const char* b_base(const Unit& u) const { return Bt + (size_t)u.pn * ((size_t)BM * K * 2); }
    __device__ __forceinline__ void a_off(const Unit&, const int (&sR)[2], const int (&sC)[2], unsigned (&vo)[2][2]) const {
#pragma unroll
        for (int h = 0; h < 2; ++h)
#pragma unroll
            for (int i = 0; i < 2; ++i) vo[h][i] = (unsigned)((h * HALF + sR[i]) * K + sC[i]) * 2u;
    }
};
template <int NPN_SHIFT, bool GATHER>
struct MoeSched {
    static constexpr bool LATE = GATHER;
    static constexpr int TBL_OFF = 131072 + 4096;
    __device__ __forceinline__ void prefetch_rows(const Unit& u, LAS unsigned char* lds, int buf, int wid, int lane) const {
        if (wid < 4) __builtin_amdgcn_global_load_lds((const unsigned*)(row_tok + u.pm * BM + wid * 64 + lane), (LAS unsigned*)(lds + TBL_OFF + buf * 1024 + wid * 256), 4, 0, 0);
    }
    __device__ __forceinline__ void a_off_lds(const Unit&, const int (&sR)[2], const int (&sC)[2], LAS unsigned char* lds, int buf, unsigned (&vo)[2][2]) const {
        const LAS int* tb = (const LAS int*)(lds + TBL_OFF + buf * 1024);
#pragma unroll
        for (int h = 0; h < 2; ++h)
#pragma unroll
            for (int i = 0; i < 2; ++i) vo[h][i] = (unsigned)(tb[h * HALF + sR[i]] * K + sC[i]) * 2u;
    }
    const LAS int* tpre; int ntiles, G, c, K; const char* A; const char* Bt; size_t estride; const int* row_tok;
    __device__ __forceinline__ bool next(int i, Unit& u) const {
        int g, pn;
        if (G == 256) { const int x = c & 7, j = c >> 3; constexpr int TPR = 256 >> NPN_SHIFT, PX = TPR / 8; g = i * TPR + x * PX + (j >> NPN_SHIFT); pn = j & ((1 << NPN_SHIFT) - 1); }
        else { const int L = i * G + c; g = L >> NPN_SHIFT; pn = L & ((1 << NPN_SHIFT) - 1); }
        if (g >= ntiles) return false;
        int e = 0; while (e < 31 && tpre[e + 1] <= g) ++e;
        u.pm = g; u.pn = pn; u.e = e; return true;
    }
    __device__ __forceinline__ const char* a_base(const Unit& u) const { return GATHER ? A : A + (size_t)u.pm * ((size_t)BM * K * 2); }
    __device__ __forceinline__ const char* b_base(const Unit& u) const { return Bt + (size_t)u.e * estride + (size_t)u.pn * ((size_t)BM * K * 2); }
    __device__ __forceinline__ void a_off(const Unit& u, const int (&sR)[2], const int (&sC)[2], unsigned (&vo)[2][2]) const {
#pragma unroll
        for (int h = 0; h < 2; ++h)
#pragma unroll
            for (int i = 0; i < 2; ++i) {
                if (GATHER) { const int tok = row_tok[u.pm * BM + h * HALF + sR[i]]; vo[h][i] = (unsigned)(tok * K + sC[i]) * 2u; }
                else vo[h][i] = (unsigned)((h * HALF + sR[i]) * K + sC[i]) * 2u;
            }
    }
};

typedef int v8i_ __attribute__((ext_vector_type(8)));
__device__ __forceinline__ v8i_ cat16(const bf16x8 a, const bf16x8 b) { const u32x4 x = __builtin_bit_cast(u32x4, a), y = __builtin_bit_cast(u32x4, b); return (v8i_){(int)x.x, (int)x.y, (int)x.z, (int)x.w, (int)y.x, (int)y.y, (int)y.z, (int)y.w}; }
__device__ __forceinline__ v8i_ lds_ld32(const LAS unsigned char* p) { const u32x4 x = *(const LAS u32x4*)p, y = *(const LAS u32x4*)(p + 1024); return (v8i_){(int)x.x, (int)x.y, (int)x.z, (int)x.w, (int)y.x, (int)y.y, (int)y.z, (int)y.w}; }
template <class Epi, class Sched, bool ALIGN_EPI, bool FP8 = false, int SCALE_W = 127>
__device__ __forceinline__ void gemm_phase2(LAS unsigned char* lds, const int K_, const Sched& S, const Epi& E) {
    int K = K_; asm volatile("" : "+s"(K));
    const int tid = threadIdx.x, wid = __builtin_amdgcn_readfirstlane(tid >> 6), lane = tid & 63, wr = wid >> 2, wc = wid & 3, fr = lane & 15, fq = lane >> 4;
    const int nt = K / BK;
    int sR[2], sC[2]; unsigned voffB[2];
#pragma unroll
    for (int i = 0; i < 2; ++i) { int R, C; stage_rc(tid * 16 + i * 8192, R, C); sR[i] = R; sC[i] = C; const int Rb = Epi::PERM ? ((R & ~31) + perm32(R & 31)) : R; voffB[i] = (unsigned)(Rb * K + C) * 2u; }
    const size_t kstep = (size_t)(BK * 2);
    const size_t hstep = (size_t)HALF * K * 2;
    const unsigned ldsw = (unsigned)wid * 1024u;
    const int aoff = lds_byte(wr * 64 + fr, fq * 8), boff = lds_byte(wc * 32 + fr, fq * 8);
#define PG8_SA(b, h) (((b) * 2 + (h)) * HTB)
#define PG8_SB(b, h) ((4 + (b) * 2 + (h)) * HTB)
#define PG8_STAGE_B(bufoff, gbase) do { _Pragma("unroll") for (int _i = 0; _i < 2; ++_i) \
        __builtin_amdgcn_global_load_lds((const unsigned*)((const char*)(gbase) + voffB[_i]), (LAS unsigned*)(lds + (bufoff) + ldsw + _i * 8192), 16, 0, 0); } while (0)
#define PG8_STAGE_A(bufoff, gbase, o0, o1) do { \
        __builtin_amdgcn_global_load_lds((const unsigned*)((const char*)(gbase) + (o0)), (LAS unsigned*)(lds + (bufoff) + ldsw), 16, 0, 0); \
        __builtin_amdgcn_global_load_lds((const unsigned*)((const char*)(gbase) + (o1)), (LAS unsigned*)(lds + (bufoff) + ldsw + 8192), 16, 0, 0); } while (0)
#define PG8_LDA(dst, b, h) do { if constexpr (FP8) { _Pragma("unroll") for (int m = 0; m < 4; ++m) dst##8[m] = lds_ld32(lds + PG8_SA(b, h) + aoff + m * 2048); } else { _Pragma("unroll") for (int m = 0; m < 4; ++m) _Pragma("unroll") for (int k = 0; k < 2; ++k) dst[m][k] = *(const LAS bf16x8*)(lds + PG8_SA(b, h) + aoff + m * 2048 + k * 1024); } } while (0)
#define PG8_LDB(dst, b, h) do { if constexpr (FP8) { _Pragma("unroll") for (int n = 0; n < 2; ++n) dst##8[n] = lds_ld32(lds + PG8_SB(b, h) + boff + n * 2048); } else { _Pragma("unroll") for (int n = 0; n < 2; ++n) _Pragma("unroll") for (int k = 0; k < 2; ++k) dst[n][k] = *(const LAS bf16x8*)(lds + PG8_SB(b, h) + boff + n * 2048 + k * 1024); } } while (0)
#define PG8_MMA(ai, bj, At, Bt) do { __builtin_amdgcn_s_setprio(1); if constexpr (FP8) { _Pragma("unroll") for (int m = 0; m < 4; ++m) _Pragma("unroll") for (int n = 0; n < 2; ++n) \
        asm volatile("v_mfma_scale_f32_16x16x128_f8f6f4 %0, %1, %2, %0, %3, %4 op_sel_hi:[0,0,0]" : "+v"(acc[ai][bj][m][n]) : "v"(Bt##8[n]), "v"(At##8[m]), "v"(scw_), "v"(sca_)); } else { \
        _Pragma("unroll") for (int m = 0; m < 4; ++m) _Pragma("unroll") for (int n = 0; n < 2; ++n) _Pragma("unroll") for (int k = 0; k < 2; ++k) \
        acc[ai][bj][m][n] = __builtin_amdgcn_mfma_f32_16x16x32_bf16(Bt[n][k], At[m][k], acc[ai][bj][m][n], 0, 0, 0); } __builtin_amdgcn_s_setprio(0); } while (0)
#define PG8_WAIT_V(n) asm volatile("s_waitcnt vmcnt(" #n ")" ::: "memory")
#define PG8_WAIT_L(n) asm volatile("s_waitcnt lgkmcnt(" #n ")" ::: "memory")
#define PG8_BAR __builtin_amdgcn_s_barrier()
#define PG8_SCHED __builtin_amdgcn_sched_barrier(0)
    Unit cur, nxt; int ui = 0;
    if (!S.next(0, cur)) return;
    f32x4 acc[2][2][4][2];
#pragma unroll
    for (int a = 0; a < 2; ++a)
#pragma unroll
        for (int b = 0; b < 2; ++b)
#pragma unroll
            for (int m = 0; m < 4; ++m)
#pragma unroll
                for (int n = 0; n < 2; ++n) acc[a][b][m][n] = (f32x4){0.f, 0.f, 0.f, 0.f};
    bf16x8 At[4][2], B0[2][2], B1[2][2]; v8i_ At8[4], B08[2], B18[2];
    int scw_ = SCALE_W * 0x01010101, sca_ = 0x7f7f7f7f; asm volatile("" : "+v"(scw_), "+v"(sca_));
    unsigned voA[2][2], voN[2][2];
    S.a_off(cur, sR, sC, voA);
    const char* cA = S.a_base(cur); const char* cB = S.b_base(cur);
    PG8_STAGE_B(PG8_SB(0, 0), cB); PG8_STAGE_B(PG8_SB(0, 1), cB + hstep); PG8_STAGE_A(PG8_SA(0, 0), cA, voA[0][0], voA[0][1]); PG8_STAGE_A(PG8_SA(0, 1), cA, voA[1][0], voA[1][1]);
    if (wr == 1) PG8_BAR;
    PG8_WAIT_V(2); PG8_BAR;
    PG8_STAGE_B(PG8_SB(1, 0), cB + kstep); PG8_STAGE_A(PG8_SA(1, 0), cA + kstep, voA[0][0], voA[0][1]); PG8_STAGE_B(PG8_SB(1, 1), cB + hstep + kstep);
    PG8_WAIT_V(6); PG8_BAR;
    for (;;) {
        const bool has_next = S.next(ui + 1, nxt);
        const char* nA = cA; const char* nB = cB;
#pragma unroll
        for (int h = 0; h < 2; ++h)
#pragma unroll
            for (int i = 0; i < 2; ++i) voN[h][i] = voA[h][i];
        if (has_next) { nA = S.a_base(nxt); nB = S.b_base(nxt); if constexpr (Sched::LATE) S.prefetch_rows(nxt, lds, (ui + 1) & 1, wid, lane); else S.a_off(nxt, sR, sC, voN); }
        for (int t = 0; t < nt; t += 2) {
            const bool last = (t == nt - 2);
            if constexpr (Sched::LATE) { if (last && has_next) S.a_off_lds(nxt, sR, sC, lds, (ui + 1) & 1, voN); }
            const char* a1 = cA + (size_t)(t + 1) * kstep;
            const char* a2 = last ? nA : cA + (size_t)(t + 2) * kstep; const char* b2 = last ? nB : cB + (size_t)(t + 2) * kstep;
            const char* a3 = a2 + kstep; const char* b3 = b2 + kstep;
            const unsigned s00 = last ? voN[0][0] : voA[0][0], s01 = last ? voN[0][1] : voA[0][1], s10 = last ? voN[1][0] : voA[1][0], s11 = last ? voN[1][1] : voA[1][1];
            PG8_LDB(B0, 0, 0); PG8_LDB(B1, 0, 1); PG8_SCHED; PG8_LDA(At, 0, 0); PG8_STAGE_A(PG8_SA(1, 1), a1, voA[1][0], voA[1][1]);
            PG8_WAIT_V(8); PG8_WAIT_L(0); PG8_BAR; PG8_MMA(0, 0, At, B0); PG8_MMA(0, 1, At, B1); PG8_BAR; PG8_SCHED;
            PG8_LDA(At, 0, 1); PG8_STAGE_B(PG8_SB(0, 0), b2); PG8_STAGE_B(PG8_SB(0, 1), b2 + hstep); PG8_STAGE_A(PG8_SA(0, 0), a2, s00, s01);
            PG8_WAIT_V(8); PG8_WAIT_L(0); PG8_BAR; PG8_MMA(1, 0, At, B0); PG8_MMA(1, 1, At, B1); PG8_BAR; PG8_SCHED;
            PG8_LDB(B0, 1, 0); PG8_LDB(B1, 1, 1); PG8_SCHED; PG8_LDA(At, 1, 0); PG8_STAGE_A(PG8_SA(0, 1), a2, s10, s11);
            PG8_WAIT_V(8); PG8_WAIT_L(0); PG8_BAR; PG8_MMA(0, 0, At, B0); PG8_MMA(0, 1, At, B1); PG8_BAR; PG8_SCHED;
            PG8_LDA(At, 1, 1); PG8_STAGE_B(PG8_SB(1, 0), b3); PG8_STAGE_B(PG8_SB(1, 1), b3 + hstep); PG8_STAGE_A(PG8_SA(1, 0), a3, s00, s01);
            PG8_WAIT_V(8); PG8_WAIT_L(0); PG8_BAR; PG8_MMA(1, 0, At, B0); PG8_MMA(1, 1, At, B1); PG8_BAR; PG8_SCHED;
        }
        if constexpr (ALIGN_EPI) { if (wr == 0) PG8_BAR; }
        E(acc, cur, wr, wc, fr, fq);
        if (!has_next) break;
#pragma unroll
        for (int a = 0; a < 2; ++a)
#pragma unroll
            for (int b = 0; b < 2; ++b)
#pragma unroll
                for (int m = 0; m < 4; ++m)
#pragma unroll
                    for (int n = 0; n < 2; ++n) acc[a][b][m][n] = (f32x4){0.f, 0.f, 0.f, 0.f};
        cur = nxt; cA = nA; cB = nB; ++ui;
#pragma unroll
        for (int h = 0; h < 2; ++h)
#pragma unroll
            for (int i = 0; i < 2; ++i) voA[h][i] = voN[h][i];
        if constexpr (ALIGN_EPI) { if (wr == 1) PG8_BAR; }
    }
    PG8_WAIT_V(0);
    if constexpr (!ALIGN_EPI) { if (wr == 0) PG8_BAR; }
    PG8_BAR;
#undef PG8_SA
#undef PG8_SB
#undef PG8_STAGE_A
#undef PG8_STAGE_B
#undef PG8_LDA
#undef PG8_LDB
#undef PG8_MMA
#undef PG8_WAIT_V
#undef PG8_WAIT_L
#undef PG8_BAR
#undef PG8_SCHED
}
}

#define XB_TMO      128
#define XB_XCNT(j)  (256  + 64 * (j))
#define XB_XSUB(j)  (1280 + 64 * (j))
#define XB_XGEN(j)  (2304 + 64 * (j))
#define XB_TOP      3328
#define XB_TOPGEN   3392
#define XCD_BAR_WORDS 3456
#define XB_SPIN_CAP (1u << 18)

__device__ __forceinline__ unsigned xb_ld(unsigned* p)              { return __hip_atomic_load(p, __ATOMIC_RELAXED, __HIP_MEMORY_SCOPE_AGENT); }
__device__ __forceinline__ unsigned xb_add(unsigned* p, unsigned v) { return __hip_atomic_fetch_add(p, v, __ATOMIC_RELAXED, __HIP_MEMORY_SCOPE_AGENT); }
__device__ __forceinline__ unsigned xb_xcc_id() { return (unsigned)__builtin_amdgcn_s_getreg((3 << 11) | 20) & 0xFu; }
#define XB_SPIN(cond, bar) do { unsigned _sp = 0; while (cond) { __builtin_amdgcn_s_sleep(1); \
    if ((++_sp & 255u) == 0u) { if (xb_ld(&(bar)[XB_TMO])) break; if (_sp > XB_SPIN_CAP) { atomicAdd(&(bar)[XB_TMO], 1u); break; } } } } while (0)

struct XcdBarrier {
    unsigned* bar; unsigned x;
    volatile LAS unsigned* st;
};
__device__ __forceinline__ XcdBarrier xcd_barrier_post(unsigned* bar, volatile LAS unsigned* st) {
    XcdBarrier b; b.bar = bar; b.x = xb_xcc_id(); b.st = st;
    if (threadIdx.x == 0) (void)xb_add(&bar[XB_XCNT(b.x)], 1u);
    return b;
}
__device__ __forceinline__ void xcd_barrier_complete(unsigned* bar, unsigned x, unsigned& nloc, unsigned& nx) {
    const unsigned G = gridDim.x * gridDim.y * gridDim.z;
    unsigned sum, cnt, mine, sp = 0u;
    for (;;) {
        sum = 0u; cnt = 0u; mine = 0u;
#pragma unroll
        for (unsigned j = 0; j < 16; ++j) { const unsigned c = xb_ld(&bar[XB_XCNT(j)]); sum += c; cnt += (c > 0u) ? 1u : 0u; mine = (j == x) ? c : mine; }
        if (sum == G) break;
        __builtin_amdgcn_s_sleep(1);
        if ((++sp & 255u) == 0u) { if (xb_ld(&bar[XB_TMO])) break; if (sp > XB_SPIN_CAP) { atomicAdd(&bar[XB_TMO], 1u); break; } }
    }
    nloc = mine > 0u ? mine : 1u; nx = cnt > 0u ? cnt : 1u;
}
__device__ __forceinline__ void xcd_barrier(const XcdBarrier& b) {
    asm volatile("s_waitcnt vmcnt(0)" ::: "memory");
    __syncthreads();
    if (threadIdx.x == 0) {
        unsigned* bar = b.bar;
        __builtin_amdgcn_s_waitcnt(0);
        unsigned nloc = b.st[0], nx = b.st[1];
        if (nloc == 0u) { xcd_barrier_complete(bar, b.x, nloc, nx); b.st[0] = nloc; b.st[1] = nx; }
        const unsigned old = xb_add(&bar[XB_XSUB(b.x)], 1u);
        const unsigned gen = old / nloc;
        if (old + 1u == (gen + 1u) * nloc) {
            __builtin_amdgcn_fence(__ATOMIC_RELEASE, "agent");
            asm volatile("s_waitcnt vmcnt(0)" ::: "memory");
            const unsigned og = xb_add(&bar[XB_TOP], 1u);
            const unsigned tg = og / nx;
            if (og + 1u == (tg + 1u) * nx) xb_add(&bar[XB_TOPGEN], 1u);
            else XB_SPIN(xb_ld(&bar[XB_TOPGEN]) == tg, bar);
            __builtin_amdgcn_fence(__ATOMIC_ACQUIRE, "agent");
            xb_add(&bar[XB_XGEN(b.x)], 1u);
            asm volatile("s_waitcnt vmcnt(0)" ::: "memory");
        } else {
            XB_SPIN(xb_ld(&bar[XB_XGEN(b.x)]) == gen, bar);
            __builtin_amdgcn_fence(__ATOMIC_ACQUIRE, "agent");
            asm volatile("s_waitcnt vmcnt(0)" ::: "memory");
        }
    }
    __syncthreads();
}

#define EPI_WALK(...) \
    _Pragma("unroll") for (int ai = 0; ai < 2; ++ai) _Pragma("unroll") for (int m = 0; m < 4; ++m) { \
        const int row = u.pm * 256 + ai * 128 + wr * 64 + m * 16 + fr; \
        _Pragma("unroll") for (int bj = 0; bj < 2; ++bj) { const int cw = bj * 128 + wc * 32 + 8 * fq; \
            float v[8] = {acc[ai][bj][m][0][0], acc[ai][bj][m][0][1], acc[ai][bj][m][0][2], acc[ai][bj][m][0][3], acc[ai][bj][m][1][0], acc[ai][bj][m][1][1], acc[ai][bj][m][1][2], acc[ai][bj][m][1][3]}; \
            __VA_ARGS__ } asm volatile("" ::: "memory"); }

__device__ __forceinline__ void rope8(float (&v)[8], const f32x2* rope_row, int i0) {
#pragma unroll
    for (int j = 0; j < 4; ++j) { const f32x2 cs = rope_row[i0 + j]; const float x1 = v[2 * j], x2 = v[2 * j + 1]; v[2 * j] = x1 * cs.x - x2 * cs.y; v[2 * j + 1] = x2 * cs.x + x1 * cs.y; }
}

struct EpiInProj {
    static constexpr bool PERM = true;
    unsigned char* ws;
    __device__ __forceinline__ void operator()(const f32x4 (&acc)[2][2][4][2], const pg8::Unit& u, int wr, int wc, int fr, int fq) const {
        const int pn = u.pn;
        if (pn < 6) {
            bf16_t* base = (bf16_t*)(ws + (pn < 2 ? WS_QA : pn < 4 ? WS_KA : WS_VA)) + (pn & 1) * 256;
            EPI_WALK({ *(u32x4*)(base + (size_t)row * 512 + cw) = pack8(v); })
        } else if (pn == 6) {
            bf16_t* base = (bf16_t*)(ws + WS_CQ);
            EPI_WALK({ *(u32x4*)(base + (size_t)row * 256 + cw) = pack8(v); })
        } else if (pn == 7) {
            bf16_t* ckv = (bf16_t*)(ws + WS_CKV); bf16_t* kr = (bf16_t*)(ws + WS_KR); const f32x2* rope = (const f32x2*)(ws + WS_ROPE);
            EPI_WALK({ if (cw < 128) { *(u32x4*)(ckv + (size_t)row * 128 + cw) = pack8(v); }
                       else if (cw < 160) { rope8(v, rope + (size_t)(row & (SEQ - 1)) * 16, (cw - 128) >> 1); *(u32x4*)(kr + (size_t)row * 32 + (cw - 128)) = pack8(v); } })
        } else {
            bf16_t* base = (bf16_t*)(ws + (pn < 12 ? WS_GA : WS_GB)) + ((pn - 8) & 3) * 256;
            EPI_WALK({ _Pragma("unroll") for (int j = 0; j < 8; ++j) v[j] = sigmoidf_(v[j]); *(u32x4*)(base + (size_t)row * 1024 + cw) = pack8(v); })
        }
    }
};
#define EPI_ROW(ai, m) (u.pm * 256 + (ai) * 128 + wr * 64 + (m) * 16 + fr)
#define EPI_LOAD_RS(rs) float rs8[2][4]; _Pragma("unroll") for (int ai = 0; ai < 2; ++ai) _Pragma("unroll") for (int m = 0; m < 4; ++m) rs8[ai][m] = (rs)[EPI_ROW(ai, m)];
struct EpiQ {
    static constexpr bool PERM = true;
    unsigned char* ws;
    __device__ __forceinline__ void operator()(const f32x4 (&acc)[2][2][4][2], const pg8::Unit& u, int wr, int wc, int fr, int fq) const {
        bf16_t* qb = (bf16_t*)(ws + WS_QB); const float* rs = (const float*)(ws + WS_RSTDQ); const f32x2* rope = (const f32x2*)(ws + WS_ROPE);
        EPI_LOAD_RS(rs)
        EPI_WALK({ const int col = u.pn * 256 + cw; const int w = col % 96; const float r = rs8[ai][m];
                   _Pragma("unroll") for (int j = 0; j < 8; ++j) v[j] *= r;
                   if (w >= 64) rope8(v, rope + (size_t)(row & (SEQ - 1)) * 16, (w - 64) >> 1);
                   *(u32x4*)(qb + (size_t)row * 768 + col) = pack8(v);
                   *(u32x2*)(ws + WS_Q8 + (size_t)row * 768 + col) = (u32x2){pack4_fp8(v[0] * 16.f, v[1] * 16.f, v[2] * 16.f, v[3] * 16.f), pack4_fp8(v[4] * 16.f, v[5] * 16.f, v[6] * 16.f, v[7] * 16.f)}; })
    }
};
struct EpiKV {
    static constexpr bool PERM = true;
    unsigned char* ws;
    __device__ __forceinline__ void operator()(const f32x4 (&acc)[2][2][4][2], const pg8::Unit& u, int wr, int wc, int fr, int fq) const {
        const float* rs = (const float*)(ws + WS_RSTDKV); bf16_t* kimg = (bf16_t*)(ws + WS_KIMG); bf16_t* vimg = (bf16_t*)(ws + WS_VIMG);
        EPI_LOAD_RS(rs)
        EPI_WALK({ const float r = rs8[ai][m];
                   _Pragma("unroll") for (int j = 0; j < 8; ++j) v[j] *= r;
                   const int col = (u.pn & 1) * 256 + cw, h = col >> 6, b = row >> 14, sq = row & (SEQ - 1), tile = sq >> 6, rr = sq & 63; const size_t tb = (size_t)((b * 8 + h) * 256 + tile);
                   if (u.pn < 2) { *(u32x4*)(kimg + tb * 6144 + ((col & 63) >> 3) * 512 + rr * 8) = pack8(v);
                       *(u32x2*)(ws + WS_K8 + tb * 6144 + ((col & 63) >> 4) * 1024 + rr * 16 + (col & 8)) = (u32x2){pack4_fp8(v[0], v[1], v[2], v[3]), pack4_fp8(v[4], v[5], v[6], v[7])}; }
                   else *(u32x4*)(vimg + tb * 4096 + ((col & 63) >> 5) * 2048 + rr * 32 + (col & 31)) = pack8(v); })
    }
};
template <bool SECOND> struct EpiGate {
    static constexpr bool PERM = true;
    unsigned char* ws;
    __device__ __forceinline__ void operator()(const f32x4 (&acc)[2][2][4][2], const pg8::Unit& u, int wr, int wc, int fr, int fq) const {
        bf16_t* mg = (bf16_t*)(ws + WS_MERGED); const bf16_t* gt = (const bf16_t*)(ws + (SECOND ? WS_GB : WS_GA));
#pragma unroll
        for (int ai = 0; ai < 2; ++ai) {
            u32x4 gw[4][2], pw[4][2];
#pragma unroll
            for (int m = 0; m < 4; ++m)
#pragma unroll
                for (int bj = 0; bj < 2; ++bj) { const size_t o = (size_t)EPI_ROW(ai, m) * 1024 + u.pn * 256 + bj * 128 + wc * 32 + 8 * fq; gw[m][bj] = *(const u32x4*)(gt + o); if (SECOND) pw[m][bj] = *(const u32x4*)(mg + o); }
#pragma unroll
            for (int m = 0; m < 4; ++m)
#pragma unroll
                for (int bj = 0; bj < 2; ++bj) { const size_t o = (size_t)EPI_ROW(ai, m) * 1024 + u.pn * 256 + bj * 128 + wc * 32 + 8 * fq;
                    float v[8] = {acc[ai][bj][m][0][0], acc[ai][bj][m][0][1], acc[ai][bj][m][0][2], acc[ai][bj][m][0][3], acc[ai][bj][m][1][0], acc[ai][bj][m][1][1], acc[ai][bj][m][1][2], acc[ai][bj][m][1][3]};
                    float g[8]; unpack8(gw[m][bj], g);
                    if (SECOND) { float p[8]; unpack8(pw[m][bj], p); _Pragma("unroll") for (int j = 0; j < 8; ++j) v[j] = p[j] + g[j] * v[j]; }
                    else { _Pragma("unroll") for (int j = 0; j < 8; ++j) v[j] = g[j] * v[j]; }
                    *(u32x4*)(mg + o) = pack8(v); }
            asm volatile("" ::: "memory");
        }
    }
};
struct EpiResid {
    static constexpr bool PERM = true;
    unsigned char* ws; const float* x; float* x1;
    __device__ __forceinline__ void operator()(const f32x4 (&acc)[2][2][4][2], const pg8::Unit& u, int wr, int wc, int fr, int fq) const {
        bf16_t* h2 = (bf16_t*)(ws + WS_H2);
#pragma unroll
        for (int ai = 0; ai < 2; ++ai) {
            f32x4 xa[4][2][2];
#pragma unroll
            for (int m = 0; m < 4; ++m)
#pragma unroll
                for (int bj = 0; bj < 2; ++bj) { const size_t o = (size_t)EPI_ROW(ai, m) * 1024 + u.pn * 256 + bj * 128 + wc * 32 + 8 * fq; xa[m][bj][0] = *(const f32x4*)(x + o); xa[m][bj][1] = *(const f32x4*)(x + o + 4); }
#pragma unroll
            for (int m = 0; m < 4; ++m)
#pragma unroll
                for (int bj = 0; bj < 2; ++bj) { const size_t o = (size_t)EPI_ROW(ai, m) * 1024 + u.pn * 256 + bj * 128 + wc * 32 + 8 * fq;
                    const f32x4 r0 = acc[ai][bj][m][0] + xa[m][bj][0], r1 = acc[ai][bj][m][1] + xa[m][bj][1];
                    *(f32x4*)(x1 + o) = r0; *(f32x4*)(x1 + o + 4) = r1;
                    const float v[8] = {r0[0], r0[1], r0[2], r0[3], r1[0], r1[1], r1[2], r1[3]};
                    *(u32x2*)((unsigned char*)h2 + o) = (u32x2){pack4_fp8(v[0], v[1], v[2], v[3]), pack4_fp8(v[4], v[5], v[6], v[7])}; }
            asm volatile("" ::: "memory");
        }
    }
};
struct EpiSwiglu {
    static constexpr bool PERM = true;
    unsigned char* ws; const float* bgu;
    __device__ __forceinline__ void operator()(const f32x4 (&acc)[2][2][4][2], const pg8::Unit& u, int wr, int wc, int fr, int fq) const {
        bf16_t* act = (bf16_t*)(ws + WS_ACT); const float* rsc = (const float*)(ws + WS_ROWSCALE);
        const int c0 = u.pn * 128 + wc * 32 + 8 * fq; const float* bg = bgu + (size_t)u.e * 2048 + c0;
        float bgv[8], buv[8];
#pragma unroll
        for (int j = 0; j < 8; ++j) { bgv[j] = bg[j]; buv[j] = bg[1024 + j]; }
        EPI_LOAD_RS(rsc)
#pragma unroll
        for (int ai = 0; ai < 2; ++ai)
#pragma unroll
            for (int m = 0; m < 4; ++m) {
                const int row = u.pm * 256 + ai * 128 + wr * 64 + m * 16 + fr; const float r = rs8[ai][m]; float o[8];
#pragma unroll
                for (int j = 0; j < 8; ++j) { const float g0 = acc[ai][0][m][j >> 2][j & 3] * r + bgv[j], u0 = acc[ai][1][m][j >> 2][j & 3] * r + buv[j];
                    const float g = fminf(g0, 7.f), up = __builtin_amdgcn_fmed3f(u0, -7.f, 7.f);
                    const float gs = g * frcp(1.f + fexp2(g * (-1.702f * LOG2E)));
                    o[j] = __builtin_fmaf(up, gs, gs); }
                *(u32x2*)((unsigned char*)act + (size_t)row * 1024 + c0) = (u32x2){pack4_fp8(o[0], o[1], o[2], o[3]), pack4_fp8(o[4], o[5], o[6], o[7])};
            }
    }
};
struct EpiDown {
    static constexpr bool PERM = true;
    unsigned char* ws; const float* bd;
    __device__ __forceinline__ void operator()(const f32x4 (&acc)[2][2][4][2], const pg8::Unit& u, int wr, int wc, int fr, int fq) const {
        bf16_t* y = (bf16_t*)(ws + WS_Y); const float* b = bd + (size_t)u.e * 1024 + u.pn * 256;
        EPI_WALK({ _Pragma("unroll") for (int j = 0; j < 8; ++j) v[j] += b[cw + j];
                   *(u32x4*)(y + (size_t)row * 1024 + u.pn * 256 + cw) = pack8(v); })
    }
};

typedef short v4i16_t __attribute__((ext_vector_type(4)));
__device__ __forceinline__ s16x4 vtr(const LAS char* p) { return __builtin_bit_cast(s16x4, __builtin_amdgcn_ds_read_tr16_b64_v4i16((LAS v4i16_t*)p)); }
__device__ __forceinline__ float swapmax(float m) { auto rr = __builtin_amdgcn_permlane32_swap(__float_as_uint(m), __float_as_uint(m), false, false); return fmaxf(__uint_as_float(rr[0]), __uint_as_float(rr[1])); }
__device__ __forceinline__ float swapsum(float m) { auto rr = __builtin_amdgcn_permlane32_swap(__float_as_uint(m), __float_as_uint(m), false, false); return __uint_as_float(rr[0]) + __uint_as_float(rr[1]); }

struct AttnState { f32x16 o0, o1; float m, l; };

struct MlaKL {
    const bf16_t* K; const bf16_t* V;
    template <int D0> __device__ __forceinline__ bf16x8 kfrag(int c, int r32, int hi) const { return *(const bf16x8*)(K + (size_t)(c >> 1) * 6144 + (2 * D0 + hi) * 512 + ((c & 1) * 32 + r32) * 8); }
    __device__ __forceinline__ u32x4 vpiece(int c, int row, int c8) const { return *(const u32x4*)(V + (size_t)(c >> 1) * 4096 + (c8 >> 2) * 2048 + ((c & 1) * 32 + row) * 32 + (c8 & 3) * 8); }
    __device__ __forceinline__ void modify(int, f32x16&, int, int) const {}
    __device__ __forceinline__ int order(int i) const { return i; }
};
struct DilKL {
    const bf16_t* K; const bf16_t* V;
    int dil, res, u0, L; float slope2d;
    __device__ __forceinline__ size_t tok(int c, int kk) const { int v = u0 - 64 + 32 * c + kk; v = v < 0 ? 0 : (v >= L ? L - 1 : v); return (size_t)(res + dil * v); }
    template <int D0> __device__ __forceinline__ bf16x8 kfrag(int c, int r32, int hi) const { return *(const bf16x8*)(K + tok(c, r32) * 512 + 16 * D0 + 8 * hi); }
    __device__ __forceinline__ u32x4 vpiece(int c, int row, int c8) const { return *(const u32x4*)(V + tok(c, row) * 512 + 8 * c8); }
    __device__ __forceinline__ void modify(int c, f32x16& s, int r32, int hi) const {
        const float c0 = (float)(32 * c - 64); const int vb = u0 - 64 + 32 * c;
#pragma unroll
        for (int r = 0; r < 16; ++r) { const float d = (float)(crow(r, hi) - r32); s[r] = s[r] - slope2d * fabsf(d + c0); }
        if (c == 0) {
#pragma unroll
            for (int r = 0; r < 16; ++r) s[r] = (crow(r, hi) >= r32) ? s[r] : -1e30f; }
        if (c == 4) {
#pragma unroll
            for (int r = 0; r < 16; ++r) s[r] = (crow(r, hi) <= r32) ? s[r] : -1e30f; }
        if (vb < 0 || vb + 31 >= L) {
#pragma unroll
            for (int r = 0; r < 16; ++r) { const int v = vb + crow(r, hi); s[r] = (v >= 0 && v < L) ? s[r] : -1e30f; } }
    }
    __device__ __forceinline__ int order(int i) const { return i == 0 ? 2 : i == 1 ? 1 : i == 2 ? 3 : i == 3 ? 0 : 4; }
};

template <int NDK, class KL> __device__ __forceinline__ void attn_load_k(bf16x8 (&kf)[NDK], const KL& kl, int c, int r32, int hi) {
    kf[0] = kl.template kfrag<0>(c, r32, hi); kf[1] = kl.template kfrag<1>(c, r32, hi); kf[2] = kl.template kfrag<2>(c, r32, hi); kf[3] = kl.template kfrag<3>(c, r32, hi);
    if constexpr (NDK == 6) { kf[4] = kl.template kfrag<4>(c, r32, hi); kf[5] = kl.template kfrag<5>(c, r32, hi); }
}
template <class KL> __device__ __forceinline__ void attn_load_v(u32x4 (&vp)[4], const KL& kl, int c, int lane) {
#pragma unroll
    for (int i = 0; i < 4; ++i) { const int p = lane + 64 * i; vp[i] = kl.vpiece(c, p >> 3, p & 7); }
}
__device__ __forceinline__ void attn_store_v(const u32x4 (&vp)[4], LAS char* vimg, int lane) {
#pragma unroll
    for (int i = 0; i < 4; ++i) { const int p = lane + 64 * i, row = p >> 3, c8 = p & 7; *(LAS u32x4*)(vimg + (c8 >> 2) * 2048 + row * 64 + (c8 & 3) * 16) = vp[i]; }
}
template <int NDK, class KL> __device__ __forceinline__ void attn_core(AttnState& st, const bf16x8 (&qf)[NDK], const bf16x8 (&kf)[NDK], const KL& kl, int c, LAS char* vimg, LAS float* wsf, int lane, int r32, int hi) {
    f32x16 s = {};
#pragma unroll
    for (int d0 = 0; d0 < NDK; ++d0) s = __builtin_amdgcn_mfma_f32_32x32x16_bf16(kf[d0], qf[d0], s, 0, 0, 0);
    kl.modify(c, s, r32, hi);
    float mx = s[0];
#pragma unroll
    for (int r = 1; r < 16; ++r) mx = fmaxf(mx, s[r]);
    mx = swapmax(mx);
    const float mn = fmaxf(st.m, mx), alpha = fexp2(st.m - mn);
    float ps = 0.f;
#pragma unroll
    for (int r = 0; r < 16; ++r) { s[r] = fexp2(s[r] - mn); ps += s[r]; }
    st.l = st.l * alpha + ps; st.m = mn;
    if (__any(alpha != 1.f)) {
        if (hi == 0) wsf[r32] = alpha;
#pragma unroll
        for (int r = 0; r < 16; ++r) { const float a = wsf[crow(r, hi)]; st.o0[r] *= a; st.o1[r] *= a; }
    }
    const u32x4 pw0 = {cvtpk(s[0], s[1]), cvtpk(s[2], s[3]), cvtpk(s[4], s[5]), cvtpk(s[6], s[7])};
    const u32x4 pw1 = {cvtpk(s[8], s[9]), cvtpk(s[10], s[11]), cvtpk(s[12], s[13]), cvtpk(s[14], s[15])};
    const bf16x8 pa0 = __builtin_bit_cast(bf16x8, pw0), pa1 = __builtin_bit_cast(bf16x8, pw1);
    const LAS char* vp = vimg + ((lane >> 4) & 1) * 32 + (lane & 3) * 8 + (4 * hi + ((lane & 15) >> 2)) * 64;
#pragma unroll
    for (int ks = 0; ks < 2; ++ks) {
        const s16x4 l0 = vtr(vp + ks * 1024), h0 = vtr(vp + ks * 1024 + 512), l1 = vtr(vp + 2048 + ks * 1024), h1 = vtr(vp + 2048 + ks * 1024 + 512);
        const bf16x8 v0 = {l0[0], l0[1], l0[2], l0[3], h0[0], h0[1], h0[2], h0[3]}, v1 = {l1[0], l1[1], l1[2], l1[3], h1[0], h1[1], h1[2], h1[3]};
        st.o0 = __builtin_amdgcn_mfma_f32_32x32x16_bf16(ks == 0 ? pa0 : pa1, v0, st.o0, 0, 0, 0);
        st.o1 = __builtin_amdgcn_mfma_f32_32x32x16_bf16(ks == 0 ? pa0 : pa1, v1, st.o1, 0, 0, 0);
    }
}
template <int NDK, class KL> __device__ __forceinline__ void wave_attn(AttnState& st, const bf16x8 (&qf)[NDK], const KL& kl, int nchunk, LAS char* vimg, LAS float* wsf, int lane) {
    const int r32 = lane & 31, hi = lane >> 5;
    st.o0 = f32x16{}; st.o1 = f32x16{}; st.m = -1e30f; st.l = 0.f;
    bf16x8 kfa[NDK], kfb[NDK]; u32x4 vp[4];
    attn_load_k<NDK>(kfa, kl, kl.order(0), r32, hi); attn_load_v(vp, kl, kl.order(0), lane);
    asm volatile("" : "+s"(nchunk));
#pragma unroll 1
    for (int c = 0; c < nchunk; c += 2) {
        attn_store_v(vp, vimg, lane);
        if (c + 1 < nchunk) { attn_load_k<NDK>(kfb, kl, kl.order(c + 1), r32, hi); attn_load_v(vp, kl, kl.order(c + 1), lane); }
        attn_core<NDK>(st, qf, kfa, kl, kl.order(c), vimg, wsf, lane, r32, hi);
        if (c + 1 < nchunk) {
            attn_store_v(vp, vimg, lane);
            if (c + 2 < nchunk) { attn_load_k<NDK>(kfa, kl, kl.order(c + 2), r32, hi); attn_load_v(vp, kl, kl.order(c + 2), lane); }
            attn_core<NDK>(st, qf, kfb, kl, kl.order(c + 1), vimg, wsf, lane, r32, hi);
        }
    }
}
__device__ __forceinline__ float attn_finish(AttnState& st, LAS char* vimg, LAS float* wsf, int lane) {
    const int r32 = lane & 31, hi = lane >> 5;
    const float lt = swapsum(st.l);
    if (hi == 0) wsf[32 + r32] = lt;
    LAS bf16_t* stg = (LAS bf16_t*)vimg;
#pragma unroll
    for (int r = 0; r < 16; ++r) { const int q = crow(r, hi); const float il = frcp(wsf[32 + q]);
        stg[q * 64 + r32] = (bf16_t)f2bf(st.o0[r] * il); stg[q * 64 + 32 + r32] = (bf16_t)f2bf(st.o1[r] * il); }
    return lt;
}

namespace mla {
constexpr int NW = 8, QBLK = 32, QB = 256, KVBLK = 64, NT = SEQ / KVBLK;
constexpr int KSLOT = 12288, VSLOT = 8192, LDS_K = 0, LDS_V = 3 * KSLOT, LDS_WS = LDS_V + 3 * VSLOT, LDS_OST = LDS_WS + NW * 256, LDS_BYTES_ = LDS_OST + NW * 4096;
#define SBAR() __builtin_amdgcn_sched_barrier(0)
#define WAIT_BAR(N) asm volatile("s_waitcnt vmcnt(" #N ") lgkmcnt(0)\n\ts_barrier" ::: "memory")
__device__ __forceinline__ void glds16(const void* gsrc, unsigned lds_dst) { unsigned keep;
    asm volatile("s_mov_b32 %0, m0\n\ts_mov_b32 m0, %2\n\ts_nop 0\n\tglobal_load_lds_dwordx4 %1, off\n\ts_mov_b32 m0, %0" : "=&s"(keep) : "v"(gsrc), "s"(lds_dst) : "memory"); }
typedef LAS const char* lds_cptr;
__device__ __forceinline__ void kload2(bf16x8* kf, lds_cptr kp, int j) { kf[2 * j] = *(const LAS bf16x8*)(kp + j * 2048); kf[2 * j + 1] = *(const LAS bf16x8*)(kp + j * 2048 + 512); }

__device__ __forceinline__ void mla_unit(int b, int h, int qb, const bf16_t* Q, const bf16_t* __restrict__ Kim, const bf16_t* __restrict__ Vim, bf16_t* O, LAS char* shm) {
    const int tid = threadIdx.x, lane = tid & 63, r32 = lane & 31, hi = lane >> 5; const int wid = __builtin_amdgcn_readfirstlane(tid >> 6);
    const long rowbase = (long)b * SEQ; const int q0 = qb * QB;
    const bf16_t* Qw = Q + (rowbase + q0 + wid * QBLK) * 768 + h * 96;
    const unsigned lds0 = (unsigned)(uintptr_t)shm;
    LAS float* wsf = (LAS float*)(shm + LDS_WS) + wid * 64;
    const bf16_t* ksrc = Kim + wid * 512 + lane * 8;
    const bf16_t* rsrc = Kim + (8 + (wid & 3)) * 512 + lane * 8;
    const bf16_t* vsrc = Vim + wid * 512 + lane * 8;
    const unsigned kdst = lds0 + LDS_K + wid * 1024, rdst = lds0 + LDS_K + (8 + (wid & 3)) * 1024, vdst = lds0 + LDS_V + wid * 1024;
#define DMA_K(t, ks) do { glds16(ksrc + (long)(t) * 6144, (unsigned)__builtin_amdgcn_readfirstlane(kdst + (ks))); glds16(rsrc + (long)(t) * 6144, (unsigned)__builtin_amdgcn_readfirstlane(rdst + (ks))); } while (0)
#define DMA_V(t, vs) glds16(vsrc + (long)(t) * 4096, (unsigned)__builtin_amdgcn_readfirstlane(vdst + (vs)))
    const lds_cptr shm3 = (lds_cptr)shm; const lds_cptr kp0 = shm3 + LDS_K + hi * 1024 + r32 * 16;
    const lds_cptr vp0 = shm3 + LDS_V + ((lane >> 4) & 1) * 32 + (lane & 3) * 8 + (4 * hi + ((lane & 15) >> 2)) * 64;
    bf16x8 kf[12];
    DMA_K(0, 0); DMA_V(0, 0); DMA_K(1, KSLOT);
    bf16x8 qr[6];
#pragma unroll
    for (int d0 = 0; d0 < 6; ++d0) qr[d0] = *reinterpret_cast<const bf16x8*>(&Qw[(long)r32 * 768 + d0 * 16 + hi * 8]);
    float l_reg = 0.f; f32x16 o[2]; o[0] = f32x16{}; o[1] = f32x16{};
    f32x16 pA0, pA1, pB0, pB1;
    int si_prev = 0, si_cur = 0, si_next = 1;
#define ROT() do { si_prev = si_cur; si_cur = si_next; si_next = (si_next == 2) ? 0 : si_next + 1; } while (0)
    DMA_K(2, 2 * KSLOT);
    WAIT_BAR(5);
    { const lds_cptr kb = kp0;
#pragma unroll
      for (int d0 = 0; d0 < 6; ++d0) { const bf16x8 b0 = *(const LAS bf16x8*)(kb + d0 * 2048), b1 = *(const LAS bf16x8*)(kb + d0 * 2048 + 512);
          if (d0 == 0) { pA0 = __builtin_amdgcn_mfma_f32_32x32x16_bf16(b0, qr[0], f32x16{}, 0, 0, 0); pA1 = __builtin_amdgcn_mfma_f32_32x32x16_bf16(b1, qr[0], f32x16{}, 0, 0, 0); }
          else { pA0 = __builtin_amdgcn_mfma_f32_32x32x16_bf16(b0, qr[d0], pA0, 0, 0, 0); pA1 = __builtin_amdgcn_mfma_f32_32x32x16_bf16(b1, qr[d0], pA1, 0, 0, 0); } } }
#pragma unroll
    for (int r = 0; r < 16; ++r) { pA0[r] = __builtin_amdgcn_exp2f(pA0[r]); pA1[r] = __builtin_amdgcn_exp2f(pA1[r]); }
    WAIT_BAR(0);
    DMA_K(3, 0); DMA_V(1, VSLOT);
    ROT();
#pragma unroll
    for (int j = 0; j < 6; ++j) kload2(kf, kp0 + si_cur * KSLOT, j);
    WAIT_BAR(3);
    s16x4 vlo[8], vhi[8]; u32x4 pw0, pw1, pw2, pw3;
#define PKW(P, B) cvtpk(P[B], P[B + 1])
#define PAF(k) __builtin_bit_cast(bf16x8, pw##k)
#define VFR(i) (bf16x8){vlo[i][0], vlo[i][1], vlo[i][2], vlo[i][3], vhi[i][0], vhi[i][1], vhi[i][2], vhi[i][3]}
#define PIN(x) asm volatile("" : "+v"(x))
#define MF(a, b, c) __builtin_amdgcn_mfma_f32_32x32x16_bf16(a, b, c, 0, 0, 0)
#define GAPA(MFX, A0, A1, A2, A3, W0, W1, PW) do { MFX; sacc += A0; sacc += A1; sacc += A2; sacc += A3; PIN(sacc); W0; W1; PIN(PW); SBAR(); } while (0)
#define GAPM(MFX) do { MFX; SBAR(); } while (0)
#define EX(v) __builtin_amdgcn_exp2f(v)
#define GAPB(MFX, X, B) do { MFX; X[B] = EX(X[B]); X[B + 1] = EX(X[B + 1]); X[B + 2] = EX(X[B + 2]); X[B + 3] = EX(X[B + 3]); PIN(X); SBAR(); } while (0)
#define VRD(i) do { vlo[i] = vtr(vp_ + (((i) >> 2) * 4096 + ((i) & 3) * 1024)); vhi[i] = vtr(vp_ + (((i) >> 2) * 4096 + ((i) & 3) * 1024 + 512)); } while (0)
#define KRD(G, j) do { if (G) { kload2(kf, kp0 + si_next * KSLOT, j); SBAR(); } } while (0)
#define STEP(C0, C1, P0, P1, t, GK, GV, GL) do { SBAR(); \
    const lds_cptr vp_ = vp0 + si_prev * VSLOT; \
    VRD(0); SBAR(); float sacc = (P0[0] + P0[1]); \
    GAPA(C0 = MF(kf[0], qr[0], f32x16{}), P0[2], P0[3], P0[4], P0[5],     pw0[0] = PKW(P0, 0),  pw0[1] = PKW(P0, 2),  pw0); \
    VRD(4); SBAR(); GAPA(C1 = MF(kf[1], qr[0], f32x16{}), P0[6], P0[7], P0[8], P0[9],     pw0[2] = PKW(P0, 4),  pw0[3] = PKW(P0, 6),  pw0); \
    VRD(1); SBAR(); GAPA(C0 = MF(kf[2], qr[1], C0),   P0[10], P0[11], P0[12], P0[13], pw1[0] = PKW(P0, 8),  pw1[1] = PKW(P0, 10), pw1); \
    VRD(5); SBAR(); GAPA(C1 = MF(kf[3], qr[1], C1),   P0[14], P0[15], P1[0], P1[1],   pw1[2] = PKW(P0, 12), pw1[3] = PKW(P0, 14), pw1); \
    VRD(2); SBAR(); GAPA(C0 = MF(kf[4], qr[2], C0),   P1[2], P1[3], P1[4], P1[5],     pw2[0] = PKW(P1, 0),  pw2[1] = PKW(P1, 2),  pw2); \
    VRD(6); SBAR(); GAPA(C1 = MF(kf[5], qr[2], C1),   P1[6], P1[7], P1[8], P1[9],     pw2[2] = PKW(P1, 4),  pw2[3] = PKW(P1, 6),  pw2); \
    VRD(3); SBAR(); GAPA(C0 = MF(kf[6], qr[3], C0),   P1[10], P1[11], P1[12], P1[13], pw3[0] = PKW(P1, 8),  pw3[1] = PKW(P1, 10), pw3); \
    VRD(7); SBAR(); GAPA(C1 = MF(kf[7], qr[3], C1),   P1[14], P1[15], 0.f, 0.f,       pw3[2] = PKW(P1, 12), pw3[3] = PKW(P1, 14), pw3); \
    GAPM(C0 = MF(kf[8], qr[4], C0)); GAPM(C1 = MF(kf[9], qr[4], C1)); GAPM(C0 = MF(kf[10], qr[5], C0)); GAPM(C1 = MF(kf[11], qr[5], C1)); \
    l_reg += sacc; \
    if (GK) { DMA_K((t) + 3, si_cur * KSLOT); } if (GV) { DMA_V((t) + 1, si_next * VSLOT); } \
    SBAR(); \
    GAPB(o[0] = MF(PAF(0), VFR(0), o[0]), C0, 0); \
    GAPB(o[1] = MF(PAF(0), VFR(4), o[1]), C0, 4); \
    KRD(GL, 0); GAPB(o[0] = MF(PAF(1), VFR(1), o[0]), C0, 8); \
    KRD(GL, 1); GAPB(o[1] = MF(PAF(1), VFR(5), o[1]), C0, 12); \
    KRD(GL, 2); GAPB(o[0] = MF(PAF(2), VFR(2), o[0]), C1, 0); \
    KRD(GL, 3); GAPB(o[1] = MF(PAF(2), VFR(6), o[1]), C1, 4); \
    KRD(GL, 4); GAPB(o[0] = MF(PAF(3), VFR(3), o[0]), C1, 8); \
    KRD(GL, 5); GAPB(o[1] = MF(PAF(3), VFR(7), o[1]), C1, 12); \
    } while (0)
    int t = 1;
    for (; t + 5 < NT; t += 2) {
        STEP(pB0, pB1, pA0, pA1, t, true, true, true);     WAIT_BAR(3); ROT();
        STEP(pA0, pA1, pB0, pB1, t + 1, true, true, true); WAIT_BAR(3); ROT();
    }
#define ENDW(tt) do { if ((tt) + 3 < NT) { WAIT_BAR(3); } else if ((tt) + 2 < NT) { WAIT_BAR(1); } else { WAIT_BAR(0); } } while (0)
    for (; t + 1 < NT; t += 2) {
        STEP(pB0, pB1, pA0, pA1, t, (t + 3 < NT), (t + 1 < NT), (t + 1 < NT));         ENDW(t);     ROT();
        STEP(pA0, pA1, pB0, pB1, t + 1, (t + 4 < NT), (t + 2 < NT), (t + 2 < NT));     ENDW(t + 1); ROT();
    }
    STEP(pB0, pB1, pA0, pA1, NT - 1, false, false, false);
    { float sacc = pB0[0] + pB0[1];
#pragma unroll
      for (int r = 2; r < 16; ++r) sacc += pB0[r];
#pragma unroll
      for (int r = 0; r < 16; ++r) sacc += pB1[r];
      l_reg += sacc;
      pw0 = (u32x4){PKW(pB0, 0), PKW(pB0, 2), PKW(pB0, 4), PKW(pB0, 6)}; pw1 = (u32x4){PKW(pB0, 8), PKW(pB0, 10), PKW(pB0, 12), PKW(pB0, 14)};
      pw2 = (u32x4){PKW(pB1, 0), PKW(pB1, 2), PKW(pB1, 4), PKW(pB1, 6)}; pw3 = (u32x4){PKW(pB1, 8), PKW(pB1, 10), PKW(pB1, 12), PKW(pB1, 14)};
      SBAR();
      const lds_cptr vp_ = vp0 + si_cur * VSLOT;
#pragma unroll
      for (int d0 = 0; d0 < 2; ++d0) {
          s16x4 lo4[4], hi4[4];
#pragma unroll
          for (int ks = 0; ks < 4; ++ks) { lo4[ks] = vtr(vp_ + d0 * 4096 + ks * 1024); hi4[ks] = vtr(vp_ + d0 * 4096 + ks * 1024 + 512); }
#define PK4(k) (bf16x8){lo4[k][0], lo4[k][1], lo4[k][2], lo4[k][3], hi4[k][0], hi4[k][1], hi4[k][2], hi4[k][3]}
          o[d0] = MF(PAF(0), PK4(0), o[d0]); o[d0] = MF(PAF(1), PK4(1), o[d0]); o[d0] = MF(PAF(2), PK4(2), o[d0]); o[d0] = MF(PAF(3), PK4(3), o[d0]);
#undef PK4
      } }
    l_reg = swapsum(l_reg);
    if (hi == 0) wsf[32 + r32] = l_reg;
    asm volatile("s_waitcnt lgkmcnt(0)" ::: "memory");
    float rli[16];
#pragma unroll
    for (int r = 0; r < 16; ++r) rli[r] = __builtin_amdgcn_rcpf(wsf[32 + crow(r, hi)]);
    bf16_t* Ow = O + (rowbase + q0 + wid * QBLK) * 512 + h * 64;
    { LAS bf16_t* stg = (LAS bf16_t*)(shm + LDS_OST) + wid * 2048;
#pragma unroll
      for (int r = 0; r < 16; ++r) { const int orow = crow(r, hi);
#pragma unroll
          for (int d0 = 0; d0 < 2; ++d0) stg[orow * 64 + d0 * 32 + r32] = (bf16_t)f2bf(o[d0][r] * rli[r]); }
      asm volatile("s_waitcnt lgkmcnt(0)" ::: "memory");
#pragma unroll
      for (int i = 0; i < 4; ++i) { const int row = i * 8 + (lane >> 3), ch = lane & 7; const u32x4 v = *(const LAS u32x4*)(stg + row * 64 + ch * 8); *(u32x4*)(Ow + (long)row * 512 + ch * 8) = v; } }
    asm volatile("s_waitcnt lgkmcnt(0)\n\ts_barrier" ::: "memory");
#undef DMA_K
#undef DMA_V
#undef ROT
#undef PKW
#undef PAF
#undef VFR
#undef PIN
#undef MF
#undef GAPA
#undef GAPM
#undef GAPB
#undef EX
#undef VRD
#undef KRD
#undef STEP
#undef ENDW
}
#undef SBAR
#undef WAIT_BAR
}

namespace mla8 {
using mla::glds16; using mla::lds_cptr;
typedef int v8i __attribute__((ext_vector_type(8)));
constexpr int NW = 8, QBLK = 32, QB = 256, KVBLK = 64, NT = SEQ / KVBLK;
constexpr int KSLOT = 6144, VSLOT = 8192, LDS_K = 0, LDS_V = 3 * KSLOT, LDS_WS = LDS_V + 3 * VSLOT, LDS_OST = LDS_WS + NW * 256, LDS_BYTES_ = LDS_OST + NW * 4096;
#define SBAR() __builtin_amdgcn_sched_barrier(0)
#define WAIT_BAR(N) asm volatile("s_waitcnt vmcnt(" #N ") lgkmcnt(0)\n\ts_barrier" ::: "memory")
__device__ __forceinline__ v8i kfrag8(lds_cptr slot, int n, int ks, int r32, int hi) {
    const lds_cptr p = slot + (ks == 0 ? 2 * hi : 4) * 1024 + (32 * n + r32) * 16;
    const u32x4 a = *(const LAS u32x4*)p, b = *(const LAS u32x4*)(p + 1024);
    return (v8i){(int)a.x, (int)a.y, (int)a.z, (int)a.w, (int)b.x, (int)b.y, (int)b.z, (int)b.w};
}
#define MF8(a, b, c) __builtin_amdgcn_mfma_scale_f32_32x32x64_f8f6f4(a, b, c, 0, 0, 0, 0x7f7f7f7f, 0, 0x7b7b7b7b)

__device__ __forceinline__ void mla8_unit(int b, int h, int qb, const unsigned char* Q8, const unsigned char* __restrict__ K8im, const bf16_t* __restrict__ Vim, bf16_t* O, LAS char* shm) {
    const int tid = threadIdx.x, lane = tid & 63, r32 = lane & 31, hi = lane >> 5; const int wid = __builtin_amdgcn_readfirstlane(tid >> 6);
    const long rowbase = (long)b * SEQ; const int q0 = qb * QB;
    const unsigned char* Qw = Q8 + (size_t)(rowbase + q0 + wid * QBLK + r32) * 768 + h * 96;
    const unsigned lds0 = (unsigned)(uintptr_t)shm;
    LAS float* wsf = (LAS float*)(shm + LDS_WS) + wid * 64;
    const int kpc = wid < 6 ? wid : wid - 6;
    const unsigned char* ksrc = K8im + kpc * 1024 + lane * 16;
    const bf16_t* vsrc = Vim + wid * 512 + lane * 8;
    const unsigned kdst = lds0 + LDS_K + kpc * 1024, vdst = lds0 + LDS_V + wid * 1024;
#define DMA_K(t, ks) glds16(ksrc + (long)(t) * 6144, (unsigned)__builtin_amdgcn_readfirstlane(kdst + (ks)))
#define DMA_V(t, vs) glds16(vsrc + (long)(t) * 4096, (unsigned)__builtin_amdgcn_readfirstlane(vdst + (vs)))
    const lds_cptr shm3 = (lds_cptr)shm; const lds_cptr ks0 = shm3 + LDS_K;
    const lds_cptr vp0 = shm3 + LDS_V + ((lane >> 4) & 1) * 32 + (lane & 3) * 8 + (4 * hi + ((lane & 15) >> 2)) * 64;
    v8i kf[4];
    DMA_K(0, 0); DMA_V(0, 0); DMA_K(1, KSLOT);
    v8i qr[2];
    { const u32x4 a = *(const u32x4*)(Qw + 32 * hi), c = *(const u32x4*)(Qw + 32 * hi + 16); qr[0] = (v8i){(int)a.x, (int)a.y, (int)a.z, (int)a.w, (int)c.x, (int)c.y, (int)c.z, (int)c.w};
      u32x4 d = *(const u32x4*)(Qw + 64), e = *(const u32x4*)(Qw + 80); if (hi) { d = (u32x4){0u, 0u, 0u, 0u}; e = d; }
      qr[1] = (v8i){(int)d.x, (int)d.y, (int)d.z, (int)d.w, (int)e.x, (int)e.y, (int)e.z, (int)e.w}; }
    float l_reg = 0.f; f32x16 o[2]; o[0] = f32x16{}; o[1] = f32x16{};
    f32x16 pA0, pA1, pB0, pB1;
    int si_prev = 0, si_cur = 0, si_next = 1;
#define ROT() do { si_prev = si_cur; si_cur = si_next; si_next = (si_next == 2) ? 0 : si_next + 1; } while (0)
    DMA_K(2, 2 * KSLOT);
    WAIT_BAR(3);
    { pA0 = MF8(kfrag8(ks0, 0, 0, r32, hi), qr[0], f32x16{}); pA1 = MF8(kfrag8(ks0, 1, 0, r32, hi), qr[0], f32x16{});
      pA0 = MF8(kfrag8(ks0, 0, 1, r32, hi), qr[1], pA0); pA1 = MF8(kfrag8(ks0, 1, 1, r32, hi), qr[1], pA1); }
#pragma unroll
    for (int r = 0; r < 16; ++r) { pA0[r] = __builtin_amdgcn_exp2f(pA0[r]); pA1[r] = __builtin_amdgcn_exp2f(pA1[r]); }
    WAIT_BAR(0);
    DMA_K(3, 0); DMA_V(1, VSLOT);
    ROT();
    kf[0] = kfrag8(ks0 + si_cur * KSLOT, 0, 0, r32, hi); kf[1] = kfrag8(ks0 + si_cur * KSLOT, 0, 1, r32, hi); kf[2] = kfrag8(ks0 + si_cur * KSLOT, 1, 0, r32, hi); kf[3] = kfrag8(ks0 + si_cur * KSLOT, 1, 1, r32, hi);
    WAIT_BAR(2);
    s16x4 vlo[8], vhi[8]; u32x4 pw0, pw1, pw2, pw3;
#define PKW(P, B) cvtpk(P[B], P[B + 1])
#define PAF(k) __builtin_bit_cast(bf16x8, pw##k)
#define VFR(i) (bf16x8){vlo[i][0], vlo[i][1], vlo[i][2], vlo[i][3], vhi[i][0], vhi[i][1], vhi[i][2], vhi[i][3]}
#define PIN(x) asm volatile("" : "+v"(x))
#define MF(a, b, c) __builtin_amdgcn_mfma_f32_32x32x16_bf16(a, b, c, 0, 0, 0)
#define GAPA(MFX, A0, A1, A2, A3, W0, W1, PW) do { MFX; sacc += A0; sacc += A1; sacc += A2; sacc += A3; PIN(sacc); W0; W1; PIN(PW); SBAR(); } while (0)
#define GAPM(MFX) do { MFX; SBAR(); } while (0)
#define EX(v) __builtin_amdgcn_exp2f(v)
#define GAPB(MFX, X, B) do { MFX; X[B] = EX(X[B]); X[B + 1] = EX(X[B + 1]); X[B + 2] = EX(X[B + 2]); X[B + 3] = EX(X[B + 3]); PIN(X); SBAR(); } while (0)
#define VRD(i) do { vlo[i] = vtr(vp_ + (((i) >> 2) * 4096 + ((i) & 3) * 1024)); vhi[i] = vtr(vp_ + (((i) >> 2) * 4096 + ((i) & 3) * 1024 + 512)); } while (0)
#define KRD(G, j) do { if (G) { kf[j] = kfrag8(ks0 + si_next * KSLOT, (j) >> 1, (j) & 1, r32, hi); SBAR(); } } while (0)
#define GAPA8(MFX, A0, A1, A2, A3, A4, A5, A6, A7, W0, W1, W2, W3, PWa, PWb) do { MFX; sacc += A0; sacc += A1; sacc += A2; sacc += A3; PIN(sacc); W0; W1; PIN(PWa); sacc += A4; sacc += A5; sacc += A6; sacc += A7; PIN(sacc); W2; W3; PIN(PWb); SBAR(); } while (0)
#define STEP(C0, C1, P0, P1, t, GK, GV, GL) do { SBAR(); \
    const lds_cptr vp_ = vp0 + si_prev * VSLOT; \
    VRD(0); VRD(4); SBAR(); float sacc = (P0[0] + P0[1]); \
    GAPA8(C0 = MF8(kf[0], qr[0], f32x16{}), P0[2], P0[3], P0[4], P0[5], P0[6], P0[7], P0[8], P0[9],         pw0[0] = PKW(P0, 0), pw0[1] = PKW(P0, 2), pw0[2] = PKW(P0, 4), pw0[3] = PKW(P0, 6), pw0, pw0); \
    VRD(1); VRD(5); SBAR(); \
    GAPA8(C1 = MF8(kf[2], qr[0], f32x16{}), P0[10], P0[11], P0[12], P0[13], P0[14], P0[15], P1[0], P1[1],   pw1[0] = PKW(P0, 8), pw1[1] = PKW(P0, 10), pw1[2] = PKW(P0, 12), pw1[3] = PKW(P0, 14), pw1, pw1); \
    VRD(2); VRD(6); SBAR(); \
    GAPA8(C0 = MF8(kf[1], qr[1], C0),       P1[2], P1[3], P1[4], P1[5], P1[6], P1[7], P1[8], P1[9],         pw2[0] = PKW(P1, 0), pw2[1] = PKW(P1, 2), pw2[2] = PKW(P1, 4), pw2[3] = PKW(P1, 6), pw2, pw2); \
    VRD(3); VRD(7); SBAR(); \
    GAPA8(C1 = MF8(kf[3], qr[1], C1),       P1[10], P1[11], P1[12], P1[13], P1[14], P1[15], 0.f, 0.f,       pw3[0] = PKW(P1, 8), pw3[1] = PKW(P1, 10), pw3[2] = PKW(P1, 12), pw3[3] = PKW(P1, 14), pw3, pw3); \
    l_reg += sacc; \
    if (GK) { DMA_K((t) + 3, si_cur * KSLOT); } if (GV) { DMA_V((t) + 1, si_next * VSLOT); } \
    SBAR(); \
    GAPB(o[0] = MF(PAF(0), VFR(0), o[0]), C0, 0); \
    GAPB(o[1] = MF(PAF(0), VFR(4), o[1]), C0, 4); \
    KRD(GL, 0); GAPB(o[0] = MF(PAF(1), VFR(1), o[0]), C0, 8); \
    KRD(GL, 1); GAPB(o[1] = MF(PAF(1), VFR(5), o[1]), C0, 12); \
    KRD(GL, 2); GAPB(o[0] = MF(PAF(2), VFR(2), o[0]), C1, 0); \
    KRD(GL, 3); GAPB(o[1] = MF(PAF(2), VFR(6), o[1]), C1, 4); \
    GAPB(o[0] = MF(PAF(3), VFR(3), o[0]), C1, 8); \
    GAPB(o[1] = MF(PAF(3), VFR(7), o[1]), C1, 12); \
    } while (0)
    int t = 1;
    for (; t + 5 < NT; t += 2) {
        STEP(pB0, pB1, pA0, pA1, t, true, true, true);     WAIT_BAR(2); ROT();
        STEP(pA0, pA1, pB0, pB1, t + 1, true, true, true); WAIT_BAR(2); ROT();
    }
#define ENDW(tt) do { if ((tt) + 3 < NT) { WAIT_BAR(2); } else if ((tt) + 2 < NT) { WAIT_BAR(1); } else { WAIT_BAR(0); } } while (0)
    for (; t + 1 < NT; t += 2) {
        STEP(pB0, pB1, pA0, pA1, t, (t + 3 < NT), (t + 1 < NT), (t + 1 < NT));         ENDW(t);     ROT();
        STEP(pA0, pA1, pB0, pB1, t + 1, (t + 4 < NT), (t + 2 < NT), (t + 2 < NT));     ENDW(t + 1); ROT();
    }
    STEP(pB0, pB1, pA0, pA1, NT - 1, false, false, false);
    { float sacc = pB0[0] + pB0[1];
#pragma unroll
      for (int r = 2; r < 16; ++r) sacc += pB0[r];
#pragma unroll
      for (int r = 0; r < 16; ++r) sacc += pB1[r];
      l_reg += sacc;
      pw0 = (u32x4){PKW(pB0, 0), PKW(pB0, 2), PKW(pB0, 4), PKW(pB0, 6)}; pw1 = (u32x4){PKW(pB0, 8), PKW(pB0, 10), PKW(pB0, 12), PKW(pB0, 14)};
      pw2 = (u32x4){PKW(pB1, 0), PKW(pB1, 2), PKW(pB1, 4), PKW(pB1, 6)}; pw3 = (u32x4){PKW(pB1, 8), PKW(pB1, 10), PKW(pB1, 12), PKW(pB1, 14)};
      SBAR();
      const lds_cptr vp_ = vp0 + si_cur * VSLOT;
#pragma unroll
      for (int d0 = 0; d0 < 2; ++d0) {
          s16x4 lo4[4], hi4[4];
#pragma unroll
          for (int ks = 0; ks < 4; ++ks) { lo4[ks] = vtr(vp_ + d0 * 4096 + ks * 1024); hi4[ks] = vtr(vp_ + d0 * 4096 + ks * 1024 + 512); }
#define PK4(k) (bf16x8){lo4[k][0], lo4[k][1], lo4[k][2], lo4[k][3], hi4[k][0], hi4[k][1], hi4[k][2], hi4[k][3]}
          o[d0] = MF(PAF(0), PK4(0), o[d0]); o[d0] = MF(PAF(1), PK4(1), o[d0]); o[d0] = MF(PAF(2), PK4(2), o[d0]); o[d0] = MF(PAF(3), PK4(3), o[d0]);
#undef PK4
      } }
    l_reg = swapsum(l_reg);
    if (hi == 0) wsf[32 + r32] = l_reg;
    asm volatile("s_waitcnt lgkmcnt(0)" ::: "memory");
    float rli[16];
#pragma unroll
    for (int r = 0; r < 16; ++r) rli[r] = __builtin_amdgcn_rcpf(wsf[32 + crow(r, hi)]);
    bf16_t* Ow = O + (rowbase + q0 + wid * QBLK) * 512 + h * 64;
    { LAS bf16_t* stg = (LAS bf16_t*)(shm + LDS_OST) + wid * 2048;
#pragma unroll
      for (int r = 0; r < 16; ++r) { const int orow = crow(r, hi);
#pragma unroll
          for (int d0 = 0; d0 < 2; ++d0) stg[orow * 64 + d0 * 32 + r32] = (bf16_t)f2bf(o[d0][r] * rli[r]); }
      asm volatile("s_waitcnt lgkmcnt(0)" ::: "memory");
#pragma unroll
      for (int i = 0; i < 4; ++i) { const int row = i * 8 + (lane >> 3), ch = lane & 7; const u32x4 v = *(const LAS u32x4*)(stg + row * 64 + ch * 8); *(u32x4*)(Ow + (long)row * 512 + ch * 8) = v; } }
    asm volatile("s_waitcnt lgkmcnt(0)\n\ts_barrier" ::: "memory");
#undef DMA_K
#undef DMA_V
#undef ROT
#undef PKW
#undef PAF
#undef VFR
#undef PIN
#undef MF
#undef GAPA
#undef GAPA8
#undef GAPM
#undef GAPB
#undef EX
#undef VRD
#undef KRD
#undef STEP
#undef ENDW
}
#undef SBAR
#undef WAIT_BAR
#undef MF8
}

template <bool F8, class CM> __device__ __forceinline__ void tr_item(const float* W, int ld, const float* rs, bf16_t* WT, int K, int k0, int n0, const CM& cm, LAS float* scr, int lane) {
    const int n = lane & 31, sc = cm.col(n0 + n); const float cs = cm.scale(n0 + n);
#pragma unroll 8
    for (int i = 0; i < 32; ++i) { const int kk = 2 * i + (lane >> 5); float v = 0.f; if (sc >= 0) v = W[(size_t)(k0 + kk) * ld + sc] * cs * (rs ? rs[k0 + kk] : 1.f); scr[kk * 33 + n] = v; }
    asm volatile("s_waitcnt lgkmcnt(0)" ::: "memory");
    const int c = lane & 7;
#pragma unroll
    for (int j = 0; j < 4; ++j) { const int nn = (lane >> 3) + 8 * j; const LAS float* s = scr + (8 * c) * 33 + nn;
        if constexpr (F8) { *(u32x2*)((unsigned char*)WT + (size_t)(n0 + nn) * K + k0 + 8 * c) = (u32x2){pack4_fp8(s[0 * 33], s[1 * 33], s[2 * 33], s[3 * 33]), pack4_fp8(s[4 * 33], s[5 * 33], s[6 * 33], s[7 * 33])}; }
        else { u32x4 o; o.x = pk2(s[0 * 33], s[1 * 33]); o.y = pk2(s[2 * 33], s[3 * 33]); o.z = pk2(s[4 * 33], s[5 * 33]); o.w = pk2(s[6 * 33], s[7 * 33]);
        *(u32x4*)(WT + (size_t)(n0 + nn) * K + k0 + 8 * c) = o; } }
    asm volatile("s_waitcnt lgkmcnt(0)" ::: "memory");
}
template <class CM> __device__ __forceinline__ void tr4_load(f32x4 (&v)[8], const float* W, int ld, int k0, int n0, const CM& cm, int lane) {
    const int n4 = (lane & 7) * 4, sc = cm.col(n0 + n4);
#pragma unroll
    for (int i = 0; i < 8; ++i) { const int kk = (lane >> 3) + 8 * i; v[i] = (sc >= 0) ? *(const f32x4*)(W + (size_t)(k0 + kk) * ld + sc) : (f32x4){0.f, 0.f, 0.f, 0.f}; }
}
template <bool F8, class CM> __device__ __forceinline__ void tr4_finish(const f32x4 (&v)[8], const float* rs, bf16_t* WT, int K, int k0, int n0, const CM& cm, LAS float* scr, int lane) {
    const int n4 = (lane & 7) * 4; const float cs = cm.scale(n0 + n4);
#pragma unroll
    for (int i = 0; i < 8; ++i) { const int kk = (lane >> 3) + 8 * i; const float r = cs * (rs ? rs[k0 + kk] : 1.f); LAS float* d = scr + kk * 33 + n4; d[0] = v[i].x * r; d[1] = v[i].y * r; d[2] = v[i].z * r; d[3] = v[i].w * r; }
    asm volatile("s_waitcnt lgkmcnt(0)" ::: "memory");
    const int c = lane & 7;
#pragma unroll
    for (int j = 0; j < 4; ++j) { const int nn = (lane >> 3) + 8 * j; const LAS float* s = scr + (8 * c) * 33 + nn;
        if constexpr (F8) { *(u32x2*)((unsigned char*)WT + (size_t)(n0 + nn) * K + k0 + 8 * c) = (u32x2){pack4_fp8(s[0 * 33], s[1 * 33], s[2 * 33], s[3 * 33]), pack4_fp8(s[4 * 33], s[5 * 33], s[6 * 33], s[7 * 33])}; }
        else { u32x4 o; o.x = pk2(s[0 * 33], s[1 * 33]); o.y = pk2(s[2 * 33], s[3 * 33]); o.z = pk2(s[4 * 33], s[5 * 33]); o.w = pk2(s[6 * 33], s[7 * 33]);
        *(u32x4*)(WT + (size_t)(n0 + nn) * K + k0 + 8 * c) = o; } }
    asm volatile("s_waitcnt lgkmcnt(0)" ::: "memory");
}
template <bool F8, class CM> __device__ __forceinline__ void tr_item4(const float* W, int ld, const float* rs, bf16_t* WT, int K, int k0, int n0, const CM& cm, LAS float* scr, int lane) {
    f32x4 v[8]; tr4_load(v, W, ld, k0, n0, cm, lane); tr4_finish<F8>(v, rs, WT, K, k0, n0, cm, scr, lane);
}
struct CmIn {
    __device__ __forceinline__ int col(int n) const {
        if (n < 1920) return n;
        if (n < 1952) { const int j = n - 1920, i = j >> 1; return 1920 + ((j & 1) ? i + 16 : i); }
        if (n < 2048) return -1;
        if (n < 3072) return 1952 + (n - 2048);
        return 2976 + (n - 3072);
    }
    __device__ __forceinline__ float scale(int n) const { return n < 512 ? 0.125f * LOG2E : 1.f; }
    __device__ __forceinline__ bool regular(int n0) const { return n0 < 1920 || n0 >= 1952; }
};
struct CmUq {
    __device__ __forceinline__ int col(int n) const { const int h = n / 96, w = n % 96; if (w < 64) return n; const int j = w - 64, i = j >> 1; return h * 96 + 64 + ((j & 1) ? i + 16 : i); }
    __device__ __forceinline__ float scale(int) const { return 0.10206207261596577f * LOG2E; }
    __device__ __forceinline__ bool regular(int n0) const { return (n0 % 96) < 64; }
};
struct CmId64 { __device__ __forceinline__ int col(int n) const { return n; } __device__ __forceinline__ float scale(int) const { return 64.f; } __device__ __forceinline__ bool regular(int) const { return true; } };
struct CmId { int off; __device__ __forceinline__ int col(int n) const { return n - off; } __device__ __forceinline__ float scale(int) const { return 1.f; } __device__ __forceinline__ bool regular(int) const { return true; } };
struct CmGu {
    __device__ __forceinline__ int col(int n) const { const int pn = n >> 8, w = n & 255; return w < 128 ? 128 * pn + w : 1024 + 128 * pn + (w - 128); }
    __device__ __forceinline__ float scale(int) const { return 64.f; }
    __device__ __forceinline__ bool regular(int) const { return true; }
};
template <class CM, bool F8 = false> __device__ __forceinline__ void tr_any(const float* W, int ld, const float* rs, bf16_t* WT, int K, int k0, int n0, const CM& cm, LAS float* scr, int lane) {
    if (cm.regular(n0)) tr_item4<F8>(W, ld, rs, WT, K, k0, n0, cm, scr, lane); else tr_item<F8>(W, ld, rs, WT, K, k0, n0, cm, scr, lane);
}

struct Args { const float* in[19]; float* out; unsigned char* ws; int ph_lo, ph_hi, li, pad; };

__device__ __forceinline__ void p0_prologue(const Args& a, LAS unsigned char* lds, int wave, int lane) {
    LAS float* scr = (LAS float*)(lds + wave * 16384);
    const int gw = blockIdx.x * NWAVES + wave, NGW = gridDim.x * NWAVES;
    unsigned char* ws = a.ws;
    constexpr int I_IN = 16 * 128, I_UQ = 4 * 24, I_UK = 2 * 16, I_UV = 2 * 16, I_A = 8 * 32, I_B = 8 * 32, I_O = 16 * 32, I_GU = 32 * 16 * 64, I_D = 32 * 16 * 32;
    constexpr int NITEMS = I_IN + I_UQ + I_UK + I_UV + I_A + I_B + I_O;
    for (int it = gw; it < NITEMS; it += NGW) {
        int r = it;
        if (r < I_IN) { tr_any(a.in[2], 4000, a.in[1], (bf16_t*)(ws + WS_WIN), 1024, 64 * (r / 128), 32 * (r % 128), CmIn{}, scr, lane); continue; } r -= I_IN;
        if (r < I_UQ) { tr_any(a.in[5], 768, a.in[3], (bf16_t*)(ws + WS_WUQ), 256, 64 * (r / 24), 32 * (r % 24), CmUq{}, scr, lane); continue; } r -= I_UQ;
        if (r < I_UK) { tr_any(a.in[6], 512, a.in[4], (bf16_t*)(ws + WS_WUKV), 128, 64 * (r / 16), 32 * (r % 16), CmId{0}, scr, lane); continue; } r -= I_UK;
        if (r < I_UV) { tr_any(a.in[7], 512, a.in[4], (bf16_t*)(ws + WS_WUKV), 128, 64 * (r / 16), 512 + 32 * (r % 16), CmId{512}, scr, lane); continue; } r -= I_UV;
        if (r < I_A) { tr_any(a.in[8], 1024, nullptr, (bf16_t*)(ws + WS_WA), 512, 64 * (r / 32), 32 * (r % 32), CmId{0}, scr, lane); continue; } r -= I_A;
        if (r < I_B) { tr_any(a.in[9], 1024, nullptr, (bf16_t*)(ws + WS_WB), 512, 64 * (r / 32), 32 * (r % 32), CmId{0}, scr, lane); continue; } r -= I_B;
        tr_any(a.in[10], 1024, nullptr, (bf16_t*)(ws + WS_WO), 1024, 64 * (r / 32), 32 * (r % 32), CmId{0}, scr, lane);
    }
    {   f32x4 va[8], vb[8];
#define GU_LOAD(v, r) tr4_load(v, a.in[14] + (size_t)((r) / 1024) * 1024 * 2048, 2048, 64 * (((r) % 1024) / 64), 32 * ((r) % 64), CmGu{}, lane)
#define GU_FIN(v, r) tr4_finish<true>(v, a.in[11], (bf16_t*)(ws + WS_WGU + (size_t)((r) / 1024) * 2048 * 1024), 1024, 64 * (((r) % 1024) / 64), 32 * ((r) % 64), CmGu{}, scr, lane)
        int r = gw; if (r < I_GU) GU_LOAD(va, r);
        for (; r < I_GU; r += 2 * NGW) {
            if (r + NGW < I_GU) GU_LOAD(vb, r + NGW);
            GU_FIN(va, r);
            if (r + NGW < I_GU) { if (r + 2 * NGW < I_GU) GU_LOAD(va, r + 2 * NGW); GU_FIN(vb, r + NGW); }
        }
#undef GU_LOAD
#undef GU_FIN
#define D_LOAD(v, r) tr4_load(v, a.in[16] + (size_t)((r) / 512) * 1024 * 1024, 1024, 64 * (((r) % 512) / 32), 32 * ((r) % 32), CmId64{}, lane)
#define D_FIN(v, r) tr4_finish<true>(v, nullptr, (bf16_t*)(ws + WS_WD + (size_t)((r) / 512) * 1024 * 1024), 1024, 64 * (((r) % 512) / 32), 32 * ((r) % 32), CmId64{}, scr, lane)
        r = gw; if (r < I_D) D_LOAD(va, r);
        for (; r < I_D; r += 2 * NGW) {
            if (r + NGW < I_D) D_LOAD(vb, r + NGW);
            D_FIN(va, r);
            if (r + NGW < I_D) { if (r + 2 * NGW < I_D) D_LOAD(va, r + 2 * NGW); D_FIN(vb, r + NGW); }
        }
#undef D_LOAD
#undef D_FIN
    }
    for (int m = gw; m < T; m += NGW) {
        const f32x4* xr = (const f32x4*)(a.in[0] + (size_t)m * DM) + lane;
        f32x4 v[4]; float s2 = 0.f;
#pragma unroll
        for (int j = 0; j < 4; ++j) { v[j] = xr[64 * j]; s2 += (v[j].x * v[j].x + v[j].y * v[j].y) + (v[j].z * v[j].z + v[j].w * v[j].w); }
        const float rstd = 1.f / sqrtf(wave_sum(s2) * (1.f / DM) + EPS);
        u32x2* o8 = (u32x2*)((bf16_t*)(ws + WS_XB) + (size_t)m * DM) + lane;
#pragma unroll
        for (int j = 0; j < 4; ++j) o8[64 * j] = (u32x2){pk2(v[j].x * rstd, v[j].y * rstd), pk2(v[j].z * rstd, v[j].w * rstd)};
    }
    const int gt = blockIdx.x * NTHREADS + threadIdx.x, NGT = gridDim.x * NTHREADS;
    for (int idx = gt; idx < SEQ * 16; idx += NGT) {
        ((f32x2*)(ws + WS_ROPE))[idx] = rope_cs(idx >> 4, idx & 15);
    }
    for (int idx = gt; idx < 1024 * 32; idx += NGT) ((float*)(ws + WS_WRP))[idx] = a.in[12][idx] * a.in[11][idx >> 5];
}

__device__ __forceinline__ void p2_stats(const Args& a, int wave, int lane) {
    const int gw = blockIdx.x * NWAVES + wave, NGW = gridDim.x * NWAVES; unsigned char* ws = a.ws;
    for (int m = gw; m < T; m += NGW) {
        const u32x2 q = ((const u32x2*)((const bf16_t*)(ws + WS_CQ) + (size_t)m * 256))[lane];
        const unsigned kv = ((const unsigned*)((const bf16_t*)(ws + WS_CKV) + (size_t)m * 128))[lane];
        const float a0 = bflo(q.x), a1 = bfhi(q.x), a2 = bflo(q.y), a3 = bfhi(q.y), b0 = bflo(kv), b1 = bfhi(kv);
        const float sq = wave_sum((a0 * a0 + a1 * a1) + (a2 * a2 + a3 * a3)), sk = wave_sum(b0 * b0 + b1 * b1);
        if (lane == 0) { ((float*)(ws + WS_RSTDQ))[m] = 1.f / sqrtf(sq * (1.f / 256.f) + EPS); ((float*)(ws + WS_RSTDKV))[m] = 1.f / sqrtf(sk * (1.f / 128.f) + EPS); }
        if (lane < 32) { const int b = m >> 14, sq2 = m & (SEQ - 1); const u32x4 kr = *(const u32x4*)((const bf16_t*)(ws + WS_KR) + (size_t)m * 32 + 8 * (lane & 3));
            *(u32x4*)((bf16_t*)(ws + WS_KIMG) + (size_t)((b * 8 + (lane >> 2)) * 256 + (sq2 >> 6)) * 6144 + (8 + (lane & 3)) * 512 + (sq2 & 63) * 8) = kr; }
        if (lane < 16) { const int b = m >> 14, sq2 = m & (SEQ - 1); const bf16_t* kp = (const bf16_t*)(ws + WS_KR) + (size_t)m * 32 + 16 * (lane & 1);
            float k0[8], k1[8]; unpack8(*(const u32x4*)kp, k0); unpack8(*(const u32x4*)(kp + 8), k1);
            *(u32x4*)(ws + WS_K8 + (size_t)((b * 8 + (lane >> 1)) * 256 + (sq2 >> 6)) * 6144 + (4 + (lane & 1)) * 1024 + (sq2 & 63) * 16) =
                (u32x4){pack4_fp8(k0[0], k0[1], k0[2], k0[3]), pack4_fp8(k0[4], k0[5], k0[6], k0[7]), pack4_fp8(k1[0], k1[1], k1[2], k1[3]), pack4_fp8(k1[4], k1[5], k1[6], k1[7])}; }
    }
}

__device__ __forceinline__ void p4_dilated(const Args& a, LAS unsigned char* lds, volatile LAS unsigned* MISC, int wave, int lane) {
    unsigned char* ws = a.ws;
    const int r32 = lane & 31, hi = lane >> 5;
    {
        LAS unsigned* nm = (LAS unsigned*)(MISC + MI_NRM);
        if (threadIdx.x < 32) nm[threadIdx.x] = 0u;
        __syncthreads();
        const bf16_t* QB = (const bf16_t*)(ws + WS_QB); const bf16_t* KIM = (const bf16_t*)(ws + WS_KIMG); const bf16_t* KR = (const bf16_t*)(ws + WS_KR);
        const int gw = blockIdx.x * NWAVES + wave, NGW = gridDim.x * NWAVES;
        for (int t = gw; t < T; t += NGW) {
            const int b = t >> 14;
            const u32x2* qp = (const u32x2*)(QB + (size_t)t * 768 + 12 * lane);
            const u32x2 q0 = qp[0], q1 = qp[1], q2 = qp[2];
            float sq = (bflo(q0.x) * bflo(q0.x) + bfhi(q0.x) * bfhi(q0.x)) + (bflo(q0.y) * bflo(q0.y) + bfhi(q0.y) * bfhi(q0.y));
            sq += (bflo(q1.x) * bflo(q1.x) + bfhi(q1.x) * bfhi(q1.x)) + (bflo(q1.y) * bflo(q1.y) + bfhi(q1.y) * bfhi(q1.y));
            sq += (bflo(q2.x) * bflo(q2.x) + bfhi(q2.x) * bfhi(q2.x)) + (bflo(q2.y) * bflo(q2.y) + bfhi(q2.y) * bfhi(q2.y));
            float kk8[8]; unpack8(*(const u32x4*)(KIM + (size_t)((b * 8 + (lane >> 3)) * 256 + ((t & (SEQ - 1)) >> 6)) * 6144 + (lane & 7) * 512 + (t & 63) * 8), kk8);
            float sk = 0.f;
#pragma unroll
            for (int j = 0; j < 8; ++j) sk += kk8[j] * kk8[j];
            float kr8[8]; unpack8(*(const u32x4*)(KR + (size_t)t * 32 + 8 * (lane & 3)), kr8);
            float sr = 0.f;
#pragma unroll
            for (int j = 0; j < 8; ++j) sr += kr8[j] * kr8[j];
            sr += __shfl_xor(sr, 1); sr += __shfl_xor(sr, 2);
            sq += __shfl_xor(sq, 1); sq += __shfl_xor(sq, 2); sq += __shfl_xor(sq, 4);
            sk += __shfl_xor(sk, 1); sk += __shfl_xor(sk, 2); sk += __shfl_xor(sk, 4);
            sk += sr;
            if ((lane & 7) == 0) { const int hh = lane >> 3;
                __hip_atomic_fetch_max(&nm[b * 8 + hh], __float_as_uint(sq), __ATOMIC_RELAXED, __HIP_MEMORY_SCOPE_WORKGROUP);
                __hip_atomic_fetch_max(&nm[16 + b * 8 + hh], __float_as_uint(sk), __ATOMIC_RELAXED, __HIP_MEMORY_SCOPE_WORKGROUP); }
        }
        __syncthreads();
        if (threadIdx.x < 32) __hip_atomic_fetch_max((unsigned*)(ws + WS_CTL) + CW_NRM + threadIdx.x, nm[threadIdx.x], __ATOMIC_RELAXED, __HIP_MEMORY_SCOPE_AGENT);
    }
    __syncthreads();
    const bf16_t* QA = (const bf16_t*)(ws + WS_QA); const bf16_t* KA = (const bf16_t*)(ws + WS_KA); const bf16_t* VA = (const bf16_t*)(ws + WS_VA);
    bf16_t* PO = (bf16_t*)(ws + WS_PARTO); float* PL = (float*)(ws + WS_PARTL);
    constexpr int DK = 0, DV = 49152, DWS = 98304;
    const unsigned lds0 = (unsigned)(uintptr_t)lds;
    LAS float* wsf = (LAS float*)(lds + DWS) + wave * 64;
    for (int un = blockIdx.x; un < NB * 8 * 192; un += gridDim.x) {
        const int bh = un / 192, within = un % 192, b = bh >> 3, h = bh & 7;
        int p, dil, res, blk, L;
        if (within < 64) { p = 0; dil = 1; res = 0; blk = within; L = SEQ; }
        else if (within < 128) { p = 1; dil = 4; res = (within - 64) >> 4; blk = (within - 64) & 15; L = SEQ / 4; }
        else { p = 2; dil = 16; res = (within - 128) >> 2; blk = (within - 128) & 3; L = SEQ / 16; }
        const size_t bo = (size_t)b * SEQ; const int u0w = 256 * blk - 64;
#pragma unroll
        for (int j = 0; j < 6; ++j) {
            int uk = u0w + 64 * j + lane; uk = uk < 0 ? 0 : (uk >= L ? L - 1 : uk);
            mla::glds16(KA + (bo + (size_t)(res + dil * uk)) * 512 + h * 64 + wave * 8, (unsigned)__builtin_amdgcn_readfirstlane(lds0 + DK + j * 8192 + wave * 1024));
            int uv = u0w + 64 * j + 16 * (wave & 3) + (lane >> 2); uv = uv < 0 ? 0 : (uv >= L ? L - 1 : uv);
            mla::glds16(VA + (bo + (size_t)(res + dil * uv)) * 512 + h * 64 + (wave >> 2) * 32 + (lane & 3) * 8, (unsigned)__builtin_amdgcn_readfirstlane(lds0 + DV + j * 8192 + wave * 1024));
        }
        const int ur = 256 * blk + 32 * wave;
        const size_t tq = bo + (size_t)(res + dil * (ur + r32));
        bf16x8 qf[4];
#pragma unroll
        for (int d0 = 0; d0 < 4; ++d0) qf[d0] = *(const bf16x8*)(QA + tq * 512 + h * 64 + 16 * d0 + 8 * hi);
        const float slope2d = __builtin_amdgcn_exp2f(-(float)(h + 1)) * LOG2E * (float)dil;
        asm volatile("s_waitcnt vmcnt(0)\n\ts_barrier" ::: "memory");
        f32x16 o0 = {}, o1 = {}; float m_run = -1e30f, l_run = 0.f;
#pragma unroll 1
        for (int ci = 0; ci < 5; ++ci) {
            const int c = ci == 0 ? 2 : ci == 1 ? 1 : ci == 2 ? 3 : ci == 3 ? 0 : 4;
            const int cw = wave + c, j = cw >> 1, n = cw & 1;
            const LAS char* kp = (const LAS char*)lds + DK + j * 8192 + hi * 1024 + (32 * n + r32) * 16;
            f32x16 s = {};
#pragma unroll
            for (int d0 = 0; d0 < 4; ++d0) s = __builtin_amdgcn_mfma_f32_32x32x16_bf16(*(const LAS bf16x8*)(kp + d0 * 2048), qf[d0], s, 0, 0, 0);
            { const float c0 = (float)(32 * c - 64); const int vb = ur - 64 + 32 * c;
#pragma unroll
              for (int r = 0; r < 16; ++r) { const float d = (float)(crow(r, hi) - r32); s[r] = s[r] - slope2d * fabsf(d + c0); }
              if (c == 0) {
#pragma unroll
                  for (int r = 0; r < 16; ++r) s[r] = (crow(r, hi) >= r32) ? s[r] : -1e30f; }
              if (c == 4) {
#pragma unroll
                  for (int r = 0; r < 16; ++r) s[r] = (crow(r, hi) <= r32) ? s[r] : -1e30f; }
              if (vb < 0 || vb + 31 >= L) {
#pragma unroll
                  for (int r = 0; r < 16; ++r) { const int v = vb + crow(r, hi); s[r] = (v >= 0 && v < L) ? s[r] : -1e30f; } } }
            float mx = s[0];
#pragma unroll
            for (int r = 1; r < 16; ++r) mx = fmaxf(mx, s[r]);
            mx = swapmax(mx);
            const float mn = fmaxf(m_run, mx), alpha = fexp2(m_run - mn);
            float ps = 0.f;
#pragma unroll
            for (int r = 0; r < 16; ++r) { s[r] = fexp2(s[r] - mn); ps += s[r]; }
            l_run = l_run * alpha + ps; m_run = mn;
            if (__any(alpha != 1.f)) {
                if (hi == 0) wsf[r32] = alpha;
#pragma unroll
                for (int r = 0; r < 16; ++r) { const float al = wsf[crow(r, hi)]; o0[r] *= al; o1[r] *= al; }
            }
            const u32x4 pw0 = {cvtpk(s[0], s[1]), cvtpk(s[2], s[3]), cvtpk(s[4], s[5]), cvtpk(s[6], s[7])};
            const u32x4 pw1 = {cvtpk(s[8], s[9]), cvtpk(s[10], s[11]), cvtpk(s[12], s[13]), cvtpk(s[14], s[15])};
            const bf16x8 pa0 = __builtin_bit_cast(bf16x8, pw0), pa1 = __builtin_bit_cast(bf16x8, pw1);
            const LAS char* vp = (const LAS char*)lds + DV + j * 8192 + n * 2048 + ((lane >> 4) & 1) * 32 + (lane & 3) * 8 + (4 * hi + ((lane & 15) >> 2)) * 64;
#pragma unroll
            for (int ks = 0; ks < 2; ++ks) {
                const s16x4 l0 = vtr(vp + ks * 1024), h0 = vtr(vp + ks * 1024 + 512), l1 = vtr(vp + 4096 + ks * 1024), h1 = vtr(vp + 4096 + ks * 1024 + 512);
                const bf16x8 v0 = {l0[0], l0[1], l0[2], l0[3], h0[0], h0[1], h0[2], h0[3]}, v1 = {l1[0], l1[1], l1[2], l1[3], h1[0], h1[1], h1[2], h1[3]};
                o0 = __builtin_amdgcn_mfma_f32_32x32x16_bf16(ks == 0 ? pa0 : pa1, v0, o0, 0, 0, 0);
                o1 = __builtin_amdgcn_mfma_f32_32x32x16_bf16(ks == 0 ? pa0 : pa1, v1, o1, 0, 0, 0);
            }
        }
        const float lt = swapsum(l_run);
        if (hi == 0) { wsf[32 + r32] = lt; PL[(((size_t)p * NB + b) * 8 + h) * SEQ + (res + dil * (ur + r32))] = m_run + __builtin_amdgcn_logf(lt); }
        asm volatile("s_waitcnt lgkmcnt(0)\n\ts_barrier" ::: "memory");
        { LAS bf16_t* stg = (LAS bf16_t*)(lds + DK) + wave * 2048;
#pragma unroll
          for (int r = 0; r < 16; ++r) { const int q = crow(r, hi); const float il = frcp(wsf[32 + q]);
              stg[q * 64 + r32] = (bf16_t)f2bf(o0[r] * il); stg[q * 64 + 32 + r32] = (bf16_t)f2bf(o1[r] * il); }
#pragma unroll
          for (int i = 0; i < 4; ++i) { const int row = i * 8 + (lane >> 3), ch = lane & 7; const u32x4 v = *(const LAS u32x4*)(stg + row * 64 + ch * 8);
              *(u32x4*)(PO + ((size_t)p * T + bo + (size_t)(res + dil * (ur + row))) * 512 + h * 64 + ch * 8) = v; } }
        asm volatile("s_waitcnt lgkmcnt(0)\n\ts_barrier" ::: "memory");
    }
}
__device__ __forceinline__ void p5_combine(const Args& a, int wave, int lane) {
    unsigned char* ws = a.ws; const bf16_t* PO = (const bf16_t*)(ws + WS_PARTO); const float* PL = (const float*)(ws + WS_PARTL); bf16_t* OA = (bf16_t*)(ws + WS_OA);
    const int gw = blockIdx.x * NWAVES + wave, NGW = gridDim.x * NWAVES;
    for (int it = gw; it < T; it += NGW) {
        const int t = it, b = t >> 14, s = t & (SEQ - 1), h = lane >> 3, ch = lane & 7;
        const float l0 = PL[(((size_t)0 * NB + b) * 8 + h) * SEQ + s], l1 = PL[(((size_t)1 * NB + b) * 8 + h) * SEQ + s], l2 = PL[(((size_t)2 * NB + b) * 8 + h) * SEQ + s];
        const float mx = fmaxf(fmaxf(l0, l1), l2); float w0 = fexp2(l0 - mx), w1 = fexp2(l1 - mx), w2 = fexp2(l2 - mx); const float iw = frcp(w0 + w1 + w2); w0 *= iw; w1 *= iw; w2 *= iw;
        float v0[8], v1[8], v2[8], o[8];
        unpack8(*(const u32x4*)(PO + ((size_t)0 * T + t) * 512 + h * 64 + ch * 8), v0);
        unpack8(*(const u32x4*)(PO + ((size_t)1 * T + t) * 512 + h * 64 + ch * 8), v1);
        unpack8(*(const u32x4*)(PO + ((size_t)2 * T + t) * 512 + h * 64 + ch * 8), v2);
#pragma unroll
        for (int j = 0; j < 8; ++j) o[j] = w0 * v0[j] + w1 * v1[j] + w2 * v2[j];
        *(u32x4*)(OA + (size_t)t * 512 + h * 64 + ch * 8) = pack8(o);
    }
}
__device__ __forceinline__ void p5_mla(const Args& a, LAS unsigned char* lds, int wave, int lane) {
    unsigned char* ws = a.ws;
    LAS char* vimg = (LAS char*)(lds + wave * 8192); LAS float* wsf = (LAS float*)(lds + wave * 8192 + 4096);
    const int r32 = lane & 31, hi = lane >> 5;
    const bf16_t* QB = (const bf16_t*)(ws + WS_QB); const bf16_t* KIM = (const bf16_t*)(ws + WS_KIMG); const bf16_t* VIM = (const bf16_t*)(ws + WS_VIMG);
    bf16_t* OB = (bf16_t*)(ws + WS_OB);
    const unsigned* nrm = (const unsigned*)(ws + WS_CTL) + CW_NRM;
    for (int un = blockIdx.x; un < NB * 8 * 64; un += gridDim.x) {
        const int qb = un & 63, h = (un >> 6) & 7, b = un >> 9;
        const float mq = __uint_as_float(__hip_atomic_load(nrm + b * 8 + h, __ATOMIC_RELAXED, __HIP_MEMORY_SCOPE_AGENT)), mk = __uint_as_float(__hip_atomic_load(nrm + 16 + b * 8 + h, __ATOMIC_RELAXED, __HIP_MEMORY_SCOPE_AGENT));
        bool fast = (mq * mk < 3600.f) && (mq < 700.f) && (mk < 160000.f);
#ifdef MLA_FORCE_GENERAL
        fast = false;
#endif
#ifdef MLA_BF16_FAST
        if (__builtin_amdgcn_readfirstlane((int)fast)) mla::mla_unit(b, h, qb, QB, KIM + (size_t)(b * 8 + h) * 256 * 6144, VIM + (size_t)(b * 8 + h) * 256 * 4096, OB, (LAS char*)lds);
#else
        if (__builtin_amdgcn_readfirstlane((int)fast)) mla8::mla8_unit(b, h, qb, (const unsigned char*)(ws + WS_Q8), (const unsigned char*)(ws + WS_K8) + (size_t)(b * 8 + h) * 256 * 6144, VIM + (size_t)(b * 8 + h) * 256 * 4096, OB, (LAS char*)lds);
#endif
    }
    for (int un = blockIdx.x; un < NB * 8 * 64; un += gridDim.x) {
        const int qb = un & 63, h = (un >> 6) & 7, b = un >> 9;
        const float mq = __uint_as_float(__hip_atomic_load(nrm + b * 8 + h, __ATOMIC_RELAXED, __HIP_MEMORY_SCOPE_AGENT)), mk = __uint_as_float(__hip_atomic_load(nrm + 16 + b * 8 + h, __ATOMIC_RELAXED, __HIP_MEMORY_SCOPE_AGENT));
        bool fast = (mq * mk < 3600.f) && (mq < 700.f) && (mk < 160000.f);
#ifdef MLA_FORCE_GENERAL
        fast = false;
#endif
        if (!__builtin_amdgcn_readfirstlane((int)fast)) {
            const size_t bo = (size_t)b * SEQ, tq0 = bo + (size_t)qb * 256 + wave * 32;
            MlaKL kl; kl.K = KIM + (size_t)(b * 8 + h) * 256 * 6144; kl.V = VIM + (size_t)(b * 8 + h) * 256 * 4096;
            bf16x8 qf[6];
#pragma unroll
            for (int d0 = 0; d0 < 6; ++d0) qf[d0] = *(const bf16x8*)(QB + (tq0 + r32) * 768 + h * 96 + 16 * d0 + 8 * hi);
            AttnState st; wave_attn<6>(st, qf, kl, SEQ / 32, vimg, wsf, lane);
            (void)attn_finish(st, vimg, wsf, lane);
#pragma unroll
            for (int i = 0; i < 4; ++i) { const int row = i * 8 + (lane >> 3), ch = lane & 7; const u32x4 v = *(const LAS u32x4*)(vimg + row * 128 + ch * 16);
                *(u32x4*)(OB + (tq0 + row) * 512 + h * 64 + ch * 8) = v; }
        }
    }
}

__device__ __forceinline__ void p8_router(const Args& a, LAS unsigned char* lds, volatile LAS unsigned* MISC, int wave, int lane) {
    unsigned char* ws = a.ws; const float* x1 = a.out; const float* wrp = (const float*)(ws + WS_WRP); const float* br = a.in[13];
    LAS float* lg = (LAS float*)(lds + wave * 8192);
    LAS unsigned* hist = (LAS unsigned*)(MISC + MI_HIST);
    if (threadIdx.x < 32) hist[threadIdx.x] = 0u;
    __syncthreads();
    const int G = gridDim.x, i32 = lane & 31, hi = lane >> 5;
    for (int tb = wave * G + blockIdx.x; tb < T / 32; tb += G * NWAVES) {
        const int t = tb * 32 + i32;
        const float* xr = x1 + (size_t)t * DM + 512 * hi; const float* wr_ = wrp + (size_t)(512 * hi) * 32 + i32;
        f32x16 acc = {}; float ssq = 0.f;
#pragma unroll 4
        for (int s4 = 0; s4 < 128; ++s4) {
            const f32x4 xa = *(const f32x4*)(xr + 4 * s4);
            ssq += (xa.x * xa.x + xa.y * xa.y) + (xa.z * xa.z + xa.w * xa.w);
            acc = __builtin_amdgcn_mfma_f32_32x32x2f32(xa.x, wr_[(4 * s4 + 0) * 32], acc, 0, 0, 0);
            acc = __builtin_amdgcn_mfma_f32_32x32x2f32(xa.y, wr_[(4 * s4 + 1) * 32], acc, 0, 0, 0);
            acc = __builtin_amdgcn_mfma_f32_32x32x2f32(xa.z, wr_[(4 * s4 + 2) * 32], acc, 0, 0, 0);
            acc = __builtin_amdgcn_mfma_f32_32x32x2f32(xa.w, wr_[(4 * s4 + 3) * 32], acc, 0, 0, 0);
        }
        ssq = swapsum(ssq);
        const float rstd = 1.f / sqrtf(ssq * (1.f / DM) + EPS);
#pragma unroll
        for (int r = 0; r < 16; ++r) lg[crow(r, hi) * 33 + i32] = acc[r];
        asm volatile("s_waitcnt lgkmcnt(0)" ::: "memory");
        float v[32];
#pragma unroll
        for (int e = 0; e < 32; ++e) v[e] = lg[i32 * 33 + e] * rstd + br[e];
        int ti[4]; float tv[4];
#pragma unroll
        for (int k = 0; k < 4; ++k) {
            float best = v[0]; int bi = 0;
#pragma unroll
            for (int e = 1; e < 32; ++e) { const bool g = v[e] > best; best = g ? v[e] : best; bi = g ? e : bi; }
            ti[k] = bi; tv[k] = best;
#pragma unroll
            for (int e = 0; e < 32; ++e) v[e] = (e == bi) ? -3.0e38f : v[e];
        }
        const float e1 = __expf(tv[1] - tv[0]), e2 = __expf(tv[2] - tv[0]), e3 = __expf(tv[3] - tv[0]); const float inv = 1.f / (1.f + e1 + e2 + e3);
        const float gw[4] = {inv, e1 * inv, e2 * inv, e3 * inv};
        if (hi == 0) {
            ((float*)(ws + WS_RSTD2))[t] = rstd;
#pragma unroll
            for (int k = 0; k < 4; ++k) { const unsigned rk = __hip_atomic_fetch_add(&hist[ti[k]], 1u, __ATOMIC_RELAXED, __HIP_MEMORY_SCOPE_WORKGROUP);
                ((int*)(ws + WS_TOPI))[t * 4 + k] = ti[k]; ((float*)(ws + WS_GATEW))[t * 4 + k] = gw[k]; ((int*)(ws + WS_SRANK))[t * 4 + k] = (int)rk; }
        }
        asm volatile("s_waitcnt lgkmcnt(0)" ::: "memory");
    }
    __syncthreads();
    if (threadIdx.x < 32) {
        const unsigned c = hist[threadIdx.x];
        const unsigned base = __hip_atomic_fetch_add((unsigned*)(ws + WS_CTL) + CW_GCOUNT + threadIdx.x, c, __ATOMIC_RELAXED, __HIP_MEMORY_SCOPE_AGENT);
        ((int*)(ws + WS_WGBASE))[blockIdx.x * 32 + threadIdx.x] = (int)base;
    }
}
__device__ __forceinline__ void moe_prefix(const Args& a, volatile LAS unsigned* MISC) {
    if (threadIdx.x < 64) {
        const unsigned* gc = (const unsigned*)(a.ws + WS_CTL) + CW_GCOUNT; const int e = threadIdx.x & 31;
        const int c = (int)__hip_atomic_load(gc + e, __ATOMIC_RELAXED, __HIP_MEMORY_SCOPE_AGENT), pad = (c + 255) & ~255;
        int inc = pad;
#pragma unroll
        for (int o = 1; o < 32; o <<= 1) { const int v = __shfl_up(inc, o, 32); if (e >= o) inc += v; }
        if (threadIdx.x < 32) { MISC[MI_PSTART + e] = (unsigned)(inc - pad); MISC[MI_TPRE + e] = (unsigned)((inc - pad) >> 8);
            if (e == 31) { MISC[MI_PSTART + 32] = (unsigned)inc; MISC[MI_TPRE + 32] = (unsigned)(inc >> 8); } }
    }
    __syncthreads();
}
__device__ __forceinline__ void p9_scatter(const Args& a, volatile LAS unsigned* MISC) {
    unsigned char* ws = a.ws; const int G = gridDim.x;
    moe_prefix(a, MISC);
    const int* topi = (const int*)(ws + WS_TOPI); const int* srank = (const int*)(ws + WS_SRANK); const int* wgbase = (const int*)(ws + WS_WGBASE); const float* rstd2 = (const float*)(ws + WS_RSTD2);
    int* pos = (int*)(ws + WS_POS); int* rowtok = (int*)(ws + WS_ROWTOK); float* rowscale = (float*)(ws + WS_ROWSCALE);
    for (int sl = blockIdx.x * NTHREADS + threadIdx.x; sl < NSLOT; sl += G * NTHREADS) {
        const int t = sl >> 2, e = topi[sl], wg = (t >> 5) % G;
        const int row = (int)MISC[MI_PSTART + e] + wgbase[wg * 32 + e] + srank[sl];
        pos[sl] = row; rowtok[row] = t; rowscale[row] = rstd2[t];
    }
    if (blockIdx.x < 32) {
        const int e = blockIdx.x; const int c = (int)__hip_atomic_load((const unsigned*)(ws + WS_CTL) + CW_GCOUNT + e, __ATOMIC_RELAXED, __HIP_MEMORY_SCOPE_AGENT);
        const int r0 = (int)MISC[MI_PSTART + e] + c, r1 = (int)MISC[MI_PSTART + e + 1];
        for (int r = r0 + threadIdx.x; r < r1; r += NTHREADS) { rowtok[r] = 0; rowscale[r] = 0.f; }
    }
}
__device__ __forceinline__ void p12_final(const Args& a, int wave, int lane) {
    unsigned char* ws = a.ws; const int gw = blockIdx.x * NWAVES + wave, NGW = gridDim.x * NWAVES;
    const int* pos = (const int*)(ws + WS_POS); const float* gatew = (const float*)(ws + WS_GATEW); const bf16_t* Y = (const bf16_t*)(ws + WS_Y);
    f32x4 g[4];
#pragma unroll
    for (int j = 0; j < 4; ++j) g[j] = ((const f32x4*)a.in[18])[lane + 64 * j];
    for (int t = gw; t < T; t += NGW) {
        f32x4* xr = (f32x4*)(a.out + (size_t)t * DM) + lane;
        f32x4 v[4];
#pragma unroll
        for (int j = 0; j < 4; ++j) v[j] = xr[64 * j];
#ifndef DBG_NO_MOE
#pragma unroll
        for (int k = 0; k < 4; ++k) {
            const int row = pos[t * 4 + k]; const float w = gatew[t * 4 + k];
            const u32x2* yr = (const u32x2*)(Y + (size_t)row * DM) + lane;
#pragma unroll
            for (int j = 0; j < 4; ++j) { const u32x2 y = yr[64 * j]; v[j].x += w * bflo(y.x); v[j].y += w * bfhi(y.x); v[j].z += w * bflo(y.y); v[j].w += w * bfhi(y.y); }
        }
#endif
        float s2 = 0.f;
#pragma unroll
        for (int j = 0; j < 4; ++j) s2 += (v[j].x * v[j].x + v[j].y * v[j].y) + (v[j].z * v[j].z + v[j].w * v[j].w);
        const float rstd = 1.f / sqrtf(wave_sum(s2) * (1.f / DM) + EPS);
#pragma unroll
        for (int j = 0; j < 4; ++j) xr[64 * j] = v[j] * rstd * g[j];
    }
}

#ifdef MLA_CHECK
constexpr size_t CK_BASE = 225 * MiB;
constexpr size_t CK_CKVN = CK_BASE, CK_KRR = CK_CKVN + (size_t)T * 128 * 4, CK_KN = CK_KRR + (size_t)T * 32 * 4, CK_VV = CK_KN + (size_t)T * 512 * 4, CK_QS = CK_VV + (size_t)T * 512 * 4;
constexpr int CK_NS = 16;
constexpr size_t CK_OBS = 224 * MiB;
__device__ __forceinline__ int ck_tok(int i) { const int tb[16] = {0, 1, 255, 256, 4097, 8191, 12345, 16383, 16384, 16385, 20000, 24575, 24576, 30001, 32766, 32767}; return tb[i]; }
__device__ __forceinline__ float blk_sum(float v, float* red) {
    v = wave_sum(v); __syncthreads(); if ((threadIdx.x & 63) == 0) red[threadIdx.x >> 6] = v; __syncthreads(); return red[0] + red[1] + red[2] + red[3];
}
__global__ void __launch_bounds__(256) ck_kv(const float* x, const float* g1, const float* w_in, const float* gkv, const float* w_uk, const float* w_uv, unsigned char* ws) {
    __shared__ float hn[1024]; __shared__ float red[4]; __shared__ float c[160]; __shared__ float cn[128];
    const int t = blockIdx.x, tid = threadIdx.x;
    float s2 = 0.f; for (int k = tid; k < 1024; k += 256) { const float v = x[(size_t)t * 1024 + k]; s2 += v * v; }
    const float rstd = 1.f / sqrtf(blk_sum(s2, red) / 1024.f + EPS);
    for (int k = tid; k < 1024; k += 256) hn[k] = x[(size_t)t * 1024 + k] * rstd * g1[k];
    __syncthreads();
    if (tid < 160) { float acc = 0.f; for (int k = 0; k < 1024; ++k) acc += hn[k] * w_in[(size_t)k * 4000 + 1792 + tid]; c[tid] = acc; }
    __syncthreads();
    const float q2 = blk_sum(tid < 128 ? c[tid] * c[tid] : 0.f, red); const float r2 = 1.f / sqrtf(q2 / 128.f + EPS);
    if (tid < 128) cn[tid] = c[tid] * r2 * gkv[tid];
    if (tid < 16) { const f32x2 cs = rope_cs(t & (SEQ - 1), tid); const float x1 = c[128 + tid], x2 = c[128 + 16 + tid];
        ((float*)(ws + CK_KRR))[(size_t)t * 32 + tid] = x1 * cs.x - x2 * cs.y; ((float*)(ws + CK_KRR))[(size_t)t * 32 + 16 + tid] = x2 * cs.x + x1 * cs.y; }
    __syncthreads();
    for (int o = tid; o < 512; o += 256) { float a = 0.f, b = 0.f; for (int k = 0; k < 128; ++k) { a += cn[k] * w_uk[(size_t)k * 512 + o]; b += cn[k] * w_uv[(size_t)k * 512 + o]; }
        ((float*)(ws + CK_KN))[(size_t)t * 512 + o] = a; ((float*)(ws + CK_VV))[(size_t)t * 512 + o] = b; }
}
__global__ void __launch_bounds__(256) ck_q(const float* x, const float* g1, const float* w_in, const float* gq, const float* w_uq, unsigned char* ws) {
    __shared__ float hn[1024]; __shared__ float red[4]; __shared__ float c[256]; __shared__ float qq[768];
    const int t = ck_tok(blockIdx.x), tid = threadIdx.x;
    float s2 = 0.f; for (int k = tid; k < 1024; k += 256) { const float v = x[(size_t)t * 1024 + k]; s2 += v * v; }
    const float rstd = 1.f / sqrtf(blk_sum(s2, red) / 1024.f + EPS);
    for (int k = tid; k < 1024; k += 256) hn[k] = x[(size_t)t * 1024 + k] * rstd * g1[k];
    __syncthreads();
    { float acc = 0.f; for (int k = 0; k < 1024; ++k) acc += hn[k] * w_in[(size_t)k * 4000 + 1536 + tid]; c[tid] = acc; }
    __syncthreads();
    const float q2 = blk_sum(c[tid] * c[tid], red); const float r2 = 1.f / sqrtf(q2 / 256.f + EPS);
    __syncthreads(); c[tid] = c[tid] * r2 * gq[tid]; __syncthreads();
    for (int o = tid; o < 768; o += 256) { float a = 0.f; for (int k = 0; k < 256; ++k) a += c[k] * w_uq[(size_t)k * 768 + o]; qq[o] = a; }
    __syncthreads();
    if (tid < 128) { const int hh = tid >> 4, i = tid & 15; const f32x2 cs = rope_cs(t & (SEQ - 1), i); const float x1 = qq[hh * 96 + 64 + i], x2 = qq[hh * 96 + 80 + i];
        qq[hh * 96 + 64 + i] = x1 * cs.x - x2 * cs.y; qq[hh * 96 + 80 + i] = x2 * cs.x + x1 * cs.y; }
    __syncthreads();
    for (int o = tid; o < 768; o += 256) ((float*)(ws + CK_QS))[(size_t)blockIdx.x * 768 + o] = qq[o] * 0.10206207261596577f;
}
__global__ void __launch_bounds__(256) ck_attn(unsigned char* ws, unsigned* flag) {
    __shared__ float q[96]; __shared__ float red[4]; __shared__ float part[256]; __shared__ float sc[SEQ];
    const int si = blockIdx.x >> 3, h = blockIdx.x & 7, t = ck_tok(si), b = t >> 14, tid = threadIdx.x;
    const float* KN = (const float*)(ws + CK_KN); const float* VV = (const float*)(ws + CK_VV); const float* KRR = (const float*)(ws + CK_KRR);
    if (tid < 96) q[tid] = ((const float*)(ws + CK_QS))[(size_t)si * 768 + h * 96 + tid];
    __syncthreads();
    float mx = -1e30f;
    for (int s = tid; s < SEQ; s += 256) { const size_t ts = (size_t)b * SEQ + s; float a = 0.f; for (int e = 0; e < 64; ++e) a += q[e] * KN[ts * 512 + h * 64 + e]; for (int e = 0; e < 32; ++e) a += q[64 + e] * KRR[ts * 32 + e]; sc[s] = a; mx = fmaxf(mx, a); }
    for (int o = 1; o < 64; o <<= 1) mx = fmaxf(mx, __shfl_xor(mx, o));
    __syncthreads(); if ((tid & 63) == 0) red[tid >> 6] = mx; __syncthreads(); mx = fmaxf(fmaxf(red[0], red[1]), fmaxf(red[2], red[3])); __syncthreads();
    float l = 0.f;
    for (int s = tid; s < SEQ; s += 256) { const float p = expf(sc[s] - mx); sc[s] = p; l += p; }
    l = blk_sum(l, red);
    const int e = tid & 63, g = tid >> 6; float o = 0.f;
    for (int s = g; s < SEQ; s += 4) o += sc[s] * VV[((size_t)b * SEQ + s) * 512 + h * 64 + e];
    part[tid] = o; __syncthreads();
    if (tid < 64) { const float ref = (part[tid] + part[64 + tid] + part[128 + tid] + part[192 + tid]) / l, got = bf2f(((const bf16_t*)(ws + CK_OBS))[(size_t)si * 512 + h * 64 + tid]);
        atomicMax(flag, __float_as_uint(fabsf(ref - got))); atomicMax(flag + 1, __float_as_uint(fabsf(ref))); }
}
__global__ void ck_apply(float* out, const unsigned* flag) {
    const float d = __uint_as_float(flag[0]), r = __uint_as_float(flag[1]);
    const bool bad = !(r > 0.f) || !(d <= MLA_CHECK_TOL * r);
    if (bad) for (size_t i = (size_t)blockIdx.x * blockDim.x + threadIdx.x; i < (size_t)T * DM; i += (size_t)gridDim.x * blockDim.x) out[i] = __builtin_nanf("");
}
#endif

constexpr int N_PHASES = 13;
#ifndef REP0
#define REP0 1
#endif
#ifndef REP1
#define REP1 1
#endif
#ifndef REP3
#define REP3 1
#endif
#ifndef REP5
#define REP5 1
#endif
#ifndef REP7
#define REP7 1
#endif
#ifndef REP10
#define REP10 1
#endif
#ifndef REP11
#define REP11 1
#endif
#ifndef MK_ONE_LAUNCH
#define MK_ONE_LAUNCH 0
#endif
__global__ void __launch_bounds__(NTHREADS, 2) fwd(Args args) {
    extern __shared__ __attribute__((aligned(16))) unsigned char lds_raw[];
    LAS unsigned char* lds = (LAS unsigned char*)lds_raw;
    volatile LAS unsigned* MISC = (volatile LAS unsigned*)(lds + MISC_OFF);
    const int tid = threadIdx.x, lane = tid & 63, wave = __builtin_amdgcn_readfirstlane(tid >> 6);
    const int G = gridDim.x, bx = blockIdx.x;
    unsigned char* ws = args.ws;
    for (int u = tid; u < (LDS_BYTES - RING_BYTES) / 4; u += NTHREADS) ((LAS unsigned*)(lds + RING_BYTES))[u] = 0u;
    __syncthreads();
    XcdBarrier bar; bar.bar = (unsigned*)(ws + WS_CTL) + CW_BAR; bar.x = 0; bar.st = nullptr;
    if (MK_ONE_LAUNCH) bar = xcd_barrier_post((unsigned*)(ws + WS_CTL) + CW_BAR, MISC + MI_BAR);
    const int lo = args.ph_lo, hi = args.ph_hi;
#ifdef ONLY_PHASE
#define IN(k) ((k) == ONLY_PHASE && lo <= (k) && (k) < hi)
#else
#define IN(k) (lo <= (k) && (k) < hi)
#endif
#define SEAM(k) do { if (IN(k) && IN((k) + 1)) xcd_barrier(bar); } while (0)

    if (IN(0)) { p0_prologue(args, lds, wave, lane);
#if REP0 > 1
        p0_prologue(args, lds, wave, lane);
#endif
    } SEAM(0);
#define PH1_BODY { pg8::DenseSched S; S.init((const bf16_t*)(ws + WS_XB), (const bf16_t*)(ws + WS_WIN), T, NIN, 1024, G, bx); EpiInProj E{ws}; \
        pg8::gemm_phase2<EpiInProj, pg8::DenseSched, true>(lds, 1024, S, E); }
    if (IN(1)) { PH1_BODY
#if REP1 > 1
        PH1_BODY
#endif
    } SEAM(1);
    if (IN(2)) { p2_stats(args, wave, lane); } SEAM(2);
#define PH3_BODY { { pg8::DenseSched S; S.init((const bf16_t*)(ws + WS_CQ), (const bf16_t*)(ws + WS_WUQ), T, 768, 256, G, bx); EpiQ E{ws}; \
          pg8::gemm_phase2<EpiQ, pg8::DenseSched, true>(lds, 256, S, E); } \
        { pg8::DenseSched S; S.init((const bf16_t*)(ws + WS_CKV), (const bf16_t*)(ws + WS_WUKV), T, 1024, 128, G, bx); EpiKV E{ws}; \
          pg8::gemm_phase2<EpiKV, pg8::DenseSched, true>(lds, 128, S, E); } }
    if (IN(3)) { PH3_BODY
#if REP3 > 1
        PH3_BODY
#endif
    } SEAM(3);
    if (IN(4)) { p4_dilated(args, lds, MISC, wave, lane);
#ifdef REP_DIL
        p4_dilated(args, lds, MISC, wave, lane);
#endif
    } SEAM(4);
    if (IN(5)) { p5_combine(args, wave, lane); p5_mla(args, lds, wave, lane);
#ifdef REP_MLA
        p5_mla(args, lds, wave, lane);
#endif
    } SEAM(5);
#ifdef MLA_CHECK
    if (IN(6) && bx == 0) { for (int i = tid; i < CK_NS * 512; i += NTHREADS) ((bf16_t*)(ws + CK_OBS))[i] = ((const bf16_t*)(ws + WS_OB))[(size_t)ck_tok(i >> 9) * 512 + (i & 511)]; }
#endif
    if (IN(6)) {
        { pg8::DenseSched S; S.init((const bf16_t*)(ws + WS_OA), (const bf16_t*)(ws + WS_WA), T, 1024, 512, G, bx); EpiGate<false> E{ws};
          pg8::gemm_phase2<EpiGate<false>, pg8::DenseSched, true>(lds, 512, S, E); }
        { pg8::DenseSched S; S.init((const bf16_t*)(ws + WS_OB), (const bf16_t*)(ws + WS_WB), T, 1024, 512, G, bx); EpiGate<true> E{ws};
          pg8::gemm_phase2<EpiGate<true>, pg8::DenseSched, true>(lds, 512, S, E); }
    } SEAM(6);
#define PH7_BODY { pg8::DenseSched S; S.init((const bf16_t*)(ws + WS_MERGED), (const bf16_t*)(ws + WS_WO), T, 1024, 1024, G, bx); EpiResid E{ws, args.in[0], args.out}; \
        pg8::gemm_phase2<EpiResid, pg8::DenseSched, true>(lds, 1024, S, E); }
    if (IN(7)) { PH7_BODY
#if REP7 > 1
        PH7_BODY
#endif
    } SEAM(7);
    if (IN(8)) { p8_router(args, lds, MISC, wave, lane); } SEAM(8);
    if (IN(9)) { p9_scatter(args, MISC); } SEAM(9);
#define PH10_BODY { moe_prefix(args, MISC); \
        pg8::MoeSched<3, true> S; S.tpre = (const LAS int*)(MISC + MI_TPRE); S.ntiles = (int)MISC[MI_TPRE + 32]; S.G = G; S.c = bx; S.K = 512; \
        S.A = (const char*)(ws + WS_H2); S.Bt = (const char*)(ws + WS_WGU); S.estride = (size_t)2048 * 1024; S.row_tok = (const int*)(ws + WS_ROWTOK); \
        EpiSwiglu E{ws, args.in[15]}; \
        pg8::gemm_phase2<EpiSwiglu, pg8::MoeSched<3, true>, true, true, 121>(lds, 512, S, E); }
    if (IN(10)) { PH10_BODY
#if REP10 > 1
        PH10_BODY
#endif
    } SEAM(10);
#define PH11_BODY { moe_prefix(args, MISC); \
        pg8::MoeSched<2, false> S; S.tpre = (const LAS int*)(MISC + MI_TPRE); S.ntiles = (int)MISC[MI_TPRE + 32]; S.G = G; S.c = bx; S.K = 512; \
        S.A = (const char*)(ws + WS_ACT); S.Bt = (const char*)(ws + WS_WD); S.estride = (size_t)1024 * 1024; S.row_tok = nullptr; \
        EpiDown E{ws, args.in[17]}; \
        pg8::gemm_phase2<EpiDown, pg8::MoeSched<2, false>, true, true, 121>(lds, 512, S, E); }
    if (IN(11)) { PH11_BODY
#if REP11 > 1
        PH11_BODY
#endif
    } SEAM(11);
    if (IN(12)) { p12_final(args, wave, lane); }
#undef IN
#undef SEAM
}

extern "C" void kernel_launch(void* const* d_in, const int* in_sizes, int n_in, void* d_out, int out_size, void* d_ws, size_t ws_size, hipStream_t stream) {
    static int grid = 0;
    if (grid == 0) {
        if (n_in != 19 || in_sizes[0] != T * DM || out_size != T * DM || ws_size < WS_END) { fprintf(stderr, "kernel_launch: unexpected shapes (n_in %d, in0 %d, out %d, ws %zu); nothing launched\n", n_in, n_in > 0 ? in_sizes[0] : -1, out_size, ws_size); grid = -1; return; }
        int dev = 0, cus = 0, per_cu = 0;
        if (hipGetDevice(&dev) != hipSuccess || hipDeviceGetAttribute(&cus, hipDeviceAttributeMultiprocessorCount, dev) != hipSuccess) { grid = -1; return; }
        if (hipFuncSetAttribute((const void*)fwd, hipFuncAttributeMaxDynamicSharedMemorySize, LDS_BYTES) != hipSuccess) { fprintf(stderr, "kernel_launch: hipFuncSetAttribute failed\n"); grid = -1; return; }
        if (hipOccupancyMaxActiveBlocksPerMultiprocessor(&per_cu, (const void*)fwd, NTHREADS, LDS_BYTES) != hipSuccess || per_cu < 1) fprintf(stderr, "kernel_launch: occupancy query reports %d\n", per_cu);
        (void)hipGetLastError();
        grid = cus;
    }
    if (grid < 0) return;
    if (hipMemsetAsync((char*)d_ws + WS_CTL, 0, CTL_ZERO_BYTES, stream) != hipSuccess) { fprintf(stderr, "kernel_launch: memset failed\n"); return; }
    Args a{};
    for (int i = 0; i < 19; ++i) a.in[i] = (const float*)d_in[i];
    a.out = (float*)d_out; a.ws = (unsigned char*)d_ws; a.li = 0; a.pad = 0;
#if MK_ONE_LAUNCH
    a.ph_lo = 0; a.ph_hi = N_PHASES;
    hipLaunchKernelGGL(fwd, dim3(grid), dim3(NTHREADS), LDS_BYTES, stream, a);
#else
    for (int p = 0; p < N_PHASES; ++p) {
        a.ph_lo = p; a.ph_hi = p + 1; hipLaunchKernelGGL(fwd, dim3(grid), dim3(NTHREADS), LDS_BYTES, stream, a); }

#endif
#ifdef MLA_CHECK
    {   unsigned* flag = (unsigned*)((unsigned char*)d_ws + WS_CTL) + 16384;
        hipLaunchKernelGGL(ck_kv, dim3(T), dim3(256), 0, stream, a.in[0], a.in[1], a.in[2], a.in[4], a.in[6], a.in[7], (unsigned char*)d_ws);
        hipLaunchKernelGGL(ck_q, dim3(CK_NS), dim3(256), 0, stream, a.in[0], a.in[1], a.in[2], a.in[3], a.in[5], (unsigned char*)d_ws);
        hipLaunchKernelGGL(ck_attn, dim3(CK_NS * 8), dim3(256), 0, stream, (unsigned char*)d_ws, flag);
        hipLaunchKernelGGL(ck_apply, dim3(1024), dim3(256), 0, stream, (float*)d_out, (const unsigned*)flag); }
#endif
    const hipError_t le = hipPeekAtLastError();
    if (le != hipSuccess) fprintf(stderr, "kernel_launch: launch failed: %s\n", hipGetErrorName(le));
}
```

```cpp
#define MK_ONE_LAUNCH 1
#define INPROJ_FP8 1
#include <hip/hip_runtime.h>
#include <cstdio>
#include <cstdint>

#define LAS __attribute__((address_space(3)))
#define GAS __attribute__((address_space(1)))
typedef unsigned short bf16_t;
typedef short bf16x8 __attribute__((ext_vector_type(8)));
typedef short s16x4 __attribute__((ext_vector_type(4)));
typedef float f32x2 __attribute__((ext_vector_type(2)));
typedef float f32x4 __attribute__((ext_vector_type(4)));
typedef float f32x16 __attribute__((ext_vector_type(16)));
typedef unsigned u32x2 __attribute__((ext_vector_type(2)));
typedef unsigned u32x4 __attribute__((ext_vector_type(4)));

constexpr int NB = 2, SEQ = 16384, T = NB * SEQ, DM = 1024;
constexpr int NIN = 4096;
constexpr int NEXP = 32, TOPK = 4, NSLOT = T * TOPK, NPMAX = NSLOT + NEXP * 256;
constexpr float EPS = 1e-5f, LOG2E = 1.4426950408889634f;
constexpr int NWAVES = 8, NTHREADS = 512;

constexpr size_t MiB = 1u << 20;
constexpr size_t WS_CTL = 0, CTL_ZERO_BYTES = 128 * 1024;
constexpr size_t WS_WIN = 1 * MiB;
constexpr size_t WS_WUQ = 9 * MiB;
constexpr size_t WS_WUKV = 10 * MiB;
constexpr size_t WS_WA = 11 * MiB, WS_WB = 12 * MiB;
constexpr size_t WS_WO = 13 * MiB;
constexpr size_t WS_ROPE = 15 * MiB;
constexpr size_t WS_WGU = 17 * MiB;
constexpr size_t WS_WD = 145 * MiB;
constexpr size_t WS_SMALL = 209 * MiB;
constexpr size_t WS_RSTDQ = WS_SMALL, WS_RSTDKV = WS_RSTDQ + T * 4, WS_RSTD2 = WS_RSTDKV + T * 4;
constexpr size_t WS_TOPI = WS_RSTD2 + T * 4, WS_GATEW = WS_TOPI + (size_t)NSLOT * 4, WS_SRANK = WS_GATEW + (size_t)NSLOT * 4, WS_POS = WS_SRANK + (size_t)NSLOT * 4;
constexpr size_t WS_ROWTOK = WS_POS + (size_t)NSLOT * 4, WS_ROWSCALE = WS_ROWTOK + 1 * MiB, WS_WGBASE = WS_ROWSCALE + 1 * MiB;
constexpr size_t WS_WRP = WS_WGBASE + 64 * 1024;
constexpr size_t WS_PARTL = WS_WRP + 128 * 1024;
static_assert(WS_PARTL + 3 * MiB <= 225 * MiB, "small region");
constexpr size_t WS_XB = 225 * MiB;
constexpr size_t WS_QA = 289 * MiB, WS_KA = 321 * MiB, WS_VA = 353 * MiB;
constexpr size_t WS_CQ = 385 * MiB;
constexpr size_t WS_CKV = 401 * MiB;
constexpr size_t WS_KR = 409 * MiB;
constexpr size_t WS_GA = 411 * MiB, WS_GB = 475 * MiB;
constexpr size_t WS_K8 = 587 * MiB;
constexpr size_t WS_Q8 = 249 * MiB;
constexpr size_t WS_V8T = 273 * MiB;
constexpr size_t WS_ACT = 225 * MiB;
static_assert(WS_ACT + (size_t)NPMAX * 2048 <= 539 * MiB, "ACT overlay");
constexpr size_t WS_QB = 539 * MiB;
constexpr size_t WS_KIMG = 587 * MiB;
constexpr size_t WS_VIMG = 635 * MiB;
constexpr size_t WS_OA = 667 * MiB, WS_OB = 699 * MiB;
constexpr size_t WS_MERGED = 731 * MiB;
constexpr size_t WS_PARTO = 795 * MiB;
constexpr size_t WS_H2 = 891 * MiB;
constexpr size_t WS_Y = 539 * MiB;
static_assert(WS_Y + (size_t)NPMAX * 2048 <= WS_H2, "Y overlay");
constexpr size_t WS_END = 955 * MiB;
constexpr int CW_TMO = 0, CW_BAR = 4096, CW_GCOUNT = 8192, CW_NRM = 8256;

constexpr int RING_BYTES = 131072, LDS_BYTES = 163840, MISC_OFF = LDS_BYTES - 4096;
constexpr int MI_BAR = 8, MI_TPRE = 16, MI_HIST = 64, MI_PSTART = 96, MI_NRM = 160;

__device__ __forceinline__ unsigned f2bf(float f) { unsigned u = __builtin_bit_cast(unsigned, f); return (u + 0x7fffu + ((u >> 16) & 1u)) >> 16; }
__device__ __forceinline__ unsigned pk2(float lo, float hi) { return f2bf(lo) | (f2bf(hi) << 16); }
__device__ __forceinline__ float bf2f(unsigned short b) { return __builtin_bit_cast(float, (unsigned)b << 16); }
__device__ __forceinline__ float bflo(unsigned w) { return __builtin_bit_cast(float, w << 16); }
__device__ __forceinline__ float bfhi(unsigned w) { return __builtin_bit_cast(float, w & 0xffff0000u); }
typedef __bf16 bf16x2_t __attribute__((ext_vector_type(2)));
__device__ __forceinline__ unsigned cvtpk(float lo, float hi) { const f32x2 v = {lo, hi}; const bf16x2_t b = __builtin_convertvector(v, bf16x2_t); return __builtin_bit_cast(unsigned, b); }
__device__ __forceinline__ unsigned pack4_fp8(float a, float b, float c, float d) { int w = 0; w = __builtin_amdgcn_cvt_pk_fp8_f32(a, b, w, false); w = __builtin_amdgcn_cvt_pk_fp8_f32(c, d, w, true); return (unsigned)w; }
__device__ __forceinline__ float wave_sum(float v) {
#pragma unroll
    for (int o = 1; o < 64; o <<= 1) v += __shfl_xor(v, o);
    return v;
}
__device__ __forceinline__ int lane_now() { int t = threadIdx.x; asm volatile("" : "+v"(t)); return t & 63; }
__device__ __forceinline__ float fexp2(float x) { return __builtin_amdgcn_exp2f(x); }
__device__ __forceinline__ float frcp(float x) { return __builtin_amdgcn_rcpf(x); }
__device__ __forceinline__ float sigmoidf_(float z) { return frcp(1.f + fexp2(-z * LOG2E)); }
__device__ __forceinline__ int crow(int r, int hi) { return (r & 3) + 8 * (r >> 2) + 4 * hi; }
__device__ __forceinline__ u32x4 pack8(const float (&v)[8]) { u32x4 w; w.x = cvtpk(v[0], v[1]); w.y = cvtpk(v[2], v[3]); w.z = cvtpk(v[4], v[5]); w.w = cvtpk(v[6], v[7]); return w; }
__device__ __forceinline__ void unpack8(const u32x4 w, float (&v)[8]) { v[0] = bflo(w.x); v[1] = bfhi(w.x); v[2] = bflo(w.y); v[3] = bfhi(w.y); v[4] = bflo(w.z); v[5] = bfhi(w.z); v[6] = bflo(w.w); v[7] = bfhi(w.w); }
__device__ __forceinline__ f32x2 rope_cs(int pos, int i) {
    const float inv = __builtin_powf(10000.f, -(float)i * (1.f / 16.f));
    const float ang = (float)pos * inv;
    double x = (double)ang; const double n = __builtin_rint(x * 0.15915494309189535); x = (x - n * 6.283185307179586) - n * 2.4492935982947064e-16;
    const double x2 = x * x; double sn = 1.0, cs = 1.0;
#pragma unroll
    for (int k = 13; k >= 1; --k) { sn = 1.0 - sn * x2 * (1.0 / (double)((2 * k) * (2 * k + 1))); cs = 1.0 - cs * x2 * (1.0 / (double)((2 * k - 1) * (2 * k))); }
    sn *= x;
    return (f32x2){(float)cs, (float)sn};
}

namespace pg8 {
constexpr int BM = 256, BK = 64, HALF = 128, HTB = HALF * BK * 2  , NXCD = 8, WGM = 8;
__host__ __device__ __forceinline__ int lds_byte(int r, int c) { const int st = (r >> 4) * 2 + (c >> 5), rr = r & 15, cc = c & 31, ob = rr * 64 + cc * 2; return st * 1024 + (ob ^ (((ob >> 9) & 1) << 5)); }
__host__ __device__ __forceinline__ void stage_rc(int b, int& R, int& C) { const int st = b / 1024, sb = b % 1024, swz = sb ^ (((sb >> 9) & 1) << 5); R = (st >> 1) * 16 + swz / 64; C = (st & 1) * 32 + (swz % 64) / 2; }
__host__ __device__ __forceinline__ int perm32(int rho) { const int n = rho >> 4, i = rho & 15; return 8 * (i >> 2) + 4 * n + (i & 3); }

struct Unit { int pm, pn, e; };

struct StaticOrder {
    int nM, nN, nwg, G, c;
    __host__ __device__ void init(int M, int N, int G_, int c_) { nM = M / BM; nN = N / BM; nwg = nM * nN; G = G_; c = c_; }
    __host__ __device__ bool next(int i, Unit& u) const {
        const long L = (long)i * G + c; if (L >= nwg) return false;
        int wgid = (int)L; { const int q = nwg / NXCD, r = nwg % NXCD, xcd = wgid % NXCD, off = wgid / NXCD; wgid = (xcd < r ? xcd * (q + 1) : r * (q + 1) + (xcd - r) * q) + off; }
        const int nig = WGM * nN, gid = wgid / nig, fm = gid * WGM, gsz = (nM - fm) < WGM ? (nM - fm) : WGM;
        u.pm = fm + ((wgid % nig) % gsz); u.pn = (wgid % nig) / gsz; u.e = 0; return true;
    }
};
struct DenseSched {
    static constexpr bool LATE = false, KEEP_ACC = false;
    StaticOrder so; const char* A; const char* Bt; int K;
    __device__ __forceinline__ void prefetch_rows(const Unit&, LAS unsigned char*, int, int, int) const {}
    __device__ __forceinline__ void a_off_lds(const Unit&, const int (&)[2], const int (&)[2], LAS unsigned char*, int, unsigned (&)[2][2]) const {}
    __device__ __forceinline__ void init(const bf16_t* A_, const bf16_t* Bt_, int M, int N, int K_, int G, int c) { so.init(M, N, G, c); A = (const char*)A_; Bt = (const char*)Bt_; K = K_; }
    __device__ __forceinline__ bool next(int i, Unit& u) const { return so.next(i, u); }
    __device__ __forceinline__ const char* a_base(const Unit& u) const { return A + (size_t)u.pm * ((size_t)BM * K * 2); }
    __device__ __forceinline__ const char* b_base(const Unit& u) const { return Bt + (size_t)u.pn * ((size_t)BM * K * 2); }
    __device__ __forceinline__ void a_off(const Unit&, const int (&sR)[2], const int (&sC)[2], unsigned (&vo)[2][2]) const {
#pragma unroll
        for (int h = 0; h < 2; ++h)
#pragma unroll
            for (int i = 0; i < 2; ++i) vo[h][i] = (unsigned)((h * HALF + sR[i]) * K + sC[i]) * 2u;
    }
};
struct TwoSegSched {
    static constexpr bool LATE = false, KEEP_ACC = true;
    StaticOrder so; const char* A0; const char* A1; const char* B0; const char* B1; int K;
    __device__ __forceinline__ void prefetch_rows(const Unit&, LAS unsigned char*, int, int, int) const {}
    __device__ __forceinline__ void a_off_lds(const Unit&, const int (&)[2], const int (&)[2], LAS unsigned char*, int, unsigned (&)[2][2]) const {}
    __device__ __forceinline__ void init(const bf16_t* A0_, const bf16_t* B0_, const bf16_t* A1_, const bf16_t* B1_, int M, int N, int K_, int G, int c) { so.init(M, N, G, c); A0 = (const char*)A0_; A1 = (const char*)A1_; B0 = (const char*)B0_; B1 = (const char*)B1_; K = K_; }
    __device__ __forceinline__ bool next(int i, Unit& u) const { const bool ok = so.next(i >> 1, u); u.e = i & 1; return ok; }
    __device__ __forceinline__ const char* a_base(const Unit& u) const { return (u.e ? A1 : A0) + (size_t)u.pm * ((size_t)BM * K * 2); }
    __device__ __forceinline__ const char* b_base(const Unit& u) const { return (u.e ? B1 : B0) + (size_t)u.pn * ((size_t)BM * K * 2); }
    __device__ __forceinline__ void a_off(const Unit&, const int (&sR)[2], const int (&sC)[2], unsigned (&vo)[2][2]) const {
#pragma unroll
        for (int h = 0; h < 2; ++h)
#pragma unroll
            for (int i = 0; i < 2; ++i) vo[h][i] = (unsigned)((h * HALF + sR[i]) * K + sC[i]) * 2u;
    }
};
template <int NPN_SHIFT, bool GATHER, bool REVERSE = false>
struct MoeSched {
    static constexpr bool KEEP_ACC = false;
    static constexpr bool LATE = GATHER;
    static constexpr int TBL_OFF = 131072 + 4096;
    __device__ __forceinline__ void prefetch_rows(const Unit& u, LAS unsigned char* lds, int buf, int wid, int lane) const {
        if (wid < 4) __builtin_amdgcn_global_load_lds((const unsigned*)(row_tok + u.pm * BM + wid * 64 + lane), (LAS unsigned*)(lds + TBL_OFF + buf * 1024 + wid * 256), 4, 0, 0);
    }
    __device__ __forceinline__ void a_off_lds(const Unit&, const int (&sR)[2], const int (&sC)[2], LAS unsigned char* lds, int buf, unsigned (&vo)[2][2]) const {
        const LAS int* tb = (const LAS int*)(lds + TBL_OFF + buf * 1024);
#pragma unroll
        for (int h = 0; h < 2; ++h)
#pragma unroll
            for (int i = 0; i < 2; ++i) vo[h][i] = (unsigned)(tb[h * HALF + sR[i]] * K + sC[i]) * 2u;
    }
    const LAS int* tpre; int ntiles, G, c, K; const char* A; const char* Bt; size_t estride; const int* row_tok;
    __device__ __forceinline__ bool next(int i, Unit& u) const {
        int g, pn;
        if (G == 256) { const int x = c & 7, j = c >> 3; constexpr int TPR = 256 >> NPN_SHIFT, PX = TPR / 8; g = i * TPR + x * PX + (j >> NPN_SHIFT); pn = j & ((1 << NPN_SHIFT) - 1); }
        else { const int L = i * G + c; g = L >> NPN_SHIFT; pn = L & ((1 << NPN_SHIFT) - 1); }
        if (g >= ntiles) return false;
        if (REVERSE) g = ntiles - 1 - g;
        int e = 0; while (e < 31 && tpre[e + 1] <= g) ++e;
        u.pm = g; u.pn = pn; u.e = e; return true;
    }
    __device__ __forceinline__ const char* a_base(const Unit& u) const { return GATHER ? A : A + (size_t)u.pm * ((size_t)BM * K * 2); }
    __device__ __forceinline__ const char* b_base(const Unit& u) const { return Bt + (size_t)u.e * estride + (size_t)u.pn * ((size_t)BM * K * 2); }
    __device__ __forceinline__ void a_off(const Unit& u, const int (&sR)[2], const int (&sC)[2], unsigned (&vo)[2][2]) const {
#pragma unroll
        for (int h = 0; h < 2; ++h)
#pragma unroll
            for (int i = 0; i < 2; ++i) {
                if (GATHER) { const int tok = row_tok[u.pm * BM + h * HALF + sR[i]]; vo[h][i] = (unsigned)(tok * K + sC[i]) * 2u; }
                else vo[h][i] = (unsigned)((h * HALF + sR[i]) * K + sC[i]) * 2u;
            }
    }
};

typedef int v8i_ __attribute__((ext_vector_type(8)));
__device__ __forceinline__ v8i_ cat16(const bf16x8 a, const bf16x8 b) { const u32x4 x = __builtin_bit_cast(u32x4, a), y = __builtin_bit_cast(u32x4, b); return (v8i_){(int)x.x, (int)x.y, (int)x.z, (int)x.w, (int)y.x, (int)y.y, (int)y.z, (int)y.w}; }
__device__ __forceinline__ v8i_ lds_ld32(const LAS unsigned char* p) { const u32x4 x = *(const LAS u32x4*)p, y = *(const LAS u32x4*)(p + 1024); return (v8i_){(int)x.x, (int)x.y, (int)x.z, (int)x.w, (int)y.x, (int)y.y, (int)y.z, (int)y.w}; }
template <class Epi, class Sched, bool ALIGN_EPI, bool FP8 = false, int SCALE_W = 127>
__device__ __forceinline__ void gemm_phase2(LAS unsigned char* lds, const int K_, const Sched& S, const Epi& E) {
    int K = K_; asm volatile("" : "+s"(K));
    const int tid = threadIdx.x, wid = __builtin_amdgcn_readfirstlane(tid >> 6), lane = tid & 63, wr = wid >> 2, wc = wid & 3, fr = lane & 15, fq = lane >> 4;
    const int nt = K / BK;
    int sR[2], sC[2]; unsigned voffB[2];
#pragma unroll
    for (int i = 0; i < 2; ++i) { int R, C; stage_rc(tid * 16 + i * 8192, R, C); sR[i] = R; sC[i] = C; const int Rb = Epi::PERM ? ((R & ~31) + perm32(R & 31)) : R; voffB[i] = (unsigned)(Rb * K + C) * 2u; }
    const size_t kstep = (size_t)(BK * 2);
    const size_t hstep = (size_t)HALF * K * 2;
    const unsigned ldsw = (unsigned)wid * 1024u;
    const int aoff = lds_byte(wr * 64 + fr, fq * 8), boff = lds_byte(wc * 32 + fr, fq * 8);
#define PG8_SA(b, h) (((b) * 2 + (h)) * HTB)
#define PG8_SB(b, h) ((4 + (b) * 2 + (h)) * HTB)
#define PG8_STAGE_B(bufoff, gbase) do { _Pragma("unroll") for (int _i = 0; _i < 2; ++_i) \
        __builtin_amdgcn_global_load_lds((const unsigned*)((const char*)(gbase) + voffB[_i]), (LAS unsigned*)(lds + (bufoff) + ldsw + _i * 8192), 16, 0, 0); } while (0)
#define PG8_STAGE_A(bufoff, gbase, o0, o1) do { \
        __builtin_amdgcn_global_load_lds((const unsigned*)((const char*)(gbase) + (o0)), (LAS unsigned*)(lds + (bufoff) + ldsw), 16, 0, 0); \
        __builtin_amdgcn_global_load_lds((const unsigned*)((const char*)(gbase) + (o1)), (LAS unsigned*)(lds + (bufoff) + ldsw + 8192), 16, 0, 0); } while (0)
#define PG8_LDA(dst, b, h) do { if constexpr (FP8) { _Pragma("unroll") for (int m = 0; m < 4; ++m) dst##8[m] = lds_ld32(lds + PG8_SA(b, h) + aoff + m * 2048); } else { _Pragma("unroll") for (int m = 0; m < 4; ++m) _Pragma("unroll") for (int k = 0; k < 2; ++k) dst[m][k] = *(const LAS bf16x8*)(lds + PG8_SA(b, h) + aoff + m * 2048 + k * 1024); } } while (0)
#define PG8_LDB(dst, b, h) do { if constexpr (FP8) { _Pragma("unroll") for (int n = 0; n < 2; ++n) dst##8[n] = lds_ld32(lds + PG8_SB(b, h) + boff + n * 2048); } else { _Pragma("unroll") for (int n = 0; n < 2; ++n) _Pragma("unroll") for (int k = 0; k < 2; ++k) dst[n][k] = *(const LAS bf16x8*)(lds + PG8_SB(b, h) + boff + n * 2048 + k * 1024); } } while (0)
#define PG8_MMA(ai, bj, At, Bt) do { __builtin_amdgcn_s_setprio(1); if constexpr (FP8) { _Pragma("unroll") for (int m = 0; m < 4; ++m) _Pragma("unroll") for (int n = 0; n < 2; ++n) \
        asm volatile("v_mfma_scale_f32_16x16x128_f8f6f4 %0, %1, %2, %0, %3, %4 op_sel_hi:[0,0,0]" : "+v"(acc[ai][bj][m][n]) : "v"(Bt##8[n]), "v"(At##8[m]), "v"(scw_), "v"(sca_)); } else { \
        _Pragma("unroll") for (int m = 0; m < 4; ++m) _Pragma("unroll") for (int n = 0; n < 2; ++n) _Pragma("unroll") for (int k = 0; k < 2; ++k) \
        acc[ai][bj][m][n] = __builtin_amdgcn_mfma_f32_16x16x32_bf16(Bt[n][k], At[m][k], acc[ai][bj][m][n], 0, 0, 0); } __builtin_amdgcn_s_setprio(0); } while (0)
#define PG8_WAIT_V(n) asm volatile("s_waitcnt vmcnt(" #n ")" ::: "memory")
#define PG8_WAIT_L(n) asm volatile("s_waitcnt lgkmcnt(" #n ")" ::: "memory")
#define PG8_BAR __builtin_amdgcn_s_barrier()
#define PG8_SCHED __builtin_amdgcn_sched_barrier(0)
    Unit cur, nxt; int ui = 0;
    if (!S.next(0, cur)) return;
    f32x4 acc[2][2][4][2];
#pragma unroll
    for (int a = 0; a < 2; ++a)
#pragma unroll
        for (int b = 0; b < 2; ++b)
#pragma unroll
            for (int m = 0; m < 4; ++m)
#pragma unroll
                for (int n = 0; n < 2; ++n) acc[a][b][m][n] = (f32x4){0.f, 0.f, 0.f, 0.f};
    bf16x8 At[4][2], B0[2][2], B1[2][2]; v8i_ At8[4], B08[2], B18[2];
    int scw_ = SCALE_W * 0x01010101, sca_ = 0x7f7f7f7f; asm volatile("" : "+v"(scw_), "+v"(sca_));
    unsigned voA[2][2], voN[2][2];
    S.a_off(cur, sR, sC, voA);
    const char* cA = S.a_base(cur); const char* cB = S.b_base(cur);
    PG8_STAGE_B(PG8_SB(0, 0), cB); PG8_STAGE_B(PG8_SB(0, 1), cB + hstep); PG8_STAGE_A(PG8_SA(0, 0), cA, voA[0][0], voA[0][1]); PG8_STAGE_A(PG8_SA(0, 1), cA, voA[1][0], voA[1][1]);
    if (wr == 1) PG8_BAR;
    PG8_WAIT_V(2); PG8_BAR;
    PG8_STAGE_B(PG8_SB(1, 0), cB + kstep); PG8_STAGE_A(PG8_SA(1, 0), cA + kstep, voA[0][0], voA[0][1]); PG8_STAGE_B(PG8_SB(1, 1), cB + hstep + kstep);
    PG8_WAIT_V(6); PG8_BAR;
    for (;;) {
        const bool has_next = S.next(ui + 1, nxt);
        const char* nA = cA; const char* nB = cB;
#pragma unroll
        for (int h = 0; h < 2; ++h)
#pragma unroll
            for (int i = 0; i < 2; ++i) voN[h][i] = voA[h][i];
        if (has_next) { nA = S.a_base(nxt); nB = S.b_base(nxt); if constexpr (Sched::LATE) S.prefetch_rows(nxt, lds, (ui + 1) & 1, wid, lane); else S.a_off(nxt, sR, sC, voN); }
        for (int t = 0; t < nt; t += 2) {
            const bool last = (t == nt - 2);
            if constexpr (Sched::LATE) { if (last && has_next) S.a_off_lds(nxt, sR, sC, lds, (ui + 1) & 1, voN); }
            const char* a1 = cA + (size_t)(t + 1) * kstep;
            const char* a2 = last ? nA : cA + (size_t)(t + 2) * kstep; const char* b2 = last ? nB : cB + (size_t)(t + 2) * kstep;
            const char* a3 = a2 + kstep; const char* b3 = b2 + kstep;
            const unsigned s00 = last ? voN[0][0] : voA[0][0], s01 = last ? voN[0][1] : voA[0][1], s10 = last ? voN[1][0] : voA[1][0], s11 = last ? voN[1][1] : voA[1][1];
            PG8_LDB(B0, 0, 0); PG8_LDB(B1, 0, 1); PG8_SCHED; PG8_LDA(At, 0, 0); PG8_STAGE_A(PG8_SA(1, 1), a1, voA[1][0], voA[1][1]);
            PG8_WAIT_V(8); PG8_WAIT_L(0); PG8_BAR; PG8_MMA(0, 0, At, B0); PG8_MMA(0, 1, At, B1); PG8_BAR; PG8_SCHED;
            PG8_LDA(At, 0, 1); PG8_STAGE_B(PG8_SB(0, 0), b2); PG8_STAGE_B(PG8_SB(0, 1), b2 + hstep); PG8_STAGE_A(PG8_SA(0, 0), a2, s00, s01);
            PG8_WAIT_V(8); PG8_WAIT_L(0); PG8_BAR; PG8_MMA(1, 0, At, B0); PG8_MMA(1, 1, At, B1); PG8_BAR; PG8_SCHED;
            PG8_LDB(B0, 1, 0); PG8_LDB(B1, 1, 1); PG8_SCHED; PG8_LDA(At, 1, 0); PG8_STAGE_A(PG8_SA(0, 1), a2, s10, s11);
            PG8_WAIT_V(8); PG8_WAIT_L(0); PG8_BAR; PG8_MMA(0, 0, At, B0); PG8_MMA(0, 1, At, B1); PG8_BAR; PG8_SCHED;
            PG8_LDA(At, 1, 1); PG8_STAGE_B(PG8_SB(1, 0), b3); PG8_STAGE_B(PG8_SB(1, 1), b3 + hstep); PG8_STAGE_A(PG8_SA(1, 0), a3, s00, s01);
            PG8_WAIT_V(8); PG8_WAIT_L(0); PG8_BAR; PG8_MMA(1, 0, At, B0); PG8_MMA(1, 1, At, B1); PG8_BAR; PG8_SCHED;
        }
        if constexpr (ALIGN_EPI) { if (wr == 0) PG8_BAR; }
        E(acc, cur, wr, wc, fr, fq);
#ifdef PROBE_EPI2
        if (Epi::PROBE2) { asm volatile("" ::: "memory"); E(acc, cur, wr, wc, fr, fq); }
#endif
        if (!has_next) break;
        if (!(Sched::KEEP_ACC && nxt.e != 0)) {
#pragma unroll
        for (int a = 0; a < 2; ++a)
#pragma unroll
            for (int b = 0; b < 2; ++b)
#pragma unroll
                for (int m = 0; m < 4; ++m)
#pragma unroll
                    for (int n = 0; n < 2; ++n) acc[a][b][m][n] = (f32x4){0.f, 0.f, 0.f, 0.f};
        }
        cur = nxt; cA = nA; cB = nB; ++ui;
#pragma unroll
        for (int h = 0; h < 2; ++h)
#pragma unroll
            for (int i = 0; i < 2; ++i) voA[h][i] = voN[h][i];
        if constexpr (ALIGN_EPI) { if (wr == 1) PG8_BAR; }
    }
    PG8_WAIT_V(0);
    if constexpr (!ALIGN_EPI) { if (wr == 0) PG8_BAR; }
    PG8_BAR;
#undef PG8_SA
#undef PG8_SB
#undef PG8_STAGE_A
#undef PG8_STAGE_B
#undef PG8_LDA
#undef PG8_LDB
#undef PG8_MMA
#undef PG8_WAIT_V
#undef PG8_WAIT_L
#undef PG8_BAR
#undef PG8_SCHED
}
}

#define XB_TMO      128
#define XB_XCNT(j)  (256  + 64 * (j))
#define XB_XSUB(j)  (1280 + 64 * (j))
#define XB_XGEN(j)  (2304 + 64 * (j))
#define XB_TOP      3328
#define XB_TOPGEN   3392
#define XCD_BAR_WORDS 3456
#define XB_SPIN_CAP (1u << 18)

__device__ __forceinline__ unsigned xb_ld(unsigned* p)              { return __hip_atomic_load(p, __ATOMIC_RELAXED, __HIP_MEMORY_SCOPE_AGENT); }
__device__ __forceinline__ unsigned xb_add(unsigned* p, unsigned v) { return __hip_atomic_fetch_add(p, v, __ATOMIC_RELAXED, __HIP_MEMORY_SCOPE_AGENT); }
__device__ __forceinline__ unsigned xb_xcc_id() { return (unsigned)__builtin_amdgcn_s_getreg((3 << 11) | 20) & 0xFu; }
#define XB_SPIN(cond, bar) do { unsigned _sp = 0; while (cond) { __builtin_amdgcn_s_sleep(1); \
    if ((++_sp & 255u) == 0u) { if (xb_ld(&(bar)[XB_TMO])) break; if (_sp > XB_SPIN_CAP) { atomicAdd(&(bar)[XB_TMO], 1u); break; } } } } while (0)

struct XcdBarrier {
    unsigned* bar; unsigned x;
    volatile LAS unsigned* st;
};
__device__ __forceinline__ XcdBarrier xcd_barrier_post(unsigned* bar, volatile LAS unsigned* st) {
    XcdBarrier b; b.bar = bar; b.x = xb_xcc_id(); b.st = st;
    if (threadIdx.x == 0) (void)xb_add(&bar[XB_XCNT(b.x)], 1u);
    return b;
}
__device__ __forceinline__ void xcd_barrier_complete(unsigned* bar, unsigned x, unsigned& nloc, unsigned& nx) {
    const unsigned G = gridDim.x * gridDim.y * gridDim.z;
    unsigned sum, cnt, mine, sp = 0u;
    for (;;) {
        sum = 0u; cnt = 0u; mine = 0u;
#pragma unroll
        for (unsigned j = 0; j < 16; ++j) { const unsigned c = xb_ld(&bar[XB_XCNT(j)]); sum += c; cnt += (c > 0u) ? 1u : 0u; mine = (j == x) ? c : mine; }
        if (sum == G) break;
        __builtin_amdgcn_s_sleep(1);
        if ((++sp & 255u) == 0u) { if (xb_ld(&bar[XB_TMO])) break; if (sp > XB_SPIN_CAP) { atomicAdd(&bar[XB_TMO], 1u); break; } }
    }
    nloc = mine > 0u ? mine : 1u; nx = cnt > 0u ? cnt : 1u;
}
__device__ __forceinline__ void xcd_barrier(const XcdBarrier& b) {
    asm volatile("s_waitcnt vmcnt(0)" ::: "memory");
    __syncthreads();
    if (threadIdx.x == 0) {
        unsigned* bar = b.bar;
        __builtin_amdgcn_s_waitcnt(0);
        unsigned nloc = b.st[0], nx = b.st[1];
        if (nloc == 0u) { xcd_barrier_complete(bar, b.x, nloc, nx); b.st[0] = nloc; b.st[1] = nx; }
        const unsigned old = xb_add(&bar[XB_XSUB(b.x)], 1u);
        const unsigned gen = old / nloc;
        if (old + 1u == (gen + 1u) * nloc) {
            __builtin_amdgcn_fence(__ATOMIC_RELEASE, "agent");
            asm volatile("s_waitcnt vmcnt(0)" ::: "memory");
            const unsigned og = xb_add(&bar[XB_TOP], 1u);
            const unsigned tg = og / nx;
            if (og + 1u == (tg + 1u) * nx) xb_add(&bar[XB_TOPGEN], 1u);
            else XB_SPIN(xb_ld(&bar[XB_TOPGEN]) == tg, bar);
            __builtin_amdgcn_fence(__ATOMIC_ACQUIRE, "agent");
            xb_add(&bar[XB_XGEN(b.x)], 1u);
            asm volatile("s_waitcnt vmcnt(0)" ::: "memory");
        } else {
            XB_SPIN(xb_ld(&bar[XB_XGEN(b.x)]) == gen, bar);
            __builtin_amdgcn_fence(__ATOMIC_ACQUIRE, "agent");
            asm volatile("s_waitcnt vmcnt(0)" ::: "memory");
        }
    }
    __syncthreads();
}

#define EPI_WALK(...) \
    _Pragma("unroll") for (int ai = 0; ai < 2; ++ai) _Pragma("unroll") for (int m = 0; m < 4; ++m) { \
        const int row = u.pm * 256 + ai * 128 + wr * 64 + m * 16 + fr; \
        _Pragma("unroll") for (int bj = 0; bj < 2; ++bj) { const int cw = bj * 128 + wc * 32 + 8 * fq; \
            float v[8] = {acc[ai][bj][m][0][0], acc[ai][bj][m][0][1], acc[ai][bj][m][0][2], acc[ai][bj][m][0][3], acc[ai][bj][m][1][0], acc[ai][bj][m][1][1], acc[ai][bj][m][1][2], acc[ai][bj][m][1][3]}; \
            __VA_ARGS__ } asm volatile("" ::: "memory"); }

__device__ __forceinline__ void rope8(float (&v)[8], const f32x2* rope_row, int i0) {
#pragma unroll
    for (int j = 0; j < 4; ++j) { const f32x2 cs = rope_row[i0 + j]; const float x1 = v[2 * j], x2 = v[2 * j + 1]; v[2 * j] = x1 * cs.x - x2 * cs.y; v[2 * j + 1] = x2 * cs.x + x1 * cs.y; }
}

#define EPI_ROW_(ai, m) (u.pm * 256 + (ai) * 128 + wr * 64 + (m) * 16 + fr)
struct EpiInProj {
    static constexpr bool PERM = true;
    __device__ __forceinline__ void row_rstd(float (&ssr)[2][4], float* dst, float inv_n, const pg8::Unit& u, int wr, int wc, int fr, int fq) const {
        LAS float* red = (LAS float*)(lds + 139264);
#pragma unroll
        for (int ai = 0; ai < 2; ++ai)
#pragma unroll
            for (int m = 0; m < 4; ++m) { float s = ssr[ai][m]; s += __shfl_xor(s, 16); s += __shfl_xor(s, 32);
                if (fq == 0) red[(ai * 128 + wr * 64 + m * 16 + fr) * 4 + wc] = s; }
        __syncthreads();
        if (wc == 0 && fq == 0) {
#pragma unroll
            for (int ai = 0; ai < 2; ++ai)
#pragma unroll
                for (int m = 0; m < 4; ++m) { const int r = ai * 128 + wr * 64 + m * 16 + fr; const f32x4 p = *(const LAS f32x4*)(red + r * 4);
                    dst[u.pm * 256 + r] = 1.f / sqrtf(((p.x + p.y) + (p.z + p.w)) * inv_n + EPS); }
        }
        __syncthreads();
    }
#ifdef PROBE_EPI2
    static constexpr bool PROBE2 = (PROBE_EPI2 == 0);
#endif
    unsigned char* ws; LAS unsigned char* lds;
    __device__ __forceinline__ void operator()(const f32x4 (&acc)[2][2][4][2], const pg8::Unit& u, int wr, int wc, int fr, int fq) const {
        asm volatile("" : "+v"(fr), "+v"(fq));
        const int pn = u.pn;
        if (pn < 6) {
            bf16_t* base = (bf16_t*)(ws + (pn < 2 ? WS_QA : pn < 4 ? WS_KA : WS_VA)) + (pn & 1) * 256;
            EPI_WALK({ *(u32x4*)(base + (size_t)row * 512 + cw) = pack8(v); })
        } else if (pn == 6) {
            bf16_t* base = (bf16_t*)(ws + WS_CQ); float ssr[2][4] = {};
            EPI_WALK({ _Pragma("unroll") for (int j = 0; j < 8; ++j) ssr[ai][m] = __builtin_fmaf(v[j], v[j], ssr[ai][m]); *(u32x4*)(base + (size_t)row * 256 + cw) = pack8(v); })
            row_rstd(ssr, (float*)(ws + WS_RSTDQ), 1.f / 256.f, u, wr, wc, fr, fq);
        } else if (pn == 7) {
            bf16_t* ckv = (bf16_t*)(ws + WS_CKV); const f32x2* rope = (const f32x2*)(ws + WS_ROPE); float ssr[2][4] = {};
            EPI_WALK({ if (cw < 128) { _Pragma("unroll") for (int j = 0; j < 8; ++j) ssr[ai][m] = __builtin_fmaf(v[j], v[j], ssr[ai][m]); *(u32x4*)(ckv + (size_t)row * 128 + cw) = pack8(v); }
                       else if (cw < 160) { rope8(v, rope + (size_t)(row & (SEQ - 1)) * 16, (cw - 128) >> 1);
                           const u32x2 w8 = {pack4_fp8(v[0], v[1], v[2], v[3]), pack4_fp8(v[4], v[5], v[6], v[7])};
                           const int b = row >> 14, sq2 = row & (SEQ - 1); unsigned char* kp = ws + WS_K8 + (size_t)(b * 8 * 256 + (sq2 >> 6)) * 6144 + (4 + ((cw - 128) >> 4)) * 1024 + (sq2 & 63) * 16 + ((cw - 128) & 8);
                           _Pragma("unroll") for (int hh = 0; hh < 8; ++hh) { asm volatile("" : "+v"(kp)); *(u32x2*)kp = w8; kp += (size_t)256 * 6144; } } })
            row_rstd(ssr, (float*)(ws + WS_RSTDKV), 1.f / 128.f, u, wr, wc, fr, fq);
        } else {
            bf16_t* gr = (bf16_t*)(ws + WS_GA) + (pn - 8) * 128 + wc * 32 + 8 * fq; bf16_t* gbp = (bf16_t*)(ws + WS_GB) + (pn - 8) * 128 + wc * 32 + 8 * fq;
#pragma unroll
            for (int ai = 0; ai < 2; ++ai)
#pragma unroll
                for (int m = 0; m < 4; ++m) { const size_t ro = (size_t)EPI_ROW_(ai, m) * 1024; float r[8], g[8];
#pragma unroll
                    for (int j = 0; j < 8; ++j) { const float ga = sigmoidf_(acc[ai][0][m][j >> 2][j & 3]); g[j] = fmaxf(sigmoidf_(acc[ai][1][m][j >> 2][j & 3]), 8.6736174e-19f); r[j] = ga * frcp(g[j]); }
                    *(u32x4*)(gr + ro) = pack8(r); *(u32x4*)(gbp + ro) = pack8(g); }
        }
    }
};
#define EPI_ROW(ai, m) (u.pm * 256 + (ai) * 128 + wr * 64 + (m) * 16 + fr)
#define EPI_LOAD_RS(rs) float rs8[2][4]; _Pragma("unroll") for (int ai = 0; ai < 2; ++ai) _Pragma("unroll") for (int m = 0; m < 4; ++m) rs8[ai][m] = (rs)[EPI_ROW(ai, m)];
struct EpiQ {
    static constexpr bool PERM = true;
#ifdef PROBE_EPI2
    static constexpr bool PROBE2 = (PROBE_EPI2 == 1);
#endif
    unsigned char* ws;
    __device__ __forceinline__ void operator()(const f32x4 (&acc)[2][2][4][2], const pg8::Unit& u, int wr, int wc, int fr, int fq) const {
        bf16_t* qb = (bf16_t*)(ws + WS_QB); const float* rs = (const float*)(ws + WS_RSTDQ); const f32x2* rope = (const f32x2*)(ws + WS_ROPE);
        EPI_LOAD_RS(rs)
        EPI_WALK({ const int col = u.pn * 256 + cw; const int w = col % 96; const float r = rs8[ai][m];
                   _Pragma("unroll") for (int j = 0; j < 8; ++j) v[j] *= r;
                   if (w >= 64) rope8(v, rope + (size_t)(row & (SEQ - 1)) * 16, (w - 64) >> 1);
#ifdef KEEP_BF16_IMAGES
                   *(u32x4*)(qb + (size_t)row * 768 + col) = pack8(v);
#endif
                   *(u32x2*)(ws + WS_Q8 + (size_t)row * 768 + col) = (u32x2){pack4_fp8(v[0] * 16.f, v[1] * 16.f, v[2] * 16.f, v[3] * 16.f), pack4_fp8(v[4] * 16.f, v[5] * 16.f, v[6] * 16.f, v[7] * 16.f)}; })
    }
};
struct EpiKV {
    static constexpr bool PERM = true;
#ifdef PROBE_EPI2
    static constexpr bool PROBE2 = (PROBE_EPI2 == 2);
#endif
    unsigned char* ws;
    __device__ __forceinline__ void operator()(const f32x4 (&acc)[2][2][4][2], const pg8::Unit& u, int wr, int wc, int fr, int fq) const {
        const float* rs = (const float*)(ws + WS_RSTDKV); bf16_t* kimg = (bf16_t*)(ws + WS_KIMG); bf16_t* vimg = (bf16_t*)(ws + WS_VIMG);
        EPI_LOAD_RS(rs)
        EPI_WALK({ const float r = rs8[ai][m];
                   _Pragma("unroll") for (int j = 0; j < 8; ++j) v[j] *= r;
                   const int col = (u.pn & 1) * 256 + cw, h = col >> 6, b = row >> 14, sq = row & (SEQ - 1), tile = sq >> 6, rr = sq & 63; const size_t tb = (size_t)((b * 8 + h) * 256 + tile);
                   if (u.pn < 2) {
#ifdef KEEP_BF16_IMAGES
                       *(u32x4*)(kimg + tb * 6144 + ((col & 63) >> 3) * 512 + rr * 8) = pack8(v);
#endif
                       *(u32x2*)(ws + WS_K8 + tb * 6144 + ((col & 63) >> 4) * 1024 + rr * 16 + (col & 8)) = (u32x2){pack4_fp8(v[0], v[1], v[2], v[3]), pack4_fp8(v[4], v[5], v[6], v[7])}; }
                   else *(u32x4*)(vimg + tb * 4096 + ((col & 63) >> 5) * 2048 + rr * 32 + (col & 31)) = pack8(v); })
    }
};
template <bool SECOND> struct EpiGate {
    static constexpr bool PERM = true;
#ifdef PROBE_EPI2
    static constexpr bool PROBE2 = (PROBE_EPI2 == 3);
#endif
    unsigned char* ws;
    __device__ __forceinline__ void operator()(const f32x4 (&acc)[2][2][4][2], const pg8::Unit& u, int wr, int wc, int fr, int fq) const {
        bf16_t* mg = (bf16_t*)(ws + WS_MERGED); const bf16_t* gt = (const bf16_t*)(ws + (SECOND ? WS_GB : WS_GA));
#pragma unroll
        for (int ai = 0; ai < 2; ++ai) {
            u32x4 gw[4][2], pw[4][2];
#pragma unroll
            for (int m = 0; m < 4; ++m)
#pragma unroll
                for (int bj = 0; bj < 2; ++bj) { const size_t o = (size_t)EPI_ROW(ai, m) * 1024 + u.pn * 256 + bj * 128 + wc * 32 + 8 * fq; gw[m][bj] = *(const u32x4*)(gt + o); if (SECOND) pw[m][bj] = *(const u32x4*)(mg + o); }
#pragma unroll
            for (int m = 0; m < 4; ++m)
#pragma unroll
                for (int bj = 0; bj < 2; ++bj) { const size_t o = (size_t)EPI_ROW(ai, m) * 1024 + u.pn * 256 + bj * 128 + wc * 32 + 8 * fq;
                    float v[8] = {acc[ai][bj][m][0][0], acc[ai][bj][m][0][1], acc[ai][bj][m][0][2], acc[ai][bj][m][0][3], acc[ai][bj][m][1][0], acc[ai][bj][m][1][1], acc[ai][bj][m][1][2], acc[ai][bj][m][1][3]};
                    float g[8]; unpack8(gw[m][bj], g);
                    if (SECOND) { float p[8]; unpack8(pw[m][bj], p); _Pragma("unroll") for (int j = 0; j < 8; ++j) v[j] = p[j] + g[j] * v[j]; }
                    else { _Pragma("unroll") for (int j = 0; j < 8; ++j) v[j] = g[j] * v[j]; }
                    *(u32x4*)(mg + o) = pack8(v); }
            asm volatile("" ::: "memory");
        }
    }
};
struct EpiGateFused {
    static constexpr bool PERM = true;
#ifdef PROBE_EPI2
    static constexpr bool PROBE2 = false;
#endif
    unsigned char* ws;
    __device__ __forceinline__ void operator()(const f32x4 (&acc_)[2][2][4][2], const pg8::Unit& u, int wr, int wc, int fr, int fq) const {
        f32x4 (&acc)[2][2][4][2] = const_cast<f32x4 (&)[2][2][4][2]>(acc_);
        bf16_t* mg = (bf16_t*)(ws + WS_MERGED); const bf16_t* gt = (const bf16_t*)(ws + (u.e ? WS_GB : WS_GA));
#pragma unroll
        for (int ai = 0; ai < 2; ++ai) {
            u32x4 gw[4][2];
#pragma unroll
            for (int m = 0; m < 4; ++m)
#pragma unroll
                for (int bj = 0; bj < 2; ++bj) { const size_t o = (size_t)EPI_ROW(ai, m) * 1024 + u.pn * 256 + bj * 128 + wc * 32 + 8 * fq; gw[m][bj] = *(const u32x4*)(gt + o); }
#pragma unroll
            for (int m = 0; m < 4; ++m)
#pragma unroll
                for (int bj = 0; bj < 2; ++bj) { const size_t o = (size_t)EPI_ROW(ai, m) * 1024 + u.pn * 256 + bj * 128 + wc * 32 + 8 * fq;
                    float g[8]; unpack8(gw[m][bj], g);
                    if (u.e == 0) {
#pragma unroll
                        for (int j = 0; j < 8; ++j) acc[ai][bj][m][j >> 2][j & 3] *= g[j];
                    } else { float v[8];
#pragma unroll
                        for (int j = 0; j < 8; ++j) v[j] = g[j] * acc[ai][bj][m][j >> 2][j & 3];
                        *(u32x4*)(mg + o) = pack8(v); } }
            asm volatile("" ::: "memory");
        }
    }
};
struct EpiResid {
    static constexpr bool PERM = true;
#ifdef PROBE_EPI2
    static constexpr bool PROBE2 = (PROBE_EPI2 == 4);
#endif
    unsigned char* ws; const float* x; float* x1;
    __device__ __forceinline__ void operator()(const f32x4 (&acc)[2][2][4][2], const pg8::Unit& u, int wr, int wc, int fr, int fq) const {
        bf16_t* h2 = (bf16_t*)(ws + WS_H2);
#pragma unroll
        for (int ai = 0; ai < 2; ++ai) {
            f32x4 xa[4][2][2];
#pragma unroll
            for (int m = 0; m < 4; ++m)
#pragma unroll
                for (int bj = 0; bj < 2; ++bj) { const size_t o = (size_t)EPI_ROW(ai, m) * 1024 + u.pn * 256 + bj * 128 + wc * 32 + 8 * fq; xa[m][bj][0] = *(const f32x4*)(x + o); xa[m][bj][1] = *(const f32x4*)(x + o + 4); }
#pragma unroll
            for (int m = 0; m < 4; ++m)
#pragma unroll
                for (int bj = 0; bj < 2; ++bj) { const size_t o = (size_t)EPI_ROW(ai, m) * 1024 + u.pn * 256 + bj * 128 + wc * 32 + 8 * fq;
                    const f32x4 r0 = acc[ai][bj][m][0] + xa[m][bj][0], r1 = acc[ai][bj][m][1] + xa[m][bj][1];
                    *(f32x4*)(x1 + o) = r0; *(f32x4*)(x1 + o + 4) = r1;
                    const float v[8] = {r0[0], r0[1], r0[2], r0[3], r1[0], r1[1], r1[2], r1[3]};
                    *(u32x2*)((unsigned char*)h2 + o) = (u32x2){pack4_fp8(v[0], v[1], v[2], v[3]), pack4_fp8(v[4], v[5], v[6], v[7])}; }
            asm volatile("" ::: "memory");
        }
    }
};
struct EpiSwiglu {
    static constexpr bool PERM = true;
#ifdef PROBE_EPI2
    static constexpr bool PROBE2 = (PROBE_EPI2 == 5);
#endif
    unsigned char* ws; const float* bgu;
    __device__ __forceinline__ void operator()(const f32x4 (&acc)[2][2][4][2], const pg8::Unit& u, int wr, int wc, int fr, int fq) const {
        bf16_t* act = (bf16_t*)(ws + WS_ACT); const float* rsc = (const float*)(ws + WS_ROWSCALE);
        const int c0 = u.pn * 128 + wc * 32 + 8 * fq; const float* bg = bgu + (size_t)u.e * 2048 + c0;
        constexpr float CS = -1.702f * LOG2E;
        float bgv[8], buv[8];
#pragma unroll
        for (int j = 0; j < 8; ++j) { bgv[j] = CS * bg[j]; buv[j] = bg[1024 + j]; }
        EPI_LOAD_RS(rsc)
#pragma unroll
        for (int ai = 0; ai < 2; ++ai)
#pragma unroll
            for (int m = 0; m < 4; ++m) {
                const int row = u.pm * 256 + ai * 128 + wr * 64 + m * 16 + fr; const float r = rs8[ai][m], rc = CS * r; float o[8];
#pragma unroll
                for (int j = 0; j < 8; ++j) { const float a0 = __builtin_fmaf(acc[ai][0][m][j >> 2][j & 3], rc, bgv[j]), u0 = __builtin_fmaf(acc[ai][1][m][j >> 2][j & 3], r, buv[j]);
                    const float a = fmaxf(a0, 7.f * CS), up = __builtin_amdgcn_fmed3f(u0, -7.f, 7.f);
                    const float t = a * frcp(1.f + fexp2(a));
                    o[j] = __builtin_fmaf(up, t, t); }
                *(u32x2*)((unsigned char*)act + (size_t)row * 1024 + c0) = (u32x2){pack4_fp8(o[0], o[1], o[2], o[3]), pack4_fp8(o[4], o[5], o[6], o[7])};
            }
    }
};
struct EpiDown {
    static constexpr bool PERM = true;
#ifdef PROBE_EPI2
    static constexpr bool PROBE2 = (PROBE_EPI2 == 6);
#endif
    unsigned char* ws; const float* bd;
    __device__ __forceinline__ void operator()(const f32x4 (&acc)[2][2][4][2], const pg8::Unit& u, int wr, int wc, int fr, int fq) const {
        unsigned char* y = ws + WS_Y; const float* b = bd + (size_t)u.e * 1024 + u.pn * 256 + wc * 32 + 8 * fq;
        float bv[2][8];
#pragma unroll
        for (int bj = 0; bj < 2; ++bj) { const f32x4 b0 = *(const f32x4*)(b + bj * 128), b1 = *(const f32x4*)(b + bj * 128 + 4);
            bv[bj][0] = 16.f * b0.x; bv[bj][1] = 16.f * b0.y; bv[bj][2] = 16.f * b0.z; bv[bj][3] = 16.f * b0.w; bv[bj][4] = 16.f * b1.x; bv[bj][5] = 16.f * b1.y; bv[bj][6] = 16.f * b1.z; bv[bj][7] = 16.f * b1.w; }
        EPI_WALK({ _Pragma("unroll") for (int j = 0; j < 8; ++j) v[j] = __builtin_fmaf(16.f, v[j], bv[bj][j]);
                   *(u32x2*)(y + (size_t)row * 1024 + u.pn * 256 + cw) = (u32x2){pack4_fp8(v[0], v[1], v[2], v[3]), pack4_fp8(v[4], v[5], v[6], v[7])}; })
    }
};

typedef short v4i16_t __attribute__((ext_vector_type(4)));
__device__ __forceinline__ s16x4 vtr(const LAS char* p) { return __builtin_bit_cast(s16x4, __builtin_amdgcn_ds_read_tr16_b64_v4i16((LAS v4i16_t*)p)); }
__device__ __forceinline__ float swapmax(float m) { auto rr = __builtin_amdgcn_permlane32_swap(__float_as_uint(m), __float_as_uint(m), false, false); return fmaxf(__uint_as_float(rr[0]), __uint_as_float(rr[1])); }
__device__ __forceinline__ float swapsum(float m) { auto rr = __builtin_amdgcn_permlane32_swap(__float_as_uint(m), __float_as_uint(m), false, false); return __uint_as_float(rr[0]) + __uint_as_float(rr[1]); }

struct AttnState { f32x16 o0, o1; float m, l; };

struct MlaKL {
    const bf16_t* K; const bf16_t* V;
    template <int D0> __device__ __forceinline__ bf16x8 kfrag(int c, int r32, int hi) const { return *(const bf16x8*)(K + (size_t)(c >> 1) * 6144 + (2 * D0 + hi) * 512 + ((c & 1) * 32 + r32) * 8); }
    __device__ __forceinline__ u32x4 vpiece(int c, int row, int c8) const { return *(const u32x4*)(V + (size_t)(c >> 1) * 4096 + (c8 >> 2) * 2048 + ((c & 1) * 32 + row) * 32 + (c8 & 3) * 8); }
    __device__ __forceinline__ void modify(int, f32x16&, int, int) const {}
    __device__ __forceinline__ int order(int i) const { return i; }
};
__device__ __forceinline__ bf16x8 fp8x8_to_bf16(u32x2 w, float sc) {
    const f32x2 a = __builtin_amdgcn_cvt_pk_f32_fp8((int)w.x, false), b = __builtin_amdgcn_cvt_pk_f32_fp8((int)w.x, true), c = __builtin_amdgcn_cvt_pk_f32_fp8((int)w.y, false), d = __builtin_amdgcn_cvt_pk_f32_fp8((int)w.y, true);
    const u32x4 o = {cvtpk(a.x * sc, a.y * sc), cvtpk(b.x * sc, b.y * sc), cvtpk(c.x * sc, c.y * sc), cvtpk(d.x * sc, d.y * sc)};
    return __builtin_bit_cast(bf16x8, o);
}
struct MlaKL8 {
    const unsigned char* K; const bf16_t* V;
    template <int D0> __device__ __forceinline__ bf16x8 kfrag(int c, int r32, int hi) const { return fp8x8_to_bf16(*(const u32x2*)(K + (size_t)(c >> 1) * 6144 + D0 * 1024 + ((c & 1) * 32 + r32) * 16 + hi * 8), 1.f); }
    __device__ __forceinline__ u32x4 vpiece(int c, int row, int c8) const { return *(const u32x4*)(V + (size_t)(c >> 1) * 4096 + (c8 >> 2) * 2048 + ((c & 1) * 32 + row) * 32 + (c8 & 3) * 8); }
    __device__ __forceinline__ void modify(int, f32x16&, int, int) const {}
    __device__ __forceinline__ int order(int i) const { return i; }
};
struct DilKL {
    const bf16_t* K; const bf16_t* V;
    int dil, res, u0, L; float slope2d;
    __device__ __forceinline__ size_t tok(int c, int kk) const { int v = u0 - 64 + 32 * c + kk; v = v < 0 ? 0 : (v >= L ? L - 1 : v); return (size_t)(res + dil * v); }
    template <int D0> __device__ __forceinline__ bf16x8 kfrag(int c, int r32, int hi) const { return *(const bf16x8*)(K + tok(c, r32) * 512 + 16 * D0 + 8 * hi); }
    __device__ __forceinline__ u32x4 vpiece(int c, int row, int c8) const { return *(const u32x4*)(V + tok(c, row) * 512 + 8 * c8); }
    __device__ __forceinline__ void modify(int c, f32x16& s, int r32, int hi) const {
        const float c0 = (float)(32 * c - 64); const int vb = u0 - 64 + 32 * c;
#pragma unroll
        for (int r = 0; r < 16; ++r) { const float d = (float)(crow(r, hi) - r32); s[r] = s[r] - slope2d * fabsf(d + c0); }
        if (c == 0) {
#pragma unroll
            for (int r = 0; r < 16; ++r) s[r] = (crow(r, hi) >= r32) ? s[r] : -1e30f; }
        if (c == 4) {
#pragma unroll
            for (int r = 0; r < 16; ++r) s[r] = (crow(r, hi) <= r32) ? s[r] : -1e30f; }
        if (vb < 0 || vb + 31 >= L) {
#pragma unroll
            for (int r = 0; r < 16; ++r) { const int v = vb + crow(r, hi); s[r] = (v >= 0 && v < L) ? s[r] : -1e30f; } }
    }
    __device__ __forceinline__ int order(int i) const { return i == 0 ? 2 : i == 1 ? 1 : i == 2 ? 3 : i == 3 ? 0 : 4; }
};

template <int NDK, class KL> __device__ __forceinline__ void attn_load_k(bf16x8 (&kf)[NDK], const KL& kl, int c, int r32, int hi) {
    kf[0] = kl.template kfrag<0>(c, r32, hi); kf[1] = kl.template kfrag<1>(c, r32, hi); kf[2] = kl.template kfrag<2>(c, r32, hi); kf[3] = kl.template kfrag<3>(c, r32, hi);
    if constexpr (NDK == 6) { kf[4] = kl.template kfrag<4>(c, r32, hi); kf[5] = kl.template kfrag<5>(c, r32, hi); }
}
template <class KL> __device__ __forceinline__ void attn_load_v(u32x4 (&vp)[4], const KL& kl, int c, int lane) {
#pragma unroll
    for (int i = 0; i < 4; ++i) { const int p = lane + 64 * i; vp[i] = kl.vpiece(c, p >> 3, p & 7); }
}
__device__ __forceinline__ void attn_store_v(const u32x4 (&vp)[4], LAS char* vimg, int lane) {
#pragma unroll
    for (int i = 0; i < 4; ++i) { const int p = lane + 64 * i, row = p >> 3, c8 = p & 7; *(LAS u32x4*)(vimg + (c8 >> 2) * 2048 + row * 64 + (c8 & 3) * 16) = vp[i]; }
}
template <int NDK, class KL> __device__ __forceinline__ void attn_core(AttnState& st, const bf16x8 (&qf)[NDK], const bf16x8 (&kf)[NDK], const KL& kl, int c, LAS char* vimg, LAS float* wsf, int lane, int r32, int hi) {
    f32x16 s = {};
#pragma unroll
    for (int d0 = 0; d0 < NDK; ++d0) s = __builtin_amdgcn_mfma_f32_32x32x16_bf16(kf[d0], qf[d0], s, 0, 0, 0);
    kl.modify(c, s, r32, hi);
    float mx = s[0];
#pragma unroll
    for (int r = 1; r < 16; ++r) mx = fmaxf(mx, s[r]);
    mx = swapmax(mx);
    const float mn = fmaxf(st.m, mx), alpha = fexp2(st.m - mn);
    float ps = 0.f;
#pragma unroll
    for (int r = 0; r < 16; ++r) { s[r] = fexp2(s[r] - mn); ps += s[r]; }
    st.l = st.l * alpha + ps; st.m = mn;
    if (__any(alpha != 1.f)) {
        if (hi == 0) wsf[r32] = alpha;
#pragma unroll
        for (int r = 0; r < 16; ++r) { const float a = wsf[crow(r, hi)]; st.o0[r] *= a; st.o1[r] *= a; }
    }
    const u32x4 pw0 = {cvtpk(s[0], s[1]), cvtpk(s[2], s[3]), cvtpk(s[4], s[5]), cvtpk(s[6], s[7])};
    const u32x4 pw1 = {cvtpk(s[8], s[9]), cvtpk(s[10], s[11]), cvtpk(s[12], s[13]), cvtpk(s[14], s[15])};
    const bf16x8 pa0 = __builtin_bit_cast(bf16x8, pw0), pa1 = __builtin_bit_cast(bf16x8, pw1);
    const LAS char* vp = vimg + ((lane >> 4) & 1) * 32 + (lane & 3) * 8 + (4 * hi + ((lane & 15) >> 2)) * 64;
#pragma unroll
    for (int ks = 0; ks < 2; ++ks) {
        const s16x4 l0 = vtr(vp + ks * 1024), h0 = vtr(vp + ks * 1024 + 512), l1 = vtr(vp + 2048 + ks * 1024), h1 = vtr(vp + 2048 + ks * 1024 + 512);
        const bf16x8 v0 = {l0[0], l0[1], l0[2], l0[3], h0[0], h0[1], h0[2], h0[3]}, v1 = {l1[0], l1[1], l1[2], l1[3], h1[0], h1[1], h1[2], h1[3]};
        st.o0 = __builtin_amdgcn_mfma_f32_32x32x16_bf16(ks == 0 ? pa0 : pa1, v0, st.o0, 0, 0, 0);
        st.o1 = __builtin_amdgcn_mfma_f32_32x32x16_bf16(ks == 0 ? pa0 : pa1, v1, st.o1, 0, 0, 0);
    }
}
template <int NDK, class KL> __device__ __forceinline__ void wave_attn(AttnState& st, const bf16x8 (&qf)[NDK], const KL& kl, int nchunk, LAS char* vimg, LAS float* wsf, int lane) {
    const int r32 = lane & 31, hi = lane >> 5;
    st.o0 = f32x16{}; st.o1 = f32x16{}; st.m = -1e30f; st.l = 0.f;
    bf16x8 kfa[NDK], kfb[NDK]; u32x4 vp[4];
    attn_load_k<NDK>(kfa, kl, kl.order(0), r32, hi); attn_load_v(vp, kl, kl.order(0), lane);
    asm volatile("" : "+s"(nchunk));
#pragma unroll 1
    for (int c = 0; c < nchunk; c += 2) {
        attn_store_v(vp, vimg, lane);
        if (c + 1 < nchunk) { attn_load_k<NDK>(kfb, kl, kl.order(c + 1), r32, hi); attn_load_v(vp, kl, kl.order(c + 1), lane); }
        attn_core<NDK>(st, qf, kfa, kl, kl.order(c), vimg, wsf, lane, r32, hi);
        if (c + 1 < nchunk) {
            attn_store_v(vp, vimg, lane);
            if (c + 2 < nchunk) { attn_load_k<NDK>(kfa, kl, kl.order(c + 2), r32, hi); attn_load_v(vp, kl, kl.order(c + 2), lane); }
            attn_core<NDK>(st, qf, kfb, kl, kl.order(c + 1), vimg, wsf, lane, r32, hi);
        }
    }
}
__device__ __forceinline__ float attn_finish(AttnState& st, LAS char* vimg, LAS float* wsf, int lane) {
    const int r32 = lane & 31, hi = lane >> 5;
    const float lt = swapsum(st.l);
    if (hi == 0) wsf[32 + r32] = lt;
    LAS bf16_t* stg = (LAS bf16_t*)vimg;
#pragma unroll
    for (int r = 0; r < 16; ++r) { const int q = crow(r, hi); const float il = frcp(wsf[32 + q]);
        stg[q * 64 + r32] = (bf16_t)f2bf(st.o0[r] * il); stg[q * 64 + 32 + r32] = (bf16_t)f2bf(st.o1[r] * il); }
    return lt;
}

namespace mla {
constexpr int NW = 8, QBLK = 32, QB = 256, KVBLK = 64, NT = SEQ / KVBLK;
constexpr int KSLOT = 12288, VSLOT = 8192, LDS_K = 0, LDS_V = 3 * KSLOT, LDS_WS = LDS_V + 3 * VSLOT, LDS_OST = LDS_WS + NW * 256, LDS_BYTES_ = LDS_OST + NW * 4096;
#define SBAR() __builtin_amdgcn_sched_barrier(0)
#define WAIT_BAR(N) asm volatile("s_waitcnt vmcnt(" #N ") lgkmcnt(0)\n\ts_barrier" ::: "memory")
__device__ __forceinline__ void glds16(const void* gsrc, unsigned lds_dst) { unsigned keep;
    asm volatile("s_mov_b32 %0, m0\n\ts_mov_b32 m0, %2\n\ts_nop 0\n\tglobal_load_lds_dwordx4 %1, off\n\ts_mov_b32 m0, %0" : "=&s"(keep) : "v"(gsrc), "s"(lds_dst) : "memory"); }
typedef LAS const char* lds_cptr;
__device__ __forceinline__ void kload2(bf16x8* kf, lds_cptr kp, int j) { kf[2 * j] = *(const LAS bf16x8*)(kp + j * 2048); kf[2 * j + 1] = *(const LAS bf16x8*)(kp + j * 2048 + 512); }

__device__ __forceinline__ void mla_unit(int b, int h, int qb, const bf16_t* Q, const bf16_t* __restrict__ Kim, const bf16_t* __restrict__ Vim, bf16_t* O, LAS char* shm) {
    const int tid = threadIdx.x, lane = tid & 63, r32 = lane & 31, hi = lane >> 5; const int wid = __builtin_amdgcn_readfirstlane(tid >> 6);
    const long rowbase = (long)b * SEQ; const int q0 = qb * QB;
    const bf16_t* Qw = Q + (rowbase + q0 + wid * QBLK) * 768 + h * 96;
    const unsigned lds0 = (unsigned)(uintptr_t)shm;
    LAS float* wsf = (LAS float*)(shm + LDS_WS) + wid * 64;
    const bf16_t* ksrc = Kim + wid * 512 + lane * 8;
    const bf16_t* rsrc = Kim + (8 + (wid & 3)) * 512 + lane * 8;
    const bf16_t* vsrc = Vim + wid * 512 + lane * 8;
    const unsigned kdst = lds0 + LDS_K + wid * 1024, rdst = lds0 + LDS_K + (8 + (wid & 3)) * 1024, vdst = lds0 + LDS_V + wid * 1024;
#define DMA_K(t, ks) do { glds16(ksrc + (long)(t) * 6144, (unsigned)__builtin_amdgcn_readfirstlane(kdst + (ks))); glds16(rsrc + (long)(t) * 6144, (unsigned)__builtin_amdgcn_readfirstlane(rdst + (ks))); } while (0)
#define DMA_V(t, vs) glds16(vsrc + (long)(t) * 4096, (unsigned)__builtin_amdgcn_readfirstlane(vdst + (vs)))
    const lds_cptr shm3 = (lds_cptr)shm; const lds_cptr kp0 = shm3 + LDS_K + hi * 1024 + r32 * 16;
    const lds_cptr vp0 = shm3 + LDS_V + ((lane >> 4) & 1) * 32 + (lane & 3) * 8 + (4 * hi + ((lane & 15) >> 2)) * 64;
    bf16x8 kf[12];
    DMA_K(0, 0); DMA_V(0, 0); DMA_K(1, KSLOT);
    bf16x8 qr[6];
#pragma unroll
    for (int d0 = 0; d0 < 6; ++d0) qr[d0] = *reinterpret_cast<const bf16x8*>(&Qw[(long)r32 * 768 + d0 * 16 + hi * 8]);
    float l_reg = 0.f; f32x16 o[2]; o[0] = f32x16{}; o[1] = f32x16{};
    f32x16 pA0, pA1, pB0, pB1;
    int si_prev = 0, si_cur = 0, si_next = 1;
#define ROT() do { si_prev = si_cur; si_cur = si_next; si_next = (si_next == 2) ? 0 : si_next + 1; } while (0)
    DMA_K(2, 2 * KSLOT);
    WAIT_BAR(5);
    { const lds_cptr kb = kp0;
#pragma unroll
      for (int d0 = 0; d0 < 6; ++d0) { const bf16x8 b0 = *(const LAS bf16x8*)(kb + d0 * 2048), b1 = *(const LAS bf16x8*)(kb + d0 * 2048 + 512);
          if (d0 == 0) { pA0 = __builtin_amdgcn_mfma_f32_32x32x16_bf16(b0, qr[0], f32x16{}, 0, 0, 0); pA1 = __builtin_amdgcn_mfma_f32_32x32x16_bf16(b1, qr[0], f32x16{}, 0, 0, 0); }
          else { pA0 = __builtin_amdgcn_mfma_f32_32x32x16_bf16(b0, qr[d0], pA0, 0, 0, 0); pA1 = __builtin_amdgcn_mfma_f32_32x32x16_bf16(b1, qr[d0], pA1, 0, 0, 0); } } }
#pragma unroll
    for (int r = 0; r < 16; ++r) { pA0[r] = __builtin_amdgcn_exp2f(pA0[r]); pA1[r] = __builtin_amdgcn_exp2f(pA1[r]); }
    WAIT_BAR(0);
    DMA_K(3, 0); DMA_V(1, VSLOT);
    ROT();
#pragma unroll
    for (int j = 0; j < 6; ++j) kload2(kf, kp0 + si_cur * KSLOT, j);
    WAIT_BAR(3);
    s16x4 vlo[8], vhi[8]; u32x4 pw0, pw1, pw2, pw3;
#define PKW(P, B) cvtpk(P[B], P[B + 1])
#define PAF(k) __builtin_bit_cast(bf16x8, pw##k)
#define VFR(i) (bf16x8){vlo[i][0], vlo[i][1], vlo[i][2], vlo[i][3], vhi[i][0], vhi[i][1], vhi[i][2], vhi[i][3]}
#define PIN(x) asm volatile("" : "+v"(x))
#define MF(a, b, c) __builtin_amdgcn_mfma_f32_32x32x16_bf16(a, b, c, 0, 0, 0)
#define GAPA(MFX, A0, A1, A2, A3, W0, W1, PW) do { MFX; sacc += A0; sacc += A1; sacc += A2; sacc += A3; PIN(sacc); W0; W1; PIN(PW); SBAR(); } while (0)
#define GAPM(MFX) do { MFX; SBAR(); } while (0)
#define EX(v) __builtin_amdgcn_exp2f(v)
#define GAPB(MFX, X, B) do { MFX; X[B] = EX(X[B]); X[B + 1] = EX(X[B + 1]); X[B + 2] = EX(X[B + 2]); X[B + 3] = EX(X[B + 3]); PIN(X); SBAR(); } while (0)
#define VRD(i) do { vlo[i] = vtr(vp_ + (((i) >> 2) * 4096 + ((i) & 3) * 1024)); vhi[i] = vtr(vp_ + (((i) >> 2) * 4096 + ((i) & 3) * 1024 + 512)); } while (0)
#define KRD(G, j) do { if (G) { kload2(kf, kp0 + si_next * KSLOT, j); SBAR(); } } while (0)
#define STEP(C0, C1, P0, P1, t, GK, GV, GL) do { SBAR(); \
    const lds_cptr vp_ = vp0 + si_prev * VSLOT; \
    VRD(0); SBAR(); float sacc = (P0[0] + P0[1]); \
    GAPA(C0 = MF(kf[0], qr[0], f32x16{}), P0[2], P0[3], P0[4], P0[5],     pw0[0] = PKW(P0, 0),  pw0[1] = PKW(P0, 2),  pw0); \
    VRD(4); SBAR(); GAPA(C1 = MF(kf[1], qr[0], f32x16{}), P0[6], P0[7], P0[8], P0[9],     pw0[2] = PKW(P0, 4),  pw0[3] = PKW(P0, 6),  pw0); \
    VRD(1); SBAR(); GAPA(C0 = MF(kf[2], qr[1], C0),   P0[10], P0[11], P0[12], P0[13], pw1[0] = PKW(P0, 8),  pw1[1] = PKW(P0, 10), pw1); \
    VRD(5); SBAR(); GAPA(C1 = MF(kf[3], qr[1], C1),   P0[14], P0[15], P1[0], P1[1],   pw1[2] = PKW(P0, 12), pw1[3] = PKW(P0, 14), pw1); \
    VRD(2); SBAR(); GAPA(C0 = MF(kf[4], qr[2], C0),   P1[2], P1[3], P1[4], P1[5],     pw2[0] = PKW(P1, 0),  pw2[1] = PKW(P1, 2),  pw2); \
    VRD(6); SBAR(); GAPA(C1 = MF(kf[5], qr[2], C1),   P1[6], P1[7], P1[8], P1[9],     pw2[2] = PKW(P1, 4),  pw2[3] = PKW(P1, 6),  pw2); \
    VRD(3); SBAR(); GAPA(C0 = MF(kf[6], qr[3], C0),   P1[10], P1[11], P1[12], P1[13], pw3[0] = PKW(P1, 8),  pw3[1] = PKW(P1, 10), pw3); \
    VRD(7); SBAR(); GAPA(C1 = MF(kf[7], qr[3], C1),   P1[14], P1[15], 0.f, 0.f,       pw3[2] = PKW(P1, 12), pw3[3] = PKW(P1, 14), pw3); \
    GAPM(C0 = MF(kf[8], qr[4], C0)); GAPM(C1 = MF(kf[9], qr[4], C1)); GAPM(C0 = MF(kf[10], qr[5], C0)); GAPM(C1 = MF(kf[11], qr[5], C1)); \
    l_reg += sacc; \
    if (GK) { DMA_K((t) + 3, si_cur * KSLOT); } if (GV) { DMA_V((t) + 1, si_next * VSLOT); } \
    SBAR(); \
    GAPB(o[0] = MF(PAF(0), VFR(0), o[0]), C0, 0); \
    GAPB(o[1] = MF(PAF(0), VFR(4), o[1]), C0, 4); \
    KRD(GL, 0); GAPB(o[0] = MF(PAF(1), VFR(1), o[0]), C0, 8); \
    KRD(GL, 1); GAPB(o[1] = MF(PAF(1), VFR(5), o[1]), C0, 12); \
    KRD(GL, 2); GAPB(o[0] = MF(PAF(2), VFR(2), o[0]), C1, 0); \
    KRD(GL, 3); GAPB(o[1] = MF(PAF(2), VFR(6), o[1]), C1, 4); \
    KRD(GL, 4); GAPB(o[0] = MF(PAF(3), VFR(3), o[0]), C1, 8); \
    KRD(GL, 5); GAPB(o[1] = MF(PAF(3), VFR(7), o[1]), C1, 12); \
    } while (0)
    int t = 1;
    for (; t + 5 < NT; t += 2) {
        STEP(pB0, pB1, pA0, pA1, t, true, true, true);     WAIT_BAR(3); ROT();
        STEP(pA0, pA1, pB0, pB1, t + 1, true, true, true); WAIT_BAR(3); ROT();
    }
#define ENDW(tt) do { if ((tt) + 3 < NT) { WAIT_BAR(3); } else if ((tt) + 2 < NT) { WAIT_BAR(1); } else { WAIT_BAR(0); } } while (0)
    for (; t + 1 < NT; t += 2) {
        STEP(pB0, pB1, pA0, pA1, t, (t + 3 < NT), (t + 1 < NT), (t + 1 < NT));         ENDW(t);     ROT();
        STEP(pA0, pA1, pB0, pB1, t + 1, (t + 4 < NT), (t + 2 < NT), (t + 2 < NT));     ENDW(t + 1); ROT();
    }
    STEP(pB0, pB1, pA0, pA1, NT - 1, false, false, false);
    { float sacc = pB0[0] + pB0[1];
#pragma unroll
      for (int r = 2; r < 16; ++r) sacc += pB0[r];
#pragma unroll
      for (int r = 0; r < 16; ++r) sacc += pB1[r];
      l_reg += sacc;
      pw0 = (u32x4){PKW(pB0, 0), PKW(pB0, 2), PKW(pB0, 4), PKW(pB0, 6)}; pw1 = (u32x4){PKW(pB0, 8), PKW(pB0, 10), PKW(pB0, 12), PKW(pB0, 14)};
      pw2 = (u32x4){PKW(pB1, 0), PKW(pB1, 2), PKW(pB1, 4), PKW(pB1, 6)}; pw3 = (u32x4){PKW(pB1, 8), PKW(pB1, 10), PKW(pB1, 12), PKW(pB1, 14)};
      SBAR();
      const lds_cptr vp_ = vp0 + si_cur * VSLOT;
#pragma unroll
      for (int d0 = 0; d0 < 2; ++d0) {
          s16x4 lo4[4], hi4[4];
#pragma unroll
          for (int ks = 0; ks < 4; ++ks) { lo4[ks] = vtr(vp_ + d0 * 4096 + ks * 1024); hi4[ks] = vtr(vp_ + d0 * 4096 + ks * 1024 + 512); }
#define PK4(k) (bf16x8){lo4[k][0], lo4[k][1], lo4[k][2], lo4[k][3], hi4[k][0], hi4[k][1], hi4[k][2], hi4[k][3]}
          o[d0] = MF(PAF(0), PK4(0), o[d0]); o[d0] = MF(PAF(1), PK4(1), o[d0]); o[d0] = MF(PAF(2), PK4(2), o[d0]); o[d0] = MF(PAF(3), PK4(3), o[d0]);
#undef PK4
      } }
    l_reg = swapsum(l_reg);
    if (hi == 0) wsf[32 + r32] = l_reg;
    asm volatile("s_waitcnt lgkmcnt(0)" ::: "memory");
    float rli[16];
#pragma unroll
    for (int r = 0; r < 16; ++r) rli[r] = __builtin_amdgcn_rcpf(wsf[32 + crow(r, hi)]);
    bf16_t* Ow = O + (rowbase + q0 + wid * QBLK) * 512 + h * 64;
    { LAS bf16_t* stg = (LAS bf16_t*)(shm + LDS_OST) + wid * 2048;
#pragma unroll
      for (int r = 0; r < 16; ++r) { const int orow = crow(r, hi);
#pragma unroll
          for (int d0 = 0; d0 < 2; ++d0) stg[orow * 64 + d0 * 32 + r32] = (bf16_t)f2bf(o[d0][r] * rli[r]); }
      asm volatile("s_waitcnt lgkmcnt(0)" ::: "memory");
#pragma unroll
      for (int i = 0; i < 4; ++i) { const int row = i * 8 + (lane >> 3), ch = lane & 7; const u32x4 v = *(const LAS u32x4*)(stg + row * 64 + ch * 8); *(u32x4*)(Ow + (long)row * 512 + ch * 8) = v; } }
    asm volatile("s_waitcnt lgkmcnt(0)\n\ts_barrier" ::: "memory");
#undef DMA_K
#undef DMA_V
#undef ROT
#undef PKW
#undef PAF
#undef VFR
#undef PIN
#undef MF
#undef GAPA
#undef GAPM
#undef GAPB
#undef EX
#undef VRD
#undef KRD
#undef STEP
#undef ENDW
}
#undef SBAR
#undef WAIT_BAR
}

namespace mla8 {
using mla::glds16; using mla::lds_cptr;
typedef int v8i __attribute__((ext_vector_type(8)));
constexpr int NW = 8, QBLK = 32, QB = 256, KVBLK = 64, NT = SEQ / KVBLK;
constexpr int KSLOT = 6144, VSLOT = 8192, LDS_K = 0, LDS_V = 3 * KSLOT, LDS_WS = LDS_V + 3 * VSLOT, LDS_OST = LDS_WS + NW * 256, LDS_BYTES_ = LDS_OST + NW * 4096;
#define SBAR() __builtin_amdgcn_sched_barrier(0)
#define WAIT_BAR(N) asm volatile("s_waitcnt vmcnt(" #N ") lgkmcnt(0)\n\ts_barrier" ::: "memory")
__device__ __forceinline__ v8i kfrag8(lds_cptr slot, int n, int ks, int r32, int hi) {
    const lds_cptr p = slot + (ks == 0 ? 2 * hi : 4) * 1024 + (32 * n + r32) * 16;
    const u32x4 a = *(const LAS u32x4*)p, b = *(const LAS u32x4*)(p + 1024);
    return (v8i){(int)a.x, (int)a.y, (int)a.z, (int)a.w, (int)b.x, (int)b.y, (int)b.z, (int)b.w};
}
#define MF8(a, b, c) __builtin_amdgcn_mfma_scale_f32_32x32x64_f8f6f4(a, b, c, 0, 0, 0, 0x7f7f7f7f, 0, 0x7b7b7b7b)

__device__ __forceinline__ void mla8_unit(int b, int h, int qb, const unsigned char* Q8, const unsigned char* __restrict__ K8im, const bf16_t* __restrict__ Vim, bf16_t* O, LAS char* shm) {
    const int tid = threadIdx.x, lane = tid & 63, r32 = lane & 31, hi = lane >> 5; const int wid = __builtin_amdgcn_readfirstlane(tid >> 6);
    const long rowbase = (long)b * SEQ; const int q0 = qb * QB;
    const unsigned char* Qw = Q8 + (size_t)(rowbase + q0 + wid * QBLK + r32) * 768 + h * 96;
    const unsigned lds0 = (unsigned)(uintptr_t)shm;
    LAS float* wsf = (LAS float*)(shm + LDS_WS) + wid * 64;
    const int kpc = wid < 6 ? wid : wid - 6;
    const unsigned char* ksrc = K8im + kpc * 1024 + lane * 16;
    const bf16_t* vsrc = Vim + wid * 512 + lane * 8;
    const unsigned kdst = lds0 + LDS_K + kpc * 1024, vdst = lds0 + LDS_V + wid * 1024;
#define DMA_K(t, ks) glds16(ksrc + (long)(t) * 6144, (unsigned)__builtin_amdgcn_readfirstlane(kdst + (ks)))
#define DMA_V(t, vs) glds16(vsrc + (long)(t) * 4096, (unsigned)__builtin_amdgcn_readfirstlane(vdst + (vs)))
    const lds_cptr shm3 = (lds_cptr)shm; const lds_cptr ks0 = shm3 + LDS_K;
    const lds_cptr vp0 = shm3 + LDS_V + ((lane >> 4) & 1) * 32 + (lane & 3) * 8 + (4 * hi + ((lane & 15) >> 2)) * 64;
    v8i kf[4];
    DMA_K(0, 0); DMA_V(0, 0); DMA_K(1, KSLOT);
    v8i qr[2];
    { const u32x4 a = *(const u32x4*)(Qw + 32 * hi), c = *(const u32x4*)(Qw + 32 * hi + 16); qr[0] = (v8i){(int)a.x, (int)a.y, (int)a.z, (int)a.w, (int)c.x, (int)c.y, (int)c.z, (int)c.w};
      u32x4 d = *(const u32x4*)(Qw + 64), e = *(const u32x4*)(Qw + 80); if (hi) { d = (u32x4){0u, 0u, 0u, 0u}; e = d; }
      qr[1] = (v8i){(int)d.x, (int)d.y, (int)d.z, (int)d.w, (int)e.x, (int)e.y, (int)e.z, (int)e.w}; }
    float l_reg = 0.f; f32x16 o[2]; o[0] = f32x16{}; o[1] = f32x16{};
    f32x16 pA0, pA1, pB0, pB1;
    int si_prev = 0, si_cur = 0, si_next = 1;
#define ROT() do { si_prev = si_cur; si_cur = si_next; si_next = (si_next == 2) ? 0 : si_next + 1; } while (0)
    DMA_K(2, 2 * KSLOT);
    WAIT_BAR(3);
    { pA0 = MF8(kfrag8(ks0, 0, 0, r32, hi), qr[0], f32x16{}); pA1 = MF8(kfrag8(ks0, 1, 0, r32, hi), qr[0], f32x16{});
      pA0 = MF8(kfrag8(ks0, 0, 1, r32, hi), qr[1], pA0); pA1 = MF8(kfrag8(ks0, 1, 1, r32, hi), qr[1], pA1); }
#pragma unroll
    for (int r = 0; r < 16; ++r) { pA0[r] = __builtin_amdgcn_exp2f(pA0[r]); pA1[r] = __builtin_amdgcn_exp2f(pA1[r]); }
    WAIT_BAR(0);
    DMA_K(3, 0); DMA_V(1, VSLOT);
    ROT();
    kf[0] = kfrag8(ks0 + si_cur * KSLOT, 0, 0, r32, hi); kf[1] = kfrag8(ks0 + si_cur * KSLOT, 0, 1, r32, hi); kf[2] = kfrag8(ks0 + si_cur * KSLOT, 1, 0, r32, hi); kf[3] = kfrag8(ks0 + si_cur * KSLOT, 1, 1, r32, hi);
    WAIT_BAR(2);
    s16x4 vlo[8], vhi[8]; u32x4 pw0, pw1, pw2, pw3;
#define PKW(P, B) cvtpk(P[B], P[B + 1])
#define PAF(k) __builtin_bit_cast(bf16x8, pw##k)
#define VFR(i) (bf16x8){vlo[i][0], vlo[i][1], vlo[i][2], vlo[i][3], vhi[i][0], vhi[i][1], vhi[i][2], vhi[i][3]}
#define PIN(x) asm volatile("" : "+v"(x))
#define MF(a, b, c) __builtin_amdgcn_mfma_f32_32x32x16_bf16(a, b, c, 0, 0, 0)
#define GAPA(MFX, A0, A1, A2, A3, W0, W1, PW) do { MFX; sacc += A0; sacc += A1; sacc += A2; sacc += A3; PIN(sacc); W0; W1; PIN(PW); SBAR(); } while (0)
#define GAPM(MFX) do { MFX; SBAR(); } while (0)
#define EX(v) __builtin_amdgcn_exp2f(v)
#define GAPB(MFX, X, B) do { MFX; X[B] = EX(X[B]); X[B + 1] = EX(X[B + 1]); X[B + 2] = EX(X[B + 2]); X[B + 3] = EX(X[B + 3]); PIN(X); SBAR(); } while (0)
#define VRD(i) do { vlo[i] = vtr(vp_ + (((i) >> 2) * 4096 + ((i) & 3) * 1024)); vhi[i] = vtr(vp_ + (((i) >> 2) * 4096 + ((i) & 3) * 1024 + 512)); } while (0)
#define KRD(G, j) do { if (G) { kf[j] = kfrag8(ks0 + si_next * KSLOT, (j) >> 1, (j) & 1, r32, hi); SBAR(); } } while (0)
#define GAPA8(MFX, A0, A1, A2, A3, A4, A5, A6, A7, W0, W1, W2, W3, PWa, PWb) do { MFX; sacc += A0; sacc += A1; sacc += A2; sacc += A3; PIN(sacc); W0; W1; PIN(PWa); sacc += A4; sacc += A5; sacc += A6; sacc += A7; PIN(sacc); W2; W3; PIN(PWb); SBAR(); } while (0)
#define STEP(C0, C1, P0, P1, t, GK, GV, GL) do { SBAR(); \
    const lds_cptr vp_ = vp0 + si_prev * VSLOT; \
    VRD(0); VRD(4); SBAR(); float sacc = (P0[0] + P0[1]); \
    GAPA8(C0 = MF8(kf[0], qr[0], f32x16{}), P0[2], P0[3], P0[4], P0[5], P0[6], P0[7], P0[8], P0[9],         pw0[0] = PKW(P0, 0), pw0[1] = PKW(P0, 2), pw0[2] = PKW(P0, 4), pw0[3] = PKW(P0, 6), pw0, pw0); \
    VRD(1); VRD(5); SBAR(); \
    GAPA8(C1 = MF8(kf[2], qr[0], f32x16{}), P0[10], P0[11], P0[12], P0[13], P0[14], P0[15], P1[0], P1[1],   pw1[0] = PKW(P0, 8), pw1[1] = PKW(P0, 10), pw1[2] = PKW(P0, 12), pw1[3] = PKW(P0, 14), pw1, pw1); \
    VRD(2); VRD(6); SBAR(); \
    GAPA8(C0 = MF8(kf[1], qr[1], C0),       P1[2], P1[3], P1[4], P1[5], P1[6], P1[7], P1[8], P1[9],         pw2[0] = PKW(P1, 0), pw2[1] = PKW(P1, 2), pw2[2] = PKW(P1, 4), pw2[3] = PKW(P1, 6), pw2, pw2); \
    VRD(3); VRD(7); SBAR(); \
    GAPA8(C1 = MF8(kf[3], qr[1], C1),       P1[10], P1[11], P1[12], P1[13], P1[14], P1[15], 0.f, 0.f,       pw3[0] = PKW(P1, 8), pw3[1] = PKW(P1, 10), pw3[2] = PKW(P1, 12), pw3[3] = PKW(P1, 14), pw3, pw3); \
    l_reg += sacc; \
    if (GK) { DMA_K((t) + 3, si_cur * KSLOT); } if (GV) { DMA_V((t) + 1, si_next * VSLOT); } \
    SBAR(); \
    GAPB(o[0] = MF(PAF(0), VFR(0), o[0]), C0, 0); \
    GAPB(o[1] = MF(PAF(0), VFR(4), o[1]), C0, 4); \
    KRD(GL, 0); GAPB(o[0] = MF(PAF(1), VFR(1), o[0]), C0, 8); \
    KRD(GL, 1); GAPB(o[1] = MF(PAF(1), VFR(5), o[1]), C0, 12); \
    KRD(GL, 2); GAPB(o[0] = MF(PAF(2), VFR(2), o[0]), C1, 0); \
    KRD(GL, 3); GAPB(o[1] = MF(PAF(2), VFR(6), o[1]), C1, 4); \
    GAPB(o[0] = MF(PAF(3), VFR(3), o[0]), C1, 8); \
    GAPB(o[1] = MF(PAF(3), VFR(7), o[1]), C1, 12); \
    } while (0)
    int t = 1;
    for (; t + 5 < NT; t += 2) {
        STEP(pB0, pB1, pA0, pA1, t, true, true, true);     WAIT_BAR(2); ROT();
        STEP(pA0, pA1, pB0, pB1, t + 1, true, true, true); WAIT_BAR(2); ROT();
    }
#define ENDW(tt) do { if ((tt) + 3 < NT) { WAIT_BAR(2); } else if ((tt) + 2 < NT) { WAIT_BAR(1); } else { WAIT_BAR(0); } } while (0)
    for (; t + 1 < NT; t += 2) {
        STEP(pB0, pB1, pA0, pA1, t, (t + 3 < NT), (t + 1 < NT), (t + 1 < NT));         ENDW(t);     ROT();
        STEP(pA0, pA1, pB0, pB1, t + 1, (t + 4 < NT), (t + 2 < NT), (t + 2 < NT));     ENDW(t + 1); ROT();
    }
    STEP(pB0, pB1, pA0, pA1, NT - 1, false, false, false);
    { float sacc = pB0[0] + pB0[1];
#pragma unroll
      for (int r = 2; r < 16; ++r) sacc += pB0[r];
#pragma unroll
      for (int r = 0; r < 16; ++r) sacc += pB1[r];
      l_reg += sacc;
      pw0 = (u32x4){PKW(pB0, 0), PKW(pB0, 2), PKW(pB0, 4), PKW(pB0, 6)}; pw1 = (u32x4){PKW(pB0, 8), PKW(pB0, 10), PKW(pB0, 12), PKW(pB0, 14)};
      pw2 = (u32x4){PKW(pB1, 0), PKW(pB1, 2), PKW(pB1, 4), PKW(pB1, 6)}; pw3 = (u32x4){PKW(pB1, 8), PKW(pB1, 10), PKW(pB1, 12), PKW(pB1, 14)};
      SBAR();
      const lds_cptr vp_ = vp0 + si_cur * VSLOT;
#pragma unroll
      for (int d0 = 0; d0 < 2; ++d0) {
          s16x4 lo4[4], hi4[4];
#pragma unroll
          for (int ks = 0; ks < 4; ++ks) { lo4[ks] = vtr(vp_ + d0 * 4096 + ks * 1024); hi4[ks] = vtr(vp_ + d0 * 4096 + ks * 1024 + 512); }
#define PK4(k) (bf16x8){lo4[k][0], lo4[k][1], lo4[k][2], lo4[k][3], hi4[k][0], hi4[k][1], hi4[k][2], hi4[k][3]}
          o[d0] = MF(PAF(0), PK4(0), o[d0]); o[d0] = MF(PAF(1), PK4(1), o[d0]); o[d0] = MF(PAF(2), PK4(2), o[d0]); o[d0] = MF(PAF(3), PK4(3), o[d0]);
#undef PK4
      } }
    l_reg = swapsum(l_reg);
    if (hi == 0) wsf[32 + r32] = l_reg;
    asm volatile("s_waitcnt lgkmcnt(0)" ::: "memory");
    float rli[16];
#pragma unroll
    for (int r = 0; r < 16; ++r) rli[r] = __builtin_amdgcn_rcpf(wsf[32 + crow(r, hi)]);
    bf16_t* Ow = O + (rowbase + q0 + wid * QBLK) * 512 + h * 64;
    { LAS bf16_t* stg = (LAS bf16_t*)(shm + LDS_OST) + wid * 2048;
#pragma unroll
      for (int r = 0; r < 16; ++r) { const int orow = crow(r, hi);
#pragma unroll
          for (int d0 = 0; d0 < 2; ++d0) stg[orow * 64 + d0 * 32 + r32] = (bf16_t)f2bf(o[d0][r] * rli[r]); }
      asm volatile("s_waitcnt lgkmcnt(0)" ::: "memory");
#pragma unroll
      for (int i = 0; i < 4; ++i) { const int row = i * 8 + (lane >> 3), ch = lane & 7; const u32x4 v = *(const LAS u32x4*)(stg + row * 64 + ch * 8); *(u32x4*)(Ow + (long)row * 512 + ch * 8) = v; } }
    asm volatile("s_waitcnt lgkmcnt(0)\n\ts_barrier" ::: "memory");
#undef DMA_K
#undef DMA_V
#undef ROT
#undef PKW
#undef PAF
#undef VFR
#undef PIN
#undef MF
#undef GAPA
#undef GAPA8
#undef GAPM
#undef GAPB
#undef EX
#undef VRD
#undef KRD
#undef STEP
#undef ENDW
}
#undef SBAR
#undef WAIT_BAR
#undef MF8
}

namespace bgc {
constexpr int N_GU = 32 * 16 * 128, N_D = 32 * 16 * 64, N_ITEMS = N_GU + N_D;
constexpr int SCR_STRIDE = 20, SCR_BUF = 64 * SCR_STRIDE * 4, SCR_WAVE = 2 * SCR_BUF, LDS_SCR = 73728, LDS_G2 = LDS_SCR + NWAVES * SCR_WAVE;
static_assert(LDS_G2 + 4096 <= MISC_OFF, "background conversion LDS");
constexpr int G2_ONES = 1024 + 256;
static_assert(LDS_G2 + 4096 == MISC_OFF, "ones block = MISC words 256..319");
struct Bg {
    const float* wgu; const float* wd; unsigned char* ws; LAS char* scr; LAS const float* g2;
    int gw, ngw, mitems, q;
    int lane, lw, lr, ls;
    unsigned gu_src, gu_dst, d_src, d_dst; int gu_k0, d_e0;
    __device__ __forceinline__ void init(const float* wgu_, const float* wd_, unsigned char* ws_, LAS unsigned char* lds, int wave, int lane_) {
        wgu = wgu_; wd = wd_; ws = ws_; scr = (LAS char*)lds + LDS_SCR + wave * SCR_WAVE; g2 = (LAS const float*)(lds + LDS_G2);
        gw = blockIdx.x * NWAVES + wave; ngw = gridDim.x * NWAVES; mitems = (N_ITEMS + ngw - 1) / ngw; q = 0;
        lane = lane_; lw = (lane_ >> 2) * (SCR_STRIDE * 4) + (lane_ & 3) * 16; lr = (lane_ >> 4) * (4 * SCR_STRIDE * 4) + (lane_ & 15) * 4; ls = (lane_ & 15) * 1024 + (lane_ >> 4) * 4;
        { const int r = gw & 2047, kb = r >> 7, n0 = (r & 127) * 16, pn = n0 >> 8, w = n0 & 255, sc = w < 128 ? 128 * pn + w : 1024 + 128 * pn + (w - 128);
          gu_src = (unsigned)((64 * kb) * 2048 + sc) * 4u; gu_dst = (unsigned)(n0 * 1024 + 64 * kb); gu_k0 = 64 * kb; }
        { const int r = gw & 1023, kb = r >> 6, n0 = (r & 63) * 16; d_src = (unsigned)((64 * kb) * 1024 + n0) * 4u; d_dst = (unsigned)(n0 * 1024 + 64 * kb); d_e0 = (gw >> 10) & 1; }
    }
    __device__ __forceinline__ bool fast() const { return ngw == 2048; }
    __device__ __forceinline__ int clampm(int m) const { m = m < mitems ? m : mitems - 1; return m < 0 ? 0 : m; }
    __device__ __forceinline__ void decode(int m, const char*& src, unsigned char*& dst, int& sh, int& k0) const {
        m = m < 47 ? m : 47; m = m < 0 ? 0 : m;
        const bool kd = m >= 32; const int ed = d_e0 + 2 * (m - 32);
        const char* sg = (const char*)wgu + ((size_t)m << 23) + gu_src; const char* sd = (const char*)wd + ((size_t)ed << 22) + d_src;
        unsigned char* dg = ws + WS_WGU + ((size_t)m << 21) + gu_dst; unsigned char* dd = ws + WS_WD + ((size_t)ed << 20) + d_dst;
        src = kd ? sd : sg; dst = kd ? dd : dg; sh = kd ? 12 : 13; k0 = kd ? G2_ONES : gu_k0;
    }
    __device__ __forceinline__ void decode_gen(int m, const char*& src, unsigned char*& dst, int& sh, int& k0) const {
        m = clampm(m);
        int it = gw + ngw * m; it = it < N_ITEMS ? it : N_ITEMS - 1;
        if (it < N_GU) { const int e = it >> 11, r = it & 2047, kb = r >> 7, n0 = (r & 127) * 16, pn = n0 >> 8, w = n0 & 255, sc = w < 128 ? 128 * pn + w : 1024 + 128 * pn + (w - 128);
            src = (const char*)(wgu + (size_t)e * (1024 * 2048) + (size_t)(64 * kb) * 2048 + sc); dst = ws + WS_WGU + (size_t)e * (2048 * 1024) + (size_t)n0 * 1024 + 64 * kb; sh = 13; k0 = 64 * kb; }
        else { const int i2 = it - N_GU, e = i2 >> 10, r = i2 & 1023, kb = r >> 6, n0 = (r & 63) * 16;
            src = (const char*)(wd + (size_t)e * (1024 * 1024) + (size_t)(64 * kb) * 1024 + n0); dst = ws + WS_WD + (size_t)e * (1024 * 1024) + (size_t)n0 * 1024 + 64 * kb; sh = 12; k0 = G2_ONES; }
    }
    __device__ __forceinline__ f32x4 load(int tk) const {
        const char* src; unsigned char* dst; int sh, k0; decode(tk >> 2, src, dst, sh, k0);
        const char* sb = src + ((size_t)(16 * (tk & 3)) << sh);
#ifdef BGP_HOT
        sb = (const char*)wgu;
#endif
        const unsigned voff = ((unsigned)(lane >> 2) << sh) + (unsigned)((lane & 3) * 16);
        f32x4 v; asm volatile("global_load_dwordx4 %0, %1, %2 nt" : "=v"(v) : "v"(voff), "s"(sb) : "memory");
        return v;
    }
    __device__ __forceinline__ float scale(int tk) const {
        const char* src; unsigned char* dst; int sh, k0; decode(tk >> 2, src, dst, sh, k0);
        return g2[k0 + 16 * (tk & 3) + (lane >> 2)];
    }
    __device__ __forceinline__ void write(int tk, f32x4 v, float s) const {
        const int m = tk >> 2;
        *(LAS f32x4*)(scr + (m & 1) * SCR_BUF + (tk & 3) * (16 * SCR_STRIDE * 4) + lw) = v * (64.f * s);
    }
    __device__ __forceinline__ f32x4 out_read(int tk) const {
        const int m1 = (tk >> 2) - 1;
        const LAS float* s = (const LAS float*)(scr + (m1 & 1) * SCR_BUF + (tk & 3) * (16 * SCR_STRIDE * 4) + lr);
        return (f32x4){s[0], s[SCR_STRIDE], s[2 * SCR_STRIDE], s[3 * SCR_STRIDE]};
    }
    __device__ __forceinline__ void out_store(int tk, f32x4 r) const {
        const char* src; unsigned char* dst; int sh, k0; decode((tk >> 2) - 1, src, dst, sh, k0);
        const unsigned char* db = dst + 16 * (tk & 3);
        const unsigned w = pack4_fp8(r.x, r.y, r.z, r.w);
        asm volatile("global_store_dword %0, %1, %2" :: "v"(ls), "v"(w), "s"(db) : "memory");
    }
    __device__ __forceinline__ void tick_sync(int tk, bool do_out) const {
        const char* src; unsigned char* dst; int sh, k0; decode_gen(tk >> 2, src, dst, sh, k0);
        const char* p = src + ((size_t)(16 * (tk & 3) + (lane >> 2)) << sh) + (lane & 3) * 16;
        f32x4 v = *(const f32x4*)p; const float s = g2[k0 + 16 * (tk & 3) + (lane >> 2)];
        write(tk, v, s);
        asm volatile("s_waitcnt lgkmcnt(0)" ::: "memory");
        if (do_out) { const char* src1; unsigned char* dst1; int sh1, k1; decode_gen((tk >> 2) - 1, src1, dst1, sh1, k1);
            const f32x4 r = out_read(tk); *(unsigned*)(dst1 + 16 * (tk & 3) + ls) = pack4_fp8(r.x, r.y, r.z, r.w); }
    }
    __device__ __forceinline__ int q_end() const { return 4 * mitems + 4; }
};
}

namespace mla88 {
using mla::glds16; using mla::lds_cptr;
typedef int v8i __attribute__((ext_vector_type(8)));
typedef short v2s __attribute__((ext_vector_type(2)));
#ifdef PROBE_NODMA
#define PROBE_NODMA_ 1
#else
#define PROBE_NODMA_ 0
#endif
#ifndef PSCALE
#define PSCALE 16.0f
#endif
constexpr float PSCALE_LMIN = 512.f;
constexpr int NW = 8, QBLK = 32, QB = 256, KVBLK = 64, NT = SEQ / KVBLK;
constexpr int KSLOT = 6144, VSLOT = 4096, NSLOT_ = 4, LDS_K = 0, LDS_V = NSLOT_ * KSLOT, LDS_OST = LDS_V + NSLOT_ * VSLOT, LDS_WL = LDS_OST + NW * 4096, LDS_BYTES_ = LDS_WL + NW * 128;
static_assert(LDS_BYTES_ <= RING_BYTES, "mla88 LDS");
#define SBAR() __builtin_amdgcn_sched_barrier(0)
#ifdef PROBE_X2BAR
#define WAIT_BAR(N) do { asm volatile("" ::: "memory"); __builtin_amdgcn_s_waitcnt(((N) & 15) | (7 << 4) | (0 << 8)); __builtin_amdgcn_s_barrier(); __builtin_amdgcn_s_barrier(); asm volatile("" ::: "memory"); } while (0)
#else
#define WAIT_BAR(N) do { asm volatile("" ::: "memory"); __builtin_amdgcn_s_waitcnt(((N) & 15) | (7 << 4) | (0 << 8)); __builtin_amdgcn_s_barrier(); asm volatile("" ::: "memory"); } while (0)
#endif
__device__ __forceinline__ void glds16c(const void* gsrc, unsigned lds_dst) {
    asm volatile("s_mov_b32 m0, %1\n\ts_nop 0\n\tglobal_load_lds_dwordx4 %0, off" :: "v"(gsrc), "s"(lds_dst) : "memory", "m0"); }
__device__ __forceinline__ v8i kfrag8(lds_cptr slot, int n, int ks, int r32, int hi) {
    const lds_cptr p = slot + (ks == 0 ? 2 * hi : 4) * 1024 + (32 * n + r32) * 16;
    const u32x4 a = *(const LAS u32x4*)p, b = *(const LAS u32x4*)(p + 1024);
    return (v8i){(int)a.x, (int)a.y, (int)a.z, (int)a.w, (int)b.x, (int)b.y, (int)b.z, (int)b.w};
}
#define MF8(a, b, c) __builtin_amdgcn_mfma_scale_f32_32x32x64_f8f6f4(a, b, c, 0, 0, 0, 0x7f7f7f7f, 0, 0x7b7b7b7b)
#define MF8V(a, b, c) __builtin_amdgcn_mfma_scale_f32_32x32x64_f8f6f4(a, b, c, 0, 0, 0, 0x7f7f7f7f, 0, 0x7f7f7f7f)
__device__ __forceinline__ v8i vfrag8(lds_cptr slot, int dh, int r32, int hi) {
    const lds_cptr p = slot + dh * 2048 + (2 * hi) * 512 + r32 * 16;
    const u32x4 a = *(const LAS u32x4*)p, b = *(const LAS u32x4*)(p + 512);
    return (v8i){(int)a.x, (int)a.y, (int)a.z, (int)a.w, (int)b.x, (int)b.y, (int)b.z, (int)b.w};
}

__device__ __forceinline__ bool mla88_unit(int b, int h, int qb, const unsigned char* Q8, const unsigned char* __restrict__ K8im, const unsigned char* __restrict__ V8im, bf16_t* O, LAS char* shm, bgc::Bg& bg) {
    const int tid = threadIdx.x, lane = tid & 63, r32 = lane & 31, hi = lane >> 5; const int wid = __builtin_amdgcn_readfirstlane(tid >> 6);
    const long rowbase = (long)b * SEQ; const int q0 = qb * QB;
    const unsigned char* Qw = Q8 + (size_t)(rowbase + q0 + wid * QBLK + r32) * 768 + h * 96;
    const unsigned lds0 = (unsigned)(uintptr_t)shm;
    const int kpc = wid < 6 ? wid : wid - 6;
#ifdef MLA_FLAT_DMA
    const unsigned char* ksrc = K8im + kpc * 1024 + lane * 16;
    const unsigned char* vsrc = V8im + (wid & 3) * 1024 + lane * 16;
#else
    const unsigned char* dbase = K8im < V8im ? K8im : V8im;
    const __amdgpu_buffer_rsrc_t srd = __builtin_amdgcn_make_buffer_rsrc((void*)dbase, (short)0, (int)0x7fffffff, 0x00020000);
    const unsigned kso = (unsigned)__builtin_amdgcn_readfirstlane((int)(K8im - dbase)), vso = (unsigned)__builtin_amdgcn_readfirstlane((int)(V8im - dbase));
    const unsigned kvo = (unsigned)(kpc * 1024 + lane * 16), vvo = (unsigned)((wid & 3) * 1024 + lane * 16);
#endif
    const unsigned kdst = lds0 + LDS_K + kpc * 1024, vdst = lds0 + LDS_V + (wid & 3) * 1024;
#ifdef MLA_FLAT_DMA
#define DMA_K(t, sl) glds16c(ksrc + (long)(t) * 6144, (unsigned)__builtin_amdgcn_readfirstlane(kdst + (sl) * KSLOT))
#define DMA_V(t, sl) glds16c(vsrc + (long)(t) * 4096, (unsigned)__builtin_amdgcn_readfirstlane(vdst + (sl) * VSLOT))
#else
#define DMA_B(m0v, vo, so) asm volatile("s_mov_b32 m0, %0\n\ts_nop 0\n\tbuffer_load_dwordx4 %1, %2, %3 offen lds" :: "s"(m0v), "v"(vo), "s"(srd), "s"(so) : "m0", "memory")
#define DMA_K(t, sl) DMA_B((unsigned)__builtin_amdgcn_readfirstlane(kdst + (sl) * KSLOT), kvo, (unsigned)__builtin_amdgcn_readfirstlane((int)(kso + (unsigned)(t) * 6144u)))
#define DMA_V(t, sl) DMA_B((unsigned)__builtin_amdgcn_readfirstlane(vdst + (sl) * VSLOT), vvo, (unsigned)__builtin_amdgcn_readfirstlane((int)(vso + (unsigned)(t) * 4096u)))
#endif
    const lds_cptr shm3 = (lds_cptr)shm; const lds_cptr ks0 = shm3 + LDS_K; const lds_cptr vs0 = shm3 + LDS_V;
    v8i kf[4];
    DMA_K(0, 0); DMA_V(0, 0); DMA_K(1, 1); DMA_V(1, 1); DMA_K(2, 2); DMA_K(3, 3);
    v8i qr[2];
    { const u32x4 a = *(const u32x4*)(Qw + 32 * hi), c = *(const u32x4*)(Qw + 32 * hi + 16); qr[0] = (v8i){(int)a.x, (int)a.y, (int)a.z, (int)a.w, (int)c.x, (int)c.y, (int)c.z, (int)c.w};
      u32x4 d = *(const u32x4*)(Qw + 64), e = *(const u32x4*)(Qw + 80); if (hi) { d = (u32x4){0u, 0u, 0u, 0u}; e = d; }
      qr[1] = (v8i){(int)d.x, (int)d.y, (int)d.z, (int)d.w, (int)e.x, (int)e.y, (int)e.z, (int)e.w}; }
    f32x16 o[2]; o[0] = f32x16{}; o[1] = f32x16{};
    f32x16 pA0, pA1, pB0, pB1;
    WAIT_BAR(0);
    { pA0 = MF8(kfrag8(ks0, 0, 0, r32, hi), qr[0], f32x16{}); pA1 = MF8(kfrag8(ks0, 1, 0, r32, hi), qr[0], f32x16{});
      pA0 = MF8(kfrag8(ks0, 0, 1, r32, hi), qr[1], pA0); pA1 = MF8(kfrag8(ks0, 1, 1, r32, hi), qr[1], pA1); }
#pragma unroll
    for (int r = 0; r < 16; ++r) { pA0[r] = __builtin_amdgcn_exp2f(pA0[r]); if (r < 8) pA1[r] = __builtin_amdgcn_exp2f(pA1[r]); }
    kf[0] = kfrag8(ks0 + KSLOT, 0, 0, r32, hi); kf[1] = kfrag8(ks0 + KSLOT, 0, 1, r32, hi); kf[2] = kfrag8(ks0 + KSLOT, 1, 0, r32, hi); kf[3] = kfrag8(ks0 + KSLOT, 1, 1, r32, hi);
    WAIT_BAR(0);
    DMA_K(4, 0); DMA_V(2, 2);
    v8i vf[2], p8 = {0, 0, 0, 0, 0, 0, 0, 0};
    v8i ones8; { const int on = (((lane >> 4) & 1) == (lane & 15)) ? 0x38383838 : 0; ones8 = (v8i){on, on, on, on, on, on, on, on}; }
    asm volatile("" : "+v"(ones8));
    f32x4 lacc = {0.f, 0.f, 0.f, 0.f};
#define MF16S(a, b, c) __builtin_amdgcn_mfma_scale_f32_16x16x128_f8f6f4(a, b, c, 0, 0, 0, 0x7f7f7f7f, 0, 0x7f7f7f7f)
#ifdef PROBE_X2MFMA
#define X2MF
#else
#define X2MF
#endif
    float psc = PSCALE; asm volatile("" : "+v"(psc));
#define PIN(x) asm volatile("" : "+v"(x))
#ifdef PROBE_NOEXP
#define EX(v) (v)
#else
#define EX(v) __builtin_amdgcn_exp2f(v)
#endif
#ifdef PROBE_NOCVT
#define PK4O(O, P, B) do { } while (0)
#else
#define PK4O(O, P, B) do { int t_; asm volatile("v_cvt_scalef32_pk_fp8_f32 %0, %1, %2, %3" : "=v"(t_) : "v"(P[B]), "v"(P[B + 1]), "v"(psc)); \
    asm volatile("v_cvt_scalef32_pk_fp8_f32 %0, %1, %2, %3 op_sel:[0,0,0,1]" : "+v"(t_) : "v"(P[B + 2]), "v"(P[B + 3]), "v"(psc)); O = t_; } while (0)
#endif
#define KRD(G, j, SN) do { if (G) { kf[j] = kfrag8(ks0 + (SN) * KSLOT, (j) >> 1, (j) & 1, r32, hi); SBAR(); } } while (0)
#define GAPS(MFX, P, W, PE, N0, N1) do { MFX; SBAR(); _Pragma("unroll") for (int r_ = N0; r_ < N1; ++r_) PE[r_] = EX(PE[r_]); PIN(PE); \
    PK4O(p8[W], P, 0); PK4O(p8[W + 1], P, 4); PK4O(p8[W + 2], P, 8); PK4O(p8[W + 3], P, 12); PIN(p8); SBAR(); } while (0)
#ifdef PROBE_X2ADD
#define GAPE(MFX, X, N0, N1) do { MFX; SBAR(); _Pragma("unroll") for (int r_ = N0; r_ < N1; ++r_) { X[r_] = EX(X[r_]); float d_; asm volatile("v_add_f32 %0, %1, %1\n\tv_add_f32 %0, %1, %1" : "=v"(d_) : "v"(X[r_ ^ 8])); } PIN(X); SBAR(); } while (0)
#elif defined(PROBE_X2EXP)
#define GAPE(MFX, X, N0, N1) do { MFX; SBAR(); _Pragma("unroll") for (int r_ = N0; r_ < N1; ++r_) { X[r_] = EX(X[r_]); float d_; asm volatile("v_exp_f32 %0, %1" : "=v"(d_) : "v"(X[r_ ^ 8])); } PIN(X); SBAR(); } while (0)
#else
#define GAPE(MFX, X, N0, N1) do { MFX; SBAR(); _Pragma("unroll") for (int r_ = N0; r_ < N1; ++r_) X[r_] = EX(X[r_]); PIN(X); SBAR(); } while (0)
#endif
#define EXPS(X, N0, N1) do { _Pragma("unroll") for (int r_ = N0; r_ < N1; ++r_) X[r_] = EX(X[r_]); PIN(X); } while (0)
#define STEP(C0, C1, P0, P1, t, S, GK, GV, GL, H0, H1, H2) do { SBAR(); \
    H0; SBAR(); \
    C0 = MF8(kf[0], qr[0], f32x16{}); PIN(C0); SBAR(); vf[0] = vfrag8(vs0 + (((S) + 3) & 3) * VSLOT, 0, r32, hi); EXPS(P1, 8, 12);  PK4O(p8[0], P0, 0); PK4O(p8[1], P0, 4);  PIN(p8); SBAR(); \
    C0 = MF8(kf[1], qr[1], C0); PIN(C0);       SBAR(); vf[1] = vfrag8(vs0 + (((S) + 3) & 3) * VSLOT, 1, r32, hi); EXPS(P1, 12, 16); PK4O(p8[2], P0, 8); PK4O(p8[3], P0, 12); PIN(p8); SBAR(); \
    C1 = MF8(kf[2], qr[0], f32x16{}); PIN(C1); SBAR(); \
    H1; if (GK && !PROBE_NODMA_) { DMA_K((t) + 4, (S)); } if (GV && !PROBE_NODMA_) { DMA_V((t) + 2, ((S) + 2) & 3); } H2; SBAR(); \
    EXPS(C0, 0, 6);   PK4O(p8[4], P1, 0); PK4O(p8[5], P1, 4);  PIN(p8); SBAR(); \
    C1 = MF8(kf[3], qr[1], C1); PIN(C1);       SBAR(); EXPS(C0, 6, 12);  PK4O(p8[6], P1, 8); PK4O(p8[7], P1, 12); PIN(p8); SBAR(); \
    o[0] = MF8V(p8, vf[0], o[0]); PIN(o[0]); SBAR(); KRD(GL, 0, ((S) + 1) & 3); KRD(GL, 1, ((S) + 1) & 3); EXPS(C0, 12, 16); SBAR(); \
    o[1] = MF8V(p8, vf[1], o[1]); PIN(o[1]); SBAR(); KRD(GL, 2, ((S) + 1) & 3); KRD(GL, 3, ((S) + 1) & 3); EXPS(C1, 0, 4); SBAR(); \
    lacc = MF16S(p8, ones8, lacc); PIN(lacc); SBAR(); EXPS(C1, 4, 8); SBAR(); \
    } while (0)
    f32x4 bgv = {0.f, 0.f, 0.f, 0.f}, bgr = {0.f, 0.f, 0.f, 0.f}; float bgs = 0.f;
#ifdef BG_CONV
#ifndef BGP_NLD
#define BGP_NLD 1
#endif
#ifndef BGP_NST
#define BGP_NST 1
#endif
#ifndef BGP_LDS
#define BGP_LDS 1
#endif
#define BG_STR_(x) #x
#define BG_STR(x) BG_STR_(x)
#define WAIT_BARX(N) asm volatile("s_waitcnt vmcnt(" BG_STR(N) ") lgkmcnt(0)\n\ts_barrier" ::: "memory")
#if BGP_NLD
#define BG_LOAD  bgv = bg.load(bg.q)
#else
#define BG_LOAD
#endif
#if BGP_LDS
#define BG_SC    bgs = bg.scale(bg.q)
#define BG_RD    bgr = bg.out_read(bg.q)
#else
#define BG_SC
#define BG_RD
#endif
#if BGP_NST
#define BG_OUT   bg.out_store(bg.q, bgr)
#define BG_WCNT 5
#else
#define BG_OUT   do { unsigned w_ = pack4_fp8(bgr.x, bgr.y, bgr.z, bgr.w); asm volatile("" :: "v"(w_)); } while (0)
#define BG_WCNT 4
#endif
#if BGP_LDS
#define BG_WRITE do { asm volatile("" : "+v"(bgv)); bg.write(bg.q, bgv, bgs); } while (0)
#else
#define BG_WRITE do { asm volatile("" : "+v"(bgv)); } while (0)
#endif
#define BG_NEXT  bg.q += 1
#if BGP_NLD && BGP_NST
#define WB1 WAIT_BAR(5)
#define WB2 WAIT_BAR(6)
#define WB3 WAIT_BAR(5)
#elif BGP_NLD
#define WB1 WAIT_BAR(5)
#define WB2 WAIT_BAR(5)
#define WB3 WAIT_BAR(4)
#elif BGP_NST
#define WB1 WAIT_BAR(4)
#define WB2 WAIT_BAR(5)
#define WB3 WAIT_BAR(5)
#else
#define WB1 WAIT_BAR(4)
#define WB2 WAIT_BAR(4)
#define WB3 WAIT_BAR(4)
#endif
#else
#define BG_LOAD
#define BG_SC
#define BG_RD
#define BG_OUT
#define BG_WRITE
#define BG_NEXT
#define WB1 WAIT_BAR(4)
#define WB2 WAIT_BAR(4)
#define WB3 WAIT_BAR(4)
#endif
#define NOH do { } while (0)
#ifdef MLA_PRIO
    if (wid >= 4) __builtin_amdgcn_s_setprio(1);
#endif
    int t = 1;
    for (; t < NT - 7; t += 4) {
        STEP(pB0, pB1, pA0, pA1, t, 1, true, true, true, BG_LOAD; BG_SC, NOH, NOH);     WB1;
        STEP(pA0, pA1, pB0, pB1, t + 1, 2, true, true, true, BG_RD, NOH, BG_OUT);       WB2;
        STEP(pB0, pB1, pA0, pA1, t + 2, 3, true, true, true, NOH, NOH, NOH);            WB3;
        STEP(pA0, pA1, pB0, pB1, t + 3, 0, true, true, true, BG_WRITE, NOH, NOH);       WAIT_BAR(4); BG_NEXT;
    }
    static_assert(((NT - 7) & 3) == 1, "tail starts in slot 1");
    STEP(pB0, pB1, pA0, pA1, NT - 7, 1, true, true, true, NOH, NOH, NOH);    WAIT_BAR(4);
    STEP(pA0, pA1, pB0, pB1, NT - 6, 2, true, true, true, NOH, NOH, NOH);    WAIT_BAR(4);
    STEP(pB0, pB1, pA0, pA1, NT - 5, 3, true, true, true, NOH, NOH, NOH);    WAIT_BAR(4);
    STEP(pA0, pA1, pB0, pB1, NT - 4, 0, false, true, true, NOH, NOH, NOH);   WAIT_BAR(3);
    STEP(pB0, pB1, pA0, pA1, NT - 3, 1, false, true, true, NOH, NOH, NOH);   WAIT_BAR(2);
    STEP(pA0, pA1, pB0, pB1, NT - 2, 2, false, false, true, NOH, NOH, NOH);  WAIT_BAR(0);
    STEP(pB0, pB1, pA0, pA1, NT - 1, 3, false, false, false, NOH, NOH, NOH);
#ifdef MLA_PRIO
    __builtin_amdgcn_s_setprio(0);
#endif
    {
#pragma unroll
      for (int r = 8; r < 16; ++r) pB1[r] = __builtin_amdgcn_exp2f(pB1[r]);
      PK4O(p8[0], pB0, 0); PK4O(p8[1], pB0, 4); PK4O(p8[2], pB0, 8); PK4O(p8[3], pB0, 12); PK4O(p8[4], pB1, 0); PK4O(p8[5], pB1, 4); PK4O(p8[6], pB1, 8); PK4O(p8[7], pB1, 12);
      SBAR();
      o[0] = MF8V(p8, vfrag8(vs0 + 3 * VSLOT, 0, r32, hi), o[0]); o[1] = MF8V(p8, vfrag8(vs0 + 3 * VSLOT, 1, r32, hi), o[1]); lacc = MF16S(p8, ones8, lacc); }
    float rli[16]; bool bad = false;
    { LAS float* wl2 = (LAS float*)(shm + LDS_WL) + wid * 32;
      if ((lane & 15) < 2) {
#pragma unroll
          for (int i = 0; i < 4; ++i) wl2[4 * (lane >> 4) + i + 16 * (lane & 15)] = lacc[i]; }
      asm volatile("s_waitcnt lgkmcnt(0)" ::: "memory");
#pragma unroll
      for (int r = 0; r < 16; ++r) { const float l = wl2[crow(r, hi)]; rli[r] = __builtin_amdgcn_rcpf(l); bad = bad || !(l >= PSCALE_LMIN); }
    }
    bf16_t* Ow = O + (rowbase + q0 + wid * QBLK) * 512 + h * 64;
    { LAS bf16_t* stg = (LAS bf16_t*)(shm + LDS_OST) + wid * 2048;
#pragma unroll
      for (int r = 0; r < 16; ++r) { const int orow = crow(r, hi);
#pragma unroll
          for (int d0 = 0; d0 < 2; ++d0) stg[orow * 64 + d0 * 32 + r32] = (bf16_t)f2bf(o[d0][r] * rli[r]); }
      asm volatile("s_waitcnt lgkmcnt(0)" ::: "memory");
#pragma unroll
      for (int i = 0; i < 4; ++i) { const int row = i * 8 + (lane >> 3), ch = lane & 7; const u32x4 v = *(const LAS u32x4*)(stg + row * 64 + ch * 8); *(u32x4*)(Ow + (long)row * 512 + ch * 8) = v; } }
    asm volatile("s_waitcnt lgkmcnt(0)\n\ts_barrier" ::: "memory");
#undef DMA_K
#undef DMA_V
#ifndef MLA_FLAT_DMA
#undef DMA_B
#endif
#undef PIN
#undef PK4O
#undef GAPS
#undef GAPE
#undef EX
#undef KRD
#undef STEP
#undef EXPS
#undef BG_LOAD
#undef BG_SC
#undef BG_RD
#undef BG_OUT
#undef BG_WRITE
#undef BG_NEXT
#undef WB1
#undef WB2
#undef WB3
#undef NOH
    return __any(bad) != 0;
}
#undef SBAR
#undef WAIT_BAR
#undef MF8
#undef MF8V
#undef MF16S
}

template <bool F8, class CM> __device__ __forceinline__ void tr_item(const float* W, int ld, const float* rs, bf16_t* WT, int K, int k0, int n0, const CM& cm, LAS float* scr, int lane) {
    const int n = lane & 31, sc = cm.col(n0 + n); const float cs = cm.scale(n0 + n);
#pragma unroll 8
    for (int i = 0; i < 32; ++i) { const int kk = 2 * i + (lane >> 5); float v = 0.f; if (sc >= 0) v = W[(size_t)(k0 + kk) * ld + sc] * cs * (rs ? rs[k0 + kk] : 1.f); scr[kk * 33 + n] = v; }
    asm volatile("s_waitcnt lgkmcnt(0)" ::: "memory");
    const int c = lane & 7;
#pragma unroll
    for (int j = 0; j < 4; ++j) { const int nn = (lane >> 3) + 8 * j; const LAS float* s = scr + (8 * c) * 33 + nn;
        if constexpr (F8) { *(u32x2*)((unsigned char*)WT + (size_t)(n0 + nn) * K + k0 + 8 * c) = (u32x2){pack4_fp8(s[0 * 33], s[1 * 33], s[2 * 33], s[3 * 33]), pack4_fp8(s[4 * 33], s[5 * 33], s[6 * 33], s[7 * 33])}; }
        else { u32x4 o; o.x = pk2(s[0 * 33], s[1 * 33]); o.y = pk2(s[2 * 33], s[3 * 33]); o.z = pk2(s[4 * 33], s[5 * 33]); o.w = pk2(s[6 * 33], s[7 * 33]);
        *(u32x4*)(WT + (size_t)(n0 + nn) * K + k0 + 8 * c) = o; } }
    asm volatile("s_waitcnt lgkmcnt(0)" ::: "memory");
}
#ifdef XW_NT
#define XW_LD(p) __builtin_nontemporal_load(p)
#else
#define XW_LD(p) (*(p))
#endif
template <class CM> __device__ __forceinline__ void tr4_load(f32x4 (&v)[8], const float* W, int ld, int k0, int n0, const CM& cm, int lane) {
    const int n4 = (lane & 7) * 4, sc = cm.col(n0 + n4);
#pragma unroll
    for (int i = 0; i < 8; ++i) { const int kk = (lane >> 3) + 8 * i; v[i] = (sc >= 0) ? XW_LD((const f32x4*)(W + (size_t)(k0 + kk) * ld + sc)) : (f32x4){0.f, 0.f, 0.f, 0.f}; }
}
template <bool F8, class CM, class RSP = const float*> __device__ __forceinline__ void tr4_finish(const f32x4 (&v)[8], RSP rs, bf16_t* WT, int K, int k0, int n0, const CM& cm, LAS float* scr, int lane) {
    const int n4 = (lane & 7) * 4; const float cs = cm.scale(n0 + n4);
#pragma unroll
    for (int i = 0; i < 8; ++i) { const int kk = (lane >> 3) + 8 * i; const float r = cs * (rs ? rs[k0 + kk] : 1.f); LAS float* d = scr + kk * 33 + n4; d[0] = v[i].x * r; d[1] = v[i].y * r; d[2] = v[i].z * r; d[3] = v[i].w * r; }
    asm volatile("s_waitcnt lgkmcnt(0)" ::: "memory");
    const int c = lane & 7;
#pragma unroll
    for (int j = 0; j < 4; ++j) { const int nn = (lane >> 3) + 8 * j; const LAS float* s = scr + (8 * c) * 33 + nn;
        if constexpr (F8) { *(u32x2*)((unsigned char*)WT + (size_t)(n0 + nn) * K + k0 + 8 * c) = (u32x2){pack4_fp8(s[0 * 33], s[1 * 33], s[2 * 33], s[3 * 33]), pack4_fp8(s[4 * 33], s[5 * 33], s[6 * 33], s[7 * 33])}; }
        else { u32x4 o; o.x = pk2(s[0 * 33], s[1 * 33]); o.y = pk2(s[2 * 33], s[3 * 33]); o.z = pk2(s[4 * 33], s[5 * 33]); o.w = pk2(s[6 * 33], s[7 * 33]);
        *(u32x4*)(WT + (size_t)(n0 + nn) * K + k0 + 8 * c) = o; } }
    asm volatile("s_waitcnt lgkmcnt(0)" ::: "memory");
}
template <bool F8, class CM> __device__ __forceinline__ void tr_item4(const float* W, int ld, const float* rs, bf16_t* WT, int K, int k0, int n0, const CM& cm, LAS float* scr, int lane) {
    f32x4 v[8]; tr4_load(v, W, ld, k0, n0, cm, lane); tr4_finish<F8>(v, rs, WT, K, k0, n0, cm, scr, lane);
}
struct CmIn {
    __device__ __forceinline__ int col(int n) const {
        if (n < 1920) return n;
        if (n < 1952) { const int j = n - 1920, i = j >> 1; return 1920 + ((j & 1) ? i + 16 : i); }
        if (n < 2048) return -1;
        { const int j = (n - 2048) >> 8, w = n & 255; return w < 128 ? 1952 + 128 * j + w : 2976 + 128 * j + (w - 128); }
    }
    __device__ __forceinline__ float scale(int n) const { return n < 512 ? 0.125f * LOG2E : 1.f; }
    __device__ __forceinline__ bool regular(int n0) const { return n0 < 1920 || n0 >= 1952; }
};
#ifdef INPROJ_FP8
struct CmIn8 : CmIn { __device__ __forceinline__ float scale(int n) const { return 64.f * CmIn::scale(n); } };
#endif
struct CmUq {
    __device__ __forceinline__ int col(int n) const { const int h = n / 96, w = n % 96; if (w < 64) return n; const int j = w - 64, i = j >> 1; return h * 96 + 64 + ((j & 1) ? i + 16 : i); }
    __device__ __forceinline__ float scale(int) const { return 0.10206207261596577f * LOG2E; }
    __device__ __forceinline__ bool regular(int n0) const { return (n0 % 96) < 64; }
};
struct CmId64 { __device__ __forceinline__ int col(int n) const { return n; } __device__ __forceinline__ float scale(int) const { return 64.f / (-1.702f * LOG2E); } __device__ __forceinline__ bool regular(int) const { return true; } };
struct CmId { int off; __device__ __forceinline__ int col(int n) const { return n - off; } __device__ __forceinline__ float scale(int) const { return 1.f; } __device__ __forceinline__ bool regular(int) const { return true; } };
struct CmGu {
    __device__ __forceinline__ int col(int n) const { const int pn = n >> 8, w = n & 255; return w < 128 ? 128 * pn + w : 1024 + 128 * pn + (w - 128); }
    __device__ __forceinline__ float scale(int) const { return 64.f; }
    __device__ __forceinline__ bool regular(int) const { return true; }
};
template <class CM, bool F8 = false> __device__ __forceinline__ void tr_any(const float* W, int ld, const float* rs, bf16_t* WT, int K, int k0, int n0, const CM& cm, LAS float* scr, int lane) {
    if (cm.regular(n0)) tr_item4<F8>(W, ld, rs, WT, K, k0, n0, cm, scr, lane); else tr_item<F8>(W, ld, rs, WT, K, k0, n0, cm, scr, lane);
}

struct Args { const float* in[19]; float* out; unsigned char* ws; int ph_lo, ph_hi, li, pad; };

#ifdef XW_ITEM64
template <class CM> __device__ __forceinline__ void tr8_load(f32x4 (&v)[16], const float* W, int ld, int k0, int n0, const CM& cm, int lane) {
    const int n4 = (lane & 15) * 4, sc = cm.col(n0 + n4);
#pragma unroll
    for (int i = 0; i < 16; ++i) { const int kk = (lane >> 4) + 4 * i; v[i] = *(const f32x4*)(W + (size_t)(k0 + kk) * ld + sc); }
}
template <class CM, class RSP> __device__ __forceinline__ void tr8_write(const f32x4 (&v)[16], RSP rs, int k0, int n0, const CM& cm, LAS float* scr, int lane) {
    const int n4 = (lane & 15) * 4; const float cs = cm.scale(n0 + n4);
#pragma unroll
    for (int i = 0; i < 16; ++i) { const int kk = (lane >> 4) + 4 * i; const float r = cs * (rs ? rs[k0 + kk] : 1.f); LAS float* d = scr + kk * 65 + n4; d[0] = v[i].x * r; d[1] = v[i].y * r; d[2] = v[i].z * r; d[3] = v[i].w * r; }
    asm volatile("s_waitcnt lgkmcnt(0)" ::: "memory");
}
__device__ __forceinline__ void tr8_store(unsigned char* WT, int K, int k0, int n0, LAS float* scr, int lane) {
    const int c = lane & 7;
#pragma unroll
    for (int j = 0; j < 8; ++j) { const int nn = (lane >> 3) + 8 * j; const LAS float* s = scr + (8 * c) * 65 + nn;
        *(u32x2*)(WT + (size_t)(n0 + nn) * K + k0 + 8 * c) = (u32x2){pack4_fp8(s[0 * 65], s[1 * 65], s[2 * 65], s[3 * 65]), pack4_fp8(s[4 * 65], s[5 * 65], s[6 * 65], s[7 * 65])};
        if (j & 1) asm volatile("" ::: "memory"); }
    asm volatile("s_waitcnt lgkmcnt(0)" ::: "memory");
}
constexpr int XW_IGU = 32 * 16 * 32, XW_NI = XW_IGU + 32 * 16 * 16;
__device__ __forceinline__ void xw_load(f32x4 (&v)[16], const Args& a, int r, int lane) {
    if (r < XW_IGU) tr8_load(v, a.in[14] + (size_t)(r / 512) * 1024 * 2048, 2048, 64 * ((r % 512) / 32), 64 * (r % 32), CmGu{}, lane);
    else { const int q = r - XW_IGU; tr8_load(v, a.in[16] + (size_t)(q / 256) * 1024 * 1024, 1024, 64 * ((q % 256) / 16), 64 * (q % 16), CmId64{}, lane); }
}
__device__ __forceinline__ void xw_write(const f32x4 (&v)[16], const Args& a, int r, LAS float* scr, const LAS float* g2l, int lane) {
    if (r < XW_IGU) tr8_write(v, g2l, 64 * ((r % 512) / 32), 64 * (r % 32), CmGu{}, scr, lane);
    else { const int q = r - XW_IGU; tr8_write(v, (const LAS float*)nullptr, 64 * ((q % 256) / 16), 64 * (q % 16), CmId64{}, scr, lane); }
}
__device__ __forceinline__ void xw_store(const Args& a, int r, LAS float* scr, int lane) {
    unsigned char* ws = a.ws;
    if (r < XW_IGU) tr8_store(ws + WS_WGU + (size_t)(r / 512) * 2048 * 1024, 1024, 64 * ((r % 512) / 32), 64 * (r % 32), scr, lane);
    else { const int q = r - XW_IGU; tr8_store(ws + WS_WD + (size_t)(q / 256) * 1024 * 1024, 1024, 64 * ((q % 256) / 16), 64 * (q % 16), scr, lane); }
}
__device__ __forceinline__ void p0_experts(const Args& a, LAS unsigned char* lds, int wave, int lane, int gw, int NGW, int r0, int NI) {
    LAS float* scr = (LAS float*)(lds + wave * 16640); LAS float* g2l = (LAS float*)(lds + 8 * 16640);
    { int tx = threadIdx.x; asm volatile("" : "+v"(tx)); for (int i = tx; i < 1024; i += NTHREADS) g2l[i] = a.in[11][i]; }
    __syncthreads();
    f32x4 va[16];
    int r = r0 + gw;
    if (r < NI) xw_load(va, a, r, lane);
    for (; r < NI; r += NGW) {
        xw_write(va, a, r, scr, g2l, lane);
        if (r + NGW < NI) xw_load(va, a, r + NGW, lane);
        xw_store(a, r, scr, lane);
    }
}
#else
__device__ __forceinline__ int xw_map(int v, int NGW) {
    constexpr int I_GU = 32 * 16 * 64, NI = I_GU + 32 * 16 * 32;
#ifdef XW_PAIR_K
    if (NI % (2 * NGW) != 0 || I_GU % (2 * NGW) != 0) return v;
    const int q = v / NGW, g = v - q * NGW, pi = g + NGW * (q >> 1), lsb = q & 1;
    if (pi < I_GU / 2) { const int e = pi / 512, t = pi % 512; return e * 1024 + (2 * (t / 64) + lsb) * 64 + (t % 64); }
    const int p2 = pi - I_GU / 2, e = p2 / 256, t = p2 % 256; return I_GU + e * 512 + (2 * (t / 32) + lsb) * 32 + (t % 32);
#else
    return v;
#endif
}
__device__ __forceinline__ void xw_load(f32x4 (&v)[8], const Args& a, int r, int lane) {
    constexpr int I_GU = 32 * 16 * 64;
    if (r < I_GU) tr4_load(v, a.in[14] + (size_t)(r / 1024) * 1024 * 2048, 2048, 64 * ((r % 1024) / 64), 32 * (r % 64), CmGu{}, lane);
    else { const int q = r - I_GU; tr4_load(v, a.in[16] + (size_t)(q / 512) * 1024 * 1024, 1024, 64 * ((q % 512) / 32), 32 * (q % 32), CmId64{}, lane); }
}
__device__ __forceinline__ void xw_fin(const f32x4 (&v)[8], const Args& a, int r, LAS float* scr, const LAS float* g2l, int lane) {
    constexpr int I_GU = 32 * 16 * 64; unsigned char* ws = a.ws;
    if (r < I_GU) tr4_finish<true>(v, g2l, (bf16_t*)(ws + WS_WGU + (size_t)(r / 1024) * 2048 * 1024), 1024, 64 * ((r % 1024) / 64), 32 * (r % 64), CmGu{}, scr, lane);
    else { const int q = r - I_GU; tr4_finish<true>(v, (const LAS float*)nullptr, (bf16_t*)(ws + WS_WD + (size_t)(q / 512) * 1024 * 1024), 1024, 64 * ((q % 512) / 32), 32 * (q % 32), CmId64{}, scr, lane); }
}
__device__ __forceinline__ void p0_experts(const Args& a, LAS unsigned char* lds, int wave, int lane, int gw, int NGW, int r0, int NI) {
    LAS float* scr = (LAS float*)(lds + wave * 16384); LAS float* g2l = (LAS float*)(lds + 131072);
    { int tx = threadIdx.x; asm volatile("" : "+v"(tx)); for (int i = tx; i < 1024; i += NTHREADS) g2l[i] = a.in[11][i]; }
    __syncthreads();
    f32x4 va[8], vb[8], vc[8], vd[8];
    int r = r0 + gw;
    if (r < NI) xw_load(va, a, xw_map(r, NGW), lane);
    if (r + NGW < NI) xw_load(vb, a, xw_map(r + NGW, NGW), lane);
    if (r + 2 * NGW < NI) xw_load(vc, a, xw_map(r + 2 * NGW, NGW), lane);
    for (; r < NI; r += 4 * NGW) {
        if (r + 3 * NGW < NI) xw_load(vd, a, xw_map(r + 3 * NGW, NGW), lane);
        xw_fin(va, a, xw_map(r, NGW), scr, g2l, lane);
        if (r + NGW < NI) { if (r + 4 * NGW < NI) xw_load(va, a, xw_map(r + 4 * NGW, NGW), lane); xw_fin(vb, a, xw_map(r + NGW, NGW), scr, g2l, lane); }
        if (r + 2 * NGW < NI) { if (r + 5 * NGW < NI) xw_load(vb, a, xw_map(r + 5 * NGW, NGW), lane); xw_fin(vc, a, xw_map(r + 2 * NGW, NGW), scr, g2l, lane); }
        if (r + 3 * NGW < NI) { if (r + 6 * NGW < NI) xw_load(vc, a, xw_map(r + 6 * NGW, NGW), lane); xw_fin(vd, a, xw_map(r + 3 * NGW, NGW), scr, g2l, lane); }
    }
}

#endif
__device__ __forceinline__ void p0_prologue(const Args& a, LAS unsigned char* lds, int wave, int lane, int xw_end) {
    LAS float* scr = (LAS float*)(lds + wave * 16384);
    const int gw = blockIdx.x * NWAVES + wave, NGW = gridDim.x * NWAVES;
    unsigned char* ws = a.ws;
    constexpr int I_IN = 16 * 128, I_UQ = 4 * 24, I_UK = 2 * 16, I_UV = 2 * 16, I_A = 8 * 32, I_B = 8 * 32, I_O = 16 * 32, I_GU = 32 * 16 * 64, I_D = 32 * 16 * 32;
    constexpr int NITEMS = I_IN + I_UQ + I_UK + I_UV + I_A + I_B + I_O;
    for (int it = gw; it < NITEMS; it += NGW) {
        int r = it;
#ifdef INPROJ_FP8
        if (r < I_IN) { tr_any<CmIn8, true>(a.in[2], 4000, a.in[1], (bf16_t*)(ws + WS_WIN), 1024, 64 * (r / 128), 32 * (r % 128), CmIn8{}, scr, lane); continue; } r -= I_IN;
#else
        if (r < I_IN) { tr_any(a.in[2], 4000, a.in[1], (bf16_t*)(ws + WS_WIN), 1024, 64 * (r / 128), 32 * (r % 128), CmIn{}, scr, lane); continue; } r -= I_IN;
#endif
        if (r < I_UQ) { tr_any(a.in[5], 768, a.in[3], (bf16_t*)(ws + WS_WUQ), 256, 64 * (r / 24), 32 * (r % 24), CmUq{}, scr, lane); continue; } r -= I_UQ;
        if (r < I_UK) { tr_any(a.in[6], 512, a.in[4], (bf16_t*)(ws + WS_WUKV), 128, 64 * (r / 16), 32 * (r % 16), CmId{0}, scr, lane); continue; } r -= I_UK;
        if (r < I_UV) { tr_any(a.in[7], 512, a.in[4], (bf16_t*)(ws + WS_WUKV), 128, 64 * (r / 16), 512 + 32 * (r % 16), CmId{512}, scr, lane); continue; } r -= I_UV;
        if (r < I_A) { tr_any(a.in[8], 1024, nullptr, (bf16_t*)(ws + WS_WA), 512, 64 * (r / 32), 32 * (r % 32), CmId{0}, scr, lane); continue; } r -= I_A;
        if (r < I_B) { tr_any(a.in[9], 1024, nullptr, (bf16_t*)(ws + WS_WB), 512, 64 * (r / 32), 32 * (r % 32), CmId{0}, scr, lane); continue; } r -= I_B;
        tr_any(a.in[10], 1024, nullptr, (bf16_t*)(ws + WS_WO), 1024, 64 * (r / 32), 32 * (r % 32), CmId{0}, scr, lane);
    }
#if (!defined(BG_CONV) || defined(BG_KEEP_P0))
    if (xw_end > 0) p0_experts(a, lds, wave, lane, gw, NGW, 0, xw_end);
#endif
    for (int m = gw; m < T; m += NGW) {
        const f32x4* xr = (const f32x4*)(a.in[0] + (size_t)m * DM) + lane;
        f32x4 v[4]; float s2 = 0.f;
#pragma unroll
        for (int j = 0; j < 4; ++j) { v[j] = xr[64 * j]; s2 += (v[j].x * v[j].x + v[j].y * v[j].y) + (v[j].z * v[j].z + v[j].w * v[j].w); }
        const float rstd = 1.f / sqrtf(wave_sum(s2) * (1.f / DM) + EPS);
        u32x2* o8 = (u32x2*)((bf16_t*)(ws + WS_XB) + (size_t)m * DM) + lane;
#pragma unroll
#ifdef INPROJ_FP8
        for (int j = 0; j < 4; ++j) ((unsigned*)(ws + WS_XB + (size_t)m * DM))[lane + 64 * j] = pack4_fp8(v[j].x * rstd, v[j].y * rstd, v[j].z * rstd, v[j].w * rstd);
#else
        for (int j = 0; j < 4; ++j) o8[64 * j] = (u32x2){pk2(v[j].x * rstd, v[j].y * rstd), pk2(v[j].z * rstd, v[j].w * rstd)};
#endif
    }
    const int gt = blockIdx.x * NTHREADS + threadIdx.x, NGT = gridDim.x * NTHREADS;
    for (int idx = gt; idx < SEQ * 16; idx += NGT) {
        ((f32x2*)(ws + WS_ROPE))[idx] = rope_cs(idx >> 4, idx & 15);
    }
    for (int idx = gt; idx < 1024 * 32; idx += NGT) ((float*)(ws + WS_WRP))[idx] = a.in[12][idx] * a.in[11][idx >> 5];
}

__device__ __forceinline__ void p2_stats(const Args& a, int wave, int lane) {
    const int gw = blockIdx.x * NWAVES + wave, NGW = gridDim.x * NWAVES; unsigned char* ws = a.ws;
    for (int m = gw; m < T; m += NGW) {
        const u32x2 q = ((const u32x2*)((const bf16_t*)(ws + WS_CQ) + (size_t)m * 256))[lane];
        const unsigned kv = ((const unsigned*)((const bf16_t*)(ws + WS_CKV) + (size_t)m * 128))[lane];
        const float a0 = bflo(q.x), a1 = bfhi(q.x), a2 = bflo(q.y), a3 = bfhi(q.y), b0 = bflo(kv), b1 = bfhi(kv);
        const float sq = wave_sum((a0 * a0 + a1 * a1) + (a2 * a2 + a3 * a3)), sk = wave_sum(b0 * b0 + b1 * b1);
        if (lane == 0) { ((float*)(ws + WS_RSTDQ))[m] = 1.f / sqrtf(sq * (1.f / 256.f) + EPS); ((float*)(ws + WS_RSTDKV))[m] = 1.f / sqrtf(sk * (1.f / 128.f) + EPS); }
#ifdef KEEP_BF16_IMAGES
        if (lane < 32) { const int b = m >> 14, sq2 = m & (SEQ - 1); const u32x4 kr = *(const u32x4*)((const bf16_t*)(ws + WS_KR) + (size_t)m * 32 + 8 * (lane & 3));
            *(u32x4*)((bf16_t*)(ws + WS_KIMG) + (size_t)((b * 8 + (lane >> 2)) * 256 + (sq2 >> 6)) * 6144 + (8 + (lane & 3)) * 512 + (sq2 & 63) * 8) = kr; }
#endif
        if (lane < 16) { const int b = m >> 14, sq2 = m & (SEQ - 1); const bf16_t* kp = (const bf16_t*)(ws + WS_KR) + (size_t)m * 32 + 16 * (lane & 1);
            float k0[8], k1[8]; unpack8(*(const u32x4*)kp, k0); unpack8(*(const u32x4*)(kp + 8), k1);
            *(u32x4*)(ws + WS_K8 + (size_t)((b * 8 + (lane >> 1)) * 256 + (sq2 >> 6)) * 6144 + (4 + (lane & 1)) * 1024 + (sq2 & 63) * 16) =
                (u32x4){pack4_fp8(k0[0], k0[1], k0[2], k0[3]), pack4_fp8(k0[4], k0[5], k0[6], k0[7]), pack4_fp8(k1[0], k1[1], k1[2], k1[3]), pack4_fp8(k1[4], k1[5], k1[6], k1[7])}; }
    }
}

__device__ __forceinline__ void p4_v8t(unsigned char* ws) {
    const bf16_t* VIM = (const bf16_t*)(ws + WS_VIMG); unsigned char* V8 = ws + WS_V8T;
    for (int g = blockIdx.x * NTHREADS + threadIdx.x; g < NB * 8 * 256 * 128; g += gridDim.x * NTHREADS) {
        const int dp = g & 15, ch = (g >> 4) & 3, dh = (g >> 6) & 1, tile = g >> 7, hi = ch >> 1;
        const bf16_t* src = VIM + (size_t)tile * 4096 + dh * 2048 + (ch & 1) * 1024 + 2 * dp;
        unsigned w[16];
#pragma unroll
        for (int i = 0; i < 16; ++i) w[i] = *(const unsigned*)(src + crow(i, hi) * 32);
        u32x4 lo, hi4;
        lo.x = pack4_fp8(bflo(w[0]), bflo(w[1]), bflo(w[2]), bflo(w[3]));     lo.y = pack4_fp8(bflo(w[4]), bflo(w[5]), bflo(w[6]), bflo(w[7]));
        lo.z = pack4_fp8(bflo(w[8]), bflo(w[9]), bflo(w[10]), bflo(w[11]));   lo.w = pack4_fp8(bflo(w[12]), bflo(w[13]), bflo(w[14]), bflo(w[15]));
        hi4.x = pack4_fp8(bfhi(w[0]), bfhi(w[1]), bfhi(w[2]), bfhi(w[3]));    hi4.y = pack4_fp8(bfhi(w[4]), bfhi(w[5]), bfhi(w[6]), bfhi(w[7]));
        hi4.z = pack4_fp8(bfhi(w[8]), bfhi(w[9]), bfhi(w[10]), bfhi(w[11]));  hi4.w = pack4_fp8(bfhi(w[12]), bfhi(w[13]), bfhi(w[14]), bfhi(w[15]));
        u32x4* dst = (u32x4*)(V8 + (size_t)tile * 4096 + dh * 2048 + ch * 512 + dp * 32);
        dst[0] = lo; dst[1] = hi4;
    }
}

__device__ __forceinline__ void p4_dilated(const Args& a, LAS unsigned char* lds, volatile LAS unsigned* MISC, int wave, int lane) {
    unsigned char* ws = a.ws;
    const int r32 = lane & 31, hi = lane >> 5;
#ifndef MLA_PV_BF16
    p4_v8t(ws);
#endif
    {
        LAS unsigned* nm = (LAS unsigned*)(MISC + MI_NRM);
        if (threadIdx.x < 32) nm[threadIdx.x] = 0u;
        __syncthreads();
        const bf16_t* QB = (const bf16_t*)(ws + WS_QB); const bf16_t* KIM = (const bf16_t*)(ws + WS_KIMG); const bf16_t* KR = (const bf16_t*)(ws + WS_KR);
        const int gw = blockIdx.x * NWAVES + wave, NGW = gridDim.x * NWAVES;
#ifndef NORMS_PASS
        for (int t = gw; t < 0; t += NGW) {
#else
        for (int t = gw; t < T; t += NGW) {
#endif
            const int b = t >> 14;
            const u32x2* qp = (const u32x2*)(QB + (size_t)t * 768 + 12 * lane);
            const u32x2 q0 = qp[0], q1 = qp[1], q2 = qp[2];
            float sq = (bflo(q0.x) * bflo(q0.x) + bfhi(q0.x) * bfhi(q0.x)) + (bflo(q0.y) * bflo(q0.y) + bfhi(q0.y) * bfhi(q0.y));
            sq += (bflo(q1.x) * bflo(q1.x) + bfhi(q1.x) * bfhi(q1.x)) + (bflo(q1.y) * bflo(q1.y) + bfhi(q1.y) * bfhi(q1.y));
            sq += (bflo(q2.x) * bflo(q2.x) + bfhi(q2.x) * bfhi(q2.x)) + (bflo(q2.y) * bflo(q2.y) + bfhi(q2.y) * bfhi(q2.y));
            float kk8[8]; unpack8(*(const u32x4*)(KIM + (size_t)((b * 8 + (lane >> 3)) * 256 + ((t & (SEQ - 1)) >> 6)) * 6144 + (lane & 7) * 512 + (t & 63) * 8), kk8);
            float sk = 0.f;
#pragma unroll
            for (int j = 0; j < 8; ++j) sk += kk8[j] * kk8[j];
            float kr8[8]; unpack8(*(const u32x4*)(KR + (size_t)t * 32 + 8 * (lane & 3)), kr8);
            float sr = 0.f;
#pragma unroll
            for (int j = 0; j < 8; ++j) sr += kr8[j] * kr8[j];
            sr += __shfl_xor(sr, 1); sr += __shfl_xor(sr, 2);
            sq += __shfl_xor(sq, 1); sq += __shfl_xor(sq, 2); sq += __shfl_xor(sq, 4);
            sk += __shfl_xor(sk, 1); sk += __shfl_xor(sk, 2); sk += __shfl_xor(sk, 4);
            sk += sr;
            if ((lane & 7) == 0) { const int hh = lane >> 3;
                __hip_atomic_fetch_max(&nm[b * 8 + hh], __float_as_uint(sq), __ATOMIC_RELAXED, __HIP_MEMORY_SCOPE_WORKGROUP);
                __hip_atomic_fetch_max(&nm[16 + b * 8 + hh], __float_as_uint(sk), __ATOMIC_RELAXED, __HIP_MEMORY_SCOPE_WORKGROUP); }
        }
        __syncthreads();
        { int tx = threadIdx.x; asm volatile("" : "+v"(tx));
          if (tx < 32) __hip_atomic_fetch_max((unsigned*)(ws + WS_CTL) + CW_NRM + tx, nm[tx], __ATOMIC_RELAXED, __HIP_MEMORY_SCOPE_AGENT); }
    }
    __syncthreads();
    const bf16_t* QA = (const bf16_t*)(ws + WS_QA); const bf16_t* KA = (const bf16_t*)(ws + WS_KA); const bf16_t* VA = (const bf16_t*)(ws + WS_VA);
    bf16_t* PO = (bf16_t*)(ws + WS_PARTO); float* PL = (float*)(ws + WS_PARTL);
    constexpr int DK = 0, DV = 98304, DWS = 147456;
    const unsigned lds0 = (unsigned)(uintptr_t)lds;
    LAS float* wsf = (LAS float*)(lds + DWS) + wave * 64;
    const int NU = NB * 8 * 192, G_ = gridDim.x;
#define DIL_DECODE(un, p, dil, res, blk, L, b, h) int p, dil, res, blk, L; const int b = ((un) / 192) >> 3, h = ((un) / 192) & 7; { const int w_ = (un) % 192; \
        if (w_ < 64) { p = 0; dil = 1; res = 0; blk = w_; L = SEQ; } else if (w_ < 128) { p = 1; dil = 4; res = (w_ - 64) >> 4; blk = (w_ - 64) & 15; L = SEQ / 4; } else { p = 2; dil = 16; res = (w_ - 128) >> 2; blk = (w_ - 128) & 3; L = SEQ / 16; } }
#ifdef PROBE_DIL_X2K
#define DIL_X2K(x) x
#else
#define DIL_X2K(x)
#endif
#define DIL_DMA_K(un, kb) do { DIL_DECODE(un, p_, dil_, res_, blk_, L_, b_, h_) (void)p_; const int u0_ = 256 * blk_ - 64; _Pragma("unroll") for (int j = 0; j < 6; ++j) { \
        int uk = u0_ + 64 * j + lane; uk = uk < 0 ? 0 : (uk >= L_ ? L_ - 1 : uk); \
        mla::glds16(KA + ((size_t)b_ * SEQ + (size_t)(res_ + dil_ * uk)) * 512 + h_ * 64 + wave * 8, (unsigned)__builtin_amdgcn_readfirstlane(lds0 + DK + (kb) * 49152 + j * 8192 + wave * 1024)); \
        DIL_X2K(mla::glds16(KA + ((size_t)b_ * SEQ + (size_t)(res_ + dil_ * uk)) * 512 + h_ * 64 + wave * 8, (unsigned)__builtin_amdgcn_readfirstlane(lds0 + DK + (kb) * 49152 + j * 8192 + wave * 1024))); } } while (0)
#define DIL_DMA_V(un) do { DIL_DECODE(un, p_, dil_, res_, blk_, L_, b_, h_) (void)p_; const int u0_ = 256 * blk_ - 64; _Pragma("unroll") for (int j = 0; j < 6; ++j) { \
        int uv = u0_ + 64 * j + 16 * (wave & 3) + (lane >> 2); uv = uv < 0 ? 0 : (uv >= L_ ? L_ - 1 : uv); \
        mla::glds16(VA + ((size_t)b_ * SEQ + (size_t)(res_ + dil_ * uv)) * 512 + h_ * 64 + (wave >> 2) * 32 + (lane & 3) * 8, (unsigned)__builtin_amdgcn_readfirstlane(lds0 + DV + j * 8192 + wave * 1024)); } } while (0)
#define DIL_LOAD_Q(un, q) do { DIL_DECODE(un, p_, dil_, res_, blk_, L_, b_, h_) (void)p_; (void)L_; const size_t tq_ = (size_t)b_ * SEQ + (size_t)(res_ + dil_ * (256 * blk_ + 32 * wave + r32)); \
        _Pragma("unroll") for (int d0 = 0; d0 < 4; ++d0) q[d0] = *(const bf16x8*)(QA + tq_ * 512 + h_ * 64 + 16 * d0 + 8 * hi); } while (0)
    float dr[16];
#pragma unroll
    for (int r = 0; r < 16; ++r) dr[r] = (float)(crow(r, hi) - r32);
    int un = blockIdx.x, it = 0;
    bf16x8 qn[4] = {};
    if (un < NU) { DIL_LOAD_Q(un, qn); DIL_DMA_K(un, 0); DIL_DMA_V(un); }
    for (; un < NU; un += G_, ++it) {
        DIL_DECODE(un, p, dil, res, blk, L, b, h)
        const size_t bo = (size_t)b * SEQ; const int kb = it & 1;
        const int ur = 256 * blk + 32 * wave;
        const float slope2d = __builtin_amdgcn_exp2f(-(float)(h + 1)) * LOG2E * (float)dil;
        float sdr[16];
#pragma unroll
        for (int r = 0; r < 16; ++r) sdr[r] = slope2d * dr[r];
        asm volatile("s_waitcnt vmcnt(6)\n\ts_barrier" ::: "memory");
#define DIL_KC(c) (-slope2d * (float)((c) < 2 ? 64 - 32 * (c) : 32 * (c) - 64))
#define DIL_SCORE(c, sc) f32x16 sc = {}; { const int cw = wave + (c), j = cw >> 1, n = cw & 1; \
            const LAS char* kp = (const LAS char*)lds + DK + kb * 49152 + j * 8192 + hi * 1024 + (32 * n + r32) * 16; \
            _Pragma("unroll") for (int d0 = 0; d0 < 4; ++d0) sc = __builtin_amdgcn_mfma_f32_32x32x16_bf16(*(const LAS bf16x8*)(kp + d0 * 2048), qn[d0], sc, 0, 0, 0); \
            const int vb = ur - 64 + 32 * (c); \
              \
              \
            if ((c) < 2) { _Pragma("unroll") for (int r = 0; r < 16; ++r) sc[r] += sdr[r]; } \
            else if ((c) == 2) { _Pragma("unroll") for (int r = 0; r < 16; ++r) sc[r] -= fabsf(sdr[r]); } \
            else { _Pragma("unroll") for (int r = 0; r < 16; ++r) sc[r] -= sdr[r]; } \
            if ((c) == 0) { _Pragma("unroll") for (int r = 0; r < 16; ++r) sc[r] = (dr[r] >= 0.f) ? sc[r] : -1e30f; }       \
            if ((c) == 4) { _Pragma("unroll") for (int r = 0; r < 16; ++r) sc[r] = (dr[r] <= 0.f) ? sc[r] : -1e30f; }       \
            if (vb < 0 || vb + 31 >= L) { _Pragma("unroll") for (int r = 0; r < 16; ++r) { const int v = vb + crow(r, hi); sc[r] = (v >= 0 && v < L) ? sc[r] : -1e30f; } } }
        float mx = -1e30f;
#ifdef DIL_TWO_SWEEPS
#pragma unroll
        for (int c = 0; c < 5; ++c) { DIL_SCORE(c, sc)
#pragma unroll
            for (int r = 0; r < 16; ++r) mx = fmaxf(mx, sc[r] + DIL_KC(c));
            asm volatile("" : "+v"(mx) :: "memory"); __builtin_amdgcn_sched_barrier(0); }
        mx = swapmax(mx);
#else
        f32x16 sc2;
        { DIL_SCORE(2, sc)
#pragma unroll
            for (int r = 0; r < 16; ++r) mx = fmaxf(mx, sc[r]);
            sc2 = sc;
            asm volatile("" : "+v"(mx), "+v"(sc2) :: "memory"); __builtin_amdgcn_sched_barrier(0); }
        mx = swapmax(mx) + 32.f;
#endif
        float ps = 0.f; u32x4 pw[5][2];
#pragma unroll
        for (int c = 0; c < 5; ++c) {
#ifdef DIL_TWO_SWEEPS
            DIL_SCORE(c, sc)
#else
            f32x16 sc; if (c == 2) sc = sc2; else { DIL_SCORE(c, scx) sc = scx; }
#endif
            const float mc = mx - DIL_KC(c);
#pragma unroll
            for (int r = 0; r < 16; ++r) { sc[r] = fexp2(sc[r] - mc); ps += sc[r]; }
            pw[c][0] = (u32x4){cvtpk(sc[0], sc[1]), cvtpk(sc[2], sc[3]), cvtpk(sc[4], sc[5]), cvtpk(sc[6], sc[7])};
            pw[c][1] = (u32x4){cvtpk(sc[8], sc[9]), cvtpk(sc[10], sc[11]), cvtpk(sc[12], sc[13]), cvtpk(sc[14], sc[15])};
            asm volatile("" : "+v"(ps), "+v"(pw[c][0]), "+v"(pw[c][1]) :: "memory"); __builtin_amdgcn_sched_barrier(0); }
#if !defined(DIL_TWO_SWEEPS) && !defined(DIL_NO_GUARD)
#ifdef DIL_FORCE_REDO
        if (true) {
#else
        if (__builtin_expect(__any(!(ps < 3.0e38f)), 0)) {
#endif
            mx = -1e30f;
#pragma unroll
            for (int c = 0; c < 5; ++c) { DIL_SCORE(c, sc)
#pragma unroll
                for (int r = 0; r < 16; ++r) mx = fmaxf(mx, sc[r] + DIL_KC(c));
                asm volatile("" : "+v"(mx) :: "memory"); __builtin_amdgcn_sched_barrier(0); }
            mx = swapmax(mx); ps = 0.f;
#pragma unroll
            for (int c = 0; c < 5; ++c) { DIL_SCORE(c, sc) const float mc = mx - DIL_KC(c);
#pragma unroll
                for (int r = 0; r < 16; ++r) { sc[r] = fexp2(sc[r] - mc); ps += sc[r]; }
                pw[c][0] = (u32x4){cvtpk(sc[0], sc[1]), cvtpk(sc[2], sc[3]), cvtpk(sc[4], sc[5]), cvtpk(sc[6], sc[7])};
                pw[c][1] = (u32x4){cvtpk(sc[8], sc[9]), cvtpk(sc[10], sc[11]), cvtpk(sc[12], sc[13]), cvtpk(sc[14], sc[15])};
                asm volatile("" : "+v"(ps), "+v"(pw[c][0]), "+v"(pw[c][1]) :: "memory"); __builtin_amdgcn_sched_barrier(0); }
        }
#endif
#undef DIL_SCORE
#undef DIL_KC
        if (un + G_ < NU) DIL_LOAD_Q(un + G_, qn);
        const float lt = swapsum(ps);
        if (hi == 0) { wsf[32 + r32] = lt; PL[(((size_t)p * NB + b) * 8 + h) * SEQ + (res + dil * (ur + r32))] = mx + __builtin_amdgcn_logf(lt); }
        asm volatile("s_waitcnt vmcnt(0) lgkmcnt(0)\n\ts_barrier" ::: "memory");
        if (un + G_ < NU) DIL_DMA_K(un + G_, kb ^ 1);
        f32x16 o0 = {}, o1 = {};
#pragma unroll
        for (int c = 0; c < 5; ++c) {
            const int cw = wave + c, j = cw >> 1, n = cw & 1;
            const LAS char* vp = (const LAS char*)lds + DV + j * 8192 + n * 2048 + ((lane >> 4) & 1) * 32 + (lane & 3) * 8 + (4 * hi + ((lane & 15) >> 2)) * 64;
#pragma unroll
            for (int ks = 0; ks < 2; ++ks) {
                const s16x4 l0 = vtr(vp + ks * 1024), h0 = vtr(vp + ks * 1024 + 512), l1 = vtr(vp + 4096 + ks * 1024), h1 = vtr(vp + 4096 + ks * 1024 + 512);
                const bf16x8 v0 = {l0[0], l0[1], l0[2], l0[3], h0[0], h0[1], h0[2], h0[3]}, v1 = {l1[0], l1[1], l1[2], l1[3], h1[0], h1[1], h1[2], h1[3]};
                const bf16x8 pa = __builtin_bit_cast(bf16x8, pw[c][ks]);
                o0 = __builtin_amdgcn_mfma_f32_32x32x16_bf16(pa, v0, o0, 0, 0, 0);
                o1 = __builtin_amdgcn_mfma_f32_32x32x16_bf16(pa, v1, o1, 0, 0, 0);
            }
        }
#ifdef PARTO_BF16
        { LAS bf16_t* stg = (LAS bf16_t*)(lds + DK + kb * 49152) + wave * 2048;
#pragma unroll
          for (int r = 0; r < 16; ++r) { const int q = crow(r, hi); const float il = frcp(wsf[32 + q]);
              const unsigned w01 = cvtpk(o0[r] * il, o1[r] * il);
              stg[q * 64 + r32] = (bf16_t)(w01 & 0xffffu); stg[q * 64 + 32 + r32] = (bf16_t)(w01 >> 16); }
#pragma unroll
          for (int i = 0; i < 4; ++i) { const int row = i * 8 + (lane >> 3), ch = lane & 7; const u32x4 v = *(const LAS u32x4*)(stg + row * 64 + ch * 8);
              *(u32x4*)(PO + ((size_t)p * T + bo + (size_t)(res + dil * (ur + row))) * 512 + h * 64 + ch * 8) = v; } }
#else
        { LAS unsigned char* stg = (LAS unsigned char*)(lds + DK + kb * 49152) + wave * 2048;
#pragma unroll
          for (int r = 0; r < 16; ++r) { const int q = crow(r, hi); const float il = 16.f * frcp(wsf[32 + q]);
              const int w01 = __builtin_amdgcn_cvt_pk_fp8_f32(o0[r] * il, o1[r] * il, 0, false);
              stg[q * 64 + r32] = (unsigned char)(w01 & 0xff); stg[q * 64 + 32 + r32] = (unsigned char)((w01 >> 8) & 0xff); }
#pragma unroll
          for (int i = 0; i < 2; ++i) { const int row = i * 16 + (lane >> 2), ch = lane & 3; const u32x4 v = *(const LAS u32x4*)(stg + row * 64 + ch * 16);
              *(u32x4*)((unsigned char*)PO + ((size_t)p * T + bo + (size_t)(res + dil * (ur + row))) * 512 + h * 64 + ch * 16) = v; } }
#endif
        asm volatile("s_waitcnt lgkmcnt(0)\n\ts_barrier" ::: "memory");
        if (un + G_ < NU) DIL_DMA_V(un + G_);
    }
    asm volatile("s_waitcnt vmcnt(0)" ::: "memory");
    __syncthreads();
#undef DIL_LOAD_Q
#undef DIL_DECODE
#undef DIL_DMA_K
#undef DIL_DMA_V
}
__device__ __forceinline__ void p5_combine(const Args& a, int wave, int lane) {
    unsigned char* ws = a.ws; const bf16_t* PO = (const bf16_t*)(ws + WS_PARTO); const float* PL = (const float*)(ws + WS_PARTL); bf16_t* OA = (bf16_t*)(ws + WS_OA);
    const int gw = blockIdx.x * NWAVES + wave, NGW = gridDim.x * NWAVES;
    for (int it = gw; it < T; it += NGW) {
        const int t = it, b = t >> 14, s = t & (SEQ - 1), h = lane >> 3, ch = lane & 7;
        const float l0 = PL[(((size_t)0 * NB + b) * 8 + h) * SEQ + s], l1 = PL[(((size_t)1 * NB + b) * 8 + h) * SEQ + s], l2 = PL[(((size_t)2 * NB + b) * 8 + h) * SEQ + s];
        const float mx = fmaxf(fmaxf(l0, l1), l2); float w0 = fexp2(l0 - mx), w1 = fexp2(l1 - mx), w2 = fexp2(l2 - mx); const float iw = frcp(w0 + w1 + w2); w0 *= iw; w1 *= iw; w2 *= iw;
        float v0[8], v1[8], v2[8], o[8];
#ifdef PARTO_BF16
        unpack8(*(const u32x4*)(PO + ((size_t)0 * T + t) * 512 + h * 64 + ch * 8), v0);
        unpack8(*(const u32x4*)(PO + ((size_t)1 * T + t) * 512 + h * 64 + ch * 8), v1);
        unpack8(*(const u32x4*)(PO + ((size_t)2 * T + t) * 512 + h * 64 + ch * 8), v2);
#else
        { const unsigned char* P8 = (const unsigned char*)PO; w0 *= 0.0625f; w1 *= 0.0625f; w2 *= 0.0625f;
          const u32x2 a0 = *(const u32x2*)(P8 + ((size_t)0 * T + t) * 512 + h * 64 + ch * 8), a1 = *(const u32x2*)(P8 + ((size_t)1 * T + t) * 512 + h * 64 + ch * 8), a2 = *(const u32x2*)(P8 + ((size_t)2 * T + t) * 512 + h * 64 + ch * 8);
#define UNP8(w, v) do { const f32x2 e0 = __builtin_amdgcn_cvt_pk_f32_fp8((int)w.x, false), e1 = __builtin_amdgcn_cvt_pk_f32_fp8((int)w.x, true), e2 = __builtin_amdgcn_cvt_pk_f32_fp8((int)w.y, false), e3 = __builtin_amdgcn_cvt_pk_f32_fp8((int)w.y, true); \
            v[0] = e0.x; v[1] = e0.y; v[2] = e1.x; v[3] = e1.y; v[4] = e2.x; v[5] = e2.y; v[6] = e3.x; v[7] = e3.y; } while (0)
          UNP8(a0, v0); UNP8(a1, v1); UNP8(a2, v2);
#undef UNP8
        }
#endif
#pragma unroll
        for (int j = 0; j < 8; ++j) o[j] = w0 * v0[j] + w1 * v1[j] + w2 * v2[j];
        *(u32x4*)(OA + (size_t)t * 512 + h * 64 + ch * 8) = pack8(o);
    }
}
__device__ __forceinline__ void p5_mla(const Args& a, LAS unsigned char* lds, int wave, int lane) {
    unsigned char* ws = a.ws;
    LAS char* vimg = (LAS char*)(lds + wave * 8192); LAS float* wsf = (LAS float*)(lds + wave * 8192 + 4096);
    const int r32 = lane & 31, hi = lane >> 5;
    const bf16_t* QB = (const bf16_t*)(ws + WS_QB); const bf16_t* KIM = (const bf16_t*)(ws + WS_KIMG); const bf16_t* VIM = (const bf16_t*)(ws + WS_VIMG);
    bf16_t* OB = (bf16_t*)(ws + WS_OB);
    const unsigned* nrm = (const unsigned*)(ws + WS_CTL) + CW_NRM;
    unsigned redo = 0u;
    bgc::Bg bg; bg.init(a.in[14], a.in[16], ws, lds, wave, lane);
#ifdef BG_CONV
    { int tx = threadIdx.x; asm volatile("" : "+v"(tx));
      for (int i = tx; i < 1024; i += NTHREADS) ((LAS float*)(lds + bgc::LDS_G2))[i] = a.in[11][i];
      if (tx < 64) ((LAS float*)(lds + bgc::LDS_G2))[bgc::G2_ONES + tx] = 1.f; }
    __syncthreads();
    for (int tk = 0; tk < 4; ++tk) bg.tick_sync(tk, false);
    bg.q = 4;
#endif
    { int it = 0;
    for (int un = blockIdx.x; un < NB * 8 * 64; un += gridDim.x, ++it) {
#ifdef MLA_XCD_MAP
        int qb = un & 63, h = (un >> 6) & 7, b = un >> 9;
        if (gridDim.x == 256) { const int k_ = un >> 8, bx_ = un & 255, pair = (bx_ & 7) + 8 * (k_ >> 1); qb = (bx_ >> 3) + 32 * (k_ & 1); h = pair & 7; b = pair >> 3; }
#else
        const int qb = un & 63, h = (un >> 6) & 7, b = un >> 9;
#endif
        bool fast = true;
#ifdef MLA_FORCE_GENERAL
        fast = false;
#endif
#ifdef MLA_BF16_FAST
        if (__builtin_amdgcn_readfirstlane((int)fast)) mla::mla_unit(b, h, qb, QB, KIM + (size_t)(b * 8 + h) * 256 * 6144, VIM + (size_t)(b * 8 + h) * 256 * 4096, OB, (LAS char*)lds);
#elif defined(MLA_PV_BF16)
        if (__builtin_amdgcn_readfirstlane((int)fast)) mla8::mla8_unit(b, h, qb, (const unsigned char*)(ws + WS_Q8), (const unsigned char*)(ws + WS_K8) + (size_t)(b * 8 + h) * 256 * 6144, VIM + (size_t)(b * 8 + h) * 256 * 4096, OB, (LAS char*)lds);
#else
        if (__builtin_amdgcn_readfirstlane((int)fast)) {
            const bool r = mla88::mla88_unit(b, h, qb, (const unsigned char*)(ws + WS_Q8), (const unsigned char*)(ws + WS_K8) + (size_t)(b * 8 + h) * 256 * 6144, (const unsigned char*)(ws + WS_V8T) + (size_t)(b * 8 + h) * 256 * 4096, OB, (LAS char*)lds, bg);
            redo |= (unsigned)__builtin_amdgcn_readfirstlane((int)r) << it;
        }
#endif
    } }
#ifdef BG_CONV
    if (!bg.fast()) bg.q = 0;
    while (bg.q < bg.q_end()) { bg.tick_sync(bg.q, bg.q >= 4); bg.q += 1; }
#endif
    int it2 = 0;
#ifdef TIME_PROBE
    redo = 0u;
#endif
    for (int un = blockIdx.x; un < NB * 8 * 64; un += gridDim.x, ++it2) {
#ifdef MLA_XCD_MAP
        int qb = un & 63, h = (un >> 6) & 7, b = un >> 9;
        if (gridDim.x == 256) { const int k_ = un >> 8, bx_ = un & 255, pair = (bx_ & 7) + 8 * (k_ >> 1); qb = (bx_ >> 3) + 32 * (k_ & 1); h = pair & 7; b = pair >> 3; }
#else
        const int qb = un & 63, h = (un >> 6) & 7, b = un >> 9;
#endif
        bool fast = !((redo >> it2) & 1u);
#ifdef MLA_FORCE_GENERAL
        fast = false;
#endif
        if (!__builtin_amdgcn_readfirstlane((int)fast)) {
            const size_t bo = (size_t)b * SEQ, tq0 = bo + (size_t)qb * 256 + wave * 32;
#ifdef KEEP_BF16_IMAGES
            MlaKL kl; kl.K = KIM + (size_t)(b * 8 + h) * 256 * 6144; kl.V = VIM + (size_t)(b * 8 + h) * 256 * 4096;
            bf16x8 qf[6];
#pragma unroll
            for (int d0 = 0; d0 < 6; ++d0) qf[d0] = *(const bf16x8*)(QB + (tq0 + r32) * 768 + h * 96 + 16 * d0 + 8 * hi);
#else
            MlaKL8 kl; kl.K = ws + WS_K8 + (size_t)(b * 8 + h) * 256 * 6144; kl.V = VIM + (size_t)(b * 8 + h) * 256 * 4096;
            bf16x8 qf[6];
#pragma unroll
            for (int d0 = 0; d0 < 6; ++d0) qf[d0] = fp8x8_to_bf16(*(const u32x2*)(ws + WS_Q8 + (tq0 + r32) * 768 + h * 96 + 16 * d0 + 8 * hi), 0.0625f);
#endif
            AttnState st; wave_attn<6>(st, qf, kl, SEQ / 32, vimg, wsf, lane);
            (void)attn_finish(st, vimg, wsf, lane);
#pragma unroll
            for (int i = 0; i < 4; ++i) { const int row = i * 8 + (lane >> 3), ch = lane & 7; const u32x4 v = *(const LAS u32x4*)(vimg + row * 128 + ch * 16);
                *(u32x4*)(OB + (tq0 + row) * 512 + h * 64 + ch * 8) = v; }
        }
    }
}

__device__ __forceinline__ void p8_router(const Args& a, LAS unsigned char* lds, volatile LAS unsigned* MISC, int wave, int lane) {
    unsigned char* ws = a.ws; const float* x1 = a.out; const float* wrp = (const float*)(ws + WS_WRP); const float* br = a.in[13];
    LAS float* lg = (LAS float*)(lds + wave * 8192);
    LAS unsigned* hist = (LAS unsigned*)(MISC + MI_HIST);
    if (threadIdx.x < 32) hist[threadIdx.x] = 0u;
    __syncthreads();
    const int G = gridDim.x, i32 = lane & 31, hi = lane >> 5;
    for (int tb = wave * G + blockIdx.x; tb < T / 32; tb += G * NWAVES) {
        const int t = tb * 32 + i32;
        const float* xr = x1 + (size_t)t * DM + 512 * hi; const float* wr_ = wrp + (size_t)(512 * hi) * 32 + i32;
        f32x16 acc = {}; float ssq = 0.f;
#define RT_LOAD(xv, s) do { _Pragma("unroll") for (int j = 0; j < 8; ++j) xv[j] = *(const f32x4*)(xr + 32 * (s) + 4 * j); } while (0)
#define RT_MMA(xv, s) do { _Pragma("unroll") for (int j = 0; j < 8; ++j) { const f32x4 xa = xv[j]; const int k4 = 32 * (s) + 4 * j; \
                ssq += (xa.x * xa.x + xa.y * xa.y) + (xa.z * xa.z + xa.w * xa.w); \
                acc = __builtin_amdgcn_mfma_f32_32x32x2f32(xa.x, wr_[(k4 + 0) * 32], acc, 0, 0, 0); \
                acc = __builtin_amdgcn_mfma_f32_32x32x2f32(xa.y, wr_[(k4 + 1) * 32], acc, 0, 0, 0); \
                acc = __builtin_amdgcn_mfma_f32_32x32x2f32(xa.z, wr_[(k4 + 2) * 32], acc, 0, 0, 0); \
                acc = __builtin_amdgcn_mfma_f32_32x32x2f32(xa.w, wr_[(k4 + 3) * 32], acc, 0, 0, 0); } } while (0)
        { f32x4 xb[8], xn[8];
          RT_LOAD(xb, 0);
#pragma unroll 1
          for (int s32 = 0; s32 < 16; s32 += 2) {
              RT_LOAD(xn, s32 + 1); RT_MMA(xb, s32);
              if (s32 + 2 < 16) RT_LOAD(xb, s32 + 2);
              RT_MMA(xn, s32 + 1);
          } }
#undef RT_LOAD
#undef RT_MMA
        ssq = swapsum(ssq);
        const float rstd = 1.f / sqrtf(ssq * (1.f / DM) + EPS);
#pragma unroll
        for (int r = 0; r < 16; ++r) lg[crow(r, hi) * 33 + i32] = acc[r];
        asm volatile("s_waitcnt lgkmcnt(0)" ::: "memory");
        float v[32];
#pragma unroll
        for (int e = 0; e < 32; ++e) v[e] = lg[i32 * 33 + e] * rstd + br[e];
        int ti[4]; float tv[4];
#pragma unroll
        for (int k = 0; k < 4; ++k) {
            float best = v[0]; int bi = 0;
#pragma unroll
            for (int e = 1; e < 32; ++e) { const bool g = v[e] > best; best = g ? v[e] : best; bi = g ? e : bi; }
            ti[k] = bi; tv[k] = best;
#pragma unroll
            for (int e = 0; e < 32; ++e) v[e] = (e == bi) ? -3.0e38f : v[e];
        }
        const float e1 = __expf(tv[1] - tv[0]), e2 = __expf(tv[2] - tv[0]), e3 = __expf(tv[3] - tv[0]); const float inv = 1.f / (1.f + e1 + e2 + e3);
        const float gw[4] = {inv, e1 * inv, e2 * inv, e3 * inv};
        if (hi == 0) {
            ((float*)(ws + WS_RSTD2))[t] = rstd;
#pragma unroll
            for (int k = 0; k < 4; ++k) { const unsigned rk = __hip_atomic_fetch_add(&hist[ti[k]], 1u, __ATOMIC_RELAXED, __HIP_MEMORY_SCOPE_WORKGROUP);
                ((int*)(ws + WS_TOPI))[t * 4 + k] = ti[k]; ((float*)(ws + WS_GATEW))[t * 4 + k] = gw[k]; ((int*)(ws + WS_SRANK))[t * 4 + k] = (int)rk; }
        }
        asm volatile("s_waitcnt lgkmcnt(0)" ::: "memory");
    }
    __syncthreads();
    { int tx = threadIdx.x; asm volatile("" : "+v"(tx));
      if (tx < 32) {
        const unsigned c = hist[tx];
        const unsigned base = __hip_atomic_fetch_add((unsigned*)(ws + WS_CTL) + CW_GCOUNT + tx, c, __ATOMIC_RELAXED, __HIP_MEMORY_SCOPE_AGENT);
        ((int*)(ws + WS_WGBASE))[blockIdx.x * 32 + tx] = (int)base;
      } }
}
__device__ __forceinline__ void moe_prefix(const Args& a, volatile LAS unsigned* MISC) {
    if (threadIdx.x < 64) {
        const unsigned* gc = (const unsigned*)(a.ws + WS_CTL) + CW_GCOUNT; const int e = threadIdx.x & 31;
        const int c = (int)__hip_atomic_load(gc + e, __ATOMIC_RELAXED, __HIP_MEMORY_SCOPE_AGENT), pad = (c + 255) & ~255;
        int inc = pad;
#pragma unroll
        for (int o = 1; o < 32; o <<= 1) { const int v = __shfl_up(inc, o, 32); if (e >= o) inc += v; }
        if (threadIdx.x < 32) { MISC[MI_PSTART + e] = (unsigned)(inc - pad); MISC[MI_TPRE + e] = (unsigned)((inc - pad) >> 8);
            if (e == 31) { MISC[MI_PSTART + 32] = (unsigned)inc; MISC[MI_TPRE + 32] = (unsigned)(inc >> 8); } }
    }
    __syncthreads();
}
__device__ __forceinline__ void p9_scatter(const Args& a, volatile LAS unsigned* MISC) {
    unsigned char* ws = a.ws; const int G = gridDim.x;
    moe_prefix(a, MISC);
    const int* topi = (const int*)(ws + WS_TOPI); const int* srank = (const int*)(ws + WS_SRANK); const int* wgbase = (const int*)(ws + WS_WGBASE); const float* rstd2 = (const float*)(ws + WS_RSTD2);
    int* pos = (int*)(ws + WS_POS); int* rowtok = (int*)(ws + WS_ROWTOK); float* rowscale = (float*)(ws + WS_ROWSCALE);
    for (int sl = blockIdx.x * NTHREADS + threadIdx.x; sl < NSLOT; sl += G * NTHREADS) {
        const int t = sl >> 2, e = topi[sl], wg = (t >> 5) % G;
        const int row = (int)MISC[MI_PSTART + e] + wgbase[wg * 32 + e] + srank[sl];
        pos[sl] = row; rowtok[row] = t; rowscale[row] = rstd2[t];
    }
    if (blockIdx.x < 32) {
        const int e = blockIdx.x; const int c = (int)__hip_atomic_load((const unsigned*)(ws + WS_CTL) + CW_GCOUNT + e, __ATOMIC_RELAXED, __HIP_MEMORY_SCOPE_AGENT);
        const int r0 = (int)MISC[MI_PSTART + e] + c, r1 = (int)MISC[MI_PSTART + e + 1];
        for (int r = r0 + threadIdx.x; r < r1; r += NTHREADS) { rowtok[r] = 0; rowscale[r] = 0.f; }
    }
}
__device__ __forceinline__ void p12_final(const Args& a, int wave, int lane) {
    unsigned char* ws = a.ws; const int gw = blockIdx.x * NWAVES + wave, NGW = gridDim.x * NWAVES;
    const int* pos = (const int*)(ws + WS_POS); const float* gatew = (const float*)(ws + WS_GATEW); const unsigned char* Y = ws + WS_Y;
    f32x4 g[4];
#pragma unroll
    for (int j = 0; j < 4; ++j) g[j] = ((const f32x4*)a.in[18])[lane + 64 * j];
    for (int t = gw; t < T; t += NGW) {
        f32x4* xr = (f32x4*)(a.out + (size_t)t * DM) + lane;
        f32x4 v[4];
#pragma unroll
        for (int j = 0; j < 4; ++j) v[j] = xr[64 * j];
#ifndef DBG_NO_MOE
#pragma unroll
        for (int k = 0; k < 4; ++k) {
            const int row = pos[t * 4 + k]; const float w = gatew[t * 4 + k] * (1.f / 16.f);
            const unsigned* yr = (const unsigned*)(Y + (size_t)row * DM) + lane;
#pragma unroll
            for (int j = 0; j < 4; ++j) { const int y = (int)yr[64 * j]; const f32x2 lo = __builtin_amdgcn_cvt_pk_f32_fp8(y, false), hi = __builtin_amdgcn_cvt_pk_f32_fp8(y, true);
                v[j].x += w * lo.x; v[j].y += w * lo.y; v[j].z += w * hi.x; v[j].w += w * hi.y; }
        }
#endif
        float s2 = 0.f;
#pragma unroll
        for (int j = 0; j < 4; ++j) s2 += (v[j].x * v[j].x + v[j].y * v[j].y) + (v[j].z * v[j].z + v[j].w * v[j].w);
        const float rstd = 1.f / sqrtf(wave_sum(s2) * (1.f / DM) + EPS);
#pragma unroll
        for (int j = 0; j < 4; ++j) xr[64 * j] = v[j] * rstd * g[j];
    }
}

#ifdef MLA_CHECK
constexpr size_t CK_BASE = 225 * MiB;
constexpr size_t CK_CKVN = CK_BASE, CK_KRR = CK_CKVN + (size_t)T * 128 * 4, CK_KN = CK_KRR + (size_t)T * 32 * 4, CK_VV = CK_KN + (size_t)T * 512 * 4, CK_QS = CK_VV + (size_t)T * 512 * 4;
constexpr int CK_NS = 16;
constexpr size_t CK_OBS = 224 * MiB;
__device__ __forceinline__ int ck_tok(int i) { const int tb[16] = {0, 1, 255, 256, 4097, 8191, 12345, 16383, 16384, 16385, 20000, 24575, 24576, 30001, 32766, 32767}; return tb[i]; }
__device__ __forceinline__ float blk_sum(float v, float* red) {
    v = wave_sum(v); __syncthreads(); if ((threadIdx.x & 63) == 0) red[threadIdx.x >> 6] = v; __syncthreads(); return red[0] + red[1] + red[2] + red[3];
}
__global__ void __launch_bounds__(256) ck_kv(const float* x, const float* g1, const float* w_in, const float* gkv, const float* w_uk, const float* w_uv, unsigned char* ws) {
    __shared__ float hn[1024]; __shared__ float red[4]; __shared__ float c[160]; __shared__ float cn[128];
    const int t = blockIdx.x, tid = threadIdx.x;
    float s2 = 0.f; for (int k = tid; k < 1024; k += 256) { const float v = x[(size_t)t * 1024 + k]; s2 += v * v; }
    const float rstd = 1.f / sqrtf(blk_sum(s2, red) / 1024.f + EPS);
    for (int k = tid; k < 1024; k += 256) hn[k] = x[(size_t)t * 1024 + k] * rstd * g1[k];
    __syncthreads();
    if (tid < 160) { float acc = 0.f; for (int k = 0; k < 1024; ++k) acc += hn[k] * w_in[(size_t)k * 4000 + 1792 + tid]; c[tid] = acc; }
    __syncthreads();
    const float q2 = blk_sum(tid < 128 ? c[tid] * c[tid] : 0.f, red); const float r2 = 1.f / sqrtf(q2 / 128.f + EPS);
    if (tid < 128) cn[tid] = c[tid] * r2 * gkv[tid];
    if (tid < 16) { const f32x2 cs = rope_cs(t & (SEQ - 1), tid); const float x1 = c[128 + tid], x2 = c[128 + 16 + tid];
        ((float*)(ws + CK_KRR))[(size_t)t * 32 + tid] = x1 * cs.x - x2 * cs.y; ((float*)(ws + CK_KRR))[(size_t)t * 32 + 16 + tid] = x2 * cs.x + x1 * cs.y; }
    __syncthreads();
    for (int o = tid; o < 512; o += 256) { float a = 0.f, b = 0.f; for (int k = 0; k < 128; ++k) { a += cn[k] * w_uk[(size_t)k * 512 + o]; b += cn[k] * w_uv[(size_t)k * 512 + o]; }
        ((float*)(ws + CK_KN))[(size_t)t * 512 + o] = a; ((float*)(ws + CK_VV))[(size_t)t * 512 + o] = b; }
}
__global__ void __launch_bounds__(256) ck_q(const float* x, const float* g1, const float* w_in, const float* gq, const float* w_uq, unsigned char* ws) {
    __shared__ float hn[1024]; __shared__ float red[4]; __shared__ float c[256]; __shared__ float qq[768];
    const int t = ck_tok(blockIdx.x), tid = threadIdx.x;
    float s2 = 0.f; for (int k = tid; k < 1024; k += 256) { const float v = x[(size_t)t * 1024 + k]; s2 += v * v; }
    const float rstd = 1.f / sqrtf(blk_sum(s2, red) / 1024.f + EPS);
    for (int k = tid; k < 1024; k += 256) hn[k] = x[(size_t)t * 1024 + k] * rstd * g1[k];
    __syncthreads();
    { float acc = 0.f; for (int k = 0; k < 1024; ++k) acc += hn[k] * w_in[(size_t)k * 4000 + 1536 + tid]; c[tid] = acc; }
    __syncthreads();
    const float q2 = blk_sum(c[tid] * c[tid], red); const float r2 = 1.f / sqrtf(q2 / 256.f + EPS);
    __syncthreads(); c[tid] = c[tid] * r2 * gq[tid]; __syncthreads();
    for (int o = tid; o < 768; o += 256) { float a = 0.f; for (int k = 0; k < 256; ++k) a += c[k] * w_uq[(size_t)k * 768 + o]; qq[o] = a; }
    __syncthreads();
    if (tid < 128) { const int hh = tid >> 4, i = tid & 15; const f32x2 cs = rope_cs(t & (SEQ - 1), i); const float x1 = qq[hh * 96 + 64 + i], x2 = qq[hh * 96 + 80 + i];
        qq[hh * 96 + 64 + i] = x1 * cs.x - x2 * cs.y; qq[hh * 96 + 80 + i] = x2 * cs.x + x1 * cs.y; }
    __syncthreads();
    for (int o = tid; o < 768; o += 256) ((float*)(ws + CK_QS))[(size_t)blockIdx.x * 768 + o] = qq[o] * 0.10206207261596577f;
}
__global__ void __launch_bounds__(256) ck_attn(unsigned char* ws, unsigned* flag) {
    __shared__ float q[96]; __shared__ float red[4]; __shared__ float part[256]; __shared__ float sc[SEQ];
    const int si = blockIdx.x >> 3, h = blockIdx.x & 7, t = ck_tok(si), b = t >> 14, tid = threadIdx.x;
    const float* KN = (const float*)(ws + CK_KN); const float* VV = (const float*)(ws + CK_VV); const float* KRR = (const float*)(ws + CK_KRR);
    if (tid < 96) q[tid] = ((const float*)(ws + CK_QS))[(size_t)si * 768 + h * 96 + tid];
    __syncthreads();
    float mx = -1e30f;
    for (int s = tid; s < SEQ; s += 256) { const size_t ts = (size_t)b * SEQ + s; float a = 0.f; for (int e = 0; e < 64; ++e) a += q[e] * KN[ts * 512 + h * 64 + e]; for (int e = 0; e < 32; ++e) a += q[64 + e] * KRR[ts * 32 + e]; sc[s] = a; mx = fmaxf(mx, a); }
    for (int o = 1; o < 64; o <<= 1) mx = fmaxf(mx, __shfl_xor(mx, o));
    __syncthreads(); if ((tid & 63) == 0) red[tid >> 6] = mx; __syncthreads(); mx = fmaxf(fmaxf(red[0], red[1]), fmaxf(red[2], red[3])); __syncthreads();
    float l = 0.f;
    for (int s = tid; s < SEQ; s += 256) { const float p = expf(sc[s] - mx); sc[s] = p; l += p; }
    l = blk_sum(l, red);
    const int e = tid & 63, g = tid >> 6; float o = 0.f;
    for (int s = g; s < SEQ; s += 4) o += sc[s] * VV[((size_t)b * SEQ + s) * 512 + h * 64 + e];
    part[tid] = o; __syncthreads();
    if (tid < 64) { const float ref = (part[tid] + part[64 + tid] + part[128 + tid] + part[192 + tid]) / l, got = bf2f(((const bf16_t*)(ws + CK_OBS))[(size_t)si * 512 + h * 64 + tid]);
        atomicMax(flag, __float_as_uint(fabsf(ref - got))); atomicMax(flag + 1, __float_as_uint(fabsf(ref))); }
}
__global__ void ck_apply(float* out, const unsigned* flag) {
    const float d = __uint_as_float(flag[0]), r = __uint_as_float(flag[1]);
    const bool bad = !(r > 0.f) || !(d <= MLA_CHECK_TOL * r);
    if (bad) for (size_t i = (size_t)blockIdx.x * blockDim.x + threadIdx.x; i < (size_t)T * DM; i += (size_t)gridDim.x * blockDim.x) out[i] = __builtin_nanf("");
}
#endif

constexpr int N_PHASES = 13;
#ifndef MOE_REV
#define MOE_REV false
#endif
#ifndef ALIGN_MOE
#define ALIGN_MOE true
#endif
#ifndef REP0
#define REP0 1
#endif
#ifndef REP1
#define REP1 1
#endif
#ifndef REP3
#define REP3 1
#endif
#ifndef REP5
#define REP5 1
#endif
#ifndef REP7
#define REP7 1
#endif
#ifndef REP10
#define REP10 1
#endif
#ifndef REP11
#define REP11 1
#endif
#ifndef MK_ONE_LAUNCH
#define MK_ONE_LAUNCH 0
#endif
__global__ void __launch_bounds__(NTHREADS, 2) fwd(Args args) {
    extern __shared__ __attribute__((aligned(16))) unsigned char lds_raw[];
    LAS unsigned char* lds = (LAS unsigned char*)lds_raw;
    volatile LAS unsigned* MISC = (volatile LAS unsigned*)(lds + MISC_OFF);
    const int tid = threadIdx.x, wave = __builtin_amdgcn_readfirstlane(tid >> 6);
#define lane lane_now()
    const int G = gridDim.x, bx = blockIdx.x;
    unsigned char* ws = args.ws;
    for (int u = tid; u < (LDS_BYTES - MISC_OFF) / 4; u += NTHREADS) ((LAS unsigned*)(lds + MISC_OFF))[u] = 0u;
    __syncthreads();
    XcdBarrier bar; bar.bar = (unsigned*)(ws + WS_CTL) + CW_BAR; bar.x = 0; bar.st = nullptr;
    if (MK_ONE_LAUNCH) bar = xcd_barrier_post((unsigned*)(ws + WS_CTL) + CW_BAR, MISC + MI_BAR);
    const int lo = args.ph_lo, hi = args.ph_hi;
#ifdef ONLY_PHASE
#define IN(k) ((k) == ONLY_PHASE && lo <= (k) && (k) < hi)
#else
#define IN(k) (lo <= (k) && (k) < hi)
#endif
#define SEAM(k) do { if (IN(k) && IN((k) + 1)) xcd_barrier(bar); } while (0)
#ifdef SKEW_TICKS
#define SKEW() do { const unsigned long long t0_ = __builtin_amdgcn_s_memrealtime(); const unsigned long long d_ = (unsigned long long)((bx >> 3) & 7) * SKEW_TICKS; while (__builtin_amdgcn_s_memrealtime() - t0_ < d_) __builtin_amdgcn_s_sleep(4); } while (0)
#else
#define SKEW() do { } while (0)
#endif

#ifndef NCONV
#define NCONV 0
#endif
#ifndef XW_P0_ITEMS
#define XW_P0_ITEMS 17408
#endif
#ifdef XW_ITEM64
    constexpr int XW_ALL = XW_NI;
#else
    constexpr int XW_ALL = 32 * 16 * 64 + 32 * 16 * 32;
#endif
    const int nconv = (G >= 4 * NCONV && ((G - NCONV) & 7) == 0) ? NCONV : 0, NGM = G - nconv, xw_p0 = nconv ? XW_P0_ITEMS : XW_ALL;
    if (IN(0)) { p0_prologue(args, lds, wave, lane, xw_p0);
#if defined(PROBE_RD_A) || defined(PROBE_RD_B)
        p0_probe_read(args, wave, lane);
#endif
#if REP0 > 1
        p0_prologue(args, lds, wave, lane, xw_p0);
#endif
    } SEAM(0);
#ifdef INPROJ_FP8
#define PH1_BODY { pg8::DenseSched S; S.init((const bf16_t*)(ws + WS_XB), (const bf16_t*)(ws + WS_WIN), T, NIN, 512, NGM, bx); EpiInProj E{ws, lds}; \
        pg8::gemm_phase2<EpiInProj, pg8::DenseSched, true, true, 121>(lds, 512, S, E); }
#else
#define PH1_BODY { pg8::DenseSched S; S.init((const bf16_t*)(ws + WS_XB), (const bf16_t*)(ws + WS_WIN), T, NIN, 1024, NGM, bx); EpiInProj E{ws, lds}; \
        pg8::gemm_phase2<EpiInProj, pg8::DenseSched, true>(lds, 1024, S, E); }
#endif
    if (IN(1)) { if (bx < NGM) PH1_BODY else p0_experts(args, lds, wave, lane, (bx - NGM) * NWAVES + wave, nconv * NWAVES, xw_p0, XW_ALL);
#if REP1 > 1
        PH1_BODY
#endif
    } SEAM(1);
#ifdef P2_PHASE
    if (IN(2)) { p2_stats(args, wave, lane); } SEAM(2);
#endif
#define PH3_BODY { { pg8::DenseSched S; S.init((const bf16_t*)(ws + WS_CQ), (const bf16_t*)(ws + WS_WUQ), T, 768, 256, G, bx); EpiQ E{ws}; \
          pg8::gemm_phase2<EpiQ, pg8::DenseSched, true>(lds, 256, S, E); } \
        { pg8::DenseSched S; S.init((const bf16_t*)(ws + WS_CKV), (const bf16_t*)(ws + WS_WUKV), T, 1024, 128, G, bx); EpiKV E{ws}; \
          pg8::gemm_phase2<EpiKV, pg8::DenseSched, true>(lds, 128, S, E); } }
    if (IN(3)) { PH3_BODY
#if REP3 > 1
        PH3_BODY
#endif
    } SEAM(3);
    if (IN(4)) { p4_dilated(args, lds, MISC, wave, lane);
#ifdef REP_DIL
        p4_dilated(args, lds, MISC, wave, lane);
#endif
    } SEAM(4);
#if defined(CLK_PROBE) || defined(TIME_PROBE)
    unsigned long long ck0_ = 0, rt0_ = 0, ck1_ = 0, rt1_ = 0;
#endif
    if (IN(5)) { p5_combine(args, wave, lane);
#if defined(CLK_PROBE) || defined(TIME_PROBE)
        ck0_ = __builtin_amdgcn_s_memtime(); rt0_ = __builtin_amdgcn_s_memrealtime();
#endif
        p5_mla(args, lds, wave, lane);
#if defined(CLK_PROBE) || defined(TIME_PROBE)
        ck1_ = __builtin_amdgcn_s_memtime(); rt1_ = __builtin_amdgcn_s_memrealtime();
#endif
#ifdef REP_MLA
        p5_mla(args, lds, wave, lane);
#endif
    } SEAM(5);
#ifdef MLA_CHECK
    if (IN(6) && bx == 0) { for (int i = tid; i < CK_NS * 512; i += NTHREADS) ((bf16_t*)(ws + CK_OBS))[i] = ((const bf16_t*)(ws + WS_OB))[(size_t)ck_tok(i >> 9) * 512 + (i & 511)]; }
#endif
    if (IN(6)) {
        { pg8::TwoSegSched S; S.init((const bf16_t*)(ws + WS_OA), (const bf16_t*)(ws + WS_WA), (const bf16_t*)(ws + WS_OB), (const bf16_t*)(ws + WS_WB), T, 1024, 512, G, bx); EpiGateFused E{ws};
          pg8::gemm_phase2<EpiGateFused, pg8::TwoSegSched, true>(lds, 512, S, E); }
    } SEAM(6);
#define PH7_BODY { pg8::DenseSched S; S.init((const bf16_t*)(ws + WS_MERGED), (const bf16_t*)(ws + WS_WO), T, 1024, 1024, G, bx); EpiResid E{ws, args.in[0], args.out}; \
        pg8::gemm_phase2<EpiResid, pg8::DenseSched, true>(lds, 1024, S, E); }
    if (IN(7)) { PH7_BODY
#if REP7 > 1
        PH7_BODY
#endif
    } SEAM(7);
    if (IN(8)) { p8_router(args, lds, MISC, wave, lane); } SEAM(8);
    if (IN(9)) { p9_scatter(args, MISC); } SEAM(9);
#define PH10_BODY { moe_prefix(args, MISC); \
        pg8::MoeSched<3, true> S; S.tpre = (const LAS int*)(MISC + MI_TPRE); S.ntiles = (int)MISC[MI_TPRE + 32]; S.G = G; S.c = bx; S.K = 512; \
        S.A = (const char*)(ws + WS_H2); S.Bt = (const char*)(ws + WS_WGU); S.estride = (size_t)2048 * 1024; S.row_tok = (const int*)(ws + WS_ROWTOK); \
        EpiSwiglu E{ws, args.in[15]}; \
        pg8::gemm_phase2<EpiSwiglu, pg8::MoeSched<3, true>, ALIGN_MOE, true, 121>(lds, 512, S, E); }
    if (IN(10)) { SKEW(); PH10_BODY
#if REP10 > 1
        PH10_BODY
#endif
    } SEAM(10);
#define PH11_BODY { moe_prefix(args, MISC); \
        pg8::MoeSched<2, false, MOE_REV> S; S.tpre = (const LAS int*)(MISC + MI_TPRE); S.ntiles = (int)MISC[MI_TPRE + 32]; S.G = G; S.c = bx; S.K = 512; \
        S.A = (const char*)(ws + WS_ACT); S.Bt = (const char*)(ws + WS_WD); S.estride = (size_t)1024 * 1024; S.row_tok = nullptr; \
        EpiDown E{ws, args.in[17]}; \
        pg8::gemm_phase2<EpiDown, pg8::MoeSched<2, false, MOE_REV>, ALIGN_MOE, true, 121>(lds, 512, S, E); }
    if (IN(11)) { SKEW(); PH11_BODY
#if REP11 > 1
        PH11_BODY
#endif
    } SEAM(11);
    if (IN(12)) { p12_final(args, wave, lane); }
#ifdef CLK_PROBE
    if (IN(12) && bx == 0) { __syncthreads(); const float mhz = 200.f * __builtin_rintf(0.5f * (float)(ck1_ - ck0_) / (float)(rt1_ - rt0_)); for (int i = tid; i < 1024; i += NTHREADS) args.out[i] = mhz; }
#endif
#ifdef TIME_PROBE
    if (IN(12) && bx == 0) { __syncthreads(); const float us = 0.01f * (float)(rt1_ - rt0_) - (float)(TIME_PROBE); for (int i = tid; i < 1024; i += NTHREADS) args.out[i] = 1000.f * us; }
#endif
#ifdef PROBE_FP8NAN
    if (IN(12) && bx == 0 && wave == 0) {
        typedef int v8i_ __attribute__((ext_vector_type(8))); typedef short v2s_ __attribute__((ext_vector_type(2)));
        float big = 1.0e5f, one = 1.0f, sc = 16.0f; asm volatile("" : "+v"(big), "+v"(one), "+v"(sc));
        v2s_ u = {0, 0}; u = __builtin_amdgcn_cvt_scalef32_pk_fp8_f32(u, big, one, sc, false); u = __builtin_amdgcn_cvt_scalef32_pk_fp8_f32(u, one, one, sc, true);
        int w = __builtin_bit_cast(int, u); asm volatile("" : "+v"(w));
        const bool cvt_nan = ((w & 0x7f) == 0x7f);
        v8i_ A = {w, w, w, w, w, w, w, w}, B = {0x38383838, 0x38383838, 0x38383838, 0x38383838, 0x38383838, 0x38383838, 0x38383838, 0x38383838};
        f32x16 c = __builtin_amdgcn_mfma_scale_f32_32x32x64_f8f6f4(A, B, f32x16{}, 0, 0, 0, 0x7f7f7f7f, 0, 0x7f7f7f7f);
        asm volatile("" : "+v"(c));
        const bool mf_nan = (c[0] != c[0]) && (c[5] != c[5]) && (c[15] != c[15]);
        if (lane == 0) { if (!cvt_nan) args.out[0] = 3.0e6f; if (!mf_nan) args.out[1] = 7.0e6f; }
    }
#endif
#undef IN
#undef SEAM
#undef lane
}

extern "C" void kernel_launch(void* const* d_in, const int* in_sizes, int n_in, void* d_out, int out_size, void* d_ws, size_t ws_size, hipStream_t stream) {
    static int grid = 0;
    if (grid == 0) {
        if (n_in != 19 || in_sizes[0] != T * DM || out_size != T * DM || ws_size < WS_END) { fprintf(stderr, "kernel_launch: unexpected shapes (n_in %d, in0 %d, out %d, ws %zu); nothing launched\n", n_in, n_in > 0 ? in_sizes[0] : -1, out_size, ws_size); grid = -1; return; }
        int dev = 0, cus = 0, per_cu = 0;
        if (hipGetDevice(&dev) != hipSuccess || hipDeviceGetAttribute(&cus, hipDeviceAttributeMultiprocessorCount, dev) != hipSuccess) { grid = -1; return; }
        if (hipFuncSetAttribute((const void*)fwd, hipFuncAttributeMaxDynamicSharedMemorySize, LDS_BYTES) != hipSuccess) { fprintf(stderr, "kernel_launch: hipFuncSetAttribute failed\n"); grid = -1; return; }
        if (hipOccupancyMaxActiveBlocksPerMultiprocessor(&per_cu, (const void*)fwd, NTHREADS, LDS_BYTES) != hipSuccess || per_cu < 1) fprintf(stderr, "kernel_launch: occupancy query reports %d\n", per_cu);
        (void)hipGetLastError();
        grid = cus;
    }
    if (grid < 0) return;
    if (hipMemsetAsync((char*)d_ws + WS_CTL, 0, CTL_ZERO_BYTES, stream) != hipSuccess) { fprintf(stderr, "kernel_launch: memset failed\n"); return; }
    Args a{};
    for (int i = 0; i < 19; ++i) a.in[i] = (const float*)d_in[i];
    a.out = (float*)d_out; a.ws = (unsigned char*)d_ws; a.li = 0; a.pad = 0;
#if MK_ONE_LAUNCH
    a.ph_lo = 0; a.ph_hi = N_PHASES;
    hipLaunchKernelGGL(fwd, dim3(grid), dim3(NTHREADS), LDS_BYTES, stream, a);
#else
    for (int p = 0; p < N_PHASES; ++p) {
        a.ph_lo = p; a.ph_hi = p + 1; hipLaunchKernelGGL(fwd, dim3(grid), dim3(NTHREADS), LDS_BYTES, stream, a); }

#endif
#ifdef MLA_CHECK
    {   unsigned* flag = (unsigned*)((unsigned char*)d_ws + WS_CTL) + 16384;
        hipLaunchKernelGGL(ck_kv, dim3(T), dim3(256), 0, stream, a.in[0], a.in[1], a.in[2], a.in[4], a.in[6], a.in[7], (unsigned char*)d_ws);
        hipLaunchKernelGGL(ck_q, dim3(CK_NS), dim3(256), 0, stream, a.in[0], a.in[1], a.in[2], a.in[3], a.in[5], (unsigned char*)d_ws);
        hipLaunchKernelGGL(ck_attn, dim3(CK_NS * 8), dim3(256), 0, stream, (unsigned char*)d_ws, flag);
        hipLaunchKernelGGL(ck_apply, dim3(1024), dim3(256), 0, stream, (float*)d_out, (const unsigned*)flag); }
#endif
    const hipError_t le = hipPeekAtLastError();
    if (le != hipSuccess) fprintf(stderr, "kernel_launch: launch failed: %s\n", hipGetErrorName(le));
}
```

```cpp
#define MK_ONE_LAUNCH 1
#define INPROJ_FP8 1
#define WO_FP8 1
#include <hip/hip_runtime.h>
#include <cstdio>
#include <cstdint>

#define LAS __attribute__((address_space(3)))
#define GAS __attribute__((address_space(1)))
typedef unsigned short bf16_t;
typedef short bf16x8 __attribute__((ext_vector_type(8)));
typedef short s16x4 __attribute__((ext_vector_type(4)));
typedef float f32x2 __attribute__((ext_vector_type(2)));
typedef float f32x4 __attribute__((ext_vector_type(4)));
typedef float f32x16 __attribute__((ext_vector_type(16)));
typedef unsigned u32x2 __attribute__((ext_vector_type(2)));
typedef unsigned u32x4 __attribute__((ext_vector_type(4)));

constexpr int NB = 2, SEQ = 16384, T = NB * SEQ, DM = 1024;
constexpr int NIN = 4096;
constexpr int NEXP = 32, TOPK = 4, NSLOT = T * TOPK, NPMAX = NSLOT + NEXP * 256;
constexpr float EPS = 1e-5f, LOG2E = 1.4426950408889634f;
constexpr int NWAVES = 8, NTHREADS = 512;

constexpr size_t MiB = 1u << 20;
constexpr size_t WS_CTL = 0, CTL_ZERO_BYTES = 128 * 1024;
constexpr size_t WS_WIN = 1 * MiB;
constexpr size_t WS_WUQ = 9 * MiB;
constexpr size_t WS_WUKV = 10 * MiB;
constexpr size_t WS_WA = 11 * MiB, WS_WB = 12 * MiB;
constexpr size_t WS_WO = 13 * MiB;
constexpr size_t WS_ROPE = 15 * MiB;
constexpr size_t WS_WGU = 17 * MiB;
constexpr size_t WS_WD = 145 * MiB;
constexpr size_t WS_SMALL = 209 * MiB;
constexpr size_t WS_RSTDQ = WS_SMALL, WS_RSTDKV = WS_RSTDQ + T * 4, WS_RSTD2 = WS_RSTDKV + T * 4;
constexpr size_t WS_TOPI = WS_RSTD2 + T * 4, WS_GATEW = WS_TOPI + (size_t)NSLOT * 4, WS_SRANK = WS_GATEW + (size_t)NSLOT * 4, WS_POS = WS_SRANK + (size_t)NSLOT * 4;
constexpr size_t WS_ROWTOK = WS_POS + (size_t)NSLOT * 4, WS_ROWSCALE = WS_ROWTOK + 1 * MiB, WS_WGBASE = WS_ROWSCALE + 1 * MiB;
constexpr size_t WS_WRP = WS_WGBASE + 64 * 1024;
constexpr size_t WS_PARTL = WS_WRP + 128 * 1024;
static_assert(WS_PARTL + 3 * MiB <= 225 * MiB, "small region");
constexpr size_t WS_XB = 225 * MiB;
constexpr size_t WS_QA = 289 * MiB, WS_KA = 321 * MiB, WS_VA = 353 * MiB;
constexpr size_t WS_CQ = 385 * MiB;
constexpr size_t WS_CKV = 401 * MiB;
constexpr size_t WS_KR = 409 * MiB;
constexpr size_t WS_GA = 411 * MiB, WS_GB = 475 * MiB;
constexpr size_t WS_K8 = 587 * MiB;
constexpr size_t WS_Q8 = 249 * MiB;
constexpr size_t WS_V8T = 273 * MiB;
constexpr size_t WS_ACT = 225 * MiB;
static_assert(WS_ACT + (size_t)NPMAX * 2048 <= 539 * MiB, "ACT overlay");
constexpr size_t WS_QB = 539 * MiB;
constexpr size_t WS_KIMG = 587 * MiB;
constexpr size_t WS_VIMG = 635 * MiB;
constexpr size_t WS_OA = 667 * MiB, WS_OB = 699 * MiB;
constexpr size_t WS_MERGED = 731 * MiB;
constexpr size_t WS_PARTO = 795 * MiB;
constexpr size_t WS_H2 = 891 * MiB;
constexpr size_t WS_Y = 539 * MiB;
static_assert(WS_Y + (size_t)NPMAX * 2048 <= WS_H2, "Y overlay");
constexpr size_t WS_END = 955 * MiB;
constexpr int CW_TMO = 0, CW_BAR = 4096, CW_GCOUNT = 8192, CW_NRM = 8256;

constexpr int RING_BYTES = 131072, LDS_BYTES = 163840, MISC_OFF = LDS_BYTES - 4096;
constexpr int MI_BAR = 8, MI_TPRE = 16, MI_HIST = 64, MI_PSTART = 96, MI_NRM = 160;

__device__ __forceinline__ unsigned f2bf(float f) { unsigned u = __builtin_bit_cast(unsigned, f); return (u + 0x7fffu + ((u >> 16) & 1u)) >> 16; }
__device__ __forceinline__ unsigned pk2(float lo, float hi) { return f2bf(lo) | (f2bf(hi) << 16); }
__device__ __forceinline__ float bf2f(unsigned short b) { return __builtin_bit_cast(float, (unsigned)b << 16); }
__device__ __forceinline__ float bflo(unsigned w) { return __builtin_bit_cast(float, w << 16); }
__device__ __forceinline__ float bfhi(unsigned w) { return __builtin_bit_cast(float, w & 0xffff0000u); }
typedef __bf16 bf16x2_t __attribute__((ext_vector_type(2)));
__device__ __forceinline__ unsigned cvtpk(float lo, float hi) { const f32x2 v = {lo, hi}; const bf16x2_t b = __builtin_convertvector(v, bf16x2_t); return __builtin_bit_cast(unsigned, b); }
__device__ __forceinline__ unsigned pack4_fp8(float a, float b, float c, float d) { int w = 0; w = __builtin_amdgcn_cvt_pk_fp8_f32(a, b, w, false); w = __builtin_amdgcn_cvt_pk_fp8_f32(c, d, w, true); return (unsigned)w; }
__device__ __forceinline__ float wave_sum(float v) {
#pragma unroll
    for (int o = 1; o < 64; o <<= 1) v += __shfl_xor(v, o);
    return v;
}
__device__ __forceinline__ int lane_now() { int t = threadIdx.x; asm volatile("" : "+v"(t)); return t & 63; }
__device__ __forceinline__ float fexp2(float x) { return __builtin_amdgcn_exp2f(x); }
__device__ __forceinline__ float frcp(float x) { return __builtin_amdgcn_rcpf(x); }
__device__ __forceinline__ float sigmoidf_(float z) { return frcp(1.f + fexp2(-z * LOG2E)); }
__device__ __forceinline__ int crow(int r, int hi) { return (r & 3) + 8 * (r >> 2) + 4 * hi; }
__device__ __forceinline__ u32x4 pack8(const float (&v)[8]) { u32x4 w; w.x = cvtpk(v[0], v[1]); w.y = cvtpk(v[2], v[3]); w.z = cvtpk(v[4], v[5]); w.w = cvtpk(v[6], v[7]); return w; }
__device__ __forceinline__ void unpack8(const u32x4 w, float (&v)[8]) { v[0] = bflo(w.x); v[1] = bfhi(w.x); v[2] = bflo(w.y); v[3] = bfhi(w.y); v[4] = bflo(w.z); v[5] = bfhi(w.z); v[6] = bflo(w.w); v[7] = bfhi(w.w); }
__device__ __forceinline__ f32x2 rope_cs(int pos, int i) {
    const float inv = __builtin_powf(10000.f, -(float)i * (1.f / 16.f));
    const float ang = (float)pos * inv;
    double x = (double)ang; const double n = __builtin_rint(x * 0.15915494309189535); x = (x - n * 6.283185307179586) - n * 2.4492935982947064e-16;
    const double x2 = x * x; double sn = 1.0, cs = 1.0;
#pragma unroll
    for (int k = 13; k >= 1; --k) { sn = 1.0 - sn * x2 * (1.0 / (double)((2 * k) * (2 * k + 1))); cs = 1.0 - cs * x2 * (1.0 / (double)((2 * k - 1) * (2 * k))); }
    sn *= x;
    return (f32x2){(float)cs, (float)sn};
}

namespace pg8 {
constexpr int BM = 256, BK = 64, HALF = 128, HTB = HALF * BK * 2  , NXCD = 8, WGM = 8;
__host__ __device__ __forceinline__ int lds_byte(int r, int c) { const int st = (r >> 4) * 2 + (c >> 5), rr = r & 15, cc = c & 31, ob = rr * 64 + cc * 2; return st * 1024 + (ob ^ (((ob >> 9) & 1) << 5)); }
__host__ __device__ __forceinline__ void stage_rc(int b, int& R, int& C) { const int st = b / 1024, sb = b % 1024, swz = sb ^ (((sb >> 9) & 1) << 5); R = (st >> 1) * 16 + swz / 64; C = (st & 1) * 32 + (swz % 64) / 2; }
__host__ __device__ __forceinline__ int perm32(int rho) { const int n = rho >> 4, i = rho & 15; return 8 * (i >> 2) + 4 * n + (i & 3); }

struct Unit { int pm, pn, e; };

struct StaticOrder {
    int nM, nN, nwg, G, c;
    __host__ __device__ void init(int M, int N, int G_, int c_) { nM = M / BM; nN = N / BM; nwg = nM * nN; G = G_; c = c_; }
    __host__ __device__ bool next(int i, Unit& u) const {
        const long L = (long)i * G + c; if (L >= nwg) return false;
        int wgid = (int)L; { const int q = nwg / NXCD, r = nwg % NXCD, xcd = wgid % NXCD, off = wgid / NXCD; wgid = (xcd < r ? xcd * (q + 1) : r * (q + 1) + (xcd - r) * q) + off; }
        const int nig = WGM * nN, gid = wgid / nig, fm = gid * WGM, gsz = (nM - fm) < WGM ? (nM - fm) : WGM;
        u.pm = fm + ((wgid % nig) % gsz); u.pn = (wgid % nig) / gsz; u.e = 0; return true;
    }
};
struct DenseSched {
    static constexpr bool LATE = false, KEEP_ACC = false;
    StaticOrder so; const char* A; const char* Bt; int K;
    __device__ __forceinline__ void prefetch_rows(const Unit&, LAS unsigned char*, int, int, int) const {}
    __device__ __forceinline__ void a_off_lds(const Unit&, const int (&)[2], const int (&)[2], LAS unsigned char*, int, unsigned (&)[2][2]) const {}
    __device__ __forceinline__ void init(const bf16_t* A_, const bf16_t* Bt_, int M, int N, int K_, int G, int c) { so.init(M, N, G, c); A = (const char*)A_; Bt = (const char*)Bt_; K = K_; }
    __device__ __forceinline__ bool next(int i, Unit& u) const { return so.next(i, u); }
    __device__ __forceinline__ const char* a_base(const Unit& u) const { return A + (size_t)u.pm * ((size_t)BM * K * 2); }
    __device__ __forceinline__ const char* b_base(const Unit& u) const { return Bt + (size_t)u.pn * ((size_t)BM * K * 2); }
    __device__ __forceinline__ void a_off(const Unit&, const int (&sR)[2], const int (&sC)[2], unsigned (&vo)[2][2]) const {
#pragma unroll
        for (int h = 0; h < 2; ++h)
#pragma unroll
            for (int i = 0; i < 2; ++i) vo[h][i] = (unsigned)((h * HALF + sR[i]) * K + sC[i]) * 2u;
    }
};
struct TwoSegSched {
    static constexpr bool LATE = false, KEEP_ACC = true;
    StaticOrder so; const char* A0; const char* A1; const char* B0; const char* B1; int K;
    __device__ __forceinline__ void prefetch_rows(const Unit&, LAS unsigned char*, int, int, int) const {}
    __device__ __forceinline__ void a_off_lds(const Unit&, const int (&)[2], const int (&)[2], LAS unsigned char*, int, unsigned (&)[2][2]) const {}
    __device__ __forceinline__ void init(const bf16_t* A0_, const bf16_t* B0_, const bf16_t* A1_, const bf16_t* B1_, int M, int N, int K_, int G, int c) { so.init(M, N, G, c); A0 = (const char*)A0_; A1 = (const char*)A1_; B0 = (const char*)B0_; B1 = (const char*)B1_; K = K_; }
    __device__ __forceinline__ bool next(int i, Unit& u) const { const bool ok = so.next(i >> 1, u); u.e = i & 1; return ok; }
    __device__ __forceinline__ const char* a_base(const Unit& u) const { return (u.e ? A1 : A0) + (size_t)u.pm * ((size_t)BM * K * 2); }
    __device__ __forceinline__ const char* b_base(const Unit& u) const { return (u.e ? B1 : B0) + (size_t)u.pn * ((size_t)BM * K * 2); }
    __device__ __forceinline__ void a_off(const Unit&, const int (&sR)[2], const int (&sC)[2], unsigned (&vo)[2][2]) const {
#pragma unroll
        for (int h = 0; h < 2; ++h)
#pragma unroll
            for (int i = 0; i < 2; ++i) vo[h][i] = (unsigned)((h * HALF + sR[i]) * K + sC[i]) * 2u;
    }
};
template <int NPN_SHIFT, bool GATHER, bool REVERSE = false>
struct MoeSched {
    static constexpr bool KEEP_ACC = false;
    static constexpr bool LATE = GATHER;
    static constexpr int TBL_OFF = 131072 + 4096;
    __device__ __forceinline__ void prefetch_rows(const Unit& u, LAS unsigned char* lds, int buf, int wid, int lane) const {
        if (wid < 4) __builtin_amdgcn_global_load_lds((const unsigned*)(row_tok + u.pm * BM + wid * 64 + lane), (LAS unsigned*)(lds + TBL_OFF + buf * 1024 + wid * 256), 4, 0, 0);
    }
    __device__ __forceinline__ void a_off_lds(const Unit&, const int (&sR)[2], const int (&sC)[2], LAS unsigned char* lds, int buf, unsigned (&vo)[2][2]) const {
        const LAS int* tb = (const LAS int*)(lds + TBL_OFF + buf * 1024);
#pragma unroll
        for (int h = 0; h < 2; ++h)
#pragma unroll
            for (int i = 0; i < 2; ++i) vo[h][i] = (unsigned)(tb[h * HALF + sR[i]] * K + sC[i]) * 2u;
    }
    const LAS int* tpre; int ntiles, G, c, K; const char* A; const char* Bt; size_t estride; const int* row_tok;
    __device__ __forceinline__ bool next(int i, Unit& u) const {
        int g, pn;
        if (G == 256) { const int x = c & 7, j = c >> 3; constexpr int TPR = 256 >> NPN_SHIFT, PX = TPR / 8; g = i * TPR + x * PX + (j >> NPN_SHIFT); pn = j & ((1 << NPN_SHIFT) - 1); }
        else { const int L = i * G + c; g = L >> NPN_SHIFT; pn = L & ((1 << NPN_SHIFT) - 1); }
        if (g >= ntiles) return false;
        if (REVERSE) g = ntiles - 1 - g;
        int e = 0; while (e < 31 && tpre[e + 1] <= g) ++e;
        u.pm = g; u.pn = pn; u.e = e; return true;
    }
    __device__ __forceinline__ const char* a_base(const Unit& u) const { return GATHER ? A : A + (size_t)u.pm * ((size_t)BM * K * 2); }
    __device__ __forceinline__ const char* b_base(const Unit& u) const { return Bt + (size_t)u.e * estride + (size_t)u.pn * ((size_t)BM * K * 2); }
    __device__ __forceinline__ void a_off(const Unit& u, const int (&sR)[2], const int (&sC)[2], unsigned (&vo)[2][2]) const {
#pragma unroll
        for (int h = 0; h < 2; ++h)
#pragma unroll
            for (int i = 0; i < 2; ++i) {
                if (GATHER) { const int tok = row_tok[u.pm * BM + h * HALF + sR[i]]; vo[h][i] = (unsigned)(tok * K + sC[i]) * 2u; }
                else vo[h][i] = (unsigned)((h * HALF + sR[i]) * K + sC[i]) * 2u;
            }
    }
};

typedef int v8i_ __attribute__((ext_vector_type(8)));
__device__ __forceinline__ v8i_ cat16(const bf16x8 a, const bf16x8 b) { const u32x4 x = __builtin_bit_cast(u32x4, a), y = __builtin_bit_cast(u32x4, b); return (v8i_){(int)x.x, (int)x.y, (int)x.z, (int)x.w, (int)y.x, (int)y.y, (int)y.z, (int)y.w}; }
__device__ __forceinline__ v8i_ lds_ld32(const LAS unsigned char* p) { const u32x4 x = *(const LAS u32x4*)p, y = *(const LAS u32x4*)(p + 1024); return (v8i_){(int)x.x, (int)x.y, (int)x.z, (int)x.w, (int)y.x, (int)y.y, (int)y.z, (int)y.w}; }
template <class Epi, class Sched, bool ALIGN_EPI, bool FP8 = false, int SCALE_W = 127>
__device__ __forceinline__ void gemm_phase2(LAS unsigned char* lds, const int K_, const Sched& S, const Epi& E) {
    int K = K_; asm volatile("" : "+s"(K));
    const int tid = threadIdx.x, wid = __builtin_amdgcn_readfirstlane(tid >> 6), lane = tid & 63, wr = wid >> 2, wc = wid & 3, fr = lane & 15, fq = lane >> 4;
    const int nt = K / BK;
    int sR[2], sC[2]; unsigned voffB[2];
#pragma unroll
    for (int i = 0; i < 2; ++i) { int R, C; stage_rc(tid * 16 + i * 8192, R, C); sR[i] = R; sC[i] = C; const int Rb = Epi::PERM ? ((R & ~31) + perm32(R & 31)) : R; voffB[i] = (unsigned)(Rb * K + C) * 2u; }
    const size_t kstep = (size_t)(BK * 2);
    const size_t hstep = (size_t)HALF * K * 2;
    const unsigned ldsw = (unsigned)wid * 1024u;
    const int aoff = lds_byte(wr * 64 + fr, fq * 8), boff = lds_byte(wc * 32 + fr, fq * 8);
#define PG8_SA(b, h) (((b) * 2 + (h)) * HTB)
#define PG8_SB(b, h) ((4 + (b) * 2 + (h)) * HTB)
#define PG8_STAGE_B(bufoff, gbase) do { _Pragma("unroll") for (int _i = 0; _i < 2; ++_i) \
        __builtin_amdgcn_global_load_lds((const unsigned*)((const char*)(gbase) + voffB[_i]), (LAS unsigned*)(lds + (bufoff) + ldsw + _i * 8192), 16, 0, 0); } while (0)
#define PG8_STAGE_A(bufoff, gbase, o0, o1) do { \
        __builtin_amdgcn_global_load_lds((const unsigned*)((const char*)(gbase) + (o0)), (LAS unsigned*)(lds + (bufoff) + ldsw), 16, 0, 0); \
        __builtin_amdgcn_global_load_lds((const unsigned*)((const char*)(gbase) + (o1)), (LAS unsigned*)(lds + (bufoff) + ldsw + 8192), 16, 0, 0); } while (0)
#define PG8_LDA(dst, b, h) do { if constexpr (FP8) { _Pragma("unroll") for (int m = 0; m < 4; ++m) dst##8[m] = lds_ld32(lds + PG8_SA(b, h) + aoff + m * 2048); } else { _Pragma("unroll") for (int m = 0; m < 4; ++m) _Pragma("unroll") for (int k = 0; k < 2; ++k) dst[m][k] = *(const LAS bf16x8*)(lds + PG8_SA(b, h) + aoff + m * 2048 + k * 1024); } } while (0)
#define PG8_LDB(dst, b, h) do { if constexpr (FP8) { _Pragma("unroll") for (int n = 0; n < 2; ++n) dst##8[n] = lds_ld32(lds + PG8_SB(b, h) + boff + n * 2048); } else { _Pragma("unroll") for (int n = 0; n < 2; ++n) _Pragma("unroll") for (int k = 0; k < 2; ++k) dst[n][k] = *(const LAS bf16x8*)(lds + PG8_SB(b, h) + boff + n * 2048 + k * 1024); } } while (0)
#define PG8_MMA(ai, bj, At, Bt) do { __builtin_amdgcn_s_setprio(1); if constexpr (FP8) { _Pragma("unroll") for (int m = 0; m < 4; ++m) _Pragma("unroll") for (int n = 0; n < 2; ++n) \
        asm volatile("v_mfma_scale_f32_16x16x128_f8f6f4 %0, %1, %2, %0, %3, %4 op_sel_hi:[0,0,0]" : "+v"(acc[ai][bj][m][n]) : "v"(Bt##8[n]), "v"(At##8[m]), "v"(scw_), "v"(sca_)); } else { \
        _Pragma("unroll") for (int m = 0; m < 4; ++m) _Pragma("unroll") for (int n = 0; n < 2; ++n) _Pragma("unroll") for (int k = 0; k < 2; ++k) \
        acc[ai][bj][m][n] = __builtin_amdgcn_mfma_f32_16x16x32_bf16(Bt[n][k], At[m][k], acc[ai][bj][m][n], 0, 0, 0); } __builtin_amdgcn_s_setprio(0); } while (0)
#define PG8_WAIT_V(n) asm volatile("s_waitcnt vmcnt(" #n ")" ::: "memory")
#define PG8_WAIT_L(n) asm volatile("s_waitcnt lgkmcnt(" #n ")" ::: "memory")
#define PG8_BAR __builtin_amdgcn_s_barrier()
#define PG8_SCHED __builtin_amdgcn_sched_barrier(0)
    Unit cur, nxt; int ui = 0;
    if (!S.next(0, cur)) return;
    f32x4 acc[2][2][4][2];
#pragma unroll
    for (int a = 0; a < 2; ++a)
#pragma unroll
        for (int b = 0; b < 2; ++b)
#pragma unroll
            for (int m = 0; m < 4; ++m)
#pragma unroll
                for (int n = 0; n < 2; ++n) acc[a][b][m][n] = (f32x4){0.f, 0.f, 0.f, 0.f};
    bf16x8 At[4][2], B0[2][2], B1[2][2]; v8i_ At8[4], B08[2], B18[2];
    int scw_ = SCALE_W * 0x01010101, sca_ = 0x7f7f7f7f; asm volatile("" : "+v"(scw_), "+v"(sca_));
    unsigned voA[2][2], voN[2][2];
    S.a_off(cur, sR, sC, voA);
    const char* cA = S.a_base(cur); const char* cB = S.b_base(cur);
    PG8_STAGE_B(PG8_SB(0, 0), cB); PG8_STAGE_B(PG8_SB(0, 1), cB + hstep); PG8_STAGE_A(PG8_SA(0, 0), cA, voA[0][0], voA[0][1]); PG8_STAGE_A(PG8_SA(0, 1), cA, voA[1][0], voA[1][1]);
    if (wr == 1) PG8_BAR;
    PG8_WAIT_V(2); PG8_BAR;
    PG8_STAGE_B(PG8_SB(1, 0), cB + kstep); PG8_STAGE_A(PG8_SA(1, 0), cA + kstep, voA[0][0], voA[0][1]); PG8_STAGE_B(PG8_SB(1, 1), cB + hstep + kstep);
    PG8_WAIT_V(6); PG8_BAR;
    for (;;) {
        const bool has_next = S.next(ui + 1, nxt);
        const char* nA = cA; const char* nB = cB;
#pragma unroll
        for (int h = 0; h < 2; ++h)
#pragma unroll
            for (int i = 0; i < 2; ++i) voN[h][i] = voA[h][i];
        if (has_next) { nA = S.a_base(nxt); nB = S.b_base(nxt); if constexpr (Sched::LATE) S.prefetch_rows(nxt, lds, (ui + 1) & 1, wid, lane); else S.a_off(nxt, sR, sC, voN); }
        for (int t = 0; t < nt; t += 2) {
            const bool last = (t == nt - 2);
            if constexpr (Sched::LATE) { if (last && has_next) S.a_off_lds(nxt, sR, sC, lds, (ui + 1) & 1, voN); }
            const char* a1 = cA + (size_t)(t + 1) * kstep;
            const char* a2 = last ? nA : cA + (size_t)(t + 2) * kstep; const char* b2 = last ? nB : cB + (size_t)(t + 2) * kstep;
            const char* a3 = a2 + kstep; const char* b3 = b2 + kstep;
            const unsigned s00 = last ? voN[0][0] : voA[0][0], s01 = last ? voN[0][1] : voA[0][1], s10 = last ? voN[1][0] : voA[1][0], s11 = last ? voN[1][1] : voA[1][1];
            PG8_LDB(B0, 0, 0); PG8_LDB(B1, 0, 1); PG8_SCHED; PG8_LDA(At, 0, 0); PG8_STAGE_A(PG8_SA(1, 1), a1, voA[1][0], voA[1][1]);
            PG8_WAIT_V(8); PG8_WAIT_L(0); PG8_BAR; PG8_MMA(0, 0, At, B0); PG8_MMA(0, 1, At, B1); PG8_BAR; PG8_SCHED;
            PG8_LDA(At, 0, 1); PG8_STAGE_B(PG8_SB(0, 0), b2); PG8_STAGE_B(PG8_SB(0, 1), b2 + hstep); PG8_STAGE_A(PG8_SA(0, 0), a2, s00, s01);
            PG8_WAIT_V(8); PG8_WAIT_L(0); PG8_BAR; PG8_MMA(1, 0, At, B0); PG8_MMA(1, 1, At, B1); PG8_BAR; PG8_SCHED;
            PG8_LDB(B0, 1, 0); PG8_LDB(B1, 1, 1); PG8_SCHED; PG8_LDA(At, 1, 0); PG8_STAGE_A(PG8_SA(0, 1), a2, s10, s11);
            PG8_WAIT_V(8); PG8_WAIT_L(0); PG8_BAR; PG8_MMA(0, 0, At, B0); PG8_MMA(0, 1, At, B1); PG8_BAR; PG8_SCHED;
            PG8_LDA(At, 1, 1); PG8_STAGE_B(PG8_SB(1, 0), b3); PG8_STAGE_B(PG8_SB(1, 1), b3 + hstep); PG8_STAGE_A(PG8_SA(1, 0), a3, s00, s01);
            PG8_WAIT_V(8); PG8_WAIT_L(0); PG8_BAR; PG8_MMA(1, 0, At, B0); PG8_MMA(1, 1, At, B1); PG8_BAR; PG8_SCHED;
        }
        if constexpr (ALIGN_EPI) { if (wr == 0) PG8_BAR; }
        E(acc, cur, wr, wc, fr, fq);
#ifdef PROBE_EPI2
        if (Epi::PROBE2) { asm volatile("" ::: "memory"); E(acc, cur, wr, wc, fr, fq); }
#endif
        if (!has_next) break;
        if (!(Sched::KEEP_ACC && nxt.e != 0)) {
#pragma unroll
        for (int a = 0; a < 2; ++a)
#pragma unroll
            for (int b = 0; b < 2; ++b)
#pragma unroll
                for (int m = 0; m < 4; ++m)
#pragma unroll
                    for (int n = 0; n < 2; ++n) acc[a][b][m][n] = (f32x4){0.f, 0.f, 0.f, 0.f};
        }
        cur = nxt; cA = nA; cB = nB; ++ui;
#pragma unroll
        for (int h = 0; h < 2; ++h)
#pragma unroll
            for (int i = 0; i < 2; ++i) voA[h][i] = voN[h][i];
        if constexpr (ALIGN_EPI) { if (wr == 1) PG8_BAR; }
    }
    PG8_WAIT_V(0);
    if constexpr (!ALIGN_EPI) { if (wr == 0) PG8_BAR; }
    PG8_BAR;
#undef PG8_SA
#undef PG8_SB
#undef PG8_STAGE_A
#undef PG8_STAGE_B
#undef PG8_LDA
#undef PG8_LDB
#undef PG8_MMA
#undef PG8_WAIT_V
#undef PG8_WAIT_L
#undef PG8_BAR
#undef PG8_SCHED
}
}

#define XB_TMO      128
#define XB_XCNT(j)  (256  + 64 * (j))
#define XB_XSUB(j)  (1280 + 64 * (j))
#define XB_XGEN(j)  (2304 + 64 * (j))
#define XB_TOP      3328
#define XB_TOPGEN   3392
#define XCD_BAR_WORDS 3456
#define XB_SPIN_CAP (1u << 18)

__device__ __forceinline__ unsigned xb_ld(unsigned* p)              { return __hip_atomic_load(p, __ATOMIC_RELAXED, __HIP_MEMORY_SCOPE_AGENT); }
__device__ __forceinline__ unsigned xb_add(unsigned* p, unsigned v) { return __hip_atomic_fetch_add(p, v, __ATOMIC_RELAXED, __HIP_MEMORY_SCOPE_AGENT); }
__device__ __forceinline__ unsigned xb_xcc_id() { return (unsigned)__builtin_amdgcn_s_getreg((3 << 11) | 20) & 0xFu; }
#define XB_SPIN(cond, bar) do { unsigned _sp = 0; while (cond) { __builtin_amdgcn_s_sleep(1); \
    if ((++_sp & 255u) == 0u) { if (xb_ld(&(bar)[XB_TMO])) break; if (_sp > XB_SPIN_CAP) { atomicAdd(&(bar)[XB_TMO], 1u); break; } } } } while (0)

struct XcdBarrier {
    unsigned* bar; unsigned x;
    volatile LAS unsigned* st;
};
__device__ __forceinline__ XcdBarrier xcd_barrier_post(unsigned* bar, volatile LAS unsigned* st) {
    XcdBarrier b; b.bar = bar; b.x = xb_xcc_id(); b.st = st;
    if (threadIdx.x == 0) (void)xb_add(&bar[XB_XCNT(b.x)], 1u);
    return b;
}
__device__ __forceinline__ void xcd_barrier_complete(unsigned* bar, unsigned x, unsigned& nloc, unsigned& nx) {
    const unsigned G = gridDim.x * gridDim.y * gridDim.z;
    unsigned sum, cnt, mine, sp = 0u;
    for (;;) {
        sum = 0u; cnt = 0u; mine = 0u;
#pragma unroll
        for (unsigned j = 0; j < 16; ++j) { const unsigned c = xb_ld(&bar[XB_XCNT(j)]); sum += c; cnt += (c > 0u) ? 1u : 0u; mine = (j == x) ? c : mine; }
        if (sum == G) break;
        __builtin_amdgcn_s_sleep(1);
        if ((++sp & 255u) == 0u) { if (xb_ld(&bar[XB_TMO])) break; if (sp > XB_SPIN_CAP) { atomicAdd(&bar[XB_TMO], 1u); break; } }
    }
    nloc = mine > 0u ? mine : 1u; nx = cnt > 0u ? cnt : 1u;
}
__device__ __forceinline__ void xcd_barrier(const XcdBarrier& b) {
    asm volatile("s_waitcnt vmcnt(0)" ::: "memory");
    __syncthreads();
    if (threadIdx.x == 0) {
        unsigned* bar = b.bar;
        __builtin_amdgcn_s_waitcnt(0);
        unsigned nloc = b.st[0], nx = b.st[1];
        if (nloc == 0u) { xcd_barrier_complete(bar, b.x, nloc, nx); b.st[0] = nloc; b.st[1] = nx; }
        const unsigned old = xb_add(&bar[XB_XSUB(b.x)], 1u);
        const unsigned gen = old / nloc;
        if (old + 1u == (gen + 1u) * nloc) {
            __builtin_amdgcn_fence(__ATOMIC_RELEASE, "agent");
            asm volatile("s_waitcnt vmcnt(0)" ::: "memory");
            const unsigned og = xb_add(&bar[XB_TOP], 1u);
            const unsigned tg = og / nx;
            if (og + 1u == (tg + 1u) * nx) xb_add(&bar[XB_TOPGEN], 1u);
            else XB_SPIN(xb_ld(&bar[XB_TOPGEN]) == tg, bar);
            __builtin_amdgcn_fence(__ATOMIC_ACQUIRE, "agent");
            xb_add(&bar[XB_XGEN(b.x)], 1u);
            asm volatile("s_waitcnt vmcnt(0)" ::: "memory");
        } else {
            XB_SPIN(xb_ld(&bar[XB_XGEN(b.x)]) == gen, bar);
            __builtin_amdgcn_fence(__ATOMIC_ACQUIRE, "agent");
            asm volatile("s_waitcnt vmcnt(0)" ::: "memory");
        }
    }
    __syncthreads();
}

#define EPI_WALK(...) \
    _Pragma("unroll") for (int ai = 0; ai < 2; ++ai) _Pragma("unroll") for (int m = 0; m < 4; ++m) { \
        const int row = u.pm * 256 + ai * 128 + wr * 64 + m * 16 + fr; \
        _Pragma("unroll") for (int bj = 0; bj < 2; ++bj) { const int cw = bj * 128 + wc * 32 + 8 * fq; \
            float v[8] = {acc[ai][bj][m][0][0], acc[ai][bj][m][0][1], acc[ai][bj][m][0][2], acc[ai][bj][m][0][3], acc[ai][bj][m][1][0], acc[ai][bj][m][1][1], acc[ai][bj][m][1][2], acc[ai][bj][m][1][3]}; \
            __VA_ARGS__ } asm volatile("" ::: "memory"); }

__device__ __forceinline__ void rope8(float (&v)[8], const f32x2* rope_row, int i0) {
#pragma unroll
    for (int j = 0; j < 4; ++j) { const f32x2 cs = rope_row[i0 + j]; const float x1 = v[2 * j], x2 = v[2 * j + 1]; v[2 * j] = x1 * cs.x - x2 * cs.y; v[2 * j + 1] = x2 * cs.x + x1 * cs.y; }
}

#define EPI_ROW_(ai, m) (u.pm * 256 + (ai) * 128 + wr * 64 + (m) * 16 + fr)
struct EpiInProj {
    static constexpr bool PERM = true;
    __device__ __forceinline__ void row_rstd(float (&ssr)[2][4], float* dst, float inv_n, const pg8::Unit& u, int wr, int wc, int fr, int fq) const {
        LAS float* red = (LAS float*)(lds + 139264);
#pragma unroll
        for (int ai = 0; ai < 2; ++ai)
#pragma unroll
            for (int m = 0; m < 4; ++m) { float s = ssr[ai][m]; s += __shfl_xor(s, 16); s += __shfl_xor(s, 32);
                if (fq == 0) red[(ai * 128 + wr * 64 + m * 16 + fr) * 4 + wc] = s; }
        __syncthreads();
        if (wc == 0 && fq == 0) {
#pragma unroll
            for (int ai = 0; ai < 2; ++ai)
#pragma unroll
                for (int m = 0; m < 4; ++m) { const int r = ai * 128 + wr * 64 + m * 16 + fr; const f32x4 p = *(const LAS f32x4*)(red + r * 4);
                    dst[u.pm * 256 + r] = 1.f / sqrtf(((p.x + p.y) + (p.z + p.w)) * inv_n + EPS); }
        }
        __syncthreads();
    }
#ifdef PROBE_EPI2
    static constexpr bool PROBE2 = (PROBE_EPI2 == 0);
#endif
    unsigned char* ws; LAS unsigned char* lds;
    __device__ __forceinline__ void operator()(const f32x4 (&acc)[2][2][4][2], const pg8::Unit& u, int wr, int wc, int fr, int fq) const {
        asm volatile("" : "+v"(fr), "+v"(fq));
        const int pn = u.pn;
        if (pn < 6) {
            bf16_t* base = (bf16_t*)(ws + (pn < 2 ? WS_QA : pn < 4 ? WS_KA : WS_VA)) + (pn & 1) * 256;
            EPI_WALK({ *(u32x4*)(base + (size_t)row * 512 + cw) = pack8(v); })
        } else if (pn == 6) {
            bf16_t* base = (bf16_t*)(ws + WS_CQ); float ssr[2][4] = {};
            EPI_WALK({ _Pragma("unroll") for (int j = 0; j < 8; ++j) ssr[ai][m] = __builtin_fmaf(v[j], v[j], ssr[ai][m]); *(u32x4*)(base + (size_t)row * 256 + cw) = pack8(v); })
            row_rstd(ssr, (float*)(ws + WS_RSTDQ), 1.f / 256.f, u, wr, wc, fr, fq);
        } else if (pn == 7) {
            bf16_t* ckv = (bf16_t*)(ws + WS_CKV); const f32x2* rope = (const f32x2*)(ws + WS_ROPE); float ssr[2][4] = {};
            EPI_WALK({ if (cw < 128) { _Pragma("unroll") for (int j = 0; j < 8; ++j) ssr[ai][m] = __builtin_fmaf(v[j], v[j], ssr[ai][m]); *(u32x4*)(ckv + (size_t)row * 128 + cw) = pack8(v); }
                       else if (cw < 160) { rope8(v, rope + (size_t)(row & (SEQ - 1)) * 16, (cw - 128) >> 1);
                           const u32x2 w8 = {pack4_fp8(v[0], v[1], v[2], v[3]), pack4_fp8(v[4], v[5], v[6], v[7])};
                           const int b = row >> 14, sq2 = row & (SEQ - 1); unsigned char* kp = ws + WS_K8 + (size_t)(b * 8 * 256 + (sq2 >> 6)) * 6144 + (4 + ((cw - 128) >> 4)) * 1024 + (sq2 & 63) * 16 + ((cw - 128) & 8);
                           _Pragma("unroll") for (int hh = 0; hh < 8; ++hh) { asm volatile("" : "+v"(kp)); *(u32x2*)kp = w8; kp += (size_t)256 * 6144; } } })
            row_rstd(ssr, (float*)(ws + WS_RSTDKV), 1.f / 128.f, u, wr, wc, fr, fq);
        } else {
            bf16_t* gr = (bf16_t*)(ws + WS_GA) + (pn - 8) * 128 + wc * 32 + 8 * fq; bf16_t* gbp = (bf16_t*)(ws + WS_GB) + (pn - 8) * 128 + wc * 32 + 8 * fq;
#pragma unroll
            for (int ai = 0; ai < 2; ++ai)
#pragma unroll
                for (int m = 0; m < 4; ++m) { const size_t ro = (size_t)EPI_ROW_(ai, m) * 1024; float r[8], g[8];
#pragma unroll
                    for (int j = 0; j < 8; ++j) { const float ga = sigmoidf_(acc[ai][0][m][j >> 2][j & 3]); g[j] = fmaxf(sigmoidf_(acc[ai][1][m][j >> 2][j & 3]), 8.6736174e-19f); r[j] = ga * frcp(g[j]); }
                    *(u32x4*)(gr + ro) = pack8(r); *(u32x4*)(gbp + ro) = pack8(g); }
        }
    }
};
#define EPI_ROW(ai, m) (u.pm * 256 + (ai) * 128 + wr * 64 + (m) * 16 + fr)
#define EPI_LOAD_RS(rs) float rs8[2][4]; _Pragma("unroll") for (int ai = 0; ai < 2; ++ai) _Pragma("unroll") for (int m = 0; m < 4; ++m) rs8[ai][m] = (rs)[EPI_ROW(ai, m)];
struct EpiQ {
    static constexpr bool PERM = true;
#ifdef PROBE_EPI2
    static constexpr bool PROBE2 = (PROBE_EPI2 == 1);
#endif
    unsigned char* ws;
    __device__ __forceinline__ void operator()(const f32x4 (&acc)[2][2][4][2], const pg8::Unit& u, int wr, int wc, int fr, int fq) const {
        bf16_t* qb = (bf16_t*)(ws + WS_QB); const float* rs = (const float*)(ws + WS_RSTDQ); const f32x2* rope = (const f32x2*)(ws + WS_ROPE);
        EPI_LOAD_RS(rs)
        EPI_WALK({ const int col = u.pn * 256 + cw; const int w = col % 96; const float r = rs8[ai][m];
                   _Pragma("unroll") for (int j = 0; j < 8; ++j) v[j] *= r;
                   if (w >= 64) rope8(v, rope + (size_t)(row & (SEQ - 1)) * 16, (w - 64) >> 1);
#ifdef KEEP_BF16_IMAGES
                   *(u32x4*)(qb + (size_t)row * 768 + col) = pack8(v);
#endif
                   *(u32x2*)(ws + WS_Q8 + (size_t)row * 768 + col) = (u32x2){pack4_fp8(v[0] * 16.f, v[1] * 16.f, v[2] * 16.f, v[3] * 16.f), pack4_fp8(v[4] * 16.f, v[5] * 16.f, v[6] * 16.f, v[7] * 16.f)}; })
    }
};
struct EpiKV {
    static constexpr bool PERM = true;
#ifdef PROBE_EPI2
    static constexpr bool PROBE2 = (PROBE_EPI2 == 2);
#endif
    unsigned char* ws;
    __device__ __forceinline__ void operator()(const f32x4 (&acc)[2][2][4][2], const pg8::Unit& u, int wr, int wc, int fr, int fq) const {
        const float* rs = (const float*)(ws + WS_RSTDKV); bf16_t* kimg = (bf16_t*)(ws + WS_KIMG); bf16_t* vimg = (bf16_t*)(ws + WS_VIMG);
        EPI_LOAD_RS(rs)
        EPI_WALK({ const float r = rs8[ai][m];
                   _Pragma("unroll") for (int j = 0; j < 8; ++j) v[j] *= r;
                   const int col = (u.pn & 1) * 256 + cw, h = col >> 6, b = row >> 14, sq = row & (SEQ - 1), tile = sq >> 6, rr = sq & 63; const size_t tb = (size_t)((b * 8 + h) * 256 + tile);
                   if (u.pn < 2) {
#ifdef KEEP_BF16_IMAGES
                       *(u32x4*)(kimg + tb * 6144 + ((col & 63) >> 3) * 512 + rr * 8) = pack8(v);
#endif
                       *(u32x2*)(ws + WS_K8 + tb * 6144 + ((col & 63) >> 4) * 1024 + rr * 16 + (col & 8)) = (u32x2){pack4_fp8(v[0], v[1], v[2], v[3]), pack4_fp8(v[4], v[5], v[6], v[7])}; }
                   else *(u32x4*)(vimg + tb * 4096 + ((col & 63) >> 5) * 2048 + rr * 32 + (col & 31)) = pack8(v); })
    }
};
template <bool SECOND> struct EpiGate {
    static constexpr bool PERM = true;
#ifdef PROBE_EPI2
    static constexpr bool PROBE2 = (PROBE_EPI2 == 3);
#endif
    unsigned char* ws;
    __device__ __forceinline__ void operator()(const f32x4 (&acc)[2][2][4][2], const pg8::Unit& u, int wr, int wc, int fr, int fq) const {
        bf16_t* mg = (bf16_t*)(ws + WS_MERGED); const bf16_t* gt = (const bf16_t*)(ws + (SECOND ? WS_GB : WS_GA));
#pragma unroll
        for (int ai = 0; ai < 2; ++ai) {
            u32x4 gw[4][2], pw[4][2];
#pragma unroll
            for (int m = 0; m < 4; ++m)
#pragma unroll
                for (int bj = 0; bj < 2; ++bj) { const size_t o = (size_t)EPI_ROW(ai, m) * 1024 + u.pn * 256 + bj * 128 + wc * 32 + 8 * fq; gw[m][bj] = *(const u32x4*)(gt + o); if (SECOND) pw[m][bj] = *(const u32x4*)(mg + o); }
#pragma unroll
            for (int m = 0; m < 4; ++m)
#pragma unroll
                for (int bj = 0; bj < 2; ++bj) { const size_t o = (size_t)EPI_ROW(ai, m) * 1024 + u.pn * 256 + bj * 128 + wc * 32 + 8 * fq;
                    float v[8] = {acc[ai][bj][m][0][0], acc[ai][bj][m][0][1], acc[ai][bj][m][0][2], acc[ai][bj][m][0][3], acc[ai][bj][m][1][0], acc[ai][bj][m][1][1], acc[ai][bj][m][1][2], acc[ai][bj][m][1][3]};
                    float g[8]; unpack8(gw[m][bj], g);
                    if (SECOND) { float p[8]; unpack8(pw[m][bj], p); _Pragma("unroll") for (int j = 0; j < 8; ++j) v[j] = p[j] + g[j] * v[j]; }
                    else { _Pragma("unroll") for (int j = 0; j < 8; ++j) v[j] = g[j] * v[j]; }
                    *(u32x4*)(mg + o) = pack8(v); }
            asm volatile("" ::: "memory");
        }
    }
};
struct EpiGateFused {
    static constexpr bool PERM = true;
#ifdef PROBE_EPI2
    static constexpr bool PROBE2 = false;
#endif
    unsigned char* ws;
    __device__ __forceinline__ void operator()(const f32x4 (&acc_)[2][2][4][2], const pg8::Unit& u, int wr, int wc, int fr, int fq) const {
        f32x4 (&acc)[2][2][4][2] = const_cast<f32x4 (&)[2][2][4][2]>(acc_);
        bf16_t* mg = (bf16_t*)(ws + WS_MERGED); const bf16_t* gt = (const bf16_t*)(ws + (u.e ? WS_GB : WS_GA));
#pragma unroll
        for (int ai = 0; ai < 2; ++ai) {
            u32x4 gw[4][2];
#pragma unroll
            for (int m = 0; m < 4; ++m)
#pragma unroll
                for (int bj = 0; bj < 2; ++bj) { const size_t o = (size_t)EPI_ROW(ai, m) * 1024 + u.pn * 256 + bj * 128 + wc * 32 + 8 * fq; gw[m][bj] = *(const u32x4*)(gt + o); }
#pragma unroll
            for (int m = 0; m < 4; ++m)
#pragma unroll
                for (int bj = 0; bj < 2; ++bj) { const size_t o = (size_t)EPI_ROW(ai, m) * 1024 + u.pn * 256 + bj * 128 + wc * 32 + 8 * fq;
                    float g[8]; unpack8(gw[m][bj], g);
                    if (u.e == 0) {
#pragma unroll
                        for (int j = 0; j < 8; ++j) acc[ai][bj][m][j >> 2][j & 3] *= g[j];
                    } else { float v[8];
#pragma unroll
#ifdef WO_FP8
                        for (int j = 0; j < 8; ++j) v[j] = (32.f * g[j]) * acc[ai][bj][m][j >> 2][j & 3];
                        *(u32x2*)((unsigned char*)mg + o) = (u32x2){pack4_fp8(v[0], v[1], v[2], v[3]), pack4_fp8(v[4], v[5], v[6], v[7])}; } }
#else
                        for (int j = 0; j < 8; ++j) v[j] = g[j] * acc[ai][bj][m][j >> 2][j & 3];
                        *(u32x4*)(mg + o) = pack8(v); } }
#endif
            asm volatile("" ::: "memory");
        }
    }
};
struct EpiResid {
    static constexpr bool PERM = true;
#ifdef PROBE_EPI2
    static constexpr bool PROBE2 = (PROBE_EPI2 == 4);
#endif
    unsigned char* ws; const float* x; float* x1;
    __device__ __forceinline__ void operator()(const f32x4 (&acc)[2][2][4][2], const pg8::Unit& u, int wr, int wc, int fr, int fq) const {
        bf16_t* h2 = (bf16_t*)(ws + WS_H2);
#pragma unroll
        for (int ai = 0; ai < 2; ++ai) {
            f32x4 xa[4][2][2];
#pragma unroll
            for (int m = 0; m < 4; ++m)
#pragma unroll
                for (int bj = 0; bj < 2; ++bj) { const size_t o = (size_t)EPI_ROW(ai, m) * 1024 + u.pn * 256 + bj * 128 + wc * 32 + 8 * fq; xa[m][bj][0] = *(const f32x4*)(x + o); xa[m][bj][1] = *(const f32x4*)(x + o + 4); }
#pragma unroll
            for (int m = 0; m < 4; ++m)
#pragma unroll
                for (int bj = 0; bj < 2; ++bj) { const size_t o = (size_t)EPI_ROW(ai, m) * 1024 + u.pn * 256 + bj * 128 + wc * 32 + 8 * fq;
                    const f32x4 r0 = acc[ai][bj][m][0] + xa[m][bj][0], r1 = acc[ai][bj][m][1] + xa[m][bj][1];
                    *(f32x4*)(x1 + o) = r0; *(f32x4*)(x1 + o + 4) = r1;
                    const float v[8] = {r0[0], r0[1], r0[2], r0[3], r1[0], r1[1], r1[2], r1[3]};
                    *(u32x2*)((unsigned char*)h2 + o) = (u32x2){pack4_fp8(v[0], v[1], v[2], v[3]), pack4_fp8(v[4], v[5], v[6], v[7])}; }
            asm volatile("" ::: "memory");
        }
    }
};
struct EpiSwiglu {
    static constexpr bool PERM = true;
#ifdef PROBE_EPI2
    static constexpr bool PROBE2 = (PROBE_EPI2 == 5);
#endif
    unsigned char* ws; const float* bgu;
    __device__ __forceinline__ void operator()(const f32x4 (&acc)[2][2][4][2], const pg8::Unit& u, int wr, int wc, int fr, int fq) const {
        bf16_t* act = (bf16_t*)(ws + WS_ACT); const float* rsc = (const float*)(ws + WS_ROWSCALE);
        const int c0 = u.pn * 128 + wc * 32 + 8 * fq; const float* bg = bgu + (size_t)u.e * 2048 + c0;
        constexpr float CS = -1.702f * LOG2E;
        float bgv[8], buv[8];
#pragma unroll
        for (int j = 0; j < 8; ++j) { bgv[j] = CS * bg[j]; buv[j] = bg[1024 + j]; }
        EPI_LOAD_RS(rsc)
#pragma unroll
        for (int ai = 0; ai < 2; ++ai)
#pragma unroll
            for (int m = 0; m < 4; ++m) {
                const int row = u.pm * 256 + ai * 128 + wr * 64 + m * 16 + fr; const float r = rs8[ai][m], rc = CS * r; float o[8];
#pragma unroll
                for (int j = 0; j < 8; ++j) { const float a0 = __builtin_fmaf(acc[ai][0][m][j >> 2][j & 3], rc, bgv[j]), u0 = __builtin_fmaf(acc[ai][1][m][j >> 2][j & 3], r, buv[j]);
                    const float a = fmaxf(a0, 7.f * CS), up = __builtin_amdgcn_fmed3f(u0, -7.f, 7.f);
                    const float t = a * frcp(1.f + fexp2(a));
                    o[j] = __builtin_fmaf(up, t, t); }
                *(u32x2*)((unsigned char*)act + (size_t)row * 1024 + c0) = (u32x2){pack4_fp8(o[0], o[1], o[2], o[3]), pack4_fp8(o[4], o[5], o[6], o[7])};
            }
    }
};
struct EpiDown {
    static constexpr bool PERM = true;
#ifdef PROBE_EPI2
    static constexpr bool PROBE2 = (PROBE_EPI2 == 6);
#endif
    unsigned char* ws; const float* bd;
    __device__ __forceinline__ void operator()(const f32x4 (&acc)[2][2][4][2], const pg8::Unit& u, int wr, int wc, int fr, int fq) const {
        unsigned char* y = ws + WS_Y; const float* b = bd + (size_t)u.e * 1024 + u.pn * 256 + wc * 32 + 8 * fq;
        float bv[2][8];
#pragma unroll
        for (int bj = 0; bj < 2; ++bj) { const f32x4 b0 = *(const f32x4*)(b + bj * 128), b1 = *(const f32x4*)(b + bj * 128 + 4);
            bv[bj][0] = 16.f * b0.x; bv[bj][1] = 16.f * b0.y; bv[bj][2] = 16.f * b0.z; bv[bj][3] = 16.f * b0.w; bv[bj][4] = 16.f * b1.x; bv[bj][5] = 16.f * b1.y; bv[bj][6] = 16.f * b1.z; bv[bj][7] = 16.f * b1.w; }
        EPI_WALK({ _Pragma("unroll") for (int j = 0; j < 8; ++j) v[j] = __builtin_fmaf(16.f, v[j], bv[bj][j]);
                   *(u32x2*)(y + (size_t)row * 1024 + u.pn * 256 + cw) = (u32x2){pack4_fp8(v[0], v[1], v[2], v[3]), pack4_fp8(v[4], v[5], v[6], v[7])}; })
    }
};

typedef short v4i16_t __attribute__((ext_vector_type(4)));
__device__ __forceinline__ s16x4 vtr(const LAS char* p) { return __builtin_bit_cast(s16x4, __builtin_amdgcn_ds_read_tr16_b64_v4i16((LAS v4i16_t*)p)); }
__device__ __forceinline__ float swapmax(float m) { auto rr = __builtin_amdgcn_permlane32_swap(__float_as_uint(m), __float_as_uint(m), false, false); return fmaxf(__uint_as_float(rr[0]), __uint_as_float(rr[1])); }
__device__ __forceinline__ float swapsum(float m) { auto rr = __builtin_amdgcn_permlane32_swap(__float_as_uint(m), __float_as_uint(m), false, false); return __uint_as_float(rr[0]) + __uint_as_float(rr[1]); }

struct AttnState { f32x16 o0, o1; float m, l; };

struct MlaKL {
    const bf16_t* K; const bf16_t* V;
    template <int D0> __device__ __forceinline__ bf16x8 kfrag(int c, int r32, int hi) const { return *(const bf16x8*)(K + (size_t)(c >> 1) * 6144 + (2 * D0 + hi) * 512 + ((c & 1) * 32 + r32) * 8); }
    __device__ __forceinline__ u32x4 vpiece(int c, int row, int c8) const { return *(const u32x4*)(V + (size_t)(c >> 1) * 4096 + (c8 >> 2) * 2048 + ((c & 1) * 32 + row) * 32 + (c8 & 3) * 8); }
    __device__ __forceinline__ void modify(int, f32x16&, int, int) const {}
    __device__ __forceinline__ int order(int i) const { return i; }
};
__device__ __forceinline__ bf16x8 fp8x8_to_bf16(u32x2 w, float sc) {
    const f32x2 a = __builtin_amdgcn_cvt_pk_f32_fp8((int)w.x, false), b = __builtin_amdgcn_cvt_pk_f32_fp8((int)w.x, true), c = __builtin_amdgcn_cvt_pk_f32_fp8((int)w.y, false), d = __builtin_amdgcn_cvt_pk_f32_fp8((int)w.y, true);
    const u32x4 o = {cvtpk(a.x * sc, a.y * sc), cvtpk(b.x * sc, b.y * sc), cvtpk(c.x * sc, c.y * sc), cvtpk(d.x * sc, d.y * sc)};
    return __builtin_bit_cast(bf16x8, o);
}
struct MlaKL8 {
    const unsigned char* K; const bf16_t* V;
    template <int D0> __device__ __forceinline__ bf16x8 kfrag(int c, int r32, int hi) const { return fp8x8_to_bf16(*(const u32x2*)(K + (size_t)(c >> 1) * 6144 + D0 * 1024 + ((c & 1) * 32 + r32) * 16 + hi * 8), 1.f); }
    __device__ __forceinline__ u32x4 vpiece(int c, int row, int c8) const { return *(const u32x4*)(V + (size_t)(c >> 1) * 4096 + (c8 >> 2) * 2048 + ((c & 1) * 32 + row) * 32 + (c8 & 3) * 8); }
    __device__ __forceinline__ void modify(int, f32x16&, int, int) const {}
    __device__ __forceinline__ int order(int i) const { return i; }
};
struct DilKL {
    const bf16_t* K; const bf16_t* V;
    int dil, res, u0, L; float slope2d;
    __device__ __forceinline__ size_t tok(int c, int kk) const { int v = u0 - 64 + 32 * c + kk; v = v < 0 ? 0 : (v >= L ? L - 1 : v); return (size_t)(res + dil * v); }
    template <int D0> __device__ __forceinline__ bf16x8 kfrag(int c, int r32, int hi) const { return *(const bf16x8*)(K + tok(c, r32) * 512 + 16 * D0 + 8 * hi); }
    __device__ __forceinline__ u32x4 vpiece(int c, int row, int c8) const { return *(const u32x4*)(V + tok(c, row) * 512 + 8 * c8); }
    __device__ __forceinline__ void modify(int c, f32x16& s, int r32, int hi) const {
        const float c0 = (float)(32 * c - 64); const int vb = u0 - 64 + 32 * c;
#pragma unroll
        for (int r = 0; r < 16; ++r) { const float d = (float)(crow(r, hi) - r32); s[r] = s[r] - slope2d * fabsf(d + c0); }
        if (c == 0) {
#pragma unroll
            for (int r = 0; r < 16; ++r) s[r] = (crow(r, hi) >= r32) ? s[r] : -1e30f; }
        if (c == 4) {
#pragma unroll
            for (int r = 0; r < 16; ++r) s[r] = (crow(r, hi) <= r32) ? s[r] : -1e30f; }
        if (vb < 0 || vb + 31 >= L) {
#pragma unroll
            for (int r = 0; r < 16; ++r) { const int v = vb + crow(r, hi); s[r] = (v >= 0 && v < L) ? s[r] : -1e30f; } }
    }
    __device__ __forceinline__ int order(int i) const { return i == 0 ? 2 : i == 1 ? 1 : i == 2 ? 3 : i == 3 ? 0 : 4; }
};

template <int NDK, class KL> __device__ __forceinline__ void attn_load_k(bf16x8 (&kf)[NDK], const KL& kl, int c, int r32, int hi) {
    kf[0] = kl.template kfrag<0>(c, r32, hi); kf[1] = kl.template kfrag<1>(c, r32, hi); kf[2] = kl.template kfrag<2>(c, r32, hi); kf[3] = kl.template kfrag<3>(c, r32, hi);
    if constexpr (NDK == 6) { kf[4] = kl.template kfrag<4>(c, r32, hi); kf[5] = kl.template kfrag<5>(c, r32, hi); }
}
template <class KL> __device__ __forceinline__ void attn_load_v(u32x4 (&vp)[4], const KL& kl, int c, int lane) {
#pragma unroll
    for (int i = 0; i < 4; ++i) { const int p = lane + 64 * i; vp[i] = kl.vpiece(c, p >> 3, p & 7); }
}
__device__ __forceinline__ void attn_store_v(const u32x4 (&vp)[4], LAS char* vimg, int lane) {
#pragma unroll
    for (int i = 0; i < 4; ++i) { const int p = lane + 64 * i, row = p >> 3, c8 = p & 7; *(LAS u32x4*)(vimg + (c8 >> 2) * 2048 + row * 64 + (c8 & 3) * 16) = vp[i]; }
}
template <int NDK, class KL> __device__ __forceinline__ void attn_core(AttnState& st, const bf16x8 (&qf)[NDK], const bf16x8 (&kf)[NDK], const KL& kl, int c, LAS char* vimg, LAS float* wsf, int lane, int r32, int hi) {
    f32x16 s = {};
#pragma unroll
    for (int d0 = 0; d0 < NDK; ++d0) s = __builtin_amdgcn_mfma_f32_32x32x16_bf16(kf[d0], qf[d0], s, 0, 0, 0);
    kl.modify(c, s, r32, hi);
    float mx = s[0];
#pragma unroll
    for (int r = 1; r < 16; ++r) mx = fmaxf(mx, s[r]);
    mx = swapmax(mx);
    const float mn = fmaxf(st.m, mx), alpha = fexp2(st.m - mn);
    float ps = 0.f;
#pragma unroll
    for (int r = 0; r < 16; ++r) { s[r] = fexp2(s[r] - mn); ps += s[r]; }
    st.l = st.l * alpha + ps; st.m = mn;
    if (__any(alpha != 1.f)) {
        if (hi == 0) wsf[r32] = alpha;
#pragma unroll
        for (int r = 0; r < 16; ++r) { const float a = wsf[crow(r, hi)]; st.o0[r] *= a; st.o1[r] *= a; }
    }
    const u32x4 pw0 = {cvtpk(s[0], s[1]), cvtpk(s[2], s[3]), cvtpk(s[4], s[5]), cvtpk(s[6], s[7])};
    const u32x4 pw1 = {cvtpk(s[8], s[9]), cvtpk(s[10], s[11]), cvtpk(s[12], s[13]), cvtpk(s[14], s[15])};
    const bf16x8 pa0 = __builtin_bit_cast(bf16x8, pw0), pa1 = __builtin_bit_cast(bf16x8, pw1);
    const LAS char* vp = vimg + ((lane >> 4) & 1) * 32 + (lane & 3) * 8 + (4 * hi + ((lane & 15) >> 2)) * 64;
#pragma unroll
    for (int ks = 0; ks < 2; ++ks) {
        const s16x4 l0 = vtr(vp + ks * 1024), h0 = vtr(vp + ks * 1024 + 512), l1 = vtr(vp + 2048 + ks * 1024), h1 = vtr(vp + 2048 + ks * 1024 + 512);
        const bf16x8 v0 = {l0[0], l0[1], l0[2], l0[3], h0[0], h0[1], h0[2], h0[3]}, v1 = {l1[0], l1[1], l1[2], l1[3], h1[0], h1[1], h1[2], h1[3]};
        st.o0 = __builtin_amdgcn_mfma_f32_32x32x16_bf16(ks == 0 ? pa0 : pa1, v0, st.o0, 0, 0, 0);
        st.o1 = __builtin_amdgcn_mfma_f32_32x32x16_bf16(ks == 0 ? pa0 : pa1, v1, st.o1, 0, 0, 0);
    }
}
template <int NDK, class KL> __device__ __forceinline__ void wave_attn(AttnState& st, const bf16x8 (&qf)[NDK], const KL& kl, int nchunk, LAS char* vimg, LAS float* wsf, int lane) {
    const int r32 = lane & 31, hi = lane >> 5;
    st.o0 = f32x16{}; st.o1 = f32x16{}; st.m = -1e30f; st.l = 0.f;
    bf16x8 kfa[NDK], kfb[NDK]; u32x4 vp[4];
    attn_load_k<NDK>(kfa, kl, kl.order(0), r32, hi); attn_load_v(vp, kl, kl.order(0), lane);
    asm volatile("" : "+s"(nchunk));
#pragma unroll 1
    for (int c = 0; c < nchunk; c += 2) {
        attn_store_v(vp, vimg, lane);
        if (c + 1 < nchunk) { attn_load_k<NDK>(kfb, kl, kl.order(c + 1), r32, hi); attn_load_v(vp, kl, kl.order(c + 1), lane); }
        attn_core<NDK>(st, qf, kfa, kl, kl.order(c), vimg, wsf, lane, r32, hi);
        if (c + 1 < nchunk) {
            attn_store_v(vp, vimg, lane);
            if (c + 2 < nchunk) { attn_load_k<NDK>(kfa, kl, kl.order(c + 2), r32, hi); attn_load_v(vp, kl, kl.order(c + 2), lane); }
            attn_core<NDK>(st, qf, kfb, kl, kl.order(c + 1), vimg, wsf, lane, r32, hi);
        }
    }
}
__device__ __forceinline__ float attn_finish(AttnState& st, LAS char* vimg, LAS float* wsf, int lane) {
    const int r32 = lane & 31, hi = lane >> 5;
    const float lt = swapsum(st.l);
    if (hi == 0) wsf[32 + r32] = lt;
    LAS bf16_t* stg = (LAS bf16_t*)vimg;
#pragma unroll
    for (int r = 0; r < 16; ++r) { const int q = crow(r, hi); const float il = frcp(wsf[32 + q]);
        stg[q * 64 + r32] = (bf16_t)f2bf(st.o0[r] * il); stg[q * 64 + 32 + r32] = (bf16_t)f2bf(st.o1[r] * il); }
    return lt;
}

namespace mla {
constexpr int NW = 8, QBLK = 32, QB = 256, KVBLK = 64, NT = SEQ / KVBLK;
constexpr int KSLOT = 12288, VSLOT = 8192, LDS_K = 0, LDS_V = 3 * KSLOT, LDS_WS = LDS_V + 3 * VSLOT, LDS_OST = LDS_WS + NW * 256, LDS_BYTES_ = LDS_OST + NW * 4096;
#define SBAR() __builtin_amdgcn_sched_barrier(0)
#define WAIT_BAR(N) asm volatile("s_waitcnt vmcnt(" #N ") lgkmcnt(0)\n\ts_barrier" ::: "memory")
__device__ __forceinline__ void glds16(const void* gsrc, unsigned lds_dst) { unsigned keep;
    asm volatile("s_mov_b32 %0, m0\n\ts_mov_b32 m0, %2\n\ts_nop 0\n\tglobal_load_lds_dwordx4 %1, off\n\ts_mov_b32 m0, %0" : "=&s"(keep) : "v"(gsrc), "s"(lds_dst) : "memory"); }
typedef LAS const char* lds_cptr;
__device__ __forceinline__ void kload2(bf16x8* kf, lds_cptr kp, int j) { kf[2 * j] = *(const LAS bf16x8*)(kp + j * 2048); kf[2 * j + 1] = *(const LAS bf16x8*)(kp + j * 2048 + 512); }

__device__ __forceinline__ void mla_unit(int b, int h, int qb, const bf16_t* Q, const bf16_t* __restrict__ Kim, const bf16_t* __restrict__ Vim, bf16_t* O, LAS char* shm) {
    const int tid = threadIdx.x, lane = tid & 63, r32 = lane & 31, hi = lane >> 5; const int wid = __builtin_amdgcn_readfirstlane(tid >> 6);
    const long rowbase = (long)b * SEQ; const int q0 = qb * QB;
    const bf16_t* Qw = Q + (rowbase + q0 + wid * QBLK) * 768 + h * 96;
    const unsigned lds0 = (unsigned)(uintptr_t)shm;
    LAS float* wsf = (LAS float*)(shm + LDS_WS) + wid * 64;
    const bf16_t* ksrc = Kim + wid * 512 + lane * 8;
    const bf16_t* rsrc = Kim + (8 + (wid & 3)) * 512 + lane * 8;
    const bf16_t* vsrc = Vim + wid * 512 + lane * 8;
    const unsigned kdst = lds0 + LDS_K + wid * 1024, rdst = lds0 + LDS_K + (8 + (wid & 3)) * 1024, vdst = lds0 + LDS_V + wid * 1024;
#define DMA_K(t, ks) do { glds16(ksrc + (long)(t) * 6144, (unsigned)__builtin_amdgcn_readfirstlane(kdst + (ks))); glds16(rsrc + (long)(t) * 6144, (unsigned)__builtin_amdgcn_readfirstlane(rdst + (ks))); } while (0)
#define DMA_V(t, vs) glds16(vsrc + (long)(t) * 4096, (unsigned)__builtin_amdgcn_readfirstlane(vdst + (vs)))
    const lds_cptr shm3 = (lds_cptr)shm; const lds_cptr kp0 = shm3 + LDS_K + hi * 1024 + r32 * 16;
    const lds_cptr vp0 = shm3 + LDS_V + ((lane >> 4) & 1) * 32 + (lane & 3) * 8 + (4 * hi + ((lane & 15) >> 2)) * 64;
    bf16x8 kf[12];
    DMA_K(0, 0); DMA_V(0, 0); DMA_K(1, KSLOT);
    bf16x8 qr[6];
#pragma unroll
    for (int d0 = 0; d0 < 6; ++d0) qr[d0] = *reinterpret_cast<const bf16x8*>(&Qw[(long)r32 * 768 + d0 * 16 + hi * 8]);
    float l_reg = 0.f; f32x16 o[2]; o[0] = f32x16{}; o[1] = f32x16{};
    f32x16 pA0, pA1, pB0, pB1;
    int si_prev = 0, si_cur = 0, si_next = 1;
#define ROT() do { si_prev = si_cur; si_cur = si_next; si_next = (si_next == 2) ? 0 : si_next + 1; } while (0)
    DMA_K(2, 2 * KSLOT);
    WAIT_BAR(5);
    { const lds_cptr kb = kp0;
#pragma unroll
      for (int d0 = 0; d0 < 6; ++d0) { const bf16x8 b0 = *(const LAS bf16x8*)(kb + d0 * 2048), b1 = *(const LAS bf16x8*)(kb + d0 * 2048 + 512);
          if (d0 == 0) { pA0 = __builtin_amdgcn_mfma_f32_32x32x16_bf16(b0, qr[0], f32x16{}, 0, 0, 0); pA1 = __builtin_amdgcn_mfma_f32_32x32x16_bf16(b1, qr[0], f32x16{}, 0, 0, 0); }
          else { pA0 = __builtin_amdgcn_mfma_f32_32x32x16_bf16(b0, qr[d0], pA0, 0, 0, 0); pA1 = __builtin_amdgcn_mfma_f32_32x32x16_bf16(b1, qr[d0], pA1, 0, 0, 0); } } }
#pragma unroll
    for (int r = 0; r < 16; ++r) { pA0[r] = __builtin_amdgcn_exp2f(pA0[r]); pA1[r] = __builtin_amdgcn_exp2f(pA1[r]); }
    WAIT_BAR(0);
    DMA_K(3, 0); DMA_V(1, VSLOT);
    ROT();
#pragma unroll
    for (int j = 0; j < 6; ++j) kload2(kf, kp0 + si_cur * KSLOT, j);
    WAIT_BAR(3);
    s16x4 vlo[8], vhi[8]; u32x4 pw0, pw1, pw2, pw3;
#define PKW(P, B) cvtpk(P[B], P[B + 1])
#define PAF(k) __builtin_bit_cast(bf16x8, pw##k)
#define VFR(i) (bf16x8){vlo[i][0], vlo[i][1], vlo[i][2], vlo[i][3], vhi[i][0], vhi[i][1], vhi[i][2], vhi[i][3]}
#define PIN(x) asm volatile("" : "+v"(x))
#define MF(a, b, c) __builtin_amdgcn_mfma_f32_32x32x16_bf16(a, b, c, 0, 0, 0)
#define GAPA(MFX, A0, A1, A2, A3, W0, W1, PW) do { MFX; sacc += A0; sacc += A1; sacc += A2; sacc += A3; PIN(sacc); W0; W1; PIN(PW); SBAR(); } while (0)
#define GAPM(MFX) do { MFX; SBAR(); } while (0)
#define EX(v) __builtin_amdgcn_exp2f(v)
#define GAPB(MFX, X, B) do { MFX; X[B] = EX(X[B]); X[B + 1] = EX(X[B + 1]); X[B + 2] = EX(X[B + 2]); X[B + 3] = EX(X[B + 3]); PIN(X); SBAR(); } while (0)
#define VRD(i) do { vlo[i] = vtr(vp_ + (((i) >> 2) * 4096 + ((i) & 3) * 1024)); vhi[i] = vtr(vp_ + (((i) >> 2) * 4096 + ((i) & 3) * 1024 + 512)); } while (0)
#define KRD(G, j) do { if (G) { kload2(kf, kp0 + si_next * KSLOT, j); SBAR(); } } while (0)
#define STEP(C0, C1, P0, P1, t, GK, GV, GL) do { SBAR(); \
    const lds_cptr vp_ = vp0 + si_prev * VSLOT; \
    VRD(0); SBAR(); float sacc = (P0[0] + P0[1]); \
    GAPA(C0 = MF(kf[0], qr[0], f32x16{}), P0[2], P0[3], P0[4], P0[5],     pw0[0] = PKW(P0, 0),  pw0[1] = PKW(P0, 2),  pw0); \
    VRD(4); SBAR(); GAPA(C1 = MF(kf[1], qr[0], f32x16{}), P0[6], P0[7], P0[8], P0[9],     pw0[2] = PKW(P0, 4),  pw0[3] = PKW(P0, 6),  pw0); \
    VRD(1); SBAR(); GAPA(C0 = MF(kf[2], qr[1], C0),   P0[10], P0[11], P0[12], P0[13], pw1[0] = PKW(P0, 8),  pw1[1] = PKW(P0, 10), pw1); \
    VRD(5); SBAR(); GAPA(C1 = MF(kf[3], qr[1], C1),   P0[14], P0[15], P1[0], P1[1],   pw1[2] = PKW(P0, 12), pw1[3] = PKW(P0, 14), pw1); \
    VRD(2); SBAR(); GAPA(C0 = MF(kf[4], qr[2], C0),   P1[2], P1[3], P1[4], P1[5],     pw2[0] = PKW(P1, 0),  pw2[1] = PKW(P1, 2),  pw2); \
    VRD(6); SBAR(); GAPA(C1 = MF(kf[5], qr[2], C1),   P1[6], P1[7], P1[8], P1[9],     pw2[2] = PKW(P1, 4),  pw2[3] = PKW(P1, 6),  pw2); \
    VRD(3); SBAR(); GAPA(C0 = MF(kf[6], qr[3], C0),   P1[10], P1[11], P1[12], P1[13], pw3[0] = PKW(P1, 8),  pw3[1] = PKW(P1, 10), pw3); \
    VRD(7); SBAR(); GAPA(C1 = MF(kf[7], qr[3], C1),   P1[14], P1[15], 0.f, 0.f,       pw3[2] = PKW(P1, 12), pw3[3] = PKW(P1, 14), pw3); \
    GAPM(C0 = MF(kf[8], qr[4], C0)); GAPM(C1 = MF(kf[9], qr[4], C1)); GAPM(C0 = MF(kf[10], qr[5], C0)); GAPM(C1 = MF(kf[11], qr[5], C1)); \
    l_reg += sacc; \
    if (GK) { DMA_K((t) + 3, si_cur * KSLOT); } if (GV) { DMA_V((t) + 1, si_next * VSLOT); } \
    SBAR(); \
    GAPB(o[0] = MF(PAF(0), VFR(0), o[0]), C0, 0); \
    GAPB(o[1] = MF(PAF(0), VFR(4), o[1]), C0, 4); \
    KRD(GL, 0); GAPB(o[0] = MF(PAF(1), VFR(1), o[0]), C0, 8); \
    KRD(GL, 1); GAPB(o[1] = MF(PAF(1), VFR(5), o[1]), C0, 12); \
    KRD(GL, 2); GAPB(o[0] = MF(PAF(2), VFR(2), o[0]), C1, 0); \
    KRD(GL, 3); GAPB(o[1] = MF(PAF(2), VFR(6), o[1]), C1, 4); \
    KRD(GL, 4); GAPB(o[0] = MF(PAF(3), VFR(3), o[0]), C1, 8); \
    KRD(GL, 5); GAPB(o[1] = MF(PAF(3), VFR(7), o[1]), C1, 12); \
    } while (0)
    int t = 1;
    for (; t + 5 < NT; t += 2) {
        STEP(pB0, pB1, pA0, pA1, t, true, true, true);     WAIT_BAR(3); ROT();
        STEP(pA0, pA1, pB0, pB1, t + 1, true, true, true); WAIT_BAR(3); ROT();
    }
#define ENDW(tt) do { if ((tt) + 3 < NT) { WAIT_BAR(3); } else if ((tt) + 2 < NT) { WAIT_BAR(1); } else { WAIT_BAR(0); } } while (0)
    for (; t + 1 < NT; t += 2) {
        STEP(pB0, pB1, pA0, pA1, t, (t + 3 < NT), (t + 1 < NT), (t + 1 < NT));         ENDW(t);     ROT();
        STEP(pA0, pA1, pB0, pB1, t + 1, (t + 4 < NT), (t + 2 < NT), (t + 2 < NT));     ENDW(t + 1); ROT();
    }
    STEP(pB0, pB1, pA0, pA1, NT - 1, false, false, false);
    { float sacc = pB0[0] + pB0[1];
#pragma unroll
      for (int r = 2; r < 16; ++r) sacc += pB0[r];
#pragma unroll
      for (int r = 0; r < 16; ++r) sacc += pB1[r];
      l_reg += sacc;
      pw0 = (u32x4){PKW(pB0, 0), PKW(pB0, 2), PKW(pB0, 4), PKW(pB0, 6)}; pw1 = (u32x4){PKW(pB0, 8), PKW(pB0, 10), PKW(pB0, 12), PKW(pB0, 14)};
      pw2 = (u32x4){PKW(pB1, 0), PKW(pB1, 2), PKW(pB1, 4), PKW(pB1, 6)}; pw3 = (u32x4){PKW(pB1, 8), PKW(pB1, 10), PKW(pB1, 12), PKW(pB1, 14)};
      SBAR();
      const lds_cptr vp_ = vp0 + si_cur * VSLOT;
#pragma unroll
      for (int d0 = 0; d0 < 2; ++d0) {
          s16x4 lo4[4], hi4[4];
#pragma unroll
          for (int ks = 0; ks < 4; ++ks) { lo4[ks] = vtr(vp_ + d0 * 4096 + ks * 1024); hi4[ks] = vtr(vp_ + d0 * 4096 + ks * 1024 + 512); }
#define PK4(k) (bf16x8){lo4[k][0], lo4[k][1], lo4[k][2], lo4[k][3], hi4[k][0], hi4[k][1], hi4[k][2], hi4[k][3]}
          o[d0] = MF(PAF(0), PK4(0), o[d0]); o[d0] = MF(PAF(1), PK4(1), o[d0]); o[d0] = MF(PAF(2), PK4(2), o[d0]); o[d0] = MF(PAF(3), PK4(3), o[d0]);
#undef PK4
      } }
    l_reg = swapsum(l_reg);
    if (hi == 0) wsf[32 + r32] = l_reg;
    asm volatile("s_waitcnt lgkmcnt(0)" ::: "memory");
    float rli[16];
#pragma unroll
    for (int r = 0; r < 16; ++r) rli[r] = __builtin_amdgcn_rcpf(wsf[32 + crow(r, hi)]);
    bf16_t* Ow = O + (rowbase + q0 + wid * QBLK) * 512 + h * 64;
    { LAS bf16_t* stg = (LAS bf16_t*)(shm + LDS_OST) + wid * 2048;
#pragma unroll
      for (int r = 0; r < 16; ++r) { const int orow = crow(r, hi);
#pragma unroll
          for (int d0 = 0; d0 < 2; ++d0) stg[orow * 64 + d0 * 32 + r32] = (bf16_t)f2bf(o[d0][r] * rli[r]); }
      asm volatile("s_waitcnt lgkmcnt(0)" ::: "memory");
#pragma unroll
      for (int i = 0; i < 4; ++i) { const int row = i * 8 + (lane >> 3), ch = lane & 7; const u32x4 v = *(const LAS u32x4*)(stg + row * 64 + ch * 8); *(u32x4*)(Ow + (long)row * 512 + ch * 8) = v; } }
    asm volatile("s_waitcnt lgkmcnt(0)\n\ts_barrier" ::: "memory");
#undef DMA_K
#undef DMA_V
#undef ROT
#undef PKW
#undef PAF
#undef VFR
#undef PIN
#undef MF
#undef GAPA
#undef GAPM
#undef GAPB
#undef EX
#undef VRD
#undef KRD
#undef STEP
#undef ENDW
}
#undef SBAR
#undef WAIT_BAR
}

namespace mla8 {
using mla::glds16; using mla::lds_cptr;
typedef int v8i __attribute__((ext_vector_type(8)));
constexpr int NW = 8, QBLK = 32, QB = 256, KVBLK = 64, NT = SEQ / KVBLK;
constexpr int KSLOT = 6144, VSLOT = 8192, LDS_K = 0, LDS_V = 3 * KSLOT, LDS_WS = LDS_V + 3 * VSLOT, LDS_OST = LDS_WS + NW * 256, LDS_BYTES_ = LDS_OST + NW * 4096;
#define SBAR() __builtin_amdgcn_sched_barrier(0)
#define WAIT_BAR(N) asm volatile("s_waitcnt vmcnt(" #N ") lgkmcnt(0)\n\ts_barrier" ::: "memory")
__device__ __forceinline__ v8i kfrag8(lds_cptr slot, int n, int ks, int r32, int hi) {
    const lds_cptr p = slot + (ks == 0 ? 2 * hi : 4) * 1024 + (32 * n + r32) * 16;
    const u32x4 a = *(const LAS u32x4*)p, b = *(const LAS u32x4*)(p + 1024);
    return (v8i){(int)a.x, (int)a.y, (int)a.z, (int)a.w, (int)b.x, (int)b.y, (int)b.z, (int)b.w};
}
#define MF8(a, b, c) __builtin_amdgcn_mfma_scale_f32_32x32x64_f8f6f4(a, b, c, 0, 0, 0, 0x7f7f7f7f, 0, 0x7b7b7b7b)

__device__ __forceinline__ void mla8_unit(int b, int h, int qb, const unsigned char* Q8, const unsigned char* __restrict__ K8im, const bf16_t* __restrict__ Vim, bf16_t* O, LAS char* shm) {
    const int tid = threadIdx.x, lane = tid & 63, r32 = lane & 31, hi = lane >> 5; const int wid = __builtin_amdgcn_readfirstlane(tid >> 6);
    const long rowbase = (long)b * SEQ; const int q0 = qb * QB;
    const unsigned char* Qw = Q8 + (size_t)(rowbase + q0 + wid * QBLK + r32) * 768 + h * 96;
    const unsigned lds0 = (unsigned)(uintptr_t)shm;
    LAS float* wsf = (LAS float*)(shm + LDS_WS) + wid * 64;
    const int kpc = wid < 6 ? wid : wid - 6;
    const unsigned char* ksrc = K8im + kpc * 1024 + lane * 16;
    const bf16_t* vsrc = Vim + wid * 512 + lane * 8;
    const unsigned kdst = lds0 + LDS_K + kpc * 1024, vdst = lds0 + LDS_V + wid * 1024;
#define DMA_K(t, ks) glds16(ksrc + (long)(t) * 6144, (unsigned)__builtin_amdgcn_readfirstlane(kdst + (ks)))
#define DMA_V(t, vs) glds16(vsrc + (long)(t) * 4096, (unsigned)__builtin_amdgcn_readfirstlane(vdst + (vs)))
    const lds_cptr shm3 = (lds_cptr)shm; const lds_cptr ks0 = shm3 + LDS_K;
    const lds_cptr vp0 = shm3 + LDS_V + ((lane >> 4) & 1) * 32 + (lane & 3) * 8 + (4 * hi + ((lane & 15) >> 2)) * 64;
    v8i kf[4];
    DMA_K(0, 0); DMA_V(0, 0); DMA_K(1, KSLOT);
    v8i qr[2];
    { const u32x4 a = *(const u32x4*)(Qw + 32 * hi), c = *(const u32x4*)(Qw + 32 * hi + 16); qr[0] = (v8i){(int)a.x, (int)a.y, (int)a.z, (int)a.w, (int)c.x, (int)c.y, (int)c.z, (int)c.w};
      u32x4 d = *(const u32x4*)(Qw + 64), e = *(const u32x4*)(Qw + 80); if (hi) { d = (u32x4){0u, 0u, 0u, 0u}; e = d; }
      qr[1] = (v8i){(int)d.x, (int)d.y, (int)d.z, (int)d.w, (int)e.x, (int)e.y, (int)e.z, (int)e.w}; }
    float l_reg = 0.f; f32x16 o[2]; o[0] = f32x16{}; o[1] = f32x16{};
    f32x16 pA0, pA1, pB0, pB1;
    int si_prev = 0, si_cur = 0, si_next = 1;
#define ROT() do { si_prev = si_cur; si_cur = si_next; si_next = (si_next == 2) ? 0 : si_next + 1; } while (0)
    DMA_K(2, 2 * KSLOT);
    WAIT_BAR(3);
    { pA0 = MF8(kfrag8(ks0, 0, 0, r32, hi), qr[0], f32x16{}); pA1 = MF8(kfrag8(ks0, 1, 0, r32, hi), qr[0], f32x16{});
      pA0 = MF8(kfrag8(ks0, 0, 1, r32, hi), qr[1], pA0); pA1 = MF8(kfrag8(ks0, 1, 1, r32, hi), qr[1], pA1); }
#pragma unroll
    for (int r = 0; r < 16; ++r) { pA0[r] = __builtin_amdgcn_exp2f(pA0[r]); pA1[r] = __builtin_amdgcn_exp2f(pA1[r]); }
    WAIT_BAR(0);
    DMA_K(3, 0); DMA_V(1, VSLOT);
    ROT();
    kf[0] = kfrag8(ks0 + si_cur * KSLOT, 0, 0, r32, hi); kf[1] = kfrag8(ks0 + si_cur * KSLOT, 0, 1, r32, hi); kf[2] = kfrag8(ks0 + si_cur * KSLOT, 1, 0, r32, hi); kf[3] = kfrag8(ks0 + si_cur * KSLOT, 1, 1, r32, hi);
    WAIT_BAR(2);
    s16x4 vlo[8], vhi[8]; u32x4 pw0, pw1, pw2, pw3;
#define PKW(P, B) cvtpk(P[B], P[B + 1])
#define PAF(k) __builtin_bit_cast(bf16x8, pw##k)
#define VFR(i) (bf16x8){vlo[i][0], vlo[i][1], vlo[i][2], vlo[i][3], vhi[i][0], vhi[i][1], vhi[i][2], vhi[i][3]}
#define PIN(x) asm volatile("" : "+v"(x))
#define MF(a, b, c) __builtin_amdgcn_mfma_f32_32x32x16_bf16(a, b, c, 0, 0, 0)
#define GAPA(MFX, A0, A1, A2, A3, W0, W1, PW) do { MFX; sacc += A0; sacc += A1; sacc += A2; sacc += A3; PIN(sacc); W0; W1; PIN(PW); SBAR(); } while (0)
#define GAPM(MFX) do { MFX; SBAR(); } while (0)
#define EX(v) __builtin_amdgcn_exp2f(v)
#define GAPB(MFX, X, B) do { MFX; X[B] = EX(X[B]); X[B + 1] = EX(X[B + 1]); X[B + 2] = EX(X[B + 2]); X[B + 3] = EX(X[B + 3]); PIN(X); SBAR(); } while (0)
#define VRD(i) do { vlo[i] = vtr(vp_ + (((i) >> 2) * 4096 + ((i) & 3) * 1024)); vhi[i] = vtr(vp_ + (((i) >> 2) * 4096 + ((i) & 3) * 1024 + 512)); } while (0)
#define KRD(G, j) do { if (G) { kf[j] = kfrag8(ks0 + si_next * KSLOT, (j) >> 1, (j) & 1, r32, hi); SBAR(); } } while (0)
#define GAPA8(MFX, A0, A1, A2, A3, A4, A5, A6, A7, W0, W1, W2, W3, PWa, PWb) do { MFX; sacc += A0; sacc += A1; sacc += A2; sacc += A3; PIN(sacc); W0; W1; PIN(PWa); sacc += A4; sacc += A5; sacc += A6; sacc += A7; PIN(sacc); W2; W3; PIN(PWb); SBAR(); } while (0)
#define STEP(C0, C1, P0, P1, t, GK, GV, GL) do { SBAR(); \
    const lds_cptr vp_ = vp0 + si_prev * VSLOT; \
    VRD(0); VRD(4); SBAR(); float sacc = (P0[0] + P0[1]); \
    GAPA8(C0 = MF8(kf[0], qr[0], f32x16{}), P0[2], P0[3], P0[4], P0[5], P0[6], P0[7], P0[8], P0[9],         pw0[0] = PKW(P0, 0), pw0[1] = PKW(P0, 2), pw0[2] = PKW(P0, 4), pw0[3] = PKW(P0, 6), pw0, pw0); \
    VRD(1); VRD(5); SBAR(); \
    GAPA8(C1 = MF8(kf[2], qr[0], f32x16{}), P0[10], P0[11], P0[12], P0[13], P0[14], P0[15], P1[0], P1[1],   pw1[0] = PKW(P0, 8), pw1[1] = PKW(P0, 10), pw1[2] = PKW(P0, 12), pw1[3] = PKW(P0, 14), pw1, pw1); \
    VRD(2); VRD(6); SBAR(); \
    GAPA8(C0 = MF8(kf[1], qr[1], C0),       P1[2], P1[3], P1[4], P1[5], P1[6], P1[7], P1[8], P1[9],         pw2[0] = PKW(P1, 0), pw2[1] = PKW(P1, 2), pw2[2] = PKW(P1, 4), pw2[3] = PKW(P1, 6), pw2, pw2); \
    VRD(3); VRD(7); SBAR(); \
    GAPA8(C1 = MF8(kf[3], qr[1], C1),       P1[10], P1[11], P1[12], P1[13], P1[14], P1[15], 0.f, 0.f,       pw3[0] = PKW(P1, 8), pw3[1] = PKW(P1, 10), pw3[2] = PKW(P1, 12), pw3[3] = PKW(P1, 14), pw3, pw3); \
    l_reg += sacc; \
    if (GK) { DMA_K((t) + 3, si_cur * KSLOT); } if (GV) { DMA_V((t) + 1, si_next * VSLOT); } \
    SBAR(); \
    GAPB(o[0] = MF(PAF(0), VFR(0), o[0]), C0, 0); \
    GAPB(o[1] = MF(PAF(0), VFR(4), o[1]), C0, 4); \
    KRD(GL, 0); GAPB(o[0] = MF(PAF(1), VFR(1), o[0]), C0, 8); \
    KRD(GL, 1); GAPB(o[1] = MF(PAF(1), VFR(5), o[1]), C0, 12); \
    KRD(GL, 2); GAPB(o[0] = MF(PAF(2), VFR(2), o[0]), C1, 0); \
    KRD(GL, 3); GAPB(o[1] = MF(PAF(2), VFR(6), o[1]), C1, 4); \
    GAPB(o[0] = MF(PAF(3), VFR(3), o[0]), C1, 8); \
    GAPB(o[1] = MF(PAF(3), VFR(7), o[1]), C1, 12); \
    } while (0)
    int t = 1;
    for (; t + 5 < NT; t += 2) {
        STEP(pB0, pB1, pA0, pA1, t, true, true, true);     WAIT_BAR(2); ROT();
        STEP(pA0, pA1, pB0, pB1, t + 1, true, true, true); WAIT_BAR(2); ROT();
    }
#define ENDW(tt) do { if ((tt) + 3 < NT) { WAIT_BAR(2); } else if ((tt) + 2 < NT) { WAIT_BAR(1); } else { WAIT_BAR(0); } } while (0)
    for (; t + 1 < NT; t += 2) {
        STEP(pB0, pB1, pA0, pA1, t, (t + 3 < NT), (t + 1 < NT), (t + 1 < NT));         ENDW(t);     ROT();
        STEP(pA0, pA1, pB0, pB1, t + 1, (t + 4 < NT), (t + 2 < NT), (t + 2 < NT));     ENDW(t + 1); ROT();
    }
    STEP(pB0, pB1, pA0, pA1, NT - 1, false, false, false);
    { float sacc = pB0[0] + pB0[1];
#pragma unroll
      for (int r = 2; r < 16; ++r) sacc += pB0[r];
#pragma unroll
      for (int r = 0; r < 16; ++r) sacc += pB1[r];
      l_reg += sacc;
      pw0 = (u32x4){PKW(pB0, 0), PKW(pB0, 2), PKW(pB0, 4), PKW(pB0, 6)}; pw1 = (u32x4){PKW(pB0, 8), PKW(pB0, 10), PKW(pB0, 12), PKW(pB0, 14)};
      pw2 = (u32x4){PKW(pB1, 0), PKW(pB1, 2), PKW(pB1, 4), PKW(pB1, 6)}; pw3 = (u32x4){PKW(pB1, 8), PKW(pB1, 10), PKW(pB1, 12), PKW(pB1, 14)};
      SBAR();
      const lds_cptr vp_ = vp0 + si_cur * VSLOT;
#pragma unroll
      for (int d0 = 0; d0 < 2; ++d0) {
          s16x4 lo4[4], hi4[4];
#pragma unroll
          for (int ks = 0; ks < 4; ++ks) { lo4[ks] = vtr(vp_ + d0 * 4096 + ks * 1024); hi4[ks] = vtr(vp_ + d0 * 4096 + ks * 1024 + 512); }
#define PK4(k) (bf16x8){lo4[k][0], lo4[k][1], lo4[k][2], lo4[k][3], hi4[k][0], hi4[k][1], hi4[k][2], hi4[k][3]}
          o[d0] = MF(PAF(0), PK4(0), o[d0]); o[d0] = MF(PAF(1), PK4(1), o[d0]); o[d0] = MF(PAF(2), PK4(2), o[d0]); o[d0] = MF(PAF(3), PK4(3), o[d0]);
#undef PK4
      } }
    l_reg = swapsum(l_reg);
    if (hi == 0) wsf[32 + r32] = l_reg;
    asm volatile("s_waitcnt lgkmcnt(0)" ::: "memory");
    float rli[16];
#pragma unroll
    for (int r = 0; r < 16; ++r) rli[r] = __builtin_amdgcn_rcpf(wsf[32 + crow(r, hi)]);
    bf16_t* Ow = O + (rowbase + q0 + wid * QBLK) * 512 + h * 64;
    { LAS bf16_t* stg = (LAS bf16_t*)(shm + LDS_OST) + wid * 2048;
#pragma unroll
      for (int r = 0; r < 16; ++r) { const int orow = crow(r, hi);
#pragma unroll
          for (int d0 = 0; d0 < 2; ++d0) stg[orow * 64 + d0 * 32 + r32] = (bf16_t)f2bf(o[d0][r] * rli[r]); }
      asm volatile("s_waitcnt lgkmcnt(0)" ::: "memory");
#pragma unroll
      for (int i = 0; i < 4; ++i) { const int row = i * 8 + (lane >> 3), ch = lane & 7; const u32x4 v = *(const LAS u32x4*)(stg + row * 64 + ch * 8); *(u32x4*)(Ow + (long)row * 512 + ch * 8) = v; } }
    asm volatile("s_waitcnt lgkmcnt(0)\n\ts_barrier" ::: "memory");
#undef DMA_K
#undef DMA_V
#undef ROT
#undef PKW
#undef PAF
#undef VFR
#undef PIN
#undef MF
#undef GAPA
#undef GAPA8
#undef GAPM
#undef GAPB
#undef EX
#undef VRD
#undef KRD
#undef STEP
#undef ENDW
}
#undef SBAR
#undef WAIT_BAR
#undef MF8
}

namespace bgc {
constexpr int N_GU = 32 * 16 * 128, N_D = 32 * 16 * 64, N_ITEMS = N_GU + N_D;
constexpr int SCR_STRIDE = 20, SCR_BUF = 64 * SCR_STRIDE * 4, SCR_WAVE = 2 * SCR_BUF, LDS_SCR = 73728, LDS_G2 = LDS_SCR + NWAVES * SCR_WAVE;
static_assert(LDS_G2 + 4096 <= MISC_OFF, "background conversion LDS");
constexpr int G2_ONES = 1024 + 256;
static_assert(LDS_G2 + 4096 == MISC_OFF, "ones block = MISC words 256..319");
struct Bg {
    const float* wgu; const float* wd; unsigned char* ws; LAS char* scr; LAS const float* g2;
    int gw, ngw, mitems, q;
    int lane, lw, lr, ls;
    unsigned gu_src, gu_dst, d_src, d_dst; int gu_k0, d_e0;
    __device__ __forceinline__ void init(const float* wgu_, const float* wd_, unsigned char* ws_, LAS unsigned char* lds, int wave, int lane_) {
        wgu = wgu_; wd = wd_; ws = ws_; scr = (LAS char*)lds + LDS_SCR + wave * SCR_WAVE; g2 = (LAS const float*)(lds + LDS_G2);
        gw = blockIdx.x * NWAVES + wave; ngw = gridDim.x * NWAVES; mitems = (N_ITEMS + ngw - 1) / ngw; q = 0;
        lane = lane_; lw = (lane_ >> 2) * (SCR_STRIDE * 4) + (lane_ & 3) * 16; lr = (lane_ >> 4) * (4 * SCR_STRIDE * 4) + (lane_ & 15) * 4; ls = (lane_ & 15) * 1024 + (lane_ >> 4) * 4;
        { const int r = gw & 2047, kb = r >> 7, n0 = (r & 127) * 16, pn = n0 >> 8, w = n0 & 255, sc = w < 128 ? 128 * pn + w : 1024 + 128 * pn + (w - 128);
          gu_src = (unsigned)((64 * kb) * 2048 + sc) * 4u; gu_dst = (unsigned)(n0 * 1024 + 64 * kb); gu_k0 = 64 * kb; }
        { const int r = gw & 1023, kb = r >> 6, n0 = (r & 63) * 16; d_src = (unsigned)((64 * kb) * 1024 + n0) * 4u; d_dst = (unsigned)(n0 * 1024 + 64 * kb); d_e0 = (gw >> 10) & 1; }
    }
    __device__ __forceinline__ bool fast() const { return ngw == 2048; }
    __device__ __forceinline__ int clampm(int m) const { m = m < mitems ? m : mitems - 1; return m < 0 ? 0 : m; }
    __device__ __forceinline__ void decode(int m, const char*& src, unsigned char*& dst, int& sh, int& k0) const {
        m = m < 47 ? m : 47; m = m < 0 ? 0 : m;
        const bool kd = m >= 32; const int ed = d_e0 + 2 * (m - 32);
        const char* sg = (const char*)wgu + ((size_t)m << 23) + gu_src; const char* sd = (const char*)wd + ((size_t)ed << 22) + d_src;
        unsigned char* dg = ws + WS_WGU + ((size_t)m << 21) + gu_dst; unsigned char* dd = ws + WS_WD + ((size_t)ed << 20) + d_dst;
        src = kd ? sd : sg; dst = kd ? dd : dg; sh = kd ? 12 : 13; k0 = kd ? G2_ONES : gu_k0;
    }
    __device__ __forceinline__ void decode_gen(int m, const char*& src, unsigned char*& dst, int& sh, int& k0) const {
        m = clampm(m);
        int it = gw + ngw * m; it = it < N_ITEMS ? it : N_ITEMS - 1;
        if (it < N_GU) { const int e = it >> 11, r = it & 2047, kb = r >> 7, n0 = (r & 127) * 16, pn = n0 >> 8, w = n0 & 255, sc = w < 128 ? 128 * pn + w : 1024 + 128 * pn + (w - 128);
            src = (const char*)(wgu + (size_t)e * (1024 * 2048) + (size_t)(64 * kb) * 2048 + sc); dst = ws + WS_WGU + (size_t)e * (2048 * 1024) + (size_t)n0 * 1024 + 64 * kb; sh = 13; k0 = 64 * kb; }
        else { const int i2 = it - N_GU, e = i2 >> 10, r = i2 & 1023, kb = r >> 6, n0 = (r & 63) * 16;
            src = (const char*)(wd + (size_t)e * (1024 * 1024) + (size_t)(64 * kb) * 1024 + n0); dst = ws + WS_WD + (size_t)e * (1024 * 1024) + (size_t)n0 * 1024 + 64 * kb; sh = 12; k0 = G2_ONES; }
    }
    __device__ __forceinline__ f32x4 load(int tk) const {
        const char* src; unsigned char* dst; int sh, k0; decode(tk >> 2, src, dst, sh, k0);
        const char* sb = src + ((size_t)(16 * (tk & 3)) << sh);
#ifdef BGP_HOT
        sb = (const char*)wgu;
#endif
        const unsigned voff = ((unsigned)(lane >> 2) << sh) + (unsigned)((lane & 3) * 16);
        f32x4 v; asm volatile("global_load_dwordx4 %0, %1, %2 nt" : "=v"(v) : "v"(voff), "s"(sb) : "memory");
        return v;
    }
    __device__ __forceinline__ float scale(int tk) const {
        const char* src; unsigned char* dst; int sh, k0; decode(tk >> 2, src, dst, sh, k0);
        return g2[k0 + 16 * (tk & 3) + (lane >> 2)];
    }
    __device__ __forceinline__ void write(int tk, f32x4 v, float s) const {
        const int m = tk >> 2;
        *(LAS f32x4*)(scr + (m & 1) * SCR_BUF + (tk & 3) * (16 * SCR_STRIDE * 4) + lw) = v * (64.f * s);
    }
    __device__ __forceinline__ f32x4 out_read(int tk) const {
        const int m1 = (tk >> 2) - 1;
        const LAS float* s = (const LAS float*)(scr + (m1 & 1) * SCR_BUF + (tk & 3) * (16 * SCR_STRIDE * 4) + lr);
        return (f32x4){s[0], s[SCR_STRIDE], s[2 * SCR_STRIDE], s[3 * SCR_STRIDE]};
    }
    __device__ __forceinline__ void out_store(int tk, f32x4 r) const {
        const char* src; unsigned char* dst; int sh, k0; decode((tk >> 2) - 1, src, dst, sh, k0);
        const unsigned char* db = dst + 16 * (tk & 3);
        const unsigned w = pack4_fp8(r.x, r.y, r.z, r.w);
        asm volatile("global_store_dword %0, %1, %2" :: "v"(ls), "v"(w), "s"(db) : "memory");
    }
    __device__ __forceinline__ void tick_sync(int tk, bool do_out) const {
        const char* src; unsigned char* dst; int sh, k0; decode_gen(tk >> 2, src, dst, sh, k0);
        const char* p = src + ((size_t)(16 * (tk & 3) + (lane >> 2)) << sh) + (lane & 3) * 16;
        f32x4 v = *(const f32x4*)p; const float s = g2[k0 + 16 * (tk & 3) + (lane >> 2)];
        write(tk, v, s);
        asm volatile("s_waitcnt lgkmcnt(0)" ::: "memory");
        if (do_out) { const char* src1; unsigned char* dst1; int sh1, k1; decode_gen((tk >> 2) - 1, src1, dst1, sh1, k1);
            const f32x4 r = out_read(tk); *(unsigned*)(dst1 + 16 * (tk & 3) + ls) = pack4_fp8(r.x, r.y, r.z, r.w); }
    }
    __device__ __forceinline__ int q_end() const { return 4 * mitems + 4; }
};
}

namespace mla88 {
using mla::glds16; using mla::lds_cptr;
typedef int v8i __attribute__((ext_vector_type(8)));
typedef short v2s __attribute__((ext_vector_type(2)));
#ifdef PROBE_NODMA
#define PROBE_NODMA_ 1
#else
#define PROBE_NODMA_ 0
#endif
#ifndef PSCALE
#define PSCALE 16.0f
#endif
constexpr float PSCALE_LMIN = 512.f;
constexpr int NW = 8, QBLK = 32, QB = 256, KVBLK = 64, NT = SEQ / KVBLK;
constexpr int KSLOT = 6144, VSLOT = 4096, NSLOT_ = 4, LDS_K = 0, LDS_V = NSLOT_ * KSLOT, LDS_OST = LDS_V + NSLOT_ * VSLOT, LDS_WL = LDS_OST + NW * 4096, LDS_BYTES_ = LDS_WL + NW * 128;
static_assert(LDS_BYTES_ <= RING_BYTES, "mla88 LDS");
#define SBAR() __builtin_amdgcn_sched_barrier(0)
#ifdef PROBE_X2BAR
#define WAIT_BAR(N) do { asm volatile("" ::: "memory"); __builtin_amdgcn_s_waitcnt(((N) & 15) | (7 << 4) | (0 << 8)); __builtin_amdgcn_s_barrier(); __builtin_amdgcn_s_barrier(); asm volatile("" ::: "memory"); } while (0)
#else
#define WAIT_BAR(N) do { asm volatile("" ::: "memory"); __builtin_amdgcn_s_waitcnt(((N) & 15) | (7 << 4) | (0 << 8)); __builtin_amdgcn_s_barrier(); asm volatile("" ::: "memory"); } while (0)
#endif
__device__ __forceinline__ void glds16c(const void* gsrc, unsigned lds_dst) {
    asm volatile("s_mov_b32 m0, %1\n\ts_nop 0\n\tglobal_load_lds_dwordx4 %0, off" :: "v"(gsrc), "s"(lds_dst) : "memory", "m0"); }
__device__ __forceinline__ v8i kfrag8(lds_cptr slot, int n, int ks, int r32, int hi) {
    const lds_cptr p = slot + (ks == 0 ? 2 * hi : 4) * 1024 + (32 * n + r32) * 16;
    const u32x4 a = *(const LAS u32x4*)p, b = *(const LAS u32x4*)(p + 1024);
    return (v8i){(int)a.x, (int)a.y, (int)a.z, (int)a.w, (int)b.x, (int)b.y, (int)b.z, (int)b.w};
}
#define MF8(a, b, c) __builtin_amdgcn_mfma_scale_f32_32x32x64_f8f6f4(a, b, c, 0, 0, 0, 0x7f7f7f7f, 0, 0x7b7b7b7b)
#define MF8V(a, b, c) __builtin_amdgcn_mfma_scale_f32_32x32x64_f8f6f4(a, b, c, 0, 0, 0, 0x7f7f7f7f, 0, 0x7f7f7f7f)
__device__ __forceinline__ v8i vfrag8(lds_cptr slot, int dh, int r32, int hi) {
    const lds_cptr p = slot + dh * 2048 + (2 * hi) * 512 + r32 * 16;
    const u32x4 a = *(const LAS u32x4*)p, b = *(const LAS u32x4*)(p + 512);
    return (v8i){(int)a.x, (int)a.y, (int)a.z, (int)a.w, (int)b.x, (int)b.y, (int)b.z, (int)b.w};
}

__device__ __forceinline__ bool mla88_unit(int b, int h, int qb, const unsigned char* Q8, const unsigned char* __restrict__ K8im, const unsigned char* __restrict__ V8im, bf16_t* O, LAS char* shm, bgc::Bg& bg) {
    const int tid = threadIdx.x, lane = tid & 63, r32 = lane & 31, hi = lane >> 5; const int wid = __builtin_amdgcn_readfirstlane(tid >> 6);
    const long rowbase = (long)b * SEQ; const int q0 = qb * QB;
    const unsigned char* Qw = Q8 + (size_t)(rowbase + q0 + wid * QBLK + r32) * 768 + h * 96;
    const unsigned lds0 = (unsigned)(uintptr_t)shm;
    const int kpc = wid < 6 ? wid : wid - 6;
#ifdef MLA_FLAT_DMA
    const unsigned char* ksrc = K8im + kpc * 1024 + lane * 16;
    const unsigned char* vsrc = V8im + (wid & 3) * 1024 + lane * 16;
#else
    const unsigned char* dbase = K8im < V8im ? K8im : V8im;
    const __amdgpu_buffer_rsrc_t srd = __builtin_amdgcn_make_buffer_rsrc((void*)dbase, (short)0, (int)0x7fffffff, 0x00020000);
    const unsigned kso = (unsigned)__builtin_amdgcn_readfirstlane((int)(K8im - dbase)), vso = (unsigned)__builtin_amdgcn_readfirstlane((int)(V8im - dbase));
    const unsigned kvo = (unsigned)(kpc * 1024 + lane * 16), vvo = (unsigned)((wid & 3) * 1024 + lane * 16);
#endif
    const unsigned kdst = lds0 + LDS_K + kpc * 1024, vdst = lds0 + LDS_V + (wid & 3) * 1024;
#ifdef MLA_FLAT_DMA
#define DMA_K(t, sl) glds16c(ksrc + (long)(t) * 6144, (unsigned)__builtin_amdgcn_readfirstlane(kdst + (sl) * KSLOT))
#define DMA_V(t, sl) glds16c(vsrc + (long)(t) * 4096, (unsigned)__builtin_amdgcn_readfirstlane(vdst + (sl) * VSLOT))
#else
#define DMA_B(m0v, vo, so) asm volatile("s_mov_b32 m0, %0\n\ts_nop 0\n\tbuffer_load_dwordx4 %1, %2, %3 offen lds" :: "s"(m0v), "v"(vo), "s"(srd), "s"(so) : "m0", "memory")
#define DMA_K(t, sl) DMA_B((unsigned)__builtin_amdgcn_readfirstlane(kdst + (sl) * KSLOT), kvo, (unsigned)__builtin_amdgcn_readfirstlane((int)(kso + (unsigned)(t) * 6144u)))
#define DMA_V(t, sl) DMA_B((unsigned)__builtin_amdgcn_readfirstlane(vdst + (sl) * VSLOT), vvo, (unsigned)__builtin_amdgcn_readfirstlane((int)(vso + (unsigned)(t) * 4096u)))
#endif
    const lds_cptr shm3 = (lds_cptr)shm; const lds_cptr ks0 = shm3 + LDS_K; const lds_cptr vs0 = shm3 + LDS_V;
    v8i kf[4];
    DMA_K(0, 0); DMA_V(0, 0); DMA_K(1, 1); DMA_V(1, 1); DMA_K(2, 2); DMA_K(3, 3);
    v8i qr[2];
    { const u32x4 a = *(const u32x4*)(Qw + 32 * hi), c = *(const u32x4*)(Qw + 32 * hi + 16); qr[0] = (v8i){(int)a.x, (int)a.y, (int)a.z, (int)a.w, (int)c.x, (int)c.y, (int)c.z, (int)c.w};
      u32x4 d = *(const u32x4*)(Qw + 64), e = *(const u32x4*)(Qw + 80); if (hi) { d = (u32x4){0u, 0u, 0u, 0u}; e = d; }
      qr[1] = (v8i){(int)d.x, (int)d.y, (int)d.z, (int)d.w, (int)e.x, (int)e.y, (int)e.z, (int)e.w}; }
    f32x16 o[2]; o[0] = f32x16{}; o[1] = f32x16{};
    f32x16 pA0, pA1, pB0, pB1;
    WAIT_BAR(0);
    { pA0 = MF8(kfrag8(ks0, 0, 0, r32, hi), qr[0], f32x16{}); pA1 = MF8(kfrag8(ks0, 1, 0, r32, hi), qr[0], f32x16{});
      pA0 = MF8(kfrag8(ks0, 0, 1, r32, hi), qr[1], pA0); pA1 = MF8(kfrag8(ks0, 1, 1, r32, hi), qr[1], pA1); }
#pragma unroll
    for (int r = 0; r < 16; ++r) { pA0[r] = __builtin_amdgcn_exp2f(pA0[r]); if (r < 8) pA1[r] = __builtin_amdgcn_exp2f(pA1[r]); }
    kf[0] = kfrag8(ks0 + KSLOT, 0, 0, r32, hi); kf[1] = kfrag8(ks0 + KSLOT, 0, 1, r32, hi); kf[2] = kfrag8(ks0 + KSLOT, 1, 0, r32, hi); kf[3] = kfrag8(ks0 + KSLOT, 1, 1, r32, hi);
    WAIT_BAR(0);
    DMA_K(4, 0); DMA_V(2, 2);
    v8i vf[2], p8 = {0, 0, 0, 0, 0, 0, 0, 0};
    v8i ones8; { const int on = (((lane >> 4) & 1) == (lane & 15)) ? 0x38383838 : 0; ones8 = (v8i){on, on, on, on, on, on, on, on}; }
    asm volatile("" : "+v"(ones8));
    f32x4 lacc = {0.f, 0.f, 0.f, 0.f};
#define MF16S(a, b, c) __builtin_amdgcn_mfma_scale_f32_16x16x128_f8f6f4(a, b, c, 0, 0, 0, 0x7f7f7f7f, 0, 0x7f7f7f7f)
#ifdef PROBE_X2MFMA
#define X2MF
#else
#define X2MF
#endif
    float psc = PSCALE; asm volatile("" : "+v"(psc));
#define PIN(x) asm volatile("" : "+v"(x))
#ifdef PROBE_NOEXP
#define EX(v) (v)
#else
#define EX(v) __builtin_amdgcn_exp2f(v)
#endif
#ifdef PROBE_NOCVT
#define PK4O(O, P, B) do { } while (0)
#else
#define PK4O(O, P, B) do { int t_; asm volatile("v_cvt_scalef32_pk_fp8_f32 %0, %1, %2, %3" : "=v"(t_) : "v"(P[B]), "v"(P[B + 1]), "v"(psc)); \
    asm volatile("v_cvt_scalef32_pk_fp8_f32 %0, %1, %2, %3 op_sel:[0,0,0,1]" : "+v"(t_) : "v"(P[B + 2]), "v"(P[B + 3]), "v"(psc)); O = t_; } while (0)
#endif
#define KRD(G, j, SN) do { if (G) { kf[j] = kfrag8(ks0 + (SN) * KSLOT, (j) >> 1, (j) & 1, r32, hi); SBAR(); } } while (0)
#define GAPS(MFX, P, W, PE, N0, N1) do { MFX; SBAR(); _Pragma("unroll") for (int r_ = N0; r_ < N1; ++r_) PE[r_] = EX(PE[r_]); PIN(PE); \
    PK4O(p8[W], P, 0); PK4O(p8[W + 1], P, 4); PK4O(p8[W + 2], P, 8); PK4O(p8[W + 3], P, 12); PIN(p8); SBAR(); } while (0)
#ifdef PROBE_X2ADD
#define GAPE(MFX, X, N0, N1) do { MFX; SBAR(); _Pragma("unroll") for (int r_ = N0; r_ < N1; ++r_) { X[r_] = EX(X[r_]); float d_; asm volatile("v_add_f32 %0, %1, %1\n\tv_add_f32 %0, %1, %1" : "=v"(d_) : "v"(X[r_ ^ 8])); } PIN(X); SBAR(); } while (0)
#elif defined(PROBE_X2EXP)
#define GAPE(MFX, X, N0, N1) do { MFX; SBAR(); _Pragma("unroll") for (int r_ = N0; r_ < N1; ++r_) { X[r_] = EX(X[r_]); float d_; asm volatile("v_exp_f32 %0, %1" : "=v"(d_) : "v"(X[r_ ^ 8])); } PIN(X); SBAR(); } while (0)
#else
#define GAPE(MFX, X, N0, N1) do { MFX; SBAR(); _Pragma("unroll") for (int r_ = N0; r_ < N1; ++r_) X[r_] = EX(X[r_]); PIN(X); SBAR(); } while (0)
#endif
#define EXPS(X, N0, N1) do { _Pragma("unroll") for (int r_ = N0; r_ < N1; ++r_) X[r_] = EX(X[r_]); PIN(X); } while (0)
#define STEP(C0, C1, P0, P1, t, S, GK, GV, GL, H0, H1, H2) do { SBAR(); \
    H0; SBAR(); \
    C0 = MF8(kf[0], qr[0], f32x16{}); PIN(C0); SBAR(); vf[0] = vfrag8(vs0 + (((S) + 3) & 3) * VSLOT, 0, r32, hi); EXPS(P1, 8, 12);  PK4O(p8[0], P0, 0); PK4O(p8[1], P0, 4);  PIN(p8); SBAR(); \
    C0 = MF8(kf[1], qr[1], C0); PIN(C0);       SBAR(); vf[1] = vfrag8(vs0 + (((S) + 3) & 3) * VSLOT, 1, r32, hi); EXPS(P1, 12, 16); PK4O(p8[2], P0, 8); PK4O(p8[3], P0, 12); PIN(p8); SBAR(); \
    C1 = MF8(kf[2], qr[0], f32x16{}); PIN(C1); SBAR(); \
    H1; if (GK && !PROBE_NODMA_) { DMA_K((t) + 4, (S)); } if (GV && !PROBE_NODMA_) { DMA_V((t) + 2, ((S) + 2) & 3); } H2; SBAR(); \
    EXPS(C0, 0, 6);   PK4O(p8[4], P1, 0); PK4O(p8[5], P1, 4);  PIN(p8); SBAR(); \
    C1 = MF8(kf[3], qr[1], C1); PIN(C1);       SBAR(); EXPS(C0, 6, 12);  PK4O(p8[6], P1, 8); PK4O(p8[7], P1, 12); PIN(p8); SBAR(); \
    o[0] = MF8V(p8, vf[0], o[0]); PIN(o[0]); SBAR(); KRD(GL, 0, ((S) + 1) & 3); KRD(GL, 1, ((S) + 1) & 3); EXPS(C0, 12, 16); SBAR(); \
    o[1] = MF8V(p8, vf[1], o[1]); PIN(o[1]); SBAR(); KRD(GL, 2, ((S) + 1) & 3); KRD(GL, 3, ((S) + 1) & 3); EXPS(C1, 0, 4); SBAR(); \
    lacc = MF16S(p8, ones8, lacc); PIN(lacc); SBAR(); EXPS(C1, 4, 8); SBAR(); \
    } while (0)
    f32x4 bgv = {0.f, 0.f, 0.f, 0.f}, bgr = {0.f, 0.f, 0.f, 0.f}; float bgs = 0.f;
#ifdef BG_CONV
#ifndef BGP_NLD
#define BGP_NLD 1
#endif
#ifndef BGP_NST
#define BGP_NST 1
#endif
#ifndef BGP_LDS
#define BGP_LDS 1
#endif
#define BG_STR_(x) #x
#define BG_STR(x) BG_STR_(x)
#define WAIT_BARX(N) asm volatile("s_waitcnt vmcnt(" BG_STR(N) ") lgkmcnt(0)\n\ts_barrier" ::: "memory")
#if BGP_NLD
#define BG_LOAD  bgv = bg.load(bg.q)
#else
#define BG_LOAD
#endif
#if BGP_LDS
#define BG_SC    bgs = bg.scale(bg.q)
#define BG_RD    bgr = bg.out_read(bg.q)
#else
#define BG_SC
#define BG_RD
#endif
#if BGP_NST
#define BG_OUT   bg.out_store(bg.q, bgr)
#define BG_WCNT 5
#else
#define BG_OUT   do { unsigned w_ = pack4_fp8(bgr.x, bgr.y, bgr.z, bgr.w); asm volatile("" :: "v"(w_)); } while (0)
#define BG_WCNT 4
#endif
#if BGP_LDS
#define BG_WRITE do { asm volatile("" : "+v"(bgv)); bg.write(bg.q, bgv, bgs); } while (0)
#else
#define BG_WRITE do { asm volatile("" : "+v"(bgv)); } while (0)
#endif
#define BG_NEXT  bg.q += 1
#if BGP_NLD && BGP_NST
#define WB1 WAIT_BAR(5)
#define WB2 WAIT_BAR(6)
#define WB3 WAIT_BAR(5)
#elif BGP_NLD
#define WB1 WAIT_BAR(5)
#define WB2 WAIT_BAR(5)
#define WB3 WAIT_BAR(4)
#elif BGP_NST
#define WB1 WAIT_BAR(4)
#define WB2 WAIT_BAR(5)
#define WB3 WAIT_BAR(5)
#else
#define WB1 WAIT_BAR(4)
#define WB2 WAIT_BAR(4)
#define WB3 WAIT_BAR(4)
#endif
#else
#define BG_LOAD
#define BG_SC
#define BG_RD
#define BG_OUT
#define BG_WRITE
#define BG_NEXT
#define WB1 WAIT_BAR(4)
#define WB2 WAIT_BAR(4)
#define WB3 WAIT_BAR(4)
#endif
#define NOH do { } while (0)
#ifdef MLA_PRIO
    if (wid >= 4) __builtin_amdgcn_s_setprio(1);
#endif
    int t = 1;
    for (; t < NT - 7; t += 4) {
        STEP(pB0, pB1, pA0, pA1, t, 1, true, true, true, BG_LOAD; BG_SC, NOH, NOH);     WB1;
        STEP(pA0, pA1, pB0, pB1, t + 1, 2, true, true, true, BG_RD, NOH, BG_OUT);       WB2;
        STEP(pB0, pB1, pA0, pA1, t + 2, 3, true, true, true, NOH, NOH, NOH);            WB3;
        STEP(pA0, pA1, pB0, pB1, t + 3, 0, true, true, true, BG_WRITE, NOH, NOH);       WAIT_BAR(4); BG_NEXT;
    }
    static_assert(((NT - 7) & 3) == 1, "tail starts in slot 1");
    STEP(pB0, pB1, pA0, pA1, NT - 7, 1, true, true, true, NOH, NOH, NOH);    WAIT_BAR(4);
    STEP(pA0, pA1, pB0, pB1, NT - 6, 2, true, true, true, NOH, NOH, NOH);    WAIT_BAR(4);
    STEP(pB0, pB1, pA0, pA1, NT - 5, 3, true, true, true, NOH, NOH, NOH);    WAIT_BAR(4);
    STEP(pA0, pA1, pB0, pB1, NT - 4, 0, false, true, true, NOH, NOH, NOH);   WAIT_BAR(3);
    STEP(pB0, pB1, pA0, pA1, NT - 3, 1, false, true, true, NOH, NOH, NOH);   WAIT_BAR(2);
    STEP(pA0, pA1, pB0, pB1, NT - 2, 2, false, false, true, NOH, NOH, NOH);  WAIT_BAR(0);
    STEP(pB0, pB1, pA0, pA1, NT - 1, 3, false, false, false, NOH, NOH, NOH);
#ifdef MLA_PRIO
    __builtin_amdgcn_s_setprio(0);
#endif
    {
#pragma unroll
      for (int r = 8; r < 16; ++r) pB1[r] = __builtin_amdgcn_exp2f(pB1[r]);
      PK4O(p8[0], pB0, 0); PK4O(p8[1], pB0, 4); PK4O(p8[2], pB0, 8); PK4O(p8[3], pB0, 12); PK4O(p8[4], pB1, 0); PK4O(p8[5], pB1, 4); PK4O(p8[6], pB1, 8); PK4O(p8[7], pB1, 12);
      SBAR();
      o[0] = MF8V(p8, vfrag8(vs0 + 3 * VSLOT, 0, r32, hi), o[0]); o[1] = MF8V(p8, vfrag8(vs0 + 3 * VSLOT, 1, r32, hi), o[1]); lacc = MF16S(p8, ones8, lacc); }
    float rli[16]; bool bad = false;
    { LAS float* wl2 = (LAS float*)(shm + LDS_WL) + wid * 32;
      if ((lane & 15) < 2) {
#pragma unroll
          for (int i = 0; i < 4; ++i) wl2[4 * (lane >> 4) + i + 16 * (lane & 15)] = lacc[i]; }
      asm volatile("s_waitcnt lgkmcnt(0)" ::: "memory");
#pragma unroll
      for (int r = 0; r < 16; ++r) { const float l = wl2[crow(r, hi)]; rli[r] = __builtin_amdgcn_rcpf(l); bad = bad || !(l >= PSCALE_LMIN); }
    }
    bf16_t* Ow = O + (rowbase + q0 + wid * QBLK) * 512 + h * 64;
    { LAS bf16_t* stg = (LAS bf16_t*)(shm + LDS_OST) + wid * 2048;
#pragma unroll
      for (int r = 0; r < 16; ++r) { const int orow = crow(r, hi);
#pragma unroll
          for (int d0 = 0; d0 < 2; ++d0) stg[orow * 64 + d0 * 32 + r32] = (bf16_t)f2bf(o[d0][r] * rli[r]); }
      asm volatile("s_waitcnt lgkmcnt(0)" ::: "memory");
#pragma unroll
      for (int i = 0; i < 4; ++i) { const int row = i * 8 + (lane >> 3), ch = lane & 7; const u32x4 v = *(const LAS u32x4*)(stg + row * 64 + ch * 8); *(u32x4*)(Ow + (long)row * 512 + ch * 8) = v; } }
    asm volatile("s_waitcnt lgkmcnt(0)\n\ts_barrier" ::: "memory");
#undef DMA_K
#undef DMA_V
#ifndef MLA_FLAT_DMA
#undef DMA_B
#endif
#undef PIN
#undef PK4O
#undef GAPS
#undef GAPE
#undef EX
#undef KRD
#undef STEP
#undef EXPS
#undef BG_LOAD
#undef BG_SC
#undef BG_RD
#undef BG_OUT
#undef BG_WRITE
#undef BG_NEXT
#undef WB1
#undef WB2
#undef WB3
#undef NOH
    return __any(bad) != 0;
}
#undef SBAR
#undef WAIT_BAR
#undef MF8
#undef MF8V
#undef MF16S
}

template <bool F8, class CM> __device__ __forceinline__ void tr_item(const float* W, int ld, const float* rs, bf16_t* WT, int K, int k0, int n0, const CM& cm, LAS float* scr, int lane) {
    const int n = lane & 31, sc = cm.col(n0 + n); const float cs = cm.scale(n0 + n);
#pragma unroll 8
    for (int i = 0; i < 32; ++i) { const int kk = 2 * i + (lane >> 5); float v = 0.f; if (sc >= 0) v = W[(size_t)(k0 + kk) * ld + sc] * cs * (rs ? rs[k0 + kk] : 1.f); scr[kk * 33 + n] = v; }
    asm volatile("s_waitcnt lgkmcnt(0)" ::: "memory");
    const int c = lane & 7;
#pragma unroll
    for (int j = 0; j < 4; ++j) { const int nn = (lane >> 3) + 8 * j; const LAS float* s = scr + (8 * c) * 33 + nn;
        if constexpr (F8) { *(u32x2*)((unsigned char*)WT + (size_t)(n0 + nn) * K + k0 + 8 * c) = (u32x2){pack4_fp8(s[0 * 33], s[1 * 33], s[2 * 33], s[3 * 33]), pack4_fp8(s[4 * 33], s[5 * 33], s[6 * 33], s[7 * 33])}; }
        else { u32x4 o; o.x = pk2(s[0 * 33], s[1 * 33]); o.y = pk2(s[2 * 33], s[3 * 33]); o.z = pk2(s[4 * 33], s[5 * 33]); o.w = pk2(s[6 * 33], s[7 * 33]);
        *(u32x4*)(WT + (size_t)(n0 + nn) * K + k0 + 8 * c) = o; } }
    asm volatile("s_waitcnt lgkmcnt(0)" ::: "memory");
}
#ifdef XW_NT
#define XW_LD(p) __builtin_nontemporal_load(p)
#else
#define XW_LD(p) (*(p))
#endif
template <class CM> __device__ __forceinline__ void tr4_load(f32x4 (&v)[8], const float* W, int ld, int k0, int n0, const CM& cm, int lane) {
    const int n4 = (lane & 7) * 4, sc = cm.col(n0 + n4);
#pragma unroll
    for (int i = 0; i < 8; ++i) { const int kk = (lane >> 3) + 8 * i; v[i] = (sc >= 0) ? XW_LD((const f32x4*)(W + (size_t)(k0 + kk) * ld + sc)) : (f32x4){0.f, 0.f, 0.f, 0.f}; }
}
template <bool F8, class CM, class RSP = const float*> __device__ __forceinline__ void tr4_finish(const f32x4 (&v)[8], RSP rs, bf16_t* WT, int K, int k0, int n0, const CM& cm, LAS float* scr, int lane) {
    const int n4 = (lane & 7) * 4; const float cs = cm.scale(n0 + n4);
#pragma unroll
    for (int i = 0; i < 8; ++i) { const int kk = (lane >> 3) + 8 * i; const float r = cs * (rs ? rs[k0 + kk] : 1.f); LAS float* d = scr + kk * 33 + n4; d[0] = v[i].x * r; d[1] = v[i].y * r; d[2] = v[i].z * r; d[3] = v[i].w * r; }
    asm volatile("s_waitcnt lgkmcnt(0)" ::: "memory");
    const int c = lane & 7;
#pragma unroll
    for (int j = 0; j < 4; ++j) { const int nn = (lane >> 3) + 8 * j; const LAS float* s = scr + (8 * c) * 33 + nn;
        if constexpr (F8) { *(u32x2*)((unsigned char*)WT + (size_t)(n0 + nn) * K + k0 + 8 * c) = (u32x2){pack4_fp8(s[0 * 33], s[1 * 33], s[2 * 33], s[3 * 33]), pack4_fp8(s[4 * 33], s[5 * 33], s[6 * 33], s[7 * 33])}; }
        else { u32x4 o; o.x = pk2(s[0 * 33], s[1 * 33]); o.y = pk2(s[2 * 33], s[3 * 33]); o.z = pk2(s[4 * 33], s[5 * 33]); o.w = pk2(s[6 * 33], s[7 * 33]);
        *(u32x4*)(WT + (size_t)(n0 + nn) * K + k0 + 8 * c) = o; } }
    asm volatile("s_waitcnt lgkmcnt(0)" ::: "memory");
}
template <bool F8, class CM> __device__ __forceinline__ void tr_item4(const float* W, int ld, const float* rs, bf16_t* WT, int K, int k0, int n0, const CM& cm, LAS float* scr, int lane) {
    f32x4 v[8]; tr4_load(v, W, ld, k0, n0, cm, lane); tr4_finish<F8>(v, rs, WT, K, k0, n0, cm, scr, lane);
}
struct CmIn {
    __device__ __forceinline__ int col(int n) const {
        if (n < 1920) return n;
        if (n < 1952) { const int j = n - 1920, i = j >> 1; return 1920 + ((j & 1) ? i + 16 : i); }
        if (n < 2048) return -1;
        { const int j = (n - 2048) >> 8, w = n & 255; return w < 128 ? 1952 + 128 * j + w : 2976 + 128 * j + (w - 128); }
    }
    __device__ __forceinline__ float scale(int n) const { return n < 512 ? 0.125f * LOG2E : 1.f; }
    __device__ __forceinline__ bool regular(int n0) const { return n0 < 1920 || n0 >= 1952; }
};
#ifdef INPROJ_FP8
struct CmIn8 : CmIn { __device__ __forceinline__ float scale(int n) const { return 64.f * CmIn::scale(n); } };
#endif
struct CmUq {
    __device__ __forceinline__ int col(int n) const { const int h = n / 96, w = n % 96; if (w < 64) return n; const int j = w - 64, i = j >> 1; return h * 96 + 64 + ((j & 1) ? i + 16 : i); }
    __device__ __forceinline__ float scale(int) const { return 0.10206207261596577f * LOG2E; }
    __device__ __forceinline__ bool regular(int n0) const { return (n0 % 96) < 64; }
};
struct CmId64 { __device__ __forceinline__ int col(int n) const { return n; } __device__ __forceinline__ float scale(int) const { return 64.f / (-1.702f * LOG2E); } __device__ __forceinline__ bool regular(int) const { return true; } };
struct CmId { int off; __device__ __forceinline__ int col(int n) const { return n - off; } __device__ __forceinline__ float scale(int) const { return 1.f; } __device__ __forceinline__ bool regular(int) const { return true; } };
struct CmId8 { __device__ __forceinline__ int col(int n) const { return n; } __device__ __forceinline__ float scale(int) const { return 64.f; } __device__ __forceinline__ bool regular(int) const { return true; } };
struct CmGu {
    __device__ __forceinline__ int col(int n) const { const int pn = n >> 8, w = n & 255; return w < 128 ? 128 * pn + w : 1024 + 128 * pn + (w - 128); }
    __device__ __forceinline__ float scale(int) const { return 64.f; }
    __device__ __forceinline__ bool regular(int) const { return true; }
};
template <class CM, bool F8 = false> __device__ __forceinline__ void tr_any(const float* W, int ld, const float* rs, bf16_t* WT, int K, int k0, int n0, const CM& cm, LAS float* scr, int lane) {
    if (cm.regular(n0)) tr_item4<F8>(W, ld, rs, WT, K, k0, n0, cm, scr, lane); else tr_item<F8>(W, ld, rs, WT, K, k0, n0, cm, scr, lane);
}

struct Args { const float* in[19]; float* out; unsigned char* ws; int ph_lo, ph_hi, li, pad; };

#ifdef XW_ITEM64
template <class CM> __device__ __forceinline__ void tr8_load(f32x4 (&v)[16], const float* W, int ld, int k0, int n0, const CM& cm, int lane) {
    const int n4 = (lane & 15) * 4, sc = cm.col(n0 + n4);
#pragma unroll
    for (int i = 0; i < 16; ++i) { const int kk = (lane >> 4) + 4 * i; v[i] = *(const f32x4*)(W + (size_t)(k0 + kk) * ld + sc); }
}
template <class CM, class RSP> __device__ __forceinline__ void tr8_write(const f32x4 (&v)[16], RSP rs, int k0, int n0, const CM& cm, LAS float* scr, int lane) {
    const int n4 = (lane & 15) * 4; const float cs = cm.scale(n0 + n4);
#pragma unroll
    for (int i = 0; i < 16; ++i) { const int kk = (lane >> 4) + 4 * i; const float r = cs * (rs ? rs[k0 + kk] : 1.f); LAS float* d = scr + kk * 65 + n4; d[0] = v[i].x * r; d[1] = v[i].y * r; d[2] = v[i].z * r; d[3] = v[i].w * r; }
    asm volatile("s_waitcnt lgkmcnt(0)" ::: "memory");
}
__device__ __forceinline__ void tr8_store(unsigned char* WT, int K, int k0, int n0, LAS float* scr, int lane) {
    const int c = lane & 7;
#pragma unroll
    for (int j = 0; j < 8; ++j) { const int nn = (lane >> 3) + 8 * j; const LAS float* s = scr + (8 * c) * 65 + nn;
        *(u32x2*)(WT + (size_t)(n0 + nn) * K + k0 + 8 * c) = (u32x2){pack4_fp8(s[0 * 65], s[1 * 65], s[2 * 65], s[3 * 65]), pack4_fp8(s[4 * 65], s[5 * 65], s[6 * 65], s[7 * 65])};
        if (j & 1) asm volatile("" ::: "memory"); }
    asm volatile("s_waitcnt lgkmcnt(0)" ::: "memory");
}
constexpr int XW_IGU = 32 * 16 * 32, XW_NI = XW_IGU + 32 * 16 * 16;
__device__ __forceinline__ void xw_load(f32x4 (&v)[16], const Args& a, int r, int lane) {
    if (r < XW_IGU) tr8_load(v, a.in[14] + (size_t)(r / 512) * 1024 * 2048, 2048, 64 * ((r % 512) / 32), 64 * (r % 32), CmGu{}, lane);
    else { const int q = r - XW_IGU; tr8_load(v, a.in[16] + (size_t)(q / 256) * 1024 * 1024, 1024, 64 * ((q % 256) / 16), 64 * (q % 16), CmId64{}, lane); }
}
__device__ __forceinline__ void xw_write(const f32x4 (&v)[16], const Args& a, int r, LAS float* scr, const LAS float* g2l, int lane) {
    if (r < XW_IGU) tr8_write(v, g2l, 64 * ((r % 512) / 32), 64 * (r % 32), CmGu{}, scr, lane);
    else { const int q = r - XW_IGU; tr8_write(v, (const LAS float*)nullptr, 64 * ((q % 256) / 16), 64 * (q % 16), CmId64{}, scr, lane); }
}
__device__ __forceinline__ void xw_store(const Args& a, int r, LAS float* scr, int lane) {
    unsigned char* ws = a.ws;
    if (r < XW_IGU) tr8_store(ws + WS_WGU + (size_t)(r / 512) * 2048 * 1024, 1024, 64 * ((r % 512) / 32), 64 * (r % 32), scr, lane);
    else { const int q = r - XW_IGU; tr8_store(ws + WS_WD + (size_t)(q / 256) * 1024 * 1024, 1024, 64 * ((q % 256) / 16), 64 * (q % 16), scr, lane); }
}
__device__ __forceinline__ void p0_experts(const Args& a, LAS unsigned char* lds, int wave, int lane, int gw, int NGW, int r0, int NI) {
    LAS float* scr = (LAS float*)(lds + wave * 16640); LAS float* g2l = (LAS float*)(lds + 8 * 16640);
    { int tx = threadIdx.x; asm volatile("" : "+v"(tx)); for (int i = tx; i < 1024; i += NTHREADS) g2l[i] = a.in[11][i]; }
    __syncthreads();
    f32x4 va[16];
    int r = r0 + gw;
    if (r < NI) xw_load(va, a, r, lane);
    for (; r < NI; r += NGW) {
        xw_write(va, a, r, scr, g2l, lane);
        if (r + NGW < NI) xw_load(va, a, r + NGW, lane);
        xw_store(a, r, scr, lane);
    }
}
#else
__device__ __forceinline__ int xw_map(int v, int NGW) {
    constexpr int I_GU = 32 * 16 * 64, NI = I_GU + 32 * 16 * 32;
#ifdef XW_PAIR_K
    if (NI % (2 * NGW) != 0 || I_GU % (2 * NGW) != 0) return v;
    const int q = v / NGW, g = v - q * NGW, pi = g + NGW * (q >> 1), lsb = q & 1;
    if (pi < I_GU / 2) { const int e = pi / 512, t = pi % 512; return e * 1024 + (2 * (t / 64) + lsb) * 64 + (t % 64); }
    const int p2 = pi - I_GU / 2, e = p2 / 256, t = p2 % 256; return I_GU + e * 512 + (2 * (t / 32) + lsb) * 32 + (t % 32);
#else
    return v;
#endif
}
__device__ __forceinline__ void xw_load(f32x4 (&v)[8], const Args& a, int r, int lane) {
    constexpr int I_GU = 32 * 16 * 64;
    if (r < I_GU) tr4_load(v, a.in[14] + (size_t)(r / 1024) * 1024 * 2048, 2048, 64 * ((r % 1024) / 64), 32 * (r % 64), CmGu{}, lane);
    else { const int q = r - I_GU; tr4_load(v, a.in[16] + (size_t)(q / 512) * 1024 * 1024, 1024, 64 * ((q % 512) / 32), 32 * (q % 32), CmId64{}, lane); }
}
__device__ __forceinline__ void xw_fin(const f32x4 (&v)[8], const Args& a, int r, LAS float* scr, const LAS float* g2l, int lane) {
    constexpr int I_GU = 32 * 16 * 64; unsigned char* ws = a.ws;
    if (r < I_GU) tr4_finish<true>(v, g2l, (bf16_t*)(ws + WS_WGU + (size_t)(r / 1024) * 2048 * 1024), 1024, 64 * ((r % 1024) / 64), 32 * (r % 64), CmGu{}, scr, lane);
    else { const int q = r - I_GU; tr4_finish<true>(v, (const LAS float*)nullptr, (bf16_t*)(ws + WS_WD + (size_t)(q / 512) * 1024 * 1024), 1024, 64 * ((q % 512) / 32), 32 * (q % 32), CmId64{}, scr, lane); }
}
__device__ __forceinline__ void p0_experts(const Args& a, LAS unsigned char* lds, int wave, int lane, int gw, int NGW, int r0, int NI) {
    LAS float* scr = (LAS float*)(lds + wave * 16384); LAS float* g2l = (LAS float*)(lds + 131072);
    { int tx = threadIdx.x; asm volatile("" : "+v"(tx)); for (int i = tx; i < 1024; i += NTHREADS) g2l[i] = a.in[11][i]; }
    __syncthreads();
    f32x4 va[8], vb[8], vc[8], vd[8];
    int r = r0 + gw;
    if (r < NI) xw_load(va, a, xw_map(r, NGW), lane);
    if (r + NGW < NI) xw_load(vb, a, xw_map(r + NGW, NGW), lane);
    if (r + 2 * NGW < NI) xw_load(vc, a, xw_map(r + 2 * NGW, NGW), lane);
    for (; r < NI; r += 4 * NGW) {
        if (r + 3 * NGW < NI) xw_load(vd, a, xw_map(r + 3 * NGW, NGW), lane);
        xw_fin(va, a, xw_map(r, NGW), scr, g2l, lane);
        if (r + NGW < NI) { if (r + 4 * NGW < NI) xw_load(va, a, xw_map(r + 4 * NGW, NGW), lane); xw_fin(vb, a, xw_map(r + NGW, NGW), scr, g2l, lane); }
        if (r + 2 * NGW < NI) { if (r + 5 * NGW < NI) xw_load(vb, a, xw_map(r + 5 * NGW, NGW), lane); xw_fin(vc, a, xw_map(r + 2 * NGW, NGW), scr, g2l, lane); }
        if (r + 3 * NGW < NI) { if (r + 6 * NGW < NI) xw_load(vc, a, xw_map(r + 6 * NGW, NGW), lane); xw_fin(vd, a, xw_map(r + 3 * NGW, NGW), scr, g2l, lane); }
    }
}

#endif
__device__ __forceinline__ void p0_prologue(const Args& a, LAS unsigned char* lds, int wave, int lane, int xw_end) {
    LAS float* scr = (LAS float*)(lds + wave * 16384);
    const int gw = blockIdx.x * NWAVES + wave, NGW = gridDim.x * NWAVES;
    unsigned char* ws = a.ws;
    constexpr int I_IN = 16 * 128, I_UQ = 4 * 24, I_UK = 2 * 16, I_UV = 2 * 16, I_A = 8 * 32, I_B = 8 * 32, I_O = 16 * 32, I_GU = 32 * 16 * 64, I_D = 32 * 16 * 32;
    constexpr int NITEMS = I_IN + I_UQ + I_UK + I_UV + I_A + I_B + I_O;
    for (int it = gw; it < NITEMS; it += NGW) {
        int r = it;
#ifdef INPROJ_FP8
        if (r < I_IN) { tr_any<CmIn8, true>(a.in[2], 4000, a.in[1], (bf16_t*)(ws + WS_WIN), 1024, 64 * (r / 128), 32 * (r % 128), CmIn8{}, scr, lane); continue; } r -= I_IN;
#else
        if (r < I_IN) { tr_any(a.in[2], 4000, a.in[1], (bf16_t*)(ws + WS_WIN), 1024, 64 * (r / 128), 32 * (r % 128), CmIn{}, scr, lane); continue; } r -= I_IN;
#endif
        if (r < I_UQ) { tr_any(a.in[5], 768, a.in[3], (bf16_t*)(ws + WS_WUQ), 256, 64 * (r / 24), 32 * (r % 24), CmUq{}, scr, lane); continue; } r -= I_UQ;
        if (r < I_UK) { tr_any(a.in[6], 512, a.in[4], (bf16_t*)(ws + WS_WUKV), 128, 64 * (r / 16), 32 * (r % 16), CmId{0}, scr, lane); continue; } r -= I_UK;
        if (r < I_UV) { tr_any(a.in[7], 512, a.in[4], (bf16_t*)(ws + WS_WUKV), 128, 64 * (r / 16), 512 + 32 * (r % 16), CmId{512}, scr, lane); continue; } r -= I_UV;
        if (r < I_A) { tr_any(a.in[8], 1024, nullptr, (bf16_t*)(ws + WS_WA), 512, 64 * (r / 32), 32 * (r % 32), CmId{0}, scr, lane); continue; } r -= I_A;
        if (r < I_B) { tr_any(a.in[9], 1024, nullptr, (bf16_t*)(ws + WS_WB), 512, 64 * (r / 32), 32 * (r % 32), CmId{0}, scr, lane); continue; } r -= I_B;
#ifdef WO_FP8
        tr_any<CmId8, true>(a.in[10], 1024, nullptr, (bf16_t*)(ws + WS_WO), 1024, 64 * (r / 32), 32 * (r % 32), CmId8{}, scr, lane);
#else
        tr_any(a.in[10], 1024, nullptr, (bf16_t*)(ws + WS_WO), 1024, 64 * (r / 32), 32 * (r % 32), CmId{0}, scr, lane);
#endif
    }
#if (!defined(BG_CONV) || defined(BG_KEEP_P0))
    if (xw_end > 0) p0_experts(a, lds, wave, lane, gw, NGW, 0, xw_end);
#endif
    for (int m = gw; m < T; m += NGW) {
        const f32x4* xr = (const f32x4*)(a.in[0] + (size_t)m * DM) + lane;
        f32x4 v[4]; float s2 = 0.f;
#pragma unroll
        for (int j = 0; j < 4; ++j) { v[j] = xr[64 * j]; s2 += (v[j].x * v[j].x + v[j].y * v[j].y) + (v[j].z * v[j].z + v[j].w * v[j].w); }
        const float rstd = 1.f / sqrtf(wave_sum(s2) * (1.f / DM) + EPS);
        u32x2* o8 = (u32x2*)((bf16_t*)(ws + WS_XB) + (size_t)m * DM) + lane;
#pragma unroll
#ifdef INPROJ_FP8
        for (int j = 0; j < 4; ++j) ((unsigned*)(ws + WS_XB + (size_t)m * DM))[lane + 64 * j] = pack4_fp8(v[j].x * rstd, v[j].y * rstd, v[j].z * rstd, v[j].w * rstd);
#else
        for (int j = 0; j < 4; ++j) o8[64 * j] = (u32x2){pk2(v[j].x * rstd, v[j].y * rstd), pk2(v[j].z * rstd, v[j].w * rstd)};
#endif
    }
    const int gt = blockIdx.x * NTHREADS + threadIdx.x, NGT = gridDim.x * NTHREADS;
    for (int idx = gt; idx < SEQ * 16; idx += NGT) {
        ((f32x2*)(ws + WS_ROPE))[idx] = rope_cs(idx >> 4, idx & 15);
    }
    for (int idx = gt; idx < 1024 * 32; idx += NGT) ((float*)(ws + WS_WRP))[idx] = a.in[12][idx] * a.in[11][idx >> 5];
}

__device__ __forceinline__ void p2_stats(const Args& a, int wave, int lane) {
    const int gw = blockIdx.x * NWAVES + wave, NGW = gridDim.x * NWAVES; unsigned char* ws = a.ws;
    for (int m = gw; m < T; m += NGW) {
        const u32x2 q = ((const u32x2*)((const bf16_t*)(ws + WS_CQ) + (size_t)m * 256))[lane];
        const unsigned kv = ((const unsigned*)((const bf16_t*)(ws + WS_CKV) + (size_t)m * 128))[lane];
        const float a0 = bflo(q.x), a1 = bfhi(q.x), a2 = bflo(q.y), a3 = bfhi(q.y), b0 = bflo(kv), b1 = bfhi(kv);
        const float sq = wave_sum((a0 * a0 + a1 * a1) + (a2 * a2 + a3 * a3)), sk = wave_sum(b0 * b0 + b1 * b1);
        if (lane == 0) { ((float*)(ws + WS_RSTDQ))[m] = 1.f / sqrtf(sq * (1.f / 256.f) + EPS); ((float*)(ws + WS_RSTDKV))[m] = 1.f / sqrtf(sk * (1.f / 128.f) + EPS); }
#ifdef KEEP_BF16_IMAGES
        if (lane < 32) { const int b = m >> 14, sq2 = m & (SEQ - 1); const u32x4 kr = *(const u32x4*)((const bf16_t*)(ws + WS_KR) + (size_t)m * 32 + 8 * (lane & 3));
            *(u32x4*)((bf16_t*)(ws + WS_KIMG) + (size_t)((b * 8 + (lane >> 2)) * 256 + (sq2 >> 6)) * 6144 + (8 + (lane & 3)) * 512 + (sq2 & 63) * 8) = kr; }
#endif
        if (lane < 16) { const int b = m >> 14, sq2 = m & (SEQ - 1); const bf16_t* kp = (const bf16_t*)(ws + WS_KR) + (size_t)m * 32 + 16 * (lane & 1);
            float k0[8], k1[8]; unpack8(*(const u32x4*)kp, k0); unpack8(*(const u32x4*)(kp + 8), k1);
            *(u32x4*)(ws + WS_K8 + (size_t)((b * 8 + (lane >> 1)) * 256 + (sq2 >> 6)) * 6144 + (4 + (lane & 1)) * 1024 + (sq2 & 63) * 16) =
                (u32x4){pack4_fp8(k0[0], k0[1], k0[2], k0[3]), pack4_fp8(k0[4], k0[5], k0[6], k0[7]), pack4_fp8(k1[0], k1[1], k1[2], k1[3]), pack4_fp8(k1[4], k1[5], k1[6], k1[7])}; }
    }
}

__device__ __forceinline__ void p4_v8t(unsigned char* ws) {
    const bf16_t* VIM = (const bf16_t*)(ws + WS_VIMG); unsigned char* V8 = ws + WS_V8T;
    for (int g = blockIdx.x * NTHREADS + threadIdx.x; g < NB * 8 * 256 * 128; g += gridDim.x * NTHREADS) {
        const int dp = g & 15, ch = (g >> 4) & 3, dh = (g >> 6) & 1, tile = g >> 7, hi = ch >> 1;
        const bf16_t* src = VIM + (size_t)tile * 4096 + dh * 2048 + (ch & 1) * 1024 + 2 * dp;
        unsigned w[16];
#pragma unroll
        for (int i = 0; i < 16; ++i) w[i] = *(const unsigned*)(src + crow(i, hi) * 32);
        u32x4 lo, hi4;
        lo.x = pack4_fp8(bflo(w[0]), bflo(w[1]), bflo(w[2]), bflo(w[3]));     lo.y = pack4_fp8(bflo(w[4]), bflo(w[5]), bflo(w[6]), bflo(w[7]));
        lo.z = pack4_fp8(bflo(w[8]), bflo(w[9]), bflo(w[10]), bflo(w[11]));   lo.w = pack4_fp8(bflo(w[12]), bflo(w[13]), bflo(w[14]), bflo(w[15]));
        hi4.x = pack4_fp8(bfhi(w[0]), bfhi(w[1]), bfhi(w[2]), bfhi(w[3]));    hi4.y = pack4_fp8(bfhi(w[4]), bfhi(w[5]), bfhi(w[6]), bfhi(w[7]));
        hi4.z = pack4_fp8(bfhi(w[8]), bfhi(w[9]), bfhi(w[10]), bfhi(w[11]));  hi4.w = pack4_fp8(bfhi(w[12]), bfhi(w[13]), bfhi(w[14]), bfhi(w[15]));
        u32x4* dst = (u32x4*)(V8 + (size_t)tile * 4096 + dh * 2048 + ch * 512 + dp * 32);
        dst[0] = lo; dst[1] = hi4;
    }
}

__device__ __forceinline__ void p4_dilated(const Args& a, LAS unsigned char* lds, volatile LAS unsigned* MISC, int wave, int lane) {
    unsigned char* ws = a.ws;
    const int r32 = lane & 31, hi = lane >> 5;
#ifndef MLA_PV_BF16
    p4_v8t(ws);
#endif
    {
        LAS unsigned* nm = (LAS unsigned*)(MISC + MI_NRM);
        if (threadIdx.x < 32) nm[threadIdx.x] = 0u;
        __syncthreads();
        const bf16_t* QB = (const bf16_t*)(ws + WS_QB); const bf16_t* KIM = (const bf16_t*)(ws + WS_KIMG); const bf16_t* KR = (const bf16_t*)(ws + WS_KR);
        const int gw = blockIdx.x * NWAVES + wave, NGW = gridDim.x * NWAVES;
#ifndef NORMS_PASS
        for (int t = gw; t < 0; t += NGW) {
#else
        for (int t = gw; t < T; t += NGW) {
#endif
            const int b = t >> 14;
            const u32x2* qp = (const u32x2*)(QB + (size_t)t * 768 + 12 * lane);
            const u32x2 q0 = qp[0], q1 = qp[1], q2 = qp[2];
            float sq = (bflo(q0.x) * bflo(q0.x) + bfhi(q0.x) * bfhi(q0.x)) + (bflo(q0.y) * bflo(q0.y) + bfhi(q0.y) * bfhi(q0.y));
            sq += (bflo(q1.x) * bflo(q1.x) + bfhi(q1.x) * bfhi(q1.x)) + (bflo(q1.y) * bflo(q1.y) + bfhi(q1.y) * bfhi(q1.y));
            sq += (bflo(q2.x) * bflo(q2.x) + bfhi(q2.x) * bfhi(q2.x)) + (bflo(q2.y) * bflo(q2.y) + bfhi(q2.y) * bfhi(q2.y));
            float kk8[8]; unpack8(*(const u32x4*)(KIM + (size_t)((b * 8 + (lane >> 3)) * 256 + ((t & (SEQ - 1)) >> 6)) * 6144 + (lane & 7) * 512 + (t & 63) * 8), kk8);
            float sk = 0.f;
#pragma unroll
            for (int j = 0; j < 8; ++j) sk += kk8[j] * kk8[j];
            float kr8[8]; unpack8(*(const u32x4*)(KR + (size_t)t * 32 + 8 * (lane & 3)), kr8);
            float sr = 0.f;
#pragma unroll
            for (int j = 0; j < 8; ++j) sr += kr8[j] * kr8[j];
            sr += __shfl_xor(sr, 1); sr += __shfl_xor(sr, 2);
            sq += __shfl_xor(sq, 1); sq += __shfl_xor(sq, 2); sq += __shfl_xor(sq, 4);
            sk += __shfl_xor(sk, 1); sk += __shfl_xor(sk, 2); sk += __shfl_xor(sk, 4);
            sk += sr;
            if ((lane & 7) == 0) { const int hh = lane >> 3;
                __hip_atomic_fetch_max(&nm[b * 8 + hh], __float_as_uint(sq), __ATOMIC_RELAXED, __HIP_MEMORY_SCOPE_WORKGROUP);
                __hip_atomic_fetch_max(&nm[16 + b * 8 + hh], __float_as_uint(sk), __ATOMIC_RELAXED, __HIP_MEMORY_SCOPE_WORKGROUP); }
        }
        __syncthreads();
        { int tx = threadIdx.x; asm volatile("" : "+v"(tx));
          if (tx < 32) __hip_atomic_fetch_max((unsigned*)(ws + WS_CTL) + CW_NRM + tx, nm[tx], __ATOMIC_RELAXED, __HIP_MEMORY_SCOPE_AGENT); }
    }
    __syncthreads();
    const bf16_t* QA = (const bf16_t*)(ws + WS_QA); const bf16_t* KA = (const bf16_t*)(ws + WS_KA); const bf16_t* VA = (const bf16_t*)(ws + WS_VA);
    bf16_t* PO = (bf16_t*)(ws + WS_PARTO); float* PL = (float*)(ws + WS_PARTL);
    constexpr int DK = 0, DV = 98304, DWS = 147456;
    const unsigned lds0 = (unsigned)(uintptr_t)lds;
    LAS float* wsf = (LAS float*)(lds + DWS) + wave * 64;
    const int NU = NB * 8 * 192, G_ = gridDim.x;
#define DIL_DECODE(un, p, dil, res, blk, L, b, h) int p, dil, res, blk, L; const int b = ((un) / 192) >> 3, h = ((un) / 192) & 7; { const int w_ = (un) % 192; \
        if (w_ < 64) { p = 0; dil = 1; res = 0; blk = w_; L = SEQ; } else if (w_ < 128) { p = 1; dil = 4; res = (w_ - 64) >> 4; blk = (w_ - 64) & 15; L = SEQ / 4; } else { p = 2; dil = 16; res = (w_ - 128) >> 2; blk = (w_ - 128) & 3; L = SEQ / 16; } }
#ifdef PROBE_DIL_X2K
#define DIL_X2K(x) x
#else
#define DIL_X2K(x)
#endif
#define DIL_DMA_K(un, kb) do { DIL_DECODE(un, p_, dil_, res_, blk_, L_, b_, h_) (void)p_; const int u0_ = 256 * blk_ - 64; _Pragma("unroll") for (int j = 0; j < 6; ++j) { \
        int uk = u0_ + 64 * j + lane; uk = uk < 0 ? 0 : (uk >= L_ ? L_ - 1 : uk); \
        mla::glds16(KA + ((size_t)b_ * SEQ + (size_t)(res_ + dil_ * uk)) * 512 + h_ * 64 + wave * 8, (unsigned)__builtin_amdgcn_readfirstlane(lds0 + DK + (kb) * 49152 + j * 8192 + wave * 1024)); \
        DIL_X2K(mla::glds16(KA + ((size_t)b_ * SEQ + (size_t)(res_ + dil_ * uk)) * 512 + h_ * 64 + wave * 8, (unsigned)__builtin_amdgcn_readfirstlane(lds0 + DK + (kb) * 49152 + j * 8192 + wave * 1024))); } } while (0)
#define DIL_DMA_V(un) do { DIL_DECODE(un, p_, dil_, res_, blk_, L_, b_, h_) (void)p_; const int u0_ = 256 * blk_ - 64; _Pragma("unroll") for (int j = 0; j < 6; ++j) { \
        int uv = u0_ + 64 * j + 16 * (wave & 3) + (lane >> 2); uv = uv < 0 ? 0 : (uv >= L_ ? L_ - 1 : uv); \
        mla::glds16(VA + ((size_t)b_ * SEQ + (size_t)(res_ + dil_ * uv)) * 512 + h_ * 64 + (wave >> 2) * 32 + (lane & 3) * 8, (unsigned)__builtin_amdgcn_readfirstlane(lds0 + DV + j * 8192 + wave * 1024)); } } while (0)
#define DIL_LOAD_Q(un, q) do { DIL_DECODE(un, p_, dil_, res_, blk_, L_, b_, h_) (void)p_; (void)L_; const size_t tq_ = (size_t)b_ * SEQ + (size_t)(res_ + dil_ * (256 * blk_ + 32 * wave + r32)); \
        _Pragma("unroll") for (int d0 = 0; d0 < 4; ++d0) q[d0] = *(const bf16x8*)(QA + tq_ * 512 + h_ * 64 + 16 * d0 + 8 * hi); } while (0)
    float dr[16];
#pragma unroll
    for (int r = 0; r < 16; ++r) dr[r] = (float)(crow(r, hi) - r32);
    int un = blockIdx.x, it = 0;
    bf16x8 qn[4] = {};
    if (un < NU) { DIL_LOAD_Q(un, qn); DIL_DMA_K(un, 0); DIL_DMA_V(un); }
    for (; un < NU; un += G_, ++it) {
        DIL_DECODE(un, p, dil, res, blk, L, b, h)
        const size_t bo = (size_t)b * SEQ; const int kb = it & 1;
        const int ur = 256 * blk + 32 * wave;
        const float slope2d = __builtin_amdgcn_exp2f(-(float)(h + 1)) * LOG2E * (float)dil;
        float sdr[16];
#pragma unroll
        for (int r = 0; r < 16; ++r) sdr[r] = slope2d * dr[r];
        asm volatile("s_waitcnt vmcnt(6)\n\ts_barrier" ::: "memory");
#define DIL_KC(c) (-slope2d * (float)((c) < 2 ? 64 - 32 * (c) : 32 * (c) - 64))
#define DIL_SCORE(c, sc) f32x16 sc = {}; { const int cw = wave + (c), j = cw >> 1, n = cw & 1; \
            const LAS char* kp = (const LAS char*)lds + DK + kb * 49152 + j * 8192 + hi * 1024 + (32 * n + r32) * 16; \
            _Pragma("unroll") for (int d0 = 0; d0 < 4; ++d0) sc = __builtin_amdgcn_mfma_f32_32x32x16_bf16(*(const LAS bf16x8*)(kp + d0 * 2048), qn[d0], sc, 0, 0, 0); \
            const int vb = ur - 64 + 32 * (c); \
              \
              \
            if ((c) < 2) { _Pragma("unroll") for (int r = 0; r < 16; ++r) sc[r] += sdr[r]; } \
            else if ((c) == 2) { _Pragma("unroll") for (int r = 0; r < 16; ++r) sc[r] -= fabsf(sdr[r]); } \
            else { _Pragma("unroll") for (int r = 0; r < 16; ++r) sc[r] -= sdr[r]; } \
            if ((c) == 0) { _Pragma("unroll") for (int r = 0; r < 16; ++r) sc[r] = (dr[r] >= 0.f) ? sc[r] : -1e30f; }       \
            if ((c) == 4) { _Pragma("unroll") for (int r = 0; r < 16; ++r) sc[r] = (dr[r] <= 0.f) ? sc[r] : -1e30f; }       \
            if (vb < 0 || vb + 31 >= L) { _Pragma("unroll") for (int r = 0; r < 16; ++r) { const int v = vb + crow(r, hi); sc[r] = (v >= 0 && v < L) ? sc[r] : -1e30f; } } }
        float mx = -1e30f;
#ifdef DIL_TWO_SWEEPS
#pragma unroll
        for (int c = 0; c < 5; ++c) { DIL_SCORE(c, sc)
#pragma unroll
            for (int r = 0; r < 16; ++r) mx = fmaxf(mx, sc[r] + DIL_KC(c));
            asm volatile("" : "+v"(mx) :: "memory"); __builtin_amdgcn_sched_barrier(0); }
        mx = swapmax(mx);
#else
        f32x16 sc2;
        { DIL_SCORE(2, sc)
#pragma unroll
            for (int r = 0; r < 16; ++r) mx = fmaxf(mx, sc[r]);
            sc2 = sc;
            asm volatile("" : "+v"(mx), "+v"(sc2) :: "memory"); __builtin_amdgcn_sched_barrier(0); }
        mx = swapmax(mx) + 32.f;
#endif
        float ps = 0.f; u32x4 pw[5][2];
#pragma unroll
        for (int c = 0; c < 5; ++c) {
#ifdef DIL_TWO_SWEEPS
            DIL_SCORE(c, sc)
#else
            f32x16 sc; if (c == 2) sc = sc2; else { DIL_SCORE(c, scx) sc = scx; }
#endif
            const float mc = mx - DIL_KC(c);
#pragma unroll
            for (int r = 0; r < 16; ++r) { sc[r] = fexp2(sc[r] - mc); ps += sc[r]; }
            pw[c][0] = (u32x4){cvtpk(sc[0], sc[1]), cvtpk(sc[2], sc[3]), cvtpk(sc[4], sc[5]), cvtpk(sc[6], sc[7])};
            pw[c][1] = (u32x4){cvtpk(sc[8], sc[9]), cvtpk(sc[10], sc[11]), cvtpk(sc[12], sc[13]), cvtpk(sc[14], sc[15])};
            asm volatile("" : "+v"(ps), "+v"(pw[c][0]), "+v"(pw[c][1]) :: "memory"); __builtin_amdgcn_sched_barrier(0); }
#if !defined(DIL_TWO_SWEEPS) && !defined(DIL_NO_GUARD)
#ifdef DIL_FORCE_REDO
        if (true) {
#else
        if (__builtin_expect(__any(!(ps < 3.0e38f)), 0)) {
#endif
            mx = -1e30f;
#pragma unroll
            for (int c = 0; c < 5; ++c) { DIL_SCORE(c, sc)
#pragma unroll
                for (int r = 0; r < 16; ++r) mx = fmaxf(mx, sc[r] + DIL_KC(c));
                asm volatile("" : "+v"(mx) :: "memory"); __builtin_amdgcn_sched_barrier(0); }
            mx = swapmax(mx); ps = 0.f;
#pragma unroll
            for (int c = 0; c < 5; ++c) { DIL_SCORE(c, sc) const float mc = mx - DIL_KC(c);
#pragma unroll
                for (int r = 0; r < 16; ++r) { sc[r] = fexp2(sc[r] - mc); ps += sc[r]; }
                pw[c][0] = (u32x4){cvtpk(sc[0], sc[1]), cvtpk(sc[2], sc[3]), cvtpk(sc[4], sc[5]), cvtpk(sc[6], sc[7])};
                pw[c][1] = (u32x4){cvtpk(sc[8], sc[9]), cvtpk(sc[10], sc[11]), cvtpk(sc[12], sc[13]), cvtpk(sc[14], sc[15])};
                asm volatile("" : "+v"(ps), "+v"(pw[c][0]), "+v"(pw[c][1]) :: "memory"); __builtin_amdgcn_sched_barrier(0); }
        }
#endif
#undef DIL_SCORE
#undef DIL_KC
        if (un + G_ < NU) DIL_LOAD_Q(un + G_, qn);
        const float lt = swapsum(ps);
        if (hi == 0) { wsf[32 + r32] = lt; PL[(((size_t)p * NB + b) * 8 + h) * SEQ + (res + dil * (ur + r32))] = mx + __builtin_amdgcn_logf(lt); }
        asm volatile("s_waitcnt vmcnt(0) lgkmcnt(0)\n\ts_barrier" ::: "memory");
        if (un + G_ < NU) DIL_DMA_K(un + G_, kb ^ 1);
        f32x16 o0 = {}, o1 = {};
#pragma unroll
        for (int c = 0; c < 5; ++c) {
            const int cw = wave + c, j = cw >> 1, n = cw & 1;
            const LAS char* vp = (const LAS char*)lds + DV + j * 8192 + n * 2048 + ((lane >> 4) & 1) * 32 + (lane & 3) * 8 + (4 * hi + ((lane & 15) >> 2)) * 64;
#pragma unroll
            for (int ks = 0; ks < 2; ++ks) {
                const s16x4 l0 = vtr(vp + ks * 1024), h0 = vtr(vp + ks * 1024 + 512), l1 = vtr(vp + 4096 + ks * 1024), h1 = vtr(vp + 4096 + ks * 1024 + 512);
                const bf16x8 v0 = {l0[0], l0[1], l0[2], l0[3], h0[0], h0[1], h0[2], h0[3]}, v1 = {l1[0], l1[1], l1[2], l1[3], h1[0], h1[1], h1[2], h1[3]};
                const bf16x8 pa = __builtin_bit_cast(bf16x8, pw[c][ks]);
                o0 = __builtin_amdgcn_mfma_f32_32x32x16_bf16(pa, v0, o0, 0, 0, 0);
                o1 = __builtin_amdgcn_mfma_f32_32x32x16_bf16(pa, v1, o1, 0, 0, 0);
            }
        }
        { LAS bf16_t* stg = (LAS bf16_t*)(lds + DK + kb * 49152) + wave * 2048;
#pragma unroll
          for (int r = 0; r < 16; ++r) { const int q = crow(r, hi); const float il = frcp(wsf[32 + q]);
              const unsigned w01 = cvtpk(o0[r] * il, o1[r] * il);
              stg[q * 64 + r32] = (bf16_t)(w01 & 0xffffu); stg[q * 64 + 32 + r32] = (bf16_t)(w01 >> 16); }
#pragma unroll
          for (int i = 0; i < 4; ++i) { const int row = i * 8 + (lane >> 3), ch = lane & 7; const u32x4 v = *(const LAS u32x4*)(stg + row * 64 + ch * 8);
              *(u32x4*)(PO + ((size_t)p * T + bo + (size_t)(res + dil * (ur + row))) * 512 + h * 64 + ch * 8) = v; } }
        asm volatile("s_waitcnt lgkmcnt(0)\n\ts_barrier" ::: "memory");
        if (un + G_ < NU) DIL_DMA_V(un + G_);
    }
    asm volatile("s_waitcnt vmcnt(0)" ::: "memory");
    __syncthreads();
#undef DIL_LOAD_Q
#undef DIL_DECODE
#undef DIL_DMA_K
#undef DIL_DMA_V
}
__device__ __forceinline__ void p5_combine(const Args& a, int wave, int lane) {
    unsigned char* ws = a.ws; const bf16_t* PO = (const bf16_t*)(ws + WS_PARTO); const float* PL = (const float*)(ws + WS_PARTL); bf16_t* OA = (bf16_t*)(ws + WS_OA);
    const int gw = blockIdx.x * NWAVES + wave, NGW = gridDim.x * NWAVES;
    for (int it = gw; it < T; it += NGW) {
        const int t = it, b = t >> 14, s = t & (SEQ - 1), h = lane >> 3, ch = lane & 7;
        const float l0 = PL[(((size_t)0 * NB + b) * 8 + h) * SEQ + s], l1 = PL[(((size_t)1 * NB + b) * 8 + h) * SEQ + s], l2 = PL[(((size_t)2 * NB + b) * 8 + h) * SEQ + s];
        const float mx = fmaxf(fmaxf(l0, l1), l2); float w0 = fexp2(l0 - mx), w1 = fexp2(l1 - mx), w2 = fexp2(l2 - mx); const float iw = frcp(w0 + w1 + w2); w0 *= iw; w1 *= iw; w2 *= iw;
        float v0[8], v1[8], v2[8], o[8];
        unpack8(*(const u32x4*)(PO + ((size_t)0 * T + t) * 512 + h * 64 + ch * 8), v0);
        unpack8(*(const u32x4*)(PO + ((size_t)1 * T + t) * 512 + h * 64 + ch * 8), v1);
        unpack8(*(const u32x4*)(PO + ((size_t)2 * T + t) * 512 + h * 64 + ch * 8), v2);
#pragma unroll
        for (int j = 0; j < 8; ++j) o[j] = w0 * v0[j] + w1 * v1[j] + w2 * v2[j];
        *(u32x4*)(OA + (size_t)t * 512 + h * 64 + ch * 8) = pack8(o);
    }
}
__device__ __forceinline__ void p5_mla(const Args& a, LAS unsigned char* lds, int wave, int lane) {
    unsigned char* ws = a.ws;
    LAS char* vimg = (LAS char*)(lds + wave * 8192); LAS float* wsf = (LAS float*)(lds + wave * 8192 + 4096);
    const int r32 = lane & 31, hi = lane >> 5;
    const bf16_t* QB = (const bf16_t*)(ws + WS_QB); const bf16_t* KIM = (const bf16_t*)(ws + WS_KIMG); const bf16_t* VIM = (const bf16_t*)(ws + WS_VIMG);
    bf16_t* OB = (bf16_t*)(ws + WS_OB);
    const unsigned* nrm = (const unsigned*)(ws + WS_CTL) + CW_NRM;
    unsigned redo = 0u;
    bgc::Bg bg; bg.init(a.in[14], a.in[16], ws, lds, wave, lane);
#ifdef BG_CONV
    { int tx = threadIdx.x; asm volatile("" : "+v"(tx));
      for (int i = tx; i < 1024; i += NTHREADS) ((LAS float*)(lds + bgc::LDS_G2))[i] = a.in[11][i];
      if (tx < 64) ((LAS float*)(lds + bgc::LDS_G2))[bgc::G2_ONES + tx] = 1.f; }
    __syncthreads();
    for (int tk = 0; tk < 4; ++tk) bg.tick_sync(tk, false);
    bg.q = 4;
#endif
    { int it = 0;
    for (int un = blockIdx.x; un < NB * 8 * 64; un += gridDim.x, ++it) {
#ifdef MLA_XCD_MAP
        int qb = un & 63, h = (un >> 6) & 7, b = un >> 9;
        if (gridDim.x == 256) { const int k_ = un >> 8, bx_ = un & 255, pair = (bx_ & 7) + 8 * (k_ >> 1); qb = (bx_ >> 3) + 32 * (k_ & 1); h = pair & 7; b = pair >> 3; }
#else
        const int qb = un & 63, h = (un >> 6) & 7, b = un >> 9;
#endif
        bool fast = true;
#ifdef MLA_FORCE_GENERAL
        fast = false;
#endif
#ifdef MLA_BF16_FAST
        if (__builtin_amdgcn_readfirstlane((int)fast)) mla::mla_unit(b, h, qb, QB, KIM + (size_t)(b * 8 + h) * 256 * 6144, VIM + (size_t)(b * 8 + h) * 256 * 4096, OB, (LAS char*)lds);
#elif defined(MLA_PV_BF16)
        if (__builtin_amdgcn_readfirstlane((int)fast)) mla8::mla8_unit(b, h, qb, (const unsigned char*)(ws + WS_Q8), (const unsigned char*)(ws + WS_K8) + (size_t)(b * 8 + h) * 256 * 6144, VIM + (size_t)(b * 8 + h) * 256 * 4096, OB, (LAS char*)lds);
#else
        if (__builtin_amdgcn_readfirstlane((int)fast)) {
            const bool r = mla88::mla88_unit(b, h, qb, (const unsigned char*)(ws + WS_Q8), (const unsigned char*)(ws + WS_K8) + (size_t)(b * 8 + h) * 256 * 6144, (const unsigned char*)(ws + WS_V8T) + (size_t)(b * 8 + h) * 256 * 4096, OB, (LAS char*)lds, bg);
            redo |= (unsigned)__builtin_amdgcn_readfirstlane((int)r) << it;
        }
#endif
    } }
#ifdef BG_CONV
    if (!bg.fast()) bg.q = 0;
    while (bg.q < bg.q_end()) { bg.tick_sync(bg.q, bg.q >= 4); bg.q += 1; }
#endif
    int it2 = 0;
#ifdef TIME_PROBE
    redo = 0u;
#endif
    for (int un = blockIdx.x; un < NB * 8 * 64; un += gridDim.x, ++it2) {
#ifdef MLA_XCD_MAP
        int qb = un & 63, h = (un >> 6) & 7, b = un >> 9;
        if (gridDim.x == 256) { const int k_ = un >> 8, bx_ = un & 255, pair = (bx_ & 7) + 8 * (k_ >> 1); qb = (bx_ >> 3) + 32 * (k_ & 1); h = pair & 7; b = pair >> 3; }
#else
        const int qb = un & 63, h = (un >> 6) & 7, b = un >> 9;
#endif
        bool fast = !((redo >> it2) & 1u);
#ifdef MLA_FORCE_GENERAL
        fast = false;
#endif
        if (!__builtin_amdgcn_readfirstlane((int)fast)) {
            const size_t bo = (size_t)b * SEQ, tq0 = bo + (size_t)qb * 256 + wave * 32;
#ifdef KEEP_BF16_IMAGES
            MlaKL kl; kl.K = KIM + (size_t)(b * 8 + h) * 256 * 6144; kl.V = VIM + (size_t)(b * 8 + h) * 256 * 4096;
            bf16x8 qf[6];
#pragma unroll
            for (int d0 = 0; d0 < 6; ++d0) qf[d0] = *(const bf16x8*)(QB + (tq0 + r32) * 768 + h * 96 + 16 * d0 + 8 * hi);
#else
            MlaKL8 kl; kl.K = ws + WS_K8 + (size_t)(b * 8 + h) * 256 * 6144; kl.V = VIM + (size_t)(b * 8 + h) * 256 * 4096;
            bf16x8 qf[6];
#pragma unroll
            for (int d0 = 0; d0 < 6; ++d0) qf[d0] = fp8x8_to_bf16(*(const u32x2*)(ws + WS_Q8 + (tq0 + r32) * 768 + h * 96 + 16 * d0 + 8 * hi), 0.0625f);
#endif
            AttnState st; wave_attn<6>(st, qf, kl, SEQ / 32, vimg, wsf, lane);
            (void)attn_finish(st, vimg, wsf, lane);
#pragma unroll
            for (int i = 0; i < 4; ++i) { const int row = i * 8 + (lane >> 3), ch = lane & 7; const u32x4 v = *(const LAS u32x4*)(vimg + row * 128 + ch * 16);
                *(u32x4*)(OB + (tq0 + row) * 512 + h * 64 + ch * 8) = v; }
        }
    }
}

__device__ __forceinline__ void p8_router(const Args& a, LAS unsigned char* lds, volatile LAS unsigned* MISC, int wave, int lane) {
    unsigned char* ws = a.ws; const float* x1 = a.out; const float* wrp = (const float*)(ws + WS_WRP); const float* br = a.in[13];
    LAS float* lg = (LAS float*)(lds + wave * 8192);
    LAS unsigned* hist = (LAS unsigned*)(MISC + MI_HIST);
    if (threadIdx.x < 32) hist[threadIdx.x] = 0u;
    __syncthreads();
    const int G = gridDim.x, i32 = lane & 31, hi = lane >> 5;
    for (int tb = wave * G + blockIdx.x; tb < T / 32; tb += G * NWAVES) {
        const int t = tb * 32 + i32;
        const float* xr = x1 + (size_t)t * DM + 512 * hi; const float* wr_ = wrp + (size_t)(512 * hi) * 32 + i32;
        f32x16 acc = {}; float ssq = 0.f;
#define RT_LOAD(xv, s) do { _Pragma("unroll") for (int j = 0; j < 8; ++j) xv[j] = *(const f32x4*)(xr + 32 * (s) + 4 * j); } while (0)
#define RT_MMA(xv, s) do { _Pragma("unroll") for (int j = 0; j < 8; ++j) { const f32x4 xa = xv[j]; const int k4 = 32 * (s) + 4 * j; \
                ssq += (xa.x * xa.x + xa.y * xa.y) + (xa.z * xa.z + xa.w * xa.w); \
                acc = __builtin_amdgcn_mfma_f32_32x32x2f32(xa.x, wr_[(k4 + 0) * 32], acc, 0, 0, 0); \
                acc = __builtin_amdgcn_mfma_f32_32x32x2f32(xa.y, wr_[(k4 + 1) * 32], acc, 0, 0, 0); \
                acc = __builtin_amdgcn_mfma_f32_32x32x2f32(xa.z, wr_[(k4 + 2) * 32], acc, 0, 0, 0); \
                acc = __builtin_amdgcn_mfma_f32_32x32x2f32(xa.w, wr_[(k4 + 3) * 32], acc, 0, 0, 0); } } while (0)
        { f32x4 xb[8], xn[8];
          RT_LOAD(xb, 0);
#pragma unroll 1
          for (int s32 = 0; s32 < 16; s32 += 2) {
              RT_LOAD(xn, s32 + 1); RT_MMA(xb, s32);
              if (s32 + 2 < 16) RT_LOAD(xb, s32 + 2);
              RT_MMA(xn, s32 + 1);
          } }
#undef RT_LOAD
#undef RT_MMA
        ssq = swapsum(ssq);
        const float rstd = 1.f / sqrtf(ssq * (1.f / DM) + EPS);
#pragma unroll
        for (int r = 0; r < 16; ++r) lg[crow(r, hi) * 33 + i32] = acc[r];
        asm volatile("s_waitcnt lgkmcnt(0)" ::: "memory");
        float v[32];
#pragma unroll
        for (int e = 0; e < 32; ++e) v[e] = lg[i32 * 33 + e] * rstd + br[e];
        int ti[4]; float tv[4];
#pragma unroll
        for (int k = 0; k < 4; ++k) {
            float best = v[0]; int bi = 0;
#pragma unroll
            for (int e = 1; e < 32; ++e) { const bool g = v[e] > best; best = g ? v[e] : best; bi = g ? e : bi; }
            ti[k] = bi; tv[k] = best;
#pragma unroll
            for (int e = 0; e < 32; ++e) v[e] = (e == bi) ? -3.0e38f : v[e];
        }
        const float e1 = __expf(tv[1] - tv[0]), e2 = __expf(tv[2] - tv[0]), e3 = __expf(tv[3] - tv[0]); const float inv = 1.f / (1.f + e1 + e2 + e3);
        const float gw[4] = {inv, e1 * inv, e2 * inv, e3 * inv};
        if (hi == 0) {
            ((float*)(ws + WS_RSTD2))[t] = rstd;
#pragma unroll
            for (int k = 0; k < 4; ++k) { const unsigned rk = __hip_atomic_fetch_add(&hist[ti[k]], 1u, __ATOMIC_RELAXED, __HIP_MEMORY_SCOPE_WORKGROUP);
                ((int*)(ws + WS_TOPI))[t * 4 + k] = ti[k]; ((float*)(ws + WS_GATEW))[t * 4 + k] = gw[k]; ((int*)(ws + WS_SRANK))[t * 4 + k] = (int)rk; }
        }
        asm volatile("s_waitcnt lgkmcnt(0)" ::: "memory");
    }
    __syncthreads();
    { int tx = threadIdx.x; asm volatile("" : "+v"(tx));
      if (tx < 32) {
        const unsigned c = hist[tx];
        const unsigned base = __hip_atomic_fetch_add((unsigned*)(ws + WS_CTL) + CW_GCOUNT + tx, c, __ATOMIC_RELAXED, __HIP_MEMORY_SCOPE_AGENT);
        ((int*)(ws + WS_WGBASE))[blockIdx.x * 32 + tx] = (int)base;
      } }
}
__device__ __forceinline__ void moe_prefix(const Args& a, volatile LAS unsigned* MISC) {
    if (threadIdx.x < 64) {
        const unsigned* gc = (const unsigned*)(a.ws + WS_CTL) + CW_GCOUNT; const int e = threadIdx.x & 31;
        const int c = (int)__hip_atomic_load(gc + e, __ATOMIC_RELAXED, __HIP_MEMORY_SCOPE_AGENT), pad = (c + 255) & ~255;
        int inc = pad;
#pragma unroll
        for (int o = 1; o < 32; o <<= 1) { const int v = __shfl_up(inc, o, 32); if (e >= o) inc += v; }
        if (threadIdx.x < 32) { MISC[MI_PSTART + e] = (unsigned)(inc - pad); MISC[MI_TPRE + e] = (unsigned)((inc - pad) >> 8);
            if (e == 31) { MISC[MI_PSTART + 32] = (unsigned)inc; MISC[MI_TPRE + 32] = (unsigned)(inc >> 8); } }
    }
    __syncthreads();
}
__device__ __forceinline__ void p9_scatter(const Args& a, volatile LAS unsigned* MISC) {
    unsigned char* ws = a.ws; const int G = gridDim.x;
    moe_prefix(a, MISC);
    const int* topi = (const int*)(ws + WS_TOPI); const int* srank = (const int*)(ws + WS_SRANK); const int* wgbase = (const int*)(ws + WS_WGBASE); const float* rstd2 = (const float*)(ws + WS_RSTD2);
    int* pos = (int*)(ws + WS_POS); int* rowtok = (int*)(ws + WS_ROWTOK); float* rowscale = (float*)(ws + WS_ROWSCALE);
    for (int sl = blockIdx.x * NTHREADS + threadIdx.x; sl < NSLOT; sl += G * NTHREADS) {
        const int t = sl >> 2, e = topi[sl], wg = (t >> 5) % G;
        const int row = (int)MISC[MI_PSTART + e] + wgbase[wg * 32 + e] + srank[sl];
        pos[sl] = row; rowtok[row] = t; rowscale[row] = rstd2[t];
    }
    if (blockIdx.x < 32) {
        const int e = blockIdx.x; const int c = (int)__hip_atomic_load((const unsigned*)(ws + WS_CTL) + CW_GCOUNT + e, __ATOMIC_RELAXED, __HIP_MEMORY_SCOPE_AGENT);
        const int r0 = (int)MISC[MI_PSTART + e] + c, r1 = (int)MISC[MI_PSTART + e + 1];
        for (int r = r0 + threadIdx.x; r < r1; r += NTHREADS) { rowtok[r] = 0; rowscale[r] = 0.f; }
    }
}
__device__ __forceinline__ void p12_final(const Args& a, int wave, int lane) {
    unsigned char* ws = a.ws; const int gw = blockIdx.x * NWAVES + wave, NGW = gridDim.x * NWAVES;
    const int* pos = (const int*)(ws + WS_POS); const float* gatew = (const float*)(ws + WS_GATEW); const unsigned char* Y = ws + WS_Y;
    f32x4 g[4];
#pragma unroll
    for (int j = 0; j < 4; ++j) g[j] = ((const f32x4*)a.in[18])[lane + 64 * j];
    for (int t = gw; t < T; t += NGW) {
        f32x4* xr = (f32x4*)(a.out + (size_t)t * DM) + lane;
        f32x4 v[4];
#pragma unroll
        for (int j = 0; j < 4; ++j) v[j] = xr[64 * j];
#ifndef DBG_NO_MOE
#pragma unroll
        for (int k = 0; k < 4; ++k) {
            const int row = pos[t * 4 + k]; const float w = gatew[t * 4 + k] * (1.f / 16.f);
            const unsigned* yr = (const unsigned*)(Y + (size_t)row * DM) + lane;
#pragma unroll
            for (int j = 0; j < 4; ++j) { const int y = (int)yr[64 * j]; const f32x2 lo = __builtin_amdgcn_cvt_pk_f32_fp8(y, false), hi = __builtin_amdgcn_cvt_pk_f32_fp8(y, true);
                v[j].x += w * lo.x; v[j].y += w * lo.y; v[j].z += w * hi.x; v[j].w += w * hi.y; }
        }
#endif
        float s2 = 0.f;
#pragma unroll
        for (int j = 0; j < 4; ++j) s2 += (v[j].x * v[j].x + v[j].y * v[j].y) + (v[j].z * v[j].z + v[j].w * v[j].w);
        const float rstd = 1.f / sqrtf(wave_sum(s2) * (1.f / DM) + EPS);
#pragma unroll
        for (int j = 0; j < 4; ++j) xr[64 * j] = v[j] * rstd * g[j];
    }
}

#ifdef MLA_CHECK
constexpr size_t CK_BASE = 225 * MiB;
constexpr size_t CK_CKVN = CK_BASE, CK_KRR = CK_CKVN + (size_t)T * 128 * 4, CK_KN = CK_KRR + (size_t)T * 32 * 4, CK_VV = CK_KN + (size_t)T * 512 * 4, CK_QS = CK_VV + (size_t)T * 512 * 4;
constexpr int CK_NS = 16;
constexpr size_t CK_OBS = 224 * MiB;
__device__ __forceinline__ int ck_tok(int i) { const int tb[16] = {0, 1, 255, 256, 4097, 8191, 12345, 16383, 16384, 16385, 20000, 24575, 24576, 30001, 32766, 32767}; return tb[i]; }
__device__ __forceinline__ float blk_sum(float v, float* red) {
    v = wave_sum(v); __syncthreads(); if ((threadIdx.x & 63) == 0) red[threadIdx.x >> 6] = v; __syncthreads(); return red[0] + red[1] + red[2] + red[3];
}
__global__ void __launch_bounds__(256) ck_kv(const float* x, const float* g1, const float* w_in, const float* gkv, const float* w_uk, const float* w_uv, unsigned char* ws) {
    __shared__ float hn[1024]; __shared__ float red[4]; __shared__ float c[160]; __shared__ float cn[128];
    const int t = blockIdx.x, tid = threadIdx.x;
    float s2 = 0.f; for (int k = tid; k < 1024; k += 256) { const float v = x[(size_t)t * 1024 + k]; s2 += v * v; }
    const float rstd = 1.f / sqrtf(blk_sum(s2, red) / 1024.f + EPS);
    for (int k = tid; k < 1024; k += 256) hn[k] = x[(size_t)t * 1024 + k] * rstd * g1[k];
    __syncthreads();
    if (tid < 160) { float acc = 0.f; for (int k = 0; k < 1024; ++k) acc += hn[k] * w_in[(size_t)k * 4000 + 1792 + tid]; c[tid] = acc; }
    __syncthreads();
    const float q2 = blk_sum(tid < 128 ? c[tid] * c[tid] : 0.f, red); const float r2 = 1.f / sqrtf(q2 / 128.f + EPS);
    if (tid < 128) cn[tid] = c[tid] * r2 * gkv[tid];
    if (tid < 16) { const f32x2 cs = rope_cs(t & (SEQ - 1), tid); const float x1 = c[128 + tid], x2 = c[128 + 16 + tid];
        ((float*)(ws + CK_KRR))[(size_t)t * 32 + tid] = x1 * cs.x - x2 * cs.y; ((float*)(ws + CK_KRR))[(size_t)t * 32 + 16 + tid] = x2 * cs.x + x1 * cs.y; }
    __syncthreads();
    for (int o = tid; o < 512; o += 256) { float a = 0.f, b = 0.f; for (int k = 0; k < 128; ++k) { a += cn[k] * w_uk[(size_t)k * 512 + o]; b += cn[k] * w_uv[(size_t)k * 512 + o]; }
        ((float*)(ws + CK_KN))[(size_t)t * 512 + o] = a; ((float*)(ws + CK_VV))[(size_t)t * 512 + o] = b; }
}
__global__ void __launch_bounds__(256) ck_q(const float* x, const float* g1, const float* w_in, const float* gq, const float* w_uq, unsigned char* ws) {
    __shared__ float hn[1024]; __shared__ float red[4]; __shared__ float c[256]; __shared__ float qq[768];
    const int t = ck_tok(blockIdx.x), tid = threadIdx.x;
    float s2 = 0.f; for (int k = tid; k < 1024; k += 256) { const float v = x[(size_t)t * 1024 + k]; s2 += v * v; }
    const float rstd = 1.f / sqrtf(blk_sum(s2, red) / 1024.f + EPS);
    for (int k = tid; k < 1024; k += 256) hn[k] = x[(size_t)t * 1024 + k] * rstd * g1[k];
    __syncthreads();
    { float acc = 0.f; for (int k = 0; k < 1024; ++k) acc += hn[k] * w_in[(size_t)k * 4000 + 1536 + tid]; c[tid] = acc; }
    __syncthreads();
    const float q2 = blk_sum(c[tid] * c[tid], red); const float r2 = 1.f / sqrtf(q2 / 256.f + EPS);
    __syncthreads(); c[tid] = c[tid] * r2 * gq[tid]; __syncthreads();
    for (int o = tid; o < 768; o += 256) { float a = 0.f; for (int k = 0; k < 256; ++k) a += c[k] * w_uq[(size_t)k * 768 + o]; qq[o] = a; }
    __syncthreads();
    if (tid < 128) { const int hh = tid >> 4, i = tid & 15; const f32x2 cs = rope_cs(t & (SEQ - 1), i); const float x1 = qq[hh * 96 + 64 + i], x2 = qq[hh * 96 + 80 + i];
        qq[hh * 96 + 64 + i] = x1 * cs.x - x2 * cs.y; qq[hh * 96 + 80 + i] = x2 * cs.x + x1 * cs.y; }
    __syncthreads();
    for (int o = tid; o < 768; o += 256) ((float*)(ws + CK_QS))[(size_t)blockIdx.x * 768 + o] = qq[o] * 0.10206207261596577f;
}
__global__ void __launch_bounds__(256) ck_attn(unsigned char* ws, unsigned* flag) {
    __shared__ float q[96]; __shared__ float red[4]; __shared__ float part[256]; __shared__ float sc[SEQ];
    const int si = blockIdx.x >> 3, h = blockIdx.x & 7, t = ck_tok(si), b = t >> 14, tid = threadIdx.x;
    const float* KN = (const float*)(ws + CK_KN); const float* VV = (const float*)(ws + CK_VV); const float* KRR = (const float*)(ws + CK_KRR);
    if (tid < 96) q[tid] = ((const float*)(ws + CK_QS))[(size_t)si * 768 + h * 96 + tid];
    __syncthreads();
    float mx = -1e30f;
    for (int s = tid; s < SEQ; s += 256) { const size_t ts = (size_t)b * SEQ + s; float a = 0.f; for (int e = 0; e < 64; ++e) a += q[e] * KN[ts * 512 + h * 64 + e]; for (int e = 0; e < 32; ++e) a += q[64 + e] * KRR[ts * 32 + e]; sc[s] = a; mx = fmaxf(mx, a); }
    for (int o = 1; o < 64; o <<= 1) mx = fmaxf(mx, __shfl_xor(mx, o));
    __syncthreads(); if ((tid & 63) == 0) red[tid >> 6] = mx; __syncthreads(); mx = fmaxf(fmaxf(red[0], red[1]), fmaxf(red[2], red[3])); __syncthreads();
    float l = 0.f;
    for (int s = tid; s < SEQ; s += 256) { const float p = expf(sc[s] - mx); sc[s] = p; l += p; }
    l = blk_sum(l, red);
    const int e = tid & 63, g = tid >> 6; float o = 0.f;
    for (int s = g; s < SEQ; s += 4) o += sc[s] * VV[((size_t)b * SEQ + s) * 512 + h * 64 + e];
    part[tid] = o; __syncthreads();
    if (tid < 64) { const float ref = (part[tid] + part[64 + tid] + part[128 + tid] + part[192 + tid]) / l, got = bf2f(((const bf16_t*)(ws + CK_OBS))[(size_t)si * 512 + h * 64 + tid]);
        atomicMax(flag, __float_as_uint(fabsf(ref - got))); atomicMax(flag + 1, __float_as_uint(fabsf(ref))); }
}
__global__ void ck_apply(float* out, const unsigned* flag) {
    const float d = __uint_as_float(flag[0]), r = __uint_as_float(flag[1]);
    const bool bad = !(r > 0.f) || !(d <= MLA_CHECK_TOL * r);
    if (bad) for (size_t i = (size_t)blockIdx.x * blockDim.x + threadIdx.x; i < (size_t)T * DM; i += (size_t)gridDim.x * blockDim.x) out[i] = __builtin_nanf("");
}
#endif

constexpr int N_PHASES = 13;
#ifndef MOE_REV
#define MOE_REV false
#endif
#ifndef ALIGN_MOE
#define ALIGN_MOE true
#endif
#ifndef REP0
#define REP0 1
#endif
#ifndef REP1
#define REP1 1
#endif
#ifndef REP3
#define REP3 1
#endif
#ifndef REP5
#define REP5 1
#endif
#ifndef REP7
#define REP7 1
#endif
#ifndef REP10
#define REP10 1
#endif
#ifndef REP11
#define REP11 1
#endif
#ifndef MK_ONE_LAUNCH
#define MK_ONE_LAUNCH 0
#endif
__global__ void __launch_bounds__(NTHREADS, 2) fwd(Args args) {
    extern __shared__ __attribute__((aligned(16))) unsigned char lds_raw[];
    LAS unsigned char* lds = (LAS unsigned char*)lds_raw;
    volatile LAS unsigned* MISC = (volatile LAS unsigned*)(lds + MISC_OFF);
    const int tid = threadIdx.x, wave = __builtin_amdgcn_readfirstlane(tid >> 6);
#define lane lane_now()
    const int G = gridDim.x, bx = blockIdx.x;
    unsigned char* ws = args.ws;
    for (int u = tid; u < (LDS_BYTES - MISC_OFF) / 4; u += NTHREADS) ((LAS unsigned*)(lds + MISC_OFF))[u] = 0u;
    __syncthreads();
    XcdBarrier bar; bar.bar = (unsigned*)(ws + WS_CTL) + CW_BAR; bar.x = 0; bar.st = nullptr;
    if (MK_ONE_LAUNCH) bar = xcd_barrier_post((unsigned*)(ws + WS_CTL) + CW_BAR, MISC + MI_BAR);
    const int lo = args.ph_lo, hi = args.ph_hi;
#ifdef ONLY_PHASE
#define IN(k) ((k) == ONLY_PHASE && lo <= (k) && (k) < hi)
#else
#define IN(k) (lo <= (k) && (k) < hi)
#endif
#define SEAM(k) do { if (IN(k) && IN((k) + 1)) xcd_barrier(bar); } while (0)
#ifdef SKEW_TICKS
#define SKEW() do { const unsigned long long t0_ = __builtin_amdgcn_s_memrealtime(); const unsigned long long d_ = (unsigned long long)((bx >> 3) & 7) * SKEW_TICKS; while (__builtin_amdgcn_s_memrealtime() - t0_ < d_) __builtin_amdgcn_s_sleep(4); } while (0)
#else
#define SKEW() do { } while (0)
#endif

#ifndef NCONV
#define NCONV 0
#endif
#ifndef XW_P0_ITEMS
#define XW_P0_ITEMS 17408
#endif
#ifdef XW_ITEM64
    constexpr int XW_ALL = XW_NI;
#else
    constexpr int XW_ALL = 32 * 16 * 64 + 32 * 16 * 32;
#endif
    const int nconv = (G >= 4 * NCONV && ((G - NCONV) & 7) == 0) ? NCONV : 0, NGM = G - nconv, xw_p0 = nconv ? XW_P0_ITEMS : XW_ALL;
    if (IN(0)) { p0_prologue(args, lds, wave, lane, xw_p0);
#if defined(PROBE_RD_A) || defined(PROBE_RD_B)
        p0_probe_read(args, wave, lane);
#endif
#if REP0 > 1
        p0_prologue(args, lds, wave, lane, xw_p0);
#endif
    } SEAM(0);
#ifdef INPROJ_FP8
#define PH1_BODY { pg8::DenseSched S; S.init((const bf16_t*)(ws + WS_XB), (const bf16_t*)(ws + WS_WIN), T, NIN, 512, NGM, bx); EpiInProj E{ws, lds}; \
        pg8::gemm_phase2<EpiInProj, pg8::DenseSched, true, true, 121>(lds, 512, S, E); }
#else
#define PH1_BODY { pg8::DenseSched S; S.init((const bf16_t*)(ws + WS_XB), (const bf16_t*)(ws + WS_WIN), T, NIN, 1024, NGM, bx); EpiInProj E{ws, lds}; \
        pg8::gemm_phase2<EpiInProj, pg8::DenseSched, true>(lds, 1024, S, E); }
#endif
    if (IN(1)) { if (bx < NGM) PH1_BODY else p0_experts(args, lds, wave, lane, (bx - NGM) * NWAVES + wave, nconv * NWAVES, xw_p0, XW_ALL);
#if REP1 > 1
        PH1_BODY
#endif
    } SEAM(1);
#ifdef P2_PHASE
    if (IN(2)) { p2_stats(args, wave, lane); } SEAM(2);
#endif
#define PH3_BODY { { pg8::DenseSched S; S.init((const bf16_t*)(ws + WS_CQ), (const bf16_t*)(ws + WS_WUQ), T, 768, 256, G, bx); EpiQ E{ws}; \
          pg8::gemm_phase2<EpiQ, pg8::DenseSched, true>(lds, 256, S, E); } \
        { pg8::DenseSched S; S.init((const bf16_t*)(ws + WS_CKV), (const bf16_t*)(ws + WS_WUKV), T, 1024, 128, G, bx); EpiKV E{ws}; \
          pg8::gemm_phase2<EpiKV, pg8::DenseSched, true>(lds, 128, S, E); } }
    if (IN(3)) { PH3_BODY
#if REP3 > 1
        PH3_BODY
#endif
    } SEAM(3);
    if (IN(4)) { p4_dilated(args, lds, MISC, wave, lane);
#ifdef REP_DIL
        p4_dilated(args, lds, MISC, wave, lane);
#endif
    } SEAM(4);
#if defined(CLK_PROBE) || defined(TIME_PROBE)
    unsigned long long ck0_ = 0, rt0_ = 0, ck1_ = 0, rt1_ = 0;
#endif
    if (IN(5)) { p5_combine(args, wave, lane);
#if defined(CLK_PROBE) || defined(TIME_PROBE)
        ck0_ = __builtin_amdgcn_s_memtime(); rt0_ = __builtin_amdgcn_s_memrealtime();
#endif
        p5_mla(args, lds, wave, lane);
#if defined(CLK_PROBE) || defined(TIME_PROBE)
        ck1_ = __builtin_amdgcn_s_memtime(); rt1_ = __builtin_amdgcn_s_memrealtime();
#endif
#ifdef REP_MLA
        p5_mla(args, lds, wave, lane);
#endif
    } SEAM(5);
#ifdef MLA_CHECK
    if (IN(6) && bx == 0) { for (int i = tid; i < CK_NS * 512; i += NTHREADS) ((bf16_t*)(ws + CK_OBS))[i] = ((const bf16_t*)(ws + WS_OB))[(size_t)ck_tok(i >> 9) * 512 + (i & 511)]; }
#endif
    if (IN(6)) {
        { pg8::TwoSegSched S; S.init((const bf16_t*)(ws + WS_OA), (const bf16_t*)(ws + WS_WA), (const bf16_t*)(ws + WS_OB), (const bf16_t*)(ws + WS_WB), T, 1024, 512, G, bx); EpiGateFused E{ws};
          pg8::gemm_phase2<EpiGateFused, pg8::TwoSegSched, true>(lds, 512, S, E); }
    } SEAM(6);
#ifdef WO_FP8
#define PH7_BODY { pg8::DenseSched S; S.init((const bf16_t*)(ws + WS_MERGED), (const bf16_t*)(ws + WS_WO), T, 1024, 512, G, bx); EpiResid E{ws, args.in[0], args.out}; \
        pg8::gemm_phase2<EpiResid, pg8::DenseSched, true, true, 116>(lds, 512, S, E); }
#else
#define PH7_BODY { pg8::DenseSched S; S.init((const bf16_t*)(ws + WS_MERGED), (const bf16_t*)(ws + WS_WO), T, 1024, 1024, G, bx); EpiResid E{ws, args.in[0], args.out}; \
        pg8::gemm_phase2<EpiResid, pg8::DenseSched, true>(lds, 1024, S, E); }
#endif
    if (IN(7)) { PH7_BODY
#if REP7 > 1
        PH7_BODY
#endif
    } SEAM(7);
    if (IN(8)) { p8_router(args, lds, MISC, wave, lane); } SEAM(8);
    if (IN(9)) { p9_scatter(args, MISC); } SEAM(9);
#define PH10_BODY { moe_prefix(args, MISC); \
        pg8::MoeSched<3, true> S; S.tpre = (const LAS int*)(MISC + MI_TPRE); S.ntiles = (int)MISC[MI_TPRE + 32]; S.G = G; S.c = bx; S.K = 512; \
        S.A = (const char*)(ws + WS_H2); S.Bt = (const char*)(ws + WS_WGU); S.estride = (size_t)2048 * 1024; S.row_tok = (const int*)(ws + WS_ROWTOK); \
        EpiSwiglu E{ws, args.in[15]}; \
        pg8::gemm_phase2<EpiSwiglu, pg8::MoeSched<3, true>, ALIGN_MOE, true, 121>(lds, 512, S, E); }
    if (IN(10)) { SKEW(); PH10_BODY
#if REP10 > 1
        PH10_BODY
#endif
    } SEAM(10);
#define PH11_BODY { moe_prefix(args, MISC); \
        pg8::MoeSched<2, false, MOE_REV> S; S.tpre = (const LAS int*)(MISC + MI_TPRE); S.ntiles = (int)MISC[MI_TPRE + 32]; S.G = G; S.c = bx; S.K = 512; \
        S.A = (const char*)(ws + WS_ACT); S.Bt = (const char*)(ws + WS_WD); S.estride = (size_t)1024 * 1024; S.row_tok = nullptr; \
        EpiDown E{ws, args.in[17]}; \
        pg8::gemm_phase2<EpiDown, pg8::MoeSched<2, false, MOE_REV>, ALIGN_MOE, true, 121>(lds, 512, S, E); }
    if (IN(11)) { SKEW(); PH11_BODY
#if REP11 > 1
        PH11_BODY
#endif
    } SEAM(11);
    if (IN(12)) { p12_final(args, wave, lane); }
#ifdef CLK_PROBE
    if (IN(12) && bx == 0) { __syncthreads(); const float mhz = 500.f * __builtin_rintf(0.2f * (float)(ck1_ - ck0_) / (float)(rt1_ - rt0_)); for (int i = tid; i < 1024; i += NTHREADS) args.out[i] = mhz; }
#endif
#ifdef TIME_PROBE
    if (IN(12) && bx == 0) { __syncthreads(); const float us = 0.01f * (float)(rt1_ - rt0_) - (float)(TIME_PROBE); for (int i = tid; i < 1024; i += NTHREADS) args.out[i] = 1000.f * us; }
#endif
#ifdef PROBE_FP8NAN
    if (IN(12) && bx == 0 && wave == 0) {
        typedef int v8i_ __attribute__((ext_vector_type(8))); typedef short v2s_ __attribute__((ext_vector_type(2)));
        float big = 1.0e5f, one = 1.0f, sc = 16.0f; asm volatile("" : "+v"(big), "+v"(one), "+v"(sc));
        v2s_ u = {0, 0}; u = __builtin_amdgcn_cvt_scalef32_pk_fp8_f32(u, big, one, sc, false); u = __builtin_amdgcn_cvt_scalef32_pk_fp8_f32(u, one, one, sc, true);
        int w = __builtin_bit_cast(int, u); asm volatile("" : "+v"(w));
        const bool cvt_nan = ((w & 0x7f) == 0x7f);
        v8i_ A = {w, w, w, w, w, w, w, w}, B = {0x38383838, 0x38383838, 0x38383838, 0x38383838, 0x38383838, 0x38383838, 0x38383838, 0x38383838};
        f32x16 c = __builtin_amdgcn_mfma_scale_f32_32x32x64_f8f6f4(A, B, f32x16{}, 0, 0, 0, 0x7f7f7f7f, 0, 0x7f7f7f7f);
        asm volatile("" : "+v"(c));
        const bool mf_nan = (c[0] != c[0]) && (c[5] != c[5]) && (c[15] != c[15]);
        if (lane == 0) { if (!cvt_nan) args.out[0] = 3.0e6f; if (!mf_nan) args.out[1] = 7.0e6f; }
    }
#endif
#undef IN
#undef SEAM
#undef lane
}

extern "C" void kernel_launch(void* const* d_in, const int* in_sizes, int n_in, void* d_out, int out_size, void* d_ws, size_t ws_size, hipStream_t stream) {
    static int grid = 0;
    if (grid == 0) {
        if (n_in != 19 || in_sizes[0] != T * DM || out_size != T * DM || ws_size < WS_END) { fprintf(stderr, "kernel_launch: unexpected shapes (n_in %d, in0 %d, out %d, ws %zu); nothing launched\n", n_in, n_in > 0 ? in_sizes[0] : -1, out_size, ws_size); grid = -1; return; }
        int dev = 0, cus = 0, per_cu = 0;
        if (hipGetDevice(&dev) != hipSuccess || hipDeviceGetAttribute(&cus, hipDeviceAttributeMultiprocessorCount, dev) != hipSuccess) { grid = -1; return; }
        if (hipFuncSetAttribute((const void*)fwd, hipFuncAttributeMaxDynamicSharedMemorySize, LDS_BYTES) != hipSuccess) { fprintf(stderr, "kernel_launch: hipFuncSetAttribute failed\n"); grid = -1; return; }
        if (hipOccupancyMaxActiveBlocksPerMultiprocessor(&per_cu, (const void*)fwd, NTHREADS, LDS_BYTES) != hipSuccess || per_cu < 1) fprintf(stderr, "kernel_launch: occupancy query reports %d\n", per_cu);
        (void)hipGetLastError();
        grid = cus;
    }
    if (grid < 0) return;
    if (hipMemsetAsync((char*)d_ws + WS_CTL, 0, CTL_ZERO_BYTES, stream) != hipSuccess) { fprintf(stderr, "kernel_launch: memset failed\n"); return; }
    Args a{};
    for (int i = 0; i < 19; ++i) a.in[i] = (const float*)d_in[i];
    a.out = (float*)d_out; a.ws = (unsigned char*)d_ws; a.li = 0; a.pad = 0;
#if MK_ONE_LAUNCH
    a.ph_lo = 0; a.ph_hi = N_PHASES;
    hipLaunchKernelGGL(fwd, dim3(grid), dim3(NTHREADS), LDS_BYTES, stream, a);
#else
    for (int p = 0; p < N_PHASES; ++p) {
        a.ph_lo = p; a.ph_hi = p + 1; hipLaunchKernelGGL(fwd, dim3(grid), dim3(NTHREADS), LDS_BYTES, stream, a); }

#endif
#ifdef MLA_CHECK
    {   unsigned* flag = (unsigned*)((unsigned char*)d_ws + WS_CTL) + 16384;
        hipLaunchKernelGGL(ck_kv, dim3(T), dim3(256), 0, stream, a.in[0], a.in[1], a.in[2], a.in[4], a.in[6], a.in[7], (unsigned char*)d_ws);
        hipLaunchKernelGGL(ck_q, dim3(CK_NS), dim3(256), 0, stream, a.in[0], a.in[1], a.in[2], a.in[3], a.in[5], (unsigned char*)d_ws);
        hipLaunchKernelGGL(ck_attn, dim3(CK_NS * 8), dim3(256), 0, stream, (unsigned char*)d_ws, flag);
        hipLaunchKernelGGL(ck_apply, dim3(1024), dim3(256), 0, stream, (float*)d_out, (const unsigned*)flag); }
#endif
    const hipError_t le = hipPeekAtLastError();
    if (le != hipSuccess) fprintf(stderr, "kernel_launch: launch failed: %s\n", hipGetErrorName(le));
}
```

```cpp
#define MK_ONE_LAUNCH 1
#define INPROJ_FP8 1
#define WO_FP8 1
#define OAB_FP8 1
#include <hip/hip_runtime.h>
#include <cstdio>
#include <cstdint>

#define LAS __attribute__((address_space(3)))
#define GAS __attribute__((address_space(1)))
typedef unsigned short bf16_t;
typedef short bf16x8 __attribute__((ext_vector_type(8)));
typedef short s16x4 __attribute__((ext_vector_type(4)));
typedef float f32x2 __attribute__((ext_vector_type(2)));
typedef float f32x4 __attribute__((ext_vector_type(4)));
typedef float f32x16 __attribute__((ext_vector_type(16)));
typedef unsigned u32x2 __attribute__((ext_vector_type(2)));
typedef unsigned u32x4 __attribute__((ext_vector_type(4)));

constexpr int NB = 2, SEQ = 16384, T = NB * SEQ, DM = 1024;
constexpr int NIN = 4096;
constexpr int NEXP = 32, TOPK = 4, NSLOT = T * TOPK, NPMAX = NSLOT + NEXP * 256;
constexpr float EPS = 1e-5f, LOG2E = 1.4426950408889634f;
constexpr int NWAVES = 8, NTHREADS = 512;

constexpr size_t MiB = 1u << 20;
constexpr size_t WS_CTL = 0, CTL_ZERO_BYTES = 128 * 1024;
constexpr size_t WS_WIN = 1 * MiB;
constexpr size_t WS_WUQ = 9 * MiB;
constexpr size_t WS_WUKV = 10 * MiB;
constexpr size_t WS_WA = 11 * MiB, WS_WB = 12 * MiB;
constexpr size_t WS_WO = 13 * MiB;
constexpr size_t WS_ROPE = 15 * MiB;
constexpr size_t WS_WGU = 17 * MiB;
constexpr size_t WS_WD = 145 * MiB;
constexpr size_t WS_SMALL = 209 * MiB;
constexpr size_t WS_RSTDQ = WS_SMALL, WS_RSTDKV = WS_RSTDQ + T * 4, WS_RSTD2 = WS_RSTDKV + T * 4;
constexpr size_t WS_TOPI = WS_RSTD2 + T * 4, WS_GATEW = WS_TOPI + (size_t)NSLOT * 4, WS_SRANK = WS_GATEW + (size_t)NSLOT * 4, WS_POS = WS_SRANK + (size_t)NSLOT * 4;
constexpr size_t WS_ROWTOK = WS_POS + (size_t)NSLOT * 4, WS_ROWSCALE = WS_ROWTOK + 1 * MiB, WS_WGBASE = WS_ROWSCALE + 1 * MiB;
constexpr size_t WS_WRP = WS_WGBASE + 64 * 1024;
constexpr size_t WS_PARTL = WS_WRP + 128 * 1024;
static_assert(WS_PARTL + 3 * MiB <= 225 * MiB, "small region");
constexpr size_t WS_XB = 225 * MiB;
constexpr size_t WS_QA = 289 * MiB, WS_KA = 321 * MiB, WS_VA = 353 * MiB;
constexpr size_t WS_CQ = 385 * MiB;
constexpr size_t WS_CKV = 401 * MiB;
constexpr size_t WS_KR = 409 * MiB;
constexpr size_t WS_GA = 411 * MiB, WS_GB = 475 * MiB;
constexpr size_t WS_K8 = 587 * MiB;
constexpr size_t WS_Q8 = 249 * MiB;
constexpr size_t WS_V8T = 273 * MiB;
constexpr size_t WS_ACT = 225 * MiB;
static_assert(WS_ACT + (size_t)NPMAX * 2048 <= 539 * MiB, "ACT overlay");
constexpr size_t WS_QB = 539 * MiB;
constexpr size_t WS_KIMG = 587 * MiB;
constexpr size_t WS_VIMG = 635 * MiB;
constexpr size_t WS_OA = 667 * MiB, WS_OB = 699 * MiB;
constexpr size_t WS_MERGED = 731 * MiB;
constexpr size_t WS_PARTO = 795 * MiB;
constexpr size_t WS_H2 = 891 * MiB;
constexpr size_t WS_Y = 539 * MiB;
static_assert(WS_Y + (size_t)NPMAX * 2048 <= WS_H2, "Y overlay");
constexpr size_t WS_END = 955 * MiB;
constexpr int CW_TMO = 0, CW_BAR = 4096, CW_GCOUNT = 8192, CW_NRM = 8256;

constexpr int RING_BYTES = 131072, LDS_BYTES = 163840, MISC_OFF = LDS_BYTES - 4096;
constexpr int MI_BAR = 8, MI_TPRE = 16, MI_HIST = 64, MI_PSTART = 96, MI_NRM = 160;

__device__ __forceinline__ unsigned f2bf(float f) { unsigned u = __builtin_bit_cast(unsigned, f); return (u + 0x7fffu + ((u >> 16) & 1u)) >> 16; }
__device__ __forceinline__ unsigned pk2(float lo, float hi) { return f2bf(lo) | (f2bf(hi) << 16); }
__device__ __forceinline__ float bf2f(unsigned short b) { return __builtin_bit_cast(float, (unsigned)b << 16); }
__device__ __forceinline__ float bflo(unsigned w) { return __builtin_bit_cast(float, w << 16); }
__device__ __forceinline__ float bfhi(unsigned w) { return __builtin_bit_cast(float, w & 0xffff0000u); }
typedef __bf16 bf16x2_t __attribute__((ext_vector_type(2)));
__device__ __forceinline__ unsigned cvtpk(float lo, float hi) { const f32x2 v = {lo, hi}; const bf16x2_t b = __builtin_convertvector(v, bf16x2_t); return __builtin_bit_cast(unsigned, b); }
__device__ __forceinline__ unsigned pack4_fp8(float a, float b, float c, float d) { int w = 0; w = __builtin_amdgcn_cvt_pk_fp8_f32(a, b, w, false); w = __builtin_amdgcn_cvt_pk_fp8_f32(c, d, w, true); return (unsigned)w; }
__device__ __forceinline__ float wave_sum(float v) {
#pragma unroll
    for (int o = 1; o < 64; o <<= 1) v += __shfl_xor(v, o);
    return v;
}
__device__ __forceinline__ int lane_now() { int t = threadIdx.x; asm volatile("" : "+v"(t)); return t & 63; }
__device__ __forceinline__ float fexp2(float x) { return __builtin_amdgcn_exp2f(x); }
__device__ __forceinline__ float frcp(float x) { return __builtin_amdgcn_rcpf(x); }
__device__ __forceinline__ float sigmoidf_(float z) { return frcp(1.f + fexp2(-z * LOG2E)); }
__device__ __forceinline__ int crow(int r, int hi) { return (r & 3) + 8 * (r >> 2) + 4 * hi; }
__device__ __forceinline__ u32x4 pack8(const float (&v)[8]) { u32x4 w; w.x = cvtpk(v[0], v[1]); w.y = cvtpk(v[2], v[3]); w.z = cvtpk(v[4], v[5]); w.w = cvtpk(v[6], v[7]); return w; }
__device__ __forceinline__ void unpack8(const u32x4 w, float (&v)[8]) { v[0] = bflo(w.x); v[1] = bfhi(w.x); v[2] = bflo(w.y); v[3] = bfhi(w.y); v[4] = bflo(w.z); v[5] = bfhi(w.z); v[6] = bflo(w.w); v[7] = bfhi(w.w); }
__device__ __forceinline__ f32x2 rope_cs(int pos, int i) {
    const float inv = __builtin_powf(10000.f, -(float)i * (1.f / 16.f));
    const float ang = (float)pos * inv;
    double x = (double)ang; const double n = __builtin_rint(x * 0.15915494309189535); x = (x - n * 6.283185307179586) - n * 2.4492935982947064e-16;
    const double x2 = x * x; double sn = 1.0, cs = 1.0;
#pragma unroll
    for (int k = 13; k >= 1; --k) { sn = 1.0 - sn * x2 * (1.0 / (double)((2 * k) * (2 * k + 1))); cs = 1.0 - cs * x2 * (1.0 / (double)((2 * k - 1) * (2 * k))); }
    sn *= x;
    return (f32x2){(float)cs, (float)sn};
}

namespace pg8 {
constexpr int BM = 256, BK = 64, HALF = 128, HTB = HALF * BK * 2  , NXCD = 8, WGM = 8;
__host__ __device__ __forceinline__ int lds_byte(int r, int c) { const int st = (r >> 4) * 2 + (c >> 5), rr = r & 15, cc = c & 31, ob = rr * 64 + cc * 2; return st * 1024 + (ob ^ (((ob >> 9) & 1) << 5)); }
__host__ __device__ __forceinline__ void stage_rc(int b, int& R, int& C) { const int st = b / 1024, sb = b % 1024, swz = sb ^ (((sb >> 9) & 1) << 5); R = (st >> 1) * 16 + swz / 64; C = (st & 1) * 32 + (swz % 64) / 2; }
__host__ __device__ __forceinline__ int perm32(int rho) { const int n = rho >> 4, i = rho & 15; return 8 * (i >> 2) + 4 * n + (i & 3); }

struct Unit { int pm, pn, e; };

struct StaticOrder {
    int nM, nN, nwg, G, c;
    __host__ __device__ void init(int M, int N, int G_, int c_) { nM = M / BM; nN = N / BM; nwg = nM * nN; G = G_; c = c_; }
    __host__ __device__ bool next(int i, Unit& u) const {
        const long L = (long)i * G + c; if (L >= nwg) return false;
        int wgid = (int)L; { const int q = nwg / NXCD, r = nwg % NXCD, xcd = wgid % NXCD, off = wgid / NXCD; wgid = (xcd < r ? xcd * (q + 1) : r * (q + 1) + (xcd - r) * q) + off; }
        const int nig = WGM * nN, gid = wgid / nig, fm = gid * WGM, gsz = (nM - fm) < WGM ? (nM - fm) : WGM;
        u.pm = fm + ((wgid % nig) % gsz); u.pn = (wgid % nig) / gsz; u.e = 0; return true;
    }
};
struct DenseSched {
    static constexpr bool LATE = false, KEEP_ACC = false;
    StaticOrder so; const char* A; const char* Bt; int K;
    __device__ __forceinline__ void prefetch_rows(const Unit&, LAS unsigned char*, int, int, int) const {}
    __device__ __forceinline__ void a_off_lds(const Unit&, const int (&)[2], const int (&)[2], LAS unsigned char*, int, unsigned (&)[2][2]) const {}
    __device__ __forceinline__ void init(const bf16_t* A_, const bf16_t* Bt_, int M, int N, int K_, int G, int c) { so.init(M, N, G, c); A = (const char*)A_; Bt = (const char*)Bt_; K = K_; }
    __device__ __forceinline__ bool next(int i, Unit& u) const { return so.next(i, u); }
    __device__ __forceinline__ const char* a_base(const Unit& u) const { return A + (size_t)u.pm * ((size_t)BM * K * 2); }
    __device__ __forceinline__ const char* b_base(const Unit& u) const { return Bt + (size_t)u.pn * ((size_t)BM * K * 2); }
    __device__ __forceinline__ void a_off(const Unit&, const int (&sR)[2], const int (&sC)[2], unsigned (&vo)[2][2]) const {
#pragma unroll
        for (int h = 0; h < 2; ++h)
#pragma unroll
            for (int i = 0; i < 2; ++i) vo[h][i] = (unsigned)((h * HALF + sR[i]) * K + sC[i]) * 2u;
    }
};
struct TwoSegSched {
    static constexpr bool LATE = false, KEEP_ACC = true;
    StaticOrder so; const char* A0; const char* A1; const char* B0; const char* B1; int K;
    __device__ __forceinline__ void prefetch_rows(const Unit&, LAS unsigned char*, int, int, int) const {}
    __device__ __forceinline__ void a_off_lds(const Unit&, const int (&)[2], const int (&)[2], LAS unsigned char*, int, unsigned (&)[2][2]) const {}
    __device__ __forceinline__ void init(const bf16_t* A0_, const bf16_t* B0_, const bf16_t* A1_, const bf16_t* B1_, int M, int N, int K_, int G, int c) { so.init(M, N, G, c); A0 = (const char*)A0_; A1 = (const char*)A1_; B0 = (const char*)B0_; B1 = (const char*)B1_; K = K_; }
    __device__ __forceinline__ bool next(int i, Unit& u) const { const bool ok = so.next(i >> 1, u); u.e = i & 1; return ok; }
    __device__ __forceinline__ const char* a_base(const Unit& u) const { return (u.e ? A1 : A0) + (size_t)u.pm * ((size_t)BM * K * 2); }
    __device__ __forceinline__ const char* b_base(const Unit& u) const { return (u.e ? B1 : B0) + (size_t)u.pn * ((size_t)BM * K * 2); }
    __device__ __forceinline__ void a_off(const Unit&, const int (&sR)[2], const int (&sC)[2], unsigned (&vo)[2][2]) const {
#pragma unroll
        for (int h = 0; h < 2; ++h)
#pragma unroll
            for (int i = 0; i < 2; ++i) vo[h][i] = (unsigned)((h * HALF + sR[i]) * K + sC[i]) * 2u;
    }
};
template <int NPN_SHIFT, bool GATHER, bool REVERSE = false>
struct MoeSched {
    static constexpr bool KEEP_ACC = false;
    static constexpr bool LATE = GATHER;
    static constexpr int TBL_OFF = 131072 + 4096;
    __device__ __forceinline__ void prefetch_rows(const Unit& u, LAS unsigned char* lds, int buf, int wid, int lane) const {
        if (wid < 4) __builtin_amdgcn_global_load_lds((const unsigned*)(row_tok + u.pm * BM + wid * 64 + lane), (LAS unsigned*)(lds + TBL_OFF + buf * 1024 + wid * 256), 4, 0, 0);
    }
    __device__ __forceinline__ void a_off_lds(const Unit&, const int (&sR)[2], const int (&sC)[2], LAS unsigned char* lds, int buf, unsigned (&vo)[2][2]) const {
        const LAS int* tb = (const LAS int*)(lds + TBL_OFF + buf * 1024);
#pragma unroll
        for (int h = 0; h < 2; ++h)
#pragma unroll
            for (int i = 0; i < 2; ++i) vo[h][i] = (unsigned)(tb[h * HALF + sR[i]] * K + sC[i]) * 2u;
    }
    const LAS int* tpre; int ntiles, G, c, K; const char* A; const char* Bt; size_t estride; const int* row_tok;
    __device__ __forceinline__ bool next(int i, Unit& u) const {
        int g, pn;
        if (G == 256) { const int x = c & 7, j = c >> 3; constexpr int TPR = 256 >> NPN_SHIFT, PX = TPR / 8; g = i * TPR + x * PX + (j >> NPN_SHIFT); pn = j & ((1 << NPN_SHIFT) - 1); }
        else { const int L = i * G + c; g = L >> NPN_SHIFT; pn = L & ((1 << NPN_SHIFT) - 1); }
        if (g >= ntiles) return false;
        if (REVERSE) g = ntiles - 1 - g;
        int e = 0; while (e < 31 && tpre[e + 1] <= g) ++e;
        u.pm = g; u.pn = pn; u.e = e; return true;
    }
    __device__ __forceinline__ const char* a_base(const Unit& u) const { return GATHER ? A : A + (size_t)u.pm * ((size_t)BM * K * 2); }
    __device__ __forceinline__ const char* b_base(const Unit& u) const { return Bt + (size_t)u.e * estride + (size_t)u.pn * ((size_t)BM * K * 2); }
    __device__ __forceinline__ void a_off(const Unit& u, const int (&sR)[2], const int (&sC)[2], unsigned (&vo)[2][2]) const {
#pragma unroll
        for (int h = 0; h < 2; ++h)
#pragma unroll
            for (int i = 0; i < 2; ++i) {
                if (GATHER) { const int tok = row_tok[u.pm * BM + h * HALF + sR[i]]; vo[h][i] = (unsigned)(tok * K + sC[i]) * 2u; }
                else vo[h][i] = (unsigned)((h * HALF + sR[i]) * K + sC[i]) * 2u;
            }
    }
};

typedef int v8i_ __attribute__((ext_vector_type(8)));
__device__ __forceinline__ v8i_ cat16(const bf16x8 a, const bf16x8 b) { const u32x4 x = __builtin_bit_cast(u32x4, a), y = __builtin_bit_cast(u32x4, b); return (v8i_){(int)x.x, (int)x.y, (int)x.z, (int)x.w, (int)y.x, (int)y.y, (int)y.z, (int)y.w}; }
__device__ __forceinline__ v8i_ lds_ld32(const LAS unsigned char* p) { const u32x4 x = *(const LAS u32x4*)p, y = *(const LAS u32x4*)(p + 1024); return (v8i_){(int)x.x, (int)x.y, (int)x.z, (int)x.w, (int)y.x, (int)y.y, (int)y.z, (int)y.w}; }
template <class Epi, class Sched, bool ALIGN_EPI, bool FP8 = false, int SCALE_W = 127>
__device__ __forceinline__ void gemm_phase2(LAS unsigned char* lds, const int K_, const Sched& S, const Epi& E) {
    int K = K_; asm volatile("" : "+s"(K));
    const int tid = threadIdx.x, wid = __builtin_amdgcn_readfirstlane(tid >> 6), lane = tid & 63, wr = wid >> 2, wc = wid & 3, fr = lane & 15, fq = lane >> 4;
    const int nt = K / BK;
    int sR[2], sC[2]; unsigned voffB[2];
#pragma unroll
    for (int i = 0; i < 2; ++i) { int R, C; stage_rc(tid * 16 + i * 8192, R, C); sR[i] = R; sC[i] = C; const int Rb = Epi::PERM ? ((R & ~31) + perm32(R & 31)) : R; voffB[i] = (unsigned)(Rb * K + C) * 2u; }
    const size_t kstep = (size_t)(BK * 2);
    const size_t hstep = (size_t)HALF * K * 2;
    const unsigned ldsw = (unsigned)wid * 1024u;
    const int aoff = lds_byte(wr * 64 + fr, fq * 8), boff = lds_byte(wc * 32 + fr, fq * 8);
#define PG8_SA(b, h) (((b) * 2 + (h)) * HTB)
#define PG8_SB(b, h) ((4 + (b) * 2 + (h)) * HTB)
#define PG8_STAGE_B(bufoff, gbase) do { _Pragma("unroll") for (int _i = 0; _i < 2; ++_i) \
        __builtin_amdgcn_global_load_lds((const unsigned*)((const char*)(gbase) + voffB[_i]), (LAS unsigned*)(lds + (bufoff) + ldsw + _i * 8192), 16, 0, 0); } while (0)
#define PG8_STAGE_A(bufoff, gbase, o0, o1) do { \
        __builtin_amdgcn_global_load_lds((const unsigned*)((const char*)(gbase) + (o0)), (LAS unsigned*)(lds + (bufoff) + ldsw), 16, 0, 0); \
        __builtin_amdgcn_global_load_lds((const unsigned*)((const char*)(gbase) + (o1)), (LAS unsigned*)(lds + (bufoff) + ldsw + 8192), 16, 0, 0); } while (0)
#define PG8_LDA(dst, b, h) do { if constexpr (FP8) { _Pragma("unroll") for (int m = 0; m < 4; ++m) dst##8[m] = lds_ld32(lds + PG8_SA(b, h) + aoff + m * 2048); } else { _Pragma("unroll") for (int m = 0; m < 4; ++m) _Pragma("unroll") for (int k = 0; k < 2; ++k) dst[m][k] = *(const LAS bf16x8*)(lds + PG8_SA(b, h) + aoff + m * 2048 + k * 1024); } } while (0)
#define PG8_LDB(dst, b, h) do { if constexpr (FP8) { _Pragma("unroll") for (int n = 0; n < 2; ++n) dst##8[n] = lds_ld32(lds + PG8_SB(b, h) + boff + n * 2048); } else { _Pragma("unroll") for (int n = 0; n < 2; ++n) _Pragma("unroll") for (int k = 0; k < 2; ++k) dst[n][k] = *(const LAS bf16x8*)(lds + PG8_SB(b, h) + boff + n * 2048 + k * 1024); } } while (0)
#define PG8_MMA(ai, bj, At, Bt) do { __builtin_amdgcn_s_setprio(1); if constexpr (FP8) { _Pragma("unroll") for (int m = 0; m < 4; ++m) _Pragma("unroll") for (int n = 0; n < 2; ++n) \
        asm volatile("v_mfma_scale_f32_16x16x128_f8f6f4 %0, %1, %2, %0, %3, %4 op_sel_hi:[0,0,0]" : "+v"(acc[ai][bj][m][n]) : "v"(Bt##8[n]), "v"(At##8[m]), "v"(scw_), "v"(sca_)); } else { \
        _Pragma("unroll") for (int m = 0; m < 4; ++m) _Pragma("unroll") for (int n = 0; n < 2; ++n) _Pragma("unroll") for (int k = 0; k < 2; ++k) \
        acc[ai][bj][m][n] = __builtin_amdgcn_mfma_f32_16x16x32_bf16(Bt[n][k], At[m][k], acc[ai][bj][m][n], 0, 0, 0); } __builtin_amdgcn_s_setprio(0); } while (0)
#define PG8_WAIT_V(n) asm volatile("s_waitcnt vmcnt(" #n ")" ::: "memory")
#define PG8_WAIT_L(n) asm volatile("s_waitcnt lgkmcnt(" #n ")" ::: "memory")
#define PG8_BAR __builtin_amdgcn_s_barrier()
#define PG8_SCHED __builtin_amdgcn_sched_barrier(0)
    Unit cur, nxt; int ui = 0;
    if (!S.next(0, cur)) return;
    f32x4 acc[2][2][4][2];
#pragma unroll
    for (int a = 0; a < 2; ++a)
#pragma unroll
        for (int b = 0; b < 2; ++b)
#pragma unroll
            for (int m = 0; m < 4; ++m)
#pragma unroll
                for (int n = 0; n < 2; ++n) acc[a][b][m][n] = (f32x4){0.f, 0.f, 0.f, 0.f};
    bf16x8 At[4][2], B0[2][2], B1[2][2]; v8i_ At8[4], B08[2], B18[2];
    int scw_ = SCALE_W * 0x01010101, sca_ = 0x7f7f7f7f; asm volatile("" : "+v"(scw_), "+v"(sca_));
    unsigned voA[2][2], voN[2][2];
    S.a_off(cur, sR, sC, voA);
    const char* cA = S.a_base(cur); const char* cB = S.b_base(cur);
    PG8_STAGE_B(PG8_SB(0, 0), cB); PG8_STAGE_B(PG8_SB(0, 1), cB + hstep); PG8_STAGE_A(PG8_SA(0, 0), cA, voA[0][0], voA[0][1]); PG8_STAGE_A(PG8_SA(0, 1), cA, voA[1][0], voA[1][1]);
    if (wr == 1) PG8_BAR;
    PG8_WAIT_V(2); PG8_BAR;
    PG8_STAGE_B(PG8_SB(1, 0), cB + kstep); PG8_STAGE_A(PG8_SA(1, 0), cA + kstep, voA[0][0], voA[0][1]); PG8_STAGE_B(PG8_SB(1, 1), cB + hstep + kstep);
    PG8_WAIT_V(6); PG8_BAR;
    for (;;) {
        const bool has_next = S.next(ui + 1, nxt);
        const char* nA = cA; const char* nB = cB;
#pragma unroll
        for (int h = 0; h < 2; ++h)
#pragma unroll
            for (int i = 0; i < 2; ++i) voN[h][i] = voA[h][i];
        if (has_next) { nA = S.a_base(nxt); nB = S.b_base(nxt); if constexpr (Sched::LATE) S.prefetch_rows(nxt, lds, (ui + 1) & 1, wid, lane); else S.a_off(nxt, sR, sC, voN); }
        for (int t = 0; t < nt; t += 2) {
            const bool last = (t == nt - 2);
            if constexpr (Sched::LATE) { if (last && has_next) S.a_off_lds(nxt, sR, sC, lds, (ui + 1) & 1, voN); }
            const char* a1 = cA + (size_t)(t + 1) * kstep;
            const char* a2 = last ? nA : cA + (size_t)(t + 2) * kstep; const char* b2 = last ? nB : cB + (size_t)(t + 2) * kstep;
            const char* a3 = a2 + kstep; const char* b3 = b2 + kstep;
            const unsigned s00 = last ? voN[0][0] : voA[0][0], s01 = last ? voN[0][1] : voA[0][1], s10 = last ? voN[1][0] : voA[1][0], s11 = last ? voN[1][1] : voA[1][1];
            PG8_LDB(B0, 0, 0); PG8_LDB(B1, 0, 1); PG8_SCHED; PG8_LDA(At, 0, 0); PG8_STAGE_A(PG8_SA(1, 1), a1, voA[1][0], voA[1][1]);
            PG8_WAIT_V(8); PG8_WAIT_L(0); PG8_BAR; PG8_MMA(0, 0, At, B0); PG8_MMA(0, 1, At, B1); PG8_BAR; PG8_SCHED;
            PG8_LDA(At, 0, 1); PG8_STAGE_B(PG8_SB(0, 0), b2); PG8_STAGE_B(PG8_SB(0, 1), b2 + hstep); PG8_STAGE_A(PG8_SA(0, 0), a2, s00, s01);
            PG8_WAIT_V(8); PG8_WAIT_L(0); PG8_BAR; PG8_MMA(1, 0, At, B0); PG8_MMA(1, 1, At, B1); PG8_BAR; PG8_SCHED;
            PG8_LDB(B0, 1, 0); PG8_LDB(B1, 1, 1); PG8_SCHED; PG8_LDA(At, 1, 0); PG8_STAGE_A(PG8_SA(0, 1), a2, s10, s11);
            PG8_WAIT_V(8); PG8_WAIT_L(0); PG8_BAR; PG8_MMA(0, 0, At, B0); PG8_MMA(0, 1, At, B1); PG8_BAR; PG8_SCHED;
            PG8_LDA(At, 1, 1); PG8_STAGE_B(PG8_SB(1, 0), b3); PG8_STAGE_B(PG8_SB(1, 1), b3 + hstep); PG8_STAGE_A(PG8_SA(1, 0), a3, s00, s01);
            PG8_WAIT_V(8); PG8_WAIT_L(0); PG8_BAR; PG8_MMA(1, 0, At, B0); PG8_MMA(1, 1, At, B1); PG8_BAR; PG8_SCHED;
        }
        if constexpr (ALIGN_EPI) { if (wr == 0) PG8_BAR; }
        E(acc, cur, wr, wc, fr, fq);
#ifdef PROBE_EPI2
        if (Epi::PROBE2) { asm volatile("" ::: "memory"); E(acc, cur, wr, wc, fr, fq); }
#endif
        if (!has_next) break;
        if (!(Sched::KEEP_ACC && nxt.e != 0)) {
#pragma unroll
        for (int a = 0; a < 2; ++a)
#pragma unroll
            for (int b = 0; b < 2; ++b)
#pragma unroll
                for (int m = 0; m < 4; ++m)
#pragma unroll
                    for (int n = 0; n < 2; ++n) acc[a][b][m][n] = (f32x4){0.f, 0.f, 0.f, 0.f};
        }
        cur = nxt; cA = nA; cB = nB; ++ui;
#pragma unroll
        for (int h = 0; h < 2; ++h)
#pragma unroll
            for (int i = 0; i < 2; ++i) voA[h][i] = voN[h][i];
        if constexpr (ALIGN_EPI) { if (wr == 1) PG8_BAR; }
    }
    PG8_WAIT_V(0);
    if constexpr (!ALIGN_EPI) { if (wr == 0) PG8_BAR; }
    PG8_BAR;
#undef PG8_SA
#undef PG8_SB
#undef PG8_STAGE_A
#undef PG8_STAGE_B
#undef PG8_LDA
#undef PG8_LDB
#undef PG8_MMA
#undef PG8_WAIT_V
#undef PG8_WAIT_L
#undef PG8_BAR
#undef PG8_SCHED
}
}

#define XB_TMO      128
#define XB_XCNT(j)  (256  + 64 * (j))
#define XB_XSUB(j)  (1280 + 64 * (j))
#define XB_XGEN(j)  (2304 + 64 * (j))
#define XB_TOP      3328
#define XB_TOPGEN   3392
#define XCD_BAR_WORDS 3456
#define XB_SPIN_CAP (1u << 18)

__device__ __forceinline__ unsigned xb_ld(unsigned* p)              { return __hip_atomic_load(p, __ATOMIC_RELAXED, __HIP_MEMORY_SCOPE_AGENT); }
__device__ __forceinline__ unsigned xb_add(unsigned* p, unsigned v) { return __hip_atomic_fetch_add(p, v, __ATOMIC_RELAXED, __HIP_MEMORY_SCOPE_AGENT); }
__device__ __forceinline__ unsigned xb_xcc_id() { return (unsigned)__builtin_amdgcn_s_getreg((3 << 11) | 20) & 0xFu; }
#define XB_SPIN(cond, bar) do { unsigned _sp = 0; while (cond) { __builtin_amdgcn_s_sleep(1); \
    if ((++_sp & 255u) == 0u) { if (xb_ld(&(bar)[XB_TMO])) break; if (_sp > XB_SPIN_CAP) { atomicAdd(&(bar)[XB_TMO], 1u); break; } } } } while (0)

struct XcdBarrier {
    unsigned* bar; unsigned x;
    volatile LAS unsigned* st;
};
__device__ __forceinline__ XcdBarrier xcd_barrier_post(unsigned* bar, volatile LAS unsigned* st) {
    XcdBarrier b; b.bar = bar; b.x = xb_xcc_id(); b.st = st;
    if (threadIdx.x == 0) (void)xb_add(&bar[XB_XCNT(b.x)], 1u);
    return b;
}
__device__ __forceinline__ void xcd_barrier_complete(unsigned* bar, unsigned x, unsigned& nloc, unsigned& nx) {
    const unsigned G = gridDim.x * gridDim.y * gridDim.z;
    unsigned sum, cnt, mine, sp = 0u;
    for (;;) {
        sum = 0u; cnt = 0u; mine = 0u;
#pragma unroll
        for (unsigned j = 0; j < 16; ++j) { const unsigned c = xb_ld(&bar[XB_XCNT(j)]); sum += c; cnt += (c > 0u) ? 1u : 0u; mine = (j == x) ? c : mine; }
        if (sum == G) break;
        __builtin_amdgcn_s_sleep(1);
        if ((++sp & 255u) == 0u) { if (xb_ld(&bar[XB_TMO])) break; if (sp > XB_SPIN_CAP) { atomicAdd(&bar[XB_TMO], 1u); break; } }
    }
    nloc = mine > 0u ? mine : 1u; nx = cnt > 0u ? cnt : 1u;
}
__device__ __forceinline__ void xcd_barrier(const XcdBarrier& b) {
    asm volatile("s_waitcnt vmcnt(0)" ::: "memory");
    __syncthreads();
    if (threadIdx.x == 0) {
        unsigned* bar = b.bar;
        __builtin_amdgcn_s_waitcnt(0);
        unsigned nloc = b.st[0], nx = b.st[1];
        if (nloc == 0u) { xcd_barrier_complete(bar, b.x, nloc, nx); b.st[0] = nloc; b.st[1] = nx; }
        const unsigned old = xb_add(&bar[XB_XSUB(b.x)], 1u);
        const unsigned gen = old / nloc;
        if (old + 1u == (gen + 1u) * nloc) {
            __builtin_amdgcn_fence(__ATOMIC_RELEASE, "agent");
            asm volatile("s_waitcnt vmcnt(0)" ::: "memory");
            const unsigned og = xb_add(&bar[XB_TOP], 1u);
            const unsigned tg = og / nx;
            if (og + 1u == (tg + 1u) * nx) xb_add(&bar[XB_TOPGEN], 1u);
            else XB_SPIN(xb_ld(&bar[XB_TOPGEN]) == tg, bar);
            __builtin_amdgcn_fence(__ATOMIC_ACQUIRE, "agent");
            xb_add(&bar[XB_XGEN(b.x)], 1u);
            asm volatile("s_waitcnt vmcnt(0)" ::: "memory");
        } else {
            XB_SPIN(xb_ld(&bar[XB_XGEN(b.x)]) == gen, bar);
            __builtin_amdgcn_fence(__ATOMIC_ACQUIRE, "agent");
            asm volatile("s_waitcnt vmcnt(0)" ::: "memory");
        }
    }
    __syncthreads();
}

#define EPI_WALK(...) \
    _Pragma("unroll") for (int ai = 0; ai < 2; ++ai) _Pragma("unroll") for (int m = 0; m < 4; ++m) { \
        const int row = u.pm * 256 + ai * 128 + wr * 64 + m * 16 + fr; \
        _Pragma("unroll") for (int bj = 0; bj < 2; ++bj) { const int cw = bj * 128 + wc * 32 + 8 * fq; \
            float v[8] = {acc[ai][bj][m][0][0], acc[ai][bj][m][0][1], acc[ai][bj][m][0][2], acc[ai][bj][m][0][3], acc[ai][bj][m][1][0], acc[ai][bj][m][1][1], acc[ai][bj][m][1][2], acc[ai][bj][m][1][3]}; \
            __VA_ARGS__ } asm volatile("" ::: "memory"); }

__device__ __forceinline__ void rope8(float (&v)[8], const f32x2* rope_row, int i0) {
#pragma unroll
    for (int j = 0; j < 4; ++j) { const f32x2 cs = rope_row[i0 + j]; const float x1 = v[2 * j], x2 = v[2 * j + 1]; v[2 * j] = x1 * cs.x - x2 * cs.y; v[2 * j + 1] = x2 * cs.x + x1 * cs.y; }
}

#define EPI_ROW_(ai, m) (u.pm * 256 + (ai) * 128 + wr * 64 + (m) * 16 + fr)
struct EpiInProj {
    static constexpr bool PERM = true;
    __device__ __forceinline__ void row_rstd(float (&ssr)[2][4], float* dst, float inv_n, const pg8::Unit& u, int wr, int wc, int fr, int fq) const {
        LAS float* red = (LAS float*)(lds + 139264);
#pragma unroll
        for (int ai = 0; ai < 2; ++ai)
#pragma unroll
            for (int m = 0; m < 4; ++m) { float s = ssr[ai][m]; s += __shfl_xor(s, 16); s += __shfl_xor(s, 32);
                if (fq == 0) red[(ai * 128 + wr * 64 + m * 16 + fr) * 4 + wc] = s; }
        __syncthreads();
        if (wc == 0 && fq == 0) {
#pragma unroll
            for (int ai = 0; ai < 2; ++ai)
#pragma unroll
                for (int m = 0; m < 4; ++m) { const int r = ai * 128 + wr * 64 + m * 16 + fr; const f32x4 p = *(const LAS f32x4*)(red + r * 4);
                    dst[u.pm * 256 + r] = 1.f / sqrtf(((p.x + p.y) + (p.z + p.w)) * inv_n + EPS); }
        }
        __syncthreads();
    }
#ifdef PROBE_EPI2
    static constexpr bool PROBE2 = (PROBE_EPI2 == 0);
#endif
    unsigned char* ws; LAS unsigned char* lds;
    __device__ __forceinline__ void operator()(const f32x4 (&acc)[2][2][4][2], const pg8::Unit& u, int wr, int wc, int fr, int fq) const {
        asm volatile("" : "+v"(fr), "+v"(fq));
        const int pn = u.pn;
        if (pn < 6) {
            bf16_t* base = (bf16_t*)(ws + (pn < 2 ? WS_QA : pn < 4 ? WS_KA : WS_VA)) + (pn & 1) * 256;
            EPI_WALK({ *(u32x4*)(base + (size_t)row * 512 + cw) = pack8(v); })
        } else if (pn == 6) {
            bf16_t* base = (bf16_t*)(ws + WS_CQ); float ssr[2][4] = {};
            EPI_WALK({ _Pragma("unroll") for (int j = 0; j < 8; ++j) ssr[ai][m] = __builtin_fmaf(v[j], v[j], ssr[ai][m]); *(u32x4*)(base + (size_t)row * 256 + cw) = pack8(v); })
            row_rstd(ssr, (float*)(ws + WS_RSTDQ), 1.f / 256.f, u, wr, wc, fr, fq);
        } else if (pn == 7) {
            bf16_t* ckv = (bf16_t*)(ws + WS_CKV); const f32x2* rope = (const f32x2*)(ws + WS_ROPE); float ssr[2][4] = {};
            EPI_WALK({ if (cw < 128) { _Pragma("unroll") for (int j = 0; j < 8; ++j) ssr[ai][m] = __builtin_fmaf(v[j], v[j], ssr[ai][m]); *(u32x4*)(ckv + (size_t)row * 128 + cw) = pack8(v); }
                       else if (cw < 160) { rope8(v, rope + (size_t)(row & (SEQ - 1)) * 16, (cw - 128) >> 1);
                           const u32x2 w8 = {pack4_fp8(v[0], v[1], v[2], v[3]), pack4_fp8(v[4], v[5], v[6], v[7])};
                           const int b = row >> 14, sq2 = row & (SEQ - 1); unsigned char* kp = ws + WS_K8 + (size_t)(b * 8 * 256 + (sq2 >> 6)) * 6144 + (4 + ((cw - 128) >> 4)) * 1024 + (sq2 & 63) * 16 + ((cw - 128) & 8);
                           _Pragma("unroll") for (int hh = 0; hh < 8; ++hh) { asm volatile("" : "+v"(kp)); *(u32x2*)kp = w8; kp += (size_t)256 * 6144; } } })
            row_rstd(ssr, (float*)(ws + WS_RSTDKV), 1.f / 128.f, u, wr, wc, fr, fq);
        } else {
            bf16_t* gr = (bf16_t*)(ws + WS_GA) + (pn - 8) * 128 + wc * 32 + 8 * fq; bf16_t* gbp = (bf16_t*)(ws + WS_GB) + (pn - 8) * 128 + wc * 32 + 8 * fq;
#pragma unroll
            for (int ai = 0; ai < 2; ++ai)
#pragma unroll
                for (int m = 0; m < 4; ++m) { const size_t ro = (size_t)EPI_ROW_(ai, m) * 1024; float r[8], g[8];
#pragma unroll
                    for (int j = 0; j < 8; ++j) { const float ga = sigmoidf_(acc[ai][0][m][j >> 2][j & 3]); g[j] = fmaxf(sigmoidf_(acc[ai][1][m][j >> 2][j & 3]), 8.6736174e-19f); r[j] = ga * frcp(g[j]); }
                    *(u32x4*)(gr + ro) = pack8(r); *(u32x4*)(gbp + ro) = pack8(g); }
        }
    }
};
#define EPI_ROW(ai, m) (u.pm * 256 + (ai) * 128 + wr * 64 + (m) * 16 + fr)
#define EPI_LOAD_RS(rs) float rs8[2][4]; _Pragma("unroll") for (int ai = 0; ai < 2; ++ai) _Pragma("unroll") for (int m = 0; m < 4; ++m) rs8[ai][m] = (rs)[EPI_ROW(ai, m)];
struct EpiQ {
    static constexpr bool PERM = true;
#ifdef PROBE_EPI2
    static constexpr bool PROBE2 = (PROBE_EPI2 == 1);
#endif
    unsigned char* ws;
    __device__ __forceinline__ void operator()(const f32x4 (&acc)[2][2][4][2], const pg8::Unit& u, int wr, int wc, int fr, int fq) const {
        bf16_t* qb = (bf16_t*)(ws + WS_QB); const float* rs = (const float*)(ws + WS_RSTDQ); const f32x2* rope = (const f32x2*)(ws + WS_ROPE);
        EPI_LOAD_RS(rs)
        EPI_WALK({ const int col = u.pn * 256 + cw; const int w = col % 96; const float r = rs8[ai][m];
                   _Pragma("unroll") for (int j = 0; j < 8; ++j) v[j] *= r;
                   if (w >= 64) rope8(v, rope + (size_t)(row & (SEQ - 1)) * 16, (w - 64) >> 1);
#ifdef KEEP_BF16_IMAGES
                   *(u32x4*)(qb + (size_t)row * 768 + col) = pack8(v);
#endif
                   *(u32x2*)(ws + WS_Q8 + (size_t)row * 768 + col) = (u32x2){pack4_fp8(v[0] * 16.f, v[1] * 16.f, v[2] * 16.f, v[3] * 16.f), pack4_fp8(v[4] * 16.f, v[5] * 16.f, v[6] * 16.f, v[7] * 16.f)}; })
    }
};
struct EpiKV {
    static constexpr bool PERM = true;
#ifdef PROBE_EPI2
    static constexpr bool PROBE2 = (PROBE_EPI2 == 2);
#endif
    unsigned char* ws;
    __device__ __forceinline__ void operator()(const f32x4 (&acc)[2][2][4][2], const pg8::Unit& u, int wr, int wc, int fr, int fq) const {
        const float* rs = (const float*)(ws + WS_RSTDKV); bf16_t* kimg = (bf16_t*)(ws + WS_KIMG); bf16_t* vimg = (bf16_t*)(ws + WS_VIMG);
        EPI_LOAD_RS(rs)
        EPI_WALK({ const float r = rs8[ai][m];
                   _Pragma("unroll") for (int j = 0; j < 8; ++j) v[j] *= r;
                   const int col = (u.pn & 1) * 256 + cw, h = col >> 6, b = row >> 14, sq = row & (SEQ - 1), tile = sq >> 6, rr = sq & 63; const size_t tb = (size_t)((b * 8 + h) * 256 + tile);
                   if (u.pn < 2) {
#ifdef KEEP_BF16_IMAGES
                       *(u32x4*)(kimg + tb * 6144 + ((col & 63) >> 3) * 512 + rr * 8) = pack8(v);
#endif
                       *(u32x2*)(ws + WS_K8 + tb * 6144 + ((col & 63) >> 4) * 1024 + rr * 16 + (col & 8)) = (u32x2){pack4_fp8(v[0], v[1], v[2], v[3]), pack4_fp8(v[4], v[5], v[6], v[7])}; }
                   else *(u32x4*)(vimg + tb * 4096 + ((col & 63) >> 5) * 2048 + rr * 32 + (col & 31)) = pack8(v); })
    }
};
template <bool SECOND> struct EpiGate {
    static constexpr bool PERM = true;
#ifdef PROBE_EPI2
    static constexpr bool PROBE2 = (PROBE_EPI2 == 3);
#endif
    unsigned char* ws;
    __device__ __forceinline__ void operator()(const f32x4 (&acc)[2][2][4][2], const pg8::Unit& u, int wr, int wc, int fr, int fq) const {
        bf16_t* mg = (bf16_t*)(ws + WS_MERGED); const bf16_t* gt = (const bf16_t*)(ws + (SECOND ? WS_GB : WS_GA));
#pragma unroll
        for (int ai = 0; ai < 2; ++ai) {
            u32x4 gw[4][2], pw[4][2];
#pragma unroll
            for (int m = 0; m < 4; ++m)
#pragma unroll
                for (int bj = 0; bj < 2; ++bj) { const size_t o = (size_t)EPI_ROW(ai, m) * 1024 + u.pn * 256 + bj * 128 + wc * 32 + 8 * fq; gw[m][bj] = *(const u32x4*)(gt + o); if (SECOND) pw[m][bj] = *(const u32x4*)(mg + o); }
#pragma unroll
            for (int m = 0; m < 4; ++m)
#pragma unroll
                for (int bj = 0; bj < 2; ++bj) { const size_t o = (size_t)EPI_ROW(ai, m) * 1024 + u.pn * 256 + bj * 128 + wc * 32 + 8 * fq;
                    float v[8] = {acc[ai][bj][m][0][0], acc[ai][bj][m][0][1], acc[ai][bj][m][0][2], acc[ai][bj][m][0][3], acc[ai][bj][m][1][0], acc[ai][bj][m][1][1], acc[ai][bj][m][1][2], acc[ai][bj][m][1][3]};
                    float g[8]; unpack8(gw[m][bj], g);
                    if (SECOND) { float p[8]; unpack8(pw[m][bj], p); _Pragma("unroll") for (int j = 0; j < 8; ++j) v[j] = p[j] + g[j] * v[j]; }
                    else { _Pragma("unroll") for (int j = 0; j < 8; ++j) v[j] = g[j] * v[j]; }
                    *(u32x4*)(mg + o) = pack8(v); }
            asm volatile("" ::: "memory");
        }
    }
};
struct EpiGateFused {
    static constexpr bool PERM = true;
#ifdef PROBE_EPI2
    static constexpr bool PROBE2 = false;
#endif
    unsigned char* ws;
    __device__ __forceinline__ void operator()(const f32x4 (&acc_)[2][2][4][2], const pg8::Unit& u, int wr, int wc, int fr, int fq) const {
        f32x4 (&acc)[2][2][4][2] = const_cast<f32x4 (&)[2][2][4][2]>(acc_);
        bf16_t* mg = (bf16_t*)(ws + WS_MERGED); const bf16_t* gt = (const bf16_t*)(ws + (u.e ? WS_GB : WS_GA));
#pragma unroll
        for (int ai = 0; ai < 2; ++ai) {
            u32x4 gw[4][2];
#pragma unroll
            for (int m = 0; m < 4; ++m)
#pragma unroll
                for (int bj = 0; bj < 2; ++bj) { const size_t o = (size_t)EPI_ROW(ai, m) * 1024 + u.pn * 256 + bj * 128 + wc * 32 + 8 * fq; gw[m][bj] = *(const u32x4*)(gt + o); }
#pragma unroll
            for (int m = 0; m < 4; ++m)
#pragma unroll
                for (int bj = 0; bj < 2; ++bj) { const size_t o = (size_t)EPI_ROW(ai, m) * 1024 + u.pn * 256 + bj * 128 + wc * 32 + 8 * fq;
                    float g[8]; unpack8(gw[m][bj], g);
                    if (u.e == 0) {
#pragma unroll
                        for (int j = 0; j < 8; ++j) acc[ai][bj][m][j >> 2][j & 3] *= g[j];
                    } else { float v[8];
#pragma unroll
#ifdef WO_FP8
                        for (int j = 0; j < 8; ++j) v[j] = (32.f * g[j]) * acc[ai][bj][m][j >> 2][j & 3];
                        *(u32x2*)((unsigned char*)mg + o) = (u32x2){pack4_fp8(v[0], v[1], v[2], v[3]), pack4_fp8(v[4], v[5], v[6], v[7])}; } }
#else
                        for (int j = 0; j < 8; ++j) v[j] = g[j] * acc[ai][bj][m][j >> 2][j & 3];
                        *(u32x4*)(mg + o) = pack8(v); } }
#endif
            asm volatile("" ::: "memory");
        }
    }
};
struct EpiResid {
    static constexpr bool PERM = true;
#ifdef PROBE_EPI2
    static constexpr bool PROBE2 = (PROBE_EPI2 == 4);
#endif
    unsigned char* ws; const float* x; float* x1;
    __device__ __forceinline__ void operator()(const f32x4 (&acc)[2][2][4][2], const pg8::Unit& u, int wr, int wc, int fr, int fq) const {
        bf16_t* h2 = (bf16_t*)(ws + WS_H2);
#pragma unroll
        for (int ai = 0; ai < 2; ++ai) {
            f32x4 xa[4][2][2];
#pragma unroll
            for (int m = 0; m < 4; ++m)
#pragma unroll
                for (int bj = 0; bj < 2; ++bj) { const size_t o = (size_t)EPI_ROW(ai, m) * 1024 + u.pn * 256 + bj * 128 + wc * 32 + 8 * fq; xa[m][bj][0] = *(const f32x4*)(x + o); xa[m][bj][1] = *(const f32x4*)(x + o + 4); }
#pragma unroll
            for (int m = 0; m < 4; ++m)
#pragma unroll
                for (int bj = 0; bj < 2; ++bj) { const size_t o = (size_t)EPI_ROW(ai, m) * 1024 + u.pn * 256 + bj * 128 + wc * 32 + 8 * fq;
                    const f32x4 r0 = acc[ai][bj][m][0] + xa[m][bj][0], r1 = acc[ai][bj][m][1] + xa[m][bj][1];
                    *(f32x4*)(x1 + o) = r0; *(f32x4*)(x1 + o + 4) = r1;
                    const float v[8] = {r0[0], r0[1], r0[2], r0[3], r1[0], r1[1], r1[2], r1[3]};
                    *(u32x2*)((unsigned char*)h2 + o) = (u32x2){pack4_fp8(v[0], v[1], v[2], v[3]), pack4_fp8(v[4], v[5], v[6], v[7])}; }
            asm volatile("" ::: "memory");
        }
    }
};
struct EpiSwiglu {
    static constexpr bool PERM = true;
#ifdef PROBE_EPI2
    static constexpr bool PROBE2 = (PROBE_EPI2 == 5);
#endif
    unsigned char* ws; const float* bgu;
    __device__ __forceinline__ void operator()(const f32x4 (&acc)[2][2][4][2], const pg8::Unit& u, int wr, int wc, int fr, int fq) const {
        bf16_t* act = (bf16_t*)(ws + WS_ACT); const float* rsc = (const float*)(ws + WS_ROWSCALE);
        const int c0 = u.pn * 128 + wc * 32 + 8 * fq; const float* bg = bgu + (size_t)u.e * 2048 + c0;
        constexpr float CS = -1.702f * LOG2E;
        float bgv[8], buv[8];
#pragma unroll
        for (int j = 0; j < 8; ++j) { bgv[j] = CS * bg[j]; buv[j] = bg[1024 + j]; }
        EPI_LOAD_RS(rsc)
#pragma unroll
        for (int ai = 0; ai < 2; ++ai)
#pragma unroll
            for (int m = 0; m < 4; ++m) {
                const int row = u.pm * 256 + ai * 128 + wr * 64 + m * 16 + fr; const float r = rs8[ai][m], rc = CS * r; float o[8];
#pragma unroll
                for (int j = 0; j < 8; ++j) { const float a0 = __builtin_fmaf(acc[ai][0][m][j >> 2][j & 3], rc, bgv[j]), u0 = __builtin_fmaf(acc[ai][1][m][j >> 2][j & 3], r, buv[j]);
                    const float a = fmaxf(a0, 7.f * CS), up = __builtin_amdgcn_fmed3f(u0, -7.f, 7.f);
                    const float t = a * frcp(1.f + fexp2(a));
                    o[j] = __builtin_fmaf(up, t, t); }
                *(u32x2*)((unsigned char*)act + (size_t)row * 1024 + c0) = (u32x2){pack4_fp8(o[0], o[1], o[2], o[3]), pack4_fp8(o[4], o[5], o[6], o[7])};
            }
    }
};
struct EpiDown {
    static constexpr bool PERM = true;
#ifdef PROBE_EPI2
    static constexpr bool PROBE2 = (PROBE_EPI2 == 6);
#endif
    unsigned char* ws; const float* bd;
    __device__ __forceinline__ void operator()(const f32x4 (&acc)[2][2][4][2], const pg8::Unit& u, int wr, int wc, int fr, int fq) const {
        unsigned char* y = ws + WS_Y; const float* b = bd + (size_t)u.e * 1024 + u.pn * 256 + wc * 32 + 8 * fq;
        float bv[2][8];
#pragma unroll
        for (int bj = 0; bj < 2; ++bj) { const f32x4 b0 = *(const f32x4*)(b + bj * 128), b1 = *(const f32x4*)(b + bj * 128 + 4);
            bv[bj][0] = 16.f * b0.x; bv[bj][1] = 16.f * b0.y; bv[bj][2] = 16.f * b0.z; bv[bj][3] = 16.f * b0.w; bv[bj][4] = 16.f * b1.x; bv[bj][5] = 16.f * b1.y; bv[bj][6] = 16.f * b1.z; bv[bj][7] = 16.f * b1.w; }
        EPI_WALK({ _Pragma("unroll") for (int j = 0; j < 8; ++j) v[j] = __builtin_fmaf(16.f, v[j], bv[bj][j]);
                   *(u32x2*)(y + (size_t)row * 1024 + u.pn * 256 + cw) = (u32x2){pack4_fp8(v[0], v[1], v[2], v[3]), pack4_fp8(v[4], v[5], v[6], v[7])}; })
    }
};

typedef short v4i16_t __attribute__((ext_vector_type(4)));
__device__ __forceinline__ s16x4 vtr(const LAS char* p) { return __builtin_bit_cast(s16x4, __builtin_amdgcn_ds_read_tr16_b64_v4i16((LAS v4i16_t*)p)); }
__device__ __forceinline__ float swapmax(float m) { auto rr = __builtin_amdgcn_permlane32_swap(__float_as_uint(m), __float_as_uint(m), false, false); return fmaxf(__uint_as_float(rr[0]), __uint_as_float(rr[1])); }
__device__ __forceinline__ float swapsum(float m) { auto rr = __builtin_amdgcn_permlane32_swap(__float_as_uint(m), __float_as_uint(m), false, false); return __uint_as_float(rr[0]) + __uint_as_float(rr[1]); }

struct AttnState { f32x16 o0, o1; float m, l; };

struct MlaKL {
    const bf16_t* K; const bf16_t* V;
    template <int D0> __device__ __forceinline__ bf16x8 kfrag(int c, int r32, int hi) const { return *(const bf16x8*)(K + (size_t)(c >> 1) * 6144 + (2 * D0 + hi) * 512 + ((c & 1) * 32 + r32) * 8); }
    __device__ __forceinline__ u32x4 vpiece(int c, int row, int c8) const { return *(const u32x4*)(V + (size_t)(c >> 1) * 4096 + (c8 >> 2) * 2048 + ((c & 1) * 32 + row) * 32 + (c8 & 3) * 8); }
    __device__ __forceinline__ void modify(int, f32x16&, int, int) const {}
    __device__ __forceinline__ int order(int i) const { return i; }
};
__device__ __forceinline__ bf16x8 fp8x8_to_bf16(u32x2 w, float sc) {
    const f32x2 a = __builtin_amdgcn_cvt_pk_f32_fp8((int)w.x, false), b = __builtin_amdgcn_cvt_pk_f32_fp8((int)w.x, true), c = __builtin_amdgcn_cvt_pk_f32_fp8((int)w.y, false), d = __builtin_amdgcn_cvt_pk_f32_fp8((int)w.y, true);
    const u32x4 o = {cvtpk(a.x * sc, a.y * sc), cvtpk(b.x * sc, b.y * sc), cvtpk(c.x * sc, c.y * sc), cvtpk(d.x * sc, d.y * sc)};
    return __builtin_bit_cast(bf16x8, o);
}
struct MlaKL8 {
    const unsigned char* K; const bf16_t* V;
    template <int D0> __device__ __forceinline__ bf16x8 kfrag(int c, int r32, int hi) const { return fp8x8_to_bf16(*(const u32x2*)(K + (size_t)(c >> 1) * 6144 + D0 * 1024 + ((c & 1) * 32 + r32) * 16 + hi * 8), 1.f); }
    __device__ __forceinline__ u32x4 vpiece(int c, int row, int c8) const { return *(const u32x4*)(V + (size_t)(c >> 1) * 4096 + (c8 >> 2) * 2048 + ((c & 1) * 32 + row) * 32 + (c8 & 3) * 8); }
    __device__ __forceinline__ void modify(int, f32x16&, int, int) const {}
    __device__ __forceinline__ int order(int i) const { return i; }
};
struct DilKL {
    const bf16_t* K; const bf16_t* V;
    int dil, res, u0, L; float slope2d;
    __device__ __forceinline__ size_t tok(int c, int kk) const { int v = u0 - 64 + 32 * c + kk; v = v < 0 ? 0 : (v >= L ? L - 1 : v); return (size_t)(res + dil * v); }
    template <int D0> __device__ __forceinline__ bf16x8 kfrag(int c, int r32, int hi) const { return *(const bf16x8*)(K + tok(c, r32) * 512 + 16 * D0 + 8 * hi); }
    __device__ __forceinline__ u32x4 vpiece(int c, int row, int c8) const { return *(const u32x4*)(V + tok(c, row) * 512 + 8 * c8); }
    __device__ __forceinline__ void modify(int c, f32x16& s, int r32, int hi) const {
        const float c0 = (float)(32 * c - 64); const int vb = u0 - 64 + 32 * c;
#pragma unroll
        for (int r = 0; r < 16; ++r) { const float d = (float)(crow(r, hi) - r32); s[r] = s[r] - slope2d * fabsf(d + c0); }
        if (c == 0) {
#pragma unroll
            for (int r = 0; r < 16; ++r) s[r] = (crow(r, hi) >= r32) ? s[r] : -1e30f; }
        if (c == 4) {
#pragma unroll
            for (int r = 0; r < 16; ++r) s[r] = (crow(r, hi) <= r32) ? s[r] : -1e30f; }
        if (vb < 0 || vb + 31 >= L) {
#pragma unroll
            for (int r = 0; r < 16; ++r) { const int v = vb + crow(r, hi); s[r] = (v >= 0 && v < L) ? s[r] : -1e30f; } }
    }
    __device__ __forceinline__ int order(int i) const { return i == 0 ? 2 : i == 1 ? 1 : i == 2 ? 3 : i == 3 ? 0 : 4; }
};

template <int NDK, class KL> __device__ __forceinline__ void attn_load_k(bf16x8 (&kf)[NDK], const KL& kl, int c, int r32, int hi) {
    kf[0] = kl.template kfrag<0>(c, r32, hi); kf[1] = kl.template kfrag<1>(c, r32, hi); kf[2] = kl.template kfrag<2>(c, r32, hi); kf[3] = kl.template kfrag<3>(c, r32, hi);
    if constexpr (NDK == 6) { kf[4] = kl.template kfrag<4>(c, r32, hi); kf[5] = kl.template kfrag<5>(c, r32, hi); }
}
template <class KL> __device__ __forceinline__ void attn_load_v(u32x4 (&vp)[4], const KL& kl, int c, int lane) {
#pragma unroll
    for (int i = 0; i < 4; ++i) { const int p = lane + 64 * i; vp[i] = kl.vpiece(c, p >> 3, p & 7); }
}
__device__ __forceinline__ void attn_store_v(const u32x4 (&vp)[4], LAS char* vimg, int lane) {
#pragma unroll
    for (int i = 0; i < 4; ++i) { const int p = lane + 64 * i, row = p >> 3, c8 = p & 7; *(LAS u32x4*)(vimg + (c8 >> 2) * 2048 + row * 64 + (c8 & 3) * 16) = vp[i]; }
}
template <int NDK, class KL> __device__ __forceinline__ void attn_core(AttnState& st, const bf16x8 (&qf)[NDK], const bf16x8 (&kf)[NDK], const KL& kl, int c, LAS char* vimg, LAS float* wsf, int lane, int r32, int hi) {
    f32x16 s = {};
#pragma unroll
    for (int d0 = 0; d0 < NDK; ++d0) s = __builtin_amdgcn_mfma_f32_32x32x16_bf16(kf[d0], qf[d0], s, 0, 0, 0);
    kl.modify(c, s, r32, hi);
    float mx = s[0];
#pragma unroll
    for (int r = 1; r < 16; ++r) mx = fmaxf(mx, s[r]);
    mx = swapmax(mx);
    const float mn = fmaxf(st.m, mx), alpha = fexp2(st.m - mn);
    float ps = 0.f;
#pragma unroll
    for (int r = 0; r < 16; ++r) { s[r] = fexp2(s[r] - mn); ps += s[r]; }
    st.l = st.l * alpha + ps; st.m = mn;
    if (__any(alpha != 1.f)) {
        if (hi == 0) wsf[r32] = alpha;
#pragma unroll
        for (int r = 0; r < 16; ++r) { const float a = wsf[crow(r, hi)]; st.o0[r] *= a; st.o1[r] *= a; }
    }
    const u32x4 pw0 = {cvtpk(s[0], s[1]), cvtpk(s[2], s[3]), cvtpk(s[4], s[5]), cvtpk(s[6], s[7])};
    const u32x4 pw1 = {cvtpk(s[8], s[9]), cvtpk(s[10], s[11]), cvtpk(s[12], s[13]), cvtpk(s[14], s[15])};
    const bf16x8 pa0 = __builtin_bit_cast(bf16x8, pw0), pa1 = __builtin_bit_cast(bf16x8, pw1);
    const LAS char* vp = vimg + ((lane >> 4) & 1) * 32 + (lane & 3) * 8 + (4 * hi + ((lane & 15) >> 2)) * 64;
#pragma unroll
    for (int ks = 0; ks < 2; ++ks) {
        const s16x4 l0 = vtr(vp + ks * 1024), h0 = vtr(vp + ks * 1024 + 512), l1 = vtr(vp + 2048 + ks * 1024), h1 = vtr(vp + 2048 + ks * 1024 + 512);
        const bf16x8 v0 = {l0[0], l0[1], l0[2], l0[3], h0[0], h0[1], h0[2], h0[3]}, v1 = {l1[0], l1[1], l1[2], l1[3], h1[0], h1[1], h1[2], h1[3]};
        st.o0 = __builtin_amdgcn_mfma_f32_32x32x16_bf16(ks == 0 ? pa0 : pa1, v0, st.o0, 0, 0, 0);
        st.o1 = __builtin_amdgcn_mfma_f32_32x32x16_bf16(ks == 0 ? pa0 : pa1, v1, st.o1, 0, 0, 0);
    }
}
template <int NDK, class KL> __device__ __forceinline__ void wave_attn(AttnState& st, const bf16x8 (&qf)[NDK], const KL& kl, int nchunk, LAS char* vimg, LAS float* wsf, int lane) {
    const int r32 = lane & 31, hi = lane >> 5;
    st.o0 = f32x16{}; st.o1 = f32x16{}; st.m = -1e30f; st.l = 0.f;
    bf16x8 kfa[NDK], kfb[NDK]; u32x4 vp[4];
    attn_load_k<NDK>(kfa, kl, kl.order(0), r32, hi); attn_load_v(vp, kl, kl.order(0), lane);
    asm volatile("" : "+s"(nchunk));
#pragma unroll 1
    for (int c = 0; c < nchunk; c += 2) {
        attn_store_v(vp, vimg, lane);
        if (c + 1 < nchunk) { attn_load_k<NDK>(kfb, kl, kl.order(c + 1), r32, hi); attn_load_v(vp, kl, kl.order(c + 1), lane); }
        attn_core<NDK>(st, qf, kfa, kl, kl.order(c), vimg, wsf, lane, r32, hi);
        if (c + 1 < nchunk) {
            attn_store_v(vp, vimg, lane);
            if (c + 2 < nchunk) { attn_load_k<NDK>(kfa, kl, kl.order(c + 2), r32, hi); attn_load_v(vp, kl, kl.order(c + 2), lane); }
            attn_core<NDK>(st, qf, kfb, kl, kl.order(c + 1), vimg, wsf, lane, r32, hi);
        }
    }
}
__device__ __forceinline__ float attn_finish(AttnState& st, LAS char* vimg, LAS float* wsf, int lane) {
    const int r32 = lane & 31, hi = lane >> 5;
    const float lt = swapsum(st.l);
    if (hi == 0) wsf[32 + r32] = lt;
    LAS bf16_t* stg = (LAS bf16_t*)vimg;
#pragma unroll
    for (int r = 0; r < 16; ++r) { const int q = crow(r, hi); const float il = frcp(wsf[32 + q]);
        stg[q * 64 + r32] = (bf16_t)f2bf(st.o0[r] * il); stg[q * 64 + 32 + r32] = (bf16_t)f2bf(st.o1[r] * il); }
    return lt;
}

namespace mla {
constexpr int NW = 8, QBLK = 32, QB = 256, KVBLK = 64, NT = SEQ / KVBLK;
constexpr int KSLOT = 12288, VSLOT = 8192, LDS_K = 0, LDS_V = 3 * KSLOT, LDS_WS = LDS_V + 3 * VSLOT, LDS_OST = LDS_WS + NW * 256, LDS_BYTES_ = LDS_OST + NW * 4096;
#define SBAR() __builtin_amdgcn_sched_barrier(0)
#define WAIT_BAR(N) asm volatile("s_waitcnt vmcnt(" #N ") lgkmcnt(0)\n\ts_barrier" ::: "memory")
__device__ __forceinline__ void glds16(const void* gsrc, unsigned lds_dst) { unsigned keep;
    asm volatile("s_mov_b32 %0, m0\n\ts_mov_b32 m0, %2\n\ts_nop 0\n\tglobal_load_lds_dwordx4 %1, off\n\ts_mov_b32 m0, %0" : "=&s"(keep) : "v"(gsrc), "s"(lds_dst) : "memory"); }
typedef LAS const char* lds_cptr;
__device__ __forceinline__ void kload2(bf16x8* kf, lds_cptr kp, int j) { kf[2 * j] = *(const LAS bf16x8*)(kp + j * 2048); kf[2 * j + 1] = *(const LAS bf16x8*)(kp + j * 2048 + 512); }

__device__ __forceinline__ void mla_unit(int b, int h, int qb, const bf16_t* Q, const bf16_t* __restrict__ Kim, const bf16_t* __restrict__ Vim, bf16_t* O, LAS char* shm) {
    const int tid = threadIdx.x, lane = tid & 63, r32 = lane & 31, hi = lane >> 5; const int wid = __builtin_amdgcn_readfirstlane(tid >> 6);
    const long rowbase = (long)b * SEQ; const int q0 = qb * QB;
    const bf16_t* Qw = Q + (rowbase + q0 + wid * QBLK) * 768 + h * 96;
    const unsigned lds0 = (unsigned)(uintptr_t)shm;
    LAS float* wsf = (LAS float*)(shm + LDS_WS) + wid * 64;
    const bf16_t* ksrc = Kim + wid * 512 + lane * 8;
    const bf16_t* rsrc = Kim + (8 + (wid & 3)) * 512 + lane * 8;
    const bf16_t* vsrc = Vim + wid * 512 + lane * 8;
    const unsigned kdst = lds0 + LDS_K + wid * 1024, rdst = lds0 + LDS_K + (8 + (wid & 3)) * 1024, vdst = lds0 + LDS_V + wid * 1024;
#define DMA_K(t, ks) do { glds16(ksrc + (long)(t) * 6144, (unsigned)__builtin_amdgcn_readfirstlane(kdst + (ks))); glds16(rsrc + (long)(t) * 6144, (unsigned)__builtin_amdgcn_readfirstlane(rdst + (ks))); } while (0)
#define DMA_V(t, vs) glds16(vsrc + (long)(t) * 4096, (unsigned)__builtin_amdgcn_readfirstlane(vdst + (vs)))
    const lds_cptr shm3 = (lds_cptr)shm; const lds_cptr kp0 = shm3 + LDS_K + hi * 1024 + r32 * 16;
    const lds_cptr vp0 = shm3 + LDS_V + ((lane >> 4) & 1) * 32 + (lane & 3) * 8 + (4 * hi + ((lane & 15) >> 2)) * 64;
    bf16x8 kf[12];
    DMA_K(0, 0); DMA_V(0, 0); DMA_K(1, KSLOT);
    bf16x8 qr[6];
#pragma unroll
    for (int d0 = 0; d0 < 6; ++d0) qr[d0] = *reinterpret_cast<const bf16x8*>(&Qw[(long)r32 * 768 + d0 * 16 + hi * 8]);
    float l_reg = 0.f; f32x16 o[2]; o[0] = f32x16{}; o[1] = f32x16{};
    f32x16 pA0, pA1, pB0, pB1;
    int si_prev = 0, si_cur = 0, si_next = 1;
#define ROT() do { si_prev = si_cur; si_cur = si_next; si_next = (si_next == 2) ? 0 : si_next + 1; } while (0)
    DMA_K(2, 2 * KSLOT);
    WAIT_BAR(5);
    { const lds_cptr kb = kp0;
#pragma unroll
      for (int d0 = 0; d0 < 6; ++d0) { const bf16x8 b0 = *(const LAS bf16x8*)(kb + d0 * 2048), b1 = *(const LAS bf16x8*)(kb + d0 * 2048 + 512);
          if (d0 == 0) { pA0 = __builtin_amdgcn_mfma_f32_32x32x16_bf16(b0, qr[0], f32x16{}, 0, 0, 0); pA1 = __builtin_amdgcn_mfma_f32_32x32x16_bf16(b1, qr[0], f32x16{}, 0, 0, 0); }
          else { pA0 = __builtin_amdgcn_mfma_f32_32x32x16_bf16(b0, qr[d0], pA0, 0, 0, 0); pA1 = __builtin_amdgcn_mfma_f32_32x32x16_bf16(b1, qr[d0], pA1, 0, 0, 0); } } }
#pragma unroll
    for (int r = 0; r < 16; ++r) { pA0[r] = __builtin_amdgcn_exp2f(pA0[r]); pA1[r] = __builtin_amdgcn_exp2f(pA1[r]); }
    WAIT_BAR(0);
    DMA_K(3, 0); DMA_V(1, VSLOT);
    ROT();
#pragma unroll
    for (int j = 0; j < 6; ++j) kload2(kf, kp0 + si_cur * KSLOT, j);
    WAIT_BAR(3);
    s16x4 vlo[8], vhi[8]; u32x4 pw0, pw1, pw2, pw3;
#define PKW(P, B) cvtpk(P[B], P[B + 1])
#define PAF(k) __builtin_bit_cast(bf16x8, pw##k)
#define VFR(i) (bf16x8){vlo[i][0], vlo[i][1], vlo[i][2], vlo[i][3], vhi[i][0], vhi[i][1], vhi[i][2], vhi[i][3]}
#define PIN(x) asm volatile("" : "+v"(x))
#define MF(a, b, c) __builtin_amdgcn_mfma_f32_32x32x16_bf16(a, b, c, 0, 0, 0)
#define GAPA(MFX, A0, A1, A2, A3, W0, W1, PW) do { MFX; sacc += A0; sacc += A1; sacc += A2; sacc += A3; PIN(sacc); W0; W1; PIN(PW); SBAR(); } while (0)
#define GAPM(MFX) do { MFX; SBAR(); } while (0)
#define EX(v) __builtin_amdgcn_exp2f(v)
#define GAPB(MFX, X, B) do { MFX; X[B] = EX(X[B]); X[B + 1] = EX(X[B + 1]); X[B + 2] = EX(X[B + 2]); X[B + 3] = EX(X[B + 3]); PIN(X); SBAR(); } while (0)
#define VRD(i) do { vlo[i] = vtr(vp_ + (((i) >> 2) * 4096 + ((i) & 3) * 1024)); vhi[i] = vtr(vp_ + (((i) >> 2) * 4096 + ((i) & 3) * 1024 + 512)); } while (0)
#define KRD(G, j) do { if (G) { kload2(kf, kp0 + si_next * KSLOT, j); SBAR(); } } while (0)
#define STEP(C0, C1, P0, P1, t, GK, GV, GL) do { SBAR(); \
    const lds_cptr vp_ = vp0 + si_prev * VSLOT; \
    VRD(0); SBAR(); float sacc = (P0[0] + P0[1]); \
    GAPA(C0 = MF(kf[0], qr[0], f32x16{}), P0[2], P0[3], P0[4], P0[5],     pw0[0] = PKW(P0, 0),  pw0[1] = PKW(P0, 2),  pw0); \
    VRD(4); SBAR(); GAPA(C1 = MF(kf[1], qr[0], f32x16{}), P0[6], P0[7], P0[8], P0[9],     pw0[2] = PKW(P0, 4),  pw0[3] = PKW(P0, 6),  pw0); \
    VRD(1); SBAR(); GAPA(C0 = MF(kf[2], qr[1], C0),   P0[10], P0[11], P0[12], P0[13], pw1[0] = PKW(P0, 8),  pw1[1] = PKW(P0, 10), pw1); \
    VRD(5); SBAR(); GAPA(C1 = MF(kf[3], qr[1], C1),   P0[14], P0[15], P1[0], P1[1],   pw1[2] = PKW(P0, 12), pw1[3] = PKW(P0, 14), pw1); \
    VRD(2); SBAR(); GAPA(C0 = MF(kf[4], qr[2], C0),   P1[2], P1[3], P1[4], P1[5],     pw2[0] = PKW(P1, 0),  pw2[1] = PKW(P1, 2),  pw2); \
    VRD(6); SBAR(); GAPA(C1 = MF(kf[5], qr[2], C1),   P1[6], P1[7], P1[8], P1[9],     pw2[2] = PKW(P1, 4),  pw2[3] = PKW(P1, 6),  pw2); \
    VRD(3); SBAR(); GAPA(C0 = MF(kf[6], qr[3], C0),   P1[10], P1[11], P1[12], P1[13], pw3[0] = PKW(P1, 8),  pw3[1] = PKW(P1, 10), pw3); \
    VRD(7); SBAR(); GAPA(C1 = MF(kf[7], qr[3], C1),   P1[14], P1[15], 0.f, 0.f,       pw3[2] = PKW(P1, 12), pw3[3] = PKW(P1, 14), pw3); \
    GAPM(C0 = MF(kf[8], qr[4], C0)); GAPM(C1 = MF(kf[9], qr[4], C1)); GAPM(C0 = MF(kf[10], qr[5], C0)); GAPM(C1 = MF(kf[11], qr[5], C1)); \
    l_reg += sacc; \
    if (GK) { DMA_K((t) + 3, si_cur * KSLOT); } if (GV) { DMA_V((t) + 1, si_next * VSLOT); } \
    SBAR(); \
    GAPB(o[0] = MF(PAF(0), VFR(0), o[0]), C0, 0); \
    GAPB(o[1] = MF(PAF(0), VFR(4), o[1]), C0, 4); \
    KRD(GL, 0); GAPB(o[0] = MF(PAF(1), VFR(1), o[0]), C0, 8); \
    KRD(GL, 1); GAPB(o[1] = MF(PAF(1), VFR(5), o[1]), C0, 12); \
    KRD(GL, 2); GAPB(o[0] = MF(PAF(2), VFR(2), o[0]), C1, 0); \
    KRD(GL, 3); GAPB(o[1] = MF(PAF(2), VFR(6), o[1]), C1, 4); \
    KRD(GL, 4); GAPB(o[0] = MF(PAF(3), VFR(3), o[0]), C1, 8); \
    KRD(GL, 5); GAPB(o[1] = MF(PAF(3), VFR(7), o[1]), C1, 12); \
    } while (0)
    int t = 1;
    for (; t + 5 < NT; t += 2) {
        STEP(pB0, pB1, pA0, pA1, t, true, true, true);     WAIT_BAR(3); ROT();
        STEP(pA0, pA1, pB0, pB1, t + 1, true, true, true); WAIT_BAR(3); ROT();
    }
#define ENDW(tt) do { if ((tt) + 3 < NT) { WAIT_BAR(3); } else if ((tt) + 2 < NT) { WAIT_BAR(1); } else { WAIT_BAR(0); } } while (0)
    for (; t + 1 < NT; t += 2) {
        STEP(pB0, pB1, pA0, pA1, t, (t + 3 < NT), (t + 1 < NT), (t + 1 < NT));         ENDW(t);     ROT();
        STEP(pA0, pA1, pB0, pB1, t + 1, (t + 4 < NT), (t + 2 < NT), (t + 2 < NT));     ENDW(t + 1); ROT();
    }
    STEP(pB0, pB1, pA0, pA1, NT - 1, false, false, false);
    { float sacc = pB0[0] + pB0[1];
#pragma unroll
      for (int r = 2; r < 16; ++r) sacc += pB0[r];
#pragma unroll
      for (int r = 0; r < 16; ++r) sacc += pB1[r];
      l_reg += sacc;
      pw0 = (u32x4){PKW(pB0, 0), PKW(pB0, 2), PKW(pB0, 4), PKW(pB0, 6)}; pw1 = (u32x4){PKW(pB0, 8), PKW(pB0, 10), PKW(pB0, 12), PKW(pB0, 14)};
      pw2 = (u32x4){PKW(pB1, 0), PKW(pB1, 2), PKW(pB1, 4), PKW(pB1, 6)}; pw3 = (u32x4){PKW(pB1, 8), PKW(pB1, 10), PKW(pB1, 12), PKW(pB1, 14)};
      SBAR();
      const lds_cptr vp_ = vp0 + si_cur * VSLOT;
#pragma unroll
      for (int d0 = 0; d0 < 2; ++d0) {
          s16x4 lo4[4], hi4[4];
#pragma unroll
          for (int ks = 0; ks < 4; ++ks) { lo4[ks] = vtr(vp_ + d0 * 4096 + ks * 1024); hi4[ks] = vtr(vp_ + d0 * 4096 + ks * 1024 + 512); }
#define PK4(k) (bf16x8){lo4[k][0], lo4[k][1], lo4[k][2], lo4[k][3], hi4[k][0], hi4[k][1], hi4[k][2], hi4[k][3]}
          o[d0] = MF(PAF(0), PK4(0), o[d0]); o[d0] = MF(PAF(1), PK4(1), o[d0]); o[d0] = MF(PAF(2), PK4(2), o[d0]); o[d0] = MF(PAF(3), PK4(3), o[d0]);
#undef PK4
      } }
    l_reg = swapsum(l_reg);
    if (hi == 0) wsf[32 + r32] = l_reg;
    asm volatile("s_waitcnt lgkmcnt(0)" ::: "memory");
    float rli[16];
#pragma unroll
    for (int r = 0; r < 16; ++r) rli[r] = __builtin_amdgcn_rcpf(wsf[32 + crow(r, hi)]);
    bf16_t* Ow = O + (rowbase + q0 + wid * QBLK) * 512 + h * 64;
    { LAS bf16_t* stg = (LAS bf16_t*)(shm + LDS_OST) + wid * 2048;
#pragma unroll
      for (int r = 0; r < 16; ++r) { const int orow = crow(r, hi);
#pragma unroll
          for (int d0 = 0; d0 < 2; ++d0) stg[orow * 64 + d0 * 32 + r32] = (bf16_t)f2bf(o[d0][r] * rli[r]); }
      asm volatile("s_waitcnt lgkmcnt(0)" ::: "memory");
#pragma unroll
      for (int i = 0; i < 4; ++i) { const int row = i * 8 + (lane >> 3), ch = lane & 7; const u32x4 v = *(const LAS u32x4*)(stg + row * 64 + ch * 8); *(u32x4*)(Ow + (long)row * 512 + ch * 8) = v; } }
    asm volatile("s_waitcnt lgkmcnt(0)\n\ts_barrier" ::: "memory");
#undef DMA_K
#undef DMA_V
#undef ROT
#undef PKW
#undef PAF
#undef VFR
#undef PIN
#undef MF
#undef GAPA
#undef GAPM
#undef GAPB
#undef EX
#undef VRD
#undef KRD
#undef STEP
#undef ENDW
}
#undef SBAR
#undef WAIT_BAR
}

namespace mla8 {
using mla::glds16; using mla::lds_cptr;
typedef int v8i __attribute__((ext_vector_type(8)));
constexpr int NW = 8, QBLK = 32, QB = 256, KVBLK = 64, NT = SEQ / KVBLK;
constexpr int KSLOT = 6144, VSLOT = 8192, LDS_K = 0, LDS_V = 3 * KSLOT, LDS_WS = LDS_V + 3 * VSLOT, LDS_OST = LDS_WS + NW * 256, LDS_BYTES_ = LDS_OST + NW * 4096;
#define SBAR() __builtin_amdgcn_sched_barrier(0)
#define WAIT_BAR(N) asm volatile("s_waitcnt vmcnt(" #N ") lgkmcnt(0)\n\ts_barrier" ::: "memory")
__device__ __forceinline__ v8i kfrag8(lds_cptr slot, int n, int ks, int r32, int hi) {
    const lds_cptr p = slot + (ks == 0 ? 2 * hi : 4) * 1024 + (32 * n + r32) * 16;
    const u32x4 a = *(const LAS u32x4*)p, b = *(const LAS u32x4*)(p + 1024);
    return (v8i){(int)a.x, (int)a.y, (int)a.z, (int)a.w, (int)b.x, (int)b.y, (int)b.z, (int)b.w};
}
#define MF8(a, b, c) __builtin_amdgcn_mfma_scale_f32_32x32x64_f8f6f4(a, b, c, 0, 0, 0, 0x7f7f7f7f, 0, 0x7b7b7b7b)

__device__ __forceinline__ void mla8_unit(int b, int h, int qb, const unsigned char* Q8, const unsigned char* __restrict__ K8im, const bf16_t* __restrict__ Vim, bf16_t* O, LAS char* shm) {
    const int tid = threadIdx.x, lane = tid & 63, r32 = lane & 31, hi = lane >> 5; const int wid = __builtin_amdgcn_readfirstlane(tid >> 6);
    const long rowbase = (long)b * SEQ; const int q0 = qb * QB;
    const unsigned char* Qw = Q8 + (size_t)(rowbase + q0 + wid * QBLK + r32) * 768 + h * 96;
    const unsigned lds0 = (unsigned)(uintptr_t)shm;
    LAS float* wsf = (LAS float*)(shm + LDS_WS) + wid * 64;
    const int kpc = wid < 6 ? wid : wid - 6;
    const unsigned char* ksrc = K8im + kpc * 1024 + lane * 16;
    const bf16_t* vsrc = Vim + wid * 512 + lane * 8;
    const unsigned kdst = lds0 + LDS_K + kpc * 1024, vdst = lds0 + LDS_V + wid * 1024;
#define DMA_K(t, ks) glds16(ksrc + (long)(t) * 6144, (unsigned)__builtin_amdgcn_readfirstlane(kdst + (ks)))
#define DMA_V(t, vs) glds16(vsrc + (long)(t) * 4096, (unsigned)__builtin_amdgcn_readfirstlane(vdst + (vs)))
    const lds_cptr shm3 = (lds_cptr)shm; const lds_cptr ks0 = shm3 + LDS_K;
    const lds_cptr vp0 = shm3 + LDS_V + ((lane >> 4) & 1) * 32 + (lane & 3) * 8 + (4 * hi + ((lane & 15) >> 2)) * 64;
    v8i kf[4];
    DMA_K(0, 0); DMA_V(0, 0); DMA_K(1, KSLOT);
    v8i qr[2];
    { const u32x4 a = *(const u32x4*)(Qw + 32 * hi), c = *(const u32x4*)(Qw + 32 * hi + 16); qr[0] = (v8i){(int)a.x, (int)a.y, (int)a.z, (int)a.w, (int)c.x, (int)c.y, (int)c.z, (int)c.w};
      u32x4 d = *(const u32x4*)(Qw + 64), e = *(const u32x4*)(Qw + 80); if (hi) { d = (u32x4){0u, 0u, 0u, 0u}; e = d; }
      qr[1] = (v8i){(int)d.x, (int)d.y, (int)d.z, (int)d.w, (int)e.x, (int)e.y, (int)e.z, (int)e.w}; }
    float l_reg = 0.f; f32x16 o[2]; o[0] = f32x16{}; o[1] = f32x16{};
    f32x16 pA0, pA1, pB0, pB1;
    int si_prev = 0, si_cur = 0, si_next = 1;
#define ROT() do { si_prev = si_cur; si_cur = si_next; si_next = (si_next == 2) ? 0 : si_next + 1; } while (0)
    DMA_K(2, 2 * KSLOT);
    WAIT_BAR(3);
    { pA0 = MF8(kfrag8(ks0, 0, 0, r32, hi), qr[0], f32x16{}); pA1 = MF8(kfrag8(ks0, 1, 0, r32, hi), qr[0], f32x16{});
      pA0 = MF8(kfrag8(ks0, 0, 1, r32, hi), qr[1], pA0); pA1 = MF8(kfrag8(ks0, 1, 1, r32, hi), qr[1], pA1); }
#pragma unroll
    for (int r = 0; r < 16; ++r) { pA0[r] = __builtin_amdgcn_exp2f(pA0[r]); pA1[r] = __builtin_amdgcn_exp2f(pA1[r]); }
    WAIT_BAR(0);
    DMA_K(3, 0); DMA_V(1, VSLOT);
    ROT();
    kf[0] = kfrag8(ks0 + si_cur * KSLOT, 0, 0, r32, hi); kf[1] = kfrag8(ks0 + si_cur * KSLOT, 0, 1, r32, hi); kf[2] = kfrag8(ks0 + si_cur * KSLOT, 1, 0, r32, hi); kf[3] = kfrag8(ks0 + si_cur * KSLOT, 1, 1, r32, hi);
    WAIT_BAR(2);
    s16x4 vlo[8], vhi[8]; u32x4 pw0, pw1, pw2, pw3;
#define PKW(P, B) cvtpk(P[B], P[B + 1])
#define PAF(k) __builtin_bit_cast(bf16x8, pw##k)
#define VFR(i) (bf16x8){vlo[i][0], vlo[i][1], vlo[i][2], vlo[i][3], vhi[i][0], vhi[i][1], vhi[i][2], vhi[i][3]}
#define PIN(x) asm volatile("" : "+v"(x))
#define MF(a, b, c) __builtin_amdgcn_mfma_f32_32x32x16_bf16(a, b, c, 0, 0, 0)
#define GAPA(MFX, A0, A1, A2, A3, W0, W1, PW) do { MFX; sacc += A0; sacc += A1; sacc += A2; sacc += A3; PIN(sacc); W0; W1; PIN(PW); SBAR(); } while (0)
#define GAPM(MFX) do { MFX; SBAR(); } while (0)
#define EX(v) __builtin_amdgcn_exp2f(v)
#define GAPB(MFX, X, B) do { MFX; X[B] = EX(X[B]); X[B + 1] = EX(X[B + 1]); X[B + 2] = EX(X[B + 2]); X[B + 3] = EX(X[B + 3]); PIN(X); SBAR(); } while (0)
#define VRD(i) do { vlo[i] = vtr(vp_ + (((i) >> 2) * 4096 + ((i) & 3) * 1024)); vhi[i] = vtr(vp_ + (((i) >> 2) * 4096 + ((i) & 3) * 1024 + 512)); } while (0)
#define KRD(G, j) do { if (G) { kf[j] = kfrag8(ks0 + si_next * KSLOT, (j) >> 1, (j) & 1, r32, hi); SBAR(); } } while (0)
#define GAPA8(MFX, A0, A1, A2, A3, A4, A5, A6, A7, W0, W1, W2, W3, PWa, PWb) do { MFX; sacc += A0; sacc += A1; sacc += A2; sacc += A3; PIN(sacc); W0; W1; PIN(PWa); sacc += A4; sacc += A5; sacc += A6; sacc += A7; PIN(sacc); W2; W3; PIN(PWb); SBAR(); } while (0)
#define STEP(C0, C1, P0, P1, t, GK, GV, GL) do { SBAR(); \
    const lds_cptr vp_ = vp0 + si_prev * VSLOT; \
    VRD(0); VRD(4); SBAR(); float sacc = (P0[0] + P0[1]); \
    GAPA8(C0 = MF8(kf[0], qr[0], f32x16{}), P0[2], P0[3], P0[4], P0[5], P0[6], P0[7], P0[8], P0[9],         pw0[0] = PKW(P0, 0), pw0[1] = PKW(P0, 2), pw0[2] = PKW(P0, 4), pw0[3] = PKW(P0, 6), pw0, pw0); \
    VRD(1); VRD(5); SBAR(); \
    GAPA8(C1 = MF8(kf[2], qr[0], f32x16{}), P0[10], P0[11], P0[12], P0[13], P0[14], P0[15], P1[0], P1[1],   pw1[0] = PKW(P0, 8), pw1[1] = PKW(P0, 10), pw1[2] = PKW(P0, 12), pw1[3] = PKW(P0, 14), pw1, pw1); \
    VRD(2); VRD(6); SBAR(); \
    GAPA8(C0 = MF8(kf[1], qr[1], C0),       P1[2], P1[3], P1[4], P1[5], P1[6], P1[7], P1[8], P1[9],         pw2[0] = PKW(P1, 0), pw2[1] = PKW(P1, 2), pw2[2] = PKW(P1, 4), pw2[3] = PKW(P1, 6), pw2, pw2); \
    VRD(3); VRD(7); SBAR(); \
    GAPA8(C1 = MF8(kf[3], qr[1], C1),       P1[10], P1[11], P1[12], P1[13], P1[14], P1[15], 0.f, 0.f,       pw3[0] = PKW(P1, 8), pw3[1] = PKW(P1, 10), pw3[2] = PKW(P1, 12), pw3[3] = PKW(P1, 14), pw3, pw3); \
    l_reg += sacc; \
    if (GK) { DMA_K((t) + 3, si_cur * KSLOT); } if (GV) { DMA_V((t) + 1, si_next * VSLOT); } \
    SBAR(); \
    GAPB(o[0] = MF(PAF(0), VFR(0), o[0]), C0, 0); \
    GAPB(o[1] = MF(PAF(0), VFR(4), o[1]), C0, 4); \
    KRD(GL, 0); GAPB(o[0] = MF(PAF(1), VFR(1), o[0]), C0, 8); \
    KRD(GL, 1); GAPB(o[1] = MF(PAF(1), VFR(5), o[1]), C0, 12); \
    KRD(GL, 2); GAPB(o[0] = MF(PAF(2), VFR(2), o[0]), C1, 0); \
    KRD(GL, 3); GAPB(o[1] = MF(PAF(2), VFR(6), o[1]), C1, 4); \
    GAPB(o[0] = MF(PAF(3), VFR(3), o[0]), C1, 8); \
    GAPB(o[1] = MF(PAF(3), VFR(7), o[1]), C1, 12); \
    } while (0)
    int t = 1;
    for (; t + 5 < NT; t += 2) {
        STEP(pB0, pB1, pA0, pA1, t, true, true, true);     WAIT_BAR(2); ROT();
        STEP(pA0, pA1, pB0, pB1, t + 1, true, true, true); WAIT_BAR(2); ROT();
    }
#define ENDW(tt) do { if ((tt) + 3 < NT) { WAIT_BAR(2); } else if ((tt) + 2 < NT) { WAIT_BAR(1); } else { WAIT_BAR(0); } } while (0)
    for (; t + 1 < NT; t += 2) {
        STEP(pB0, pB1, pA0, pA1, t, (t + 3 < NT), (t + 1 < NT), (t + 1 < NT));         ENDW(t);     ROT();
        STEP(pA0, pA1, pB0, pB1, t + 1, (t + 4 < NT), (t + 2 < NT), (t + 2 < NT));     ENDW(t + 1); ROT();
    }
    STEP(pB0, pB1, pA0, pA1, NT - 1, false, false, false);
    { float sacc = pB0[0] + pB0[1];
#pragma unroll
      for (int r = 2; r < 16; ++r) sacc += pB0[r];
#pragma unroll
      for (int r = 0; r < 16; ++r) sacc += pB1[r];
      l_reg += sacc;
      pw0 = (u32x4){PKW(pB0, 0), PKW(pB0, 2), PKW(pB0, 4), PKW(pB0, 6)}; pw1 = (u32x4){PKW(pB0, 8), PKW(pB0, 10), PKW(pB0, 12), PKW(pB0, 14)};
      pw2 = (u32x4){PKW(pB1, 0), PKW(pB1, 2), PKW(pB1, 4), PKW(pB1, 6)}; pw3 = (u32x4){PKW(pB1, 8), PKW(pB1, 10), PKW(pB1, 12), PKW(pB1, 14)};
      SBAR();
      const lds_cptr vp_ = vp0 + si_cur * VSLOT;
#pragma unroll
      for (int d0 = 0; d0 < 2; ++d0) {
          s16x4 lo4[4], hi4[4];
#pragma unroll
          for (int ks = 0; ks < 4; ++ks) { lo4[ks] = vtr(vp_ + d0 * 4096 + ks * 1024); hi4[ks] = vtr(vp_ + d0 * 4096 + ks * 1024 + 512); }
#define PK4(k) (bf16x8){lo4[k][0], lo4[k][1], lo4[k][2], lo4[k][3], hi4[k][0], hi4[k][1], hi4[k][2], hi4[k][3]}
          o[d0] = MF(PAF(0), PK4(0), o[d0]); o[d0] = MF(PAF(1), PK4(1), o[d0]); o[d0] = MF(PAF(2), PK4(2), o[d0]); o[d0] = MF(PAF(3), PK4(3), o[d0]);
#undef PK4
      } }
    l_reg = swapsum(l_reg);
    if (hi == 0) wsf[32 + r32] = l_reg;
    asm volatile("s_waitcnt lgkmcnt(0)" ::: "memory");
    float rli[16];
#pragma unroll
    for (int r = 0; r < 16; ++r) rli[r] = __builtin_amdgcn_rcpf(wsf[32 + crow(r, hi)]);
    bf16_t* Ow = O + (rowbase + q0 + wid * QBLK) * 512 + h * 64;
    { LAS bf16_t* stg = (LAS bf16_t*)(shm + LDS_OST) + wid * 2048;
#pragma unroll
      for (int r = 0; r < 16; ++r) { const int orow = crow(r, hi);
#pragma unroll
          for (int d0 = 0; d0 < 2; ++d0) stg[orow * 64 + d0 * 32 + r32] = (bf16_t)f2bf(o[d0][r] * rli[r]); }
      asm volatile("s_waitcnt lgkmcnt(0)" ::: "memory");
#pragma unroll
      for (int i = 0; i < 4; ++i) { const int row = i * 8 + (lane >> 3), ch = lane & 7; const u32x4 v = *(const LAS u32x4*)(stg + row * 64 + ch * 8); *(u32x4*)(Ow + (long)row * 512 + ch * 8) = v; } }
    asm volatile("s_waitcnt lgkmcnt(0)\n\ts_barrier" ::: "memory");
#undef DMA_K
#undef DMA_V
#undef ROT
#undef PKW
#undef PAF
#undef VFR
#undef PIN
#undef MF
#undef GAPA
#undef GAPA8
#undef GAPM
#undef GAPB
#undef EX
#undef VRD
#undef KRD
#undef STEP
#undef ENDW
}
#undef SBAR
#undef WAIT_BAR
#undef MF8
}

namespace bgc {
constexpr int N_GU = 32 * 16 * 128, N_D = 32 * 16 * 64, N_ITEMS = N_GU + N_D;
constexpr int SCR_STRIDE = 20, SCR_BUF = 64 * SCR_STRIDE * 4, SCR_WAVE = 2 * SCR_BUF, LDS_SCR = 73728, LDS_G2 = LDS_SCR + NWAVES * SCR_WAVE;
static_assert(LDS_G2 + 4096 <= MISC_OFF, "background conversion LDS");
constexpr int G2_ONES = 1024 + 256;
static_assert(LDS_G2 + 4096 == MISC_OFF, "ones block = MISC words 256..319");
struct Bg {
    const float* wgu; const float* wd; unsigned char* ws; LAS char* scr; LAS const float* g2;
    int gw, ngw, mitems, q;
    int lane, lw, lr, ls;
    unsigned gu_src, gu_dst, d_src, d_dst; int gu_k0, d_e0;
    __device__ __forceinline__ void init(const float* wgu_, const float* wd_, unsigned char* ws_, LAS unsigned char* lds, int wave, int lane_) {
        wgu = wgu_; wd = wd_; ws = ws_; scr = (LAS char*)lds + LDS_SCR + wave * SCR_WAVE; g2 = (LAS const float*)(lds + LDS_G2);
        gw = blockIdx.x * NWAVES + wave; ngw = gridDim.x * NWAVES; mitems = (N_ITEMS + ngw - 1) / ngw; q = 0;
        lane = lane_; lw = (lane_ >> 2) * (SCR_STRIDE * 4) + (lane_ & 3) * 16; lr = (lane_ >> 4) * (4 * SCR_STRIDE * 4) + (lane_ & 15) * 4; ls = (lane_ & 15) * 1024 + (lane_ >> 4) * 4;
        { const int r = gw & 2047, kb = r >> 7, n0 = (r & 127) * 16, pn = n0 >> 8, w = n0 & 255, sc = w < 128 ? 128 * pn + w : 1024 + 128 * pn + (w - 128);
          gu_src = (unsigned)((64 * kb) * 2048 + sc) * 4u; gu_dst = (unsigned)(n0 * 1024 + 64 * kb); gu_k0 = 64 * kb; }
        { const int r = gw & 1023, kb = r >> 6, n0 = (r & 63) * 16; d_src = (unsigned)((64 * kb) * 1024 + n0) * 4u; d_dst = (unsigned)(n0 * 1024 + 64 * kb); d_e0 = (gw >> 10) & 1; }
    }
    __device__ __forceinline__ bool fast() const { return ngw == 2048; }
    __device__ __forceinline__ int clampm(int m) const { m = m < mitems ? m : mitems - 1; return m < 0 ? 0 : m; }
    __device__ __forceinline__ void decode(int m, const char*& src, unsigned char*& dst, int& sh, int& k0) const {
        m = m < 47 ? m : 47; m = m < 0 ? 0 : m;
        const bool kd = m >= 32; const int ed = d_e0 + 2 * (m - 32);
        const char* sg = (const char*)wgu + ((size_t)m << 23) + gu_src; const char* sd = (const char*)wd + ((size_t)ed << 22) + d_src;
        unsigned char* dg = ws + WS_WGU + ((size_t)m << 21) + gu_dst; unsigned char* dd = ws + WS_WD + ((size_t)ed << 20) + d_dst;
        src = kd ? sd : sg; dst = kd ? dd : dg; sh = kd ? 12 : 13; k0 = kd ? G2_ONES : gu_k0;
    }
    __device__ __forceinline__ void decode_gen(int m, const char*& src, unsigned char*& dst, int& sh, int& k0) const {
        m = clampm(m);
        int it = gw + ngw * m; it = it < N_ITEMS ? it : N_ITEMS - 1;
        if (it < N_GU) { const int e = it >> 11, r = it & 2047, kb = r >> 7, n0 = (r & 127) * 16, pn = n0 >> 8, w = n0 & 255, sc = w < 128 ? 128 * pn + w : 1024 + 128 * pn + (w - 128);
            src = (const char*)(wgu + (size_t)e * (1024 * 2048) + (size_t)(64 * kb) * 2048 + sc); dst = ws + WS_WGU + (size_t)e * (2048 * 1024) + (size_t)n0 * 1024 + 64 * kb; sh = 13; k0 = 64 * kb; }
        else { const int i2 = it - N_GU, e = i2 >> 10, r = i2 & 1023, kb = r >> 6, n0 = (r & 63) * 16;
            src = (const char*)(wd + (size_t)e * (1024 * 1024) + (size_t)(64 * kb) * 1024 + n0); dst = ws + WS_WD + (size_t)e * (1024 * 1024) + (size_t)n0 * 1024 + 64 * kb; sh = 12; k0 = G2_ONES; }
    }
    __device__ __forceinline__ f32x4 load(int tk) const {
        const char* src; unsigned char* dst; int sh, k0; decode(tk >> 2, src, dst, sh, k0);
        const char* sb = src + ((size_t)(16 * (tk & 3)) << sh);
#ifdef BGP_HOT
        sb = (const char*)wgu;
#endif
        const unsigned voff = ((unsigned)(lane >> 2) << sh) + (unsigned)((lane & 3) * 16);
        f32x4 v; asm volatile("global_load_dwordx4 %0, %1, %2 nt" : "=v"(v) : "v"(voff), "s"(sb) : "memory");
        return v;
    }
    __device__ __forceinline__ float scale(int tk) const {
        const char* src; unsigned char* dst; int sh, k0; decode(tk >> 2, src, dst, sh, k0);
        return g2[k0 + 16 * (tk & 3) + (lane >> 2)];
    }
    __device__ __forceinline__ void write(int tk, f32x4 v, float s) const {
        const int m = tk >> 2;
        *(LAS f32x4*)(scr + (m & 1) * SCR_BUF + (tk & 3) * (16 * SCR_STRIDE * 4) + lw) = v * (64.f * s);
    }
    __device__ __forceinline__ f32x4 out_read(int tk) const {
        const int m1 = (tk >> 2) - 1;
        const LAS float* s = (const LAS float*)(scr + (m1 & 1) * SCR_BUF + (tk & 3) * (16 * SCR_STRIDE * 4) + lr);
        return (f32x4){s[0], s[SCR_STRIDE], s[2 * SCR_STRIDE], s[3 * SCR_STRIDE]};
    }
    __device__ __forceinline__ void out_store(int tk, f32x4 r) const {
        const char* src; unsigned char* dst; int sh, k0; decode((tk >> 2) - 1, src, dst, sh, k0);
        const unsigned char* db = dst + 16 * (tk & 3);
        const unsigned w = pack4_fp8(r.x, r.y, r.z, r.w);
        asm volatile("global_store_dword %0, %1, %2" :: "v"(ls), "v"(w), "s"(db) : "memory");
    }
    __device__ __forceinline__ void tick_sync(int tk, bool do_out) const {
        const char* src; unsigned char* dst; int sh, k0; decode_gen(tk >> 2, src, dst, sh, k0);
        const char* p = src + ((size_t)(16 * (tk & 3) + (lane >> 2)) << sh) + (lane & 3) * 16;
        f32x4 v = *(const f32x4*)p; const float s = g2[k0 + 16 * (tk & 3) + (lane >> 2)];
        write(tk, v, s);
        asm volatile("s_waitcnt lgkmcnt(0)" ::: "memory");
        if (do_out) { const char* src1; unsigned char* dst1; int sh1, k1; decode_gen((tk >> 2) - 1, src1, dst1, sh1, k1);
            const f32x4 r = out_read(tk); *(unsigned*)(dst1 + 16 * (tk & 3) + ls) = pack4_fp8(r.x, r.y, r.z, r.w); }
    }
    __device__ __forceinline__ int q_end() const { return 4 * mitems + 4; }
};
}

namespace mla88 {
using mla::glds16; using mla::lds_cptr;
typedef int v8i __attribute__((ext_vector_type(8)));
typedef short v2s __attribute__((ext_vector_type(2)));
#ifdef PROBE_NODMA
#define PROBE_NODMA_ 1
#else
#define PROBE_NODMA_ 0
#endif
#ifndef PSCALE
#define PSCALE 16.0f
#endif
constexpr float PSCALE_LMIN = 512.f;
constexpr int NW = 8, QBLK = 32, QB = 256, KVBLK = 64, NT = SEQ / KVBLK;
constexpr int KSLOT = 6144, VSLOT = 4096, NSLOT_ = 4, LDS_K = 0, LDS_V = NSLOT_ * KSLOT, LDS_OST = LDS_V + NSLOT_ * VSLOT, LDS_WL = LDS_OST + NW * 4096, LDS_BYTES_ = LDS_WL + NW * 128;
static_assert(LDS_BYTES_ <= RING_BYTES, "mla88 LDS");
#define SBAR() __builtin_amdgcn_sched_barrier(0)
#ifdef PROBE_X2BAR
#define WAIT_BAR(N) do { asm volatile("" ::: "memory"); __builtin_amdgcn_s_waitcnt(((N) & 15) | (7 << 4) | (0 << 8)); __builtin_amdgcn_s_barrier(); __builtin_amdgcn_s_barrier(); asm volatile("" ::: "memory"); } while (0)
#else
#define WAIT_BAR(N) do { asm volatile("" ::: "memory"); __builtin_amdgcn_s_waitcnt(((N) & 15) | (7 << 4) | (0 << 8)); __builtin_amdgcn_s_barrier(); asm volatile("" ::: "memory"); } while (0)
#endif
__device__ __forceinline__ void glds16c(const void* gsrc, unsigned lds_dst) {
    asm volatile("s_mov_b32 m0, %1\n\ts_nop 0\n\tglobal_load_lds_dwordx4 %0, off" :: "v"(gsrc), "s"(lds_dst) : "memory", "m0"); }
__device__ __forceinline__ v8i kfrag8(lds_cptr slot, int n, int ks, int r32, int hi) {
    const lds_cptr p = slot + (ks == 0 ? 2 * hi : 4) * 1024 + (32 * n + r32) * 16;
    const u32x4 a = *(const LAS u32x4*)p, b = *(const LAS u32x4*)(p + 1024);
    return (v8i){(int)a.x, (int)a.y, (int)a.z, (int)a.w, (int)b.x, (int)b.y, (int)b.z, (int)b.w};
}
#define MF8(a, b, c) __builtin_amdgcn_mfma_scale_f32_32x32x64_f8f6f4(a, b, c, 0, 0, 0, 0x7f7f7f7f, 0, 0x7b7b7b7b)
#define MF8V(a, b, c) __builtin_amdgcn_mfma_scale_f32_32x32x64_f8f6f4(a, b, c, 0, 0, 0, 0x7f7f7f7f, 0, 0x7f7f7f7f)
__device__ __forceinline__ v8i vfrag8(lds_cptr slot, int dh, int r32, int hi) {
    const lds_cptr p = slot + dh * 2048 + (2 * hi) * 512 + r32 * 16;
    const u32x4 a = *(const LAS u32x4*)p, b = *(const LAS u32x4*)(p + 512);
    return (v8i){(int)a.x, (int)a.y, (int)a.z, (int)a.w, (int)b.x, (int)b.y, (int)b.z, (int)b.w};
}

__device__ __forceinline__ bool mla88_unit(int b, int h, int qb, const unsigned char* Q8, const unsigned char* __restrict__ K8im, const unsigned char* __restrict__ V8im, bf16_t* O, LAS char* shm, bgc::Bg& bg) {
    const int tid = threadIdx.x, lane = tid & 63, r32 = lane & 31, hi = lane >> 5; const int wid = __builtin_amdgcn_readfirstlane(tid >> 6);
    const long rowbase = (long)b * SEQ; const int q0 = qb * QB;
    const unsigned char* Qw = Q8 + (size_t)(rowbase + q0 + wid * QBLK + r32) * 768 + h * 96;
    const unsigned lds0 = (unsigned)(uintptr_t)shm;
    const int kpc = wid < 6 ? wid : wid - 6;
#ifdef MLA_FLAT_DMA
    const unsigned char* ksrc = K8im + kpc * 1024 + lane * 16;
    const unsigned char* vsrc = V8im + (wid & 3) * 1024 + lane * 16;
#else
    const unsigned char* dbase = K8im < V8im ? K8im : V8im;
    const __amdgpu_buffer_rsrc_t srd = __builtin_amdgcn_make_buffer_rsrc((void*)dbase, (short)0, (int)0x7fffffff, 0x00020000);
    const unsigned kso = (unsigned)__builtin_amdgcn_readfirstlane((int)(K8im - dbase)), vso = (unsigned)__builtin_amdgcn_readfirstlane((int)(V8im - dbase));
    const unsigned kvo = (unsigned)(kpc * 1024 + lane * 16), vvo = (unsigned)((wid & 3) * 1024 + lane * 16);
#endif
    const unsigned kdst = lds0 + LDS_K + kpc * 1024, vdst = lds0 + LDS_V + (wid & 3) * 1024;
#ifdef MLA_FLAT_DMA
#define DMA_K(t, sl) glds16c(ksrc + (long)(t) * 6144, (unsigned)__builtin_amdgcn_readfirstlane(kdst + (sl) * KSLOT))
#define DMA_V(t, sl) glds16c(vsrc + (long)(t) * 4096, (unsigned)__builtin_amdgcn_readfirstlane(vdst + (sl) * VSLOT))
#else
#define DMA_B(m0v, vo, so) asm volatile("s_mov_b32 m0, %0\n\ts_nop 0\n\tbuffer_load_dwordx4 %1, %2, %3 offen lds" :: "s"(m0v), "v"(vo), "s"(srd), "s"(so) : "m0", "memory")
#define DMA_K(t, sl) DMA_B((unsigned)__builtin_amdgcn_readfirstlane(kdst + (sl) * KSLOT), kvo, (unsigned)__builtin_amdgcn_readfirstlane((int)(kso + (unsigned)(t) * 6144u)))
#define DMA_V(t, sl) DMA_B((unsigned)__builtin_amdgcn_readfirstlane(vdst + (sl) * VSLOT), vvo, (unsigned)__builtin_amdgcn_readfirstlane((int)(vso + (unsigned)(t) * 4096u)))
#endif
    const lds_cptr shm3 = (lds_cptr)shm; const lds_cptr ks0 = shm3 + LDS_K; const lds_cptr vs0 = shm3 + LDS_V;
    v8i kf[4];
    DMA_K(0, 0); DMA_V(0, 0); DMA_K(1, 1); DMA_V(1, 1); DMA_K(2, 2); DMA_K(3, 3);
    v8i qr[2];
    { const u32x4 a = *(const u32x4*)(Qw + 32 * hi), c = *(const u32x4*)(Qw + 32 * hi + 16); qr[0] = (v8i){(int)a.x, (int)a.y, (int)a.z, (int)a.w, (int)c.x, (int)c.y, (int)c.z, (int)c.w};
      u32x4 d = *(const u32x4*)(Qw + 64), e = *(const u32x4*)(Qw + 80); if (hi) { d = (u32x4){0u, 0u, 0u, 0u}; e = d; }
      qr[1] = (v8i){(int)d.x, (int)d.y, (int)d.z, (int)d.w, (int)e.x, (int)e.y, (int)e.z, (int)e.w}; }
    f32x16 o[2]; o[0] = f32x16{}; o[1] = f32x16{};
    f32x16 pA0, pA1, pB0, pB1;
    WAIT_BAR(0);
    { pA0 = MF8(kfrag8(ks0, 0, 0, r32, hi), qr[0], f32x16{}); pA1 = MF8(kfrag8(ks0, 1, 0, r32, hi), qr[0], f32x16{});
      pA0 = MF8(kfrag8(ks0, 0, 1, r32, hi), qr[1], pA0); pA1 = MF8(kfrag8(ks0, 1, 1, r32, hi), qr[1], pA1); }
#pragma unroll
    for (int r = 0; r < 16; ++r) { pA0[r] = __builtin_amdgcn_exp2f(pA0[r]); if (r < 8) pA1[r] = __builtin_amdgcn_exp2f(pA1[r]); }
    kf[0] = kfrag8(ks0 + KSLOT, 0, 0, r32, hi); kf[1] = kfrag8(ks0 + KSLOT, 0, 1, r32, hi); kf[2] = kfrag8(ks0 + KSLOT, 1, 0, r32, hi); kf[3] = kfrag8(ks0 + KSLOT, 1, 1, r32, hi);
    WAIT_BAR(0);
    DMA_K(4, 0); DMA_V(2, 2);
    v8i vf[2], p8 = {0, 0, 0, 0, 0, 0, 0, 0};
    v8i ones8; { const int on = (((lane >> 4) & 1) == (lane & 15)) ? 0x38383838 : 0; ones8 = (v8i){on, on, on, on, on, on, on, on}; }
    asm volatile("" : "+v"(ones8));
    f32x4 lacc = {0.f, 0.f, 0.f, 0.f};
#define MF16S(a, b, c) __builtin_amdgcn_mfma_scale_f32_16x16x128_f8f6f4(a, b, c, 0, 0, 0, 0x7f7f7f7f, 0, 0x7f7f7f7f)
#ifdef PROBE_X2MFMA
#define X2MF
#else
#define X2MF
#endif
    float psc = PSCALE; asm volatile("" : "+v"(psc));
#define PIN(x) asm volatile("" : "+v"(x))
#ifdef PROBE_NOEXP
#define EX(v) (v)
#else
#define EX(v) __builtin_amdgcn_exp2f(v)
#endif
#ifdef PROBE_NOCVT
#define PK4O(O, P, B) do { } while (0)
#else
#define PK4O(O, P, B) do { int t_; asm volatile("v_cvt_scalef32_pk_fp8_f32 %0, %1, %2, %3" : "=v"(t_) : "v"(P[B]), "v"(P[B + 1]), "v"(psc)); \
    asm volatile("v_cvt_scalef32_pk_fp8_f32 %0, %1, %2, %3 op_sel:[0,0,0,1]" : "+v"(t_) : "v"(P[B + 2]), "v"(P[B + 3]), "v"(psc)); O = t_; } while (0)
#endif
#define KRD(G, j, SN) do { if (G) { kf[j] = kfrag8(ks0 + (SN) * KSLOT, (j) >> 1, (j) & 1, r32, hi); SBAR(); } } while (0)
#define GAPS(MFX, P, W, PE, N0, N1) do { MFX; SBAR(); _Pragma("unroll") for (int r_ = N0; r_ < N1; ++r_) PE[r_] = EX(PE[r_]); PIN(PE); \
    PK4O(p8[W], P, 0); PK4O(p8[W + 1], P, 4); PK4O(p8[W + 2], P, 8); PK4O(p8[W + 3], P, 12); PIN(p8); SBAR(); } while (0)
#ifdef PROBE_X2ADD
#define GAPE(MFX, X, N0, N1) do { MFX; SBAR(); _Pragma("unroll") for (int r_ = N0; r_ < N1; ++r_) { X[r_] = EX(X[r_]); float d_; asm volatile("v_add_f32 %0, %1, %1\n\tv_add_f32 %0, %1, %1" : "=v"(d_) : "v"(X[r_ ^ 8])); } PIN(X); SBAR(); } while (0)
#elif defined(PROBE_X2EXP)
#define GAPE(MFX, X, N0, N1) do { MFX; SBAR(); _Pragma("unroll") for (int r_ = N0; r_ < N1; ++r_) { X[r_] = EX(X[r_]); float d_; asm volatile("v_exp_f32 %0, %1" : "=v"(d_) : "v"(X[r_ ^ 8])); } PIN(X); SBAR(); } while (0)
#else
#define GAPE(MFX, X, N0, N1) do { MFX; SBAR(); _Pragma("unroll") for (int r_ = N0; r_ < N1; ++r_) X[r_] = EX(X[r_]); PIN(X); SBAR(); } while (0)
#endif
#define EXPS(X, N0, N1) do { _Pragma("unroll") for (int r_ = N0; r_ < N1; ++r_) X[r_] = EX(X[r_]); PIN(X); } while (0)
#define STEP(C0, C1, P0, P1, t, S, GK, GV, GL, H0, H1, H2) do { SBAR(); \
    H0; SBAR(); \
    C0 = MF8(kf[0], qr[0], f32x16{}); PIN(C0); SBAR(); vf[0] = vfrag8(vs0 + (((S) + 3) & 3) * VSLOT, 0, r32, hi); EXPS(P1, 8, 12);  PK4O(p8[0], P0, 0); PK4O(p8[1], P0, 4);  PIN(p8); SBAR(); \
    C0 = MF8(kf[1], qr[1], C0); PIN(C0);       SBAR(); vf[1] = vfrag8(vs0 + (((S) + 3) & 3) * VSLOT, 1, r32, hi); EXPS(P1, 12, 16); PK4O(p8[2], P0, 8); PK4O(p8[3], P0, 12); PIN(p8); SBAR(); \
    C1 = MF8(kf[2], qr[0], f32x16{}); PIN(C1); SBAR(); \
    H1; if (GK && !PROBE_NODMA_) { DMA_K((t) + 4, (S)); } if (GV && !PROBE_NODMA_) { DMA_V((t) + 2, ((S) + 2) & 3); } H2; SBAR(); \
    EXPS(C0, 0, 6);   PK4O(p8[4], P1, 0); PK4O(p8[5], P1, 4);  PIN(p8); SBAR(); \
    C1 = MF8(kf[3], qr[1], C1); PIN(C1);       SBAR(); EXPS(C0, 6, 12);  PK4O(p8[6], P1, 8); PK4O(p8[7], P1, 12); PIN(p8); SBAR(); \
    o[0] = MF8V(p8, vf[0], o[0]); PIN(o[0]); SBAR(); KRD(GL, 0, ((S) + 1) & 3); KRD(GL, 1, ((S) + 1) & 3); EXPS(C0, 12, 16); SBAR(); \
    o[1] = MF8V(p8, vf[1], o[1]); PIN(o[1]); SBAR(); KRD(GL, 2, ((S) + 1) & 3); KRD(GL, 3, ((S) + 1) & 3); EXPS(C1, 0, 4); SBAR(); \
    lacc = MF16S(p8, ones8, lacc); PIN(lacc); SBAR(); EXPS(C1, 4, 8); SBAR(); \
    } while (0)
    f32x4 bgv = {0.f, 0.f, 0.f, 0.f}, bgr = {0.f, 0.f, 0.f, 0.f}; float bgs = 0.f;
#ifdef BG_CONV
#ifndef BGP_NLD
#define BGP_NLD 1
#endif
#ifndef BGP_NST
#define BGP_NST 1
#endif
#ifndef BGP_LDS
#define BGP_LDS 1
#endif
#define BG_STR_(x) #x
#define BG_STR(x) BG_STR_(x)
#define WAIT_BARX(N) asm volatile("s_waitcnt vmcnt(" BG_STR(N) ") lgkmcnt(0)\n\ts_barrier" ::: "memory")
#if BGP_NLD
#define BG_LOAD  bgv = bg.load(bg.q)
#else
#define BG_LOAD
#endif
#if BGP_LDS
#define BG_SC    bgs = bg.scale(bg.q)
#define BG_RD    bgr = bg.out_read(bg.q)
#else
#define BG_SC
#define BG_RD
#endif
#if BGP_NST
#define BG_OUT   bg.out_store(bg.q, bgr)
#define BG_WCNT 5
#else
#define BG_OUT   do { unsigned w_ = pack4_fp8(bgr.x, bgr.y, bgr.z, bgr.w); asm volatile("" :: "v"(w_)); } while (0)
#define BG_WCNT 4
#endif
#if BGP_LDS
#define BG_WRITE do { asm volatile("" : "+v"(bgv)); bg.write(bg.q, bgv, bgs); } while (0)
#else
#define BG_WRITE do { asm volatile("" : "+v"(bgv)); } while (0)
#endif
#define BG_NEXT  bg.q += 1
#if BGP_NLD && BGP_NST
#define WB1 WAIT_BAR(5)
#define WB2 WAIT_BAR(6)
#define WB3 WAIT_BAR(5)
#elif BGP_NLD
#define WB1 WAIT_BAR(5)
#define WB2 WAIT_BAR(5)
#define WB3 WAIT_BAR(4)
#elif BGP_NST
#define WB1 WAIT_BAR(4)
#define WB2 WAIT_BAR(5)
#define WB3 WAIT_BAR(5)
#else
#define WB1 WAIT_BAR(4)
#define WB2 WAIT_BAR(4)
#define WB3 WAIT_BAR(4)
#endif
#else
#define BG_LOAD
#define BG_SC
#define BG_RD
#define BG_OUT
#define BG_WRITE
#define BG_NEXT
#define WB1 WAIT_BAR(4)
#define WB2 WAIT_BAR(4)
#define WB3 WAIT_BAR(4)
#endif
#define NOH do { } while (0)
#ifdef MLA_PRIO
    if (wid >= 4) __builtin_amdgcn_s_setprio(1);
#endif
    int t = 1;
    for (; t < NT - 7; t += 4) {
        STEP(pB0, pB1, pA0, pA1, t, 1, true, true, true, BG_LOAD; BG_SC, NOH, NOH);     WB1;
        STEP(pA0, pA1, pB0, pB1, t + 1, 2, true, true, true, BG_RD, NOH, BG_OUT);       WB2;
        STEP(pB0, pB1, pA0, pA1, t + 2, 3, true, true, true, NOH, NOH, NOH);            WB3;
        STEP(pA0, pA1, pB0, pB1, t + 3, 0, true, true, true, BG_WRITE, NOH, NOH);       WAIT_BAR(4); BG_NEXT;
    }
    static_assert(((NT - 7) & 3) == 1, "tail starts in slot 1");
    STEP(pB0, pB1, pA0, pA1, NT - 7, 1, true, true, true, NOH, NOH, NOH);    WAIT_BAR(4);
    STEP(pA0, pA1, pB0, pB1, NT - 6, 2, true, true, true, NOH, NOH, NOH);    WAIT_BAR(4);
    STEP(pB0, pB1, pA0, pA1, NT - 5, 3, true, true, true, NOH, NOH, NOH);    WAIT_BAR(4);
    STEP(pA0, pA1, pB0, pB1, NT - 4, 0, false, true, true, NOH, NOH, NOH);   WAIT_BAR(3);
    STEP(pB0, pB1, pA0, pA1, NT - 3, 1, false, true, true, NOH, NOH, NOH);   WAIT_BAR(2);
    STEP(pA0, pA1, pB0, pB1, NT - 2, 2, false, false, true, NOH, NOH, NOH);  WAIT_BAR(0);
    STEP(pB0, pB1, pA0, pA1, NT - 1, 3, false, false, false, NOH, NOH, NOH);
#ifdef MLA_PRIO
    __builtin_amdgcn_s_setprio(0);
#endif
    {
#pragma unroll
      for (int r = 8; r < 16; ++r) pB1[r] = __builtin_amdgcn_exp2f(pB1[r]);
      PK4O(p8[0], pB0, 0); PK4O(p8[1], pB0, 4); PK4O(p8[2], pB0, 8); PK4O(p8[3], pB0, 12); PK4O(p8[4], pB1, 0); PK4O(p8[5], pB1, 4); PK4O(p8[6], pB1, 8); PK4O(p8[7], pB1, 12);
      SBAR();
      o[0] = MF8V(p8, vfrag8(vs0 + 3 * VSLOT, 0, r32, hi), o[0]); o[1] = MF8V(p8, vfrag8(vs0 + 3 * VSLOT, 1, r32, hi), o[1]); lacc = MF16S(p8, ones8, lacc); }
    float rli[16]; bool bad = false;
    { LAS float* wl2 = (LAS float*)(shm + LDS_WL) + wid * 32;
      if ((lane & 15) < 2) {
#pragma unroll
          for (int i = 0; i < 4; ++i) wl2[4 * (lane >> 4) + i + 16 * (lane & 15)] = lacc[i]; }
      asm volatile("s_waitcnt lgkmcnt(0)" ::: "memory");
#pragma unroll
      for (int r = 0; r < 16; ++r) { const float l = wl2[crow(r, hi)]; rli[r] = __builtin_amdgcn_rcpf(l); bad = bad || !(l >= PSCALE_LMIN); }
    }
    bf16_t* Ow = O + (rowbase + q0 + wid * QBLK) * 512 + h * 64;
    { LAS bf16_t* stg = (LAS bf16_t*)(shm + LDS_OST) + wid * 2048;
#pragma unroll
      for (int r = 0; r < 16; ++r) { const int orow = crow(r, hi);
#pragma unroll
          for (int d0 = 0; d0 < 2; ++d0) stg[orow * 64 + d0 * 32 + r32] = (bf16_t)f2bf(o[d0][r] * rli[r]); }
      asm volatile("s_waitcnt lgkmcnt(0)" ::: "memory");
#pragma unroll
#ifdef OAB_FP8
      for (int i = 0; i < 4; ++i) { const int row = i * 8 + (lane >> 3), ch = lane & 7; const u32x4 v = *(const LAS u32x4*)(stg + row * 64 + ch * 8); float f8_[8]; unpack8(v, f8_);
          *(u32x2*)((unsigned char*)O + ((rowbase + q0 + wid * QBLK + row) * 512 + h * 64 + ch * 8)) = (u32x2){pack4_fp8(32.f * f8_[0], 32.f * f8_[1], 32.f * f8_[2], 32.f * f8_[3]), pack4_fp8(32.f * f8_[4], 32.f * f8_[5], 32.f * f8_[6], 32.f * f8_[7])}; } }
#else
      for (int i = 0; i < 4; ++i) { const int row = i * 8 + (lane >> 3), ch = lane & 7; const u32x4 v = *(const LAS u32x4*)(stg + row * 64 + ch * 8); *(u32x4*)(Ow + (long)row * 512 + ch * 8) = v; } }
#endif
    asm volatile("s_waitcnt lgkmcnt(0)\n\ts_barrier" ::: "memory");
#undef DMA_K
#undef DMA_V
#ifndef MLA_FLAT_DMA
#undef DMA_B
#endif
#undef PIN
#undef PK4O
#undef GAPS
#undef GAPE
#undef EX
#undef KRD
#undef STEP
#undef EXPS
#undef BG_LOAD
#undef BG_SC
#undef BG_RD
#undef BG_OUT
#undef BG_WRITE
#undef BG_NEXT
#undef WB1
#undef WB2
#undef WB3
#undef NOH
    return __any(bad) != 0;
}
#undef SBAR
#undef WAIT_BAR
#undef MF8
#undef MF8V
#undef MF16S
}

template <bool F8, class CM> __device__ __forceinline__ void tr_item(const float* W, int ld, const float* rs, bf16_t* WT, int K, int k0, int n0, const CM& cm, LAS float* scr, int lane) {
    const int n = lane & 31, sc = cm.col(n0 + n); const float cs = cm.scale(n0 + n);
#pragma unroll 8
    for (int i = 0; i < 32; ++i) { const int kk = 2 * i + (lane >> 5); float v = 0.f; if (sc >= 0) v = W[(size_t)(k0 + kk) * ld + sc] * cs * (rs ? rs[k0 + kk] : 1.f); scr[kk * 33 + n] = v; }
    asm volatile("s_waitcnt lgkmcnt(0)" ::: "memory");
    const int c = lane & 7;
#pragma unroll
    for (int j = 0; j < 4; ++j) { const int nn = (lane >> 3) + 8 * j; const LAS float* s = scr + (8 * c) * 33 + nn;
        if constexpr (F8) { *(u32x2*)((unsigned char*)WT + (size_t)(n0 + nn) * K + k0 + 8 * c) = (u32x2){pack4_fp8(s[0 * 33], s[1 * 33], s[2 * 33], s[3 * 33]), pack4_fp8(s[4 * 33], s[5 * 33], s[6 * 33], s[7 * 33])}; }
        else { u32x4 o; o.x = pk2(s[0 * 33], s[1 * 33]); o.y = pk2(s[2 * 33], s[3 * 33]); o.z = pk2(s[4 * 33], s[5 * 33]); o.w = pk2(s[6 * 33], s[7 * 33]);
        *(u32x4*)(WT + (size_t)(n0 + nn) * K + k0 + 8 * c) = o; } }
    asm volatile("s_waitcnt lgkmcnt(0)" ::: "memory");
}
#ifdef XW_NT
#define XW_LD(p) __builtin_nontemporal_load(p)
#else
#define XW_LD(p) (*(p))
#endif
template <class CM> __device__ __forceinline__ void tr4_load(f32x4 (&v)[8], const float* W, int ld, int k0, int n0, const CM& cm, int lane) {
    const int n4 = (lane & 7) * 4, sc = cm.col(n0 + n4);
#pragma unroll
    for (int i = 0; i < 8; ++i) { const int kk = (lane >> 3) + 8 * i; v[i] = (sc >= 0) ? XW_LD((const f32x4*)(W + (size_t)(k0 + kk) * ld + sc)) : (f32x4){0.f, 0.f, 0.f, 0.f}; }
}
template <bool F8, class CM, class RSP = const float*> __device__ __forceinline__ void tr4_finish(const f32x4 (&v)[8], RSP rs, bf16_t* WT, int K, int k0, int n0, const CM& cm, LAS float* scr, int lane) {
    const int n4 = (lane & 7) * 4; const float cs = cm.scale(n0 + n4);
#pragma unroll
    for (int i = 0; i < 8; ++i) { const int kk = (lane >> 3) + 8 * i; const float r = cs * (rs ? rs[k0 + kk] : 1.f); LAS float* d = scr + kk * 33 + n4; d[0] = v[i].x * r; d[1] = v[i].y * r; d[2] = v[i].z * r; d[3] = v[i].w * r; }
    asm volatile("s_waitcnt lgkmcnt(0)" ::: "memory");
    const int c = lane & 7;
#pragma unroll
    for (int j = 0; j < 4; ++j) { const int nn = (lane >> 3) + 8 * j; const LAS float* s = scr + (8 * c) * 33 + nn;
        if constexpr (F8) { *(u32x2*)((unsigned char*)WT + (size_t)(n0 + nn) * K + k0 + 8 * c) = (u32x2){pack4_fp8(s[0 * 33], s[1 * 33], s[2 * 33], s[3 * 33]), pack4_fp8(s[4 * 33], s[5 * 33], s[6 * 33], s[7 * 33])}; }
        else { u32x4 o; o.x = pk2(s[0 * 33], s[1 * 33]); o.y = pk2(s[2 * 33], s[3 * 33]); o.z = pk2(s[4 * 33], s[5 * 33]); o.w = pk2(s[6 * 33], s[7 * 33]);
        *(u32x4*)(WT + (size_t)(n0 + nn) * K + k0 + 8 * c) = o; } }
    asm volatile("s_waitcnt lgkmcnt(0)" ::: "memory");
}
template <bool F8, class CM> __device__ __forceinline__ void tr_item4(const float* W, int ld, const float* rs, bf16_t* WT, int K, int k0, int n0, const CM& cm, LAS float* scr, int lane) {
    f32x4 v[8]; tr4_load(v, W, ld, k0, n0, cm, lane); tr4_finish<F8>(v, rs, WT, K, k0, n0, cm, scr, lane);
}
struct CmIn {
    __device__ __forceinline__ int col(int n) const {
        if (n < 1920) return n;
        if (n < 1952) { const int j = n - 1920, i = j >> 1; return 1920 + ((j & 1) ? i + 16 : i); }
        if (n < 2048) return -1;
        { const int j = (n - 2048) >> 8, w = n & 255; return w < 128 ? 1952 + 128 * j + w : 2976 + 128 * j + (w - 128); }
    }
    __device__ __forceinline__ float scale(int n) const { return n < 512 ? 0.125f * LOG2E : 1.f; }
    __device__ __forceinline__ bool regular(int n0) const { return n0 < 1920 || n0 >= 1952; }
};
#ifdef INPROJ_FP8
struct CmIn8 : CmIn { __device__ __forceinline__ float scale(int n) const { return 64.f * CmIn::scale(n); } };
#endif
struct CmUq {
    __device__ __forceinline__ int col(int n) const { const int h = n / 96, w = n % 96; if (w < 64) return n; const int j = w - 64, i = j >> 1; return h * 96 + 64 + ((j & 1) ? i + 16 : i); }
    __device__ __forceinline__ float scale(int) const { return 0.10206207261596577f * LOG2E; }
    __device__ __forceinline__ bool regular(int n0) const { return (n0 % 96) < 64; }
};
struct CmId64 { __device__ __forceinline__ int col(int n) const { return n; } __device__ __forceinline__ float scale(int) const { return 64.f / (-1.702f * LOG2E); } __device__ __forceinline__ bool regular(int) const { return true; } };
struct CmId { int off; __device__ __forceinline__ int col(int n) const { return n - off; } __device__ __forceinline__ float scale(int) const { return 1.f; } __device__ __forceinline__ bool regular(int) const { return true; } };
struct CmId8 { __device__ __forceinline__ int col(int n) const { return n; } __device__ __forceinline__ float scale(int) const { return 64.f; } __device__ __forceinline__ bool regular(int) const { return true; } };
struct CmGu {
    __device__ __forceinline__ int col(int n) const { const int pn = n >> 8, w = n & 255; return w < 128 ? 128 * pn + w : 1024 + 128 * pn + (w - 128); }
    __device__ __forceinline__ float scale(int) const { return 64.f; }
    __device__ __forceinline__ bool regular(int) const { return true; }
};
template <class CM, bool F8 = false> __device__ __forceinline__ void tr_any(const float* W, int ld, const float* rs, bf16_t* WT, int K, int k0, int n0, const CM& cm, LAS float* scr, int lane) {
    if (cm.regular(n0)) tr_item4<F8>(W, ld, rs, WT, K, k0, n0, cm, scr, lane); else tr_item<F8>(W, ld, rs, WT, K, k0, n0, cm, scr, lane);
}

struct Args { const float* in[19]; float* out; unsigned char* ws; int ph_lo, ph_hi, li, pad; };

#ifdef XW_ITEM64
template <class CM> __device__ __forceinline__ void tr8_load(f32x4 (&v)[16], const float* W, int ld, int k0, int n0, const CM& cm, int lane) {
    const int n4 = (lane & 15) * 4, sc = cm.col(n0 + n4);
#pragma unroll
    for (int i = 0; i < 16; ++i) { const int kk = (lane >> 4) + 4 * i; v[i] = *(const f32x4*)(W + (size_t)(k0 + kk) * ld + sc); }
}
template <class CM, class RSP> __device__ __forceinline__ void tr8_write(const f32x4 (&v)[16], RSP rs, int k0, int n0, const CM& cm, LAS float* scr, int lane) {
    const int n4 = (lane & 15) * 4; const float cs = cm.scale(n0 + n4);
#pragma unroll
    for (int i = 0; i < 16; ++i) { const int kk = (lane >> 4) + 4 * i; const float r = cs * (rs ? rs[k0 + kk] : 1.f); LAS float* d = scr + kk * 65 + n4; d[0] = v[i].x * r; d[1] = v[i].y * r; d[2] = v[i].z * r; d[3] = v[i].w * r; }
    asm volatile("s_waitcnt lgkmcnt(0)" ::: "memory");
}
__device__ __forceinline__ void tr8_store(unsigned char* WT, int K, int k0, int n0, LAS float* scr, int lane) {
    const int c = lane & 7;
#pragma unroll
    for (int j = 0; j < 8; ++j) { const int nn = (lane >> 3) + 8 * j; const LAS float* s = scr + (8 * c) * 65 + nn;
        *(u32x2*)(WT + (size_t)(n0 + nn) * K + k0 + 8 * c) = (u32x2){pack4_fp8(s[0 * 65], s[1 * 65], s[2 * 65], s[3 * 65]), pack4_fp8(s[4 * 65], s[5 * 65], s[6 * 65], s[7 * 65])};
        if (j & 1) asm volatile("" ::: "memory"); }
    asm volatile("s_waitcnt lgkmcnt(0)" ::: "memory");
}
constexpr int XW_IGU = 32 * 16 * 32, XW_NI = XW_IGU + 32 * 16 * 16;
__device__ __forceinline__ void xw_load(f32x4 (&v)[16], const Args& a, int r, int lane) {
    if (r < XW_IGU) tr8_load(v, a.in[14] + (size_t)(r / 512) * 1024 * 2048, 2048, 64 * ((r % 512) / 32), 64 * (r % 32), CmGu{}, lane);
    else { const int q = r - XW_IGU; tr8_load(v, a.in[16] + (size_t)(q / 256) * 1024 * 1024, 1024, 64 * ((q % 256) / 16), 64 * (q % 16), CmId64{}, lane); }
}
__device__ __forceinline__ void xw_write(const f32x4 (&v)[16], const Args& a, int r, LAS float* scr, const LAS float* g2l, int lane) {
    if (r < XW_IGU) tr8_write(v, g2l, 64 * ((r % 512) / 32), 64 * (r % 32), CmGu{}, scr, lane);
    else { const int q = r - XW_IGU; tr8_write(v, (const LAS float*)nullptr, 64 * ((q % 256) / 16), 64 * (q % 16), CmId64{}, scr, lane); }
}
__device__ __forceinline__ void xw_store(const Args& a, int r, LAS float* scr, int lane) {
    unsigned char* ws = a.ws;
    if (r < XW_IGU) tr8_store(ws + WS_WGU + (size_t)(r / 512) * 2048 * 1024, 1024, 64 * ((r % 512) / 32), 64 * (r % 32), scr, lane);
    else { const int q = r - XW_IGU; tr8_store(ws + WS_WD + (size_t)(q / 256) * 1024 * 1024, 1024, 64 * ((q % 256) / 16), 64 * (q % 16), scr, lane); }
}
__device__ __forceinline__ void p0_experts(const Args& a, LAS unsigned char* lds, int wave, int lane, int gw, int NGW, int r0, int NI) {
    LAS float* scr = (LAS float*)(lds + wave * 16640); LAS float* g2l = (LAS float*)(lds + 8 * 16640);
    { int tx = threadIdx.x; asm volatile("" : "+v"(tx)); for (int i = tx; i < 1024; i += NTHREADS) g2l[i] = a.in[11][i]; }
    __syncthreads();
    f32x4 va[16];
    int r = r0 + gw;
    if (r < NI) xw_load(va, a, r, lane);
    for (; r < NI; r += NGW) {
        xw_write(va, a, r, scr, g2l, lane);
        if (r + NGW < NI) xw_load(va, a, r + NGW, lane);
        xw_store(a, r, scr, lane);
    }
}
#else
__device__ __forceinline__ int xw_map(int v, int NGW) {
    constexpr int I_GU = 32 * 16 * 64, NI = I_GU + 32 * 16 * 32;
#ifdef XW_PAIR_K
    if (NI % (2 * NGW) != 0 || I_GU % (2 * NGW) != 0) return v;
    const int q = v / NGW, g = v - q * NGW, pi = g + NGW * (q >> 1), lsb = q & 1;
    if (pi < I_GU / 2) { const int e = pi / 512, t = pi % 512; return e * 1024 + (2 * (t / 64) + lsb) * 64 + (t % 64); }
    const int p2 = pi - I_GU / 2, e = p2 / 256, t = p2 % 256; return I_GU + e * 512 + (2 * (t / 32) + lsb) * 32 + (t % 32);
#else
    return v;
#endif
}
__device__ __forceinline__ void xw_load(f32x4 (&v)[8], const Args& a, int r, int lane) {
    constexpr int I_GU = 32 * 16 * 64;
    if (r < I_GU) tr4_load(v, a.in[14] + (size_t)(r / 1024) * 1024 * 2048, 2048, 64 * ((r % 1024) / 64), 32 * (r % 64), CmGu{}, lane);
    else { const int q = r - I_GU; tr4_load(v, a.in[16] + (size_t)(q / 512) * 1024 * 1024, 1024, 64 * ((q % 512) / 32), 32 * (q % 32), CmId64{}, lane); }
}
__device__ __forceinline__ void xw_fin(const f32x4 (&v)[8], const Args& a, int r, LAS float* scr, const LAS float* g2l, int lane) {
    constexpr int I_GU = 32 * 16 * 64; unsigned char* ws = a.ws;
    if (r < I_GU) tr4_finish<true>(v, g2l, (bf16_t*)(ws + WS_WGU + (size_t)(r / 1024) * 2048 * 1024), 1024, 64 * ((r % 1024) / 64), 32 * (r % 64), CmGu{}, scr, lane);
    else { const int q = r - I_GU; tr4_finish<true>(v, (const LAS float*)nullptr, (bf16_t*)(ws + WS_WD + (size_t)(q / 512) * 1024 * 1024), 1024, 64 * ((q % 512) / 32), 32 * (q % 32), CmId64{}, scr, lane); }
}
__device__ __forceinline__ void p0_experts(const Args& a, LAS unsigned char* lds, int wave, int lane, int gw, int NGW, int r0, int NI) {
    LAS float* scr = (LAS float*)(lds + wave * 16384); LAS float* g2l = (LAS float*)(lds + 131072);
    { int tx = threadIdx.x; asm volatile("" : "+v"(tx)); for (int i = tx; i < 1024; i += NTHREADS) g2l[i] = a.in[11][i]; }
    __syncthreads();
    f32x4 va[8], vb[8], vc[8], vd[8];
    int r = r0 + gw;
    if (r < NI) xw_load(va, a, xw_map(r, NGW), lane);
    if (r + NGW < NI) xw_load(vb, a, xw_map(r + NGW, NGW), lane);
    if (r + 2 * NGW < NI) xw_load(vc, a, xw_map(r + 2 * NGW, NGW), lane);
    for (; r < NI; r += 4 * NGW) {
        if (r + 3 * NGW < NI) xw_load(vd, a, xw_map(r + 3 * NGW, NGW), lane);
        xw_fin(va, a, xw_map(r, NGW), scr, g2l, lane);
        if (r + NGW < NI) { if (r + 4 * NGW < NI) xw_load(va, a, xw_map(r + 4 * NGW, NGW), lane); xw_fin(vb, a, xw_map(r + NGW, NGW), scr, g2l, lane); }
        if (r + 2 * NGW < NI) { if (r + 5 * NGW < NI) xw_load(vb, a, xw_map(r + 5 * NGW, NGW), lane); xw_fin(vc, a, xw_map(r + 2 * NGW, NGW), scr, g2l, lane); }
        if (r + 3 * NGW < NI) { if (r + 6 * NGW < NI) xw_load(vc, a, xw_map(r + 6 * NGW, NGW), lane); xw_fin(vd, a, xw_map(r + 3 * NGW, NGW), scr, g2l, lane); }
    }
}

#endif
__device__ __forceinline__ void p0_prologue(const Args& a, LAS unsigned char* lds, int wave, int lane, int xw_end) {
    LAS float* scr = (LAS float*)(lds + wave * 16384);
    const int gw = blockIdx.x * NWAVES + wave, NGW = gridDim.x * NWAVES;
    unsigned char* ws = a.ws;
    constexpr int I_IN = 16 * 128, I_UQ = 4 * 24, I_UK = 2 * 16, I_UV = 2 * 16, I_A = 8 * 32, I_B = 8 * 32, I_O = 16 * 32, I_GU = 32 * 16 * 64, I_D = 32 * 16 * 32;
    constexpr int NITEMS = I_IN + I_UQ + I_UK + I_UV + I_A + I_B + I_O;
    for (int it = gw; it < NITEMS; it += NGW) {
        int r = it;
#ifdef INPROJ_FP8
        if (r < I_IN) { tr_any<CmIn8, true>(a.in[2], 4000, a.in[1], (bf16_t*)(ws + WS_WIN), 1024, 64 * (r / 128), 32 * (r % 128), CmIn8{}, scr, lane); continue; } r -= I_IN;
#else
        if (r < I_IN) { tr_any(a.in[2], 4000, a.in[1], (bf16_t*)(ws + WS_WIN), 1024, 64 * (r / 128), 32 * (r % 128), CmIn{}, scr, lane); continue; } r -= I_IN;
#endif
        if (r < I_UQ) { tr_any(a.in[5], 768, a.in[3], (bf16_t*)(ws + WS_WUQ), 256, 64 * (r / 24), 32 * (r % 24), CmUq{}, scr, lane); continue; } r -= I_UQ;
        if (r < I_UK) { tr_any(a.in[6], 512, a.in[4], (bf16_t*)(ws + WS_WUKV), 128, 64 * (r / 16), 32 * (r % 16), CmId{0}, scr, lane); continue; } r -= I_UK;
        if (r < I_UV) { tr_any(a.in[7], 512, a.in[4], (bf16_t*)(ws + WS_WUKV), 128, 64 * (r / 16), 512 + 32 * (r % 16), CmId{512}, scr, lane); continue; } r -= I_UV;
#ifdef OAB_FP8
        if (r < I_A) { tr_any<CmId8, true>(a.in[8], 1024, nullptr, (bf16_t*)(ws + WS_WA), 512, 64 * (r / 32), 32 * (r % 32), CmId8{}, scr, lane); continue; } r -= I_A;
        if (r < I_B) { tr_any<CmId8, true>(a.in[9], 1024, nullptr, (bf16_t*)(ws + WS_WB), 512, 64 * (r / 32), 32 * (r % 32), CmId8{}, scr, lane); continue; } r -= I_B;
#else
        if (r < I_A) { tr_any(a.in[8], 1024, nullptr, (bf16_t*)(ws + WS_WA), 512, 64 * (r / 32), 32 * (r % 32), CmId{0}, scr, lane); continue; } r -= I_A;
        if (r < I_B) { tr_any(a.in[9], 1024, nullptr, (bf16_t*)(ws + WS_WB), 512, 64 * (r / 32), 32 * (r % 32), CmId{0}, scr, lane); continue; } r -= I_B;
#endif
#ifdef WO_FP8
        tr_any<CmId8, true>(a.in[10], 1024, nullptr, (bf16_t*)(ws + WS_WO), 1024, 64 * (r / 32), 32 * (r % 32), CmId8{}, scr, lane);
#else
        tr_any(a.in[10], 1024, nullptr, (bf16_t*)(ws + WS_WO), 1024, 64 * (r / 32), 32 * (r % 32), CmId{0}, scr, lane);
#endif
    }
#if (!defined(BG_CONV) || defined(BG_KEEP_P0))
    if (xw_end > 0) p0_experts(a, lds, wave, lane, gw, NGW, 0, xw_end);
#endif
    for (int m = gw; m < T; m += NGW) {
        const f32x4* xr = (const f32x4*)(a.in[0] + (size_t)m * DM) + lane;
        f32x4 v[4]; float s2 = 0.f;
#pragma unroll
        for (int j = 0; j < 4; ++j) { v[j] = xr[64 * j]; s2 += (v[j].x * v[j].x + v[j].y * v[j].y) + (v[j].z * v[j].z + v[j].w * v[j].w); }
        const float rstd = 1.f / sqrtf(wave_sum(s2) * (1.f / DM) + EPS);
        u32x2* o8 = (u32x2*)((bf16_t*)(ws + WS_XB) + (size_t)m * DM) + lane;
#pragma unroll
#ifdef INPROJ_FP8
        for (int j = 0; j < 4; ++j) ((unsigned*)(ws + WS_XB + (size_t)m * DM))[lane + 64 * j] = pack4_fp8(v[j].x * rstd, v[j].y * rstd, v[j].z * rstd, v[j].w * rstd);
#else
        for (int j = 0; j < 4; ++j) o8[64 * j] = (u32x2){pk2(v[j].x * rstd, v[j].y * rstd), pk2(v[j].z * rstd, v[j].w * rstd)};
#endif
    }
    const int gt = blockIdx.x * NTHREADS + threadIdx.x, NGT = gridDim.x * NTHREADS;
    for (int idx = gt; idx < SEQ * 16; idx += NGT) {
        ((f32x2*)(ws + WS_ROPE))[idx] = rope_cs(idx >> 4, idx & 15);
    }
    for (int idx = gt; idx < 1024 * 32; idx += NGT) ((float*)(ws + WS_WRP))[idx] = a.in[12][idx] * a.in[11][idx >> 5];
}

__device__ __forceinline__ void p2_stats(const Args& a, int wave, int lane) {
    const int gw = blockIdx.x * NWAVES + wave, NGW = gridDim.x * NWAVES; unsigned char* ws = a.ws;
    for (int m = gw; m < T; m += NGW) {
        const u32x2 q = ((const u32x2*)((const bf16_t*)(ws + WS_CQ) + (size_t)m * 256))[lane];
        const unsigned kv = ((const unsigned*)((const bf16_t*)(ws + WS_CKV) + (size_t)m * 128))[lane];
        const float a0 = bflo(q.x), a1 = bfhi(q.x), a2 = bflo(q.y), a3 = bfhi(q.y), b0 = bflo(kv), b1 = bfhi(kv);
        const float sq = wave_sum((a0 * a0 + a1 * a1) + (a2 * a2 + a3 * a3)), sk = wave_sum(b0 * b0 + b1 * b1);
        if (lane == 0) { ((float*)(ws + WS_RSTDQ))[m] = 1.f / sqrtf(sq * (1.f / 256.f) + EPS); ((float*)(ws + WS_RSTDKV))[m] = 1.f / sqrtf(sk * (1.f / 128.f) + EPS); }
#ifdef KEEP_BF16_IMAGES
        if (lane < 32) { const int b = m >> 14, sq2 = m & (SEQ - 1); const u32x4 kr = *(const u32x4*)((const bf16_t*)(ws + WS_KR) + (size_t)m * 32 + 8 * (lane & 3));
            *(u32x4*)((bf16_t*)(ws + WS_KIMG) + (size_t)((b * 8 + (lane >> 2)) * 256 + (sq2 >> 6)) * 6144 + (8 + (lane & 3)) * 512 + (sq2 & 63) * 8) = kr; }
#endif
        if (lane < 16) { const int b = m >> 14, sq2 = m & (SEQ - 1); const bf16_t* kp = (const bf16_t*)(ws + WS_KR) + (size_t)m * 32 + 16 * (lane & 1);
            float k0[8], k1[8]; unpack8(*(const u32x4*)kp, k0); unpack8(*(const u32x4*)(kp + 8), k1);
            *(u32x4*)(ws + WS_K8 + (size_t)((b * 8 + (lane >> 1)) * 256 + (sq2 >> 6)) * 6144 + (4 + (lane & 1)) * 1024 + (sq2 & 63) * 16) =
                (u32x4){pack4_fp8(k0[0], k0[1], k0[2], k0[3]), pack4_fp8(k0[4], k0[5], k0[6], k0[7]), pack4_fp8(k1[0], k1[1], k1[2], k1[3]), pack4_fp8(k1[4], k1[5], k1[6], k1[7])}; }
    }
}

__device__ __forceinline__ void p4_v8t(unsigned char* ws) {
    const bf16_t* VIM = (const bf16_t*)(ws + WS_VIMG); unsigned char* V8 = ws + WS_V8T;
    for (int g = blockIdx.x * NTHREADS + threadIdx.x; g < NB * 8 * 256 * 128; g += gridDim.x * NTHREADS) {
        const int dp = g & 15, ch = (g >> 4) & 3, dh = (g >> 6) & 1, tile = g >> 7, hi = ch >> 1;
        const bf16_t* src = VIM + (size_t)tile * 4096 + dh * 2048 + (ch & 1) * 1024 + 2 * dp;
        unsigned w[16];
#pragma unroll
        for (int i = 0; i < 16; ++i) w[i] = *(const unsigned*)(src + crow(i, hi) * 32);
        u32x4 lo, hi4;
        lo.x = pack4_fp8(bflo(w[0]), bflo(w[1]), bflo(w[2]), bflo(w[3]));     lo.y = pack4_fp8(bflo(w[4]), bflo(w[5]), bflo(w[6]), bflo(w[7]));
        lo.z = pack4_fp8(bflo(w[8]), bflo(w[9]), bflo(w[10]), bflo(w[11]));   lo.w = pack4_fp8(bflo(w[12]), bflo(w[13]), bflo(w[14]), bflo(w[15]));
        hi4.x = pack4_fp8(bfhi(w[0]), bfhi(w[1]), bfhi(w[2]), bfhi(w[3]));    hi4.y = pack4_fp8(bfhi(w[4]), bfhi(w[5]), bfhi(w[6]), bfhi(w[7]));
        hi4.z = pack4_fp8(bfhi(w[8]), bfhi(w[9]), bfhi(w[10]), bfhi(w[11]));  hi4.w = pack4_fp8(bfhi(w[12]), bfhi(w[13]), bfhi(w[14]), bfhi(w[15]));
        u32x4* dst = (u32x4*)(V8 + (size_t)tile * 4096 + dh * 2048 + ch * 512 + dp * 32);
        dst[0] = lo; dst[1] = hi4;
    }
}

__device__ __forceinline__ void p4_dilated(const Args& a, LAS unsigned char* lds, volatile LAS unsigned* MISC, int wave, int lane) {
    unsigned char* ws = a.ws;
    const int r32 = lane & 31, hi = lane >> 5;
#ifndef MLA_PV_BF16
    p4_v8t(ws);
#endif
    {
        LAS unsigned* nm = (LAS unsigned*)(MISC + MI_NRM);
        if (threadIdx.x < 32) nm[threadIdx.x] = 0u;
        __syncthreads();
        const bf16_t* QB = (const bf16_t*)(ws + WS_QB); const bf16_t* KIM = (const bf16_t*)(ws + WS_KIMG); const bf16_t* KR = (const bf16_t*)(ws + WS_KR);
        const int gw = blockIdx.x * NWAVES + wave, NGW = gridDim.x * NWAVES;
#ifndef NORMS_PASS
        for (int t = gw; t < 0; t += NGW) {
#else
        for (int t = gw; t < T; t += NGW) {
#endif
            const int b = t >> 14;
            const u32x2* qp = (const u32x2*)(QB + (size_t)t * 768 + 12 * lane);
            const u32x2 q0 = qp[0], q1 = qp[1], q2 = qp[2];
            float sq = (bflo(q0.x) * bflo(q0.x) + bfhi(q0.x) * bfhi(q0.x)) + (bflo(q0.y) * bflo(q0.y) + bfhi(q0.y) * bfhi(q0.y));
            sq += (bflo(q1.x) * bflo(q1.x) + bfhi(q1.x) * bfhi(q1.x)) + (bflo(q1.y) * bflo(q1.y) + bfhi(q1.y) * bfhi(q1.y));
            sq += (bflo(q2.x) * bflo(q2.x) + bfhi(q2.x) * bfhi(q2.x)) + (bflo(q2.y) * bflo(q2.y) + bfhi(q2.y) * bfhi(q2.y));
            float kk8[8]; unpack8(*(const u32x4*)(KIM + (size_t)((b * 8 + (lane >> 3)) * 256 + ((t & (SEQ - 1)) >> 6)) * 6144 + (lane & 7) * 512 + (t & 63) * 8), kk8);
            float sk = 0.f;
#pragma unroll
            for (int j = 0; j < 8; ++j) sk += kk8[j] * kk8[j];
            float kr8[8]; unpack8(*(const u32x4*)(KR + (size_t)t * 32 + 8 * (lane & 3)), kr8);
            float sr = 0.f;
#pragma unroll
            for (int j = 0; j < 8; ++j) sr += kr8[j] * kr8[j];
            sr += __shfl_xor(sr, 1); sr += __shfl_xor(sr, 2);
            sq += __shfl_xor(sq, 1); sq += __shfl_xor(sq, 2); sq += __shfl_xor(sq, 4);
            sk += __shfl_xor(sk, 1); sk += __shfl_xor(sk, 2); sk += __shfl_xor(sk, 4);
            sk += sr;
            if ((lane & 7) == 0) { const int hh = lane >> 3;
                __hip_atomic_fetch_max(&nm[b * 8 + hh], __float_as_uint(sq), __ATOMIC_RELAXED, __HIP_MEMORY_SCOPE_WORKGROUP);
                __hip_atomic_fetch_max(&nm[16 + b * 8 + hh], __float_as_uint(sk), __ATOMIC_RELAXED, __HIP_MEMORY_SCOPE_WORKGROUP); }
        }
        __syncthreads();
        { int tx = threadIdx.x; asm volatile("" : "+v"(tx));
          if (tx < 32) __hip_atomic_fetch_max((unsigned*)(ws + WS_CTL) + CW_NRM + tx, nm[tx], __ATOMIC_RELAXED, __HIP_MEMORY_SCOPE_AGENT); }
    }
    __syncthreads();
    const bf16_t* QA = (const bf16_t*)(ws + WS_QA); const bf16_t* KA = (const bf16_t*)(ws + WS_KA); const bf16_t* VA = (const bf16_t*)(ws + WS_VA);
    bf16_t* PO = (bf16_t*)(ws + WS_PARTO); float* PL = (float*)(ws + WS_PARTL);
    constexpr int DK = 0, DV = 98304, DWS = 147456;
    const unsigned lds0 = (unsigned)(uintptr_t)lds;
    LAS float* wsf = (LAS float*)(lds + DWS) + wave * 64;
    const int NU = NB * 8 * 192, G_ = gridDim.x;
#define DIL_DECODE(un, p, dil, res, blk, L, b, h) int p, dil, res, blk, L; const int b = ((un) / 192) >> 3, h = ((un) / 192) & 7; { const int w_ = (un) % 192; \
        if (w_ < 64) { p = 0; dil = 1; res = 0; blk = w_; L = SEQ; } else if (w_ < 128) { p = 1; dil = 4; res = (w_ - 64) >> 4; blk = (w_ - 64) & 15; L = SEQ / 4; } else { p = 2; dil = 16; res = (w_ - 128) >> 2; blk = (w_ - 128) & 3; L = SEQ / 16; } }
#ifdef PROBE_DIL_X2K
#define DIL_X2K(x) x
#else
#define DIL_X2K(x)
#endif
#define DIL_DMA_K(un, kb) do { DIL_DECODE(un, p_, dil_, res_, blk_, L_, b_, h_) (void)p_; const int u0_ = 256 * blk_ - 64; _Pragma("unroll") for (int j = 0; j < 6; ++j) { \
        int uk = u0_ + 64 * j + lane; uk = uk < 0 ? 0 : (uk >= L_ ? L_ - 1 : uk); \
        mla::glds16(KA + ((size_t)b_ * SEQ + (size_t)(res_ + dil_ * uk)) * 512 + h_ * 64 + wave * 8, (unsigned)__builtin_amdgcn_readfirstlane(lds0 + DK + (kb) * 49152 + j * 8192 + wave * 1024)); \
        DIL_X2K(mla::glds16(KA + ((size_t)b_ * SEQ + (size_t)(res_ + dil_ * uk)) * 512 + h_ * 64 + wave * 8, (unsigned)__builtin_amdgcn_readfirstlane(lds0 + DK + (kb) * 49152 + j * 8192 + wave * 1024))); } } while (0)
#define DIL_DMA_V(un) do { DIL_DECODE(un, p_, dil_, res_, blk_, L_, b_, h_) (void)p_; const int u0_ = 256 * blk_ - 64; _Pragma("unroll") for (int j = 0; j < 6; ++j) { \
        int uv = u0_ + 64 * j + 16 * (wave & 3) + (lane >> 2); uv = uv < 0 ? 0 : (uv >= L_ ? L_ - 1 : uv); \
        mla::glds16(VA + ((size_t)b_ * SEQ + (size_t)(res_ + dil_ * uv)) * 512 + h_ * 64 + (wave >> 2) * 32 + (lane & 3) * 8, (unsigned)__builtin_amdgcn_readfirstlane(lds0 + DV + j * 8192 + wave * 1024)); } } while (0)
#define DIL_LOAD_Q(un, q) do { DIL_DECODE(un, p_, dil_, res_, blk_, L_, b_, h_) (void)p_; (void)L_; const size_t tq_ = (size_t)b_ * SEQ + (size_t)(res_ + dil_ * (256 * blk_ + 32 * wave + r32)); \
        _Pragma("unroll") for (int d0 = 0; d0 < 4; ++d0) q[d0] = *(const bf16x8*)(QA + tq_ * 512 + h_ * 64 + 16 * d0 + 8 * hi); } while (0)
    float dr[16];
#pragma unroll
    for (int r = 0; r < 16; ++r) dr[r] = (float)(crow(r, hi) - r32);
    int un = blockIdx.x, it = 0;
    bf16x8 qn[4] = {};
    if (un < NU) { DIL_LOAD_Q(un, qn); DIL_DMA_K(un, 0); DIL_DMA_V(un); }
    for (; un < NU; un += G_, ++it) {
        DIL_DECODE(un, p, dil, res, blk, L, b, h)
        const size_t bo = (size_t)b * SEQ; const int kb = it & 1;
        const int ur = 256 * blk + 32 * wave;
        const float slope2d = __builtin_amdgcn_exp2f(-(float)(h + 1)) * LOG2E * (float)dil;
        float sdr[16];
#pragma unroll
        for (int r = 0; r < 16; ++r) sdr[r] = slope2d * dr[r];
        asm volatile("s_waitcnt vmcnt(6)\n\ts_barrier" ::: "memory");
#define DIL_KC(c) (-slope2d * (float)((c) < 2 ? 64 - 32 * (c) : 32 * (c) - 64))
#define DIL_SCORE(c, sc) f32x16 sc = {}; { const int cw = wave + (c), j = cw >> 1, n = cw & 1; \
            const LAS char* kp = (const LAS char*)lds + DK + kb * 49152 + j * 8192 + hi * 1024 + (32 * n + r32) * 16; \
            _Pragma("unroll") for (int d0 = 0; d0 < 4; ++d0) sc = __builtin_amdgcn_mfma_f32_32x32x16_bf16(*(const LAS bf16x8*)(kp + d0 * 2048), qn[d0], sc, 0, 0, 0); \
            const int vb = ur - 64 + 32 * (c); \
              \
              \
            if ((c) < 2) { _Pragma("unroll") for (int r = 0; r < 16; ++r) sc[r] += sdr[r]; } \
            else if ((c) == 2) { _Pragma("unroll") for (int r = 0; r < 16; ++r) sc[r] -= fabsf(sdr[r]); } \
            else { _Pragma("unroll") for (int r = 0; r < 16; ++r) sc[r] -= sdr[r]; } \
            if ((c) == 0) { _Pragma("unroll") for (int r = 0; r < 16; ++r) sc[r] = (dr[r] >= 0.f) ? sc[r] : -1e30f; }       \
            if ((c) == 4) { _Pragma("unroll") for (int r = 0; r < 16; ++r) sc[r] = (dr[r] <= 0.f) ? sc[r] : -1e30f; }       \
            if (vb < 0 || vb + 31 >= L) { _Pragma("unroll") for (int r = 0; r < 16; ++r) { const int v = vb + crow(r, hi); sc[r] = (v >= 0 && v < L) ? sc[r] : -1e30f; } } }
        float mx = -1e30f;
#ifdef DIL_TWO_SWEEPS
#pragma unroll
        for (int c = 0; c < 5; ++c) { DIL_SCORE(c, sc)
#pragma unroll
            for (int r = 0; r < 16; ++r) mx = fmaxf(mx, sc[r] + DIL_KC(c));
            asm volatile("" : "+v"(mx) :: "memory"); __builtin_amdgcn_sched_barrier(0); }
        mx = swapmax(mx);
#else
        f32x16 sc2;
        { DIL_SCORE(2, sc)
#pragma unroll
            for (int r = 0; r < 16; ++r) mx = fmaxf(mx, sc[r]);
            sc2 = sc;
            asm volatile("" : "+v"(mx), "+v"(sc2) :: "memory"); __builtin_amdgcn_sched_barrier(0); }
        mx = swapmax(mx) + 32.f;
#endif
        float ps = 0.f; u32x4 pw[5][2];
#pragma unroll
        for (int c = 0; c < 5; ++c) {
#ifdef DIL_TWO_SWEEPS
            DIL_SCORE(c, sc)
#else
            f32x16 sc; if (c == 2) sc = sc2; else { DIL_SCORE(c, scx) sc = scx; }
#endif
            const float mc = mx - DIL_KC(c);
#pragma unroll
            for (int r = 0; r < 16; ++r) { sc[r] = fexp2(sc[r] - mc); ps += sc[r]; }
            pw[c][0] = (u32x4){cvtpk(sc[0], sc[1]), cvtpk(sc[2], sc[3]), cvtpk(sc[4], sc[5]), cvtpk(sc[6], sc[7])};
            pw[c][1] = (u32x4){cvtpk(sc[8], sc[9]), cvtpk(sc[10], sc[11]), cvtpk(sc[12], sc[13]), cvtpk(sc[14], sc[15])};
            asm volatile("" : "+v"(ps), "+v"(pw[c][0]), "+v"(pw[c][1]) :: "memory"); __builtin_amdgcn_sched_barrier(0); }
#if !defined(DIL_TWO_SWEEPS) && !defined(DIL_NO_GUARD)
#ifdef DIL_FORCE_REDO
        if (true) {
#else
        if (__builtin_expect(__any(!(ps < 3.0e38f)), 0)) {
#endif
            mx = -1e30f;
#pragma unroll
            for (int c = 0; c < 5; ++c) { DIL_SCORE(c, sc)
#pragma unroll
                for (int r = 0; r < 16; ++r) mx = fmaxf(mx, sc[r] + DIL_KC(c));
                asm volatile("" : "+v"(mx) :: "memory"); __builtin_amdgcn_sched_barrier(0); }
            mx = swapmax(mx); ps = 0.f;
#pragma unroll
            for (int c = 0; c < 5; ++c) { DIL_SCORE(c, sc) const float mc = mx - DIL_KC(c);
#pragma unroll
                for (int r = 0; r < 16; ++r) { sc[r] = fexp2(sc[r] - mc); ps += sc[r]; }
                pw[c][0] = (u32x4){cvtpk(sc[0], sc[1]), cvtpk(sc[2], sc[3]), cvtpk(sc[4], sc[5]), cvtpk(sc[6], sc[7])};
                pw[c][1] = (u32x4){cvtpk(sc[8], sc[9]), cvtpk(sc[10], sc[11]), cvtpk(sc[12], sc[13]), cvtpk(sc[14], sc[15])};
                asm volatile("" : "+v"(ps), "+v"(pw[c][0]), "+v"(pw[c][1]) :: "memory"); __builtin_amdgcn_sched_barrier(0); }
        }
#endif
#undef DIL_SCORE
#undef DIL_KC
        if (un + G_ < NU) DIL_LOAD_Q(un + G_, qn);
        const float lt = swapsum(ps);
        if (hi == 0) { wsf[32 + r32] = lt; PL[(((size_t)p * NB + b) * 8 + h) * SEQ + (res + dil * (ur + r32))] = mx + __builtin_amdgcn_logf(lt); }
        asm volatile("s_waitcnt vmcnt(0) lgkmcnt(0)\n\ts_barrier" ::: "memory");
        if (un + G_ < NU) DIL_DMA_K(un + G_, kb ^ 1);
        f32x16 o0 = {}, o1 = {};
#pragma unroll
        for (int c = 0; c < 5; ++c) {
            const int cw = wave + c, j = cw >> 1, n = cw & 1;
            const LAS char* vp = (const LAS char*)lds + DV + j * 8192 + n * 2048 + ((lane >> 4) & 1) * 32 + (lane & 3) * 8 + (4 * hi + ((lane & 15) >> 2)) * 64;
#pragma unroll
            for (int ks = 0; ks < 2; ++ks) {
                const s16x4 l0 = vtr(vp + ks * 1024), h0 = vtr(vp + ks * 1024 + 512), l1 = vtr(vp + 4096 + ks * 1024), h1 = vtr(vp + 4096 + ks * 1024 + 512);
                const bf16x8 v0 = {l0[0], l0[1], l0[2], l0[3], h0[0], h0[1], h0[2], h0[3]}, v1 = {l1[0], l1[1], l1[2], l1[3], h1[0], h1[1], h1[2], h1[3]};
                const bf16x8 pa = __builtin_bit_cast(bf16x8, pw[c][ks]);
                o0 = __builtin_amdgcn_mfma_f32_32x32x16_bf16(pa, v0, o0, 0, 0, 0);
                o1 = __builtin_amdgcn_mfma_f32_32x32x16_bf16(pa, v1, o1, 0, 0, 0);
            }
        }
        { LAS bf16_t* stg = (LAS bf16_t*)(lds + DK + kb * 49152) + wave * 2048;
#pragma unroll
          for (int r = 0; r < 16; ++r) { const int q = crow(r, hi); const float il = frcp(wsf[32 + q]);
              const unsigned w01 = cvtpk(o0[r] * il, o1[r] * il);
              stg[q * 64 + r32] = (bf16_t)(w01 & 0xffffu); stg[q * 64 + 32 + r32] = (bf16_t)(w01 >> 16); }
#pragma unroll
          for (int i = 0; i < 4; ++i) { const int row = i * 8 + (lane >> 3), ch = lane & 7; const u32x4 v = *(const LAS u32x4*)(stg + row * 64 + ch * 8);
              *(u32x4*)(PO + ((size_t)p * T + bo + (size_t)(res + dil * (ur + row))) * 512 + h * 64 + ch * 8) = v; } }
        asm volatile("s_waitcnt lgkmcnt(0)\n\ts_barrier" ::: "memory");
        if (un + G_ < NU) DIL_DMA_V(un + G_);
    }
    asm volatile("s_waitcnt vmcnt(0)" ::: "memory");
    __syncthreads();
#undef DIL_LOAD_Q
#undef DIL_DECODE
#undef DIL_DMA_K
#undef DIL_DMA_V
}
__device__ __forceinline__ void p5_combine(const Args& a, int wave, int lane) {
    unsigned char* ws = a.ws; const bf16_t* PO = (const bf16_t*)(ws + WS_PARTO); const float* PL = (const float*)(ws + WS_PARTL); bf16_t* OA = (bf16_t*)(ws + WS_OA);
    const int gw = blockIdx.x * NWAVES + wave, NGW = gridDim.x * NWAVES;
    for (int it = gw; it < T; it += NGW) {
        const int t = it, b = t >> 14, s = t & (SEQ - 1), h = lane >> 3, ch = lane & 7;
        const float l0 = PL[(((size_t)0 * NB + b) * 8 + h) * SEQ + s], l1 = PL[(((size_t)1 * NB + b) * 8 + h) * SEQ + s], l2 = PL[(((size_t)2 * NB + b) * 8 + h) * SEQ + s];
        const float mx = fmaxf(fmaxf(l0, l1), l2); float w0 = fexp2(l0 - mx), w1 = fexp2(l1 - mx), w2 = fexp2(l2 - mx); const float iw = frcp(w0 + w1 + w2); w0 *= iw; w1 *= iw; w2 *= iw;
        float v0[8], v1[8], v2[8], o[8];
        unpack8(*(const u32x4*)(PO + ((size_t)0 * T + t) * 512 + h * 64 + ch * 8), v0);
        unpack8(*(const u32x4*)(PO + ((size_t)1 * T + t) * 512 + h * 64 + ch * 8), v1);
        unpack8(*(const u32x4*)(PO + ((size_t)2 * T + t) * 512 + h * 64 + ch * 8), v2);
#pragma unroll
        for (int j = 0; j < 8; ++j) o[j] = w0 * v0[j] + w1 * v1[j] + w2 * v2[j];
#ifdef OAB_FP8
        *(u32x2*)((unsigned char*)OA + (size_t)t * 512 + h * 64 + ch * 8) = (u32x2){pack4_fp8(32.f * o[0], 32.f * o[1], 32.f * o[2], 32.f * o[3]), pack4_fp8(32.f * o[4], 32.f * o[5], 32.f * o[6], 32.f * o[7])};
#else
        *(u32x4*)(OA + (size_t)t * 512 + h * 64 + ch * 8) = pack8(o);
#endif
    }
}
__device__ __forceinline__ void p5_mla(const Args& a, LAS unsigned char* lds, int wave, int lane) {
    unsigned char* ws = a.ws;
    LAS char* vimg = (LAS char*)(lds + wave * 8192); LAS float* wsf = (LAS float*)(lds + wave * 8192 + 4096);
    const int r32 = lane & 31, hi = lane >> 5;
    const bf16_t* QB = (const bf16_t*)(ws + WS_QB); const bf16_t* KIM = (const bf16_t*)(ws + WS_KIMG); const bf16_t* VIM = (const bf16_t*)(ws + WS_VIMG);
    bf16_t* OB = (bf16_t*)(ws + WS_OB);
    const unsigned* nrm = (const unsigned*)(ws + WS_CTL) + CW_NRM;
    unsigned redo = 0u;
    bgc::Bg bg; bg.init(a.in[14], a.in[16], ws, lds, wave, lane);
#ifdef BG_CONV
    { int tx = threadIdx.x; asm volatile("" : "+v"(tx));
      for (int i = tx; i < 1024; i += NTHREADS) ((LAS float*)(lds + bgc::LDS_G2))[i] = a.in[11][i];
      if (tx < 64) ((LAS float*)(lds + bgc::LDS_G2))[bgc::G2_ONES + tx] = 1.f; }
    __syncthreads();
    for (int tk = 0; tk < 4; ++tk) bg.tick_sync(tk, false);
    bg.q = 4;
#endif
    { int it = 0;
    for (int un = blockIdx.x; un < NB * 8 * 64; un += gridDim.x, ++it) {
#ifdef MLA_XCD_MAP
        int qb = un & 63, h = (un >> 6) & 7, b = un >> 9;
        if (gridDim.x == 256) { const int k_ = un >> 8, bx_ = un & 255, pair = (bx_ & 7) + 8 * (k_ >> 1); qb = (bx_ >> 3) + 32 * (k_ & 1); h = pair & 7; b = pair >> 3; }
#else
        const int qb = un & 63, h = (un >> 6) & 7, b = un >> 9;
#endif
        bool fast = true;
#ifdef MLA_FORCE_GENERAL
        fast = false;
#endif
#ifdef MLA_BF16_FAST
        if (__builtin_amdgcn_readfirstlane((int)fast)) mla::mla_unit(b, h, qb, QB, KIM + (size_t)(b * 8 + h) * 256 * 6144, VIM + (size_t)(b * 8 + h) * 256 * 4096, OB, (LAS char*)lds);
#elif defined(MLA_PV_BF16)
        if (__builtin_amdgcn_readfirstlane((int)fast)) mla8::mla8_unit(b, h, qb, (const unsigned char*)(ws + WS_Q8), (const unsigned char*)(ws + WS_K8) + (size_t)(b * 8 + h) * 256 * 6144, VIM + (size_t)(b * 8 + h) * 256 * 4096, OB, (LAS char*)lds);
#else
        if (__builtin_amdgcn_readfirstlane((int)fast)) {
            const bool r = mla88::mla88_unit(b, h, qb, (const unsigned char*)(ws + WS_Q8), (const unsigned char*)(ws + WS_K8) + (size_t)(b * 8 + h) * 256 * 6144, (const unsigned char*)(ws + WS_V8T) + (size_t)(b * 8 + h) * 256 * 4096, OB, (LAS char*)lds, bg);
            redo |= (unsigned)__builtin_amdgcn_readfirstlane((int)r) << it;
        }
#endif
    } }
#ifdef BG_CONV
    if (!bg.fast()) bg.q = 0;
    while (bg.q < bg.q_end()) { bg.tick_sync(bg.q, bg.q >= 4); bg.q += 1; }
#endif
    int it2 = 0;
#ifdef TIME_PROBE
    redo = 0u;
#endif
    for (int un = blockIdx.x; un < NB * 8 * 64; un += gridDim.x, ++it2) {
#ifdef MLA_XCD_MAP
        int qb = un & 63, h = (un >> 6) & 7, b = un >> 9;
        if (gridDim.x == 256) { const int k_ = un >> 8, bx_ = un & 255, pair = (bx_ & 7) + 8 * (k_ >> 1); qb = (bx_ >> 3) + 32 * (k_ & 1); h = pair & 7; b = pair >> 3; }
#else
        const int qb = un & 63, h = (un >> 6) & 7, b = un >> 9;
#endif
        bool fast = !((redo >> it2) & 1u);
#ifdef MLA_FORCE_GENERAL
        fast = false;
#endif
        if (!__builtin_amdgcn_readfirstlane((int)fast)) {
            const size_t bo = (size_t)b * SEQ, tq0 = bo + (size_t)qb * 256 + wave * 32;
#ifdef KEEP_BF16_IMAGES
            MlaKL kl; kl.K = KIM + (size_t)(b * 8 + h) * 256 * 6144; kl.V = VIM + (size_t)(b * 8 + h) * 256 * 4096;
            bf16x8 qf[6];
#pragma unroll
            for (int d0 = 0; d0 < 6; ++d0) qf[d0] = *(const bf16x8*)(QB + (tq0 + r32) * 768 + h * 96 + 16 * d0 + 8 * hi);
#else
            MlaKL8 kl; kl.K = ws + WS_K8 + (size_t)(b * 8 + h) * 256 * 6144; kl.V = VIM + (size_t)(b * 8 + h) * 256 * 4096;
            bf16x8 qf[6];
#pragma unroll
            for (int d0 = 0; d0 < 6; ++d0) qf[d0] = fp8x8_to_bf16(*(const u32x2*)(ws + WS_Q8 + (tq0 + r32) * 768 + h * 96 + 16 * d0 + 8 * hi), 0.0625f);
#endif
            AttnState st; wave_attn<6>(st, qf, kl, SEQ / 32, vimg, wsf, lane);
            (void)attn_finish(st, vimg, wsf, lane);
#pragma unroll
            for (int i = 0; i < 4; ++i) { const int row = i * 8 + (lane >> 3), ch = lane & 7; const u32x4 v = *(const LAS u32x4*)(vimg + row * 128 + ch * 16);
#ifdef OAB_FP8
                float f8_[8]; unpack8(v, f8_);
                *(u32x2*)((unsigned char*)OB + (tq0 + row) * 512 + h * 64 + ch * 8) = (u32x2){pack4_fp8(32.f * f8_[0], 32.f * f8_[1], 32.f * f8_[2], 32.f * f8_[3]), pack4_fp8(32.f * f8_[4], 32.f * f8_[5], 32.f * f8_[6], 32.f * f8_[7])}; }
#else
                *(u32x4*)(OB + (tq0 + row) * 512 + h * 64 + ch * 8) = v; }
#endif
        }
    }
}

__device__ __forceinline__ void p8_router(const Args& a, LAS unsigned char* lds, volatile LAS unsigned* MISC, int wave, int lane) {
    unsigned char* ws = a.ws; const float* x1 = a.out; const float* wrp = (const float*)(ws + WS_WRP); const float* br = a.in[13];
    LAS float* lg = (LAS float*)(lds + wave * 8192);
    LAS unsigned* hist = (LAS unsigned*)(MISC + MI_HIST);
    if (threadIdx.x < 32) hist[threadIdx.x] = 0u;
    __syncthreads();
    const int G = gridDim.x, i32 = lane & 31, hi = lane >> 5;
    for (int tb = wave * G + blockIdx.x; tb < T / 32; tb += G * NWAVES) {
        const int t = tb * 32 + i32;
        const float* xr = x1 + (size_t)t * DM + 512 * hi; const float* wr_ = wrp + (size_t)(512 * hi) * 32 + i32;
        f32x16 acc = {}; float ssq = 0.f;
#define RT_LOAD(xv, s) do { _Pragma("unroll") for (int j = 0; j < 8; ++j) xv[j] = *(const f32x4*)(xr + 32 * (s) + 4 * j); } while (0)
#define RT_MMA(xv, s) do { _Pragma("unroll") for (int j = 0; j < 8; ++j) { const f32x4 xa = xv[j]; const int k4 = 32 * (s) + 4 * j; \
                ssq += (xa.x * xa.x + xa.y * xa.y) + (xa.z * xa.z + xa.w * xa.w); \
                acc = __builtin_amdgcn_mfma_f32_32x32x2f32(xa.x, wr_[(k4 + 0) * 32], acc, 0, 0, 0); \
                acc = __builtin_amdgcn_mfma_f32_32x32x2f32(xa.y, wr_[(k4 + 1) * 32], acc, 0, 0, 0); \
                acc = __builtin_amdgcn_mfma_f32_32x32x2f32(xa.z, wr_[(k4 + 2) * 32], acc, 0, 0, 0); \
                acc = __builtin_amdgcn_mfma_f32_32x32x2f32(xa.w, wr_[(k4 + 3) * 32], acc, 0, 0, 0); } } while (0)
        { f32x4 xb[8], xn[8];
          RT_LOAD(xb, 0);
#pragma unroll 1
          for (int s32 = 0; s32 < 16; s32 += 2) {
              RT_LOAD(xn, s32 + 1); RT_MMA(xb, s32);
              if (s32 + 2 < 16) RT_LOAD(xb, s32 + 2);
              RT_MMA(xn, s32 + 1);
          } }
#undef RT_LOAD
#undef RT_MMA
        ssq = swapsum(ssq);
        const float rstd = 1.f / sqrtf(ssq * (1.f / DM) + EPS);
#pragma unroll
        for (int r = 0; r < 16; ++r) lg[crow(r, hi) * 33 + i32] = acc[r];
        asm volatile("s_waitcnt lgkmcnt(0)" ::: "memory");
        float v[32];
#pragma unroll
        for (int e = 0; e < 32; ++e) v[e] = lg[i32 * 33 + e] * rstd + br[e];
        int ti[4]; float tv[4];
#pragma unroll
        for (int k = 0; k < 4; ++k) {
            float best = v[0]; int bi = 0;
#pragma unroll
            for (int e = 1; e < 32; ++e) { const bool g = v[e] > best; best = g ? v[e] : best; bi = g ? e : bi; }
            ti[k] = bi; tv[k] = best;
#pragma unroll
            for (int e = 0; e < 32; ++e) v[e] = (e == bi) ? -3.0e38f : v[e];
        }
        const float e1 = __expf(tv[1] - tv[0]), e2 = __expf(tv[2] - tv[0]), e3 = __expf(tv[3] - tv[0]); const float inv = 1.f / (1.f + e1 + e2 + e3);
        const float gw[4] = {inv, e1 * inv, e2 * inv, e3 * inv};
        if (hi == 0) {
            ((float*)(ws + WS_RSTD2))[t] = rstd;
#pragma unroll
            for (int k = 0; k < 4; ++k) { const unsigned rk = __hip_atomic_fetch_add(&hist[ti[k]], 1u, __ATOMIC_RELAXED, __HIP_MEMORY_SCOPE_WORKGROUP);
                ((int*)(ws + WS_TOPI))[t * 4 + k] = ti[k]; ((float*)(ws + WS_GATEW))[t * 4 + k] = gw[k]; ((int*)(ws + WS_SRANK))[t * 4 + k] = (int)rk; }
        }
        asm volatile("s_waitcnt lgkmcnt(0)" ::: "memory");
    }
    __syncthreads();
    { int tx = threadIdx.x; asm volatile("" : "+v"(tx));
      if (tx < 32) {
        const unsigned c = hist[tx];
        const unsigned base = __hip_atomic_fetch_add((unsigned*)(ws + WS_CTL) + CW_GCOUNT + tx, c, __ATOMIC_RELAXED, __HIP_MEMORY_SCOPE_AGENT);
        ((int*)(ws + WS_WGBASE))[blockIdx.x * 32 + tx] = (int)base;
      } }
}
__device__ __forceinline__ void moe_prefix(const Args& a, volatile LAS unsigned* MISC) {
    if (threadIdx.x < 64) {
        const unsigned* gc = (const unsigned*)(a.ws + WS_CTL) + CW_GCOUNT; const int e = threadIdx.x & 31;
        const int c = (int)__hip_atomic_load(gc + e, __ATOMIC_RELAXED, __HIP_MEMORY_SCOPE_AGENT), pad = (c + 255) & ~255;
        int inc = pad;
#pragma unroll
        for (int o = 1; o < 32; o <<= 1) { const int v = __shfl_up(inc, o, 32); if (e >= o) inc += v; }
        if (threadIdx.x < 32) { MISC[MI_PSTART + e] = (unsigned)(inc - pad); MISC[MI_TPRE + e] = (unsigned)((inc - pad) >> 8);
            if (e == 31) { MISC[MI_PSTART + 32] = (unsigned)inc; MISC[MI_TPRE + 32] = (unsigned)(inc >> 8); } }
    }
    __syncthreads();
}
__device__ __forceinline__ void p9_scatter(const Args& a, volatile LAS unsigned* MISC) {
    unsigned char* ws = a.ws; const int G = gridDim.x;
    moe_prefix(a, MISC);
    const int* topi = (const int*)(ws + WS_TOPI); const int* srank = (const int*)(ws + WS_SRANK); const int* wgbase = (const int*)(ws + WS_WGBASE); const float* rstd2 = (const float*)(ws + WS_RSTD2);
    int* pos = (int*)(ws + WS_POS); int* rowtok = (int*)(ws + WS_ROWTOK); float* rowscale = (float*)(ws + WS_ROWSCALE);
    for (int sl = blockIdx.x * NTHREADS + threadIdx.x; sl < NSLOT; sl += G * NTHREADS) {
        const int t = sl >> 2, e = topi[sl], wg = (t >> 5) % G;
        const int row = (int)MISC[MI_PSTART + e] + wgbase[wg * 32 + e] + srank[sl];
        pos[sl] = row; rowtok[row] = t; rowscale[row] = rstd2[t];
    }
    if (blockIdx.x < 32) {
        const int e = blockIdx.x; const int c = (int)__hip_atomic_load((const unsigned*)(ws + WS_CTL) + CW_GCOUNT + e, __ATOMIC_RELAXED, __HIP_MEMORY_SCOPE_AGENT);
        const int r0 = (int)MISC[MI_PSTART + e] + c, r1 = (int)MISC[MI_PSTART + e + 1];
        for (int r = r0 + threadIdx.x; r < r1; r += NTHREADS) { rowtok[r] = 0; rowscale[r] = 0.f; }
    }
}
__device__ __forceinline__ void p12_final(const Args& a, int wave, int lane) {
    unsigned char* ws = a.ws; const int gw = blockIdx.x * NWAVES + wave, NGW = gridDim.x * NWAVES;
    const int* pos = (const int*)(ws + WS_POS); const float* gatew = (const float*)(ws + WS_GATEW); const unsigned char* Y = ws + WS_Y;
    f32x4 g[4];
#pragma unroll
    for (int j = 0; j < 4; ++j) g[j] = ((const f32x4*)a.in[18])[lane + 64 * j];
    for (int t = gw; t < T; t += NGW) {
        f32x4* xr = (f32x4*)(a.out + (size_t)t * DM) + lane;
        f32x4 v[4];
#pragma unroll
        for (int j = 0; j < 4; ++j) v[j] = xr[64 * j];
#ifndef DBG_NO_MOE
#pragma unroll
        for (int k = 0; k < 4; ++k) {
            const int row = pos[t * 4 + k]; const float w = gatew[t * 4 + k] * (1.f / 16.f);
            const unsigned* yr = (const unsigned*)(Y + (size_t)row * DM) + lane;
#pragma unroll
            for (int j = 0; j < 4; ++j) { const int y = (int)yr[64 * j]; const f32x2 lo = __builtin_amdgcn_cvt_pk_f32_fp8(y, false), hi = __builtin_amdgcn_cvt_pk_f32_fp8(y, true);
                v[j].x += w * lo.x; v[j].y += w * lo.y; v[j].z += w * hi.x; v[j].w += w * hi.y; }
        }
#endif
        float s2 = 0.f;
#pragma unroll
        for (int j = 0; j < 4; ++j) s2 += (v[j].x * v[j].x + v[j].y * v[j].y) + (v[j].z * v[j].z + v[j].w * v[j].w);
        const float rstd = 1.f / sqrtf(wave_sum(s2) * (1.f / DM) + EPS);
#pragma unroll
        for (int j = 0; j < 4; ++j) xr[64 * j] = v[j] * rstd * g[j];
    }
}

#ifdef MLA_CHECK
constexpr size_t CK_BASE = 225 * MiB;
constexpr size_t CK_CKVN = CK_BASE, CK_KRR = CK_CKVN + (size_t)T * 128 * 4, CK_KN = CK_KRR + (size_t)T * 32 * 4, CK_VV = CK_KN + (size_t)T * 512 * 4, CK_QS = CK_VV + (size_t)T * 512 * 4;
constexpr int CK_NS = 16;
constexpr size_t CK_OBS = 224 * MiB;
__device__ __forceinline__ int ck_tok(int i) { const int tb[16] = {0, 1, 255, 256, 4097, 8191, 12345, 16383, 16384, 16385, 20000, 24575, 24576, 30001, 32766, 32767}; return tb[i]; }
__device__ __forceinline__ float blk_sum(float v, float* red) {
    v = wave_sum(v); __syncthreads(); if ((threadIdx.x & 63) == 0) red[threadIdx.x >> 6] = v; __syncthreads(); return red[0] + red[1] + red[2] + red[3];
}
__global__ void __launch_bounds__(256) ck_kv(const float* x, const float* g1, const float* w_in, const float* gkv, const float* w_uk, const float* w_uv, unsigned char* ws) {
    __shared__ float hn[1024]; __shared__ float red[4]; __shared__ float c[160]; __shared__ float cn[128];
    const int t = blockIdx.x, tid = threadIdx.x;
    float s2 = 0.f; for (int k = tid; k < 1024; k += 256) { const float v = x[(size_t)t * 1024 + k]; s2 += v * v; }
    const float rstd = 1.f / sqrtf(blk_sum(s2, red) / 1024.f + EPS);
    for (int k = tid; k < 1024; k += 256) hn[k] = x[(size_t)t * 1024 + k] * rstd * g1[k];
    __syncthreads();
    if (tid < 160) { float acc = 0.f; for (int k = 0; k < 1024; ++k) acc += hn[k] * w_in[(size_t)k * 4000 + 1792 + tid]; c[tid] = acc; }
    __syncthreads();
    const float q2 = blk_sum(tid < 128 ? c[tid] * c[tid] : 0.f, red); const float r2 = 1.f / sqrtf(q2 / 128.f + EPS);
    if (tid < 128) cn[tid] = c[tid] * r2 * gkv[tid];
    if (tid < 16) { const f32x2 cs = rope_cs(t & (SEQ - 1), tid); const float x1 = c[128 + tid], x2 = c[128 + 16 + tid];
        ((float*)(ws + CK_KRR))[(size_t)t * 32 + tid] = x1 * cs.x - x2 * cs.y; ((float*)(ws + CK_KRR))[(size_t)t * 32 + 16 + tid] = x2 * cs.x + x1 * cs.y; }
    __syncthreads();
    for (int o = tid; o < 512; o += 256) { float a = 0.f, b = 0.f; for (int k = 0; k < 128; ++k) { a += cn[k] * w_uk[(size_t)k * 512 + o]; b += cn[k] * w_uv[(size_t)k * 512 + o]; }
        ((float*)(ws + CK_KN))[(size_t)t * 512 + o] = a; ((float*)(ws + CK_VV))[(size_t)t * 512 + o] = b; }
}
__global__ void __launch_bounds__(256) ck_q(const float* x, const float* g1, const float* w_in, const float* gq, const float* w_uq, unsigned char* ws) {
    __shared__ float hn[1024]; __shared__ float red[4]; __shared__ float c[256]; __shared__ float qq[768];
    const int t = ck_tok(blockIdx.x), tid = threadIdx.x;
    float s2 = 0.f; for (int k = tid; k < 1024; k += 256) { const float v = x[(size_t)t * 1024 + k]; s2 += v * v; }
    const float rstd = 1.f / sqrtf(blk_sum(s2, red) / 1024.f + EPS);
    for (int k = tid; k < 1024; k += 256) hn[k] = x[(size_t)t * 1024 + k] * rstd * g1[k];
    __syncthreads();
    { float acc = 0.f; for (int k = 0; k < 1024; ++k) acc += hn[k] * w_in[(size_t)k * 4000 + 1536 + tid]; c[tid] = acc; }
    __syncthreads();
    const float q2 = blk_sum(c[tid] * c[tid], red); const float r2 = 1.f / sqrtf(q2 / 256.f + EPS);
    __syncthreads(); c[tid] = c[tid] * r2 * gq[tid]; __syncthreads();
    for (int o = tid; o < 768; o += 256) { float a = 0.f; for (int k = 0; k < 256; ++k) a += c[k] * w_uq[(size_t)k * 768 + o]; qq[o] = a; }
    __syncthreads();
    if (tid < 128) { const int hh = tid >> 4, i = tid & 15; const f32x2 cs = rope_cs(t & (SEQ - 1), i); const float x1 = qq[hh * 96 + 64 + i], x2 = qq[hh * 96 + 80 + i];
        qq[hh * 96 + 64 + i] = x1 * cs.x - x2 * cs.y; qq[hh * 96 + 80 + i] = x2 * cs.x + x1 * cs.y; }
    __syncthreads();
    for (int o = tid; o < 768; o += 256) ((float*)(ws + CK_QS))[(size_t)blockIdx.x * 768 + o] = qq[o] * 0.10206207261596577f;
}
__global__ void __launch_bounds__(256) ck_attn(unsigned char* ws, unsigned* flag) {
    __shared__ float q[96]; __shared__ float red[4]; __shared__ float part[256]; __shared__ float sc[SEQ];
    const int si = blockIdx.x >> 3, h = blockIdx.x & 7, t = ck_tok(si), b = t >> 14, tid = threadIdx.x;
    const float* KN = (const float*)(ws + CK_KN); const float* VV = (const float*)(ws + CK_VV); const float* KRR = (const float*)(ws + CK_KRR);
    if (tid < 96) q[tid] = ((const float*)(ws + CK_QS))[(size_t)si * 768 + h * 96 + tid];
    __syncthreads();
    float mx = -1e30f;
    for (int s = tid; s < SEQ; s += 256) { const size_t ts = (size_t)b * SEQ + s; float a = 0.f; for (int e = 0; e < 64; ++e) a += q[e] * KN[ts * 512 + h * 64 + e]; for (int e = 0; e < 32; ++e) a += q[64 + e] * KRR[ts * 32 + e]; sc[s] = a; mx = fmaxf(mx, a); }
    for (int o = 1; o < 64; o <<= 1) mx = fmaxf(mx, __shfl_xor(mx, o));
    __syncthreads(); if ((tid & 63) == 0) red[tid >> 6] = mx; __syncthreads(); mx = fmaxf(fmaxf(red[0], red[1]), fmaxf(red[2], red[3])); __syncthreads();
    float l = 0.f;
    for (int s = tid; s < SEQ; s += 256) { const float p = expf(sc[s] - mx); sc[s] = p; l += p; }
    l = blk_sum(l, red);
    const int e = tid & 63, g = tid >> 6; float o = 0.f;
    for (int s = g; s < SEQ; s += 4) o += sc[s] * VV[((size_t)b * SEQ + s) * 512 + h * 64 + e];
    part[tid] = o; __syncthreads();
    if (tid < 64) { const float ref = (part[tid] + part[64 + tid] + part[128 + tid] + part[192 + tid]) / l, got = bf2f(((const bf16_t*)(ws + CK_OBS))[(size_t)si * 512 + h * 64 + tid]);
        atomicMax(flag, __float_as_uint(fabsf(ref - got))); atomicMax(flag + 1, __float_as_uint(fabsf(ref))); }
}
__global__ void ck_apply(float* out, const unsigned* flag) {
    const float d = __uint_as_float(flag[0]), r = __uint_as_float(flag[1]);
    const bool bad = !(r > 0.f) || !(d <= MLA_CHECK_TOL * r);
    if (bad) for (size_t i = (size_t)blockIdx.x * blockDim.x + threadIdx.x; i < (size_t)T * DM; i += (size_t)gridDim.x * blockDim.x) out[i] = __builtin_nanf("");
}
#endif

constexpr int N_PHASES = 13;
#ifndef MOE_REV
#define MOE_REV false
#endif
#ifndef ALIGN_MOE
#define ALIGN_MOE true
#endif
#ifndef REP0
#define REP0 1
#endif
#ifndef REP1
#define REP1 1
#endif
#ifndef REP3
#define REP3 1
#endif
#ifndef REP5
#define REP5 1
#endif
#ifndef REP7
#define REP7 1
#endif
#ifndef REP10
#define REP10 1
#endif
#ifndef REP11
#define REP11 1
#endif
#ifndef MK_ONE_LAUNCH
#define MK_ONE_LAUNCH 0
#endif
__global__ void __launch_bounds__(NTHREADS, 2) fwd(Args args) {
    extern __shared__ __attribute__((aligned(16))) unsigned char lds_raw[];
    LAS unsigned char* lds = (LAS unsigned char*)lds_raw;
    volatile LAS unsigned* MISC = (volatile LAS unsigned*)(lds + MISC_OFF);
    const int tid = threadIdx.x, wave = __builtin_amdgcn_readfirstlane(tid >> 6);
#define lane lane_now()
    const int G = gridDim.x, bx = blockIdx.x;
    unsigned char* ws = args.ws;
    for (int u = tid; u < (LDS_BYTES - MISC_OFF) / 4; u += NTHREADS) ((LAS unsigned*)(lds + MISC_OFF))[u] = 0u;
    __syncthreads();
    XcdBarrier bar; bar.bar = (unsigned*)(ws + WS_CTL) + CW_BAR; bar.x = 0; bar.st = nullptr;
    if (MK_ONE_LAUNCH) bar = xcd_barrier_post((unsigned*)(ws + WS_CTL) + CW_BAR, MISC + MI_BAR);
    const int lo = args.ph_lo, hi = args.ph_hi;
#ifdef ONLY_PHASE
#define IN(k) ((k) == ONLY_PHASE && lo <= (k) && (k) < hi)
#else
#define IN(k) (lo <= (k) && (k) < hi)
#endif
#define SEAM(k) do { if (IN(k) && IN((k) + 1)) xcd_barrier(bar); } while (0)
#ifdef SKEW_TICKS
#define SKEW() do { const unsigned long long t0_ = __builtin_amdgcn_s_memrealtime(); const unsigned long long d_ = (unsigned long long)((bx >> 3) & 7) * SKEW_TICKS; while (__builtin_amdgcn_s_memrealtime() - t0_ < d_) __builtin_amdgcn_s_sleep(4); } while (0)
#else
#define SKEW() do { } while (0)
#endif

#ifndef NCONV
#define NCONV 0
#endif
#ifndef XW_P0_ITEMS
#define XW_P0_ITEMS 17408
#endif
#ifdef XW_ITEM64
    constexpr int XW_ALL = XW_NI;
#else
    constexpr int XW_ALL = 32 * 16 * 64 + 32 * 16 * 32;
#endif
    const int nconv = (G >= 4 * NCONV && ((G - NCONV) & 7) == 0) ? NCONV : 0, NGM = G - nconv, xw_p0 = nconv ? XW_P0_ITEMS : XW_ALL;
    if (IN(0)) { p0_prologue(args, lds, wave, lane, xw_p0);
#if defined(PROBE_RD_A) || defined(PROBE_RD_B)
        p0_probe_read(args, wave, lane);
#endif
#if REP0 > 1
        p0_prologue(args, lds, wave, lane, xw_p0);
#endif
    } SEAM(0);
#ifdef INPROJ_FP8
#define PH1_BODY { pg8::DenseSched S; S.init((const bf16_t*)(ws + WS_XB), (const bf16_t*)(ws + WS_WIN), T, NIN, 512, NGM, bx); EpiInProj E{ws, lds}; \
        pg8::gemm_phase2<EpiInProj, pg8::DenseSched, true, true, 121>(lds, 512, S, E); }
#else
#define PH1_BODY { pg8::DenseSched S; S.init((const bf16_t*)(ws + WS_XB), (const bf16_t*)(ws + WS_WIN), T, NIN, 1024, NGM, bx); EpiInProj E{ws, lds}; \
        pg8::gemm_phase2<EpiInProj, pg8::DenseSched, true>(lds, 1024, S, E); }
#endif
    if (IN(1)) { if (bx < NGM) PH1_BODY else p0_experts(args, lds, wave, lane, (bx - NGM) * NWAVES + wave, nconv * NWAVES, xw_p0, XW_ALL);
#if REP1 > 1
        PH1_BODY
#endif
    } SEAM(1);
#ifdef P2_PHASE
    if (IN(2)) { p2_stats(args, wave, lane); } SEAM(2);
#endif
#define PH3_BODY { { pg8::DenseSched S; S.init((const bf16_t*)(ws + WS_CQ), (const bf16_t*)(ws + WS_WUQ), T, 768, 256, G, bx); EpiQ E{ws}; \
          pg8::gemm_phase2<EpiQ, pg8::DenseSched, true>(lds, 256, S, E); } \
        { pg8::DenseSched S; S.init((const bf16_t*)(ws + WS_CKV), (const bf16_t*)(ws + WS_WUKV), T, 1024, 128, G, bx); EpiKV E{ws}; \
          pg8::gemm_phase2<EpiKV, pg8::DenseSched, true>(lds, 128, S, E); } }
    if (IN(3)) { PH3_BODY
#if REP3 > 1
        PH3_BODY
#endif
    } SEAM(3);
    if (IN(4)) { p4_dilated(args, lds, MISC, wave, lane);
#ifdef REP_DIL
        p4_dilated(args, lds, MISC, wave, lane);
#endif
    } SEAM(4);
#if defined(CLK_PROBE) || defined(TIME_PROBE)
    unsigned long long ck0_ = 0, rt0_ = 0, ck1_ = 0, rt1_ = 0;
#endif
    if (IN(5)) { p5_combine(args, wave, lane);
#if defined(CLK_PROBE) || defined(TIME_PROBE)
        ck0_ = __builtin_amdgcn_s_memtime(); rt0_ = __builtin_amdgcn_s_memrealtime();
#endif
        p5_mla(args, lds, wave, lane);
#if defined(CLK_PROBE) || defined(TIME_PROBE)
        ck1_ = __builtin_amdgcn_s_memtime(); rt1_ = __builtin_amdgcn_s_memrealtime();
#endif
#ifdef REP_MLA
        p5_mla(args, lds, wave, lane);
#endif
    } SEAM(5);
#ifdef MLA_CHECK
    if (IN(6) && bx == 0) { for (int i = tid; i < CK_NS * 512; i += NTHREADS) ((bf16_t*)(ws + CK_OBS))[i] = ((const bf16_t*)(ws + WS_OB))[(size_t)ck_tok(i >> 9) * 512 + (i & 511)]; }
#endif
    if (IN(6)) {
#ifdef OAB_FP8
        { pg8::TwoSegSched S; S.init((const bf16_t*)(ws + WS_OA), (const bf16_t*)(ws + WS_WA), (const bf16_t*)(ws + WS_OB), (const bf16_t*)(ws + WS_WB), T, 1024, 256, G, bx); EpiGateFused E{ws};
          pg8::gemm_phase2<EpiGateFused, pg8::TwoSegSched, true, true, 116>(lds, 256, S, E); }
#else
        { pg8::TwoSegSched S; S.init((const bf16_t*)(ws + WS_OA), (const bf16_t*)(ws + WS_WA), (const bf16_t*)(ws + WS_OB), (const bf16_t*)(ws + WS_WB), T, 1024, 512, G, bx); EpiGateFused E{ws};
          pg8::gemm_phase2<EpiGateFused, pg8::TwoSegSched, true>(lds, 512, S, E); }
#endif
    } SEAM(6);
#ifdef WO_FP8
#define PH7_BODY { pg8::DenseSched S; S.init((const bf16_t*)(ws + WS_MERGED), (const bf16_t*)(ws + WS_WO), T, 1024, 512, G, bx); EpiResid E{ws, args.in[0], args.out}; \
        pg8::gemm_phase2<EpiResid, pg8::DenseSched, true, true, 116>(lds, 512, S, E); }
#else
#define PH7_BODY { pg8::DenseSched S; S.init((const bf16_t*)(ws + WS_MERGED), (const bf16_t*)(ws + WS_WO), T, 1024, 1024, G, bx); EpiResid E{ws, args.in[0], args.out}; \
        pg8::gemm_phase2<EpiResid, pg8::DenseSched, true>(lds, 1024, S, E); }
#endif
    if (IN(7)) { PH7_BODY
#if REP7 > 1
        PH7_BODY
#endif
    } SEAM(7);
    if (IN(8)) { p8_router(args, lds, MISC, wave, lane); } SEAM(8);
    if (IN(9)) { p9_scatter(args, MISC); } SEAM(9);
#define PH10_BODY { moe_prefix(args, MISC); \
        pg8::MoeSched<3, true> S; S.tpre = (const LAS int*)(MISC + MI_TPRE); S.ntiles = (int)MISC[MI_TPRE + 32]; S.G = G; S.c = bx; S.K = 512; \
        S.A = (const char*)(ws + WS_H2); S.Bt = (const char*)(ws + WS_WGU); S.estride = (size_t)2048 * 1024; S.row_tok = (const int*)(ws + WS_ROWTOK); \
        EpiSwiglu E{ws, args.in[15]}; \
        pg8::gemm_phase2<EpiSwiglu, pg8::MoeSched<3, true>, ALIGN_MOE, true, 121>(lds, 512, S, E); }
    if (IN(10)) { SKEW(); PH10_BODY
#if REP10 > 1
        PH10_BODY
#endif
    } SEAM(10);
#define PH11_BODY { moe_prefix(args, MISC); \
        pg8::MoeSched<2, false, MOE_REV> S; S.tpre = (const LAS int*)(MISC + MI_TPRE); S.ntiles = (int)MISC[MI_TPRE + 32]; S.G = G; S.c = bx; S.K = 512; \
        S.A = (const char*)(ws + WS_ACT); S.Bt = (const char*)(ws + WS_WD); S.estride = (size_t)1024 * 1024; S.row_tok = nullptr; \
        EpiDown E{ws, args.in[17]}; \
        pg8::gemm_phase2<EpiDown, pg8::MoeSched<2, false, MOE_REV>, ALIGN_MOE, true, 121>(lds, 512, S, E); }
    if (IN(11)) { SKEW(); PH11_BODY
#if REP11 > 1
        PH11_BODY
#endif
    } SEAM(11);
    if (IN(12)) { p12_final(args, wave, lane); }
#ifdef CLK_PROBE
    if (IN(12) && bx == 0) { __syncthreads(); const float mhz = 500.f * __builtin_rintf(0.2f * (float)(ck1_ - ck0_) / (float)(rt1_ - rt0_)); for (int i = tid; i < 1024; i += NTHREADS) args.out[i] = mhz; }
#endif
#ifdef TIME_PROBE
    if (IN(12) && bx == 0) { __syncthreads(); const float us = 0.01f * (float)(rt1_ - rt0_) - (float)(TIME_PROBE); for (int i = tid; i < 1024; i += NTHREADS) args.out[i] = 1000.f * us; }
#endif
#ifdef PROBE_FP8NAN
    if (IN(12) && bx == 0 && wave == 0) {
        typedef int v8i_ __attribute__((ext_vector_type(8))); typedef short v2s_ __attribute__((ext_vector_type(2)));
        float big = 1.0e5f, one = 1.0f, sc = 16.0f; asm volatile("" : "+v"(big), "+v"(one), "+v"(sc));
        v2s_ u = {0, 0}; u = __builtin_amdgcn_cvt_scalef32_pk_fp8_f32(u, big, one, sc, false); u = __builtin_amdgcn_cvt_scalef32_pk_fp8_f32(u, one, one, sc, true);
        int w = __builtin_bit_cast(int, u); asm volatile("" : "+v"(w));
        const bool cvt_nan = ((w & 0x7f) == 0x7f);
        v8i_ A = {w, w, w, w, w, w, w, w}, B = {0x38383838, 0x38383838, 0x38383838, 0x38383838, 0x38383838, 0x38383838, 0x38383838, 0x38383838};
        f32x16 c = __builtin_amdgcn_mfma_scale_f32_32x32x64_f8f6f4(A, B, f32x16{}, 0, 0, 0, 0x7f7f7f7f, 0, 0x7f7f7f7f);
        asm volatile("" : "+v"(c));
        const bool mf_nan = (c[0] != c[0]) && (c[5] != c[5]) && (c[15] != c[15]);
        if (lane == 0) { if (!cvt_nan) args.out[0] = 3.0e6f; if (!mf_nan) args.out[1] = 7.0e6f; }
    }
#endif
#undef IN
#undef SEAM
#undef lane
}

extern "C" void kernel_launch(void* const* d_in, const int* in_sizes, int n_in, void* d_out, int out_size, void* d_ws, size_t ws_size, hipStream_t stream) {
    static int grid = 0;
    if (grid == 0) {
        if (n_in != 19 || in_sizes[0] != T * DM || out_size != T * DM || ws_size < WS_END) { fprintf(stderr, "kernel_launch: unexpected shapes (n_in %d, in0 %d, out %d, ws %zu); nothing launched\n", n_in, n_in > 0 ? in_sizes[0] : -1, out_size, ws_size); grid = -1; return; }
        int dev = 0, cus = 0, per_cu = 0;
        if (hipGetDevice(&dev) != hipSuccess || hipDeviceGetAttribute(&cus, hipDeviceAttributeMultiprocessorCount, dev) != hipSuccess) { grid = -1; return; }
        if (hipFuncSetAttribute((const void*)fwd, hipFuncAttributeMaxDynamicSharedMemorySize, LDS_BYTES) != hipSuccess) { fprintf(stderr, "kernel_launch: hipFuncSetAttribute failed\n"); grid = -1; return; }
        if (hipOccupancyMaxActiveBlocksPerMultiprocessor(&per_cu, (const void*)fwd, NTHREADS, LDS_BYTES) != hipSuccess || per_cu < 1) fprintf(stderr, "kernel_launch: occupancy query reports %d\n", per_cu);
        (void)hipGetLastError();
        grid = cus;
    }
    if (grid < 0) return;
    if (hipMemsetAsync((char*)d_ws + WS_CTL, 0, CTL_ZERO_BYTES, stream) != hipSuccess) { fprintf(stderr, "kernel_launch: memset failed\n"); return; }
    Args a{};
    for (int i = 0; i < 19; ++i) a.in[i] = (const float*)d_in[i];
    a.out = (float*)d_out; a.ws = (unsigned char*)d_ws; a.li = 0; a.pad = 0;
#if MK_ONE_LAUNCH
    a.ph_lo = 0; a.ph_hi = N_PHASES;
    hipLaunchKernelGGL(fwd, dim3(grid), dim3(NTHREADS), LDS_BYTES, stream, a);
#else
    for (int p = 0; p < N_PHASES; ++p) {
        a.ph_lo = p; a.ph_hi = p + 1; hipLaunchKernelGGL(fwd, dim3(grid), dim3(NTHREADS), LDS_BYTES, stream, a); }

#endif
#ifdef MLA_CHECK
    {   unsigned* flag = (unsigned*)((unsigned char*)d_ws + WS_CTL) + 16384;
        hipLaunchKernelGGL(ck_kv, dim3(T), dim3(256), 0, stream, a.in[0], a.in[1], a.in[2], a.in[4], a.in[6], a.in[7], (unsigned char*)d_ws);
        hipLaunchKernelGGL(ck_q, dim3(CK_NS), dim3(256), 0, stream, a.in[0], a.in[1], a.in[2], a.in[3], a.in[5], (unsigned char*)d_ws);
        hipLaunchKernelGGL(ck_attn, dim3(CK_NS * 8), dim3(256), 0, stream, (unsigned char*)d_ws, flag);
        hipLaunchKernelGGL(ck_apply, dim3(1024), dim3(256), 0, stream, (float*)d_out, (const unsigned*)flag); }
#endif
    const hipError_t le = hipPeekAtLastError();
    if (le != hipSuccess) fprintf(stderr, "kernel_launch: launch failed: %s\n", hipGetErrorName(le));
}
```

```cpp
#define MK_ONE_LAUNCH 1
#define INPROJ_FP8 1
#define WO_FP8 1
#define OAB_FP8 1
#define QK_FP6 1
#define DMA_NODUP 1
#include <hip/hip_runtime.h>
#include <cstdio>
#include <cstdint>

#define LAS __attribute__((address_space(3)))
#define GAS __attribute__((address_space(1)))
typedef unsigned short bf16_t;
typedef short bf16x8 __attribute__((ext_vector_type(8)));
typedef short s16x4 __attribute__((ext_vector_type(4)));
typedef float f32x2 __attribute__((ext_vector_type(2)));
typedef float f32x4 __attribute__((ext_vector_type(4)));
typedef float f32x16 __attribute__((ext_vector_type(16)));
typedef unsigned u32x2 __attribute__((ext_vector_type(2)));
typedef unsigned u32x4 __attribute__((ext_vector_type(4)));

constexpr int NB = 2, SEQ = 16384, T = NB * SEQ, DM = 1024;
constexpr int NIN = 4096;
constexpr int NEXP = 32, TOPK = 4, NSLOT = T * TOPK, NPMAX = NSLOT + NEXP * 256;
constexpr float EPS = 1e-5f, LOG2E = 1.4426950408889634f;
constexpr int NWAVES = 8, NTHREADS = 512;

constexpr size_t MiB = 1u << 20;
constexpr size_t WS_CTL = 0, CTL_ZERO_BYTES = 128 * 1024;
constexpr size_t WS_WIN = 1 * MiB;
constexpr size_t WS_WUQ = 9 * MiB;
constexpr size_t WS_WUKV = 10 * MiB;
constexpr size_t WS_WA = 11 * MiB, WS_WB = 12 * MiB;
constexpr size_t WS_WO = 13 * MiB;
constexpr size_t WS_ROPE = 15 * MiB;
constexpr size_t WS_WGU = 17 * MiB;
constexpr size_t WS_WD = 145 * MiB;
constexpr size_t WS_SMALL = 209 * MiB;
constexpr size_t WS_RSTDQ = WS_SMALL, WS_RSTDKV = WS_RSTDQ + T * 4, WS_RSTD2 = WS_RSTDKV + T * 4;
constexpr size_t WS_TOPI = WS_RSTD2 + T * 4, WS_GATEW = WS_TOPI + (size_t)NSLOT * 4, WS_SRANK = WS_GATEW + (size_t)NSLOT * 4, WS_POS = WS_SRANK + (size_t)NSLOT * 4;
constexpr size_t WS_ROWTOK = WS_POS + (size_t)NSLOT * 4, WS_ROWSCALE = WS_ROWTOK + 1 * MiB, WS_WGBASE = WS_ROWSCALE + 1 * MiB;
constexpr size_t WS_WRP = WS_WGBASE + 64 * 1024;
constexpr size_t WS_PARTL = WS_WRP + 128 * 1024;
static_assert(WS_PARTL + 3 * MiB <= 225 * MiB, "small region");
constexpr size_t WS_XB = 225 * MiB;
constexpr size_t WS_QA = 289 * MiB, WS_KA = 321 * MiB, WS_VA = 353 * MiB;
constexpr size_t WS_CQ = 385 * MiB;
constexpr size_t WS_CKV = 401 * MiB;
constexpr size_t WS_KR = 409 * MiB;
constexpr size_t WS_GA = 411 * MiB, WS_GB = 475 * MiB;
constexpr size_t WS_K8 = 587 * MiB;
constexpr size_t WS_Q8 = 249 * MiB;
constexpr size_t WS_V8T = 273 * MiB;
constexpr size_t WS_ACT = 225 * MiB;
static_assert(WS_ACT + (size_t)NPMAX * 2048 <= 539 * MiB, "ACT overlay");
constexpr size_t WS_QB = 539 * MiB;
constexpr size_t WS_KIMG = 587 * MiB;
constexpr size_t WS_VIMG = 635 * MiB;
constexpr size_t WS_OA = 667 * MiB, WS_OB = 699 * MiB;
constexpr size_t WS_MERGED = 731 * MiB;
constexpr size_t WS_PARTO = 795 * MiB;
constexpr size_t WS_H2 = 891 * MiB;
constexpr size_t WS_Y = 539 * MiB;
static_assert(WS_Y + (size_t)NPMAX * 2048 <= WS_H2, "Y overlay");
constexpr size_t WS_Q6 = 539 * MiB;
constexpr size_t WS_K6 = 611 * MiB;
constexpr size_t WS_END = 955 * MiB;
constexpr int CW_TMO = 0, CW_BAR = 4096, CW_GCOUNT = 8192, CW_NRM = 8256, CW_F6BAD = 8320;

constexpr int RING_BYTES = 131072, LDS_BYTES = 163840, MISC_OFF = LDS_BYTES - 4096;
constexpr int MI_BAR = 8, MI_TPRE = 16, MI_HIST = 64, MI_PSTART = 96, MI_NRM = 160;

__device__ __forceinline__ unsigned f2bf(float f) { unsigned u = __builtin_bit_cast(unsigned, f); return (u + 0x7fffu + ((u >> 16) & 1u)) >> 16; }
__device__ __forceinline__ unsigned pk2(float lo, float hi) { return f2bf(lo) | (f2bf(hi) << 16); }
__device__ __forceinline__ float bf2f(unsigned short b) { return __builtin_bit_cast(float, (unsigned)b << 16); }
__device__ __forceinline__ float bflo(unsigned w) { return __builtin_bit_cast(float, w << 16); }
__device__ __forceinline__ float bfhi(unsigned w) { return __builtin_bit_cast(float, w & 0xffff0000u); }
typedef __bf16 bf16x2_t __attribute__((ext_vector_type(2)));
__device__ __forceinline__ unsigned cvtpk(float lo, float hi) { const f32x2 v = {lo, hi}; const bf16x2_t b = __builtin_convertvector(v, bf16x2_t); return __builtin_bit_cast(unsigned, b); }
__device__ __forceinline__ unsigned pack4_fp8(float a, float b, float c, float d) { int w = 0; w = __builtin_amdgcn_cvt_pk_fp8_f32(a, b, w, false); w = __builtin_amdgcn_cvt_pk_fp8_f32(c, d, w, true); return (unsigned)w; }
__device__ __forceinline__ float wave_sum(float v) {
#pragma unroll
    for (int o = 1; o < 64; o <<= 1) v += __shfl_xor(v, o);
    return v;
}
__device__ __forceinline__ int lane_now() { int t = threadIdx.x; asm volatile("" : "+v"(t)); return t & 63; }
__device__ __forceinline__ float fexp2(float x) { return __builtin_amdgcn_exp2f(x); }
__device__ __forceinline__ float frcp(float x) { return __builtin_amdgcn_rcpf(x); }
__device__ __forceinline__ float sigmoidf_(float z) { return frcp(1.f + fexp2(-z * LOG2E)); }
__device__ __forceinline__ int crow(int r, int hi) { return (r & 3) + 8 * (r >> 2) + 4 * hi; }
__device__ __forceinline__ u32x4 pack8(const float (&v)[8]) { u32x4 w; w.x = cvtpk(v[0], v[1]); w.y = cvtpk(v[2], v[3]); w.z = cvtpk(v[4], v[5]); w.w = cvtpk(v[6], v[7]); return w; }
__device__ __forceinline__ void unpack8(const u32x4 w, float (&v)[8]) { v[0] = bflo(w.x); v[1] = bfhi(w.x); v[2] = bflo(w.y); v[3] = bfhi(w.y); v[4] = bflo(w.z); v[5] = bfhi(w.z); v[6] = bflo(w.w); v[7] = bfhi(w.w); }
__device__ __forceinline__ f32x2 rope_cs(int pos, int i) {
    const float inv = __builtin_powf(10000.f, -(float)i * (1.f / 16.f));
    const float ang = (float)pos * inv;
    double x = (double)ang; const double n = __builtin_rint(x * 0.15915494309189535); x = (x - n * 6.283185307179586) - n * 2.4492935982947064e-16;
    const double x2 = x * x; double sn = 1.0, cs = 1.0;
#pragma unroll
    for (int k = 13; k >= 1; --k) { sn = 1.0 - sn * x2 * (1.0 / (double)((2 * k) * (2 * k + 1))); cs = 1.0 - cs * x2 * (1.0 / (double)((2 * k - 1) * (2 * k))); }
    sn *= x;
    return (f32x2){(float)cs, (float)sn};
}

namespace pg8 {
constexpr int BM = 256, BK = 64, HALF = 128, HTB = HALF * BK * 2  , NXCD = 8, WGM = 8;
__host__ __device__ __forceinline__ int lds_byte(int r, int c) { const int st = (r >> 4) * 2 + (c >> 5), rr = r & 15, cc = c & 31, ob = rr * 64 + cc * 2; return st * 1024 + (ob ^ (((ob >> 9) & 1) << 5)); }
__host__ __device__ __forceinline__ void stage_rc(int b, int& R, int& C) { const int st = b / 1024, sb = b % 1024, swz = sb ^ (((sb >> 9) & 1) << 5); R = (st >> 1) * 16 + swz / 64; C = (st & 1) * 32 + (swz % 64) / 2; }
__host__ __device__ __forceinline__ int perm32(int rho) { const int n = rho >> 4, i = rho & 15; return 8 * (i >> 2) + 4 * n + (i & 3); }

struct Unit { int pm, pn, e; };

struct StaticOrder {
    int nM, nN, nwg, G, c;
    __host__ __device__ void init(int M, int N, int G_, int c_) { nM = M / BM; nN = N / BM; nwg = nM * nN; G = G_; c = c_; }
    __host__ __device__ bool next(int i, Unit& u) const {
        const long L = (long)i * G + c; if (L >= nwg) return false;
        int wgid = (int)L; { const int q = nwg / NXCD, r = nwg % NXCD, xcd = wgid % NXCD, off = wgid / NXCD; wgid = (xcd < r ? xcd * (q + 1) : r * (q + 1) + (xcd - r) * q) + off; }
        const int nig = WGM * nN, gid = wgid / nig, fm = gid * WGM, gsz = (nM - fm) < WGM ? (nM - fm) : WGM;
        u.pm = fm + ((wgid % nig) % gsz); u.pn = (wgid % nig) / gsz; u.e = 0; return true;
    }
};
struct DenseSched {
    static constexpr bool LATE = false, KEEP_ACC = false;
    StaticOrder so; const char* A; const char* Bt; int K;
    __device__ __forceinline__ void prefetch_rows(const Unit&, LAS unsigned char*, int, int, int) const {}
    __device__ __forceinline__ void a_off_lds(const Unit&, const int (&)[2], const int (&)[2], LAS unsigned char*, int, unsigned (&)[2][2]) const {}
    __device__ __forceinline__ void init(const bf16_t* A_, const bf16_t* Bt_, int M, int N, int K_, int G, int c) { so.init(M, N, G, c); A = (const char*)A_; Bt = (const char*)Bt_; K = K_; }
    __device__ __forceinline__ bool next(int i, Unit& u) const { return so.next(i, u); }
    __device__ __forceinline__ const char* a_base(const Unit& u) const { return A + (size_t)u.pm * ((size_t)BM * K * 2); }
    __device__ __forceinline__ const char* b_base(const Unit& u) const { return Bt + (size_t)u.pn * ((size_t)BM * K * 2); }
    __device__ __forceinline__ void a_off(const Unit&, const int (&sR)[2], const int (&sC)[2], unsigned (&vo)[2][2]) const {
#pragma unroll
        for (int h = 0; h < 2; ++h)
#pragma unroll
            for (int i = 0; i < 2; ++i) vo[h][i] = (unsigned)((h * HALF + sR[i]) * K + sC[i]) * 2u;
    }
};
struct TwoSegSched {
    static constexpr bool LATE = false, KEEP_ACC = true;
    StaticOrder so; const char* A0; const char* A1; const char* B0; const char* B1; int K;
    __device__ __forceinline__ void prefetch_rows(const Unit&, LAS unsigned char*, int, int, int) const {}
    __device__ __forceinline__ void a_off_lds(const Unit&, const int (&)[2], const int (&)[2], LAS unsigned char*, int, unsigned (&)[2][2]) const {}
    __device__ __forceinline__ void init(const bf16_t* A0_, const bf16_t* B0_, const bf16_t* A1_, const bf16_t* B1_, int M, int N, int K_, int G, int c) { so.init(M, N, G, c); A0 = (const char*)A0_; A1 = (const char*)A1_; B0 = (const char*)B0_; B1 = (const char*)B1_; K = K_; }
    __device__ __forceinline__ bool next(int i, Unit& u) const { const bool ok = so.next(i >> 1, u); u.e = i & 1; return ok; }
    __device__ __forceinline__ const char* a_base(const Unit& u) const { return (u.e ? A1 : A0) + (size_t)u.pm * ((size_t)BM * K * 2); }
    __device__ __forceinline__ const char* b_base(const Unit& u) const { return (u.e ? B1 : B0) + (size_t)u.pn * ((size_t)BM * K * 2); }
    __device__ __forceinline__ void a_off(const Unit&, const int (&sR)[2], const int (&sC)[2], unsigned (&vo)[2][2]) const {
#pragma unroll
        for (int h = 0; h < 2; ++h)
#pragma unroll
            for (int i = 0; i < 2; ++i) vo[h][i] = (unsigned)((h * HALF + sR[i]) * K + sC[i]) * 2u;
    }
};
template <int NPN_SHIFT, bool GATHER, bool REVERSE = false>
struct MoeSched {
    static constexpr bool KEEP_ACC = false;
    static constexpr bool LATE = GATHER;
    static constexpr int TBL_OFF = 131072 + 4096;
    __device__ __forceinline__ void prefetch_rows(const Unit& u, LAS unsigned char* lds, int buf, int wid, int lane) const {
        if (wid < 4) __builtin_amdgcn_global_load_lds((const unsigned*)(row_tok + u.pm * BM + wid * 64 + lane), (LAS unsigned*)(lds + TBL_OFF + buf * 1024 + wid * 256), 4, 0, 0);
    }
    __device__ __forceinline__ void a_off_lds(const Unit&, const int (&sR)[2], const int (&sC)[2], LAS unsigned char* lds, int buf, unsigned (&vo)[2][2]) const {
        const LAS int* tb = (const LAS int*)(lds + TBL_OFF + buf * 1024);
#pragma unroll
        for (int h = 0; h < 2; ++h)
#pragma unroll
            for (int i = 0; i < 2; ++i) vo[h][i] = (unsigned)(tb[h * HALF + sR[i]] * K + sC[i]) * 2u;
    }
    const LAS int* tpre; int ntiles, G, c, K; const char* A; const char* Bt; size_t estride; const int* row_tok;
    __device__ __forceinline__ bool next(int i, Unit& u) const {
        int g, pn;
        if (G == 256) { const int x = c & 7, j = c >> 3; constexpr int TPR = 256 >> NPN_SHIFT, PX = TPR / 8; g = i * TPR + x * PX + (j >> NPN_SHIFT); pn = j & ((1 << NPN_SHIFT) - 1); }
        else { const int L = i * G + c; g = L >> NPN_SHIFT; pn = L & ((1 << NPN_SHIFT) - 1); }
        if (g >= ntiles) return false;
        if (REVERSE) g = ntiles - 1 - g;
        int e = 0; while (e < 31 && tpre[e + 1] <= g) ++e;
        u.pm = g; u.pn = pn; u.e = e; return true;
    }
    __device__ __forceinline__ const char* a_base(const Unit& u) const { return GATHER ? A : A + (size_t)u.pm * ((size_t)BM * K * 2); }
    __device__ __forceinline__ const char* b_base(const Unit& u) const { return Bt + (size_t)u.e * estride + (size_t)u.pn * ((size_t)BM * K * 2); }
    __device__ __forceinline__ void a_off(const Unit& u, const int (&sR)[2], const int (&sC)[2], unsigned (&vo)[2][2]) const {
#pragma unroll
        for (int h = 0; h < 2; ++h)
#pragma unroll
            for (int i = 0; i < 2; ++i) {
                if (GATHER) { const int tok = row_tok[u.pm * BM + h * HALF + sR[i]]; vo[h][i] = (unsigned)(tok * K + sC[i]) * 2u; }
                else vo[h][i] = (unsigned)((h * HALF + sR[i]) * K + sC[i]) * 2u;
            }
    }
};

typedef int v8i_ __attribute__((ext_vector_type(8)));
__device__ __forceinline__ v8i_ cat16(const bf16x8 a, const bf16x8 b) { const u32x4 x = __builtin_bit_cast(u32x4, a), y = __builtin_bit_cast(u32x4, b); return (v8i_){(int)x.x, (int)x.y, (int)x.z, (int)x.w, (int)y.x, (int)y.y, (int)y.z, (int)y.w}; }
__device__ __forceinline__ v8i_ lds_ld32(const LAS unsigned char* p) { const u32x4 x = *(const LAS u32x4*)p, y = *(const LAS u32x4*)(p + 1024); return (v8i_){(int)x.x, (int)x.y, (int)x.z, (int)x.w, (int)y.x, (int)y.y, (int)y.z, (int)y.w}; }
template <class Epi, class Sched, bool ALIGN_EPI, bool FP8 = false, int SCALE_W = 127>
__device__ __forceinline__ void gemm_phase2(LAS unsigned char* lds, const int K_, const Sched& S, const Epi& E) {
    int K = K_; asm volatile("" : "+s"(K));
    const int tid = threadIdx.x, wid = __builtin_amdgcn_readfirstlane(tid >> 6), lane = tid & 63, wr = wid >> 2, wc = wid & 3, fr = lane & 15, fq = lane >> 4;
    const int nt = K / BK;
    int sR[2], sC[2]; unsigned voffB[2];
#pragma unroll
    for (int i = 0; i < 2; ++i) { int R, C; stage_rc(tid * 16 + i * 8192, R, C); sR[i] = R; sC[i] = C; const int Rb = Epi::PERM ? ((R & ~31) + perm32(R & 31)) : R; voffB[i] = (unsigned)(Rb * K + C) * 2u; }
    const size_t kstep = (size_t)(BK * 2);
    const size_t hstep = (size_t)HALF * K * 2;
    const unsigned ldsw = (unsigned)wid * 1024u;
    const int aoff = lds_byte(wr * 64 + fr, fq * 8), boff = lds_byte(wc * 32 + fr, fq * 8);
#define PG8_SA(b, h) (((b) * 2 + (h)) * HTB)
#define PG8_SB(b, h) ((4 + (b) * 2 + (h)) * HTB)
#define PG8_STAGE_B(bufoff, gbase) do { _Pragma("unroll") for (int _i = 0; _i < 2; ++_i) \
        __builtin_amdgcn_global_load_lds((const unsigned*)((const char*)(gbase) + voffB[_i]), (LAS unsigned*)(lds + (bufoff) + ldsw + _i * 8192), 16, 0, 0); } while (0)
#define PG8_STAGE_A(bufoff, gbase, o0, o1) do { \
        __builtin_amdgcn_global_load_lds((const unsigned*)((const char*)(gbase) + (o0)), (LAS unsigned*)(lds + (bufoff) + ldsw), 16, 0, 0); \
        __builtin_amdgcn_global_load_lds((const unsigned*)((const char*)(gbase) + (o1)), (LAS unsigned*)(lds + (bufoff) + ldsw + 8192), 16, 0, 0); } while (0)
#define PG8_LDA(dst, b, h) do { if constexpr (FP8) { _Pragma("unroll") for (int m = 0; m < 4; ++m) dst##8[m] = lds_ld32(lds + PG8_SA(b, h) + aoff + m * 2048); } else { _Pragma("unroll") for (int m = 0; m < 4; ++m) _Pragma("unroll") for (int k = 0; k < 2; ++k) dst[m][k] = *(const LAS bf16x8*)(lds + PG8_SA(b, h) + aoff + m * 2048 + k * 1024); } } while (0)
#define PG8_LDB(dst, b, h) do { if constexpr (FP8) { _Pragma("unroll") for (int n = 0; n < 2; ++n) dst##8[n] = lds_ld32(lds + PG8_SB(b, h) + boff + n * 2048); } else { _Pragma("unroll") for (int n = 0; n < 2; ++n) _Pragma("unroll") for (int k = 0; k < 2; ++k) dst[n][k] = *(const LAS bf16x8*)(lds + PG8_SB(b, h) + boff + n * 2048 + k * 1024); } } while (0)
#define PG8_MMA(ai, bj, At, Bt) do { __builtin_amdgcn_s_setprio(1); if constexpr (FP8) { _Pragma("unroll") for (int m = 0; m < 4; ++m) _Pragma("unroll") for (int n = 0; n < 2; ++n) \
        asm volatile("v_mfma_scale_f32_16x16x128_f8f6f4 %0, %1, %2, %0, %3, %4 op_sel_hi:[0,0,0]" : "+v"(acc[ai][bj][m][n]) : "v"(Bt##8[n]), "v"(At##8[m]), "v"(scw_), "v"(sca_)); } else { \
        _Pragma("unroll") for (int m = 0; m < 4; ++m) _Pragma("unroll") for (int n = 0; n < 2; ++n) _Pragma("unroll") for (int k = 0; k < 2; ++k) \
        acc[ai][bj][m][n] = __builtin_amdgcn_mfma_f32_16x16x32_bf16(Bt[n][k], At[m][k], acc[ai][bj][m][n], 0, 0, 0); } __builtin_amdgcn_s_setprio(0); } while (0)
#define PG8_WAIT_V(n) asm volatile("s_waitcnt vmcnt(" #n ")" ::: "memory")
#define PG8_WAIT_L(n) asm volatile("s_waitcnt lgkmcnt(" #n ")" ::: "memory")
#define PG8_BAR __builtin_amdgcn_s_barrier()
#define PG8_SCHED __builtin_amdgcn_sched_barrier(0)
    Unit cur, nxt; int ui = 0;
    if (!S.next(0, cur)) return;
    f32x4 acc[2][2][4][2];
#pragma unroll
    for (int a = 0; a < 2; ++a)
#pragma unroll
        for (int b = 0; b < 2; ++b)
#pragma unroll
            for (int m = 0; m < 4; ++m)
#pragma unroll
                for (int n = 0; n < 2; ++n) acc[a][b][m][n] = (f32x4){0.f, 0.f, 0.f, 0.f};
    bf16x8 At[4][2], B0[2][2], B1[2][2]; v8i_ At8[4], B08[2], B18[2];
    int scw_ = SCALE_W * 0x01010101, sca_ = 0x7f7f7f7f; asm volatile("" : "+v"(scw_), "+v"(sca_));
    unsigned voA[2][2], voN[2][2];
    S.a_off(cur, sR, sC, voA);
    const char* cA = S.a_base(cur); const char* cB = S.b_base(cur);
    PG8_STAGE_B(PG8_SB(0, 0), cB); PG8_STAGE_B(PG8_SB(0, 1), cB + hstep); PG8_STAGE_A(PG8_SA(0, 0), cA, voA[0][0], voA[0][1]); PG8_STAGE_A(PG8_SA(0, 1), cA, voA[1][0], voA[1][1]);
    if (wr == 1) PG8_BAR;
    PG8_WAIT_V(2); PG8_BAR;
    PG8_STAGE_B(PG8_SB(1, 0), cB + kstep); PG8_STAGE_A(PG8_SA(1, 0), cA + kstep, voA[0][0], voA[0][1]); PG8_STAGE_B(PG8_SB(1, 1), cB + hstep + kstep);
    PG8_WAIT_V(6); PG8_BAR;
    for (;;) {
        const bool has_next = S.next(ui + 1, nxt);
        const char* nA = cA; const char* nB = cB;
#pragma unroll
        for (int h = 0; h < 2; ++h)
#pragma unroll
            for (int i = 0; i < 2; ++i) voN[h][i] = voA[h][i];
        if (has_next) { nA = S.a_base(nxt); nB = S.b_base(nxt); if constexpr (Sched::LATE) S.prefetch_rows(nxt, lds, (ui + 1) & 1, wid, lane); else S.a_off(nxt, sR, sC, voN); }
        for (int t = 0; t < nt; t += 2) {
            const bool last = (t == nt - 2);
            if constexpr (Sched::LATE) { if (last && has_next) S.a_off_lds(nxt, sR, sC, lds, (ui + 1) & 1, voN); }
            const char* a1 = cA + (size_t)(t + 1) * kstep;
            const char* a2 = last ? nA : cA + (size_t)(t + 2) * kstep; const char* b2 = last ? nB : cB + (size_t)(t + 2) * kstep;
            const char* a3 = a2 + kstep; const char* b3 = b2 + kstep;
            const unsigned s00 = last ? voN[0][0] : voA[0][0], s01 = last ? voN[0][1] : voA[0][1], s10 = last ? voN[1][0] : voA[1][0], s11 = last ? voN[1][1] : voA[1][1];
            PG8_LDB(B0, 0, 0); PG8_LDB(B1, 0, 1); PG8_SCHED; PG8_LDA(At, 0, 0); PG8_STAGE_A(PG8_SA(1, 1), a1, voA[1][0], voA[1][1]);
            PG8_WAIT_V(8); PG8_WAIT_L(0); PG8_BAR; PG8_MMA(0, 0, At, B0); PG8_MMA(0, 1, At, B1); PG8_BAR; PG8_SCHED;
            PG8_LDA(At, 0, 1); PG8_STAGE_B(PG8_SB(0, 0), b2); PG8_STAGE_B(PG8_SB(0, 1), b2 + hstep); PG8_STAGE_A(PG8_SA(0, 0), a2, s00, s01);
            PG8_WAIT_V(8); PG8_WAIT_L(0); PG8_BAR; PG8_MMA(1, 0, At, B0); PG8_MMA(1, 1, At, B1); PG8_BAR; PG8_SCHED;
            PG8_LDB(B0, 1, 0); PG8_LDB(B1, 1, 1); PG8_SCHED; PG8_LDA(At, 1, 0); PG8_STAGE_A(PG8_SA(0, 1), a2, s10, s11);
            PG8_WAIT_V(8); PG8_WAIT_L(0); PG8_BAR; PG8_MMA(0, 0, At, B0); PG8_MMA(0, 1, At, B1); PG8_BAR; PG8_SCHED;
            PG8_LDA(At, 1, 1); PG8_STAGE_B(PG8_SB(1, 0), b3); PG8_STAGE_B(PG8_SB(1, 1), b3 + hstep); PG8_STAGE_A(PG8_SA(1, 0), a3, s00, s01);
            PG8_WAIT_V(8); PG8_WAIT_L(0); PG8_BAR; PG8_MMA(1, 0, At, B0); PG8_MMA(1, 1, At, B1); PG8_BAR; PG8_SCHED;
        }
        if constexpr (ALIGN_EPI) { if (wr == 0) PG8_BAR; }
        E(acc, cur, wr, wc, fr, fq);
#ifdef PROBE_EPI2
        if (Epi::PROBE2) { asm volatile("" ::: "memory"); E(acc, cur, wr, wc, fr, fq); }
#endif
        if (!has_next) break;
        if (!(Sched::KEEP_ACC && nxt.e != 0)) {
#pragma unroll
        for (int a = 0; a < 2; ++a)
#pragma unroll
            for (int b = 0; b < 2; ++b)
#pragma unroll
                for (int m = 0; m < 4; ++m)
#pragma unroll
                    for (int n = 0; n < 2; ++n) acc[a][b][m][n] = (f32x4){0.f, 0.f, 0.f, 0.f};
        }
        cur = nxt; cA = nA; cB = nB; ++ui;
#pragma unroll
        for (int h = 0; h < 2; ++h)
#pragma unroll
            for (int i = 0; i < 2; ++i) voA[h][i] = voN[h][i];
        if constexpr (ALIGN_EPI) { if (wr == 1) PG8_BAR; }
    }
    PG8_WAIT_V(0);
    if constexpr (!ALIGN_EPI) { if (wr == 0) PG8_BAR; }
    PG8_BAR;
#undef PG8_SA
#undef PG8_SB
#undef PG8_STAGE_A
#undef PG8_STAGE_B
#undef PG8_LDA
#undef PG8_LDB
#undef PG8_MMA
#undef PG8_WAIT_V
#undef PG8_WAIT_L
#undef PG8_BAR
#undef PG8_SCHED
}
}

#define XB_TMO      128
#define XB_XCNT(j)  (256  + 64 * (j))
#define XB_XSUB(j)  (1280 + 64 * (j))
#define XB_XGEN(j)  (2304 + 64 * (j))
#define XB_TOP      3328
#define XB_TOPGEN   3392
#define XCD_BAR_WORDS 3456
#define XB_SPIN_CAP (1u << 18)

__device__ __forceinline__ unsigned xb_ld(unsigned* p)              { return __hip_atomic_load(p, __ATOMIC_RELAXED, __HIP_MEMORY_SCOPE_AGENT); }
__device__ __forceinline__ unsigned xb_add(unsigned* p, unsigned v) { return __hip_atomic_fetch_add(p, v, __ATOMIC_RELAXED, __HIP_MEMORY_SCOPE_AGENT); }
__device__ __forceinline__ unsigned xb_xcc_id() { return (unsigned)__builtin_amdgcn_s_getreg((3 << 11) | 20) & 0xFu; }
#define XB_SPIN(cond, bar) do { unsigned _sp = 0; while (cond) { __builtin_amdgcn_s_sleep(1); \
    if ((++_sp & 255u) == 0u) { if (xb_ld(&(bar)[XB_TMO])) break; if (_sp > XB_SPIN_CAP) { atomicAdd(&(bar)[XB_TMO], 1u); break; } } } } while (0)

struct XcdBarrier {
    unsigned* bar; unsigned x;
    volatile LAS unsigned* st;
};
__device__ __forceinline__ XcdBarrier xcd_barrier_post(unsigned* bar, volatile LAS unsigned* st) {
    XcdBarrier b; b.bar = bar; b.x = xb_xcc_id(); b.st = st;
    if (threadIdx.x == 0) (void)xb_add(&bar[XB_XCNT(b.x)], 1u);
    return b;
}
__device__ __forceinline__ void xcd_barrier_complete(unsigned* bar, unsigned x, unsigned& nloc, unsigned& nx) {
    const unsigned G = gridDim.x * gridDim.y * gridDim.z;
    unsigned sum, cnt, mine, sp = 0u;
    for (;;) {
        sum = 0u; cnt = 0u; mine = 0u;
#pragma unroll
        for (unsigned j = 0; j < 16; ++j) { const unsigned c = xb_ld(&bar[XB_XCNT(j)]); sum += c; cnt += (c > 0u) ? 1u : 0u; mine = (j == x) ? c : mine; }
        if (sum == G) break;
        __builtin_amdgcn_s_sleep(1);
        if ((++sp & 255u) == 0u) { if (xb_ld(&bar[XB_TMO])) break; if (sp > XB_SPIN_CAP) { atomicAdd(&bar[XB_TMO], 1u); break; } }
    }
    nloc = mine > 0u ? mine : 1u; nx = cnt > 0u ? cnt : 1u;
}
__device__ __forceinline__ void xcd_barrier(const XcdBarrier& b) {
    asm volatile("s_waitcnt vmcnt(0)" ::: "memory");
    __syncthreads();
    if (threadIdx.x == 0) {
        unsigned* bar = b.bar;
        __builtin_amdgcn_s_waitcnt(0);
        unsigned nloc = b.st[0], nx = b.st[1];
        if (nloc == 0u) { xcd_barrier_complete(bar, b.x, nloc, nx); b.st[0] = nloc; b.st[1] = nx; }
        const unsigned old = xb_add(&bar[XB_XSUB(b.x)], 1u);
        const unsigned gen = old / nloc;
        if (old + 1u == (gen + 1u) * nloc) {
            __builtin_amdgcn_fence(__ATOMIC_RELEASE, "agent");
            asm volatile("s_waitcnt vmcnt(0)" ::: "memory");
            const unsigned og = xb_add(&bar[XB_TOP], 1u);
            const unsigned tg = og / nx;
            if (og + 1u == (tg + 1u) * nx) xb_add(&bar[XB_TOPGEN], 1u);
            else XB_SPIN(xb_ld(&bar[XB_TOPGEN]) == tg, bar);
            __builtin_amdgcn_fence(__ATOMIC_ACQUIRE, "agent");
            xb_add(&bar[XB_XGEN(b.x)], 1u);
            asm volatile("s_waitcnt vmcnt(0)" ::: "memory");
        } else {
            XB_SPIN(xb_ld(&bar[XB_XGEN(b.x)]) == gen, bar);
            __builtin_amdgcn_fence(__ATOMIC_ACQUIRE, "agent");
            asm volatile("s_waitcnt vmcnt(0)" ::: "memory");
        }
    }
    __syncthreads();
}

#define EPI_WALK(...) \
    _Pragma("unroll") for (int ai = 0; ai < 2; ++ai) _Pragma("unroll") for (int m = 0; m < 4; ++m) { \
        const int row = u.pm * 256 + ai * 128 + wr * 64 + m * 16 + fr; \
        _Pragma("unroll") for (int bj = 0; bj < 2; ++bj) { const int cw = bj * 128 + wc * 32 + 8 * fq; \
            float v[8] = {acc[ai][bj][m][0][0], acc[ai][bj][m][0][1], acc[ai][bj][m][0][2], acc[ai][bj][m][0][3], acc[ai][bj][m][1][0], acc[ai][bj][m][1][1], acc[ai][bj][m][1][2], acc[ai][bj][m][1][3]}; \
            __VA_ARGS__ } asm volatile("" ::: "memory"); }

__device__ __forceinline__ void rope8(float (&v)[8], const f32x2* rope_row, int i0) {
#pragma unroll
    for (int j = 0; j < 4; ++j) { const f32x2 cs = rope_row[i0 + j]; const float x1 = v[2 * j], x2 = v[2 * j + 1]; v[2 * j] = x1 * cs.x - x2 * cs.y; v[2 * j + 1] = x2 * cs.x + x1 * cs.y; }
}

#define EPI_ROW_(ai, m) (u.pm * 256 + (ai) * 128 + wr * 64 + (m) * 16 + fr)
struct EpiInProj {
    static constexpr bool PERM = true;
    __device__ __forceinline__ void row_rstd(float (&ssr)[2][4], float* dst, float inv_n, const pg8::Unit& u, int wr, int wc, int fr, int fq) const {
        LAS float* red = (LAS float*)(lds + 139264);
#pragma unroll
        for (int ai = 0; ai < 2; ++ai)
#pragma unroll
            for (int m = 0; m < 4; ++m) { float s = ssr[ai][m]; s += __shfl_xor(s, 16); s += __shfl_xor(s, 32);
                if (fq == 0) red[(ai * 128 + wr * 64 + m * 16 + fr) * 4 + wc] = s; }
        __syncthreads();
        if (wc == 0 && fq == 0) {
#pragma unroll
            for (int ai = 0; ai < 2; ++ai)
#pragma unroll
                for (int m = 0; m < 4; ++m) { const int r = ai * 128 + wr * 64 + m * 16 + fr; const f32x4 p = *(const LAS f32x4*)(red + r * 4);
                    dst[u.pm * 256 + r] = 1.f / sqrtf(((p.x + p.y) + (p.z + p.w)) * inv_n + EPS); }
        }
        __syncthreads();
    }
#ifdef PROBE_EPI2
    static constexpr bool PROBE2 = (PROBE_EPI2 == 0);
#endif
    unsigned char* ws; LAS unsigned char* lds;
    __device__ __forceinline__ void operator()(const f32x4 (&acc)[2][2][4][2], const pg8::Unit& u, int wr, int wc, int fr, int fq) const {
        asm volatile("" : "+v"(fr), "+v"(fq));
        const int pn = u.pn;
        if (pn < 6) {
            bf16_t* base = (bf16_t*)(ws + (pn < 2 ? WS_QA : pn < 4 ? WS_KA : WS_VA)) + (pn & 1) * 256;
            EPI_WALK({ *(u32x4*)(base + (size_t)row * 512 + cw) = pack8(v); })
        } else if (pn == 6) {
            bf16_t* base = (bf16_t*)(ws + WS_CQ); float ssr[2][4] = {};
            EPI_WALK({ _Pragma("unroll") for (int j = 0; j < 8; ++j) ssr[ai][m] = __builtin_fmaf(v[j], v[j], ssr[ai][m]); *(u32x4*)(base + (size_t)row * 256 + cw) = pack8(v); })
            row_rstd(ssr, (float*)(ws + WS_RSTDQ), 1.f / 256.f, u, wr, wc, fr, fq);
        } else if (pn == 7) {
            bf16_t* ckv = (bf16_t*)(ws + WS_CKV); const f32x2* rope = (const f32x2*)(ws + WS_ROPE); float ssr[2][4] = {};
            EPI_WALK({ if (cw < 128) { _Pragma("unroll") for (int j = 0; j < 8; ++j) ssr[ai][m] = __builtin_fmaf(v[j], v[j], ssr[ai][m]); *(u32x4*)(ckv + (size_t)row * 128 + cw) = pack8(v); }
                       else if (cw < 160) { rope8(v, rope + (size_t)(row & (SEQ - 1)) * 16, (cw - 128) >> 1);
                           const u32x2 w8 = {pack4_fp8(v[0], v[1], v[2], v[3]), pack4_fp8(v[4], v[5], v[6], v[7])};
                           const int b = row >> 14, sq2 = row & (SEQ - 1); unsigned char* kp = ws + WS_K8 + (size_t)(b * 8 * 256 + (sq2 >> 6)) * 6144 + (4 + ((cw - 128) >> 4)) * 1024 + (sq2 & 63) * 16 + ((cw - 128) & 8);
                           _Pragma("unroll") for (int hh = 0; hh < 8; ++hh) { asm volatile("" : "+v"(kp)); *(u32x2*)kp = w8; kp += (size_t)256 * 6144; } } })
            row_rstd(ssr, (float*)(ws + WS_RSTDKV), 1.f / 128.f, u, wr, wc, fr, fq);
        } else {
            bf16_t* gr = (bf16_t*)(ws + WS_GA) + (pn - 8) * 128 + wc * 32 + 8 * fq; bf16_t* gbp = (bf16_t*)(ws + WS_GB) + (pn - 8) * 128 + wc * 32 + 8 * fq;
#pragma unroll
            for (int ai = 0; ai < 2; ++ai)
#pragma unroll
                for (int m = 0; m < 4; ++m) { const size_t ro = (size_t)EPI_ROW_(ai, m) * 1024; float r[8], g[8];
#pragma unroll
                    for (int j = 0; j < 8; ++j) { const float ga = sigmoidf_(acc[ai][0][m][j >> 2][j & 3]); g[j] = fmaxf(sigmoidf_(acc[ai][1][m][j >> 2][j & 3]), 8.6736174e-19f); r[j] = ga * frcp(g[j]); }
                    *(u32x4*)(gr + ro) = pack8(r); *(u32x4*)(gbp + ro) = pack8(g); }
        }
    }
};
#define EPI_ROW(ai, m) (u.pm * 256 + (ai) * 128 + wr * 64 + (m) * 16 + fr)
#define EPI_LOAD_RS(rs) float rs8[2][4]; _Pragma("unroll") for (int ai = 0; ai < 2; ++ai) _Pragma("unroll") for (int m = 0; m < 4; ++m) rs8[ai][m] = (rs)[EPI_ROW(ai, m)];
struct EpiQ {
    static constexpr bool PERM = true;
#ifdef PROBE_EPI2
    static constexpr bool PROBE2 = (PROBE_EPI2 == 1);
#endif
    unsigned char* ws;
    __device__ __forceinline__ void operator()(const f32x4 (&acc)[2][2][4][2], const pg8::Unit& u, int wr, int wc, int fr, int fq) const {
        bf16_t* qb = (bf16_t*)(ws + WS_QB); const float* rs = (const float*)(ws + WS_RSTDQ); const f32x2* rope = (const f32x2*)(ws + WS_ROPE);
        EPI_LOAD_RS(rs)
        EPI_WALK({ const int col = u.pn * 256 + cw; const int w = col % 96; const float r = rs8[ai][m];
                   _Pragma("unroll") for (int j = 0; j < 8; ++j) v[j] *= r;
                   if (w >= 64) rope8(v, rope + (size_t)(row & (SEQ - 1)) * 16, (w - 64) >> 1);
#ifdef KEEP_BF16_IMAGES
                   *(u32x4*)(qb + (size_t)row * 768 + col) = pack8(v);
#endif
                   *(u32x2*)(ws + WS_Q8 + (size_t)row * 768 + col) = (u32x2){pack4_fp8(v[0] * 16.f, v[1] * 16.f, v[2] * 16.f, v[3] * 16.f), pack4_fp8(v[4] * 16.f, v[5] * 16.f, v[6] * 16.f, v[7] * 16.f)}; })
    }
};
struct EpiKV {
    static constexpr bool PERM = true;
#ifdef PROBE_EPI2
    static constexpr bool PROBE2 = (PROBE_EPI2 == 2);
#endif
    unsigned char* ws;
    __device__ __forceinline__ void operator()(const f32x4 (&acc)[2][2][4][2], const pg8::Unit& u, int wr, int wc, int fr, int fq) const {
        const float* rs = (const float*)(ws + WS_RSTDKV); bf16_t* kimg = (bf16_t*)(ws + WS_KIMG); bf16_t* vimg = (bf16_t*)(ws + WS_VIMG);
        EPI_LOAD_RS(rs)
        EPI_WALK({ const float r = rs8[ai][m];
                   _Pragma("unroll") for (int j = 0; j < 8; ++j) v[j] *= r;
                   const int col = (u.pn & 1) * 256 + cw, h = col >> 6, b = row >> 14, sq = row & (SEQ - 1), tile = sq >> 6, rr = sq & 63; const size_t tb = (size_t)((b * 8 + h) * 256 + tile);
                   if (u.pn < 2) {
#ifdef KEEP_BF16_IMAGES
                       *(u32x4*)(kimg + tb * 6144 + ((col & 63) >> 3) * 512 + rr * 8) = pack8(v);
#endif
                       *(u32x2*)(ws + WS_K8 + tb * 6144 + ((col & 63) >> 4) * 1024 + rr * 16 + (col & 8)) = (u32x2){pack4_fp8(v[0], v[1], v[2], v[3]), pack4_fp8(v[4], v[5], v[6], v[7])}; }
                   else *(u32x4*)(vimg + tb * 4096 + ((col & 63) >> 5) * 2048 + rr * 32 + (col & 31)) = pack8(v); })
    }
};
template <bool SECOND> struct EpiGate {
    static constexpr bool PERM = true;
#ifdef PROBE_EPI2
    static constexpr bool PROBE2 = (PROBE_EPI2 == 3);
#endif
    unsigned char* ws;
    __device__ __forceinline__ void operator()(const f32x4 (&acc)[2][2][4][2], const pg8::Unit& u, int wr, int wc, int fr, int fq) const {
        bf16_t* mg = (bf16_t*)(ws + WS_MERGED); const bf16_t* gt = (const bf16_t*)(ws + (SECOND ? WS_GB : WS_GA));
#pragma unroll
        for (int ai = 0; ai < 2; ++ai) {
            u32x4 gw[4][2], pw[4][2];
#pragma unroll
            for (int m = 0; m < 4; ++m)
#pragma unroll
                for (int bj = 0; bj < 2; ++bj) { const size_t o = (size_t)EPI_ROW(ai, m) * 1024 + u.pn * 256 + bj * 128 + wc * 32 + 8 * fq; gw[m][bj] = *(const u32x4*)(gt + o); if (SECOND) pw[m][bj] = *(const u32x4*)(mg + o); }
#pragma unroll
            for (int m = 0; m < 4; ++m)
#pragma unroll
                for (int bj = 0; bj < 2; ++bj) { const size_t o = (size_t)EPI_ROW(ai, m) * 1024 + u.pn * 256 + bj * 128 + wc * 32 + 8 * fq;
                    float v[8] = {acc[ai][bj][m][0][0], acc[ai][bj][m][0][1], acc[ai][bj][m][0][2], acc[ai][bj][m][0][3], acc[ai][bj][m][1][0], acc[ai][bj][m][1][1], acc[ai][bj][m][1][2], acc[ai][bj][m][1][3]};
                    float g[8]; unpack8(gw[m][bj], g);
                    if (SECOND) { float p[8]; unpack8(pw[m][bj], p); _Pragma("unroll") for (int j = 0; j < 8; ++j) v[j] = p[j] + g[j] * v[j]; }
                    else { _Pragma("unroll") for (int j = 0; j < 8; ++j) v[j] = g[j] * v[j]; }
                    *(u32x4*)(mg + o) = pack8(v); }
            asm volatile("" ::: "memory");
        }
    }
};
struct EpiGateFused {
    static constexpr bool PERM = true;
#ifdef PROBE_EPI2
    static constexpr bool PROBE2 = false;
#endif
    unsigned char* ws;
    __device__ __forceinline__ void operator()(const f32x4 (&acc_)[2][2][4][2], const pg8::Unit& u, int wr, int wc, int fr, int fq) const {
        f32x4 (&acc)[2][2][4][2] = const_cast<f32x4 (&)[2][2][4][2]>(acc_);
        bf16_t* mg = (bf16_t*)(ws + WS_MERGED); const bf16_t* gt = (const bf16_t*)(ws + (u.e ? WS_GB : WS_GA));
#pragma unroll
        for (int ai = 0; ai < 2; ++ai) {
            u32x4 gw[4][2];
#pragma unroll
            for (int m = 0; m < 4; ++m)
#pragma unroll
                for (int bj = 0; bj < 2; ++bj) { const size_t o = (size_t)EPI_ROW(ai, m) * 1024 + u.pn * 256 + bj * 128 + wc * 32 + 8 * fq; gw[m][bj] = *(const u32x4*)(gt + o); }
#pragma unroll
            for (int m = 0; m < 4; ++m)
#pragma unroll
                for (int bj = 0; bj < 2; ++bj) { const size_t o = (size_t)EPI_ROW(ai, m) * 1024 + u.pn * 256 + bj * 128 + wc * 32 + 8 * fq;
                    float g[8]; unpack8(gw[m][bj], g);
                    if (u.e == 0) {
#pragma unroll
                        for (int j = 0; j < 8; ++j) acc[ai][bj][m][j >> 2][j & 3] *= g[j];
                    } else { float v[8];
#pragma unroll
#ifdef WO_FP8
                        for (int j = 0; j < 8; ++j) v[j] = (32.f * g[j]) * acc[ai][bj][m][j >> 2][j & 3];
                        *(u32x2*)((unsigned char*)mg + o) = (u32x2){pack4_fp8(v[0], v[1], v[2], v[3]), pack4_fp8(v[4], v[5], v[6], v[7])}; } }
#else
                        for (int j = 0; j < 8; ++j) v[j] = g[j] * acc[ai][bj][m][j >> 2][j & 3];
                        *(u32x4*)(mg + o) = pack8(v); } }
#endif
            asm volatile("" ::: "memory");
        }
    }
};
struct EpiResid {
    static constexpr bool PERM = true;
#ifdef PROBE_EPI2
    static constexpr bool PROBE2 = (PROBE_EPI2 == 4);
#endif
    unsigned char* ws; const float* x; float* x1;
    __device__ __forceinline__ void operator()(const f32x4 (&acc)[2][2][4][2], const pg8::Unit& u, int wr, int wc, int fr, int fq) const {
        bf16_t* h2 = (bf16_t*)(ws + WS_H2);
#pragma unroll
        for (int ai = 0; ai < 2; ++ai) {
            f32x4 xa[4][2][2];
#pragma unroll
            for (int m = 0; m < 4; ++m)
#pragma unroll
                for (int bj = 0; bj < 2; ++bj) { const size_t o = (size_t)EPI_ROW(ai, m) * 1024 + u.pn * 256 + bj * 128 + wc * 32 + 8 * fq; xa[m][bj][0] = *(const f32x4*)(x + o); xa[m][bj][1] = *(const f32x4*)(x + o + 4); }
#pragma unroll
            for (int m = 0; m < 4; ++m)
#pragma unroll
                for (int bj = 0; bj < 2; ++bj) { const size_t o = (size_t)EPI_ROW(ai, m) * 1024 + u.pn * 256 + bj * 128 + wc * 32 + 8 * fq;
                    const f32x4 r0 = acc[ai][bj][m][0] + xa[m][bj][0], r1 = acc[ai][bj][m][1] + xa[m][bj][1];
                    *(f32x4*)(x1 + o) = r0; *(f32x4*)(x1 + o + 4) = r1;
                    const float v[8] = {r0[0], r0[1], r0[2], r0[3], r1[0], r1[1], r1[2], r1[3]};
                    *(u32x2*)((unsigned char*)h2 + o) = (u32x2){pack4_fp8(v[0], v[1], v[2], v[3]), pack4_fp8(v[4], v[5], v[6], v[7])}; }
            asm volatile("" ::: "memory");
        }
    }
};
struct EpiSwiglu {
    static constexpr bool PERM = true;
#ifdef PROBE_EPI2
    static constexpr bool PROBE2 = (PROBE_EPI2 == 5);
#endif
    unsigned char* ws; const float* bgu;
    __device__ __forceinline__ void operator()(const f32x4 (&acc)[2][2][4][2], const pg8::Unit& u, int wr, int wc, int fr, int fq) const {
        bf16_t* act = (bf16_t*)(ws + WS_ACT); const float* rsc = (const float*)(ws + WS_ROWSCALE);
        const int c0 = u.pn * 128 + wc * 32 + 8 * fq; const float* bg = bgu + (size_t)u.e * 2048 + c0;
        constexpr float CS = -1.702f * LOG2E;
        float bgv[8], buv[8];
#pragma unroll
        for (int j = 0; j < 8; ++j) { bgv[j] = CS * bg[j]; buv[j] = bg[1024 + j]; }
        EPI_LOAD_RS(rsc)
#pragma unroll
        for (int ai = 0; ai < 2; ++ai)
#pragma unroll
            for (int m = 0; m < 4; ++m) {
                const int row = u.pm * 256 + ai * 128 + wr * 64 + m * 16 + fr; const float r = rs8[ai][m], rc = CS * r; float o[8];
#pragma unroll
                for (int j = 0; j < 8; ++j) { const float a0 = __builtin_fmaf(acc[ai][0][m][j >> 2][j & 3], rc, bgv[j]), u0 = __builtin_fmaf(acc[ai][1][m][j >> 2][j & 3], r, buv[j]);
                    const float a = fmaxf(a0, 7.f * CS), up = __builtin_amdgcn_fmed3f(u0, -7.f, 7.f);
                    const float t = a * frcp(1.f + fexp2(a));
                    o[j] = __builtin_fmaf(up, t, t); }
                *(u32x2*)((unsigned char*)act + (size_t)row * 1024 + c0) = (u32x2){pack4_fp8(o[0], o[1], o[2], o[3]), pack4_fp8(o[4], o[5], o[6], o[7])};
            }
    }
};
struct EpiDown {
    static constexpr bool PERM = true;
#ifdef PROBE_EPI2
    static constexpr bool PROBE2 = (PROBE_EPI2 == 6);
#endif
    unsigned char* ws; const float* bd;
    __device__ __forceinline__ void operator()(const f32x4 (&acc)[2][2][4][2], const pg8::Unit& u, int wr, int wc, int fr, int fq) const {
        unsigned char* y = ws + WS_Y; const float* b = bd + (size_t)u.e * 1024 + u.pn * 256 + wc * 32 + 8 * fq;
        float bv[2][8];
#pragma unroll
        for (int bj = 0; bj < 2; ++bj) { const f32x4 b0 = *(const f32x4*)(b + bj * 128), b1 = *(const f32x4*)(b + bj * 128 + 4);
            bv[bj][0] = 16.f * b0.x; bv[bj][1] = 16.f * b0.y; bv[bj][2] = 16.f * b0.z; bv[bj][3] = 16.f * b0.w; bv[bj][4] = 16.f * b1.x; bv[bj][5] = 16.f * b1.y; bv[bj][6] = 16.f * b1.z; bv[bj][7] = 16.f * b1.w; }
        EPI_WALK({ _Pragma("unroll") for (int j = 0; j < 8; ++j) v[j] = __builtin_fmaf(16.f, v[j], bv[bj][j]);
                   *(u32x2*)(y + (size_t)row * 1024 + u.pn * 256 + cw) = (u32x2){pack4_fp8(v[0], v[1], v[2], v[3]), pack4_fp8(v[4], v[5], v[6], v[7])}; })
    }
};

typedef short v4i16_t __attribute__((ext_vector_type(4)));
__device__ __forceinline__ s16x4 vtr(const LAS char* p) { return __builtin_bit_cast(s16x4, __builtin_amdgcn_ds_read_tr16_b64_v4i16((LAS v4i16_t*)p)); }
__device__ __forceinline__ float swapmax(float m) { auto rr = __builtin_amdgcn_permlane32_swap(__float_as_uint(m), __float_as_uint(m), false, false); return fmaxf(__uint_as_float(rr[0]), __uint_as_float(rr[1])); }
__device__ __forceinline__ float swapsum(float m) { auto rr = __builtin_amdgcn_permlane32_swap(__float_as_uint(m), __float_as_uint(m), false, false); return __uint_as_float(rr[0]) + __uint_as_float(rr[1]); }

struct AttnState { f32x16 o0, o1; float m, l; };

struct MlaKL {
    const bf16_t* K; const bf16_t* V;
    template <int D0> __device__ __forceinline__ bf16x8 kfrag(int c, int r32, int hi) const { return *(const bf16x8*)(K + (size_t)(c >> 1) * 6144 + (2 * D0 + hi) * 512 + ((c & 1) * 32 + r32) * 8); }
    __device__ __forceinline__ u32x4 vpiece(int c, int row, int c8) const { return *(const u32x4*)(V + (size_t)(c >> 1) * 4096 + (c8 >> 2) * 2048 + ((c & 1) * 32 + row) * 32 + (c8 & 3) * 8); }
    __device__ __forceinline__ void modify(int, f32x16&, int, int) const {}
    __device__ __forceinline__ int order(int i) const { return i; }
};
__device__ __forceinline__ bf16x8 fp8x8_to_bf16(u32x2 w, float sc) {
    const f32x2 a = __builtin_amdgcn_cvt_pk_f32_fp8((int)w.x, false), b = __builtin_amdgcn_cvt_pk_f32_fp8((int)w.x, true), c = __builtin_amdgcn_cvt_pk_f32_fp8((int)w.y, false), d = __builtin_amdgcn_cvt_pk_f32_fp8((int)w.y, true);
    const u32x4 o = {cvtpk(a.x * sc, a.y * sc), cvtpk(b.x * sc, b.y * sc), cvtpk(c.x * sc, c.y * sc), cvtpk(d.x * sc, d.y * sc)};
    return __builtin_bit_cast(bf16x8, o);
}
struct MlaKL8 {
    const unsigned char* K; const bf16_t* V;
    template <int D0> __device__ __forceinline__ bf16x8 kfrag(int c, int r32, int hi) const { return fp8x8_to_bf16(*(const u32x2*)(K + (size_t)(c >> 1) * 6144 + D0 * 1024 + ((c & 1) * 32 + r32) * 16 + hi * 8), 1.f); }
    __device__ __forceinline__ u32x4 vpiece(int c, int row, int c8) const { return *(const u32x4*)(V + (size_t)(c >> 1) * 4096 + (c8 >> 2) * 2048 + ((c & 1) * 32 + row) * 32 + (c8 & 3) * 8); }
    __device__ __forceinline__ void modify(int, f32x16&, int, int) const {}
    __device__ __forceinline__ int order(int i) const { return i; }
};
struct DilKL {
    const bf16_t* K; const bf16_t* V;
    int dil, res, u0, L; float slope2d;
    __device__ __forceinline__ size_t tok(int c, int kk) const { int v = u0 - 64 + 32 * c + kk; v = v < 0 ? 0 : (v >= L ? L - 1 : v); return (size_t)(res + dil * v); }
    template <int D0> __device__ __forceinline__ bf16x8 kfrag(int c, int r32, int hi) const { return *(const bf16x8*)(K + tok(c, r32) * 512 + 16 * D0 + 8 * hi); }
    __device__ __forceinline__ u32x4 vpiece(int c, int row, int c8) const { return *(const u32x4*)(V + tok(c, row) * 512 + 8 * c8); }
    __device__ __forceinline__ void modify(int c, f32x16& s, int r32, int hi) const {
        const float c0 = (float)(32 * c - 64); const int vb = u0 - 64 + 32 * c;
#pragma unroll
        for (int r = 0; r < 16; ++r) { const float d = (float)(crow(r, hi) - r32); s[r] = s[r] - slope2d * fabsf(d + c0); }
        if (c == 0) {
#pragma unroll
            for (int r = 0; r < 16; ++r) s[r] = (crow(r, hi) >= r32) ? s[r] : -1e30f; }
        if (c == 4) {
#pragma unroll
            for (int r = 0; r < 16; ++r) s[r] = (crow(r, hi) <= r32) ? s[r] : -1e30f; }
        if (vb < 0 || vb + 31 >= L) {
#pragma unroll
            for (int r = 0; r < 16; ++r) { const int v = vb + crow(r, hi); s[r] = (v >= 0 && v < L) ? s[r] : -1e30f; } }
    }
    __device__ __forceinline__ int order(int i) const { return i == 0 ? 2 : i == 1 ? 1 : i == 2 ? 3 : i == 3 ? 0 : 4; }
};

template <int NDK, class KL> __device__ __forceinline__ void attn_load_k(bf16x8 (&kf)[NDK], const KL& kl, int c, int r32, int hi) {
    kf[0] = kl.template kfrag<0>(c, r32, hi); kf[1] = kl.template kfrag<1>(c, r32, hi); kf[2] = kl.template kfrag<2>(c, r32, hi); kf[3] = kl.template kfrag<3>(c, r32, hi);
    if constexpr (NDK == 6) { kf[4] = kl.template kfrag<4>(c, r32, hi); kf[5] = kl.template kfrag<5>(c, r32, hi); }
}
template <class KL> __device__ __forceinline__ void attn_load_v(u32x4 (&vp)[4], const KL& kl, int c, int lane) {
#pragma unroll
    for (int i = 0; i < 4; ++i) { const int p = lane + 64 * i; vp[i] = kl.vpiece(c, p >> 3, p & 7); }
}
__device__ __forceinline__ void attn_store_v(const u32x4 (&vp)[4], LAS char* vimg, int lane) {
#pragma unroll
    for (int i = 0; i < 4; ++i) { const int p = lane + 64 * i, row = p >> 3, c8 = p & 7; *(LAS u32x4*)(vimg + (c8 >> 2) * 2048 + row * 64 + (c8 & 3) * 16) = vp[i]; }
}
template <int NDK, class KL> __device__ __forceinline__ void attn_core(AttnState& st, const bf16x8 (&qf)[NDK], const bf16x8 (&kf)[NDK], const KL& kl, int c, LAS char* vimg, LAS float* wsf, int lane, int r32, int hi) {
    f32x16 s = {};
#pragma unroll
    for (int d0 = 0; d0 < NDK; ++d0) s = __builtin_amdgcn_mfma_f32_32x32x16_bf16(kf[d0], qf[d0], s, 0, 0, 0);
    kl.modify(c, s, r32, hi);
    float mx = s[0];
#pragma unroll
    for (int r = 1; r < 16; ++r) mx = fmaxf(mx, s[r]);
    mx = swapmax(mx);
    const float mn = fmaxf(st.m, mx), alpha = fexp2(st.m - mn);
    float ps = 0.f;
#pragma unroll
    for (int r = 0; r < 16; ++r) { s[r] = fexp2(s[r] - mn); ps += s[r]; }
    st.l = st.l * alpha + ps; st.m = mn;
    if (__any(alpha != 1.f)) {
        if (hi == 0) wsf[r32] = alpha;
#pragma unroll
        for (int r = 0; r < 16; ++r) { const float a = wsf[crow(r, hi)]; st.o0[r] *= a; st.o1[r] *= a; }
    }
    const u32x4 pw0 = {cvtpk(s[0], s[1]), cvtpk(s[2], s[3]), cvtpk(s[4], s[5]), cvtpk(s[6], s[7])};
    const u32x4 pw1 = {cvtpk(s[8], s[9]), cvtpk(s[10], s[11]), cvtpk(s[12], s[13]), cvtpk(s[14], s[15])};
    const bf16x8 pa0 = __builtin_bit_cast(bf16x8, pw0), pa1 = __builtin_bit_cast(bf16x8, pw1);
    const LAS char* vp = vimg + ((lane >> 4) & 1) * 32 + (lane & 3) * 8 + (4 * hi + ((lane & 15) >> 2)) * 64;
#pragma unroll
    for (int ks = 0; ks < 2; ++ks) {
        const s16x4 l0 = vtr(vp + ks * 1024), h0 = vtr(vp + ks * 1024 + 512), l1 = vtr(vp + 2048 + ks * 1024), h1 = vtr(vp + 2048 + ks * 1024 + 512);
        const bf16x8 v0 = {l0[0], l0[1], l0[2], l0[3], h0[0], h0[1], h0[2], h0[3]}, v1 = {l1[0], l1[1], l1[2], l1[3], h1[0], h1[1], h1[2], h1[3]};
        st.o0 = __builtin_amdgcn_mfma_f32_32x32x16_bf16(ks == 0 ? pa0 : pa1, v0, st.o0, 0, 0, 0);
        st.o1 = __builtin_amdgcn_mfma_f32_32x32x16_bf16(ks == 0 ? pa0 : pa1, v1, st.o1, 0, 0, 0);
    }
}
template <int NDK, class KL> __device__ __forceinline__ void wave_attn(AttnState& st, const bf16x8 (&qf)[NDK], const KL& kl, int nchunk, LAS char* vimg, LAS float* wsf, int lane) {
    const int r32 = lane & 31, hi = lane >> 5;
    st.o0 = f32x16{}; st.o1 = f32x16{}; st.m = -1e30f; st.l = 0.f;
    bf16x8 kfa[NDK], kfb[NDK]; u32x4 vp[4];
    attn_load_k<NDK>(kfa, kl, kl.order(0), r32, hi); attn_load_v(vp, kl, kl.order(0), lane);
    asm volatile("" : "+s"(nchunk));
#pragma unroll 1
    for (int c = 0; c < nchunk; c += 2) {
        attn_store_v(vp, vimg, lane);
        if (c + 1 < nchunk) { attn_load_k<NDK>(kfb, kl, kl.order(c + 1), r32, hi); attn_load_v(vp, kl, kl.order(c + 1), lane); }
        attn_core<NDK>(st, qf, kfa, kl, kl.order(c), vimg, wsf, lane, r32, hi);
        if (c + 1 < nchunk) {
            attn_store_v(vp, vimg, lane);
            if (c + 2 < nchunk) { attn_load_k<NDK>(kfa, kl, kl.order(c + 2), r32, hi); attn_load_v(vp, kl, kl.order(c + 2), lane); }
            attn_core<NDK>(st, qf, kfb, kl, kl.order(c + 1), vimg, wsf, lane, r32, hi);
        }
    }
}
__device__ __forceinline__ float attn_finish(AttnState& st, LAS char* vimg, LAS float* wsf, int lane) {
    const int r32 = lane & 31, hi = lane >> 5;
    const float lt = swapsum(st.l);
    if (hi == 0) wsf[32 + r32] = lt;
    LAS bf16_t* stg = (LAS bf16_t*)vimg;
#pragma unroll
    for (int r = 0; r < 16; ++r) { const int q = crow(r, hi); const float il = frcp(wsf[32 + q]);
        stg[q * 64 + r32] = (bf16_t)f2bf(st.o0[r] * il); stg[q * 64 + 32 + r32] = (bf16_t)f2bf(st.o1[r] * il); }
    return lt;
}

namespace mla {
constexpr int NW = 8, QBLK = 32, QB = 256, KVBLK = 64, NT = SEQ / KVBLK;
constexpr int KSLOT = 12288, VSLOT = 8192, LDS_K = 0, LDS_V = 3 * KSLOT, LDS_WS = LDS_V + 3 * VSLOT, LDS_OST = LDS_WS + NW * 256, LDS_BYTES_ = LDS_OST + NW * 4096;
#define SBAR() __builtin_amdgcn_sched_barrier(0)
#define WAIT_BAR(N) asm volatile("s_waitcnt vmcnt(" #N ") lgkmcnt(0)\n\ts_barrier" ::: "memory")
__device__ __forceinline__ void glds16(const void* gsrc, unsigned lds_dst) { unsigned keep;
    asm volatile("s_mov_b32 %0, m0\n\ts_mov_b32 m0, %2\n\ts_nop 0\n\tglobal_load_lds_dwordx4 %1, off\n\ts_mov_b32 m0, %0" : "=&s"(keep) : "v"(gsrc), "s"(lds_dst) : "memory"); }
typedef LAS const char* lds_cptr;
__device__ __forceinline__ void kload2(bf16x8* kf, lds_cptr kp, int j) { kf[2 * j] = *(const LAS bf16x8*)(kp + j * 2048); kf[2 * j + 1] = *(const LAS bf16x8*)(kp + j * 2048 + 512); }

__device__ __forceinline__ void mla_unit(int b, int h, int qb, const bf16_t* Q, const bf16_t* __restrict__ Kim, const bf16_t* __restrict__ Vim, bf16_t* O, LAS char* shm) {
    const int tid = threadIdx.x, lane = tid & 63, r32 = lane & 31, hi = lane >> 5; const int wid = __builtin_amdgcn_readfirstlane(tid >> 6);
    const long rowbase = (long)b * SEQ; const int q0 = qb * QB;
    const bf16_t* Qw = Q + (rowbase + q0 + wid * QBLK) * 768 + h * 96;
    const unsigned lds0 = (unsigned)(uintptr_t)shm;
    LAS float* wsf = (LAS float*)(shm + LDS_WS) + wid * 64;
    const bf16_t* ksrc = Kim + wid * 512 + lane * 8;
    const bf16_t* rsrc = Kim + (8 + (wid & 3)) * 512 + lane * 8;
    const bf16_t* vsrc = Vim + wid * 512 + lane * 8;
    const unsigned kdst = lds0 + LDS_K + wid * 1024, rdst = lds0 + LDS_K + (8 + (wid & 3)) * 1024, vdst = lds0 + LDS_V + wid * 1024;
#define DMA_K(t, ks) do { glds16(ksrc + (long)(t) * 6144, (unsigned)__builtin_amdgcn_readfirstlane(kdst + (ks))); glds16(rsrc + (long)(t) * 6144, (unsigned)__builtin_amdgcn_readfirstlane(rdst + (ks))); } while (0)
#define DMA_V(t, vs) glds16(vsrc + (long)(t) * 4096, (unsigned)__builtin_amdgcn_readfirstlane(vdst + (vs)))
    const lds_cptr shm3 = (lds_cptr)shm; const lds_cptr kp0 = shm3 + LDS_K + hi * 1024 + r32 * 16;
    const lds_cptr vp0 = shm3 + LDS_V + ((lane >> 4) & 1) * 32 + (lane & 3) * 8 + (4 * hi + ((lane & 15) >> 2)) * 64;
    bf16x8 kf[12];
    DMA_K(0, 0); DMA_V(0, 0); DMA_K(1, KSLOT);
    bf16x8 qr[6];
#pragma unroll
    for (int d0 = 0; d0 < 6; ++d0) qr[d0] = *reinterpret_cast<const bf16x8*>(&Qw[(long)r32 * 768 + d0 * 16 + hi * 8]);
    float l_reg = 0.f; f32x16 o[2]; o[0] = f32x16{}; o[1] = f32x16{};
    f32x16 pA0, pA1, pB0, pB1;
    int si_prev = 0, si_cur = 0, si_next = 1;
#define ROT() do { si_prev = si_cur; si_cur = si_next; si_next = (si_next == 2) ? 0 : si_next + 1; } while (0)
    DMA_K(2, 2 * KSLOT);
    WAIT_BAR(5);
    { const lds_cptr kb = kp0;
#pragma unroll
      for (int d0 = 0; d0 < 6; ++d0) { const bf16x8 b0 = *(const LAS bf16x8*)(kb + d0 * 2048), b1 = *(const LAS bf16x8*)(kb + d0 * 2048 + 512);
          if (d0 == 0) { pA0 = __builtin_amdgcn_mfma_f32_32x32x16_bf16(b0, qr[0], f32x16{}, 0, 0, 0); pA1 = __builtin_amdgcn_mfma_f32_32x32x16_bf16(b1, qr[0], f32x16{}, 0, 0, 0); }
          else { pA0 = __builtin_amdgcn_mfma_f32_32x32x16_bf16(b0, qr[d0], pA0, 0, 0, 0); pA1 = __builtin_amdgcn_mfma_f32_32x32x16_bf16(b1, qr[d0], pA1, 0, 0, 0); } } }
#pragma unroll
    for (int r = 0; r < 16; ++r) { pA0[r] = __builtin_amdgcn_exp2f(pA0[r]); pA1[r] = __builtin_amdgcn_exp2f(pA1[r]); }
    WAIT_BAR(0);
    DMA_K(3, 0); DMA_V(1, VSLOT);
    ROT();
#pragma unroll
    for (int j = 0; j < 6; ++j) kload2(kf, kp0 + si_cur * KSLOT, j);
    WAIT_BAR(3);
    s16x4 vlo[8], vhi[8]; u32x4 pw0, pw1, pw2, pw3;
#define PKW(P, B) cvtpk(P[B], P[B + 1])
#define PAF(k) __builtin_bit_cast(bf16x8, pw##k)
#define VFR(i) (bf16x8){vlo[i][0], vlo[i][1], vlo[i][2], vlo[i][3], vhi[i][0], vhi[i][1], vhi[i][2], vhi[i][3]}
#define PIN(x) asm volatile("" : "+v"(x))
#define MF(a, b, c) __builtin_amdgcn_mfma_f32_32x32x16_bf16(a, b, c, 0, 0, 0)
#define GAPA(MFX, A0, A1, A2, A3, W0, W1, PW) do { MFX; sacc += A0; sacc += A1; sacc += A2; sacc += A3; PIN(sacc); W0; W1; PIN(PW); SBAR(); } while (0)
#define GAPM(MFX) do { MFX; SBAR(); } while (0)
#define EX(v) __builtin_amdgcn_exp2f(v)
#define GAPB(MFX, X, B) do { MFX; X[B] = EX(X[B]); X[B + 1] = EX(X[B + 1]); X[B + 2] = EX(X[B + 2]); X[B + 3] = EX(X[B + 3]); PIN(X); SBAR(); } while (0)
#define VRD(i) do { vlo[i] = vtr(vp_ + (((i) >> 2) * 4096 + ((i) & 3) * 1024)); vhi[i] = vtr(vp_ + (((i) >> 2) * 4096 + ((i) & 3) * 1024 + 512)); } while (0)
#define KRD(G, j) do { if (G) { kload2(kf, kp0 + si_next * KSLOT, j); SBAR(); } } while (0)
#define STEP(C0, C1, P0, P1, t, GK, GV, GL) do { SBAR(); \
    const lds_cptr vp_ = vp0 + si_prev * VSLOT; \
    VRD(0); SBAR(); float sacc = (P0[0] + P0[1]); \
    GAPA(C0 = MF(kf[0], qr[0], f32x16{}), P0[2], P0[3], P0[4], P0[5],     pw0[0] = PKW(P0, 0),  pw0[1] = PKW(P0, 2),  pw0); \
    VRD(4); SBAR(); GAPA(C1 = MF(kf[1], qr[0], f32x16{}), P0[6], P0[7], P0[8], P0[9],     pw0[2] = PKW(P0, 4),  pw0[3] = PKW(P0, 6),  pw0); \
    VRD(1); SBAR(); GAPA(C0 = MF(kf[2], qr[1], C0),   P0[10], P0[11], P0[12], P0[13], pw1[0] = PKW(P0, 8),  pw1[1] = PKW(P0, 10), pw1); \
    VRD(5); SBAR(); GAPA(C1 = MF(kf[3], qr[1], C1),   P0[14], P0[15], P1[0], P1[1],   pw1[2] = PKW(P0, 12), pw1[3] = PKW(P0, 14), pw1); \
    VRD(2); SBAR(); GAPA(C0 = MF(kf[4], qr[2], C0),   P1[2], P1[3], P1[4], P1[5],     pw2[0] = PKW(P1, 0),  pw2[1] = PKW(P1, 2),  pw2); \
    VRD(6); SBAR(); GAPA(C1 = MF(kf[5], qr[2], C1),   P1[6], P1[7], P1[8], P1[9],     pw2[2] = PKW(P1, 4),  pw2[3] = PKW(P1, 6),  pw2); \
    VRD(3); SBAR(); GAPA(C0 = MF(kf[6], qr[3], C0),   P1[10], P1[11], P1[12], P1[13], pw3[0] = PKW(P1, 8),  pw3[1] = PKW(P1, 10), pw3); \
    VRD(7); SBAR(); GAPA(C1 = MF(kf[7], qr[3], C1),   P1[14], P1[15], 0.f, 0.f,       pw3[2] = PKW(P1, 12), pw3[3] = PKW(P1, 14), pw3); \
    GAPM(C0 = MF(kf[8], qr[4], C0)); GAPM(C1 = MF(kf[9], qr[4], C1)); GAPM(C0 = MF(kf[10], qr[5], C0)); GAPM(C1 = MF(kf[11], qr[5], C1)); \
    l_reg += sacc; \
    if (GK) { DMA_K((t) + 3, si_cur * KSLOT); } if (GV) { DMA_V((t) + 1, si_next * VSLOT); } \
    SBAR(); \
    GAPB(o[0] = MF(PAF(0), VFR(0), o[0]), C0, 0); \
    GAPB(o[1] = MF(PAF(0), VFR(4), o[1]), C0, 4); \
    KRD(GL, 0); GAPB(o[0] = MF(PAF(1), VFR(1), o[0]), C0, 8); \
    KRD(GL, 1); GAPB(o[1] = MF(PAF(1), VFR(5), o[1]), C0, 12); \
    KRD(GL, 2); GAPB(o[0] = MF(PAF(2), VFR(2), o[0]), C1, 0); \
    KRD(GL, 3); GAPB(o[1] = MF(PAF(2), VFR(6), o[1]), C1, 4); \
    KRD(GL, 4); GAPB(o[0] = MF(PAF(3), VFR(3), o[0]), C1, 8); \
    KRD(GL, 5); GAPB(o[1] = MF(PAF(3), VFR(7), o[1]), C1, 12); \
    } while (0)
    int t = 1;
    for (; t + 5 < NT; t += 2) {
        STEP(pB0, pB1, pA0, pA1, t, true, true, true);     WAIT_BAR(3); ROT();
        STEP(pA0, pA1, pB0, pB1, t + 1, true, true, true); WAIT_BAR(3); ROT();
    }
#define ENDW(tt) do { if ((tt) + 3 < NT) { WAIT_BAR(3); } else if ((tt) + 2 < NT) { WAIT_BAR(1); } else { WAIT_BAR(0); } } while (0)
    for (; t + 1 < NT; t += 2) {
        STEP(pB0, pB1, pA0, pA1, t, (t + 3 < NT), (t + 1 < NT), (t + 1 < NT));         ENDW(t);     ROT();
        STEP(pA0, pA1, pB0, pB1, t + 1, (t + 4 < NT), (t + 2 < NT), (t + 2 < NT));     ENDW(t + 1); ROT();
    }
    STEP(pB0, pB1, pA0, pA1, NT - 1, false, false, false);
    { float sacc = pB0[0] + pB0[1];
#pragma unroll
      for (int r = 2; r < 16; ++r) sacc += pB0[r];
#pragma unroll
      for (int r = 0; r < 16; ++r) sacc += pB1[r];
      l_reg += sacc;
      pw0 = (u32x4){PKW(pB0, 0), PKW(pB0, 2), PKW(pB0, 4), PKW(pB0, 6)}; pw1 = (u32x4){PKW(pB0, 8), PKW(pB0, 10), PKW(pB0, 12), PKW(pB0, 14)};
      pw2 = (u32x4){PKW(pB1, 0), PKW(pB1, 2), PKW(pB1, 4), PKW(pB1, 6)}; pw3 = (u32x4){PKW(pB1, 8), PKW(pB1, 10), PKW(pB1, 12), PKW(pB1, 14)};
      SBAR();
      const lds_cptr vp_ = vp0 + si_cur * VSLOT;
#pragma unroll
      for (int d0 = 0; d0 < 2; ++d0) {
          s16x4 lo4[4], hi4[4];
#pragma unroll
          for (int ks = 0; ks < 4; ++ks) { lo4[ks] = vtr(vp_ + d0 * 4096 + ks * 1024); hi4[ks] = vtr(vp_ + d0 * 4096 + ks * 1024 + 512); }
#define PK4(k) (bf16x8){lo4[k][0], lo4[k][1], lo4[k][2], lo4[k][3], hi4[k][0], hi4[k][1], hi4[k][2], hi4[k][3]}
          o[d0] = MF(PAF(0), PK4(0), o[d0]); o[d0] = MF(PAF(1), PK4(1), o[d0]); o[d0] = MF(PAF(2), PK4(2), o[d0]); o[d0] = MF(PAF(3), PK4(3), o[d0]);
#undef PK4
      } }
    l_reg = swapsum(l_reg);
    if (hi == 0) wsf[32 + r32] = l_reg;
    asm volatile("s_waitcnt lgkmcnt(0)" ::: "memory");
    float rli[16];
#pragma unroll
    for (int r = 0; r < 16; ++r) rli[r] = __builtin_amdgcn_rcpf(wsf[32 + crow(r, hi)]);
    bf16_t* Ow = O + (rowbase + q0 + wid * QBLK) * 512 + h * 64;
    { LAS bf16_t* stg = (LAS bf16_t*)(shm + LDS_OST) + wid * 2048;
#pragma unroll
      for (int r = 0; r < 16; ++r) { const int orow = crow(r, hi);
#pragma unroll
          for (int d0 = 0; d0 < 2; ++d0) stg[orow * 64 + d0 * 32 + r32] = (bf16_t)f2bf(o[d0][r] * rli[r]); }
      asm volatile("s_waitcnt lgkmcnt(0)" ::: "memory");
#pragma unroll
      for (int i = 0; i < 4; ++i) { const int row = i * 8 + (lane >> 3), ch = lane & 7; const u32x4 v = *(const LAS u32x4*)(stg + row * 64 + ch * 8); *(u32x4*)(Ow + (long)row * 512 + ch * 8) = v; } }
    asm volatile("s_waitcnt lgkmcnt(0)\n\ts_barrier" ::: "memory");
#undef DMA_K
#undef DMA_V
#undef ROT
#undef PKW
#undef PAF
#undef VFR
#undef PIN
#undef MF
#undef GAPA
#undef GAPM
#undef GAPB
#undef EX
#undef VRD
#undef KRD
#undef STEP
#undef ENDW
}
#undef SBAR
#undef WAIT_BAR
}

namespace mla8 {
using mla::glds16; using mla::lds_cptr;
typedef int v8i __attribute__((ext_vector_type(8)));
constexpr int NW = 8, QBLK = 32, QB = 256, KVBLK = 64, NT = SEQ / KVBLK;
constexpr int KSLOT = 6144, VSLOT = 8192, LDS_K = 0, LDS_V = 3 * KSLOT, LDS_WS = LDS_V + 3 * VSLOT, LDS_OST = LDS_WS + NW * 256, LDS_BYTES_ = LDS_OST + NW * 4096;
#define SBAR() __builtin_amdgcn_sched_barrier(0)
#define WAIT_BAR(N) asm volatile("s_waitcnt vmcnt(" #N ") lgkmcnt(0)\n\ts_barrier" ::: "memory")
__device__ __forceinline__ v8i kfrag8(lds_cptr slot, int n, int ks, int r32, int hi) {
    const lds_cptr p = slot + (ks == 0 ? 2 * hi : 4) * 1024 + (32 * n + r32) * 16;
    const u32x4 a = *(const LAS u32x4*)p, b = *(const LAS u32x4*)(p + 1024);
    return (v8i){(int)a.x, (int)a.y, (int)a.z, (int)a.w, (int)b.x, (int)b.y, (int)b.z, (int)b.w};
}
#define MF8(a, b, c) __builtin_amdgcn_mfma_scale_f32_32x32x64_f8f6f4(a, b, c, 0, 0, 0, 0x7f7f7f7f, 0, 0x7b7b7b7b)

__device__ __forceinline__ void mla8_unit(int b, int h, int qb, const unsigned char* Q8, const unsigned char* __restrict__ K8im, const bf16_t* __restrict__ Vim, bf16_t* O, LAS char* shm) {
    const int tid = threadIdx.x, lane = tid & 63, r32 = lane & 31, hi = lane >> 5; const int wid = __builtin_amdgcn_readfirstlane(tid >> 6);
    const long rowbase = (long)b * SEQ; const int q0 = qb * QB;
    const unsigned char* Qw = Q8 + (size_t)(rowbase + q0 + wid * QBLK + r32) * 768 + h * 96;
    const unsigned lds0 = (unsigned)(uintptr_t)shm;
    LAS float* wsf = (LAS float*)(shm + LDS_WS) + wid * 64;
    const int kpc = wid < 6 ? wid : wid - 6;
    const unsigned char* ksrc = K8im + kpc * 1024 + lane * 16;
    const bf16_t* vsrc = Vim + wid * 512 + lane * 8;
    const unsigned kdst = lds0 + LDS_K + kpc * 1024, vdst = lds0 + LDS_V + wid * 1024;
#define DMA_K(t, ks) glds16(ksrc + (long)(t) * 6144, (unsigned)__builtin_amdgcn_readfirstlane(kdst + (ks)))
#define DMA_V(t, vs) glds16(vsrc + (long)(t) * 4096, (unsigned)__builtin_amdgcn_readfirstlane(vdst + (vs)))
    const lds_cptr shm3 = (lds_cptr)shm; const lds_cptr ks0 = shm3 + LDS_K;
    const lds_cptr vp0 = shm3 + LDS_V + ((lane >> 4) & 1) * 32 + (lane & 3) * 8 + (4 * hi + ((lane & 15) >> 2)) * 64;
    v8i kf[4];
    DMA_K(0, 0); DMA_V(0, 0); DMA_K(1, KSLOT);
    v8i qr[2];
    { const u32x4 a = *(const u32x4*)(Qw + 32 * hi), c = *(const u32x4*)(Qw + 32 * hi + 16); qr[0] = (v8i){(int)a.x, (int)a.y, (int)a.z, (int)a.w, (int)c.x, (int)c.y, (int)c.z, (int)c.w};
      u32x4 d = *(const u32x4*)(Qw + 64), e = *(const u32x4*)(Qw + 80); if (hi) { d = (u32x4){0u, 0u, 0u, 0u}; e = d; }
      qr[1] = (v8i){(int)d.x, (int)d.y, (int)d.z, (int)d.w, (int)e.x, (int)e.y, (int)e.z, (int)e.w}; }
    float l_reg = 0.f; f32x16 o[2]; o[0] = f32x16{}; o[1] = f32x16{};
    f32x16 pA0, pA1, pB0, pB1;
    int si_prev = 0, si_cur = 0, si_next = 1;
#define ROT() do { si_prev = si_cur; si_cur = si_next; si_next = (si_next == 2) ? 0 : si_next + 1; } while (0)
    DMA_K(2, 2 * KSLOT);
    WAIT_BAR(3);
    { pA0 = MF8(kfrag8(ks0, 0, 0, r32, hi), qr[0], f32x16{}); pA1 = MF8(kfrag8(ks0, 1, 0, r32, hi), qr[0], f32x16{});
      pA0 = MF8(kfrag8(ks0, 0, 1, r32, hi), qr[1], pA0); pA1 = MF8(kfrag8(ks0, 1, 1, r32, hi), qr[1], pA1); }
#pragma unroll
    for (int r = 0; r < 16; ++r) { pA0[r] = __builtin_amdgcn_exp2f(pA0[r]); pA1[r] = __builtin_amdgcn_exp2f(pA1[r]); }
    WAIT_BAR(0);
    DMA_K(3, 0); DMA_V(1, VSLOT);
    ROT();
    kf[0] = kfrag8(ks0 + si_cur * KSLOT, 0, 0, r32, hi); kf[1] = kfrag8(ks0 + si_cur * KSLOT, 0, 1, r32, hi); kf[2] = kfrag8(ks0 + si_cur * KSLOT, 1, 0, r32, hi); kf[3] = kfrag8(ks0 + si_cur * KSLOT, 1, 1, r32, hi);
    WAIT_BAR(2);
    s16x4 vlo[8], vhi[8]; u32x4 pw0, pw1, pw2, pw3;
#define PKW(P, B) cvtpk(P[B], P[B + 1])
#define PAF(k) __builtin_bit_cast(bf16x8, pw##k)
#define VFR(i) (bf16x8){vlo[i][0], vlo[i][1], vlo[i][2], vlo[i][3], vhi[i][0], vhi[i][1], vhi[i][2], vhi[i][3]}
#define PIN(x) asm volatile("" : "+v"(x))
#define MF(a, b, c) __builtin_amdgcn_mfma_f32_32x32x16_bf16(a, b, c, 0, 0, 0)
#define GAPA(MFX, A0, A1, A2, A3, W0, W1, PW) do { MFX; sacc += A0; sacc += A1; sacc += A2; sacc += A3; PIN(sacc); W0; W1; PIN(PW); SBAR(); } while (0)
#define GAPM(MFX) do { MFX; SBAR(); } while (0)
#define EX(v) __builtin_amdgcn_exp2f(v)
#define GAPB(MFX, X, B) do { MFX; X[B] = EX(X[B]); X[B + 1] = EX(X[B + 1]); X[B + 2] = EX(X[B + 2]); X[B + 3] = EX(X[B + 3]); PIN(X); SBAR(); } while (0)
#define VRD(i) do { vlo[i] = vtr(vp_ + (((i) >> 2) * 4096 + ((i) & 3) * 1024)); vhi[i] = vtr(vp_ + (((i) >> 2) * 4096 + ((i) & 3) * 1024 + 512)); } while (0)
#define KRD(G, j) do { if (G) { kf[j] = kfrag8(ks0 + si_next * KSLOT, (j) >> 1, (j) & 1, r32, hi); SBAR(); } } while (0)
#define GAPA8(MFX, A0, A1, A2, A3, A4, A5, A6, A7, W0, W1, W2, W3, PWa, PWb) do { MFX; sacc += A0; sacc += A1; sacc += A2; sacc += A3; PIN(sacc); W0; W1; PIN(PWa); sacc += A4; sacc += A5; sacc += A6; sacc += A7; PIN(sacc); W2; W3; PIN(PWb); SBAR(); } while (0)
#define STEP(C0, C1, P0, P1, t, GK, GV, GL) do { SBAR(); \
    const lds_cptr vp_ = vp0 + si_prev * VSLOT; \
    VRD(0); VRD(4); SBAR(); float sacc = (P0[0] + P0[1]); \
    GAPA8(C0 = MF8(kf[0], qr[0], f32x16{}), P0[2], P0[3], P0[4], P0[5], P0[6], P0[7], P0[8], P0[9],         pw0[0] = PKW(P0, 0), pw0[1] = PKW(P0, 2), pw0[2] = PKW(P0, 4), pw0[3] = PKW(P0, 6), pw0, pw0); \
    VRD(1); VRD(5); SBAR(); \
    GAPA8(C1 = MF8(kf[2], qr[0], f32x16{}), P0[10], P0[11], P0[12], P0[13], P0[14], P0[15], P1[0], P1[1],   pw1[0] = PKW(P0, 8), pw1[1] = PKW(P0, 10), pw1[2] = PKW(P0, 12), pw1[3] = PKW(P0, 14), pw1, pw1); \
    VRD(2); VRD(6); SBAR(); \
    GAPA8(C0 = MF8(kf[1], qr[1], C0),       P1[2], P1[3], P1[4], P1[5], P1[6], P1[7], P1[8], P1[9],         pw2[0] = PKW(P1, 0), pw2[1] = PKW(P1, 2), pw2[2] = PKW(P1, 4), pw2[3] = PKW(P1, 6), pw2, pw2); \
    VRD(3); VRD(7); SBAR(); \
    GAPA8(C1 = MF8(kf[3], qr[1], C1),       P1[10], P1[11], P1[12], P1[13], P1[14], P1[15], 0.f, 0.f,       pw3[0] = PKW(P1, 8), pw3[1] = PKW(P1, 10), pw3[2] = PKW(P1, 12), pw3[3] = PKW(P1, 14), pw3, pw3); \
    l_reg += sacc; \
    if (GK) { DMA_K((t) + 3, si_cur * KSLOT); } if (GV) { DMA_V((t) + 1, si_next * VSLOT); } \
    SBAR(); \
    GAPB(o[0] = MF(PAF(0), VFR(0), o[0]), C0, 0); \
    GAPB(o[1] = MF(PAF(0), VFR(4), o[1]), C0, 4); \
    KRD(GL, 0); GAPB(o[0] = MF(PAF(1), VFR(1), o[0]), C0, 8); \
    KRD(GL, 1); GAPB(o[1] = MF(PAF(1), VFR(5), o[1]), C0, 12); \
    KRD(GL, 2); GAPB(o[0] = MF(PAF(2), VFR(2), o[0]), C1, 0); \
    KRD(GL, 3); GAPB(o[1] = MF(PAF(2), VFR(6), o[1]), C1, 4); \
    GAPB(o[0] = MF(PAF(3), VFR(3), o[0]), C1, 8); \
    GAPB(o[1] = MF(PAF(3), VFR(7), o[1]), C1, 12); \
    } while (0)
    int t = 1;
    for (; t + 5 < NT; t += 2) {
        STEP(pB0, pB1, pA0, pA1, t, true, true, true);     WAIT_BAR(2); ROT();
        STEP(pA0, pA1, pB0, pB1, t + 1, true, true, true); WAIT_BAR(2); ROT();
    }
#define ENDW(tt) do { if ((tt) + 3 < NT) { WAIT_BAR(2); } else if ((tt) + 2 < NT) { WAIT_BAR(1); } else { WAIT_BAR(0); } } while (0)
    for (; t + 1 < NT; t += 2) {
        STEP(pB0, pB1, pA0, pA1, t, (t + 3 < NT), (t + 1 < NT), (t + 1 < NT));         ENDW(t);     ROT();
        STEP(pA0, pA1, pB0, pB1, t + 1, (t + 4 < NT), (t + 2 < NT), (t + 2 < NT));     ENDW(t + 1); ROT();
    }
    STEP(pB0, pB1, pA0, pA1, NT - 1, false, false, false);
    { float sacc = pB0[0] + pB0[1];
#pragma unroll
      for (int r = 2; r < 16; ++r) sacc += pB0[r];
#pragma unroll
      for (int r = 0; r < 16; ++r) sacc += pB1[r];
      l_reg += sacc;
      pw0 = (u32x4){PKW(pB0, 0), PKW(pB0, 2), PKW(pB0, 4), PKW(pB0, 6)}; pw1 = (u32x4){PKW(pB0, 8), PKW(pB0, 10), PKW(pB0, 12), PKW(pB0, 14)};
      pw2 = (u32x4){PKW(pB1, 0), PKW(pB1, 2), PKW(pB1, 4), PKW(pB1, 6)}; pw3 = (u32x4){PKW(pB1, 8), PKW(pB1, 10), PKW(pB1, 12), PKW(pB1, 14)};
      SBAR();
      const lds_cptr vp_ = vp0 + si_cur * VSLOT;
#pragma unroll
      for (int d0 = 0; d0 < 2; ++d0) {
          s16x4 lo4[4], hi4[4];
#pragma unroll
          for (int ks = 0; ks < 4; ++ks) { lo4[ks] = vtr(vp_ + d0 * 4096 + ks * 1024); hi4[ks] = vtr(vp_ + d0 * 4096 + ks * 1024 + 512); }
#define PK4(k) (bf16x8){lo4[k][0], lo4[k][1], lo4[k][2], lo4[k][3], hi4[k][0], hi4[k][1], hi4[k][2], hi4[k][3]}
          o[d0] = MF(PAF(0), PK4(0), o[d0]); o[d0] = MF(PAF(1), PK4(1), o[d0]); o[d0] = MF(PAF(2), PK4(2), o[d0]); o[d0] = MF(PAF(3), PK4(3), o[d0]);
#undef PK4
      } }
    l_reg = swapsum(l_reg);
    if (hi == 0) wsf[32 + r32] = l_reg;
    asm volatile("s_waitcnt lgkmcnt(0)" ::: "memory");
    float rli[16];
#pragma unroll
    for (int r = 0; r < 16; ++r) rli[r] = __builtin_amdgcn_rcpf(wsf[32 + crow(r, hi)]);
    bf16_t* Ow = O + (rowbase + q0 + wid * QBLK) * 512 + h * 64;
    { LAS bf16_t* stg = (LAS bf16_t*)(shm + LDS_OST) + wid * 2048;
#pragma unroll
      for (int r = 0; r < 16; ++r) { const int orow = crow(r, hi);
#pragma unroll
          for (int d0 = 0; d0 < 2; ++d0) stg[orow * 64 + d0 * 32 + r32] = (bf16_t)f2bf(o[d0][r] * rli[r]); }
      asm volatile("s_waitcnt lgkmcnt(0)" ::: "memory");
#pragma unroll
      for (int i = 0; i < 4; ++i) { const int row = i * 8 + (lane >> 3), ch = lane & 7; const u32x4 v = *(const LAS u32x4*)(stg + row * 64 + ch * 8); *(u32x4*)(Ow + (long)row * 512 + ch * 8) = v; } }
    asm volatile("s_waitcnt lgkmcnt(0)\n\ts_barrier" ::: "memory");
#undef DMA_K
#undef DMA_V
#undef ROT
#undef PKW
#undef PAF
#undef VFR
#undef PIN
#undef MF
#undef GAPA
#undef GAPA8
#undef GAPM
#undef GAPB
#undef EX
#undef VRD
#undef KRD
#undef STEP
#undef ENDW
}
#undef SBAR
#undef WAIT_BAR
#undef MF8
}

namespace bgc {
constexpr int N_GU = 32 * 16 * 128, N_D = 32 * 16 * 64, N_ITEMS = N_GU + N_D;
constexpr int SCR_STRIDE = 20, SCR_BUF = 64 * SCR_STRIDE * 4, SCR_WAVE = 2 * SCR_BUF, LDS_SCR = 73728, LDS_G2 = LDS_SCR + NWAVES * SCR_WAVE;
static_assert(LDS_G2 + 4096 <= MISC_OFF, "background conversion LDS");
constexpr int G2_ONES = 1024 + 256;
static_assert(LDS_G2 + 4096 == MISC_OFF, "ones block = MISC words 256..319");
struct Bg {
    const float* wgu; const float* wd; unsigned char* ws; LAS char* scr; LAS const float* g2;
    int gw, ngw, mitems, q;
    int lane, lw, lr, ls;
    unsigned gu_src, gu_dst, d_src, d_dst; int gu_k0, d_e0;
    __device__ __forceinline__ void init(const float* wgu_, const float* wd_, unsigned char* ws_, LAS unsigned char* lds, int wave, int lane_) {
        wgu = wgu_; wd = wd_; ws = ws_; scr = (LAS char*)lds + LDS_SCR + wave * SCR_WAVE; g2 = (LAS const float*)(lds + LDS_G2);
        gw = blockIdx.x * NWAVES + wave; ngw = gridDim.x * NWAVES; mitems = (N_ITEMS + ngw - 1) / ngw; q = 0;
        lane = lane_; lw = (lane_ >> 2) * (SCR_STRIDE * 4) + (lane_ & 3) * 16; lr = (lane_ >> 4) * (4 * SCR_STRIDE * 4) + (lane_ & 15) * 4; ls = (lane_ & 15) * 1024 + (lane_ >> 4) * 4;
        { const int r = gw & 2047, kb = r >> 7, n0 = (r & 127) * 16, pn = n0 >> 8, w = n0 & 255, sc = w < 128 ? 128 * pn + w : 1024 + 128 * pn + (w - 128);
          gu_src = (unsigned)((64 * kb) * 2048 + sc) * 4u; gu_dst = (unsigned)(n0 * 1024 + 64 * kb); gu_k0 = 64 * kb; }
        { const int r = gw & 1023, kb = r >> 6, n0 = (r & 63) * 16; d_src = (unsigned)((64 * kb) * 1024 + n0) * 4u; d_dst = (unsigned)(n0 * 1024 + 64 * kb); d_e0 = (gw >> 10) & 1; }
    }
    __device__ __forceinline__ bool fast() const { return ngw == 2048; }
    __device__ __forceinline__ int clampm(int m) const { m = m < mitems ? m : mitems - 1; return m < 0 ? 0 : m; }
    __device__ __forceinline__ void decode(int m, const char*& src, unsigned char*& dst, int& sh, int& k0) const {
        m = m < 47 ? m : 47; m = m < 0 ? 0 : m;
        const bool kd = m >= 32; const int ed = d_e0 + 2 * (m - 32);
        const char* sg = (const char*)wgu + ((size_t)m << 23) + gu_src; const char* sd = (const char*)wd + ((size_t)ed << 22) + d_src;
        unsigned char* dg = ws + WS_WGU + ((size_t)m << 21) + gu_dst; unsigned char* dd = ws + WS_WD + ((size_t)ed << 20) + d_dst;
        src = kd ? sd : sg; dst = kd ? dd : dg; sh = kd ? 12 : 13; k0 = kd ? G2_ONES : gu_k0;
    }
    __device__ __forceinline__ void decode_gen(int m, const char*& src, unsigned char*& dst, int& sh, int& k0) const {
        m = clampm(m);
        int it = gw + ngw * m; it = it < N_ITEMS ? it : N_ITEMS - 1;
        if (it < N_GU) { const int e = it >> 11, r = it & 2047, kb = r >> 7, n0 = (r & 127) * 16, pn = n0 >> 8, w = n0 & 255, sc = w < 128 ? 128 * pn + w : 1024 + 128 * pn + (w - 128);
            src = (const char*)(wgu + (size_t)e * (1024 * 2048) + (size_t)(64 * kb) * 2048 + sc); dst = ws + WS_WGU + (size_t)e * (2048 * 1024) + (size_t)n0 * 1024 + 64 * kb; sh = 13; k0 = 64 * kb; }
        else { const int i2 = it - N_GU, e = i2 >> 10, r = i2 & 1023, kb = r >> 6, n0 = (r & 63) * 16;
            src = (const char*)(wd + (size_t)e * (1024 * 1024) + (size_t)(64 * kb) * 1024 + n0); dst = ws + WS_WD + (size_t)e * (1024 * 1024) + (size_t)n0 * 1024 + 64 * kb; sh = 12; k0 = G2_ONES; }
    }
    __device__ __forceinline__ f32x4 load(int tk) const {
        const char* src; unsigned char* dst; int sh, k0; decode(tk >> 2, src, dst, sh, k0);
        const char* sb = src + ((size_t)(16 * (tk & 3)) << sh);
#ifdef BGP_HOT
        sb = (const char*)wgu;
#endif
        const unsigned voff = ((unsigned)(lane >> 2) << sh) + (unsigned)((lane & 3) * 16);
        f32x4 v; asm volatile("global_load_dwordx4 %0, %1, %2 nt" : "=v"(v) : "v"(voff), "s"(sb) : "memory");
        return v;
    }
    __device__ __forceinline__ float scale(int tk) const {
        const char* src; unsigned char* dst; int sh, k0; decode(tk >> 2, src, dst, sh, k0);
        return g2[k0 + 16 * (tk & 3) + (lane >> 2)];
    }
    __device__ __forceinline__ void write(int tk, f32x4 v, float s) const {
        const int m = tk >> 2;
        *(LAS f32x4*)(scr + (m & 1) * SCR_BUF + (tk & 3) * (16 * SCR_STRIDE * 4) + lw) = v * (64.f * s);
    }
    __device__ __forceinline__ f32x4 out_read(int tk) const {
        const int m1 = (tk >> 2) - 1;
        const LAS float* s = (const LAS float*)(scr + (m1 & 1) * SCR_BUF + (tk & 3) * (16 * SCR_STRIDE * 4) + lr);
        return (f32x4){s[0], s[SCR_STRIDE], s[2 * SCR_STRIDE], s[3 * SCR_STRIDE]};
    }
    __device__ __forceinline__ void out_store(int tk, f32x4 r) const {
        const char* src; unsigned char* dst; int sh, k0; decode((tk >> 2) - 1, src, dst, sh, k0);
        const unsigned char* db = dst + 16 * (tk & 3);
        const unsigned w = pack4_fp8(r.x, r.y, r.z, r.w);
        asm volatile("global_store_dword %0, %1, %2" :: "v"(ls), "v"(w), "s"(db) : "memory");
    }
    __device__ __forceinline__ void tick_sync(int tk, bool do_out) const {
        const char* src; unsigned char* dst; int sh, k0; decode_gen(tk >> 2, src, dst, sh, k0);
        const char* p = src + ((size_t)(16 * (tk & 3) + (lane >> 2)) << sh) + (lane & 3) * 16;
        f32x4 v = *(const f32x4*)p; const float s = g2[k0 + 16 * (tk & 3) + (lane >> 2)];
        write(tk, v, s);
        asm volatile("s_waitcnt lgkmcnt(0)" ::: "memory");
        if (do_out) { const char* src1; unsigned char* dst1; int sh1, k1; decode_gen((tk >> 2) - 1, src1, dst1, sh1, k1);
            const f32x4 r = out_read(tk); *(unsigned*)(dst1 + 16 * (tk & 3) + ls) = pack4_fp8(r.x, r.y, r.z, r.w); }
    }
    __device__ __forceinline__ int q_end() const { return 4 * mitems + 4; }
};
}

namespace mla88 {
using mla::glds16; using mla::lds_cptr;
typedef int v8i __attribute__((ext_vector_type(8)));
typedef short v2s __attribute__((ext_vector_type(2)));
#ifdef PROBE_NODMA
#define PROBE_NODMA_ 1
#else
#define PROBE_NODMA_ 0
#endif
#ifndef PSCALE
#define PSCALE 16.0f
#endif
constexpr float PSCALE_LMIN = 512.f;
constexpr int NW = 8, QBLK = 32, QB = 256, KVBLK = 64, NT = SEQ / KVBLK;
#ifdef QK_FP6
constexpr int KSLOT = 5120, KTILE = 5120, KPIECES = 5;
#else
constexpr int KSLOT = 6144, KTILE = 6144, KPIECES = 6;
#endif
constexpr int VSLOT = 4096; constexpr int NSLOT_ = 4, LDS_K = 0, LDS_V = NSLOT_ * KSLOT, LDS_OST = LDS_V + NSLOT_ * VSLOT, LDS_WL = LDS_OST + NW * 4096, LDS_DUMMY = LDS_WL + NW * 128, LDS_BYTES_ = LDS_DUMMY + NSLOT_ * KSLOT + 1024;
static_assert(LDS_BYTES_ <= RING_BYTES, "mla88 LDS");
#define SBAR() __builtin_amdgcn_sched_barrier(0)
#ifdef PROBE_X2BAR
#define WAIT_BAR(N) do { asm volatile("" ::: "memory"); __builtin_amdgcn_s_waitcnt(((N) & 15) | (7 << 4) | (0 << 8)); __builtin_amdgcn_s_barrier(); __builtin_amdgcn_s_barrier(); asm volatile("" ::: "memory"); } while (0)
#else
#define WAIT_BAR(N) do { asm volatile("" ::: "memory"); __builtin_amdgcn_s_waitcnt(((N) & 15) | (7 << 4) | (0 << 8)); __builtin_amdgcn_s_barrier(); asm volatile("" ::: "memory"); } while (0)
#endif
__device__ __forceinline__ void glds16c(const void* gsrc, unsigned lds_dst) {
    asm volatile("s_mov_b32 m0, %1\n\ts_nop 0\n\tglobal_load_lds_dwordx4 %0, off" :: "v"(gsrc), "s"(lds_dst) : "memory", "m0"); }
__device__ __forceinline__ v8i kfrag8(lds_cptr slot, int n, int ks, int r32, int hi) {
    const lds_cptr p = slot + (ks == 0 ? 2 * hi : 4) * 1024 + (32 * n + r32) * 16;
    const u32x4 a = *(const LAS u32x4*)p, b = *(const LAS u32x4*)(p + 1024);
    return (v8i){(int)a.x, (int)a.y, (int)a.z, (int)a.w, (int)b.x, (int)b.y, (int)b.z, (int)b.w};
}
#define MF8(a, b, c) __builtin_amdgcn_mfma_scale_f32_32x32x64_f8f6f4(a, b, c, 0, 0, 0, 0x7f7f7f7f, 0, 0x7b7b7b7b)
#define MF8V(a, b, c) __builtin_amdgcn_mfma_scale_f32_32x32x64_f8f6f4(a, b, c, 0, 0, 0, 0x7f7f7f7f, 0, 0x7f7f7f7f)
#ifdef QK_FP6
typedef __bf16 bf16x32_t __attribute__((ext_vector_type(32)));
typedef unsigned u32x6_t __attribute__((ext_vector_type(6)));
typedef int i32x16_t __attribute__((ext_vector_type(16)));
__device__ __forceinline__ u32x6_t fp8x32_fp6(const u32x4 a, const u32x4 b, float div, unsigned& nan) {
    const unsigned w[8] = {a.x, a.y, a.z, a.w, b.x, b.y, b.z, b.w};
    i32x16_t p;
#pragma unroll
    for (int i = 0; i < 8; ++i) {
        const unsigned f0 = __builtin_bit_cast(unsigned, __builtin_amdgcn_cvt_f32_fp8((int)w[i], 0)), f1 = __builtin_bit_cast(unsigned, __builtin_amdgcn_cvt_f32_fp8((int)w[i], 1));
        const unsigned f2 = __builtin_bit_cast(unsigned, __builtin_amdgcn_cvt_f32_fp8((int)w[i], 2)), f3 = __builtin_bit_cast(unsigned, __builtin_amdgcn_cvt_f32_fp8((int)w[i], 3));
        p[2 * i] = (int)((f0 >> 16) | (f1 & 0xffff0000u)); p[2 * i + 1] = (int)((f2 >> 16) | (f3 & 0xffff0000u));
        nan |= ((w[i] & 0x7f7f7f7fu) + 0x01010101u) & 0x80808080u;
    }
    return __builtin_amdgcn_cvt_scalef32_pk32_fp6_bf16(__builtin_bit_cast(bf16x32_t, p), div);
}
__device__ __forceinline__ v8i kfrag6(lds_cptr slot, int n, int ks, int r32, int hi) {
    const lds_cptr p = slot + (ks == 0 ? hi : 2) * 1536 + (32 * n + r32) * 24;
    const u32x2 a = *(const LAS u32x2*)p, b = *(const LAS u32x2*)(p + 8), c = *(const LAS u32x2*)(p + 16);
    return (v8i){(int)a.x, (int)a.y, (int)b.x, (int)b.y, (int)c.x, (int)c.y, 0, 0};
}
#define KFRAG kfrag6
#define MFQK(a, b, c) __builtin_amdgcn_mfma_scale_f32_32x32x64_f8f6f4(a, b, c, 2, 2, 0, 0x7f7f7f7f, 0, 0x7c7c7c7c)
#else
#define KFRAG kfrag8
#define MFQK(a, b, c) MF8(a, b, c)
#endif
__device__ __forceinline__ v8i vfrag8(lds_cptr slot, int dh, int r32, int hi) {
    const lds_cptr p = slot + dh * 2048 + (2 * hi) * 512 + r32 * 16;
    const u32x4 a = *(const LAS u32x4*)p, b = *(const LAS u32x4*)(p + 512);
    return (v8i){(int)a.x, (int)a.y, (int)a.z, (int)a.w, (int)b.x, (int)b.y, (int)b.z, (int)b.w};
}

__device__ __forceinline__ bool mla88_unit(int b, int h, int qb, const unsigned char* Q8, const unsigned char* __restrict__ K8im, const unsigned char* __restrict__ V8im, bf16_t* O, LAS char* shm, bgc::Bg& bg) {
    const int tid = threadIdx.x, lane = tid & 63, r32 = lane & 31, hi = lane >> 5; const int wid = __builtin_amdgcn_readfirstlane(tid >> 6);
    const long rowbase = (long)b * SEQ; const int q0 = qb * QB;
    const unsigned char* Qw = Q8 + (size_t)(rowbase + q0 + wid * QBLK + r32) * 768 + h * 96;
    const unsigned lds0 = (unsigned)(uintptr_t)shm;
    const int kpc = wid < KPIECES ? wid : wid - KPIECES;
#ifdef MLA_FLAT_DMA
    const unsigned char* ksrc = K8im + kpc * 1024 + lane * 16;
    const unsigned char* vsrc = V8im + (wid & 3) * 1024 + lane * 16;
#else
    const unsigned char* dbase = K8im < V8im ? K8im : V8im;
    const __amdgpu_buffer_rsrc_t srd = __builtin_amdgcn_make_buffer_rsrc((void*)dbase, (short)0, (int)0x7fffffff, 0x00020000);
    const unsigned kso = (unsigned)__builtin_amdgcn_readfirstlane((int)(K8im - dbase)), vso = (unsigned)__builtin_amdgcn_readfirstlane((int)(V8im - dbase));
#ifdef DMA_NODUP
    const unsigned kvo = wid < KPIECES ? (unsigned)(kpc * 1024 + lane * 16) : 0x80000000u, vvo = wid < 4 ? (unsigned)((wid & 3) * 1024 + lane * 16) : 0x80000000u;
#else
    const unsigned kvo = (unsigned)(kpc * 1024 + lane * 16), vvo = (unsigned)((wid & 3) * 1024 + lane * 16);
#endif
#endif
#ifdef DMA_NODUP
    const unsigned kdst = wid < KPIECES ? lds0 + LDS_K + kpc * 1024 : lds0 + LDS_DUMMY, vdst = wid < 4 ? lds0 + LDS_V + (wid & 3) * 1024 : lds0 + LDS_DUMMY;
#else
    const unsigned kdst = lds0 + LDS_K + kpc * 1024, vdst = lds0 + LDS_V + (wid & 3) * 1024;
#endif
#ifdef MLA_FLAT_DMA
#define DMA_K(t, sl) glds16c(ksrc + (long)(t) * KTILE, (unsigned)__builtin_amdgcn_readfirstlane(kdst + (sl) * KSLOT))
#define DMA_V(t, sl) glds16c(vsrc + (long)(t) * 4096, (unsigned)__builtin_amdgcn_readfirstlane(vdst + (sl) * VSLOT))
#else
#define DMA_B(m0v, vo, so) asm volatile("s_mov_b32 m0, %0\n\ts_nop 0\n\tbuffer_load_dwordx4 %1, %2, %3 offen lds" :: "s"(m0v), "v"(vo), "s"(srd), "s"(so) : "m0", "memory")
#define DMA_K(t, sl) DMA_B((unsigned)__builtin_amdgcn_readfirstlane(kdst + (sl) * KSLOT), kvo, (unsigned)__builtin_amdgcn_readfirstlane((int)(kso + (unsigned)(t) * (unsigned)KTILE)))
#define DMA_V(t, sl) DMA_B((unsigned)__builtin_amdgcn_readfirstlane(vdst + (sl) * VSLOT), vvo, (unsigned)__builtin_amdgcn_readfirstlane((int)(vso + (unsigned)(t) * 4096u)))
#endif
    const lds_cptr shm3 = (lds_cptr)shm; const lds_cptr ks0 = shm3 + LDS_K; const lds_cptr vs0 = shm3 + LDS_V;
    v8i kf[4];
    DMA_K(0, 0); DMA_V(0, 0); DMA_K(1, 1); DMA_V(1, 1); DMA_K(2, 2); DMA_K(3, 3);
    v8i qr[2];
#ifdef QK_FP6
    unsigned qnan = 0u;
    { const u32x6_t a6 = fp8x32_fp6(*(const u32x4*)(Qw + 32 * hi), *(const u32x4*)(Qw + 32 * hi + 16), 2.f, qnan); qr[0] = (v8i){(int)a6[0], (int)a6[1], (int)a6[2], (int)a6[3], (int)a6[4], (int)a6[5], 0, 0};
      u32x6_t d6 = fp8x32_fp6(*(const u32x4*)(Qw + 64), *(const u32x4*)(Qw + 80), 2.f, qnan); if (hi) d6 = (u32x6_t){0u, 0u, 0u, 0u, 0u, 0u};
      qr[1] = (v8i){(int)d6[0], (int)d6[1], (int)d6[2], (int)d6[3], (int)d6[4], (int)d6[5], 0, 0}; }
#else
    { const u32x4 a = *(const u32x4*)(Qw + 32 * hi), c = *(const u32x4*)(Qw + 32 * hi + 16); qr[0] = (v8i){(int)a.x, (int)a.y, (int)a.z, (int)a.w, (int)c.x, (int)c.y, (int)c.z, (int)c.w};
      u32x4 d = *(const u32x4*)(Qw + 64), e = *(const u32x4*)(Qw + 80); if (hi) { d = (u32x4){0u, 0u, 0u, 0u}; e = d; }
      qr[1] = (v8i){(int)d.x, (int)d.y, (int)d.z, (int)d.w, (int)e.x, (int)e.y, (int)e.z, (int)e.w}; }
#endif
    f32x16 o[2]; o[0] = f32x16{}; o[1] = f32x16{};
    f32x16 pA0, pA1, pB0, pB1;
    WAIT_BAR(0);
    { pA0 = MFQK(KFRAG(ks0, 0, 0, r32, hi), qr[0], f32x16{}); pA1 = MFQK(KFRAG(ks0, 1, 0, r32, hi), qr[0], f32x16{});
      pA0 = MFQK(KFRAG(ks0, 0, 1, r32, hi), qr[1], pA0); pA1 = MFQK(KFRAG(ks0, 1, 1, r32, hi), qr[1], pA1); }
#pragma unroll
    for (int r = 0; r < 16; ++r) { pA0[r] = __builtin_amdgcn_exp2f(pA0[r]); if (r < 8) pA1[r] = __builtin_amdgcn_exp2f(pA1[r]); }
    kf[0] = KFRAG(ks0 + KSLOT, 0, 0, r32, hi); kf[1] = KFRAG(ks0 + KSLOT, 0, 1, r32, hi); kf[2] = KFRAG(ks0 + KSLOT, 1, 0, r32, hi); kf[3] = KFRAG(ks0 + KSLOT, 1, 1, r32, hi);
    WAIT_BAR(0);
    DMA_K(4, 0); DMA_V(2, 2);
    v8i vf[2], p8 = {0, 0, 0, 0, 0, 0, 0, 0};
    v8i ones8; { const int on = (((lane >> 4) & 1) == (lane & 15)) ? 0x38383838 : 0; ones8 = (v8i){on, on, on, on, on, on, on, on}; }
    asm volatile("" : "+v"(ones8));
    f32x4 lacc = {0.f, 0.f, 0.f, 0.f};
#define MF16S(a, b, c) __builtin_amdgcn_mfma_scale_f32_16x16x128_f8f6f4(a, b, c, 0, 0, 0, 0x7f7f7f7f, 0, 0x7f7f7f7f)
#ifdef PROBE_X2MFMA
#define X2MF
#else
#define X2MF
#endif
    float psc = PSCALE; asm volatile("" : "+v"(psc));
#define PIN(x) asm volatile("" : "+v"(x))
#ifdef PROBE_NOEXP
#define EX(v) (v)
#else
#define EX(v) __builtin_amdgcn_exp2f(v)
#endif
#ifdef PROBE_NOCVT
#define PK4O(O, P, B) do { } while (0)
#else
#define PK4O(O, P, B) do { int t_; asm volatile("v_cvt_scalef32_pk_fp8_f32 %0, %1, %2, %3" : "=v"(t_) : "v"(P[B]), "v"(P[B + 1]), "v"(psc)); \
    asm volatile("v_cvt_scalef32_pk_fp8_f32 %0, %1, %2, %3 op_sel:[0,0,0,1]" : "+v"(t_) : "v"(P[B + 2]), "v"(P[B + 3]), "v"(psc)); O = t_; } while (0)
#endif
#define KRD(G, j, SN) do { if (G) { kf[j] = KFRAG(ks0 + (SN) * KSLOT, (j) >> 1, (j) & 1, r32, hi); SBAR(); } } while (0)
#define GAPS(MFX, P, W, PE, N0, N1) do { MFX; SBAR(); _Pragma("unroll") for (int r_ = N0; r_ < N1; ++r_) PE[r_] = EX(PE[r_]); PIN(PE); \
    PK4O(p8[W], P, 0); PK4O(p8[W + 1], P, 4); PK4O(p8[W + 2], P, 8); PK4O(p8[W + 3], P, 12); PIN(p8); SBAR(); } while (0)
#ifdef PROBE_X2ADD
#define GAPE(MFX, X, N0, N1) do { MFX; SBAR(); _Pragma("unroll") for (int r_ = N0; r_ < N1; ++r_) { X[r_] = EX(X[r_]); float d_; asm volatile("v_add_f32 %0, %1, %1\n\tv_add_f32 %0, %1, %1" : "=v"(d_) : "v"(X[r_ ^ 8])); } PIN(X); SBAR(); } while (0)
#elif defined(PROBE_X2EXP)
#define GAPE(MFX, X, N0, N1) do { MFX; SBAR(); _Pragma("unroll") for (int r_ = N0; r_ < N1; ++r_) { X[r_] = EX(X[r_]); float d_; asm volatile("v_exp_f32 %0, %1" : "=v"(d_) : "v"(X[r_ ^ 8])); } PIN(X); SBAR(); } while (0)
#else
#define GAPE(MFX, X, N0, N1) do { MFX; SBAR(); _Pragma("unroll") for (int r_ = N0; r_ < N1; ++r_) X[r_] = EX(X[r_]); PIN(X); SBAR(); } while (0)
#endif
#define EXPS(X, N0, N1) do { _Pragma("unroll") for (int r_ = N0; r_ < N1; ++r_) X[r_] = EX(X[r_]); PIN(X); } while (0)
#define STEP(C0, C1, P0, P1, t, S, GK, GV, GL, H0, H1, H2) do { SBAR(); \
    H0; SBAR(); \
    C0 = MFQK(kf[0], qr[0], f32x16{}); PIN(C0); SBAR(); vf[0] = vfrag8(vs0 + (((S) + 3) & 3) * VSLOT, 0, r32, hi); EXPS(P1, 8, 12);  PK4O(p8[0], P0, 0); PK4O(p8[1], P0, 4);  PIN(p8); SBAR(); \
    C0 = MFQK(kf[1], qr[1], C0); PIN(C0);       SBAR(); vf[1] = vfrag8(vs0 + (((S) + 3) & 3) * VSLOT, 1, r32, hi); EXPS(P1, 12, 16); PK4O(p8[2], P0, 8); PK4O(p8[3], P0, 12); PIN(p8); SBAR(); \
    C1 = MFQK(kf[2], qr[0], f32x16{}); PIN(C1); SBAR(); \
    H1; if (GK && !PROBE_NODMA_) { DMA_K((t) + 4, (S)); } if (GV && !PROBE_NODMA_) { DMA_V((t) + 2, ((S) + 2) & 3); } H2; SBAR(); \
    EXPS(C0, 0, 4);   PK4O(p8[4], P1, 0); PK4O(p8[5], P1, 4);  PIN(p8); SBAR(); \
    C1 = MFQK(kf[3], qr[1], C1); PIN(C1);       SBAR(); EXPS(C0, 4, 8);  PK4O(p8[6], P1, 8); PK4O(p8[7], P1, 12); PIN(p8); SBAR(); \
    o[0] = MF8V(p8, vf[0], o[0]); PIN(o[0]); SBAR(); KRD(GL, 0, ((S) + 1) & 3); KRD(GL, 1, ((S) + 1) & 3); EXPS(C0, 8, 14); SBAR(); \
    o[1] = MF8V(p8, vf[1], o[1]); PIN(o[1]); SBAR(); KRD(GL, 2, ((S) + 1) & 3); KRD(GL, 3, ((S) + 1) & 3); EXPS(C0, 14, 16); EXPS(C1, 0, 4); SBAR(); \
    lacc = MF16S(p8, ones8, lacc); PIN(lacc); SBAR(); EXPS(C1, 4, 8); SBAR(); \
    } while (0)
    f32x4 bgv = {0.f, 0.f, 0.f, 0.f}, bgr = {0.f, 0.f, 0.f, 0.f}; float bgs = 0.f;
#ifdef BG_CONV
#ifndef BGP_NLD
#define BGP_NLD 1
#endif
#ifndef BGP_NST
#define BGP_NST 1
#endif
#ifndef BGP_LDS
#define BGP_LDS 1
#endif
#define BG_STR_(x) #x
#define BG_STR(x) BG_STR_(x)
#define WAIT_BARX(N) asm volatile("s_waitcnt vmcnt(" BG_STR(N) ") lgkmcnt(0)\n\ts_barrier" ::: "memory")
#if BGP_NLD
#define BG_LOAD  bgv = bg.load(bg.q)
#else
#define BG_LOAD
#endif
#if BGP_LDS
#define BG_SC    bgs = bg.scale(bg.q)
#define BG_RD    bgr = bg.out_read(bg.q)
#else
#define BG_SC
#define BG_RD
#endif
#if BGP_NST
#define BG_OUT   bg.out_store(bg.q, bgr)
#define BG_WCNT 5
#else
#define BG_OUT   do { unsigned w_ = pack4_fp8(bgr.x, bgr.y, bgr.z, bgr.w); asm volatile("" :: "v"(w_)); } while (0)
#define BG_WCNT 4
#endif
#if BGP_LDS
#define BG_WRITE do { asm volatile("" : "+v"(bgv)); bg.write(bg.q, bgv, bgs); } while (0)
#else
#define BG_WRITE do { asm volatile("" : "+v"(bgv)); } while (0)
#endif
#define BG_NEXT  bg.q += 1
#if BGP_NLD && BGP_NST
#define WB1 WAIT_BAR(5)
#define WB2 WAIT_BAR(6)
#define WB3 WAIT_BAR(5)
#elif BGP_NLD
#define WB1 WAIT_BAR(5)
#define WB2 WAIT_BAR(5)
#define WB3 WAIT_BAR(4)
#elif BGP_NST
#define WB1 WAIT_BAR(4)
#define WB2 WAIT_BAR(5)
#define WB3 WAIT_BAR(5)
#else
#define WB1 WAIT_BAR(4)
#define WB2 WAIT_BAR(4)
#define WB3 WAIT_BAR(4)
#endif
#else
#define BG_LOAD
#define BG_SC
#define BG_RD
#define BG_OUT
#define BG_WRITE
#define BG_NEXT
#define WB1 WAIT_BAR(4)
#define WB2 WAIT_BAR(4)
#define WB3 WAIT_BAR(4)
#endif
#define NOH do { } while (0)
#ifdef MLA_PRIO
    if (wid >= 4) __builtin_amdgcn_s_setprio(1);
#endif
    int t = 1;
    for (; t < NT - 7; t += 4) {
        STEP(pB0, pB1, pA0, pA1, t, 1, true, true, true, BG_LOAD; BG_SC, NOH, NOH);     WB1;
        STEP(pA0, pA1, pB0, pB1, t + 1, 2, true, true, true, BG_RD, NOH, BG_OUT);       WB2;
        STEP(pB0, pB1, pA0, pA1, t + 2, 3, true, true, true, NOH, NOH, NOH);            WB3;
        STEP(pA0, pA1, pB0, pB1, t + 3, 0, true, true, true, BG_WRITE, NOH, NOH);       WAIT_BAR(4); BG_NEXT;
    }
    static_assert(((NT - 7) & 3) == 1, "tail starts in slot 1");
    STEP(pB0, pB1, pA0, pA1, NT - 7, 1, true, true, true, NOH, NOH, NOH);    WAIT_BAR(4);
    STEP(pA0, pA1, pB0, pB1, NT - 6, 2, true, true, true, NOH, NOH, NOH);    WAIT_BAR(4);
    STEP(pB0, pB1, pA0, pA1, NT - 5, 3, true, true, true, NOH, NOH, NOH);    WAIT_BAR(4);
    STEP(pA0, pA1, pB0, pB1, NT - 4, 0, false, true, true, NOH, NOH, NOH);   WAIT_BAR(3);
    STEP(pB0, pB1, pA0, pA1, NT - 3, 1, false, true, true, NOH, NOH, NOH);   WAIT_BAR(2);
    STEP(pA0, pA1, pB0, pB1, NT - 2, 2, false, false, true, NOH, NOH, NOH);  WAIT_BAR(0);
    STEP(pB0, pB1, pA0, pA1, NT - 1, 3, false, false, false, NOH, NOH, NOH);
#ifdef MLA_PRIO
    __builtin_amdgcn_s_setprio(0);
#endif
    {
#pragma unroll
      for (int r = 8; r < 16; ++r) pB1[r] = __builtin_amdgcn_exp2f(pB1[r]);
      PK4O(p8[0], pB0, 0); PK4O(p8[1], pB0, 4); PK4O(p8[2], pB0, 8); PK4O(p8[3], pB0, 12); PK4O(p8[4], pB1, 0); PK4O(p8[5], pB1, 4); PK4O(p8[6], pB1, 8); PK4O(p8[7], pB1, 12);
      SBAR();
      o[0] = MF8V(p8, vfrag8(vs0 + 3 * VSLOT, 0, r32, hi), o[0]); o[1] = MF8V(p8, vfrag8(vs0 + 3 * VSLOT, 1, r32, hi), o[1]); lacc = MF16S(p8, ones8, lacc); }
    float rli[16]; bool bad = false;
#ifdef QK_FP6
    bad = qnan != 0u;
#endif
    { LAS float* wl2 = (LAS float*)(shm + LDS_WL) + wid * 32;
      if ((lane & 15) < 2) {
#pragma unroll
          for (int i = 0; i < 4; ++i) wl2[4 * (lane >> 4) + i + 16 * (lane & 15)] = lacc[i]; }
      asm volatile("s_waitcnt lgkmcnt(0)" ::: "memory");
#pragma unroll
      for (int r = 0; r < 16; ++r) { const float l = wl2[crow(r, hi)]; rli[r] = __builtin_amdgcn_rcpf(l); bad = bad || !(l >= PSCALE_LMIN); }
    }
    bf16_t* Ow = O + (rowbase + q0 + wid * QBLK) * 512 + h * 64;
    { LAS bf16_t* stg = (LAS bf16_t*)(shm + LDS_OST) + wid * 2048;
#pragma unroll
      for (int r = 0; r < 16; ++r) { const int orow = crow(r, hi);
#pragma unroll
          for (int d0 = 0; d0 < 2; ++d0) stg[orow * 64 + d0 * 32 + r32] = (bf16_t)f2bf(o[d0][r] * rli[r]); }
      asm volatile("s_waitcnt lgkmcnt(0)" ::: "memory");
#pragma unroll
#ifdef OAB_FP8
      for (int i = 0; i < 4; ++i) { const int row = i * 8 + (lane >> 3), ch = lane & 7; const u32x4 v = *(const LAS u32x4*)(stg + row * 64 + ch * 8); float f8_[8]; unpack8(v, f8_);
          *(u32x2*)((unsigned char*)O + ((rowbase + q0 + wid * QBLK + row) * 512 + h * 64 + ch * 8)) = (u32x2){pack4_fp8(32.f * f8_[0], 32.f * f8_[1], 32.f * f8_[2], 32.f * f8_[3]), pack4_fp8(32.f * f8_[4], 32.f * f8_[5], 32.f * f8_[6], 32.f * f8_[7])}; } }
#else
      for (int i = 0; i < 4; ++i) { const int row = i * 8 + (lane >> 3), ch = lane & 7; const u32x4 v = *(const LAS u32x4*)(stg + row * 64 + ch * 8); *(u32x4*)(Ow + (long)row * 512 + ch * 8) = v; } }
#endif
    asm volatile("s_waitcnt lgkmcnt(0)\n\ts_barrier" ::: "memory");
#undef DMA_K
#undef DMA_V
#ifndef MLA_FLAT_DMA
#undef DMA_B
#endif
#undef PIN
#undef PK4O
#undef GAPS
#undef GAPE
#undef EX
#undef KRD
#undef STEP
#undef EXPS
#undef BG_LOAD
#undef BG_SC
#undef BG_RD
#undef BG_OUT
#undef BG_WRITE
#undef BG_NEXT
#undef WB1
#undef WB2
#undef WB3
#undef NOH
    return __any(bad) != 0;
}
#undef SBAR
#undef WAIT_BAR
#undef MF8
#undef MF8V
#undef MF16S
}

template <bool F8, class CM> __device__ __forceinline__ void tr_item(const float* W, int ld, const float* rs, bf16_t* WT, int K, int k0, int n0, const CM& cm, LAS float* scr, int lane) {
    const int n = lane & 31, sc = cm.col(n0 + n); const float cs = cm.scale(n0 + n);
#pragma unroll 8
    for (int i = 0; i < 32; ++i) { const int kk = 2 * i + (lane >> 5); float v = 0.f; if (sc >= 0) v = W[(size_t)(k0 + kk) * ld + sc] * cs * (rs ? rs[k0 + kk] : 1.f); scr[kk * 33 + n] = v; }
    asm volatile("s_waitcnt lgkmcnt(0)" ::: "memory");
    const int c = lane & 7;
#pragma unroll
    for (int j = 0; j < 4; ++j) { const int nn = (lane >> 3) + 8 * j; const LAS float* s = scr + (8 * c) * 33 + nn;
        if constexpr (F8) { *(u32x2*)((unsigned char*)WT + (size_t)(n0 + nn) * K + k0 + 8 * c) = (u32x2){pack4_fp8(s[0 * 33], s[1 * 33], s[2 * 33], s[3 * 33]), pack4_fp8(s[4 * 33], s[5 * 33], s[6 * 33], s[7 * 33])}; }
        else { u32x4 o; o.x = pk2(s[0 * 33], s[1 * 33]); o.y = pk2(s[2 * 33], s[3 * 33]); o.z = pk2(s[4 * 33], s[5 * 33]); o.w = pk2(s[6 * 33], s[7 * 33]);
        *(u32x4*)(WT + (size_t)(n0 + nn) * K + k0 + 8 * c) = o; } }
    asm volatile("s_waitcnt lgkmcnt(0)" ::: "memory");
}
#ifdef XW_NT
#define XW_LD(p) __builtin_nontemporal_load(p)
#else
#define XW_LD(p) (*(p))
#endif
template <class CM> __device__ __forceinline__ void tr4_load(f32x4 (&v)[8], const float* W, int ld, int k0, int n0, const CM& cm, int lane) {
    const int n4 = (lane & 7) * 4, sc = cm.col(n0 + n4);
#pragma unroll
    for (int i = 0; i < 8; ++i) { const int kk = (lane >> 3) + 8 * i; v[i] = (sc >= 0) ? XW_LD((const f32x4*)(W + (size_t)(k0 + kk) * ld + sc)) : (f32x4){0.f, 0.f, 0.f, 0.f}; }
}
template <bool F8, class CM, class RSP = const float*> __device__ __forceinline__ void tr4_finish(const f32x4 (&v)[8], RSP rs, bf16_t* WT, int K, int k0, int n0, const CM& cm, LAS float* scr, int lane) {
    const int n4 = (lane & 7) * 4; const float cs = cm.scale(n0 + n4);
#pragma unroll
    for (int i = 0; i < 8; ++i) { const int kk = (lane >> 3) + 8 * i; const float r = cs * (rs ? rs[k0 + kk] : 1.f); LAS float* d = scr + kk * 33 + n4; d[0] = v[i].x * r; d[1] = v[i].y * r; d[2] = v[i].z * r; d[3] = v[i].w * r; }
    asm volatile("s_waitcnt lgkmcnt(0)" ::: "memory");
    const int c = lane & 7;
#pragma unroll
    for (int j = 0; j < 4; ++j) { const int nn = (lane >> 3) + 8 * j; const LAS float* s = scr + (8 * c) * 33 + nn;
        if constexpr (F8) { *(u32x2*)((unsigned char*)WT + (size_t)(n0 + nn) * K + k0 + 8 * c) = (u32x2){pack4_fp8(s[0 * 33], s[1 * 33], s[2 * 33], s[3 * 33]), pack4_fp8(s[4 * 33], s[5 * 33], s[6 * 33], s[7 * 33])}; }
        else { u32x4 o; o.x = pk2(s[0 * 33], s[1 * 33]); o.y = pk2(s[2 * 33], s[3 * 33]); o.z = pk2(s[4 * 33], s[5 * 33]); o.w = pk2(s[6 * 33], s[7 * 33]);
        *(u32x4*)(WT + (size_t)(n0 + nn) * K + k0 + 8 * c) = o; } }
    asm volatile("s_waitcnt lgkmcnt(0)" ::: "memory");
}
template <bool F8, class CM> __device__ __forceinline__ void tr_item4(const float* W, int ld, const float* rs, bf16_t* WT, int K, int k0, int n0, const CM& cm, LAS float* scr, int lane) {
    f32x4 v[8]; tr4_load(v, W, ld, k0, n0, cm, lane); tr4_finish<F8>(v, rs, WT, K, k0, n0, cm, scr, lane);
}
struct CmIn {
    __device__ __forceinline__ int col(int n) const {
        if (n < 1920) return n;
        if (n < 1952) { const int j = n - 1920, i = j >> 1; return 1920 + ((j & 1) ? i + 16 : i); }
        if (n < 2048) return -1;
        { const int j = (n - 2048) >> 8, w = n & 255; return w < 128 ? 1952 + 128 * j + w : 2976 + 128 * j + (w - 128); }
    }
    __device__ __forceinline__ float scale(int n) const { return n < 512 ? 0.125f * LOG2E : 1.f; }
    __device__ __forceinline__ bool regular(int n0) const { return n0 < 1920 || n0 >= 1952; }
};
#ifdef INPROJ_FP8
struct CmIn8 : CmIn { __device__ __forceinline__ float scale(int n) const { return 64.f * CmIn::scale(n); } };
#endif
struct CmUq {
    __device__ __forceinline__ int col(int n) const { const int h = n / 96, w = n % 96; if (w < 64) return n; const int j = w - 64, i = j >> 1; return h * 96 + 64 + ((j & 1) ? i + 16 : i); }
    __device__ __forceinline__ float scale(int) const { return 0.10206207261596577f * LOG2E; }
    __device__ __forceinline__ bool regular(int n0) const { return (n0 % 96) < 64; }
};
struct CmId64 { __device__ __forceinline__ int col(int n) const { return n; } __device__ __forceinline__ float scale(int) const { return 64.f / (-1.702f * LOG2E); } __device__ __forceinline__ bool regular(int) const { return true; } };
struct CmId { int off; __device__ __forceinline__ int col(int n) const { return n - off; } __device__ __forceinline__ float scale(int) const { return 1.f; } __device__ __forceinline__ bool regular(int) const { return true; } };
struct CmId8 { __device__ __forceinline__ int col(int n) const { return n; } __device__ __forceinline__ float scale(int) const { return 64.f; } __device__ __forceinline__ bool regular(int) const { return true; } };
struct CmGu {
    __device__ __forceinline__ int col(int n) const { const int pn = n >> 8, w = n & 255; return w < 128 ? 128 * pn + w : 1024 + 128 * pn + (w - 128); }
    __device__ __forceinline__ float scale(int) const { return 64.f; }
    __device__ __forceinline__ bool regular(int) const { return true; }
};
template <class CM, bool F8 = false> __device__ __forceinline__ void tr_any(const float* W, int ld, const float* rs, bf16_t* WT, int K, int k0, int n0, const CM& cm, LAS float* scr, int lane) {
    if (cm.regular(n0)) tr_item4<F8>(W, ld, rs, WT, K, k0, n0, cm, scr, lane); else tr_item<F8>(W, ld, rs, WT, K, k0, n0, cm, scr, lane);
}

struct Args { const float* in[19]; float* out; unsigned char* ws; int ph_lo, ph_hi, li, pad; };

#ifdef XW_ITEM64
template <class CM> __device__ __forceinline__ void tr8_load(f32x4 (&v)[16], const float* W, int ld, int k0, int n0, const CM& cm, int lane) {
    const int n4 = (lane & 15) * 4, sc = cm.col(n0 + n4);
#pragma unroll
    for (int i = 0; i < 16; ++i) { const int kk = (lane >> 4) + 4 * i; v[i] = *(const f32x4*)(W + (size_t)(k0 + kk) * ld + sc); }
}
template <class CM, class RSP> __device__ __forceinline__ void tr8_write(const f32x4 (&v)[16], RSP rs, int k0, int n0, const CM& cm, LAS float* scr, int lane) {
    const int n4 = (lane & 15) * 4; const float cs = cm.scale(n0 + n4);
#pragma unroll
    for (int i = 0; i < 16; ++i) { const int kk = (lane >> 4) + 4 * i; const float r = cs * (rs ? rs[k0 + kk] : 1.f); LAS float* d = scr + kk * 65 + n4; d[0] = v[i].x * r; d[1] = v[i].y * r; d[2] = v[i].z * r; d[3] = v[i].w * r; }
    asm volatile("s_waitcnt lgkmcnt(0)" ::: "memory");
}
__device__ __forceinline__ void tr8_store(unsigned char* WT, int K, int k0, int n0, LAS float* scr, int lane) {
    const int c = lane & 7;
#pragma unroll
    for (int j = 0; j < 8; ++j) { const int nn = (lane >> 3) + 8 * j; const LAS float* s = scr + (8 * c) * 65 + nn;
        *(u32x2*)(WT + (size_t)(n0 + nn) * K + k0 + 8 * c) = (u32x2){pack4_fp8(s[0 * 65], s[1 * 65], s[2 * 65], s[3 * 65]), pack4_fp8(s[4 * 65], s[5 * 65], s[6 * 65], s[7 * 65])};
        if (j & 1) asm volatile("" ::: "memory"); }
    asm volatile("s_waitcnt lgkmcnt(0)" ::: "memory");
}
constexpr int XW_IGU = 32 * 16 * 32, XW_NI = XW_IGU + 32 * 16 * 16;
__device__ __forceinline__ void xw_load(f32x4 (&v)[16], const Args& a, int r, int lane) {
    if (r < XW_IGU) tr8_load(v, a.in[14] + (size_t)(r / 512) * 1024 * 2048, 2048, 64 * ((r % 512) / 32), 64 * (r % 32), CmGu{}, lane);
    else { const int q = r - XW_IGU; tr8_load(v, a.in[16] + (size_t)(q / 256) * 1024 * 1024, 1024, 64 * ((q % 256) / 16), 64 * (q % 16), CmId64{}, lane); }
}
__device__ __forceinline__ void xw_write(const f32x4 (&v)[16], const Args& a, int r, LAS float* scr, const LAS float* g2l, int lane) {
    if (r < XW_IGU) tr8_write(v, g2l, 64 * ((r % 512) / 32), 64 * (r % 32), CmGu{}, scr, lane);
    else { const int q = r - XW_IGU; tr8_write(v, (const LAS float*)nullptr, 64 * ((q % 256) / 16), 64 * (q % 16), CmId64{}, scr, lane); }
}
__device__ __forceinline__ void xw_store(const Args& a, int r, LAS float* scr, int lane) {
    unsigned char* ws = a.ws;
    if (r < XW_IGU) tr8_store(ws + WS_WGU + (size_t)(r / 512) * 2048 * 1024, 1024, 64 * ((r % 512) / 32), 64 * (r % 32), scr, lane);
    else { const int q = r - XW_IGU; tr8_store(ws + WS_WD + (size_t)(q / 256) * 1024 * 1024, 1024, 64 * ((q % 256) / 16), 64 * (q % 16), scr, lane); }
}
__device__ __forceinline__ void p0_experts(const Args& a, LAS unsigned char* lds, int wave, int lane, int gw, int NGW, int r0, int NI) {
    LAS float* scr = (LAS float*)(lds + wave * 16640); LAS float* g2l = (LAS float*)(lds + 8 * 16640);
    { int tx = threadIdx.x; asm volatile("" : "+v"(tx)); for (int i = tx; i < 1024; i += NTHREADS) g2l[i] = a.in[11][i]; }
    __syncthreads();
    f32x4 va[16];
    int r = r0 + gw;
    if (r < NI) xw_load(va, a, r, lane);
    for (; r < NI; r += NGW) {
        xw_write(va, a, r, scr, g2l, lane);
        if (r + NGW < NI) xw_load(va, a, r + NGW, lane);
        xw_store(a, r, scr, lane);
    }
}
#else
__device__ __forceinline__ int xw_map(int v, int NGW) {
    constexpr int I_GU = 32 * 16 * 64, NI = I_GU + 32 * 16 * 32;
#ifdef XW_PAIR_K
    if (NI % (2 * NGW) != 0 || I_GU % (2 * NGW) != 0) return v;
    const int q = v / NGW, g = v - q * NGW, pi = g + NGW * (q >> 1), lsb = q & 1;
    if (pi < I_GU / 2) { const int e = pi / 512, t = pi % 512; return e * 1024 + (2 * (t / 64) + lsb) * 64 + (t % 64); }
    const int p2 = pi - I_GU / 2, e = p2 / 256, t = p2 % 256; return I_GU + e * 512 + (2 * (t / 32) + lsb) * 32 + (t % 32);
#else
    return v;
#endif
}
__device__ __forceinline__ void xw_load(f32x4 (&v)[8], const Args& a, int r, int lane) {
    constexpr int I_GU = 32 * 16 * 64;
    if (r < I_GU) tr4_load(v, a.in[14] + (size_t)(r / 1024) * 1024 * 2048, 2048, 64 * ((r % 1024) / 64), 32 * (r % 64), CmGu{}, lane);
    else { const int q = r - I_GU; tr4_load(v, a.in[16] + (size_t)(q / 512) * 1024 * 1024, 1024, 64 * ((q % 512) / 32), 32 * (q % 32), CmId64{}, lane); }
}
__device__ __forceinline__ void xw_fin(const f32x4 (&v)[8], const Args& a, int r, LAS float* scr, const LAS float* g2l, int lane) {
    constexpr int I_GU = 32 * 16 * 64; unsigned char* ws = a.ws;
    if (r < I_GU) tr4_finish<true>(v, g2l, (bf16_t*)(ws + WS_WGU + (size_t)(r / 1024) * 2048 * 1024), 1024, 64 * ((r % 1024) / 64), 32 * (r % 64), CmGu{}, scr, lane);
    else { const int q = r - I_GU; tr4_finish<true>(v, (const LAS float*)nullptr, (bf16_t*)(ws + WS_WD + (size_t)(q / 512) * 1024 * 1024), 1024, 64 * ((q % 512) / 32), 32 * (q % 32), CmId64{}, scr, lane); }
}
__device__ __forceinline__ void p0_experts(const Args& a, LAS unsigned char* lds, int wave, int lane, int gw, int NGW, int r0, int NI) {
    LAS float* scr = (LAS float*)(lds + wave * 16384); LAS float* g2l = (LAS float*)(lds + 131072);
    { int tx = threadIdx.x; asm volatile("" : "+v"(tx)); for (int i = tx; i < 1024; i += NTHREADS) g2l[i] = a.in[11][i]; }
    __syncthreads();
    f32x4 va[8], vb[8], vc[8], vd[8];
    int r = r0 + gw;
    if (r < NI) xw_load(va, a, xw_map(r, NGW), lane);
    if (r + NGW < NI) xw_load(vb, a, xw_map(r + NGW, NGW), lane);
    if (r + 2 * NGW < NI) xw_load(vc, a, xw_map(r + 2 * NGW, NGW), lane);
    for (; r < NI; r += 4 * NGW) {
        if (r + 3 * NGW < NI) xw_load(vd, a, xw_map(r + 3 * NGW, NGW), lane);
        xw_fin(va, a, xw_map(r, NGW), scr, g2l, lane);
        if (r + NGW < NI) { if (r + 4 * NGW < NI) xw_load(va, a, xw_map(r + 4 * NGW, NGW), lane); xw_fin(vb, a, xw_map(r + NGW, NGW), scr, g2l, lane); }
        if (r + 2 * NGW < NI) { if (r + 5 * NGW < NI) xw_load(vb, a, xw_map(r + 5 * NGW, NGW), lane); xw_fin(vc, a, xw_map(r + 2 * NGW, NGW), scr, g2l, lane); }
        if (r + 3 * NGW < NI) { if (r + 6 * NGW < NI) xw_load(vc, a, xw_map(r + 6 * NGW, NGW), lane); xw_fin(vd, a, xw_map(r + 3 * NGW, NGW), scr, g2l, lane); }
    }
}

#endif
__device__ __forceinline__ void p0_prologue(const Args& a, LAS unsigned char* lds, int wave, int lane, int xw_end) {
    LAS float* scr = (LAS float*)(lds + wave * 16384);
    const int gw = blockIdx.x * NWAVES + wave, NGW = gridDim.x * NWAVES;
    unsigned char* ws = a.ws;
    constexpr int I_IN = 16 * 128, I_UQ = 4 * 24, I_UK = 2 * 16, I_UV = 2 * 16, I_A = 8 * 32, I_B = 8 * 32, I_O = 16 * 32, I_GU = 32 * 16 * 64, I_D = 32 * 16 * 32;
    constexpr int NITEMS = I_IN + I_UQ + I_UK + I_UV + I_A + I_B + I_O;
    for (int it = gw; it < NITEMS; it += NGW) {
        int r = it;
#ifdef INPROJ_FP8
        if (r < I_IN) { tr_any<CmIn8, true>(a.in[2], 4000, a.in[1], (bf16_t*)(ws + WS_WIN), 1024, 64 * (r / 128), 32 * (r % 128), CmIn8{}, scr, lane); continue; } r -= I_IN;
#else
        if (r < I_IN) { tr_any(a.in[2], 4000, a.in[1], (bf16_t*)(ws + WS_WIN), 1024, 64 * (r / 128), 32 * (r % 128), CmIn{}, scr, lane); continue; } r -= I_IN;
#endif
        if (r < I_UQ) { tr_any(a.in[5], 768, a.in[3], (bf16_t*)(ws + WS_WUQ), 256, 64 * (r / 24), 32 * (r % 24), CmUq{}, scr, lane); continue; } r -= I_UQ;
        if (r < I_UK) { tr_any(a.in[6], 512, a.in[4], (bf16_t*)(ws + WS_WUKV), 128, 64 * (r / 16), 32 * (r % 16), CmId{0}, scr, lane); continue; } r -= I_UK;
        if (r < I_UV) { tr_any(a.in[7], 512, a.in[4], (bf16_t*)(ws + WS_WUKV), 128, 64 * (r / 16), 512 + 32 * (r % 16), CmId{512}, scr, lane); continue; } r -= I_UV;
#ifdef OAB_FP8
        if (r < I_A) { tr_any<CmId8, true>(a.in[8], 1024, nullptr, (bf16_t*)(ws + WS_WA), 512, 64 * (r / 32), 32 * (r % 32), CmId8{}, scr, lane); continue; } r -= I_A;
        if (r < I_B) { tr_any<CmId8, true>(a.in[9], 1024, nullptr, (bf16_t*)(ws + WS_WB), 512, 64 * (r / 32), 32 * (r % 32), CmId8{}, scr, lane); continue; } r -= I_B;
#else
        if (r < I_A) { tr_any(a.in[8], 1024, nullptr, (bf16_t*)(ws + WS_WA), 512, 64 * (r / 32), 32 * (r % 32), CmId{0}, scr, lane); continue; } r -= I_A;
        if (r < I_B) { tr_any(a.in[9], 1024, nullptr, (bf16_t*)(ws + WS_WB), 512, 64 * (r / 32), 32 * (r % 32), CmId{0}, scr, lane); continue; } r -= I_B;
#endif
#ifdef WO_FP8
        tr_any<CmId8, true>(a.in[10], 1024, nullptr, (bf16_t*)(ws + WS_WO), 1024, 64 * (r / 32), 32 * (r % 32), CmId8{}, scr, lane);
#else
        tr_any(a.in[10], 1024, nullptr, (bf16_t*)(ws + WS_WO), 1024, 64 * (r / 32), 32 * (r % 32), CmId{0}, scr, lane);
#endif
    }
#if (!defined(BG_CONV) || defined(BG_KEEP_P0))
    if (xw_end > 0) p0_experts(a, lds, wave, lane, gw, NGW, 0, xw_end);
#endif
    for (int m = gw; m < T; m += NGW) {
        const f32x4* xr = (const f32x4*)(a.in[0] + (size_t)m * DM) + lane;
        f32x4 v[4]; float s2 = 0.f;
#pragma unroll
        for (int j = 0; j < 4; ++j) { v[j] = xr[64 * j]; s2 += (v[j].x * v[j].x + v[j].y * v[j].y) + (v[j].z * v[j].z + v[j].w * v[j].w); }
        const float rstd = 1.f / sqrtf(wave_sum(s2) * (1.f / DM) + EPS);
        u32x2* o8 = (u32x2*)((bf16_t*)(ws + WS_XB) + (size_t)m * DM) + lane;
#pragma unroll
#ifdef INPROJ_FP8
        for (int j = 0; j < 4; ++j) ((unsigned*)(ws + WS_XB + (size_t)m * DM))[lane + 64 * j] = pack4_fp8(v[j].x * rstd, v[j].y * rstd, v[j].z * rstd, v[j].w * rstd);
#else
        for (int j = 0; j < 4; ++j) o8[64 * j] = (u32x2){pk2(v[j].x * rstd, v[j].y * rstd), pk2(v[j].z * rstd, v[j].w * rstd)};
#endif
    }
    const int gt = blockIdx.x * NTHREADS + threadIdx.x, NGT = gridDim.x * NTHREADS;
    for (int idx = gt; idx < SEQ * 16; idx += NGT) {
        ((f32x2*)(ws + WS_ROPE))[idx] = rope_cs(idx >> 4, idx & 15);
    }
    for (int idx = gt; idx < 1024 * 32; idx += NGT) ((float*)(ws + WS_WRP))[idx] = a.in[12][idx] * a.in[11][idx >> 5];
}

__device__ __forceinline__ void p2_stats(const Args& a, int wave, int lane) {
    const int gw = blockIdx.x * NWAVES + wave, NGW = gridDim.x * NWAVES; unsigned char* ws = a.ws;
    for (int m = gw; m < T; m += NGW) {
        const u32x2 q = ((const u32x2*)((const bf16_t*)(ws + WS_CQ) + (size_t)m * 256))[lane];
        const unsigned kv = ((const unsigned*)((const bf16_t*)(ws + WS_CKV) + (size_t)m * 128))[lane];
        const float a0 = bflo(q.x), a1 = bfhi(q.x), a2 = bflo(q.y), a3 = bfhi(q.y), b0 = bflo(kv), b1 = bfhi(kv);
        const float sq = wave_sum((a0 * a0 + a1 * a1) + (a2 * a2 + a3 * a3)), sk = wave_sum(b0 * b0 + b1 * b1);
        if (lane == 0) { ((float*)(ws + WS_RSTDQ))[m] = 1.f / sqrtf(sq * (1.f / 256.f) + EPS); ((float*)(ws + WS_RSTDKV))[m] = 1.f / sqrtf(sk * (1.f / 128.f) + EPS); }
#ifdef KEEP_BF16_IMAGES
        if (lane < 32) { const int b = m >> 14, sq2 = m & (SEQ - 1); const u32x4 kr = *(const u32x4*)((const bf16_t*)(ws + WS_KR) + (size_t)m * 32 + 8 * (lane & 3));
            *(u32x4*)((bf16_t*)(ws + WS_KIMG) + (size_t)((b * 8 + (lane >> 2)) * 256 + (sq2 >> 6)) * 6144 + (8 + (lane & 3)) * 512 + (sq2 & 63) * 8) = kr; }
#endif
        if (lane < 16) { const int b = m >> 14, sq2 = m & (SEQ - 1); const bf16_t* kp = (const bf16_t*)(ws + WS_KR) + (size_t)m * 32 + 16 * (lane & 1);
            float k0[8], k1[8]; unpack8(*(const u32x4*)kp, k0); unpack8(*(const u32x4*)(kp + 8), k1);
            *(u32x4*)(ws + WS_K8 + (size_t)((b * 8 + (lane >> 1)) * 256 + (sq2 >> 6)) * 6144 + (4 + (lane & 1)) * 1024 + (sq2 & 63) * 16) =
                (u32x4){pack4_fp8(k0[0], k0[1], k0[2], k0[3]), pack4_fp8(k0[4], k0[5], k0[6], k0[7]), pack4_fp8(k1[0], k1[1], k1[2], k1[3]), pack4_fp8(k1[4], k1[5], k1[6], k1[7])}; }
    }
}

__device__ __forceinline__ void p4_v8t(unsigned char* ws) {
    const bf16_t* VIM = (const bf16_t*)(ws + WS_VIMG); unsigned char* V8 = ws + WS_V8T;
    for (int g = blockIdx.x * NTHREADS + threadIdx.x; g < NB * 8 * 256 * 128; g += gridDim.x * NTHREADS) {
        const int dp = g & 15, ch = (g >> 4) & 3, dh = (g >> 6) & 1, tile = g >> 7, hi = ch >> 1;
        const bf16_t* src = VIM + (size_t)tile * 4096 + dh * 2048 + (ch & 1) * 1024 + 2 * dp;
        unsigned w[16];
#pragma unroll
        for (int i = 0; i < 16; ++i) w[i] = *(const unsigned*)(src + crow(i, hi) * 32);
        u32x4 lo, hi4;
        lo.x = pack4_fp8(bflo(w[0]), bflo(w[1]), bflo(w[2]), bflo(w[3]));     lo.y = pack4_fp8(bflo(w[4]), bflo(w[5]), bflo(w[6]), bflo(w[7]));
        lo.z = pack4_fp8(bflo(w[8]), bflo(w[9]), bflo(w[10]), bflo(w[11]));   lo.w = pack4_fp8(bflo(w[12]), bflo(w[13]), bflo(w[14]), bflo(w[15]));
        hi4.x = pack4_fp8(bfhi(w[0]), bfhi(w[1]), bfhi(w[2]), bfhi(w[3]));    hi4.y = pack4_fp8(bfhi(w[4]), bfhi(w[5]), bfhi(w[6]), bfhi(w[7]));
        hi4.z = pack4_fp8(bfhi(w[8]), bfhi(w[9]), bfhi(w[10]), bfhi(w[11]));  hi4.w = pack4_fp8(bfhi(w[12]), bfhi(w[13]), bfhi(w[14]), bfhi(w[15]));
        u32x4* dst = (u32x4*)(V8 + (size_t)tile * 4096 + dh * 2048 + ch * 512 + dp * 32);
        dst[0] = lo; dst[1] = hi4;
    }
}

#ifdef QK_FP6
__device__ __forceinline__ void fp8x32_to_fp6(const u32x4 a, const u32x4 b, float div, unsigned char* dst, unsigned& nan) {
    const mla88::u32x6_t r = mla88::fp8x32_fp6(a, b, div, nan);
    *(u32x2*)dst = (u32x2){r[0], r[1]}; *(u32x2*)(dst + 8) = (u32x2){r[2], r[3]}; *(u32x2*)(dst + 16) = (u32x2){r[4], r[5]};
}
__device__ __forceinline__ void p4_k6q6(unsigned char* ws) {
    unsigned nan = 0u;
    for (int g = blockIdx.x * NTHREADS + threadIdx.x; g < NB * 8 * 256 * 64; g += gridDim.x * NTHREADS) {
        const int tb = g >> 6, key = g & 63; const unsigned char* src = ws + WS_K8 + (size_t)tb * 6144 + key * 16; unsigned char* dst = ws + WS_K6 + (size_t)tb * 5120 + key * 24;
#pragma unroll
        for (int blk = 0; blk < 3; ++blk) fp8x32_to_fp6(*(const u32x4*)(src + (2 * blk) * 1024), *(const u32x4*)(src + (2 * blk + 1) * 1024), 1.f, dst + blk * 1536, nan);
    }
    if (__any(nan != 0u)) { if ((threadIdx.x & 63) == 0) __hip_atomic_fetch_or((unsigned*)(ws + WS_CTL) + CW_F6BAD, 1u, __ATOMIC_RELAXED, __HIP_MEMORY_SCOPE_AGENT); }
}
#endif
__device__ __forceinline__ void p4_dilated(const Args& a, LAS unsigned char* lds, volatile LAS unsigned* MISC, int wave, int lane) {
    unsigned char* ws = a.ws;
    const int r32 = lane & 31, hi = lane >> 5;
#ifndef MLA_PV_BF16
    p4_v8t(ws);
#endif
#ifdef QK_FP6
    p4_k6q6(ws);
#endif
    {
        LAS unsigned* nm = (LAS unsigned*)(MISC + MI_NRM);
        if (threadIdx.x < 32) nm[threadIdx.x] = 0u;
        __syncthreads();
        const bf16_t* QB = (const bf16_t*)(ws + WS_QB); const bf16_t* KIM = (const bf16_t*)(ws + WS_KIMG); const bf16_t* KR = (const bf16_t*)(ws + WS_KR);
        const int gw = blockIdx.x * NWAVES + wave, NGW = gridDim.x * NWAVES;
#ifndef NORMS_PASS
        for (int t = gw; t < 0; t += NGW) {
#else
        for (int t = gw; t < T; t += NGW) {
#endif
            const int b = t >> 14;
            const u32x2* qp = (const u32x2*)(QB + (size_t)t * 768 + 12 * lane);
            const u32x2 q0 = qp[0], q1 = qp[1], q2 = qp[2];
            float sq = (bflo(q0.x) * bflo(q0.x) + bfhi(q0.x) * bfhi(q0.x)) + (bflo(q0.y) * bflo(q0.y) + bfhi(q0.y) * bfhi(q0.y));
            sq += (bflo(q1.x) * bflo(q1.x) + bfhi(q1.x) * bfhi(q1.x)) + (bflo(q1.y) * bflo(q1.y) + bfhi(q1.y) * bfhi(q1.y));
            sq += (bflo(q2.x) * bflo(q2.x) + bfhi(q2.x) * bfhi(q2.x)) + (bflo(q2.y) * bflo(q2.y) + bfhi(q2.y) * bfhi(q2.y));
            float kk8[8]; unpack8(*(const u32x4*)(KIM + (size_t)((b * 8 + (lane >> 3)) * 256 + ((t & (SEQ - 1)) >> 6)) * 6144 + (lane & 7) * 512 + (t & 63) * 8), kk8);
            float sk = 0.f;
#pragma unroll
            for (int j = 0; j < 8; ++j) sk += kk8[j] * kk8[j];
            float kr8[8]; unpack8(*(const u32x4*)(KR + (size_t)t * 32 + 8 * (lane & 3)), kr8);
            float sr = 0.f;
#pragma unroll
            for (int j = 0; j < 8; ++j) sr += kr8[j] * kr8[j];
            sr += __shfl_xor(sr, 1); sr += __shfl_xor(sr, 2);
            sq += __shfl_xor(sq, 1); sq += __shfl_xor(sq, 2); sq += __shfl_xor(sq, 4);
            sk += __shfl_xor(sk, 1); sk += __shfl_xor(sk, 2); sk += __shfl_xor(sk, 4);
            sk += sr;
            if ((lane & 7) == 0) { const int hh = lane >> 3;
                __hip_atomic_fetch_max(&nm[b * 8 + hh], __float_as_uint(sq), __ATOMIC_RELAXED, __HIP_MEMORY_SCOPE_WORKGROUP);
                __hip_atomic_fetch_max(&nm[16 + b * 8 + hh], __float_as_uint(sk), __ATOMIC_RELAXED, __HIP_MEMORY_SCOPE_WORKGROUP); }
        }
        __syncthreads();
        { int tx = threadIdx.x; asm volatile("" : "+v"(tx));
          if (tx < 32) __hip_atomic_fetch_max((unsigned*)(ws + WS_CTL) + CW_NRM + tx, nm[tx], __ATOMIC_RELAXED, __HIP_MEMORY_SCOPE_AGENT); }
    }
    __syncthreads();
    const bf16_t* QA = (const bf16_t*)(ws + WS_QA); const bf16_t* KA = (const bf16_t*)(ws + WS_KA); const bf16_t* VA = (const bf16_t*)(ws + WS_VA);
    bf16_t* PO = (bf16_t*)(ws + WS_PARTO); float* PL = (float*)(ws + WS_PARTL);
    constexpr int DK = 0, DV = 98304, DWS = 147456;
    const unsigned lds0 = (unsigned)(uintptr_t)lds;
    LAS float* wsf = (LAS float*)(lds + DWS) + wave * 64;
    const int NU = NB * 8 * 192, G_ = gridDim.x;
#define DIL_DECODE(un, p, dil, res, blk, L, b, h) int p, dil, res, blk, L; const int b = ((un) / 192) >> 3, h = ((un) / 192) & 7; { const int w_ = (un) % 192; \
        if (w_ < 64) { p = 0; dil = 1; res = 0; blk = w_; L = SEQ; } else if (w_ < 128) { p = 1; dil = 4; res = (w_ - 64) >> 4; blk = (w_ - 64) & 15; L = SEQ / 4; } else { p = 2; dil = 16; res = (w_ - 128) >> 2; blk = (w_ - 128) & 3; L = SEQ / 16; } }
#ifdef PROBE_DIL_X2K
#define DIL_X2K(x) x
#else
#define DIL_X2K(x)
#endif
#define DIL_DMA_K(un, kb) do { DIL_DECODE(un, p_, dil_, res_, blk_, L_, b_, h_) (void)p_; const int u0_ = 256 * blk_ - 64; _Pragma("unroll") for (int j = 0; j < 6; ++j) { \
        int uk = u0_ + 64 * j + lane; uk = uk < 0 ? 0 : (uk >= L_ ? L_ - 1 : uk); \
        mla::glds16(KA + ((size_t)b_ * SEQ + (size_t)(res_ + dil_ * uk)) * 512 + h_ * 64 + wave * 8, (unsigned)__builtin_amdgcn_readfirstlane(lds0 + DK + (kb) * 49152 + j * 8192 + wave * 1024)); \
        DIL_X2K(mla::glds16(KA + ((size_t)b_ * SEQ + (size_t)(res_ + dil_ * uk)) * 512 + h_ * 64 + wave * 8, (unsigned)__builtin_amdgcn_readfirstlane(lds0 + DK + (kb) * 49152 + j * 8192 + wave * 1024))); } } while (0)
#define DIL_DMA_V(un) do { DIL_DECODE(un, p_, dil_, res_, blk_, L_, b_, h_) (void)p_; const int u0_ = 256 * blk_ - 64; _Pragma("unroll") for (int j = 0; j < 6; ++j) { \
        int uv = u0_ + 64 * j + 16 * (wave & 3) + (lane >> 2); uv = uv < 0 ? 0 : (uv >= L_ ? L_ - 1 : uv); \
        mla::glds16(VA + ((size_t)b_ * SEQ + (size_t)(res_ + dil_ * uv)) * 512 + h_ * 64 + (wave >> 2) * 32 + (lane & 3) * 8, (unsigned)__builtin_amdgcn_readfirstlane(lds0 + DV + j * 8192 + wave * 1024)); } } while (0)
#define DIL_LOAD_Q(un, q) do { DIL_DECODE(un, p_, dil_, res_, blk_, L_, b_, h_) (void)p_; (void)L_; const size_t tq_ = (size_t)b_ * SEQ + (size_t)(res_ + dil_ * (256 * blk_ + 32 * wave + r32)); \
        _Pragma("unroll") for (int d0 = 0; d0 < 4; ++d0) q[d0] = *(const bf16x8*)(QA + tq_ * 512 + h_ * 64 + 16 * d0 + 8 * hi); } while (0)
    float dr[16];
#pragma unroll
    for (int r = 0; r < 16; ++r) dr[r] = (float)(crow(r, hi) - r32);
    int un = blockIdx.x, it = 0;
    bf16x8 qn[4] = {};
    if (un < NU) { DIL_LOAD_Q(un, qn); DIL_DMA_K(un, 0); DIL_DMA_V(un); }
    for (; un < NU; un += G_, ++it) {
        DIL_DECODE(un, p, dil, res, blk, L, b, h)
        const size_t bo = (size_t)b * SEQ; const int kb = it & 1;
        const int ur = 256 * blk + 32 * wave;
        const float slope2d = __builtin_amdgcn_exp2f(-(float)(h + 1)) * LOG2E * (float)dil;
        float sdr[16];
#pragma unroll
        for (int r = 0; r < 16; ++r) sdr[r] = slope2d * dr[r];
        asm volatile("s_waitcnt vmcnt(6)\n\ts_barrier" ::: "memory");
#define DIL_KC(c) (-slope2d * (float)((c) < 2 ? 64 - 32 * (c) : 32 * (c) - 64))
#define DIL_SCORE(c, sc) f32x16 sc = {}; { const int cw = wave + (c), j = cw >> 1, n = cw & 1; \
            const LAS char* kp = (const LAS char*)lds + DK + kb * 49152 + j * 8192 + hi * 1024 + (32 * n + r32) * 16; \
            _Pragma("unroll") for (int d0 = 0; d0 < 4; ++d0) sc = __builtin_amdgcn_mfma_f32_32x32x16_bf16(*(const LAS bf16x8*)(kp + d0 * 2048), qn[d0], sc, 0, 0, 0); \
            const int vb = ur - 64 + 32 * (c); \
              \
              \
            if ((c) < 2) { _Pragma("unroll") for (int r = 0; r < 16; ++r) sc[r] += sdr[r]; } \
            else if ((c) == 2) { _Pragma("unroll") for (int r = 0; r < 16; ++r) sc[r] -= fabsf(sdr[r]); } \
            else { _Pragma("unroll") for (int r = 0; r < 16; ++r) sc[r] -= sdr[r]; } \
            if ((c) == 0) { _Pragma("unroll") for (int r = 0; r < 16; ++r) sc[r] = (dr[r] >= 0.f) ? sc[r] : -1e30f; }       \
            if ((c) == 4) { _Pragma("unroll") for (int r = 0; r < 16; ++r) sc[r] = (dr[r] <= 0.f) ? sc[r] : -1e30f; }       \
            if (vb < 0 || vb + 31 >= L) { _Pragma("unroll") for (int r = 0; r < 16; ++r) { const int v = vb + crow(r, hi); sc[r] = (v >= 0 && v < L) ? sc[r] : -1e30f; } } }
        float mx = -1e30f;
#ifdef DIL_TWO_SWEEPS
#pragma unroll
        for (int c = 0; c < 5; ++c) { DIL_SCORE(c, sc)
#pragma unroll
            for (int r = 0; r < 16; ++r) mx = fmaxf(mx, sc[r] + DIL_KC(c));
            asm volatile("" : "+v"(mx) :: "memory"); __builtin_amdgcn_sched_barrier(0); }
        mx = swapmax(mx);
#else
        f32x16 sc2;
        { DIL_SCORE(2, sc)
#pragma unroll
            for (int r = 0; r < 16; ++r) mx = fmaxf(mx, sc[r]);
            sc2 = sc;
            asm volatile("" : "+v"(mx), "+v"(sc2) :: "memory"); __builtin_amdgcn_sched_barrier(0); }
        mx = swapmax(mx) + 32.f;
#endif
        float ps = 0.f; u32x4 pw[5][2];
#pragma unroll
        for (int c = 0; c < 5; ++c) {
#ifdef DIL_TWO_SWEEPS
            DIL_SCORE(c, sc)
#else
            f32x16 sc; if (c == 2) sc = sc2; else { DIL_SCORE(c, scx) sc = scx; }
#endif
            const float mc = mx - DIL_KC(c);
#pragma unroll
            for (int r = 0; r < 16; ++r) { sc[r] = fexp2(sc[r] - mc); ps += sc[r]; }
            pw[c][0] = (u32x4){cvtpk(sc[0], sc[1]), cvtpk(sc[2], sc[3]), cvtpk(sc[4], sc[5]), cvtpk(sc[6], sc[7])};
            pw[c][1] = (u32x4){cvtpk(sc[8], sc[9]), cvtpk(sc[10], sc[11]), cvtpk(sc[12], sc[13]), cvtpk(sc[14], sc[15])};
            asm volatile("" : "+v"(ps), "+v"(pw[c][0]), "+v"(pw[c][1]) :: "memory"); __builtin_amdgcn_sched_barrier(0); }
#if !defined(DIL_TWO_SWEEPS) && !defined(DIL_NO_GUARD)
#ifdef DIL_FORCE_REDO
        if (true) {
#else
        if (__builtin_expect(__any(!(ps < 3.0e38f)), 0)) {
#endif
            mx = -1e30f;
#pragma unroll
            for (int c = 0; c < 5; ++c) { DIL_SCORE(c, sc)
#pragma unroll
                for (int r = 0; r < 16; ++r) mx = fmaxf(mx, sc[r] + DIL_KC(c));
                asm volatile("" : "+v"(mx) :: "memory"); __builtin_amdgcn_sched_barrier(0); }
            mx = swapmax(mx); ps = 0.f;
#pragma unroll
            for (int c = 0; c < 5; ++c) { DIL_SCORE(c, sc) const float mc = mx - DIL_KC(c);
#pragma unroll
                for (int r = 0; r < 16; ++r) { sc[r] = fexp2(sc[r] - mc); ps += sc[r]; }
                pw[c][0] = (u32x4){cvtpk(sc[0], sc[1]), cvtpk(sc[2], sc[3]), cvtpk(sc[4], sc[5]), cvtpk(sc[6], sc[7])};
                pw[c][1] = (u32x4){cvtpk(sc[8], sc[9]), cvtpk(sc[10], sc[11]), cvtpk(sc[12], sc[13]), cvtpk(sc[14], sc[15])};
                asm volatile("" : "+v"(ps), "+v"(pw[c][0]), "+v"(pw[c][1]) :: "memory"); __builtin_amdgcn_sched_barrier(0); }
        }
#endif
#undef DIL_SCORE
#undef DIL_KC
        if (un + G_ < NU) DIL_LOAD_Q(un + G_, qn);
        const float lt = swapsum(ps);
        if (hi == 0) { wsf[32 + r32] = lt; PL[(((size_t)p * NB + b) * 8 + h) * SEQ + (res + dil * (ur + r32))] = mx + __builtin_amdgcn_logf(lt); }
        asm volatile("s_waitcnt vmcnt(0) lgkmcnt(0)\n\ts_barrier" ::: "memory");
        if (un + G_ < NU) DIL_DMA_K(un + G_, kb ^ 1);
        f32x16 o0 = {}, o1 = {};
#pragma unroll
        for (int c = 0; c < 5; ++c) {
            const int cw = wave + c, j = cw >> 1, n = cw & 1;
            const LAS char* vp = (const LAS char*)lds + DV + j * 8192 + n * 2048 + ((lane >> 4) & 1) * 32 + (lane & 3) * 8 + (4 * hi + ((lane & 15) >> 2)) * 64;
#pragma unroll
            for (int ks = 0; ks < 2; ++ks) {
                const s16x4 l0 = vtr(vp + ks * 1024), h0 = vtr(vp + ks * 1024 + 512), l1 = vtr(vp + 4096 + ks * 1024), h1 = vtr(vp + 4096 + ks * 1024 + 512);
                const bf16x8 v0 = {l0[0], l0[1], l0[2], l0[3], h0[0], h0[1], h0[2], h0[3]}, v1 = {l1[0], l1[1], l1[2], l1[3], h1[0], h1[1], h1[2], h1[3]};
                const bf16x8 pa = __builtin_bit_cast(bf16x8, pw[c][ks]);
                o0 = __builtin_amdgcn_mfma_f32_32x32x16_bf16(pa, v0, o0, 0, 0, 0);
                o1 = __builtin_amdgcn_mfma_f32_32x32x16_bf16(pa, v1, o1, 0, 0, 0);
            }
        }
        { LAS bf16_t* stg = (LAS bf16_t*)(lds + DK + kb * 49152) + wave * 2048;
#pragma unroll
          for (int r = 0; r < 16; ++r) { const int q = crow(r, hi); const float il = frcp(wsf[32 + q]);
              const unsigned w01 = cvtpk(o0[r] * il, o1[r] * il);
              stg[q * 64 + r32] = (bf16_t)(w01 & 0xffffu); stg[q * 64 + 32 + r32] = (bf16_t)(w01 >> 16); }
#pragma unroll
          for (int i = 0; i < 4; ++i) { const int row = i * 8 + (lane >> 3), ch = lane & 7; const u32x4 v = *(const LAS u32x4*)(stg + row * 64 + ch * 8);
              *(u32x4*)(PO + ((size_t)p * T + bo + (size_t)(res + dil * (ur + row))) * 512 + h * 64 + ch * 8) = v; } }
        asm volatile("s_waitcnt lgkmcnt(0)\n\ts_barrier" ::: "memory");
        if (un + G_ < NU) DIL_DMA_V(un + G_);
    }
    asm volatile("s_waitcnt vmcnt(0)" ::: "memory");
    __syncthreads();
#undef DIL_LOAD_Q
#undef DIL_DECODE
#undef DIL_DMA_K
#undef DIL_DMA_V
}
__device__ __forceinline__ void p5_combine(const Args& a, int wave, int lane) {
    unsigned char* ws = a.ws; const bf16_t* PO = (const bf16_t*)(ws + WS_PARTO); const float* PL = (const float*)(ws + WS_PARTL); bf16_t* OA = (bf16_t*)(ws + WS_OA);
    const int gw = blockIdx.x * NWAVES + wave, NGW = gridDim.x * NWAVES;
    for (int it = gw; it < T; it += NGW) {
        const int t = it, b = t >> 14, s = t & (SEQ - 1), h = lane >> 3, ch = lane & 7;
        const float l0 = PL[(((size_t)0 * NB + b) * 8 + h) * SEQ + s], l1 = PL[(((size_t)1 * NB + b) * 8 + h) * SEQ + s], l2 = PL[(((size_t)2 * NB + b) * 8 + h) * SEQ + s];
        const float mx = fmaxf(fmaxf(l0, l1), l2); float w0 = fexp2(l0 - mx), w1 = fexp2(l1 - mx), w2 = fexp2(l2 - mx); const float iw = frcp(w0 + w1 + w2); w0 *= iw; w1 *= iw; w2 *= iw;
        float v0[8], v1[8], v2[8], o[8];
        unpack8(*(const u32x4*)(PO + ((size_t)0 * T + t) * 512 + h * 64 + ch * 8), v0);
        unpack8(*(const u32x4*)(PO + ((size_t)1 * T + t) * 512 + h * 64 + ch * 8), v1);
        unpack8(*(const u32x4*)(PO + ((size_t)2 * T + t) * 512 + h * 64 + ch * 8), v2);
#pragma unroll
        for (int j = 0; j < 8; ++j) o[j] = w0 * v0[j] + w1 * v1[j] + w2 * v2[j];
#ifdef OAB_FP8
        *(u32x2*)((unsigned char*)OA + (size_t)t * 512 + h * 64 + ch * 8) = (u32x2){pack4_fp8(32.f * o[0], 32.f * o[1], 32.f * o[2], 32.f * o[3]), pack4_fp8(32.f * o[4], 32.f * o[5], 32.f * o[6], 32.f * o[7])};
#else
        *(u32x4*)(OA + (size_t)t * 512 + h * 64 + ch * 8) = pack8(o);
#endif
    }
}
__device__ __forceinline__ void p5_mla(const Args& a, LAS unsigned char* lds, int wave, int lane) {
    unsigned char* ws = a.ws;
    LAS char* vimg = (LAS char*)(lds + wave * 8192); LAS float* wsf = (LAS float*)(lds + wave * 8192 + 4096);
    const int r32 = lane & 31, hi = lane >> 5;
    const bf16_t* QB = (const bf16_t*)(ws + WS_QB); const bf16_t* KIM = (const bf16_t*)(ws + WS_KIMG); const bf16_t* VIM = (const bf16_t*)(ws + WS_VIMG);
    bf16_t* OB = (bf16_t*)(ws + WS_OB);
    const unsigned* nrm = (const unsigned*)(ws + WS_CTL) + CW_NRM;
    unsigned redo = 0u;
#ifdef QK_FP6
    const bool f6ok = __hip_atomic_load((const unsigned*)(ws + WS_CTL) + CW_F6BAD, __ATOMIC_RELAXED, __HIP_MEMORY_SCOPE_AGENT) == 0u;
#endif
    bgc::Bg bg; bg.init(a.in[14], a.in[16], ws, lds, wave, lane);
#ifdef BG_CONV
    { int tx = threadIdx.x; asm volatile("" : "+v"(tx));
      for (int i = tx; i < 1024; i += NTHREADS) ((LAS float*)(lds + bgc::LDS_G2))[i] = a.in[11][i];
      if (tx < 64) ((LAS float*)(lds + bgc::LDS_G2))[bgc::G2_ONES + tx] = 1.f; }
    __syncthreads();
    for (int tk = 0; tk < 4; ++tk) bg.tick_sync(tk, false);
    bg.q = 4;
#endif
    { int it = 0;
    for (int un = blockIdx.x; un < NB * 8 * 64; un += gridDim.x, ++it) {
#ifdef MLA_XCD_MAP
        int qb = un & 63, h = (un >> 6) & 7, b = un >> 9;
        if (gridDim.x == 256) { const int k_ = un >> 8, bx_ = un & 255, pair = (bx_ & 7) + 8 * (k_ >> 1); qb = (bx_ >> 3) + 32 * (k_ & 1); h = pair & 7; b = pair >> 3; }
#else
        const int qb = un & 63, h = (un >> 6) & 7, b = un >> 9;
#endif
        bool fast = true;
#ifdef QK_FP6
        fast = f6ok;
#endif
#ifdef MLA_FORCE_GENERAL
        fast = false;
#endif
#ifdef MLA_BF16_FAST
        if (__builtin_amdgcn_readfirstlane((int)fast)) mla::mla_unit(b, h, qb, QB, KIM + (size_t)(b * 8 + h) * 256 * 6144, VIM + (size_t)(b * 8 + h) * 256 * 4096, OB, (LAS char*)lds);
#elif defined(MLA_PV_BF16)
        if (__builtin_amdgcn_readfirstlane((int)fast)) mla8::mla8_unit(b, h, qb, (const unsigned char*)(ws + WS_Q8), (const unsigned char*)(ws + WS_K8) + (size_t)(b * 8 + h) * 256 * 6144, VIM + (size_t)(b * 8 + h) * 256 * 4096, OB, (LAS char*)lds);
#else
        if (__builtin_amdgcn_readfirstlane((int)fast)) {
#ifdef QK_FP6
            const bool r = mla88::mla88_unit(b, h, qb, (const unsigned char*)(ws + WS_Q8), (const unsigned char*)(ws + WS_K6) + (size_t)(b * 8 + h) * 256 * 5120,
#else
            const bool r = mla88::mla88_unit(b, h, qb, (const unsigned char*)(ws + WS_Q8), (const unsigned char*)(ws + WS_K8) + (size_t)(b * 8 + h) * 256 * 6144,
#endif
                (const unsigned char*)(ws + WS_V8T) + (size_t)(b * 8 + h) * 256 * 4096, OB, (LAS char*)lds, bg);
            redo |= (unsigned)__builtin_amdgcn_readfirstlane((int)r) << it;
        }
#endif
    } }
#ifdef BG_CONV
    if (!bg.fast()) bg.q = 0;
    while (bg.q < bg.q_end()) { bg.tick_sync(bg.q, bg.q >= 4); bg.q += 1; }
#endif
    int it2 = 0;
#ifdef TIME_PROBE
    redo = 0u;
#endif
    for (int un = blockIdx.x; un < NB * 8 * 64; un += gridDim.x, ++it2) {
#ifdef MLA_XCD_MAP
        int qb = un & 63, h = (un >> 6) & 7, b = un >> 9;
        if (gridDim.x == 256) { const int k_ = un >> 8, bx_ = un & 255, pair = (bx_ & 7) + 8 * (k_ >> 1); qb = (bx_ >> 3) + 32 * (k_ & 1); h = pair & 7; b = pair >> 3; }
#else
        const int qb = un & 63, h = (un >> 6) & 7, b = un >> 9;
#endif
        bool fast = !((redo >> it2) & 1u);
#ifdef QK_FP6
        fast = fast && f6ok;
#endif
#ifdef MLA_FORCE_GENERAL
        fast = false;
#endif
        if (!__builtin_amdgcn_readfirstlane((int)fast)) {
            const size_t bo = (size_t)b * SEQ, tq0 = bo + (size_t)qb * 256 + wave * 32;
#ifdef KEEP_BF16_IMAGES
            MlaKL kl; kl.K = KIM + (size_t)(b * 8 + h) * 256 * 6144; kl.V = VIM + (size_t)(b * 8 + h) * 256 * 4096;
            bf16x8 qf[6];
#pragma unroll
            for (int d0 = 0; d0 < 6; ++d0) qf[d0] = *(const bf16x8*)(QB + (tq0 + r32) * 768 + h * 96 + 16 * d0 + 8 * hi);
#else
            MlaKL8 kl; kl.K = ws + WS_K8 + (size_t)(b * 8 + h) * 256 * 6144; kl.V = VIM + (size_t)(b * 8 + h) * 256 * 4096;
            bf16x8 qf[6];
#pragma unroll
            for (int d0 = 0; d0 < 6; ++d0) qf[d0] = fp8x8_to_bf16(*(const u32x2*)(ws + WS_Q8 + (tq0 + r32) * 768 + h * 96 + 16 * d0 + 8 * hi), 0.0625f);
#endif
            AttnState st; wave_attn<6>(st, qf, kl, SEQ / 32, vimg, wsf, lane);
            (void)attn_finish(st, vimg, wsf, lane);
#pragma unroll
            for (int i = 0; i < 4; ++i) { const int row = i * 8 + (lane >> 3), ch = lane & 7; const u32x4 v = *(const LAS u32x4*)(vimg + row * 128 + ch * 16);
#ifdef OAB_FP8
                float f8_[8]; unpack8(v, f8_);
                *(u32x2*)((unsigned char*)OB + (tq0 + row) * 512 + h * 64 + ch * 8) = (u32x2){pack4_fp8(32.f * f8_[0], 32.f * f8_[1], 32.f * f8_[2], 32.f * f8_[3]), pack4_fp8(32.f * f8_[4], 32.f * f8_[5], 32.f * f8_[6], 32.f * f8_[7])}; }
#else
                *(u32x4*)(OB + (tq0 + row) * 512 + h * 64 + ch * 8) = v; }
#endif
        }
    }
}

__device__ __forceinline__ void p8_router(const Args& a, LAS unsigned char* lds, volatile LAS unsigned* MISC, int wave, int lane) {
    unsigned char* ws = a.ws; const float* x1 = a.out; const float* wrp = (const float*)(ws + WS_WRP); const float* br = a.in[13];
    LAS float* lg = (LAS float*)(lds + wave * 8192);
    LAS unsigned* hist = (LAS unsigned*)(MISC + MI_HIST);
    if (threadIdx.x < 32) hist[threadIdx.x] = 0u;
    __syncthreads();
    const int G = gridDim.x, i32 = lane & 31, hi = lane >> 5;
    for (int tb = wave * G + blockIdx.x; tb < T / 32; tb += G * NWAVES) {
        const int t = tb * 32 + i32;
        const float* xr = x1 + (size_t)t * DM + 512 * hi; const float* wr_ = wrp + (size_t)(512 * hi) * 32 + i32;
        f32x16 acc = {}; float ssq = 0.f;
#define RT_LOAD(xv, s) do { _Pragma("unroll") for (int j = 0; j < 8; ++j) xv[j] = *(const f32x4*)(xr + 32 * (s) + 4 * j); } while (0)
#define RT_MMA(xv, s) do { _Pragma("unroll") for (int j = 0; j < 8; ++j) { const f32x4 xa = xv[j]; const int k4 = 32 * (s) + 4 * j; \
                ssq += (xa.x * xa.x + xa.y * xa.y) + (xa.z * xa.z + xa.w * xa.w); \
                acc = __builtin_amdgcn_mfma_f32_32x32x2f32(xa.x, wr_[(k4 + 0) * 32], acc, 0, 0, 0); \
                acc = __builtin_amdgcn_mfma_f32_32x32x2f32(xa.y, wr_[(k4 + 1) * 32], acc, 0, 0, 0); \
                acc = __builtin_amdgcn_mfma_f32_32x32x2f32(xa.z, wr_[(k4 + 2) * 32], acc, 0, 0, 0); \
                acc = __builtin_amdgcn_mfma_f32_32x32x2f32(xa.w, wr_[(k4 + 3) * 32], acc, 0, 0, 0); } } while (0)
        { f32x4 xb[8], xn[8];
          RT_LOAD(xb, 0);
#pragma unroll 1
          for (int s32 = 0; s32 < 16; s32 += 2) {
              RT_LOAD(xn, s32 + 1); RT_MMA(xb, s32);
              if (s32 + 2 < 16) RT_LOAD(xb, s32 + 2);
              RT_MMA(xn, s32 + 1);
          } }
#undef RT_LOAD
#undef RT_MMA
        ssq = swapsum(ssq);
        const float rstd = 1.f / sqrtf(ssq * (1.f / DM) + EPS);
#pragma unroll
        for (int r = 0; r < 16; ++r) lg[crow(r, hi) * 33 + i32] = acc[r];
        asm volatile("s_waitcnt lgkmcnt(0)" ::: "memory");
        float v[32];
#pragma unroll
        for (int e = 0; e < 32; ++e) v[e] = lg[i32 * 33 + e] * rstd + br[e];
        int ti[4]; float tv[4];
#pragma unroll
        for (int k = 0; k < 4; ++k) {
            float best = v[0]; int bi = 0;
#pragma unroll
            for (int e = 1; e < 32; ++e) { const bool g = v[e] > best; best = g ? v[e] : best; bi = g ? e : bi; }
            ti[k] = bi; tv[k] = best;
#pragma unroll
            for (int e = 0; e < 32; ++e) v[e] = (e == bi) ? -3.0e38f : v[e];
        }
        const float e1 = __expf(tv[1] - tv[0]), e2 = __expf(tv[2] - tv[0]), e3 = __expf(tv[3] - tv[0]); const float inv = 1.f / (1.f + e1 + e2 + e3);
        const float gw[4] = {inv, e1 * inv, e2 * inv, e3 * inv};
        if (hi == 0) {
            ((float*)(ws + WS_RSTD2))[t] = rstd;
#pragma unroll
            for (int k = 0; k < 4; ++k) { const unsigned rk = __hip_atomic_fetch_add(&hist[ti[k]], 1u, __ATOMIC_RELAXED, __HIP_MEMORY_SCOPE_WORKGROUP);
                ((int*)(ws + WS_TOPI))[t * 4 + k] = ti[k]; ((float*)(ws + WS_GATEW))[t * 4 + k] = gw[k]; ((int*)(ws + WS_SRANK))[t * 4 + k] = (int)rk; }
        }
        asm volatile("s_waitcnt lgkmcnt(0)" ::: "memory");
    }
    __syncthreads();
    { int tx = threadIdx.x; asm volatile("" : "+v"(tx));
      if (tx < 32) {
        const unsigned c = hist[tx];
        const unsigned base = __hip_atomic_fetch_add((unsigned*)(ws + WS_CTL) + CW_GCOUNT + tx, c, __ATOMIC_RELAXED, __HIP_MEMORY_SCOPE_AGENT);
        ((int*)(ws + WS_WGBASE))[blockIdx.x * 32 + tx] = (int)base;
      } }
}
__device__ __forceinline__ void moe_prefix(const Args& a, volatile LAS unsigned* MISC) {
    if (threadIdx.x < 64) {
        const unsigned* gc = (const unsigned*)(a.ws + WS_CTL) + CW_GCOUNT; const int e = threadIdx.x & 31;
        const int c = (int)__hip_atomic_load(gc + e, __ATOMIC_RELAXED, __HIP_MEMORY_SCOPE_AGENT), pad = (c + 255) & ~255;
        int inc = pad;
#pragma unroll
        for (int o = 1; o < 32; o <<= 1) { const int v = __shfl_up(inc, o, 32); if (e >= o) inc += v; }
        if (threadIdx.x < 32) { MISC[MI_PSTART + e] = (unsigned)(inc - pad); MISC[MI_TPRE + e] = (unsigned)((inc - pad) >> 8);
            if (e == 31) { MISC[MI_PSTART + 32] = (unsigned)inc; MISC[MI_TPRE + 32] = (unsigned)(inc >> 8); } }
    }
    __syncthreads();
}
__device__ __forceinline__ void p9_scatter(const Args& a, volatile LAS unsigned* MISC) {
    unsigned char* ws = a.ws; const int G = gridDim.x;
    moe_prefix(a, MISC);
    const int* topi = (const int*)(ws + WS_TOPI); const int* srank = (const int*)(ws + WS_SRANK); const int* wgbase = (const int*)(ws + WS_WGBASE); const float* rstd2 = (const float*)(ws + WS_RSTD2);
    int* pos = (int*)(ws + WS_POS); int* rowtok = (int*)(ws + WS_ROWTOK); float* rowscale = (float*)(ws + WS_ROWSCALE);
    for (int sl = blockIdx.x * NTHREADS + threadIdx.x; sl < NSLOT; sl += G * NTHREADS) {
        const int t = sl >> 2, e = topi[sl], wg = (t >> 5) % G;
        const int row = (int)MISC[MI_PSTART + e] + wgbase[wg * 32 + e] + srank[sl];
        pos[sl] = row; rowtok[row] = t; rowscale[row] = rstd2[t];
    }
    if (blockIdx.x < 32) {
        const int e = blockIdx.x; const int c = (int)__hip_atomic_load((const unsigned*)(ws + WS_CTL) + CW_GCOUNT + e, __ATOMIC_RELAXED, __HIP_MEMORY_SCOPE_AGENT);
        const int r0 = (int)MISC[MI_PSTART + e] + c, r1 = (int)MISC[MI_PSTART + e + 1];
        for (int r = r0 + threadIdx.x; r < r1; r += NTHREADS) { rowtok[r] = 0; rowscale[r] = 0.f; }
    }
}
__device__ __forceinline__ void p12_final(const Args& a, int wave, int lane) {
    unsigned char* ws = a.ws; const int gw = blockIdx.x * NWAVES + wave, NGW = gridDim.x * NWAVES;
    const int* pos = (const int*)(ws + WS_POS); const float* gatew = (const float*)(ws + WS_GATEW); const unsigned char* Y = ws + WS_Y;
    f32x4 g[4];
#pragma unroll
    for (int j = 0; j < 4; ++j) g[j] = ((const f32x4*)a.in[18])[lane + 64 * j];
    for (int t = gw; t < T; t += NGW) {
        f32x4* xr = (f32x4*)(a.out + (size_t)t * DM) + lane;
        f32x4 v[4];
#pragma unroll
        for (int j = 0; j < 4; ++j) v[j] = xr[64 * j];
#ifndef DBG_NO_MOE
#pragma unroll
        for (int k = 0; k < 4; ++k) {
            const int row = pos[t * 4 + k]; const float w = gatew[t * 4 + k] * (1.f / 16.f);
            const unsigned* yr = (const unsigned*)(Y + (size_t)row * DM) + lane;
#pragma unroll
            for (int j = 0; j < 4; ++j) { const int y = (int)yr[64 * j]; const f32x2 lo = __builtin_amdgcn_cvt_pk_f32_fp8(y, false), hi = __builtin_amdgcn_cvt_pk_f32_fp8(y, true);
                v[j].x += w * lo.x; v[j].y += w * lo.y; v[j].z += w * hi.x; v[j].w += w * hi.y; }
        }
#endif
        float s2 = 0.f;
#pragma unroll
        for (int j = 0; j < 4; ++j) s2 += (v[j].x * v[j].x + v[j].y * v[j].y) + (v[j].z * v[j].z + v[j].w * v[j].w);
        const float rstd = 1.f / sqrtf(wave_sum(s2) * (1.f / DM) + EPS);
#pragma unroll
        for (int j = 0; j < 4; ++j) xr[64 * j] = v[j] * rstd * g[j];
    }
}

#ifdef MLA_CHECK
constexpr size_t CK_BASE = 225 * MiB;
constexpr size_t CK_CKVN = CK_BASE, CK_KRR = CK_CKVN + (size_t)T * 128 * 4, CK_KN = CK_KRR + (size_t)T * 32 * 4, CK_VV = CK_KN + (size_t)T * 512 * 4, CK_QS = CK_VV + (size_t)T * 512 * 4;
constexpr int CK_NS = 16;
constexpr size_t CK_OBS = 224 * MiB;
__device__ __forceinline__ int ck_tok(int i) { const int tb[16] = {0, 1, 255, 256, 4097, 8191, 12345, 16383, 16384, 16385, 20000, 24575, 24576, 30001, 32766, 32767}; return tb[i]; }
__device__ __forceinline__ float blk_sum(float v, float* red) {
    v = wave_sum(v); __syncthreads(); if ((threadIdx.x & 63) == 0) red[threadIdx.x >> 6] = v; __syncthreads(); return red[0] + red[1] + red[2] + red[3];
}
__global__ void __launch_bounds__(256) ck_kv(const float* x, const float* g1, const float* w_in, const float* gkv, const float* w_uk, const float* w_uv, unsigned char* ws) {
    __shared__ float hn[1024]; __shared__ float red[4]; __shared__ float c[160]; __shared__ float cn[128];
    const int t = blockIdx.x, tid = threadIdx.x;
    float s2 = 0.f; for (int k = tid; k < 1024; k += 256) { const float v = x[(size_t)t * 1024 + k]; s2 += v * v; }
    const float rstd = 1.f / sqrtf(blk_sum(s2, red) / 1024.f + EPS);
    for (int k = tid; k < 1024; k += 256) hn[k] = x[(size_t)t * 1024 + k] * rstd * g1[k];
    __syncthreads();
    if (tid < 160) { float acc = 0.f; for (int k = 0; k < 1024; ++k) acc += hn[k] * w_in[(size_t)k * 4000 + 1792 + tid]; c[tid] = acc; }
    __syncthreads();
    const float q2 = blk_sum(tid < 128 ? c[tid] * c[tid] : 0.f, red); const float r2 = 1.f / sqrtf(q2 / 128.f + EPS);
    if (tid < 128) cn[tid] = c[tid] * r2 * gkv[tid];
    if (tid < 16) { const f32x2 cs = rope_cs(t & (SEQ - 1), tid); const float x1 = c[128 + tid], x2 = c[128 + 16 + tid];
        ((float*)(ws + CK_KRR))[(size_t)t * 32 + tid] = x1 * cs.x - x2 * cs.y; ((float*)(ws + CK_KRR))[(size_t)t * 32 + 16 + tid] = x2 * cs.x + x1 * cs.y; }
    __syncthreads();
    for (int o = tid; o < 512; o += 256) { float a = 0.f, b = 0.f; for (int k = 0; k < 128; ++k) { a += cn[k] * w_uk[(size_t)k * 512 + o]; b += cn[k] * w_uv[(size_t)k * 512 + o]; }
        ((float*)(ws + CK_KN))[(size_t)t * 512 + o] = a; ((float*)(ws + CK_VV))[(size_t)t * 512 + o] = b; }
}
__global__ void __launch_bounds__(256) ck_q(const float* x, const float* g1, const float* w_in, const float* gq, const float* w_uq, unsigned char* ws) {
    __shared__ float hn[1024]; __shared__ float red[4]; __shared__ float c[256]; __shared__ float qq[768];
    const int t = ck_tok(blockIdx.x), tid = threadIdx.x;
    float s2 = 0.f; for (int k = tid; k < 1024; k += 256) { const float v = x[(size_t)t * 1024 + k]; s2 += v * v; }
    const float rstd = 1.f / sqrtf(blk_sum(s2, red) / 1024.f + EPS);
    for (int k = tid; k < 1024; k += 256) hn[k] = x[(size_t)t * 1024 + k] * rstd * g1[k];
    __syncthreads();
    { float acc = 0.f; for (int k = 0; k < 1024; ++k) acc += hn[k] * w_in[(size_t)k * 4000 + 1536 + tid]; c[tid] = acc; }
    __syncthreads();
    const float q2 = blk_sum(c[tid] * c[tid], red); const float r2 = 1.f / sqrtf(q2 / 256.f + EPS);
    __syncthreads(); c[tid] = c[tid] * r2 * gq[tid]; __syncthreads();
    for (int o = tid; o < 768; o += 256) { float a = 0.f; for (int k = 0; k < 256; ++k) a += c[k] * w_uq[(size_t)k * 768 + o]; qq[o] = a; }
    __syncthreads();
    if (tid < 128) { const int hh = tid >> 4, i = tid & 15; const f32x2 cs = rope_cs(t & (SEQ - 1), i); const float x1 = qq[hh * 96 + 64 + i], x2 = qq[hh * 96 + 80 + i];
        qq[hh * 96 + 64 + i] = x1 * cs.x - x2 * cs.y; qq[hh * 96 + 80 + i] = x2 * cs.x + x1 * cs.y; }
    __syncthreads();
    for (int o = tid; o < 768; o += 256) ((float*)(ws + CK_QS))[(size_t)blockIdx.x * 768 + o] = qq[o] * 0.10206207261596577f;
}
__global__ void __launch_bounds__(256) ck_attn(unsigned char* ws, unsigned* flag) {
    __shared__ float q[96]; __shared__ float red[4]; __shared__ float part[256]; __shared__ float sc[SEQ];
    const int si = blockIdx.x >> 3, h = blockIdx.x & 7, t = ck_tok(si), b = t >> 14, tid = threadIdx.x;
    const float* KN = (const float*)(ws + CK_KN); const float* VV = (const float*)(ws + CK_VV); const float* KRR = (const float*)(ws + CK_KRR);
    if (tid < 96) q[tid] = ((const float*)(ws + CK_QS))[(size_t)si * 768 + h * 96 + tid];
    __syncthreads();
    float mx = -1e30f;
    for (int s = tid; s < SEQ; s += 256) { const size_t ts = (size_t)b * SEQ + s; float a = 0.f; for (int e = 0; e < 64; ++e) a += q[e] * KN[ts * 512 + h * 64 + e]; for (int e = 0; e < 32; ++e) a += q[64 + e] * KRR[ts * 32 + e]; sc[s] = a; mx = fmaxf(mx, a); }
    for (int o = 1; o < 64; o <<= 1) mx = fmaxf(mx, __shfl_xor(mx, o));
    __syncthreads(); if ((tid & 63) == 0) red[tid >> 6] = mx; __syncthreads(); mx = fmaxf(fmaxf(red[0], red[1]), fmaxf(red[2], red[3])); __syncthreads();
    float l = 0.f;
    for (int s = tid; s < SEQ; s += 256) { const float p = expf(sc[s] - mx); sc[s] = p; l += p; }
    l = blk_sum(l, red);
    const int e = tid & 63, g = tid >> 6; float o = 0.f;
    for (int s = g; s < SEQ; s += 4) o += sc[s] * VV[((size_t)b * SEQ + s) * 512 + h * 64 + e];
    part[tid] = o; __syncthreads();
    if (tid < 64) { const float ref = (part[tid] + part[64 + tid] + part[128 + tid] + part[192 + tid]) / l, got = bf2f(((const bf16_t*)(ws + CK_OBS))[(size_t)si * 512 + h * 64 + tid]);
        atomicMax(flag, __float_as_uint(fabsf(ref - got))); atomicMax(flag + 1, __float_as_uint(fabsf(ref))); }
}
__global__ void ck_apply(float* out, const unsigned* flag) {
    const float d = __uint_as_float(flag[0]), r = __uint_as_float(flag[1]);
    const bool bad = !(r > 0.f) || !(d <= MLA_CHECK_TOL * r);
    if (bad) for (size_t i = (size_t)blockIdx.x * blockDim.x + threadIdx.x; i < (size_t)T * DM; i += (size_t)gridDim.x * blockDim.x) out[i] = __builtin_nanf("");
}
#endif

constexpr int N_PHASES = 13;
#ifndef MOE_REV
#define MOE_REV false
#endif
#ifndef ALIGN_MOE
#define ALIGN_MOE true
#endif
#ifndef REP0
#define REP0 1
#endif
#ifndef REP1
#define REP1 1
#endif
#ifndef REP3
#define REP3 1
#endif
#ifndef REP5
#define REP5 1
#endif
#ifndef REP7
#define REP7 1
#endif
#ifndef REP10
#define REP10 1
#endif
#ifndef REP11
#define REP11 1
#endif
#ifndef MK_ONE_LAUNCH
#define MK_ONE_LAUNCH 0
#endif
__global__ void __launch_bounds__(NTHREADS, 2) fwd(Args args) {
    extern __shared__ __attribute__((aligned(16))) unsigned char lds_raw[];
    LAS unsigned char* lds = (LAS unsigned char*)lds_raw;
    volatile LAS unsigned* MISC = (volatile LAS unsigned*)(lds + MISC_OFF);
    const int tid = threadIdx.x, wave = __builtin_amdgcn_readfirstlane(tid >> 6);
#define lane lane_now()
    const int G = gridDim.x, bx = blockIdx.x;
    unsigned char* ws = args.ws;
    for (int u = tid; u < (LDS_BYTES - MISC_OFF) / 4; u += NTHREADS) ((LAS unsigned*)(lds + MISC_OFF))[u] = 0u;
    __syncthreads();
    XcdBarrier bar; bar.bar = (unsigned*)(ws + WS_CTL) + CW_BAR; bar.x = 0; bar.st = nullptr;
    if (MK_ONE_LAUNCH) bar = xcd_barrier_post((unsigned*)(ws + WS_CTL) + CW_BAR, MISC + MI_BAR);
    const int lo = args.ph_lo, hi = args.ph_hi;
#ifdef ONLY_PHASE
#define IN(k) ((k) == ONLY_PHASE && lo <= (k) && (k) < hi)
#else
#define IN(k) (lo <= (k) && (k) < hi)
#endif
#define SEAM(k) do { if (IN(k) && IN((k) + 1)) xcd_barrier(bar); } while (0)
#ifdef SKEW_TICKS
#define SKEW() do { const unsigned long long t0_ = __builtin_amdgcn_s_memrealtime(); const unsigned long long d_ = (unsigned long long)((bx >> 3) & 7) * SKEW_TICKS; while (__builtin_amdgcn_s_memrealtime() - t0_ < d_) __builtin_amdgcn_s_sleep(4); } while (0)
#else
#define SKEW() do { } while (0)
#endif

#ifndef NCONV
#define NCONV 0
#endif
#ifndef XW_P0_ITEMS
#define XW_P0_ITEMS 17408
#endif
#ifdef XW_ITEM64
    constexpr int XW_ALL = XW_NI;
#else
    constexpr int XW_ALL = 32 * 16 * 64 + 32 * 16 * 32;
#endif
    const int nconv = (G >= 4 * NCONV && ((G - NCONV) & 7) == 0) ? NCONV : 0, NGM = G - nconv, xw_p0 = nconv ? XW_P0_ITEMS : XW_ALL;
    if (IN(0)) { p0_prologue(args, lds, wave, lane, xw_p0);
#if defined(PROBE_RD_A) || defined(PROBE_RD_B)
        p0_probe_read(args, wave, lane);
#endif
#if REP0 > 1
        p0_prologue(args, lds, wave, lane, xw_p0);
#endif
    } SEAM(0);
#ifdef INPROJ_FP8
#define PH1_BODY { pg8::DenseSched S; S.init((const bf16_t*)(ws + WS_XB), (const bf16_t*)(ws + WS_WIN), T, NIN, 512, NGM, bx); EpiInProj E{ws, lds}; \
        pg8::gemm_phase2<EpiInProj, pg8::DenseSched, true, true, 121>(lds, 512, S, E); }
#else
#define PH1_BODY { pg8::DenseSched S; S.init((const bf16_t*)(ws + WS_XB), (const bf16_t*)(ws + WS_WIN), T, NIN, 1024, NGM, bx); EpiInProj E{ws, lds}; \
        pg8::gemm_phase2<EpiInProj, pg8::DenseSched, true>(lds, 1024, S, E); }
#endif
    if (IN(1)) { if (bx < NGM) PH1_BODY else p0_experts(args, lds, wave, lane, (bx - NGM) * NWAVES + wave, nconv * NWAVES, xw_p0, XW_ALL);
#if REP1 > 1
        PH1_BODY
#endif
    } SEAM(1);
#ifdef P2_PHASE
    if (IN(2)) { p2_stats(args, wave, lane); } SEAM(2);
#endif
#define PH3_BODY { { pg8::DenseSched S; S.init((const bf16_t*)(ws + WS_CQ), (const bf16_t*)(ws + WS_WUQ), T, 768, 256, G, bx); EpiQ E{ws}; \
          pg8::gemm_phase2<EpiQ, pg8::DenseSched, true>(lds, 256, S, E); } \
        { pg8::DenseSched S; S.init((const bf16_t*)(ws + WS_CKV), (const bf16_t*)(ws + WS_WUKV), T, 1024, 128, G, bx); EpiKV E{ws}; \
          pg8::gemm_phase2<EpiKV, pg8::DenseSched, true>(lds, 128, S, E); } }
    if (IN(3)) { PH3_BODY
#if REP3 > 1
        PH3_BODY
#endif
    } SEAM(3);
    if (IN(4)) { p4_dilated(args, lds, MISC, wave, lane);
#ifdef REP_DIL
        p4_dilated(args, lds, MISC, wave, lane);
#endif
    } SEAM(4);
#if defined(CLK_PROBE) || defined(TIME_PROBE)
    unsigned long long ck0_ = 0, rt0_ = 0, ck1_ = 0, rt1_ = 0;
#endif
    if (IN(5)) { p5_combine(args, wave, lane);
#if defined(CLK_PROBE) || defined(TIME_PROBE)
        ck0_ = __builtin_amdgcn_s_memtime(); rt0_ = __builtin_amdgcn_s_memrealtime();
#endif
        p5_mla(args, lds, wave, lane);
#if defined(CLK_PROBE) || defined(TIME_PROBE)
        ck1_ = __builtin_amdgcn_s_memtime(); rt1_ = __builtin_amdgcn_s_memrealtime();
#endif
#ifdef REP_MLA
        p5_mla(args, lds, wave, lane);
#endif
    } SEAM(5);
#ifdef MLA_CHECK
    if (IN(6) && bx == 0) { for (int i = tid; i < CK_NS * 512; i += NTHREADS) ((bf16_t*)(ws + CK_OBS))[i] = ((const bf16_t*)(ws + WS_OB))[(size_t)ck_tok(i >> 9) * 512 + (i & 511)]; }
#endif
    if (IN(6)) {
#ifdef OAB_FP8
        { pg8::TwoSegSched S; S.init((const bf16_t*)(ws + WS_OA), (const bf16_t*)(ws + WS_WA), (const bf16_t*)(ws + WS_OB), (const bf16_t*)(ws + WS_WB), T, 1024, 256, G, bx); EpiGateFused E{ws};
          pg8::gemm_phase2<EpiGateFused, pg8::TwoSegSched, true, true, 116>(lds, 256, S, E); }
#else
        { pg8::TwoSegSched S; S.init((const bf16_t*)(ws + WS_OA), (const bf16_t*)(ws + WS_WA), (const bf16_t*)(ws + WS_OB), (const bf16_t*)(ws + WS_WB), T, 1024, 512, G, bx); EpiGateFused E{ws};
          pg8::gemm_phase2<EpiGateFused, pg8::TwoSegSched, true>(lds, 512, S, E); }
#endif
    } SEAM(6);
#ifdef WO_FP8
#define PH7_BODY { pg8::DenseSched S; S.init((const bf16_t*)(ws + WS_MERGED), (const bf16_t*)(ws + WS_WO), T, 1024, 512, G, bx); EpiResid E{ws, args.in[0], args.out}; \
        pg8::gemm_phase2<EpiResid, pg8::DenseSched, true, true, 116>(lds, 512, S, E); }
#else
#define PH7_BODY { pg8::DenseSched S; S.init((const bf16_t*)(ws + WS_MERGED), (const bf16_t*)(ws + WS_WO), T, 1024, 1024, G, bx); EpiResid E{ws, args.in[0], args.out}; \
        pg8::gemm_phase2<EpiResid, pg8::DenseSched, true>(lds, 1024, S, E); }
#endif
    if (IN(7)) { PH7_BODY
#if REP7 > 1
        PH7_BODY
#endif
    } SEAM(7);
    if (IN(8)) { p8_router(args, lds, MISC, wave, lane); } SEAM(8);
    if (IN(9)) { p9_scatter(args, MISC); } SEAM(9);
#define PH10_BODY { moe_prefix(args, MISC); \
        pg8::MoeSched<3, true> S; S.tpre = (const LAS int*)(MISC + MI_TPRE); S.ntiles = (int)MISC[MI_TPRE + 32]; S.G = G; S.c = bx; S.K = 512; \
        S.A = (const char*)(ws + WS_H2); S.Bt = (const char*)(ws + WS_WGU); S.estride = (size_t)2048 * 1024; S.row_tok = (const int*)(ws + WS_ROWTOK); \
        EpiSwiglu E{ws, args.in[15]}; \
        pg8::gemm_phase2<EpiSwiglu, pg8::MoeSched<3, true>, ALIGN_MOE, true, 121>(lds, 512, S, E); }
    if (IN(10)) { SKEW(); PH10_BODY
#if REP10 > 1
        PH10_BODY
#endif
    } SEAM(10);
#define PH11_BODY { moe_prefix(args, MISC); \
        pg8::MoeSched<2, false, MOE_REV> S; S.tpre = (const LAS int*)(MISC + MI_TPRE); S.ntiles = (int)MISC[MI_TPRE + 32]; S.G = G; S.c = bx; S.K = 512; \
        S.A = (const char*)(ws + WS_ACT); S.Bt = (const char*)(ws + WS_WD); S.estride = (size_t)1024 * 1024; S.row_tok = nullptr; \
        EpiDown E{ws, args.in[17]}; \
        pg8::gemm_phase2<EpiDown, pg8::MoeSched<2, false, MOE_REV>, ALIGN_MOE, true, 121>(lds, 512, S, E); }
    if (IN(11)) { SKEW(); PH11_BODY
#if REP11 > 1
        PH11_BODY
#endif
    } SEAM(11);
    if (IN(12)) { p12_final(args, wave, lane); }
#ifdef CLK_PROBE
    if (IN(12) && bx == 0) { __syncthreads(); const float mhz = 500.f * __builtin_rintf(0.2f * (float)(ck1_ - ck0_) / (float)(rt1_ - rt0_)); for (int i = tid; i < 1024; i += NTHREADS) args.out[i] = mhz; }
#endif
#ifdef TIME_PROBE
    if (IN(12) && bx == 0) { __syncthreads(); const float us = 0.01f * (float)(rt1_ - rt0_) - (float)(TIME_PROBE); for (int i = tid; i < 1024; i += NTHREADS) args.out[i] = 1000.f * us; }
#endif
#ifdef PROBE_FP8NAN
    if (IN(12) && bx == 0 && wave == 0) {
        typedef int v8i_ __attribute__((ext_vector_type(8))); typedef short v2s_ __attribute__((ext_vector_type(2)));
        float big = 1.0e5f, one = 1.0f, sc = 16.0f; asm volatile("" : "+v"(big), "+v"(one), "+v"(sc));
        v2s_ u = {0, 0}; u = __builtin_amdgcn_cvt_scalef32_pk_fp8_f32(u, big, one, sc, false); u = __builtin_amdgcn_cvt_scalef32_pk_fp8_f32(u, one, one, sc, true);
        int w = __builtin_bit_cast(int, u); asm volatile("" : "+v"(w));
        const bool cvt_nan = ((w & 0x7f) == 0x7f);
        v8i_ A = {w, w, w, w, w, w, w, w}, B = {0x38383838, 0x38383838, 0x38383838, 0x38383838, 0x38383838, 0x38383838, 0x38383838, 0x38383838};
        f32x16 c = __builtin_amdgcn_mfma_scale_f32_32x32x64_f8f6f4(A, B, f32x16{}, 0, 0, 0, 0x7f7f7f7f, 0, 0x7f7f7f7f);
        asm volatile("" : "+v"(c));
        const bool mf_nan = (c[0] != c[0]) && (c[5] != c[5]) && (c[15] != c[15]);
        if (lane == 0) { if (!cvt_nan) args.out[0] = 3.0e6f; if (!mf_nan) args.out[1] = 7.0e6f; }
    }
#endif
#undef IN
#undef SEAM
#undef lane
}

extern "C" void kernel_launch(void* const* d_in, const int* in_sizes, int n_in, void* d_out, int out_size, void* d_ws, size_t ws_size, hipStream_t stream) {
    static int grid = 0;
    if (grid == 0) {
        if (n_in != 19 || in_sizes[0] != T * DM || out_size != T * DM || ws_size < WS_END) { fprintf(stderr, "kernel_launch: unexpected shapes (n_in %d, in0 %d, out %d, ws %zu); nothing launched\n", n_in, n_in > 0 ? in_sizes[0] : -1, out_size, ws_size); grid = -1; return; }
        int dev = 0, cus = 0, per_cu = 0;
        if (hipGetDevice(&dev) != hipSuccess || hipDeviceGetAttribute(&cus, hipDeviceAttributeMultiprocessorCount, dev) != hipSuccess) { grid = -1; return; }
        if (hipFuncSetAttribute((const void*)fwd, hipFuncAttributeMaxDynamicSharedMemorySize, LDS_BYTES) != hipSuccess) { fprintf(stderr, "kernel_launch: hipFuncSetAttribute failed\n"); grid = -1; return; }
        if (hipOccupancyMaxActiveBlocksPerMultiprocessor(&per_cu, (const void*)fwd, NTHREADS, LDS_BYTES) != hipSuccess || per_cu < 1) fprintf(stderr, "kernel_launch: occupancy query reports %d\n", per_cu);
        (void)hipGetLastError();
        grid = cus;
    }
    if (grid < 0) return;
    if (hipMemsetAsync((char*)d_ws + WS_CTL, 0, CTL_ZERO_BYTES, stream) != hipSuccess) { fprintf(stderr, "kernel_launch: memset failed\n"); return; }
    Args a{};
    for (int i = 0; i < 19; ++i) a.in[i] = (const float*)d_in[i];
    a.out = (float*)d_out; a.ws = (unsigned char*)d_ws; a.li = 0; a.pad = 0;
#if MK_ONE_LAUNCH
    a.ph_lo = 0; a.ph_hi = N_PHASES;
    hipLaunchKernelGGL(fwd, dim3(grid), dim3(NTHREADS), LDS_BYTES, stream, a);
#else
    for (int p = 0; p < N_PHASES; ++p) {
        a.ph_lo = p; a.ph_hi = p + 1; hipLaunchKernelGGL(fwd, dim3(grid), dim3(NTHREADS), LDS_BYTES, stream, a); }

#endif
#ifdef MLA_CHECK
    {   unsigned* flag = (unsigned*)((unsigned char*)d_ws + WS_CTL) + 16384;
        hipLaunchKernelGGL(ck_kv, dim3(T), dim3(256), 0, stream, a.in[0], a.in[1], a.in[2], a.in[4], a.in[6], a.in[7], (unsigned char*)d_ws);
        hipLaunchKernelGGL(ck_q, dim3(CK_NS), dim3(256), 0, stream, a.in[0], a.in[1], a.in[2], a.in[3], a.in[5], (unsigned char*)d_ws);
        hipLaunchKernelGGL(ck_attn, dim3(CK_NS * 8), dim3(256), 0, stream, (unsigned char*)d_ws, flag);
        hipLaunchKernelGGL(ck_apply, dim3(1024), dim3(256), 0, stream, (float*)d_out, (const unsigned*)flag); }
#endif
    const hipError_t le = hipPeekAtLastError();
    if (le != hipSuccess) fprintf(stderr, "kernel_launch: launch failed: %s\n", hipGetErrorName(le));
}
```
